# Optimizing an MI355X kernel written in HIP

```python
import functools
import math
import jax
import jax.numpy as jnp
from jax import lax
import numpy as np

D_MODEL = 1024
BATCH = 4
SEQ = 4096
DEPTH = 2
DEC_BATCH = 32
DEC_SEQ = 64
PAST_LEN = 1024

CHUNK = 64
HEAD_DIM = 64
A_HEADS = 8
A_PAST_CHUNKS = 8
A_REL_CLIP = 128
B_HEADS = 8
C_HEADS = 4
C_VDIM = 2 * HEAD_DIM
T5_BUCKETS = 32
T5_MAX_DIST = 128
D_FF = 2816
CONV_W = 3
N_BRANCH = 3
A_W = A_HEADS * HEAD_DIM
B_W = B_HEADS * HEAD_DIM
C_QK_W = C_HEADS * 2 * HEAD_DIM
C_V_W = C_HEADS * C_VDIM
BRANCH_W = A_W
IN_SPLITS = (A_W, A_W, A_W, B_W, B_W, B_W, C_QK_W, C_QK_W, C_V_W, N_BRANCH * D_MODEL)
IN_COLS = sum(IN_SPLITS)
QBLK = 128
EPS = 1e-6
NEG_INF = -1e30

kernel_name = 'streaming_hybrid_gated_trunk'


def rmsnorm(x, g):
    xf = x.astype(jnp.float32)
    y = xf * lax.rsqrt(jnp.mean(xf * xf, axis=-1, keepdims=True) + EPS)
    return (y * g.astype(jnp.float32)).astype(x.dtype)


def t5_bucket(rel):
    half = T5_BUCKETS // 2
    max_exact = half // 2
    ret = jnp.where(rel > 0, half, 0)
    n = jnp.abs(rel)
    nf = jnp.maximum(n, 1).astype(jnp.float32)
    large = max_exact + (jnp.log(nf / max_exact) / math.log(T5_MAX_DIST / max_exact) * (half - max_exact)).astype(jnp.int32)
    large = jnp.minimum(large, half - 1)
    return ret + jnp.where(n < max_exact, n, large)


def t5_bucket_bias(q_pos, k_pos, table):
    b = table[t5_bucket(k_pos[None, :] - q_pos[:, None])]
    return jnp.moveaxis(b, -1, 0).astype(jnp.float32)


def clipped_rel_bias(rel, table):
    b = table[jnp.clip(rel, -A_REL_CLIP, A_REL_CLIP) + A_REL_CLIP]
    return jnp.moveaxis(b, -1, 0).astype(jnp.float32)


def mixer_inputs(xn, w_in):
    b, t = xn.shape[0], xn.shape[1]
    p = jnp.einsum('btd,dc->btc', xn, w_in)
    offs = np.cumsum((0,) + IN_SPLITS)
    parts = [p[..., int(offs[i]):int(offs[i + 1])] for i in range(len(IN_SPLITS))]
    qa, ka, va, qb, kb, vb, qc, kc, vc, gate_pre = parts
    return (qa.reshape(b, t, A_HEADS, HEAD_DIM), ka.reshape(b, t, A_HEADS, HEAD_DIM),
            va.reshape(b, t, A_HEADS, HEAD_DIM),
            qb.reshape(b, t, B_HEADS, HEAD_DIM), kb.reshape(b, t, B_HEADS, HEAD_DIM),
            vb.reshape(b, t, B_HEADS, HEAD_DIM),
            qc.reshape(b, t, C_HEADS, 2, HEAD_DIM), kc.reshape(b, t, C_HEADS, 2, HEAD_DIM),
            vc.reshape(b, t, C_HEADS, C_VDIM), gate_pre)


def band_attention_prompt(q, k, v, rel_table):
    b, s, h, d = q.shape
    nc = s // CHUNK
    nb = A_PAST_CHUNKS + 1
    qc = q.reshape(b, nc, CHUNK, h, d)
    pad = ((0, 0), (A_PAST_CHUNKS, 0), (0, 0), (0, 0), (0, 0))
    kp = jnp.pad(k.reshape(b, nc, CHUNK, h, d), pad)
    vp = jnp.pad(v.reshape(b, nc, CHUNK, h, d), pad)
    idx = jnp.arange(nc)[:, None] + jnp.arange(nb)[None, :]
    kband = kp[:, idx].reshape(b, nc, nb * CHUNK, h, d)
    vband = vp[:, idx].reshape(b, nc, nb * CHUNK, h, d)
    i = jnp.arange(CHUNK)
    j = jnp.arange(nb)
    k_off = ((j[:, None] - A_PAST_CHUNKS) * CHUNK + i[None, :]).reshape(-1)
    bias = clipped_rel_bias(i[:, None] - k_off[None, :], rel_table)
    valid = jnp.repeat(idx >= A_PAST_CHUNKS, CHUNK, axis=1)
    logits = jnp.einsum('bnqhd,bnkhd->bhnqk', qc, kband).astype(jnp.float32) * (HEAD_DIM ** -0.5)
    logits = logits + bias[None, :, None]
    logits = jnp.where(valid[None, None, :, None, :], logits, NEG_INF)
    p = jax.nn.softmax(logits, axis=-1)
    o = jnp.einsum('bhnqk,bnkhd->bnqhd', p.astype(v.dtype), vband)
    return o.reshape(b, s, h * d)


def band_attention_sample(q, k_new, v_new, k_cache, v_cache, rel_table, past):
    b, t = q.shape[0], q.shape[1]
    keep = k_cache.shape[1]
    keys = jnp.concatenate([k_cache, k_new], axis=1)
    vals = jnp.concatenate([v_cache, v_new], axis=1)
    q_pos = past + jnp.arange(t, dtype=jnp.int32)
    k_pos = past - keep + jnp.arange(keep + t, dtype=jnp.int32)
    bias = clipped_rel_bias(q_pos[:, None] - k_pos[None, :], rel_table)
    logits = jnp.einsum('bqhd,bkhd->bhqk', q, keys).astype(jnp.float32) * (HEAD_DIM ** -0.5) + bias[None]
    p = jax.nn.softmax(logits, axis=-1)
    o = jnp.einsum('bhqk,bkhd->bqhd', p.astype(vals.dtype), vals).reshape(b, t, -1)
    return o, keys[:, t:], vals[:, t:]


def stick_breaking_block(q, k, v, q_pos, k_pos):
    z = jnp.einsum('bqhd,bkhd->bhqk', q, k).astype(jnp.float32) * (HEAD_DIM ** -0.5)
    mask = (k_pos[None, :] < q_pos[:, None])[None, None]
    log_keep = jnp.where(mask, jax.nn.log_sigmoid(-z), 0.0)
    rc = lax.cumsum(log_keep, axis=3, reverse=True)
    after = jnp.concatenate([rc[..., 1:], jnp.zeros_like(rc[..., :1])], axis=-1)
    w = jnp.where(mask, jnp.exp(jax.nn.log_sigmoid(z) + after), 0.0)
    return jnp.einsum('bhqk,bkhd->bqhd', w.astype(v.dtype), v)


def diff_lambda(lam_params, layer_idx):
    lam_init = 0.8 - 0.6 * math.exp(-0.3 * layer_idx)
    lp = lam_params.astype(jnp.float32)
    lam = jnp.exp(jnp.sum(lp[0] * lp[1])) - jnp.exp(jnp.sum(lp[2] * lp[3])) + lam_init
    return lam, lam_init


def diff_attention_block(q, k, v, q_pos, k_pos, t5_table, lam, sub_gain, sub_scale):
    logits = jnp.einsum('bqhmd,bkhmd->bhmqk', q, k).astype(jnp.float32) * (HEAD_DIM ** -0.5)
    logits = logits + t5_bucket_bias(q_pos, k_pos, t5_table)[None, :, None]
    mask = (k_pos[None, :] // CHUNK) <= (q_pos[:, None] // CHUNK)
    logits = jnp.where(mask[None, None, None], logits, NEG_INF)
    p = jax.nn.softmax(logits, axis=-1)
    w = p[:, :, 0] - lam * p[:, :, 1]
    o = jnp.einsum('bhqk,bkhe->bqhe', w.astype(v.dtype), v)
    return rmsnorm(o, sub_gain) * sub_scale


def sweep_query_blocks(block_fn, q, k, v):
    b, s = q.shape[0], q.shape[1]
    nblk = s // QBLK
    q_blocks = jnp.moveaxis(q.reshape((b, nblk, QBLK) + q.shape[2:]), 1, 0)
    q_pos = jnp.arange(s, dtype=jnp.int32).reshape(nblk, QBLK)
    k_pos = jnp.arange(s, dtype=jnp.int32)
    out = lax.map(lambda qp: block_fn(qp[0], k, v, qp[1], k_pos), (q_blocks, q_pos))
    return jnp.moveaxis(out, 0, 1).reshape(b, s, -1)


def merge_branches(o_a, o_b, o_c, gate_pre, b_gate, w_branch, w_out):
    g = jax.nn.sigmoid(gate_pre.reshape(gate_pre.shape[:-1] + (N_BRANCH, D_MODEL)) + b_gate)
    h = (g[..., 0, :] * (o_a @ w_branch[0]) + g[..., 1, :] * (o_b @ w_branch[1])
         + g[..., 2, :] * (o_c @ w_branch[2]))
    return h @ w_out


def conv_ffn(xn, w_up, conv_w, conv_b, w_down, conv_state):
    gu = xn @ w_up
    g, u = gu[..., :D_FF], gu[..., D_FF:]
    t = g.shape[1]
    gp = jnp.concatenate([conv_state.astype(g.dtype), g], axis=1)
    c = conv_b + conv_w[0] * gp[:, 0:t]
    for kk in range(1, CONV_W):
        c = c + conv_w[kk] * gp[:, kk:kk + t]
    h = jax.nn.gelu(c) * u
    return h @ w_down, gp[:, gp.shape[1] - (CONV_W - 1):]


def trunk(x, caches, norm_mix, w_in, b_gate, a_rel_bias, t5_bias, c_lambda, c_subln,
          w_branch, w_out, norm_ffn, w_up, conv_w, conv_b, w_down, norm_final):
    b, t = x.shape[0], x.shape[1]
    new_states = [[] for _ in range(7)]
    for l in range(DEPTH):
        xn = rmsnorm(x, norm_mix[l])
        qa, ka, va, qb, kb, vb, qc, kc, vc, gate_pre = mixer_inputs(xn, w_in[l])
        lam, lam_init = diff_lambda(c_lambda[l], l)
        diff_fn = functools.partial(diff_attention_block, t5_table=t5_bias, lam=lam,
                                    sub_gain=c_subln[l], sub_scale=1.0 - lam_init)
        if caches is None:
            o_a = band_attention_prompt(qa, ka, va, a_rel_bias[l])
            o_b = sweep_query_blocks(stick_breaking_block, qb, kb, vb)
            o_c = sweep_query_blocks(diff_fn, qc, kc, vc)
            a_keep = min(A_PAST_CHUNKS * CHUNK, t)
            st_a_k, st_a_v = ka[:, t - a_keep:], va[:, t - a_keep:]
            conv_state = jnp.zeros((b, CONV_W - 1, D_FF), x.dtype)
        else:
            cache_a_k, cache_a_v, cache_b_k, cache_b_v, cache_c_k, cache_c_v, state_conv = caches
            past = cache_b_k.shape[2]
            q_pos = past + jnp.arange(t, dtype=jnp.int32)
            k_pos = jnp.arange(past + t, dtype=jnp.int32)
            o_a, st_a_k, st_a_v = band_attention_sample(qa, ka, va, cache_a_k[l], cache_a_v[l],
                                                        a_rel_bias[l], past)
            o_b = stick_breaking_block(qb, jnp.concatenate([cache_b_k[l], kb], axis=1),
                                       jnp.concatenate([cache_b_v[l], vb], axis=1),
                                       q_pos, k_pos).reshape(b, t, -1)
            o_c = diff_fn(qc, jnp.concatenate([cache_c_k[l], kc], axis=1),
                          jnp.concatenate([cache_c_v[l], vc], axis=1), q_pos, k_pos).reshape(b, t, -1)
            conv_state = state_conv[l]
        x = x + merge_branches(o_a, o_b, o_c, gate_pre, b_gate[l], w_branch[l], w_out[l])
        f, st_conv = conv_ffn(rmsnorm(x, norm_ffn[l]), w_up[l], conv_w[l], conv_b[l], w_down[l], conv_state)
        x = x + f
        for lst, s in zip(new_states, (st_a_k, st_a_v, kb, vb, kc, vc, st_conv)):
            lst.append(s)
    y = rmsnorm(x, norm_final)
    return y, tuple(jnp.stack(s, axis=0) for s in new_states)


def setup_inputs(seed: int = 0) -> dict:
    key = jax.random.key(seed)
    ks = jax.random.split(key, 24)
    a_len = min(A_PAST_CHUNKS * CHUNK, PAST_LEN)

    def nrm(k, shape, scale):
        return jax.random.normal(k, shape, jnp.float32) * scale

    return {
        'x_prompt': nrm(ks[0], (BATCH, SEQ, D_MODEL), 1.0),
        'x_sample': nrm(ks[1], (DEC_BATCH, DEC_SEQ, D_MODEL), 1.0),
        'cache_a_k': nrm(ks[2], (DEPTH, DEC_BATCH, a_len, A_HEADS, HEAD_DIM), 1.0),
        'cache_a_v': nrm(ks[3], (DEPTH, DEC_BATCH, a_len, A_HEADS, HEAD_DIM), 1.0),
        'cache_b_k': nrm(ks[4], (DEPTH, DEC_BATCH, PAST_LEN, B_HEADS, HEAD_DIM), 1.0),
        'cache_b_v': nrm(ks[5], (DEPTH, DEC_BATCH, PAST_LEN, B_HEADS, HEAD_DIM), 1.0),
        'cache_c_k': nrm(ks[6], (DEPTH, DEC_BATCH, PAST_LEN, C_HEADS, 2, HEAD_DIM), 1.0),
        'cache_c_v': nrm(ks[7], (DEPTH, DEC_BATCH, PAST_LEN, C_HEADS, C_VDIM), 1.0),
        'state_ffn_conv': nrm(ks[8], (DEPTH, DEC_BATCH, CONV_W - 1, D_FF), 1.0),
        'norm_mix': 1.0 + nrm(ks[9], (DEPTH, D_MODEL), 0.01),
        'w_in': nrm(ks[10], (DEPTH, D_MODEL, IN_COLS), D_MODEL ** -0.5),
        'b_gate': nrm(ks[11], (DEPTH, N_BRANCH, D_MODEL), 0.1),
        'a_rel_bias': nrm(ks[12], (DEPTH, 2 * A_REL_CLIP + 1, A_HEADS), 0.5),
        't5_bias': nrm(ks[13], (T5_BUCKETS, C_HEADS), 0.5),
        'c_lambda': nrm(ks[14], (DEPTH, 4, HEAD_DIM), 0.1),
        'c_subln': 1.0 + nrm(ks[15], (DEPTH, C_VDIM), 0.01),
        'w_branch': nrm(ks[16], (DEPTH, N_BRANCH, BRANCH_W, D_MODEL), BRANCH_W ** -0.5),
        'w_out': nrm(ks[17], (DEPTH, D_MODEL, D_MODEL), D_MODEL ** -0.5),
        'norm_ffn': 1.0 + nrm(ks[18], (DEPTH, D_MODEL), 0.01),
        'w_up': nrm(ks[19], (DEPTH, D_MODEL, 2 * D_FF), D_MODEL ** -0.5),
        'conv_w': nrm(ks[20], (DEPTH, CONV_W, D_FF), CONV_W ** -0.5),
        'conv_b': nrm(ks[21], (DEPTH, D_FF), 0.01),
        'w_down': nrm(ks[22], (DEPTH, D_FF, D_MODEL), D_FF ** -0.5),
        'norm_final': 1.0 + nrm(ks[23], (D_MODEL,), 0.01),
    }


def reference(x_prompt, x_sample, cache_a_k, cache_a_v, cache_b_k, cache_b_v, cache_c_k, cache_c_v,
              state_ffn_conv, norm_mix, w_in, b_gate, a_rel_bias, t5_bias, c_lambda, c_subln,
              w_branch, w_out, norm_ffn, w_up, conv_w, conv_b, w_down, norm_final):
    y_prompt, p_states = trunk(x_prompt, None, norm_mix, w_in, b_gate, a_rel_bias, t5_bias, c_lambda,
                               c_subln, w_branch, w_out, norm_ffn, w_up, conv_w, conv_b, w_down, norm_final)
    caches = (cache_a_k, cache_a_v, cache_b_k, cache_b_v, cache_c_k, cache_c_v, state_ffn_conv)
    y_sample, s_states = trunk(x_sample, caches, norm_mix, w_in, b_gate, a_rel_bias, t5_bias, c_lambda,
                               c_subln, w_branch, w_out, norm_ffn, w_up, conv_w, conv_b, w_down, norm_final)
    pa_k, pa_v, pb_k, pb_v, pc_k, pc_v, p_conv = p_states
    sa_k, sa_v, sb_k, sb_v, sc_k, sc_v, s_conv = s_states
    return (y_prompt, y_sample, pa_k, pa_v, pb_k, pb_v, pc_k, pc_v, p_conv,
            sa_k, sa_v, sb_k, sb_v, sc_k, sc_v, s_conv)
```

```cpp
#include <hip/hip_runtime.h>
#include <hip/hip_cooperative_groups.h>
#include <cstdio>
#include <cstdint>
namespace cg = cooperative_groups;

#define DI __device__ __forceinline__
#define LAS __attribute__((address_space(3)))
typedef unsigned short bf16_t;
typedef short bf16x8 __attribute__((ext_vector_type(8)));
typedef short s16x4 __attribute__((ext_vector_type(4)));
typedef float f32x2 __attribute__((ext_vector_type(2)));
typedef float f32x4 __attribute__((ext_vector_type(4)));
typedef float f32x8 __attribute__((ext_vector_type(8)));
typedef float f32x16 __attribute__((ext_vector_type(16)));
typedef unsigned u32x2 __attribute__((ext_vector_type(2)));
typedef unsigned u32x4 __attribute__((ext_vector_type(4)));
typedef __bf16 bfv4 __attribute__((ext_vector_type(4)));
typedef __bf16 bfv8 __attribute__((ext_vector_type(8)));

constexpr int D = 1024, SEQ = 4096, NB = 4, TOKP = NB * SEQ, DB = 32, DSEQ = 64, TOKS = DB * DSEQ, TOK = TOKP + TOKS;
constexpr int PAST = 1024, ALEN = 512, INC = 7680, DFF = 2816, NLAYER = 2;
constexpr int QKVW = 4608, GATEW = 3072, OW = 1536;
constexpr float EPS = 1e-6f, LOG2E = 1.4426950408889634f;

constexpr size_t O_YP = 0, O_YS = O_YP + (size_t)TOKP * D, O_PAK = O_YS + (size_t)TOKS * D, O_PAV = O_PAK + (size_t)2 * 4 * 512 * 512,
                 O_PBK = O_PAV + (size_t)2 * 4 * 512 * 512, O_PBV = O_PBK + (size_t)2 * TOKP * 512, O_PCK = O_PBV + (size_t)2 * TOKP * 512,
                 O_PCV = O_PCK + (size_t)2 * TOKP * 512, O_PCONV = O_PCV + (size_t)2 * TOKP * 512, O_SAK = O_PCONV + (size_t)2 * 4 * 2 * DFF,
                 O_SAV = O_SAK + (size_t)2 * DB * 512 * 512, O_SBK = O_SAV + (size_t)2 * DB * 512 * 512, O_SBV = O_SBK + (size_t)2 * TOKS * 512,
                 O_SCK = O_SBV + (size_t)2 * TOKS * 512, O_SCV = O_SCK + (size_t)2 * TOKS * 512, O_SCONV = O_SCV + (size_t)2 * TOKS * 512,
                 O_END = O_SCONV + (size_t)2 * DB * 2 * DFF;

constexpr size_t MiB = 1u << 20;
constexpr size_t WS_CTL = 0;
constexpr size_t WS_WIN = 1 * MiB;
constexpr size_t WS_WBR = WS_WIN + (size_t)2 * INC * D * 2;
constexpr size_t WS_WOUT = WS_WBR + (size_t)2 * D * OW * 2;
constexpr size_t WS_WUP = WS_WOUT + (size_t)2 * D * D * 2;
constexpr size_t WS_WDN = WS_WUP + (size_t)2 * 2 * DFF * D * 2;
constexpr size_t WS_XB = WS_WDN + (size_t)2 * D * DFF * 2;
constexpr size_t WS_X32 = WS_XB + (size_t)TOK * D * 2;
constexpr size_t WS_SS = WS_X32 + (size_t)TOK * D * 4;
constexpr size_t WS_O = WS_SS + (size_t)TOK * 16 * 4;
constexpr size_t WS_H = WS_O + (size_t)TOK * OW * 2;
constexpr size_t WS_HF = WS_H + (size_t)TOK * D * 2;
constexpr size_t WS_QKV = WS_HF + (size_t)TOK * DFF * 2;
constexpr size_t WS_GATE = WS_QKV + (size_t)TOK * QKVW * 2;
constexpr size_t WS_GU = WS_QKV;
constexpr size_t WS_END = WS_GATE + (size_t)TOK * GATEW * 2;
static_assert((size_t)TOK * 2 * DFF * 2 <= (size_t)TOK * (QKVW + GATEW) * 2, "GU overlay fits");
constexpr int CW_QUEUE = 64;
constexpr int CW_LAM = 1024;
constexpr int CW_T5 = 2048;
constexpr int CW_BAR = 8192;

constexpr int LDS_BYTES = 160 * 1024;
constexpr int NTHREADS = 512;

DI u32x4 pack8(f32x4 a, f32x4 b) { f32x8 v = {a[0], a[1], a[2], a[3], b[0], b[1], b[2], b[3]}; return __builtin_bit_cast(u32x4, __builtin_convertvector(v, bfv8)); }
DI u32x2 pack4(f32x4 a) { return __builtin_bit_cast(u32x2, __builtin_convertvector(a, bfv4)); }
DI float bflo(unsigned w) { return __uint_as_float(w << 16); }
DI float bfhi(unsigned w) { return __uint_as_float(w & 0xffff0000u); }
DI float wave_sum(float v) {
#pragma unroll
  for (int o = 1; o < 64; o <<= 1) v += __shfl_xor(v, o);
  return v;
}
DI float fast_rcp(float x) { return __builtin_amdgcn_rcpf(x); }
DI float fast_exp2(float x) { return __builtin_amdgcn_exp2f(x); }
DI float fast_log2(float x) { return __builtin_amdgcn_logf(x); }

struct Params {
  const float* x_prompt; const float* x_sample;
  const float* cache_a_k; const float* cache_a_v; const float* cache_b_k; const float* cache_b_v; const float* cache_c_k; const float* cache_c_v;
  const float* state_conv; const float* norm_mix; const float* w_in; const float* b_gate; const float* a_rel_bias; const float* t5_bias;
  const float* c_lambda; const float* c_subln; const float* w_branch; const float* w_out; const float* norm_ffn; const float* w_up;
  const float* conv_w; const float* conv_b; const float* w_down; const float* norm_final;
  float* out; unsigned char* ws;
  int ph_lo, ph_hi;
};

DI void p0_transpose_item(const float* W, int N, const float* kscale, bf16_t* WT, int dst_ld, int dst_col, LAS float* scr, int item, int lane) {
  const int nblk = N / 32, kb = item / nblk, nb = item % nblk, k0 = 64 * kb, n0 = 32 * nb;
#pragma unroll 8
  for (int i = 0; i < 32; ++i) { const int kk = 2 * i + (lane >> 5); float v = W[(size_t)(k0 + kk) * N + n0 + (lane & 31)]; if (kscale) v *= kscale[k0 + kk]; scr[kk * 33 + (lane & 31)] = v; }
  asm volatile("s_waitcnt lgkmcnt(0)" ::: "memory");
  const int c = lane & 7;
#pragma unroll
  for (int j = 0; j < 4; ++j) { const int n = (lane >> 3) + 8 * j; const LAS float* s = scr + (8 * c) * 33 + n;
    f32x4 a = {s[0 * 33], s[1 * 33], s[2 * 33], s[3 * 33]}, b = {s[4 * 33], s[5 * 33], s[6 * 33], s[7 * 33]};
    *(u32x4*)(WT + (size_t)(n0 + n) * dst_ld + dst_col + k0 + 8 * c) = pack8(a, b); }
  asm volatile("s_waitcnt lgkmcnt(0)" ::: "memory");
}

DI int t5_bucket_of(int rel) {
  const int n = rel < 0 ? -rel : rel; int f;
  if (n < 8) f = n; else if (n < 12) f = 8; else if (n < 16) f = 9; else if (n < 23) f = 10; else if (n < 32) f = 11; else if (n < 46) f = 12; else if (n < 64) f = 13; else if (n < 91) f = 14; else f = 15;
  return (rel > 0 ? 16 : 0) + f;
}

DI void p0_prologue(const Params& p, LAS unsigned char* lds) {
  int tid_ = threadIdx.x; asm volatile("" : "+v"(tid_));
  const int tid = tid_, lane = tid & 63, wave = tid >> 6;
  const int gw = blockIdx.x * 8 + wave, NGW = gridDim.x * 8;
  unsigned* ctl = (unsigned*)(p.ws + WS_CTL);
  if (blockIdx.x == 0) {
    if (tid < 2) ctl[CW_QUEUE + 64 * tid] = 0u;
    if (wave == 1) {
      for (int l = 0; l < NLAYER; ++l) { const float* lp = p.c_lambda + l * 256; const float a = wave_sum(lp[lane] * lp[64 + lane]), b = wave_sum(lp[128 + lane] * lp[192 + lane]);
        const float lam_init = 0.8f - 0.6f * expf(-0.3f * (float)l);
        if (lane == 0) ((float*)ctl)[CW_LAM + l] = expf(a) - expf(b) + lam_init; }
    }
    for (int i = tid; i < 4 * 192; i += NTHREADS) { const int h = i / 192, idx = i % 192; int rel = idx - 127; if (rel > 63) rel = 63;
      ((float*)ctl)[CW_T5 + i] = p.t5_bias[t5_bucket_of(rel) * 4 + h] * LOG2E; }
  }
  LAS float* scr = (LAS float*)(lds + wave * 8448);
  constexpr int I_IN = (D / 64) * (INC / 32), I_BR = (512 / 64) * (D / 32), I_OUT = (D / 64) * (D / 32), I_UP = (D / 64) * (2 * DFF / 32), I_DN = (DFF / 64) * (D / 32);
  constexpr int PER_LAYER = I_IN + 3 * I_BR + I_OUT + I_UP + I_DN;
  for (int it = gw; it < NLAYER * PER_LAYER; it += NGW) {
    const int l = it / PER_LAYER; int r = it % PER_LAYER;
    if (r < I_IN) { p0_transpose_item(p.w_in + (size_t)l * D * INC, INC, p.norm_mix + l * D, (bf16_t*)(p.ws + WS_WIN) + (size_t)l * INC * D, D, 0, scr, r, lane); continue; } r -= I_IN;
    if (r < 3 * I_BR) { const int n = r / I_BR; p0_transpose_item(p.w_branch + ((size_t)l * 3 + n) * 512 * D, D, nullptr, (bf16_t*)(p.ws + WS_WBR) + (size_t)l * D * OW, OW, 512 * n, scr, r % I_BR, lane); continue; } r -= 3 * I_BR;
    if (r < I_OUT) { p0_transpose_item(p.w_out + (size_t)l * D * D, D, nullptr, (bf16_t*)(p.ws + WS_WOUT) + (size_t)l * D * D, D, 0, scr, r, lane); continue; } r -= I_OUT;
    if (r < I_UP) { p0_transpose_item(p.w_up + (size_t)l * D * 2 * DFF, 2 * DFF, p.norm_ffn + l * D, (bf16_t*)(p.ws + WS_WUP) + (size_t)l * 2 * DFF * D, D, 0, scr, r, lane); continue; } r -= I_UP;
    p0_transpose_item(p.w_down + (size_t)l * DFF * D, D, nullptr, (bf16_t*)(p.ws + WS_WDN) + (size_t)l * D * DFF, DFF, 0, scr, r, lane);
  }
  float* X32 = (float*)(p.ws + WS_X32); bf16_t* XB = (bf16_t*)(p.ws + WS_XB); float* SS = (float*)(p.ws + WS_SS);
  for (int m = gw; m < TOK; m += NGW) {
    const float* src = m < TOKP ? p.x_prompt + (size_t)m * D : p.x_sample + (size_t)(m - TOKP) * D;
    float s = 0.f;
#pragma unroll
    for (int j = 0; j < 4; ++j) { const f32x4 v = ((const f32x4*)src)[lane + 64 * j]; ((f32x4*)(X32 + (size_t)m * D))[lane + 64 * j] = v; ((u32x2*)(XB + (size_t)m * D))[lane + 64 * j] = pack4(v);
      s += (v[0] * v[0] + v[1] * v[1]) + (v[2] * v[2] + v[3] * v[3]); }
    s = wave_sum(s);
    if (lane < 16) SS[(size_t)m * 16 + lane] = lane == 0 ? s : 0.f;
  }
  { const size_t gt = (size_t)blockIdx.x * NTHREADS + tid, gs = (size_t)gridDim.x * NTHREADS; constexpr size_t PER = (size_t)448 * 128, TOT = (size_t)NLAYER * DB * PER;
    for (size_t i = gt; i < 2 * TOT; i += gs) { const int which = i >= TOT; const size_t j = which ? i - TOT : i; const size_t lb = j / PER, rem = j % PER;
      const f32x4* src = (const f32x4*)((which ? p.cache_a_v : p.cache_a_k) + lb * 512 * 512 + 64 * 512) + rem;
      f32x4* dst = (f32x4*)(p.out + (which ? O_SAV : O_SAK) + lb * 512 * 512) + rem; *dst = *src; } }
}

namespace pg8 {
constexpr int BM = 256, BK = 64, HALF = 128, HTB = HALF * BK * 2, STAGE_BYTES = 8 * HTB, NXCD = 8, WGM = 8;
DI int lds_byte(int r, int c) { const int st = (r >> 4) * 2 + (c >> 5), rr = r & 15, cc = c & 31, ob = rr * 64 + cc * 2; return st * 1024 + (ob ^ (((ob >> 9) & 1) << 5)); }
DI void stage_rc(int b, int& R, int& C) { const int st = b / 1024, sb = b % 1024, swz = sb ^ (((sb >> 9) & 1) << 5); R = (st >> 1) * 16 + swz / 64; C = (st & 1) * 32 + (swz % 64) / 2; }
DI int perm32(int rho) { const int n = rho >> 4, i = rho & 15; return 8 * (i >> 2) + 4 * n + (i & 3); }
struct Unit { int pm, pn; };
struct GemmDesc { const char* A; const char* B; int lda, ldb, nt; size_t b_tile, b_half; };
struct StaticOrder {
  int nM, nN, nwg, G, c;
  DI void init(int nM_, int nN_, int G_, int c_) { nM = nM_; nN = nN_; nwg = nM * nN; G = G_; c = c_; }
  DI bool next(int i, Unit& u) const {
    const long L = (long)i * G + c; if (L >= nwg) return false;
    int wgid = (int)L; { const int q = nwg / NXCD, r = nwg % NXCD, xcd = wgid % NXCD, off = wgid / NXCD; wgid = (xcd < r ? xcd * (q + 1) : r * (q + 1) + (xcd - r) * q) + off; }
    const int nig = WGM * nN, gid = wgid / nig, fm = gid * WGM, gsz = (nM - fm) < WGM ? (nM - fm) : WGM;
    u.pm = fm + ((wgid % nig) % gsz); u.pn = (wgid % nig) / gsz; return true;
  }
};
template <class Epi>
DI void gemm_phase(LAS unsigned char* lds, const GemmDesc g, const StaticOrder& S, const Epi& E) {
  int tid_ = threadIdx.x; asm volatile("" : "+v"(tid_));
  const int tid = tid_, wid = __builtin_amdgcn_readfirstlane(tid >> 6), lane = tid & 63, wr = wid >> 2, wc = wid & 3, fr = lane & 15, fq = lane >> 4;
  const int nt = g.nt;
  unsigned voffA[2], voffB[2];
#pragma unroll
  for (int i = 0; i < 2; ++i) { int R, C; stage_rc(tid * 16 + i * 8192, R, C); const int Rb = Epi::PERM ? ((R & ~31) + perm32(R & 31)) : R;
    voffA[i] = (unsigned)(R * g.lda + C) * 2u; voffB[i] = (unsigned)(Rb * g.ldb + C) * 2u; }
  const size_t kstep = (size_t)(BK * 2);
  const size_t hsA = (size_t)HALF * g.lda * 2, tsA = 2 * hsA, hsB = g.b_half, tsB = g.b_tile;
  const unsigned ldsw = (unsigned)wid * 1024u;
  const int aoff = lds_byte(wr * 64 + fr, fq * 8), boff = lds_byte(wc * 32 + fr, fq * 8);
#define PG8_SA(b, h) (((b) * 2 + (h)) * HTB)
#define PG8_SB(b, h) ((4 + (b) * 2 + (h)) * HTB)
#define PG8_STAGE(bufoff, gbase, voff) do { _Pragma("unroll") for (int _i = 0; _i < 2; ++_i) \
    __builtin_amdgcn_global_load_lds((const unsigned*)((const char*)(gbase) + (voff)[_i]), (LAS unsigned*)(lds + (bufoff) + ldsw + _i * 8192), 16, 0, 0); } while (0)
#define PG8_LDA(dst, b, h) do { _Pragma("unroll") for (int m = 0; m < 4; ++m) _Pragma("unroll") for (int k = 0; k < 2; ++k) dst[m][k] = *(const LAS bf16x8*)(lds + PG8_SA(b, h) + aoff + m * 2048 + k * 1024); } while (0)
#define PG8_LDB(dst, b, h) do { _Pragma("unroll") for (int n = 0; n < 2; ++n) _Pragma("unroll") for (int k = 0; k < 2; ++k) dst[n][k] = *(const LAS bf16x8*)(lds + PG8_SB(b, h) + boff + n * 2048 + k * 1024); } while (0)
#define PG8_MMA(ai, bj, At, Bt) do { __builtin_amdgcn_s_setprio(1); _Pragma("unroll") for (int m = 0; m < 4; ++m) _Pragma("unroll") for (int n = 0; n < 2; ++n) _Pragma("unroll") for (int k = 0; k < 2; ++k) \
    acc[ai][bj][m][n] = __builtin_amdgcn_mfma_f32_16x16x32_bf16(Bt[n][k], At[m][k], acc[ai][bj][m][n], 0, 0, 0); __builtin_amdgcn_s_setprio(0); } while (0)
#define PG8_WAIT_V(n) asm volatile("s_waitcnt vmcnt(" #n ")" ::: "memory")
#define PG8_WAIT_L(n) asm volatile("s_waitcnt lgkmcnt(" #n ")" ::: "memory")
#define PG8_BAR __builtin_amdgcn_s_barrier()
#define PG8_SCHED __builtin_amdgcn_sched_barrier(0)
  Unit cur, nxt; int ui = 0;
  if (!S.next(0, cur)) return;
  f32x4 acc[2][2][4][2];
#pragma unroll
  for (int a = 0; a < 2; ++a)
#pragma unroll
    for (int b = 0; b < 2; ++b)
#pragma unroll
      for (int m = 0; m < 4; ++m)
#pragma unroll
        for (int n = 0; n < 2; ++n) acc[a][b][m][n] = (f32x4){0.f, 0.f, 0.f, 0.f};
  bf16x8 At[4][2], B0[2][2], B1[2][2];
  const char* cA = g.A + (size_t)cur.pm * tsA; const char* cB = g.B + (size_t)cur.pn * tsB;
  PG8_STAGE(PG8_SB(0, 0), cB, voffB); PG8_STAGE(PG8_SB(0, 1), cB + hsB, voffB); PG8_STAGE(PG8_SA(0, 0), cA, voffA); PG8_STAGE(PG8_SA(0, 1), cA + hsA, voffA);
  if (wr == 1) PG8_BAR;
  PG8_WAIT_V(2); PG8_BAR;
  PG8_STAGE(PG8_SB(1, 0), cB + kstep, voffB); PG8_STAGE(PG8_SA(1, 0), cA + kstep, voffA); PG8_STAGE(PG8_SB(1, 1), cB + hsB + kstep, voffB);
  PG8_WAIT_V(6); PG8_BAR;
  for (;;) {
    const bool has_next = S.next(ui + 1, nxt);
    const char* nA = has_next ? g.A + (size_t)nxt.pm * tsA : cA; const char* nB = has_next ? g.B + (size_t)nxt.pn * tsB : cB;
    for (int t = 0; t < nt; t += 2) {
      const bool last = (t == nt - 2);
      const char* a1 = cA + (size_t)(t + 1) * kstep;
      const char* a2 = last ? nA : cA + (size_t)(t + 2) * kstep; const char* b2 = last ? nB : cB + (size_t)(t + 2) * kstep;
      const char* a3 = a2 + kstep; const char* b3 = b2 + kstep;
      if constexpr (Epi::HAS_MID) { if (t == 8 || t == 16) E.mid(acc, cur, t, wr, wc, fr, fq); }
      PG8_LDB(B0, 0, 0); PG8_LDB(B1, 0, 1); PG8_SCHED; PG8_LDA(At, 0, 0); PG8_STAGE(PG8_SA(1, 1), a1 + hsA, voffA);
      PG8_WAIT_V(8); PG8_WAIT_L(0); PG8_BAR; PG8_MMA(0, 0, At, B0); PG8_MMA(0, 1, At, B1); PG8_BAR; PG8_SCHED;
      PG8_LDA(At, 0, 1); PG8_STAGE(PG8_SB(0, 0), b2, voffB); PG8_STAGE(PG8_SB(0, 1), b2 + hsB, voffB); PG8_STAGE(PG8_SA(0, 0), a2, voffA);
      PG8_WAIT_V(8); PG8_WAIT_L(0); PG8_BAR; PG8_MMA(1, 0, At, B0); PG8_MMA(1, 1, At, B1); PG8_BAR; PG8_SCHED;
      PG8_LDB(B0, 1, 0); PG8_LDB(B1, 1, 1); PG8_SCHED; PG8_LDA(At, 1, 0); PG8_STAGE(PG8_SA(0, 1), a2 + hsA, voffA);
      PG8_WAIT_V(8); PG8_WAIT_L(0); PG8_BAR; PG8_MMA(0, 0, At, B0); PG8_MMA(0, 1, At, B1); PG8_BAR; PG8_SCHED;
      PG8_LDA(At, 1, 1); PG8_STAGE(PG8_SB(1, 0), b3, voffB); PG8_STAGE(PG8_SB(1, 1), b3 + hsB, voffB); PG8_STAGE(PG8_SA(1, 0), a3, voffA);
      PG8_WAIT_V(8); PG8_WAIT_L(0); PG8_BAR; PG8_MMA(1, 0, At, B0); PG8_MMA(1, 1, At, B1); PG8_BAR; PG8_SCHED;
    }
    if (wr == 0) PG8_BAR;
    E(acc, cur, wr, wc, fr, fq);
    if (!has_next) break;
#pragma unroll
    for (int a = 0; a < 2; ++a)
#pragma unroll
      for (int b = 0; b < 2; ++b)
#pragma unroll
        for (int m = 0; m < 4; ++m)
#pragma unroll
          for (int n = 0; n < 2; ++n) acc[a][b][m][n] = (f32x4){0.f, 0.f, 0.f, 0.f};
    cur = nxt; cA = nA; cB = nB; ++ui;
    if (wr == 1) PG8_BAR;
  }
  PG8_WAIT_V(0);
  PG8_BAR;
#undef PG8_SA
#undef PG8_SB
#undef PG8_STAGE
#undef PG8_LDA
#undef PG8_LDB
#undef PG8_MMA
#undef PG8_WAIT_V
#undef PG8_WAIT_L
#undef PG8_BAR
#undef PG8_SCHED
}
}
using pg8::Unit;
DI float row_rs(const float* SS, int r) {
  const f32x4* s = (const f32x4*)(SS + (size_t)r * 16); const f32x4 a = s[0], b = s[1], c = s[2], d = s[3];
  const float t = ((a[0] + a[1]) + (a[2] + a[3])) + ((b[0] + b[1]) + (b[2] + b[3])) + ((c[0] + c[1]) + (c[2] + c[3])) + ((d[0] + d[1]) + (d[2] + d[3]));
  return __builtin_amdgcn_rsqf(t * (1.0f / D) + EPS);
}
DI float sigmoidf_(float x) { return fast_rcp(1.0f + fast_exp2(-x * LOG2E)); }

struct EpiP1 {
  static constexpr bool PERM = true, HAS_MID = false;
  const float* SS; bf16_t* QKV; bf16_t* GATE; const float* bgate; float* out; int layer;
  DI void mid(f32x4 (&)[2][2][4][2], const Unit&, int, int, int, int, int) const {}
  DI void operator()(f32x4 (&acc)[2][2][4][2], const Unit& u, int wr, int wc, int fr, int fq) const {
    const int pn = u.pn, rin0 = wr * 64 + fr, row0 = u.pm * 256 + rin0;
    float rs[2][4];
#pragma unroll
    for (int ai = 0; ai < 2; ++ai)
#pragma unroll
      for (int m = 0; m < 4; ++m) rs[ai][m] = row_rs(SS, row0 + ai * 128 + m * 16);
    if (pn < 18) {
      const int colq = pn * 256 + wc * 32 + 8 * fq;
      const int kind = (pn >> 1) % 3, br = pn / 6, tcol = (pn & 1) * 256 + wc * 32 + 8 * fq;
      float* sbase = nullptr; size_t srow_stride = 512; int rowshift = 0; bool prompt = u.pm < 64; bool do_state = kind != 0;
      int b = 0, t0 = 0;
      if (do_state) {
        const bool isv = kind == 2;
        if (prompt) { b = u.pm >> 4; t0 = (u.pm & 15) * 256;
          if (br == 0) { if ((u.pm & 15) < 14) do_state = false; else { sbase = out + (isv ? O_PAV : O_PAK) + (size_t)(layer * 4 + b) * 512 * 512; rowshift = t0 - 3584; } }
          else { sbase = out + (br == 1 ? (isv ? O_PBV : O_PBK) : (isv ? O_PCV : O_PCK)) + (size_t)(layer * 4 + b) * SEQ * 512; rowshift = t0; }
        }
      }
#pragma unroll
      for (int ai = 0; ai < 2; ++ai)
#pragma unroll
        for (int m = 0; m < 4; ++m) {
          const int rin = rin0 + ai * 128 + m * 16, r = u.pm * 256 + rin; const float s = rs[ai][m];
          bf16_t* rowp = QKV + (size_t)r * QKVW + colq;
          float* sp = nullptr;
          if (do_state) {
            if (prompt) sp = sbase + (size_t)(rowshift + rin) * 512 + tcol;
            else { const int sidx = (u.pm - 64) * 256 + rin, bd = sidx >> 6, t = sidx & 63; const bool isv = kind == 2;
              if (br == 0) sp = out + (isv ? O_SAV : O_SAK) + ((size_t)(layer * DB + bd) * 512 + 448 + t) * 512 + tcol;
              else sp = out + (br == 1 ? (isv ? O_SBV : O_SBK) : (isv ? O_SCV : O_SCK)) + ((size_t)(layer * DB + bd) * 64 + t) * 512 + tcol; }
          }
#pragma unroll
          for (int bj = 0; bj < 2; ++bj) { const f32x4 v0 = acc[ai][bj][m][0] * s, v1 = acc[ai][bj][m][1] * s;
            *(u32x4*)(rowp + bj * 128) = pack8(v0, v1);
            if (do_state) { *(f32x4*)(sp + bj * 128) = v0; *(f32x4*)(sp + bj * 128 + 4) = v1; } }
        }
    } else {
      const int gi = pn - 18, nb = gi >> 2, colg = (gi & 3) * 256 + wc * 32 + 8 * fq;
      f32x4 bv[2][2];
#pragma unroll
      for (int bj = 0; bj < 2; ++bj) { bv[bj][0] = *(const f32x4*)(bgate + nb * D + colg + bj * 128); bv[bj][1] = *(const f32x4*)(bgate + nb * D + colg + bj * 128 + 4); }
#pragma unroll
      for (int ai = 0; ai < 2; ++ai)
#pragma unroll
        for (int m = 0; m < 4; ++m) { const int r = row0 + ai * 128 + m * 16; const float s = rs[ai][m];
          bf16_t* rowp = GATE + (size_t)r * GATEW + gi * 256 + wc * 32 + 8 * fq;
#pragma unroll
          for (int bj = 0; bj < 2; ++bj) { f32x4 v0 = acc[ai][bj][m][0] * s + bv[bj][0], v1 = acc[ai][bj][m][1] * s + bv[bj][1];
#pragma unroll
            for (int j = 0; j < 4; ++j) { v0[j] = sigmoidf_(v0[j]); v1[j] = sigmoidf_(v1[j]); }
            *(u32x4*)(rowp + bj * 128) = pack8(v0, v1); } }
    }
  }
};

struct EpiP3 {
  static constexpr bool PERM = true, HAS_MID = true;
  const bf16_t* GATE; bf16_t* H;
  DI void mid(f32x4 (&acc)[2][2][4][2], const Unit& u, int t, int wr, int wc, int fr, int fq) const {
    const int nb = (t >> 3) - 1;
    const bf16_t* gp = GATE + (size_t)(u.pm * 256 + wr * 64 + fr) * GATEW + nb * D + u.pn * 256 + wc * 32 + 8 * fq;
#pragma unroll
    for (int ai = 0; ai < 2; ++ai)
#pragma unroll
      for (int m = 0; m < 4; ++m) {
#pragma unroll
        for (int bj = 0; bj < 2; ++bj)
#pragma unroll
          for (int n = 0; n < 2; ++n) { const bf16_t* q = gp + (size_t)(ai * 128 + m * 16) * GATEW + bj * 128 + 4 * n;
            const u32x2 ga = *(const u32x2*)q, gb = *(const u32x2*)(q + D);
            acc[ai][bj][m][n][0] *= bflo(ga[0]) * fast_rcp(bflo(gb[0])); acc[ai][bj][m][n][1] *= bfhi(ga[0]) * fast_rcp(bfhi(gb[0]));
            acc[ai][bj][m][n][2] *= bflo(ga[1]) * fast_rcp(bflo(gb[1])); acc[ai][bj][m][n][3] *= bfhi(ga[1]) * fast_rcp(bfhi(gb[1])); }
        asm volatile("" ::: "memory"); }
  }
  DI void operator()(f32x4 (&acc)[2][2][4][2], const Unit& u, int wr, int wc, int fr, int fq) const {
    const int row0 = u.pm * 256 + wr * 64 + fr, col0 = u.pn * 256 + wc * 32 + 8 * fq;
#pragma unroll
    for (int ai = 0; ai < 2; ++ai)
#pragma unroll
      for (int m = 0; m < 4; ++m) { const int r = row0 + ai * 128 + m * 16; const bf16_t* gp = GATE + (size_t)r * GATEW + 2 * D + col0; bf16_t* hp = H + (size_t)r * D + col0;
#pragma unroll
        for (int bj = 0; bj < 2; ++bj) { const u32x4 g = *(const u32x4*)(gp + bj * 128); f32x4 v0 = acc[ai][bj][m][0], v1 = acc[ai][bj][m][1];
          v0[0] *= bflo(g[0]); v0[1] *= bfhi(g[0]); v0[2] *= bflo(g[1]); v0[3] *= bfhi(g[1]); v1[0] *= bflo(g[2]); v1[1] *= bfhi(g[2]); v1[2] *= bflo(g[3]); v1[3] *= bfhi(g[3]);
          *(u32x4*)(hp + bj * 128) = pack8(v0, v1); } }
  }
};

struct EpiRes {
  static constexpr bool PERM = false, HAS_MID = false;
  float* X32; bf16_t* XB; float* SS;
  DI void mid(f32x4 (&)[2][2][4][2], const Unit&, int, int, int, int, int) const {}
  DI void operator()(f32x4 (&acc)[2][2][4][2], const Unit& u, int wr, int wc, int fr, int fq) const {
    const int row0 = u.pm * 256 + wr * 64 + fr, col0 = u.pn * 256 + wc * 32 + 4 * fq;
#pragma unroll
    for (int ai = 0; ai < 2; ++ai)
#pragma unroll
      for (int m = 0; m < 4; ++m) { const int r = row0 + ai * 128 + m * 16; float* xp = X32 + (size_t)r * D + col0; bf16_t* bp = XB + (size_t)r * D + col0; float q = 0.f;
#pragma unroll
        for (int bj = 0; bj < 2; ++bj)
#pragma unroll
          for (int n = 0; n < 2; ++n) { const f32x4 xo = *(const f32x4*)(xp + bj * 128 + n * 16); const f32x4 xn = xo + acc[ai][bj][m][n];
            *(f32x4*)(xp + bj * 128 + n * 16) = xn; *(u32x2*)(bp + bj * 128 + n * 16) = pack4(xn); q += (xn[0] * xn[0] + xn[1] * xn[1]) + (xn[2] * xn[2] + xn[3] * xn[3]); }
        q += __shfl_xor(q, 16); q += __shfl_xor(q, 32);
        if (fq == 0) SS[(size_t)r * 16 + u.pn * 4 + wc] = q; }
  }
};

struct EpiP5 {
  static constexpr bool PERM = true, HAS_MID = false;
  const float* SS; bf16_t* GU; float* out; int layer;
  DI void mid(f32x4 (&)[2][2][4][2], const Unit&, int, int, int, int, int) const {}
  DI void operator()(f32x4 (&acc)[2][2][4][2], const Unit& u, int wr, int wc, int fr, int fq) const {
    const int rin0 = wr * 64 + fr, col0 = u.pn * 128 + wc * 32 + 8 * fq;
#pragma unroll
    for (int ai = 0; ai < 2; ++ai)
#pragma unroll
      for (int m = 0; m < 4; ++m) { const int rin = rin0 + ai * 128 + m * 16, r = u.pm * 256 + rin; const float s = row_rs(SS, r);
        const f32x4 g0 = acc[ai][0][m][0] * s, g1 = acc[ai][0][m][1] * s, u0 = acc[ai][1][m][0] * s, u1 = acc[ai][1][m][1] * s;
        bf16_t* gp = GU + (size_t)r * (2 * DFF) + col0; *(u32x4*)gp = pack8(g0, g1); *(u32x4*)(gp + DFF) = pack8(u0, u1);
        float* cp = nullptr;
        if (u.pm < 64) { const int t = (u.pm & 15) * 256 + rin; if (t >= SEQ - 2) cp = out + O_PCONV + ((size_t)(layer * 4 + (u.pm >> 4)) * 2 + (t - (SEQ - 2))) * DFF + col0; }
        else { const int sidx = (u.pm - 64) * 256 + rin, bd = sidx >> 6, t = sidx & 63; if (t >= 62) cp = out + O_SCONV + ((size_t)(layer * DB + bd) * 2 + (t - 62)) * DFF + col0; }
        if (cp) { *(f32x4*)cp = g0; *(f32x4*)(cp + 4) = g1; } }
  }
};

DI float gelu_tanh(float x) {
  const float y = 0.7978845608028654f * (x + 0.044715f * x * x * x);
  const float e = fast_exp2(2.0f * LOG2E * y);
  const float th = 1.0f - 2.0f * fast_rcp(e + 1.0f);
  return 0.5f * x * (1.0f + th);
}
DI void p5b_ffn_act(const Params& p, int layer) {
  const bf16_t* GU = (const bf16_t*)(p.ws + WS_GU); bf16_t* HF = (bf16_t*)(p.ws + WS_HF);
  const float* cw = p.conv_w + (size_t)layer * 3 * DFF; const float* cb = p.conv_b + (size_t)layer * DFF; const float* st = p.state_conv + (size_t)layer * DB * 2 * DFF;
  constexpr int CPR = DFF / 8;
  int tid_ = threadIdx.x; asm volatile("" : "+v"(tid_));
  const size_t gt = (size_t)blockIdx.x * NTHREADS + tid_, gs = (size_t)gridDim.x * NTHREADS;
  for (size_t i = gt; i < (size_t)TOK * CPR; i += gs) {
    const int r = (int)(i / CPR), c = (int)(i % CPR) * 8;
    int t; const float* strow = nullptr;
    if (r < TOKP) t = r & (SEQ - 1); else { const int s = r - TOKP; t = s & 63; strow = st + (size_t)(s >> 6) * 2 * DFF; }
    const u32x4 g2 = *(const u32x4*)(GU + (size_t)r * (2 * DFF) + c), uu = *(const u32x4*)(GU + (size_t)r * (2 * DFF) + DFF + c);
    float gm1[8], gm2[8];
    if (t >= 1) { const u32x4 v = *(const u32x4*)(GU + (size_t)(r - 1) * (2 * DFF) + c);
#pragma unroll
      for (int j = 0; j < 4; ++j) { gm1[2 * j] = bflo(v[j]); gm1[2 * j + 1] = bfhi(v[j]); } }
    else {
#pragma unroll
      for (int j = 0; j < 8; ++j) gm1[j] = strow ? strow[DFF + c + j] : 0.f; }
    if (t >= 2) { const u32x4 v = *(const u32x4*)(GU + (size_t)(r - 2) * (2 * DFF) + c);
#pragma unroll
      for (int j = 0; j < 4; ++j) { gm2[2 * j] = bflo(v[j]); gm2[2 * j + 1] = bfhi(v[j]); } }
    else {
#pragma unroll
      for (int j = 0; j < 8; ++j) gm2[j] = strow ? strow[(size_t)t * DFF + c + j] : 0.f; }
    float o[8];
#pragma unroll
    for (int j = 0; j < 8; ++j) { const float g = (j & 1) ? bfhi(g2[j >> 1]) : bflo(g2[j >> 1]), uv = (j & 1) ? bfhi(uu[j >> 1]) : bflo(uu[j >> 1]);
      const float cv = cb[c + j] + cw[c + j] * gm2[j] + cw[DFF + c + j] * gm1[j] + cw[2 * DFF + c + j] * g;
      o[j] = gelu_tanh(cv) * uv; }
    *(u32x4*)(HF + (size_t)r * DFF + c) = pack8((f32x4){o[0], o[1], o[2], o[3]}, (f32x4){o[4], o[5], o[6], o[7]});
  }
}
DI void pfinal_norm(const Params& p) {
  const float* X32 = (const float*)(p.ws + WS_X32); const float* SS = (const float*)(p.ws + WS_SS);
  int tid_ = threadIdx.x; asm volatile("" : "+v"(tid_));
  const int lane = tid_ & 63, gw = blockIdx.x * 8 + (tid_ >> 6), NGW = gridDim.x * 8;
  for (int m = gw; m < TOK; m += NGW) { const float s = row_rs(SS, m);
#pragma unroll
    for (int j = 0; j < 4; ++j) { const f32x4 v = ((const f32x4*)(X32 + (size_t)m * D))[lane + 64 * j], g = ((const f32x4*)p.norm_final)[lane + 64 * j];
      ((f32x4*)(p.out + (size_t)m * D))[lane + 64 * j] = v * s * g; } }
}
namespace attn {
constexpr int L_K1 = 0, L_K2 = 8192, L_V = 16384, L_LUT = 40960, L_FLAGS = 43008, L_XCH = 49152;
constexpr int N_CS = 128, N_CP = 512, N_AP = 512, N_BP = 512, N_AS = 256, N_BS = 256, NITEMS = N_CS + N_CP + N_AP + N_BP + N_AS + N_BS;
constexpr float STICK_DONE2 = -60.0f * LOG2E;

struct Item { int mode, h, tok0, past, q0, nqv; const float* cK; const float* cV; };

DI Item decode(const Params& p, int layer, int idx) {
  Item it; it.cK = nullptr; it.cV = nullptr; it.past = 0;
  if (idx < N_CS) { const int bd = idx >> 2, h = idx & 3; it.mode = 2; it.h = h; it.tok0 = TOKP + bd * 64; it.past = PAST; it.q0 = PAST; it.nqv = 64;
    it.cK = p.cache_c_k + (size_t)(layer * DB + bd) * PAST * 512 + h * 128; it.cV = p.cache_c_v + (size_t)(layer * DB + bd) * PAST * 512 + h * 128; return it; }
  idx -= N_CS;
  if (idx < N_CP) { const int jj = 31 - (idx >> 4), rem = idx & 15; it.mode = 2; it.h = rem & 3; it.tok0 = (rem >> 2) * SEQ; it.q0 = jj * 128; it.nqv = 128; return it; }
  idx -= N_CP;
  if (idx < N_AP + N_BP) { const int isb = idx >= N_AP; if (isb) idx -= N_AP; const int qt = 15 - (idx >> 5), rem = idx & 31; it.mode = isb; it.h = rem & 7; it.tok0 = (rem >> 3) * SEQ; it.q0 = qt * 256; it.nqv = 256; return it; }
  idx -= N_AP + N_BP;
  if (idx < N_AS) { const int bd = idx >> 3, h = idx & 7; it.mode = 0; it.h = h; it.tok0 = TOKP + bd * 64; it.past = ALEN; it.q0 = ALEN; it.nqv = 64;
    it.cK = p.cache_a_k + (size_t)(layer * DB + bd) * ALEN * 512 + h * 64; it.cV = p.cache_a_v + (size_t)(layer * DB + bd) * ALEN * 512 + h * 64; return it; }
  idx -= N_AS;
  { const int bd = idx >> 3, h = idx & 7; it.mode = 1; it.h = h; it.tok0 = TOKP + bd * 64; it.past = PAST; it.q0 = PAST; it.nqv = 64;
    it.cK = p.cache_b_k + (size_t)(layer * DB + bd) * PAST * 512 + h * 64; it.cV = p.cache_b_v + (size_t)(layer * DB + bd) * PAST * 512 + h * 64; return it; }
}


template <int MODE>
DI void load_tile(u32x4& k0, u32x4& k1, u32x4& k2, u32x4& k3, u32x4& v0, u32x4& v1, u32x4& v2, u32x4& v3, const Item& it, const bf16_t* QKV, int kcol, int vcol, int kt, int tid) {
  constexpr int CPR = MODE == 2 ? 16 : 8;
  const int j0 = kt * 64;
  const int r0 = tid / CPR, c0 = tid % CPR, r1 = (tid + NTHREADS) / CPR, c1 = (tid + NTHREADS) % CPR;
  if (j0 < it.past) {
    { const u32x4* kp = (const u32x4*)(it.cK + (size_t)(j0 + r0) * 512 + c0 * 8); const u32x4* vp = (const u32x4*)(it.cV + (size_t)(j0 + r0) * 512 + c0 * 8);
      k0 = kp[0]; k1 = kp[1]; v0 = vp[0]; v1 = vp[1]; }
    if constexpr (MODE == 2) { const u32x4* kp = (const u32x4*)(it.cK + (size_t)(j0 + r1) * 512 + c1 * 8); const u32x4* vp = (const u32x4*)(it.cV + (size_t)(j0 + r1) * 512 + c1 * 8);
      k2 = kp[0]; k3 = kp[1]; v2 = vp[0]; v3 = vp[1]; }
  } else {
    { const bf16_t* base = QKV + (size_t)(it.tok0 + j0 + r0 - it.past) * QKVW + c0 * 8; k0 = *(const u32x4*)(base + kcol); v0 = *(const u32x4*)(base + vcol); }
    if constexpr (MODE == 2) { const bf16_t* base = QKV + (size_t)(it.tok0 + j0 + r1 - it.past) * QKVW + c1 * 8; k2 = *(const u32x4*)(base + kcol); v2 = *(const u32x4*)(base + vcol); }
  }
}
DI u32x4 cvt8(u32x4 a, u32x4 b) { return pack8(__builtin_bit_cast(f32x4, a), __builtin_bit_cast(f32x4, b)); }
template <int MODE>
DI void write_tile(const u32x4& k0, const u32x4& k1, const u32x4& k2, const u32x4& k3, const u32x4& v0, const u32x4& v1, const u32x4& v2, const u32x4& v3, const Item& it, LAS unsigned char* lds, int kt, int tid) {
  constexpr int CPR = MODE == 2 ? 16 : 8, VS = MODE == 2 ? 320 : 192;
  const bool f32src = kt * 64 < it.past;
  const int r0 = tid / CPR, c0 = tid % CPR, r1 = (tid + NTHREADS) / CPR, c1 = (tid + NTHREADS) % CPR;
  { const u32x4 kk = f32src ? cvt8(k0, k1) : k0, vv = f32src ? cvt8(v0, v1) : v0;
    const int kreg = (MODE == 2 && c0 >= 8) ? L_K2 : L_K1;
    *(LAS u32x4*)(lds + kreg + r0 * 128 + (((c0 & 7) ^ ((r0 >> 1) & 7)) << 4)) = kk;
    *(LAS u32x4*)(lds + L_V + r0 * VS + c0 * 16) = vv; }
  if constexpr (MODE == 2) { const u32x4 kk = f32src ? cvt8(k2, k3) : k2, vv = f32src ? cvt8(v2, v3) : v2;
    const int kreg = (c1 >= 8) ? L_K2 : L_K1;
    *(LAS u32x4*)(lds + kreg + r1 * 128 + (((c1 & 7) ^ ((r1 >> 1) & 7)) << 4)) = kk;
    *(LAS u32x4*)(lds + L_V + r1 * VS + c1 * 16) = vv; }
}

DI bf16x8 pack_p(const f32x16& x, int s) {
  const f32x4 a = {x[8 * s], x[8 * s + 1], x[8 * s + 2], x[8 * s + 3]}, b = {x[8 * s + 4], x[8 * s + 5], x[8 * s + 6], x[8 * s + 7]};
  return __builtin_bit_cast(bf16x8, pack8(a, b));
}
#define MFMA32(a, b, c) __builtin_amdgcn_mfma_f32_32x32x16_bf16((a), (b), (c), 0, 0, 0)

template <int MODE>
DI void run_item(const Params& p, int layer, const Item& it, LAS unsigned char* lds) {
  constexpr int NDV = MODE == 2 ? 4 : 2, VS = MODE == 2 ? 320 : 192;
  int tid_ = threadIdx.x; asm volatile("" : "+v"(tid_));
  const int tid = tid_, lane = tid & 63, wave = __builtin_amdgcn_readfirstlane(tid >> 6);
  const int qi = lane & 31, h2 = lane >> 5;
  const int mp = MODE == 2 ? (wave >> 2) : 0, wrow = MODE == 2 ? (wave & 3) : wave;
  const int q0w = it.q0 + 32 * wrow;
  const bool active = 32 * wrow < it.nqv;
  const bf16_t* QKV = (const bf16_t*)(p.ws + WS_QKV);
  const int hb = MODE == 2 ? it.h * 128 : it.h * 64;
  const int qcol = (MODE == 0 ? 0 : MODE == 1 ? 1536 : 3072) + hb + 64 * mp, kcol = (MODE == 0 ? 512 : MODE == 1 ? 2048 : 3584) + hb, vcol = (MODE == 0 ? 1024 : MODE == 1 ? 2560 : 4096) + hb;
  LAS float* lut = (LAS float*)(lds + L_LUT);
  LAS unsigned* flags = (LAS unsigned*)(lds + L_FLAGS);
  if (MODE == 0) { for (int i = tid; i < 257; i += NTHREADS) lut[i] = p.a_rel_bias[((size_t)layer * 257 + i) * 8 + it.h] * LOG2E; }
  if (MODE == 2) { if (tid < 192) lut[tid] = ((const float*)(p.ws + WS_CTL))[CW_T5 + it.h * 192 + tid]; }
  bf16x8 qf[4];
  if (active) { const bf16_t* qp = QKV + (size_t)(it.tok0 + q0w + qi - it.past) * QKVW + qcol + 8 * h2;
#pragma unroll
    for (int s = 0; s < 4; ++s) { const u32x4 w = *(const u32x4*)(qp + 16 * s);
      const f32x4 a = {bflo(w[0]) * 0.125f, bfhi(w[0]) * 0.125f, bflo(w[1]) * 0.125f, bfhi(w[1]) * 0.125f}, b = {bflo(w[2]) * 0.125f, bfhi(w[2]) * 0.125f, bflo(w[3]) * 0.125f, bfhi(w[3]) * 0.125f};
      qf[s] = __builtin_bit_cast(bf16x8, pack8(a, b)); } }
  const int cw = q0w >> 6;
  int kt_first, kt_last, step;
  if (MODE == 0) { kt_first = (it.q0 >> 6) - 8; if (kt_first < 0) kt_first = 0; kt_last = (it.q0 + it.nqv - 1) >> 6; step = 1; }
  else if (MODE == 2) { kt_first = 0; kt_last = (it.q0 + it.nqv - 1) >> 6; step = 1; }
  else { kt_first = (it.q0 + it.nqv - 2) >> 6; kt_last = 0; step = -1; }
  f32x16 O[NDV];
#pragma unroll
  for (int b = 0; b < NDV; ++b)
#pragma unroll
    for (int i = 0; i < 16; ++i) O[b][i] = 0.f;
  float m_run = -1e30f, l_run = 0.f, R2 = 0.f; bool done = false;
  const int krow_off = qi * 128, kswz = (qi >> 1) & 7;
  const int g16 = lane >> 4, trq = (lane & 15) >> 2, trp = lane & 3;
  const int vtr_off = L_V + (4 * (g16 >> 1) + trq) * VS + (16 * (g16 & 1) + 4 * trp) * 2;

  u32x4 sk0 = {}, sk1 = {}, sk2 = {}, sk3 = {}, sv0 = {}, sv1 = {}, sv2 = {}, sv3 = {};
  load_tile<MODE>(sk0, sk1, sk2, sk3, sv0, sv1, sv2, sv3, it, QKV, kcol, vcol, kt_first, tid);
  for (int kt = kt_first;; kt += step) {
    __syncthreads();
    if (MODE == 1 && kt != kt_first) { const unsigned any = flags[0] | flags[1] | flags[2] | flags[3] | flags[4] | flags[5] | flags[6] | flags[7]; if (!any) break; }
    write_tile<MODE>(sk0, sk1, sk2, sk3, sv0, sv1, sv2, sv3, it, lds, kt, tid);
    __syncthreads();
    if (kt != kt_last) load_tile<MODE>(sk0, sk1, sk2, sk3, sv0, sv1, sv2, sv3, it, QKV, kcol, vcol, kt + step, tid);
    bool mine;
    if (MODE == 0) mine = active && kt >= cw - 8 && kt <= cw;
    else if (MODE == 2) mine = active && kt <= cw;
    else mine = active && !done && kt * 64 <= q0w + 30;
    if (mine) {
      f32x16 sA, sB;
#pragma unroll
      for (int i = 0; i < 16; ++i) { sA[i] = 0.f; sB[i] = 0.f; }
      const int kreg = (MODE == 2 && mp) ? L_K2 : L_K1;
#pragma unroll
      for (int s = 0; s < 4; ++s) { const int cs = ((2 * s + h2) ^ kswz) << 4;
        const bf16x8 ka = *(const LAS bf16x8*)(lds + kreg + krow_off + cs), kb = *(const LAS bf16x8*)(lds + kreg + 4096 + krow_off + cs);
        sA = MFMA32(ka, qf[s], sA); sB = MFMA32(kb, qf[s], sB); }
      const int kbase = kt * 64 + 4 * h2;
      if (MODE != 1) {
        bool cst; float cbias = 0.f;
        if (MODE == 0) { cst = q0w - (kt * 64 + 63) >= 128; if (cst) cbias = lut[256]; } else { cst = kt * 64 + 63 - q0w <= -127; if (cst) cbias = lut[0]; }
        if (cst) {
#pragma unroll
          for (int i = 0; i < 16; ++i) { sA[i] = sA[i] * LOG2E + cbias; sB[i] = sB[i] * LOG2E + cbias; }
        } else {
#pragma unroll
          for (int i = 0; i < 16; ++i) { const int ko = (i & 3) + 8 * (i >> 2);
            int ia, ib;
            if (MODE == 0) { const int d = (q0w + qi) - (kbase + ko); ia = d; ib = d - 32; ia = (ia < -128 ? -128 : ia > 128 ? 128 : ia) + 128; ib = (ib < -128 ? -128 : ib > 128 ? 128 : ib) + 128; }
            else { const int d = (kbase + ko) - (q0w + qi); ia = d; ib = d + 32; ia = (ia < -127 ? -127 : ia > 63 ? 63 : ia) + 127; ib = (ib < -127 ? -127 : ib > 63 ? 63 : ib) + 127; }
            sA[i] = sA[i] * LOG2E + lut[ia]; sB[i] = sB[i] * LOG2E + lut[ib]; }
        }
        float mx = sA[0];
#pragma unroll
        for (int i = 1; i < 16; ++i) mx = fmaxf(mx, sA[i]);
#pragma unroll
        for (int i = 0; i < 16; ++i) mx = fmaxf(mx, sB[i]);
        mx = fmaxf(mx, __shfl_xor(mx, 32));
        const float mnew = fmaxf(m_run, mx), alpha = fast_exp2(m_run - mnew); m_run = mnew;
        float ls = 0.f;
#pragma unroll
        for (int i = 0; i < 16; ++i) { sA[i] = fast_exp2(sA[i] - mnew); sB[i] = fast_exp2(sB[i] - mnew); ls += sA[i] + sB[i]; }
        l_run = l_run * alpha + ls;
#pragma unroll
        for (int b = 0; b < NDV; ++b)
#pragma unroll
          for (int i = 0; i < 16; ++i) O[b][i] *= alpha;
      } else {
        const bool diag = kt * 64 + 63 >= q0w;
        float lkA[16], lkB[16];
#pragma unroll
        for (int i = 0; i < 16; ++i) { const int ko = (i & 3) + 8 * (i >> 2);
          { const float z2 = sA[i] * LOG2E, e = fast_exp2(-fabsf(z2)), sp = fmaxf(z2, 0.f) + fast_log2(1.0f + e); const bool ok = !diag || (kbase + ko) < (q0w + qi);
            lkA[i] = ok ? -sp : 0.f; sA[i] = ok ? z2 - sp : -1e30f; }
          { const float z2 = sB[i] * LOG2E, e = fast_exp2(-fabsf(z2)), sp = fmaxf(z2, 0.f) + fast_log2(1.0f + e); const bool ok = !diag || (kbase + 32 + ko) < (q0w + qi);
            lkB[i] = ok ? -sp : 0.f; sB[i] = ok ? z2 - sp : -1e30f; } }
        float gs[8], pg[8];
#pragma unroll
        for (int g = 0; g < 4; ++g) { gs[g] = (lkA[4 * g] + lkA[4 * g + 1]) + (lkA[4 * g + 2] + lkA[4 * g + 3]); gs[4 + g] = (lkB[4 * g] + lkB[4 * g + 1]) + (lkB[4 * g + 2] + lkB[4 * g + 3]); }
#pragma unroll
        for (int g = 0; g < 8; ++g) pg[g] = __shfl_xor(gs[g], 32);
        float suf = R2;
#pragma unroll
        for (int g = 7; g >= 0; --g) { const float off = suf + (h2 == 0 ? pg[g] : 0.f);
          if (g >= 4) { const int b = 4 * (g - 4); float a3 = off, a2 = a3 + lkB[b + 3], a1 = a2 + lkB[b + 2], a0 = a1 + lkB[b + 1];
            sB[b + 3] = fast_exp2(sB[b + 3] + a3); sB[b + 2] = fast_exp2(sB[b + 2] + a2); sB[b + 1] = fast_exp2(sB[b + 1] + a1); sB[b] = fast_exp2(sB[b] + a0); }
          else { const int b = 4 * g; float a3 = off, a2 = a3 + lkA[b + 3], a1 = a2 + lkA[b + 2], a0 = a1 + lkA[b + 1];
            sA[b + 3] = fast_exp2(sA[b + 3] + a3); sA[b + 2] = fast_exp2(sA[b + 2] + a2); sA[b + 1] = fast_exp2(sA[b + 1] + a1); sA[b] = fast_exp2(sA[b] + a0); }
          suf += gs[g] + pg[g]; }
        R2 = suf;
        done = __all(R2 < STICK_DONE2) != 0;
      }
#pragma unroll
      for (int s = 0; s < 4; ++s) { const bf16x8 pf = s < 2 ? pack_p(sA, s) : pack_p(sB, s - 2);
#pragma unroll
        for (int b = 0; b < NDV; ++b) { const int a0 = vtr_off + 16 * s * VS + 64 * b;
          const s16x4 lo = __builtin_amdgcn_ds_read_tr16_b64_v4i16((LAS s16x4*)(lds + a0)), hi = __builtin_amdgcn_ds_read_tr16_b64_v4i16((LAS s16x4*)(lds + a0 + 8 * VS));
          const bf16x8 vf = __builtin_shufflevector(lo, hi, 0, 1, 2, 3, 4, 5, 6, 7);
          O[b] = MFMA32(vf, pf, O[b]); } }
    }
    if (MODE == 1) { if (lane == 0) flags[wave] = (active && !done && kt > 0 && (kt - 1) * 64 <= q0w + 30) ? 1u : 0u; }
    if (kt == kt_last) break;
  }
  bf16_t* Ob = (bf16_t*)(p.ws + WS_O);
  const int ocol = MODE == 0 ? hb : MODE == 1 ? 512 + hb : 1024 + hb;
  if (MODE != 2) {
    if (active) { float sc = 1.f; if (MODE == 0) { const float lt = l_run + __shfl_xor(l_run, 32); sc = fast_rcp(lt); }
      bf16_t* op = Ob + (size_t)(it.tok0 + q0w + qi - it.past) * OW + ocol + 4 * h2;
#pragma unroll
      for (int b = 0; b < NDV; ++b)
#pragma unroll
        for (int g = 0; g < 4; ++g) { const f32x4 v = {O[b][4 * g] * sc, O[b][4 * g + 1] * sc, O[b][4 * g + 2] * sc, O[b][4 * g + 3] * sc}; *(u32x2*)(op + 32 * b + 8 * g) = pack4(v); } }
    __syncthreads();
  } else {
    const float lam = ((const float*)(p.ws + WS_CTL))[CW_LAM + layer];
    const float sub_scale = 1.0f - (0.8f - 0.6f * expf(-0.3f * (float)layer));
    LAS float* xch = (LAS float*)(lds + L_XCH);
    __syncthreads();
    if (active && mp == 1) { const float lt = l_run + __shfl_xor(l_run, 32), sc = lam * fast_rcp(lt);
#pragma unroll
      for (int b = 0; b < NDV; ++b)
#pragma unroll
        for (int i = 0; i < 16; ++i) xch[((wave & 3) * 64 + b * 16 + i) * 64 + lane] = O[b][i] * sc; }
    __syncthreads();
    if (active && mp == 0) { const float lt = l_run + __shfl_xor(l_run, 32), sc = fast_rcp(lt); float q = 0.f;
#pragma unroll
      for (int b = 0; b < NDV; ++b)
#pragma unroll
        for (int i = 0; i < 16; ++i) { const float o = O[b][i] * sc - xch[((wave & 3) * 64 + b * 16 + i) * 64 + lane]; O[b][i] = o; q += o * o; }
      q += __shfl_xor(q, 32);
      const float rstd = __builtin_amdgcn_rsqf(q * (1.0f / 128.0f) + EPS) * sub_scale;
      const float* gain = p.c_subln + layer * 128 + 4 * h2;
      bf16_t* op = Ob + (size_t)(it.tok0 + q0w + qi - it.past) * OW + ocol + 4 * h2;
#pragma unroll
      for (int b = 0; b < NDV; ++b)
#pragma unroll
        for (int g = 0; g < 4; ++g) { const f32x4 gn = *(const f32x4*)(gain + 32 * b + 8 * g);
          const f32x4 v = {O[b][4 * g] * rstd * gn[0], O[b][4 * g + 1] * rstd * gn[1], O[b][4 * g + 2] * rstd * gn[2], O[b][4 * g + 3] * rstd * gn[3]}; *(u32x2*)(op + 32 * b + 8 * g) = pack4(v); } }
    __syncthreads();
  }
}

DI void attn_phase(const Params& p, int layer, LAS unsigned char* lds) {
  unsigned* head = (unsigned*)(p.ws + WS_CTL) + CW_QUEUE + 64 * layer;
  LAS unsigned* slot = (LAS unsigned*)(lds + L_FLAGS + 64);
  for (;;) {
    if (threadIdx.x == 0) slot[0] = atomicAdd(head, 1u);
    __syncthreads();
    const int idx = (int)slot[0];
    __syncthreads();
    if (idx >= NITEMS) break;
    const Item it = decode(p, layer, idx);
    if (it.mode == 0) run_item<0>(p, layer, it, lds); else if (it.mode == 1) run_item<1>(p, layer, it, lds); else run_item<2>(p, layer, it, lds);
  }
}
}
constexpr int NPHASE = 2 + 7 * NLAYER;
__global__ void __launch_bounds__(NTHREADS, 2) fwd_megakernel(Params p) {
  extern __shared__ __attribute__((aligned(16))) unsigned char lds_raw[];
  LAS unsigned char* lds = (LAS unsigned char*)lds_raw;
  cg::grid_group grid = cg::this_grid();
  const int lo = p.ph_lo, hi = p.ph_hi;
#define IN(k) (lo <= (k) && (k) < hi)
#define SEAM(k) do { if (IN(k) && IN((k) + 1)) grid.sync(); } while (0)
  unsigned char* ws = p.ws;
  const int G = gridDim.x, c = blockIdx.x;
  if (IN(0)) { p0_prologue(p, lds); }
  SEAM(0);
  for (int l = 0; l < NLAYER; ++l) {
    const int pb = 1 + 7 * l;
    if (IN(pb + 0)) {
      pg8::GemmDesc g{(const char*)(ws + WS_XB), (const char*)(ws + WS_WIN) + (size_t)l * INC * D * 2, D, D, D / 64, (size_t)256 * D * 2, (size_t)128 * D * 2};
      pg8::StaticOrder S; S.init(TOK / 256, INC / 256, G, c);
      EpiP1 E{(const float*)(ws + WS_SS), (bf16_t*)(ws + WS_QKV), (bf16_t*)(ws + WS_GATE), p.b_gate + (size_t)l * 3 * D, p.out, l};
      pg8::gemm_phase<EpiP1>(lds, g, S, E);
    }
    SEAM(pb + 0);
    if (IN(pb + 1)) { attn::attn_phase(p, l, lds); }
    SEAM(pb + 1);
    if (IN(pb + 2)) {
      pg8::GemmDesc g{(const char*)(ws + WS_O), (const char*)(ws + WS_WBR) + (size_t)l * D * OW * 2, OW, OW, OW / 64, (size_t)256 * OW * 2, (size_t)128 * OW * 2};
      pg8::StaticOrder S; S.init(TOK / 256, D / 256, G, c);
      EpiP3 E{(const bf16_t*)(ws + WS_GATE), (bf16_t*)(ws + WS_H)};
      pg8::gemm_phase<EpiP3>(lds, g, S, E);
    }
    SEAM(pb + 2);
    if (IN(pb + 3)) {
      pg8::GemmDesc g{(const char*)(ws + WS_H), (const char*)(ws + WS_WOUT) + (size_t)l * D * D * 2, D, D, D / 64, (size_t)256 * D * 2, (size_t)128 * D * 2};
      pg8::StaticOrder S; S.init(TOK / 256, D / 256, G, c);
      EpiRes E{(float*)(ws + WS_X32), (bf16_t*)(ws + WS_XB), (float*)(ws + WS_SS)};
      pg8::gemm_phase<EpiRes>(lds, g, S, E);
    }
    SEAM(pb + 3);
    if (IN(pb + 4)) {
      pg8::GemmDesc g{(const char*)(ws + WS_XB), (const char*)(ws + WS_WUP) + (size_t)l * 2 * DFF * D * 2, D, D, D / 64, (size_t)128 * D * 2, (size_t)DFF * D * 2};
      pg8::StaticOrder S; S.init(TOK / 256, DFF / 128, G, c);
      EpiP5 E{(const float*)(ws + WS_SS), (bf16_t*)(ws + WS_GU), p.out, l};
      pg8::gemm_phase<EpiP5>(lds, g, S, E);
    }
    SEAM(pb + 4);
    if (IN(pb + 5)) { p5b_ffn_act(p, l); }
    SEAM(pb + 5);
    if (IN(pb + 6)) {
      pg8::GemmDesc g{(const char*)(ws + WS_HF), (const char*)(ws + WS_WDN) + (size_t)l * D * DFF * 2, DFF, DFF, DFF / 64, (size_t)256 * DFF * 2, (size_t)128 * DFF * 2};
      pg8::StaticOrder S; S.init(TOK / 256, D / 256, G, c);
      EpiRes E{(float*)(ws + WS_X32), (bf16_t*)(ws + WS_XB), (float*)(ws + WS_SS)};
      pg8::gemm_phase<EpiRes>(lds, g, S, E);
    }
    SEAM(pb + 6);
  }
  if (IN(NPHASE - 1)) { pfinal_norm(p); }
#undef IN
#undef SEAM
}

#ifndef MK_ONE_LAUNCH
#define MK_ONE_LAUNCH 1
#endif
extern "C" void kernel_launch(void* const* d_in, const int* in_sizes, int n_in, void* d_out, int out_size, void* d_ws, size_t ws_size, hipStream_t stream) {
  static int grid_blocks = 0;
  if (grid_blocks == 0) {
    int dev = 0, cus = 0, per_cu = 0;
    (void)hipGetDevice(&dev);
    (void)hipDeviceGetAttribute(&cus, hipDeviceAttributeMultiprocessorCount, dev);
    (void)hipFuncSetAttribute((const void*)fwd_megakernel, hipFuncAttributeMaxDynamicSharedMemorySize, LDS_BYTES);
    (void)hipOccupancyMaxActiveBlocksPerMultiprocessor(&per_cu, (const void*)fwd_megakernel, NTHREADS, LDS_BYTES);
    if (per_cu < 1) { fprintf(stderr, "kernel_launch: occupancy query says %d blocks/CU\n", per_cu); per_cu = 1; }
    grid_blocks = cus * per_cu;
    if (n_in != 24 || (size_t)out_size != O_END || ws_size < WS_END) { fprintf(stderr, "kernel_launch: unexpected problem (n_in %d out %d ws %zu, need %zu)\n", n_in, out_size, ws_size, (size_t)WS_END); grid_blocks = -1; }
  }
  if (grid_blocks < 0) return;
  Params p{};
  const float** f = (const float**)&p;
  for (int i = 0; i < 24; ++i) f[i] = (const float*)d_in[i];
  p.out = (float*)d_out; p.ws = (unsigned char*)d_ws;
#if MK_ONE_LAUNCH
  p.ph_lo = 0; p.ph_hi = NPHASE;
  { void* args[] = {&p};
    hipError_t e = hipLaunchCooperativeKernel((void*)fwd_megakernel, dim3(grid_blocks), dim3(NTHREADS), args, LDS_BYTES, stream);
    if (e != hipSuccess) fprintf(stderr, "cooperative launch failed: %s (grid %d)\n", hipGetErrorString(e), grid_blocks); }
#else
  for (int k = 0; k < NPHASE; ++k) { p.ph_lo = k; p.ph_hi = k + 1; void* args[] = {&p};
    hipError_t e = hipLaunchCooperativeKernel((void*)fwd_megakernel, dim3(grid_blocks), dim3(NTHREADS), args, LDS_BYTES, stream);
    if (e != hipSuccess) { fprintf(stderr, "launch %d failed: %s (grid %d)\n", k, hipGetErrorString(e), grid_blocks); break; } }
#endif
}
```

```cpp
#include <hip/hip_runtime.h>
#include <hip/hip_cooperative_groups.h>
#include <cstdio>
#include <cstdint>
namespace cg = cooperative_groups;

#define DI __device__ __forceinline__
#define LAS __attribute__((address_space(3)))
typedef unsigned short bf16_t;
typedef short bf16x8 __attribute__((ext_vector_type(8)));
typedef short s16x4 __attribute__((ext_vector_type(4)));
typedef float f32x2 __attribute__((ext_vector_type(2)));
typedef float f32x4 __attribute__((ext_vector_type(4)));
typedef float f32x8 __attribute__((ext_vector_type(8)));
typedef float f32x16 __attribute__((ext_vector_type(16)));
typedef unsigned u32x2 __attribute__((ext_vector_type(2)));
typedef unsigned u32x4 __attribute__((ext_vector_type(4)));
typedef __bf16 bfv4 __attribute__((ext_vector_type(4)));
typedef __bf16 bfv8 __attribute__((ext_vector_type(8)));

constexpr int D = 1024, SEQ = 4096, NB = 4, TOKP = NB * SEQ, DB = 32, DSEQ = 64, TOKS = DB * DSEQ, TOK = TOKP + TOKS;
constexpr int PAST = 1024, ALEN = 512, INC = 7680, DFF = 2816, NLAYER = 2;
constexpr int QKVW = 4608, GATEW = 3072, OW = 1536;
constexpr float EPS = 1e-6f, LOG2E = 1.4426950408889634f;

constexpr size_t O_YP = 0, O_YS = O_YP + (size_t)TOKP * D, O_PAK = O_YS + (size_t)TOKS * D, O_PAV = O_PAK + (size_t)2 * 4 * 512 * 512,
                 O_PBK = O_PAV + (size_t)2 * 4 * 512 * 512, O_PBV = O_PBK + (size_t)2 * TOKP * 512, O_PCK = O_PBV + (size_t)2 * TOKP * 512,
                 O_PCV = O_PCK + (size_t)2 * TOKP * 512, O_PCONV = O_PCV + (size_t)2 * TOKP * 512, O_SAK = O_PCONV + (size_t)2 * 4 * 2 * DFF,
                 O_SAV = O_SAK + (size_t)2 * DB * 512 * 512, O_SBK = O_SAV + (size_t)2 * DB * 512 * 512, O_SBV = O_SBK + (size_t)2 * TOKS * 512,
                 O_SCK = O_SBV + (size_t)2 * TOKS * 512, O_SCV = O_SCK + (size_t)2 * TOKS * 512, O_SCONV = O_SCV + (size_t)2 * TOKS * 512,
                 O_END = O_SCONV + (size_t)2 * DB * 2 * DFF;

constexpr size_t MiB = 1u << 20;
constexpr size_t WS_CTL = 0;
constexpr size_t WS_WIN = 1 * MiB;
constexpr size_t WS_WBR = WS_WIN + (size_t)2 * INC * D * 2;
constexpr size_t WS_WOUT = WS_WBR + (size_t)2 * D * OW * 2;
constexpr size_t WS_WUP = WS_WOUT + (size_t)2 * D * D * 2;
constexpr size_t WS_WDN = WS_WUP + (size_t)2 * 2 * DFF * D * 2;
constexpr size_t WS_XB = WS_WDN + (size_t)2 * D * DFF * 2;
constexpr size_t WS_X32 = WS_XB + (size_t)TOK * D * 2;
constexpr size_t WS_SS = WS_X32 + (size_t)TOK * D * 4;
constexpr size_t WS_O = WS_SS + (size_t)TOK * 16 * 4;
constexpr size_t WS_H = WS_O + (size_t)TOK * OW * 2;
constexpr size_t WS_HF = WS_H + (size_t)TOK * D * 2;
constexpr size_t WS_QKV = WS_HF + (size_t)TOK * DFF * 2;
constexpr size_t WS_GATE = WS_QKV + (size_t)TOK * QKVW * 2;
constexpr size_t WS_GU = WS_QKV;
constexpr size_t WS_END = WS_GATE + (size_t)TOK * GATEW * 2;
static_assert((size_t)TOK * 2 * DFF * 2 <= (size_t)TOK * (QKVW + GATEW) * 2, "GU overlay fits");
constexpr int CW_QUEUE = 64;
constexpr int CW_LAM = 1024;
constexpr int CW_T5 = 2048;
constexpr int CW_BAR = 8192;

constexpr int LDS_BYTES = 160 * 1024;
constexpr int NTHREADS = 512;

DI u32x4 pack8(f32x4 a, f32x4 b) { f32x8 v = {a[0], a[1], a[2], a[3], b[0], b[1], b[2], b[3]}; return __builtin_bit_cast(u32x4, __builtin_convertvector(v, bfv8)); }
DI u32x2 pack4(f32x4 a) { return __builtin_bit_cast(u32x2, __builtin_convertvector(a, bfv4)); }
DI float bflo(unsigned w) { return __uint_as_float(w << 16); }
DI float bfhi(unsigned w) { return __uint_as_float(w & 0xffff0000u); }
DI float wave_sum(float v) {
#pragma unroll
  for (int o = 1; o < 64; o <<= 1) v += __shfl_xor(v, o);
  return v;
}
DI float fast_rcp(float x) { return __builtin_amdgcn_rcpf(x); }
DI float fast_exp2(float x) { return __builtin_amdgcn_exp2f(x); }
DI float fast_log2(float x) { return __builtin_amdgcn_logf(x); }

struct Params {
  const float* x_prompt; const float* x_sample;
  const float* cache_a_k; const float* cache_a_v; const float* cache_b_k; const float* cache_b_v; const float* cache_c_k; const float* cache_c_v;
  const float* state_conv; const float* norm_mix; const float* w_in; const float* b_gate; const float* a_rel_bias; const float* t5_bias;
  const float* c_lambda; const float* c_subln; const float* w_branch; const float* w_out; const float* norm_ffn; const float* w_up;
  const float* conv_w; const float* conv_b; const float* w_down; const float* norm_final;
  float* out; unsigned char* ws;
  int ph_lo, ph_hi;
};

DI void p0_transpose_item(const float* W, int N, const float* kscale, bf16_t* WT, int dst_ld, int dst_col, LAS float* scr, int item, int lane) {
  const int nblk = N / 32, kb = item / nblk, nb = item % nblk, k0 = 64 * kb, n0 = 32 * nb;
#pragma unroll 8
  for (int i = 0; i < 32; ++i) { const int kk = 2 * i + (lane >> 5); float v = W[(size_t)(k0 + kk) * N + n0 + (lane & 31)]; if (kscale) v *= kscale[k0 + kk]; scr[kk * 33 + (lane & 31)] = v; }
  asm volatile("s_waitcnt lgkmcnt(0)" ::: "memory");
  const int c = lane & 7;
#pragma unroll
  for (int j = 0; j < 4; ++j) { const int n = (lane >> 3) + 8 * j; const LAS float* s = scr + (8 * c) * 33 + n;
    f32x4 a = {s[0 * 33], s[1 * 33], s[2 * 33], s[3 * 33]}, b = {s[4 * 33], s[5 * 33], s[6 * 33], s[7 * 33]};
    *(u32x4*)(WT + (size_t)(n0 + n) * dst_ld + dst_col + k0 + 8 * c) = pack8(a, b); }
  asm volatile("s_waitcnt lgkmcnt(0)" ::: "memory");
}

DI int t5_bucket_of(int rel) {
  const int n = rel < 0 ? -rel : rel; int f;
  if (n < 8) f = n; else if (n < 12) f = 8; else if (n < 16) f = 9; else if (n < 23) f = 10; else if (n < 32) f = 11; else if (n < 46) f = 12; else if (n < 64) f = 13; else if (n < 91) f = 14; else f = 15;
  return (rel > 0 ? 16 : 0) + f;
}

DI void p0_prologue(const Params& p, LAS unsigned char* lds) {
  int tid_ = threadIdx.x; asm volatile("" : "+v"(tid_));
  const int tid = tid_, lane = tid & 63, wave = tid >> 6;
  const int gw = blockIdx.x * 8 + wave, NGW = gridDim.x * 8;
  unsigned* ctl = (unsigned*)(p.ws + WS_CTL);
  if (blockIdx.x == 0) {
    if (tid < 4) ctl[CW_QUEUE + 64 * tid] = 0u;
    for (int i = tid; i < 3456; i += NTHREADS) ctl[CW_BAR + i] = 0u;
    if (wave == 1) {
      for (int l = 0; l < NLAYER; ++l) { const float* lp = p.c_lambda + l * 256; const float a = wave_sum(lp[lane] * lp[64 + lane]), b = wave_sum(lp[128 + lane] * lp[192 + lane]);
        const float lam_init = 0.8f - 0.6f * expf(-0.3f * (float)l);
        if (lane == 0) ((float*)ctl)[CW_LAM + l] = expf(a) - expf(b) + lam_init; }
    }
    for (int i = tid; i < 4 * 192; i += NTHREADS) { const int h = i / 192, idx = i % 192; int rel = idx - 127; if (rel > 63) rel = 63;
      ((float*)ctl)[CW_T5 + i] = p.t5_bias[t5_bucket_of(rel) * 4 + h] * LOG2E; }
  }
  LAS float* scr = (LAS float*)(lds + wave * 8448);
  constexpr int I_IN = (D / 64) * (INC / 32), I_BR = (512 / 64) * (D / 32), I_OUT = (D / 64) * (D / 32), I_UP = (D / 64) * (2 * DFF / 32), I_DN = (DFF / 64) * (D / 32);
  constexpr int PER_LAYER = I_IN + 3 * I_BR + I_OUT + I_UP + I_DN;
  for (int it = gw; it < NLAYER * PER_LAYER; it += NGW) {
    const int l = it / PER_LAYER; int r = it % PER_LAYER;
    if (r < I_IN) { p0_transpose_item(p.w_in + (size_t)l * D * INC, INC, p.norm_mix + l * D, (bf16_t*)(p.ws + WS_WIN) + (size_t)l * INC * D, D, 0, scr, r, lane); continue; } r -= I_IN;
    if (r < 3 * I_BR) { const int n = r / I_BR; p0_transpose_item(p.w_branch + ((size_t)l * 3 + n) * 512 * D, D, nullptr, (bf16_t*)(p.ws + WS_WBR) + (size_t)l * D * OW, OW, 512 * n, scr, r % I_BR, lane); continue; } r -= 3 * I_BR;
    if (r < I_OUT) { p0_transpose_item(p.w_out + (size_t)l * D * D, D, nullptr, (bf16_t*)(p.ws + WS_WOUT) + (size_t)l * D * D, D, 0, scr, r, lane); continue; } r -= I_OUT;
    if (r < I_UP) { p0_transpose_item(p.w_up + (size_t)l * D * 2 * DFF, 2 * DFF, p.norm_ffn + l * D, (bf16_t*)(p.ws + WS_WUP) + (size_t)l * 2 * DFF * D, D, 0, scr, r, lane); continue; } r -= I_UP;
    p0_transpose_item(p.w_down + (size_t)l * DFF * D, D, nullptr, (bf16_t*)(p.ws + WS_WDN) + (size_t)l * D * DFF, DFF, 0, scr, r, lane);
  }
  float* X32 = (float*)(p.ws + WS_X32); bf16_t* XB = (bf16_t*)(p.ws + WS_XB); float* SS = (float*)(p.ws + WS_SS);
  for (int m = gw; m < TOK; m += NGW) {
    const float* src = m < TOKP ? p.x_prompt + (size_t)m * D : p.x_sample + (size_t)(m - TOKP) * D;
    float s = 0.f;
#pragma unroll
    for (int j = 0; j < 4; ++j) { const f32x4 v = ((const f32x4*)src)[lane + 64 * j]; ((f32x4*)(X32 + (size_t)m * D))[lane + 64 * j] = v; ((u32x2*)(XB + (size_t)m * D))[lane + 64 * j] = pack4(v);
      s += (v[0] * v[0] + v[1] * v[1]) + (v[2] * v[2] + v[3] * v[3]); }
    s = wave_sum(s);
    if (lane < 16) SS[(size_t)m * 16 + lane] = lane == 0 ? s : 0.f;
  }
  { const size_t gt = (size_t)blockIdx.x * NTHREADS + tid, gs = (size_t)gridDim.x * NTHREADS; constexpr size_t PER = (size_t)448 * 128, TOT = (size_t)NLAYER * DB * PER;
    for (size_t i = gt; i < 2 * TOT; i += gs) { const int which = i >= TOT; const size_t j = which ? i - TOT : i; const size_t lb = j / PER, rem = j % PER;
      const f32x4* src = (const f32x4*)((which ? p.cache_a_v : p.cache_a_k) + lb * 512 * 512 + 64 * 512) + rem;
      f32x4* dst = (f32x4*)(p.out + (which ? O_SAV : O_SAK) + lb * 512 * 512) + rem; *dst = *src; } }
}

namespace pg8 {
constexpr int BM = 256, BK = 64, HALF = 128, HTB = HALF * BK * 2, STAGE_BYTES = 8 * HTB, NXCD = 8, WGM = 8;
DI int lds_byte(int r, int c) { const int st = (r >> 4) * 2 + (c >> 5), rr = r & 15, cc = c & 31, ob = rr * 64 + cc * 2; return st * 1024 + (ob ^ (((ob >> 9) & 1) << 5)); }
DI void stage_rc(int b, int& R, int& C) { const int st = b / 1024, sb = b % 1024, swz = sb ^ (((sb >> 9) & 1) << 5); R = (st >> 1) * 16 + swz / 64; C = (st & 1) * 32 + (swz % 64) / 2; }
DI int perm32(int rho) { const int n = rho >> 4, i = rho & 15; return 8 * (i >> 2) + 4 * n + (i & 3); }
struct Unit { int pm, pn; };
struct GemmDesc { const char* A; const char* B; int lda, ldb, nt; size_t b_tile, b_half; };
struct StaticOrder {
  int nM, nN, nwg, G, c;
  DI void init(int nM_, int nN_, int G_, int c_) { nM = nM_; nN = nN_; nwg = nM * nN; G = G_; c = c_; }
  DI bool next(int i, Unit& u) const {
    const long L = (long)i * G + c; if (L >= nwg) return false;
    int wgid = (int)L; { const int q = nwg / NXCD, r = nwg % NXCD, xcd = wgid % NXCD, off = wgid / NXCD; wgid = (xcd < r ? xcd * (q + 1) : r * (q + 1) + (xcd - r) * q) + off; }
    const int nig = WGM * nN, gid = wgid / nig, fm = gid * WGM, gsz = (nM - fm) < WGM ? (nM - fm) : WGM;
    u.pm = fm + ((wgid % nig) % gsz); u.pn = (wgid % nig) / gsz; return true;
  }
};
template <class Epi>
DI void gemm_phase(LAS unsigned char* lds, const GemmDesc g, const StaticOrder& S, const Epi& E) {
  int tid_ = threadIdx.x; asm volatile("" : "+v"(tid_));
  const int tid = tid_, wid = __builtin_amdgcn_readfirstlane(tid >> 6), lane = tid & 63, wr = wid >> 2, wc = wid & 3, fr = lane & 15, fq = lane >> 4;
  const int nt = g.nt;
  unsigned voffA[2], voffB[2];
#pragma unroll
  for (int i = 0; i < 2; ++i) { int R, C; stage_rc(tid * 16 + i * 8192, R, C); const int Rb = Epi::PERM ? ((R & ~31) + perm32(R & 31)) : R;
    voffA[i] = (unsigned)(R * g.lda + C) * 2u; voffB[i] = (unsigned)(Rb * g.ldb + C) * 2u; }
  const size_t kstep = (size_t)(BK * 2);
  const size_t hsA = (size_t)HALF * g.lda * 2, tsA = 2 * hsA, hsB = g.b_half, tsB = g.b_tile;
  const unsigned ldsw = (unsigned)wid * 1024u;
  const int aoff = lds_byte(wr * 64 + fr, fq * 8), boff = lds_byte(wc * 32 + fr, fq * 8);
#define PG8_SA(b, h) (((b) * 2 + (h)) * HTB)
#define PG8_SB(b, h) ((4 + (b) * 2 + (h)) * HTB)
#define PG8_STAGE(bufoff, gbase, voff) do { _Pragma("unroll") for (int _i = 0; _i < 2; ++_i) \
    __builtin_amdgcn_global_load_lds((const unsigned*)((const char*)(gbase) + (voff)[_i]), (LAS unsigned*)(lds + (bufoff) + ldsw + _i * 8192), 16, 0, 0); } while (0)
#define PG8_LDA(dst, b, h) do { _Pragma("unroll") for (int m = 0; m < 4; ++m) _Pragma("unroll") for (int k = 0; k < 2; ++k) dst[m][k] = *(const LAS bf16x8*)(lds + PG8_SA(b, h) + aoff + m * 2048 + k * 1024); } while (0)
#define PG8_LDB(dst, b, h) do { _Pragma("unroll") for (int n = 0; n < 2; ++n) _Pragma("unroll") for (int k = 0; k < 2; ++k) dst[n][k] = *(const LAS bf16x8*)(lds + PG8_SB(b, h) + boff + n * 2048 + k * 1024); } while (0)
#define PG8_MMA(ai, bj, At, Bt) do { __builtin_amdgcn_s_setprio(1); _Pragma("unroll") for (int m = 0; m < 4; ++m) _Pragma("unroll") for (int n = 0; n < 2; ++n) _Pragma("unroll") for (int k = 0; k < 2; ++k) \
    acc[ai][bj][m][n] = __builtin_amdgcn_mfma_f32_16x16x32_bf16(Bt[n][k], At[m][k], acc[ai][bj][m][n], 0, 0, 0); __builtin_amdgcn_s_setprio(0); } while (0)
#define PG8_WAIT_V(n) asm volatile("s_waitcnt vmcnt(" #n ")" ::: "memory")
#define PG8_WAIT_L(n) asm volatile("s_waitcnt lgkmcnt(" #n ")" ::: "memory")
#define PG8_BAR __builtin_amdgcn_s_barrier()
#define PG8_SCHED __builtin_amdgcn_sched_barrier(0)
  Unit cur, nxt; int ui = 0;
  if (!S.next(0, cur)) return;
  f32x4 acc[2][2][4][2];
#pragma unroll
  for (int a = 0; a < 2; ++a)
#pragma unroll
    for (int b = 0; b < 2; ++b)
#pragma unroll
      for (int m = 0; m < 4; ++m)
#pragma unroll
        for (int n = 0; n < 2; ++n) acc[a][b][m][n] = (f32x4){0.f, 0.f, 0.f, 0.f};
  bf16x8 At[4][2], B0[2][2], B1[2][2];
  const char* cA = g.A + (size_t)cur.pm * tsA; const char* cB = g.B + (size_t)cur.pn * tsB;
  PG8_STAGE(PG8_SB(0, 0), cB, voffB); PG8_STAGE(PG8_SB(0, 1), cB + hsB, voffB); PG8_STAGE(PG8_SA(0, 0), cA, voffA); PG8_STAGE(PG8_SA(0, 1), cA + hsA, voffA);
  if (wr == 1) PG8_BAR;
  PG8_WAIT_V(2); PG8_BAR;
  PG8_STAGE(PG8_SB(1, 0), cB + kstep, voffB); PG8_STAGE(PG8_SA(1, 0), cA + kstep, voffA); PG8_STAGE(PG8_SB(1, 1), cB + hsB + kstep, voffB);
  PG8_WAIT_V(6); PG8_BAR;
  for (;;) {
    const bool has_next = S.next(ui + 1, nxt);
    const char* nA = has_next ? g.A + (size_t)nxt.pm * tsA : cA; const char* nB = has_next ? g.B + (size_t)nxt.pn * tsB : cB;
    for (int t = 0; t < nt; t += 2) {
      const bool last = (t == nt - 2);
      const char* a1 = cA + (size_t)(t + 1) * kstep;
      const char* a2 = last ? nA : cA + (size_t)(t + 2) * kstep; const char* b2 = last ? nB : cB + (size_t)(t + 2) * kstep;
      const char* a3 = a2 + kstep; const char* b3 = b2 + kstep;
      if constexpr (Epi::HAS_MID) { if (t == 8 || t == 16) E.mid(acc, cur, t, wr, wc, fr, fq); }
      PG8_LDB(B0, 0, 0); PG8_LDB(B1, 0, 1); PG8_SCHED; PG8_LDA(At, 0, 0); PG8_STAGE(PG8_SA(1, 1), a1 + hsA, voffA);
      PG8_WAIT_V(8); PG8_WAIT_L(0); PG8_BAR; PG8_MMA(0, 0, At, B0); PG8_MMA(0, 1, At, B1); PG8_BAR; PG8_SCHED;
      PG8_LDA(At, 0, 1); PG8_STAGE(PG8_SB(0, 0), b2, voffB); PG8_STAGE(PG8_SB(0, 1), b2 + hsB, voffB); PG8_STAGE(PG8_SA(0, 0), a2, voffA);
      PG8_WAIT_V(8); PG8_WAIT_L(0); PG8_BAR; PG8_MMA(1, 0, At, B0); PG8_MMA(1, 1, At, B1); PG8_BAR; PG8_SCHED;
      PG8_LDB(B0, 1, 0); PG8_LDB(B1, 1, 1); PG8_SCHED; PG8_LDA(At, 1, 0); PG8_STAGE(PG8_SA(0, 1), a2 + hsA, voffA);
      PG8_WAIT_V(8); PG8_WAIT_L(0); PG8_BAR; PG8_MMA(0, 0, At, B0); PG8_MMA(0, 1, At, B1); PG8_BAR; PG8_SCHED;
      PG8_LDA(At, 1, 1); PG8_STAGE(PG8_SB(1, 0), b3, voffB); PG8_STAGE(PG8_SB(1, 1), b3 + hsB, voffB); PG8_STAGE(PG8_SA(1, 0), a3, voffA);
      PG8_WAIT_V(8); PG8_WAIT_L(0); PG8_BAR; PG8_MMA(1, 0, At, B0); PG8_MMA(1, 1, At, B1); PG8_BAR; PG8_SCHED;
    }
    if (wr == 0) PG8_BAR;
    E(acc, cur, wr, wc, fr, fq);
    if (!has_next) break;
#pragma unroll
    for (int a = 0; a < 2; ++a)
#pragma unroll
      for (int b = 0; b < 2; ++b)
#pragma unroll
        for (int m = 0; m < 4; ++m)
#pragma unroll
          for (int n = 0; n < 2; ++n) acc[a][b][m][n] = (f32x4){0.f, 0.f, 0.f, 0.f};
    cur = nxt; cA = nA; cB = nB; ++ui;
    if (wr == 1) PG8_BAR;
  }
  PG8_WAIT_V(0);
  PG8_BAR;
#undef PG8_SA
#undef PG8_SB
#undef PG8_STAGE
#undef PG8_LDA
#undef PG8_LDB
#undef PG8_MMA
#undef PG8_WAIT_V
#undef PG8_WAIT_L
#undef PG8_BAR
#undef PG8_SCHED
}
}
using pg8::Unit;
DI float row_rs(const float* SS, int r) {
  const f32x4* s = (const f32x4*)(SS + (size_t)r * 16); const f32x4 a = s[0], b = s[1], c = s[2], d = s[3];
  const float t = ((a[0] + a[1]) + (a[2] + a[3])) + ((b[0] + b[1]) + (b[2] + b[3])) + ((c[0] + c[1]) + (c[2] + c[3])) + ((d[0] + d[1]) + (d[2] + d[3]));
  return __builtin_amdgcn_rsqf(t * (1.0f / D) + EPS);
}
DI float sigmoidf_(float x) { return fast_rcp(1.0f + fast_exp2(-x * LOG2E)); }

struct EpiP1 {
  static constexpr bool PERM = true, HAS_MID = false;
  const float* SS; bf16_t* QKV; bf16_t* GATE; const float* bgate; float* out; int layer;
  DI void mid(f32x4 (&)[2][2][4][2], const Unit&, int, int, int, int, int) const {}
  DI void operator()(f32x4 (&acc)[2][2][4][2], const Unit& u, int wr, int wc, int fr, int fq) const {
    const int pn = u.pn, rin0 = wr * 64 + fr, row0 = u.pm * 256 + rin0;
    float rs[2][4];
#pragma unroll
    for (int ai = 0; ai < 2; ++ai)
#pragma unroll
      for (int m = 0; m < 4; ++m) rs[ai][m] = row_rs(SS, row0 + ai * 128 + m * 16);
    if (pn < 18) {
      const int colq = pn * 256 + wc * 32 + 8 * fq;
      const int kind = (pn >> 1) % 3, br = pn / 6, tcol = (pn & 1) * 256 + wc * 32 + 8 * fq;
      float* sbase = nullptr; size_t srow_stride = 512; int rowshift = 0; bool prompt = u.pm < 64; bool do_state = kind != 0;
      int b = 0, t0 = 0;
      if (do_state) {
        const bool isv = kind == 2;
        if (prompt) { b = u.pm >> 4; t0 = (u.pm & 15) * 256;
          if (br == 0) { if ((u.pm & 15) < 14) do_state = false; else { sbase = out + (isv ? O_PAV : O_PAK) + (size_t)(layer * 4 + b) * 512 * 512; rowshift = t0 - 3584; } }
          else { sbase = out + (br == 1 ? (isv ? O_PBV : O_PBK) : (isv ? O_PCV : O_PCK)) + (size_t)(layer * 4 + b) * SEQ * 512; rowshift = t0; }
        }
      }
#pragma unroll
      for (int ai = 0; ai < 2; ++ai)
#pragma unroll
        for (int m = 0; m < 4; ++m) {
          const int rin = rin0 + ai * 128 + m * 16, r = u.pm * 256 + rin; const float s = rs[ai][m];
          bf16_t* rowp = QKV + (size_t)r * QKVW + colq;
          float* sp = nullptr;
          if (do_state) {
            if (prompt) sp = sbase + (size_t)(rowshift + rin) * 512 + tcol;
            else { const int sidx = (u.pm - 64) * 256 + rin, bd = sidx >> 6, t = sidx & 63; const bool isv = kind == 2;
              if (br == 0) sp = out + (isv ? O_SAV : O_SAK) + ((size_t)(layer * DB + bd) * 512 + 448 + t) * 512 + tcol;
              else sp = out + (br == 1 ? (isv ? O_SBV : O_SBK) : (isv ? O_SCV : O_SCK)) + ((size_t)(layer * DB + bd) * 64 + t) * 512 + tcol; }
          }
#pragma unroll
          for (int bj = 0; bj < 2; ++bj) { const f32x4 v0 = acc[ai][bj][m][0] * s, v1 = acc[ai][bj][m][1] * s;
            *(u32x4*)(rowp + bj * 128) = pack8(v0, v1);
            if (do_state) { *(f32x4*)(sp + bj * 128) = v0; *(f32x4*)(sp + bj * 128 + 4) = v1; } }
        }
    } else {
      const int gi = pn - 18, nb = gi >> 2, colg = (gi & 3) * 256 + wc * 32 + 8 * fq;
      f32x4 bv[2][2];
#pragma unroll
      for (int bj = 0; bj < 2; ++bj) { bv[bj][0] = *(const f32x4*)(bgate + nb * D + colg + bj * 128); bv[bj][1] = *(const f32x4*)(bgate + nb * D + colg + bj * 128 + 4); }
#pragma unroll
      for (int ai = 0; ai < 2; ++ai)
#pragma unroll
        for (int m = 0; m < 4; ++m) { const int r = row0 + ai * 128 + m * 16; const float s = rs[ai][m];
          bf16_t* rowp = GATE + (size_t)r * GATEW + gi * 256 + wc * 32 + 8 * fq;
#pragma unroll
          for (int bj = 0; bj < 2; ++bj) { f32x4 v0 = acc[ai][bj][m][0] * s + bv[bj][0], v1 = acc[ai][bj][m][1] * s + bv[bj][1];
#pragma unroll
            for (int j = 0; j < 4; ++j) { v0[j] = sigmoidf_(v0[j]); v1[j] = sigmoidf_(v1[j]); }
            *(u32x4*)(rowp + bj * 128) = pack8(v0, v1); } }
    }
  }
};

struct EpiP3 {
  static constexpr bool PERM = true, HAS_MID = true;
  const bf16_t* GATE; bf16_t* H;
  DI void mid(f32x4 (&acc)[2][2][4][2], const Unit& u, int t, int wr, int wc, int fr, int fq) const {
    const int nb = (t >> 3) - 1;
    const bf16_t* gp = GATE + (size_t)(u.pm * 256 + wr * 64 + fr) * GATEW + nb * D + u.pn * 256 + wc * 32 + 8 * fq;
#pragma unroll
    for (int ai = 0; ai < 2; ++ai)
#pragma unroll
      for (int m = 0; m < 4; ++m) {
#pragma unroll
        for (int bj = 0; bj < 2; ++bj)
#pragma unroll
          for (int n = 0; n < 2; ++n) { const bf16_t* q = gp + (size_t)(ai * 128 + m * 16) * GATEW + bj * 128 + 4 * n;
            const u32x2 ga = *(const u32x2*)q, gb = *(const u32x2*)(q + D);
            acc[ai][bj][m][n][0] *= bflo(ga[0]) * fast_rcp(bflo(gb[0])); acc[ai][bj][m][n][1] *= bfhi(ga[0]) * fast_rcp(bfhi(gb[0]));
            acc[ai][bj][m][n][2] *= bflo(ga[1]) * fast_rcp(bflo(gb[1])); acc[ai][bj][m][n][3] *= bfhi(ga[1]) * fast_rcp(bfhi(gb[1])); }
        asm volatile("" ::: "memory"); }
  }
  DI void operator()(f32x4 (&acc)[2][2][4][2], const Unit& u, int wr, int wc, int fr, int fq) const {
    const int row0 = u.pm * 256 + wr * 64 + fr, col0 = u.pn * 256 + wc * 32 + 8 * fq;
#pragma unroll
    for (int ai = 0; ai < 2; ++ai)
#pragma unroll
      for (int m = 0; m < 4; ++m) { const int r = row0 + ai * 128 + m * 16; const bf16_t* gp = GATE + (size_t)r * GATEW + 2 * D + col0; bf16_t* hp = H + (size_t)r * D + col0;
#pragma unroll
        for (int bj = 0; bj < 2; ++bj) { const u32x4 g = *(const u32x4*)(gp + bj * 128); f32x4 v0 = acc[ai][bj][m][0], v1 = acc[ai][bj][m][1];
          v0[0] *= bflo(g[0]); v0[1] *= bfhi(g[0]); v0[2] *= bflo(g[1]); v0[3] *= bfhi(g[1]); v1[0] *= bflo(g[2]); v1[1] *= bfhi(g[2]); v1[2] *= bflo(g[3]); v1[3] *= bfhi(g[3]);
          *(u32x4*)(hp + bj * 128) = pack8(v0, v1); } }
  }
};

struct EpiRes {
  static constexpr bool PERM = false, HAS_MID = false;
  float* X32; bf16_t* XB; float* SS;
  DI void mid(f32x4 (&)[2][2][4][2], const Unit&, int, int, int, int, int) const {}
  DI void operator()(f32x4 (&acc)[2][2][4][2], const Unit& u, int wr, int wc, int fr, int fq) const {
    const int row0 = u.pm * 256 + wr * 64 + fr, col0 = u.pn * 256 + wc * 32 + 4 * fq;
#pragma unroll
    for (int ai = 0; ai < 2; ++ai)
#pragma unroll
      for (int m = 0; m < 4; ++m) { const int r = row0 + ai * 128 + m * 16; float* xp = X32 + (size_t)r * D + col0; bf16_t* bp = XB + (size_t)r * D + col0; float q = 0.f;
#pragma unroll
        for (int bj = 0; bj < 2; ++bj)
#pragma unroll
          for (int n = 0; n < 2; ++n) { const f32x4 xo = *(const f32x4*)(xp + bj * 128 + n * 16); const f32x4 xn = xo + acc[ai][bj][m][n];
            *(f32x4*)(xp + bj * 128 + n * 16) = xn; *(u32x2*)(bp + bj * 128 + n * 16) = pack4(xn); q += (xn[0] * xn[0] + xn[1] * xn[1]) + (xn[2] * xn[2] + xn[3] * xn[3]); }
        q += __shfl_xor(q, 16); q += __shfl_xor(q, 32);
        if (fq == 0) SS[(size_t)r * 16 + u.pn * 4 + wc] = q; }
  }
};

struct EpiP5 {
  static constexpr bool PERM = true, HAS_MID = false;
  const float* SS; bf16_t* GU; float* out; int layer;
  DI void mid(f32x4 (&)[2][2][4][2], const Unit&, int, int, int, int, int) const {}
  DI void operator()(f32x4 (&acc)[2][2][4][2], const Unit& u, int wr, int wc, int fr, int fq) const {
    const int rin0 = wr * 64 + fr, col0 = u.pn * 128 + wc * 32 + 8 * fq;
#pragma unroll
    for (int ai = 0; ai < 2; ++ai)
#pragma unroll
      for (int m = 0; m < 4; ++m) { const int rin = rin0 + ai * 128 + m * 16, r = u.pm * 256 + rin; const float s = row_rs(SS, r);
        const f32x4 g0 = acc[ai][0][m][0] * s, g1 = acc[ai][0][m][1] * s, u0 = acc[ai][1][m][0] * s, u1 = acc[ai][1][m][1] * s;
        bf16_t* gp = GU + (size_t)r * (2 * DFF) + col0; *(u32x4*)gp = pack8(g0, g1); *(u32x4*)(gp + DFF) = pack8(u0, u1);
        float* cp = nullptr;
        if (u.pm < 64) { const int t = (u.pm & 15) * 256 + rin; if (t >= SEQ - 2) cp = out + O_PCONV + ((size_t)(layer * 4 + (u.pm >> 4)) * 2 + (t - (SEQ - 2))) * DFF + col0; }
        else { const int sidx = (u.pm - 64) * 256 + rin, bd = sidx >> 6, t = sidx & 63; if (t >= 62) cp = out + O_SCONV + ((size_t)(layer * DB + bd) * 2 + (t - 62)) * DFF + col0; }
        if (cp) { *(f32x4*)cp = g0; *(f32x4*)(cp + 4) = g1; } }
  }
};

DI float gelu_tanh(float x) {
  const float y = 0.7978845608028654f * (x + 0.044715f * x * x * x);
  const float e = fast_exp2(2.0f * LOG2E * y);
  const float th = 1.0f - 2.0f * fast_rcp(e + 1.0f);
  return 0.5f * x * (1.0f + th);
}
DI void p5b_ffn_act(const Params& p, int layer) {
  const bf16_t* GU = (const bf16_t*)(p.ws + WS_GU); bf16_t* HF = (bf16_t*)(p.ws + WS_HF);
  const float* cw = p.conv_w + (size_t)layer * 3 * DFF; const float* cb = p.conv_b + (size_t)layer * DFF; const float* st = p.state_conv + (size_t)layer * DB * 2 * DFF;
  constexpr int CPR = DFF / 8;
  int tid_ = threadIdx.x; asm volatile("" : "+v"(tid_));
  const size_t gt = (size_t)blockIdx.x * NTHREADS + tid_, gs = (size_t)gridDim.x * NTHREADS;
  for (size_t i = gt; i < (size_t)TOK * CPR; i += gs) {
    const int r = (int)(i / CPR), c = (int)(i % CPR) * 8;
    int t; const float* strow = nullptr;
    if (r < TOKP) t = r & (SEQ - 1); else { const int s = r - TOKP; t = s & 63; strow = st + (size_t)(s >> 6) * 2 * DFF; }
    const u32x4 g2 = *(const u32x4*)(GU + (size_t)r * (2 * DFF) + c), uu = *(const u32x4*)(GU + (size_t)r * (2 * DFF) + DFF + c);
    float gm1[8], gm2[8];
    if (t >= 1) { const u32x4 v = *(const u32x4*)(GU + (size_t)(r - 1) * (2 * DFF) + c);
#pragma unroll
      for (int j = 0; j < 4; ++j) { gm1[2 * j] = bflo(v[j]); gm1[2 * j + 1] = bfhi(v[j]); } }
    else {
#pragma unroll
      for (int j = 0; j < 8; ++j) gm1[j] = strow ? strow[DFF + c + j] : 0.f; }
    if (t >= 2) { const u32x4 v = *(const u32x4*)(GU + (size_t)(r - 2) * (2 * DFF) + c);
#pragma unroll
      for (int j = 0; j < 4; ++j) { gm2[2 * j] = bflo(v[j]); gm2[2 * j + 1] = bfhi(v[j]); } }
    else {
#pragma unroll
      for (int j = 0; j < 8; ++j) gm2[j] = strow ? strow[(size_t)t * DFF + c + j] : 0.f; }
    float o[8];
#pragma unroll
    for (int j = 0; j < 8; ++j) { const float g = (j & 1) ? bfhi(g2[j >> 1]) : bflo(g2[j >> 1]), uv = (j & 1) ? bfhi(uu[j >> 1]) : bflo(uu[j >> 1]);
      const float cv = cb[c + j] + cw[c + j] * gm2[j] + cw[DFF + c + j] * gm1[j] + cw[2 * DFF + c + j] * g;
      o[j] = gelu_tanh(cv) * uv; }
    *(u32x4*)(HF + (size_t)r * DFF + c) = pack8((f32x4){o[0], o[1], o[2], o[3]}, (f32x4){o[4], o[5], o[6], o[7]});
  }
}
DI void pfinal_norm(const Params& p) {
  const float* X32 = (const float*)(p.ws + WS_X32); const float* SS = (const float*)(p.ws + WS_SS);
  int tid_ = threadIdx.x; asm volatile("" : "+v"(tid_));
  const int lane = tid_ & 63, gw = blockIdx.x * 8 + (tid_ >> 6), NGW = gridDim.x * 8;
  for (int m = gw; m < TOK; m += NGW) { const float s = row_rs(SS, m);
#pragma unroll
    for (int j = 0; j < 4; ++j) { const f32x4 v = ((const f32x4*)(X32 + (size_t)m * D))[lane + 64 * j], g = ((const f32x4*)p.norm_final)[lane + 64 * j];
      ((f32x4*)(p.out + (size_t)m * D))[lane + 64 * j] = v * s * g; } }
}
namespace attn {
constexpr int L_K1 = 0, L_K2 = 8192, L_V = 16384, L_LUT = 40960, L_FLAGS = 43008, L_XCH = 49152;
constexpr int N_CS = 128, N_CP = 512, N_AP = 512, N_BP = 512, N_AS = 256, N_BS = 256, NITEMS = N_CS + N_CP + N_AP + N_BP + N_AS + N_BS;
constexpr float STICK_DONE2 = -60.0f * LOG2E;

struct Item { int mode, h, tok0, past, q0, nqv; const float* cK; const float* cV; };

DI Item decode(const Params& p, int layer, int idx) {
  Item it; it.cK = nullptr; it.cV = nullptr; it.past = 0;
  if (idx < N_CS) { const int bd = idx >> 2, h = idx & 3; it.mode = 2; it.h = h; it.tok0 = TOKP + bd * 64; it.past = PAST; it.q0 = PAST; it.nqv = 64;
    it.cK = p.cache_c_k + (size_t)(layer * DB + bd) * PAST * 512 + h * 128; it.cV = p.cache_c_v + (size_t)(layer * DB + bd) * PAST * 512 + h * 128; return it; }
  idx -= N_CS;
  if (idx < N_CP) { const int jj = 31 - (idx >> 4), rem = idx & 15; it.mode = 2; it.h = rem & 3; it.tok0 = (rem >> 2) * SEQ; it.q0 = jj * 128; it.nqv = 128; return it; }
  idx -= N_CP;
  if (idx < N_AP + N_BP) { const int isb = idx >= N_AP; if (isb) idx -= N_AP; const int qt = 15 - (idx >> 5), rem = idx & 31; it.mode = isb; it.h = rem & 7; it.tok0 = (rem >> 3) * SEQ; it.q0 = qt * 256; it.nqv = 256; return it; }
  idx -= N_AP + N_BP;
  if (idx < N_AS) { const int bd = idx >> 3, h = idx & 7; it.mode = 0; it.h = h; it.tok0 = TOKP + bd * 64; it.past = ALEN; it.q0 = ALEN; it.nqv = 64;
    it.cK = p.cache_a_k + (size_t)(layer * DB + bd) * ALEN * 512 + h * 64; it.cV = p.cache_a_v + (size_t)(layer * DB + bd) * ALEN * 512 + h * 64; return it; }
  idx -= N_AS;
  { const int bd = idx >> 3, h = idx & 7; it.mode = 1; it.h = h; it.tok0 = TOKP + bd * 64; it.past = PAST; it.q0 = PAST; it.nqv = 64;
    it.cK = p.cache_b_k + (size_t)(layer * DB + bd) * PAST * 512 + h * 64; it.cV = p.cache_b_v + (size_t)(layer * DB + bd) * PAST * 512 + h * 64; return it; }
}


template <int MODE>
DI void load_tile(u32x4& k0, u32x4& k1, u32x4& k2, u32x4& k3, u32x4& v0, u32x4& v1, u32x4& v2, u32x4& v3, const Item& it, const bf16_t* QKV, int kcol, int vcol, int kt, int tid) {
  constexpr int CPR = MODE == 2 ? 16 : 8;
  const int j0 = kt * 64;
  const int r0 = tid / CPR, c0 = tid % CPR, r1 = (tid + NTHREADS) / CPR, c1 = (tid + NTHREADS) % CPR;
  if (j0 < it.past) {
    { const u32x4* kp = (const u32x4*)(it.cK + (size_t)(j0 + r0) * 512 + c0 * 8); const u32x4* vp = (const u32x4*)(it.cV + (size_t)(j0 + r0) * 512 + c0 * 8);
      k0 = kp[0]; k1 = kp[1]; v0 = vp[0]; v1 = vp[1]; }
    if constexpr (MODE == 2) { const u32x4* kp = (const u32x4*)(it.cK + (size_t)(j0 + r1) * 512 + c1 * 8); const u32x4* vp = (const u32x4*)(it.cV + (size_t)(j0 + r1) * 512 + c1 * 8);
      k2 = kp[0]; k3 = kp[1]; v2 = vp[0]; v3 = vp[1]; }
  } else {
    { const bf16_t* base = QKV + (size_t)(it.tok0 + j0 + r0 - it.past) * QKVW + c0 * 8; k0 = *(const u32x4*)(base + kcol); v0 = *(const u32x4*)(base + vcol); }
    if constexpr (MODE == 2) { const bf16_t* base = QKV + (size_t)(it.tok0 + j0 + r1 - it.past) * QKVW + c1 * 8; k2 = *(const u32x4*)(base + kcol); v2 = *(const u32x4*)(base + vcol); }
  }
}
DI u32x4 cvt8(u32x4 a, u32x4 b) { return pack8(__builtin_bit_cast(f32x4, a), __builtin_bit_cast(f32x4, b)); }
template <int MODE>
DI void write_tile(const u32x4& k0, const u32x4& k1, const u32x4& k2, const u32x4& k3, const u32x4& v0, const u32x4& v1, const u32x4& v2, const u32x4& v3, const Item& it, LAS unsigned char* lds, int kt, int tid) {
  constexpr int CPR = MODE == 2 ? 16 : 8, VS = MODE == 2 ? 320 : 192;
  const bool f32src = kt * 64 < it.past;
  const int r0 = tid / CPR, c0 = tid % CPR, r1 = (tid + NTHREADS) / CPR, c1 = (tid + NTHREADS) % CPR;
  { const u32x4 kk = f32src ? cvt8(k0, k1) : k0, vv = f32src ? cvt8(v0, v1) : v0;
    const int kreg = (MODE == 2 && c0 >= 8) ? L_K2 : L_K1;
    *(LAS u32x4*)(lds + kreg + r0 * 128 + (((c0 & 7) ^ ((r0 >> 1) & 7)) << 4)) = kk;
    *(LAS u32x4*)(lds + L_V + r0 * VS + c0 * 16) = vv; }
  if constexpr (MODE == 2) { const u32x4 kk = f32src ? cvt8(k2, k3) : k2, vv = f32src ? cvt8(v2, v3) : v2;
    const int kreg = (c1 >= 8) ? L_K2 : L_K1;
    *(LAS u32x4*)(lds + kreg + r1 * 128 + (((c1 & 7) ^ ((r1 >> 1) & 7)) << 4)) = kk;
    *(LAS u32x4*)(lds + L_V + r1 * VS + c1 * 16) = vv; }
}

DI bf16x8 pack_p(const f32x16& x, int s) {
  const f32x4 a = {x[8 * s], x[8 * s + 1], x[8 * s + 2], x[8 * s + 3]}, b = {x[8 * s + 4], x[8 * s + 5], x[8 * s + 6], x[8 * s + 7]};
  return __builtin_bit_cast(bf16x8, pack8(a, b));
}
#define MFMA32(a, b, c) __builtin_amdgcn_mfma_f32_32x32x16_bf16((a), (b), (c), 0, 0, 0)

template <int MODE>
DI void run_item(const Params& p, int layer, const Item& it, LAS unsigned char* lds) {
  constexpr int NDV = MODE == 2 ? 4 : 2, VS = MODE == 2 ? 320 : 192;
  int tid_ = threadIdx.x; asm volatile("" : "+v"(tid_));
  const int tid = tid_, lane = tid & 63, wave = __builtin_amdgcn_readfirstlane(tid >> 6);
  const int qi = lane & 31, h2 = lane >> 5;
  const int mp = MODE == 2 ? (wave >> 2) : 0, wrow = MODE == 2 ? (wave & 3) : wave;
  const int q0w = it.q0 + 32 * wrow;
  const bool active = 32 * wrow < it.nqv;
  const bf16_t* QKV = (const bf16_t*)(p.ws + WS_QKV);
  const int hb = MODE == 2 ? it.h * 128 : it.h * 64;
  const int qcol = (MODE == 0 ? 0 : MODE == 1 ? 1536 : 3072) + hb + 64 * mp, kcol = (MODE == 0 ? 512 : MODE == 1 ? 2048 : 3584) + hb, vcol = (MODE == 0 ? 1024 : MODE == 1 ? 2560 : 4096) + hb;
  LAS float* lut = (LAS float*)(lds + L_LUT);
  LAS unsigned* flags = (LAS unsigned*)(lds + L_FLAGS);
  if (MODE == 0) { for (int i = tid; i < 257; i += NTHREADS) lut[i] = p.a_rel_bias[((size_t)layer * 257 + i) * 8 + it.h] * LOG2E; }
  if (MODE == 2) { if (tid < 192) lut[tid] = ((const float*)(p.ws + WS_CTL))[CW_T5 + it.h * 192 + tid]; }
  bf16x8 qf[4];
  if (active) { const bf16_t* qp = QKV + (size_t)(it.tok0 + q0w + qi - it.past) * QKVW + qcol + 8 * h2;
#pragma unroll
    for (int s = 0; s < 4; ++s) { const u32x4 w = *(const u32x4*)(qp + 16 * s);
      const f32x4 a = {bflo(w[0]) * 0.125f, bfhi(w[0]) * 0.125f, bflo(w[1]) * 0.125f, bfhi(w[1]) * 0.125f}, b = {bflo(w[2]) * 0.125f, bfhi(w[2]) * 0.125f, bflo(w[3]) * 0.125f, bfhi(w[3]) * 0.125f};
      qf[s] = __builtin_bit_cast(bf16x8, pack8(a, b)); } }
  const int cw = q0w >> 6;
  int kt_first, kt_last, step;
  if (MODE == 0) { kt_first = (it.q0 >> 6) - 8; if (kt_first < 0) kt_first = 0; kt_last = (it.q0 + it.nqv - 1) >> 6; step = 1; }
  else if (MODE == 2) { kt_first = 0; kt_last = (it.q0 + it.nqv - 1) >> 6; step = 1; }
  else { kt_first = (it.q0 + it.nqv - 2) >> 6; kt_last = 0; step = -1; }
  f32x16 O[NDV];
#pragma unroll
  for (int b = 0; b < NDV; ++b)
#pragma unroll
    for (int i = 0; i < 16; ++i) O[b][i] = 0.f;
  float m_run = -1e30f, l_run = 0.f, R2 = 0.f; bool done = false;
  const int krow_off = qi * 128, kswz = (qi >> 1) & 7;
  const int g16 = lane >> 4, trq = (lane & 15) >> 2, trp = lane & 3;
  const int vtr_off = L_V + (4 * (g16 >> 1) + trq) * VS + (16 * (g16 & 1) + 4 * trp) * 2;

  u32x4 sk0 = {}, sk1 = {}, sk2 = {}, sk3 = {}, sv0 = {}, sv1 = {}, sv2 = {}, sv3 = {};
  load_tile<MODE>(sk0, sk1, sk2, sk3, sv0, sv1, sv2, sv3, it, QKV, kcol, vcol, kt_first, tid);
  for (int kt = kt_first;; kt += step) {
    __syncthreads();
    if (MODE == 1 && kt != kt_first) { const unsigned any = flags[0] | flags[1] | flags[2] | flags[3] | flags[4] | flags[5] | flags[6] | flags[7]; if (!any) break; }
    write_tile<MODE>(sk0, sk1, sk2, sk3, sv0, sv1, sv2, sv3, it, lds, kt, tid);
    __syncthreads();
    if (kt != kt_last) load_tile<MODE>(sk0, sk1, sk2, sk3, sv0, sv1, sv2, sv3, it, QKV, kcol, vcol, kt + step, tid);
    bool mine;
    if (MODE == 0) mine = active && kt >= cw - 8 && kt <= cw;
    else if (MODE == 2) mine = active && kt <= cw;
    else mine = active && !done && kt * 64 <= q0w + 30;
    if (mine) {
      f32x16 sA, sB;
#pragma unroll
      for (int i = 0; i < 16; ++i) { sA[i] = 0.f; sB[i] = 0.f; }
      const int kreg = (MODE == 2 && mp) ? L_K2 : L_K1;
#pragma unroll
      for (int s = 0; s < 4; ++s) { const int cs = ((2 * s + h2) ^ kswz) << 4;
        const bf16x8 ka = *(const LAS bf16x8*)(lds + kreg + krow_off + cs), kb = *(const LAS bf16x8*)(lds + kreg + 4096 + krow_off + cs);
        sA = MFMA32(ka, qf[s], sA); sB = MFMA32(kb, qf[s], sB); }
      const int kbase = kt * 64 + 4 * h2;
      if (MODE != 1) {
        bool cst; float cbias = 0.f;
        if (MODE == 0) { cst = q0w - (kt * 64 + 63) >= 128; if (cst) cbias = lut[256]; } else { cst = kt * 64 + 63 - q0w <= -127; if (cst) cbias = lut[0]; }
        if (cst) {
#pragma unroll
          for (int i = 0; i < 16; ++i) { sA[i] = sA[i] * LOG2E + cbias; sB[i] = sB[i] * LOG2E + cbias; }
        } else {
#pragma unroll
          for (int i = 0; i < 16; ++i) { const int ko = (i & 3) + 8 * (i >> 2);
            int ia, ib;
            if (MODE == 0) { const int d = (q0w + qi) - (kbase + ko); ia = d; ib = d - 32; ia = (ia < -128 ? -128 : ia > 128 ? 128 : ia) + 128; ib = (ib < -128 ? -128 : ib > 128 ? 128 : ib) + 128; }
            else { const int d = (kbase + ko) - (q0w + qi); ia = d; ib = d + 32; ia = (ia < -127 ? -127 : ia > 63 ? 63 : ia) + 127; ib = (ib < -127 ? -127 : ib > 63 ? 63 : ib) + 127; }
            sA[i] = sA[i] * LOG2E + lut[ia]; sB[i] = sB[i] * LOG2E + lut[ib]; }
        }
        float mx = sA[0];
#pragma unroll
        for (int i = 1; i < 16; ++i) mx = fmaxf(mx, sA[i]);
#pragma unroll
        for (int i = 0; i < 16; ++i) mx = fmaxf(mx, sB[i]);
        mx = fmaxf(mx, __shfl_xor(mx, 32));
        const float mnew = fmaxf(m_run, mx), alpha = fast_exp2(m_run - mnew); m_run = mnew;
        float ls = 0.f;
#pragma unroll
        for (int i = 0; i < 16; ++i) { sA[i] = fast_exp2(sA[i] - mnew); sB[i] = fast_exp2(sB[i] - mnew); ls += sA[i] + sB[i]; }
        l_run = l_run * alpha + ls;
#pragma unroll
        for (int b = 0; b < NDV; ++b)
#pragma unroll
          for (int i = 0; i < 16; ++i) O[b][i] *= alpha;
      } else {
        const bool diag = kt * 64 + 63 >= q0w;
        float lkA[16], lkB[16];
#pragma unroll
        for (int i = 0; i < 16; ++i) { const int ko = (i & 3) + 8 * (i >> 2);
          { const float z2 = sA[i] * LOG2E, e = fast_exp2(-fabsf(z2)), sp = fmaxf(z2, 0.f) + fast_log2(1.0f + e); const bool ok = !diag || (kbase + ko) < (q0w + qi);
            lkA[i] = ok ? -sp : 0.f; sA[i] = ok ? z2 - sp : -1e30f; }
          { const float z2 = sB[i] * LOG2E, e = fast_exp2(-fabsf(z2)), sp = fmaxf(z2, 0.f) + fast_log2(1.0f + e); const bool ok = !diag || (kbase + 32 + ko) < (q0w + qi);
            lkB[i] = ok ? -sp : 0.f; sB[i] = ok ? z2 - sp : -1e30f; } }
        float gs[8], pg[8];
#pragma unroll
        for (int g = 0; g < 4; ++g) { gs[g] = (lkA[4 * g] + lkA[4 * g + 1]) + (lkA[4 * g + 2] + lkA[4 * g + 3]); gs[4 + g] = (lkB[4 * g] + lkB[4 * g + 1]) + (lkB[4 * g + 2] + lkB[4 * g + 3]); }
#pragma unroll
        for (int g = 0; g < 8; ++g) pg[g] = __shfl_xor(gs[g], 32);
        float suf = R2;
#pragma unroll
        for (int g = 7; g >= 0; --g) { const float off = suf + (h2 == 0 ? pg[g] : 0.f);
          if (g >= 4) { const int b = 4 * (g - 4); float a3 = off, a2 = a3 + lkB[b + 3], a1 = a2 + lkB[b + 2], a0 = a1 + lkB[b + 1];
            sB[b + 3] = fast_exp2(sB[b + 3] + a3); sB[b + 2] = fast_exp2(sB[b + 2] + a2); sB[b + 1] = fast_exp2(sB[b + 1] + a1); sB[b] = fast_exp2(sB[b] + a0); }
          else { const int b = 4 * g; float a3 = off, a2 = a3 + lkA[b + 3], a1 = a2 + lkA[b + 2], a0 = a1 + lkA[b + 1];
            sA[b + 3] = fast_exp2(sA[b + 3] + a3); sA[b + 2] = fast_exp2(sA[b + 2] + a2); sA[b + 1] = fast_exp2(sA[b + 1] + a1); sA[b] = fast_exp2(sA[b] + a0); }
          suf += gs[g] + pg[g]; }
        R2 = suf;
        done = __all(R2 < STICK_DONE2) != 0;
      }
#pragma unroll
      for (int s = 0; s < 4; ++s) { const bf16x8 pf = s < 2 ? pack_p(sA, s) : pack_p(sB, s - 2);
#pragma unroll
        for (int b = 0; b < NDV; ++b) { const int a0 = vtr_off + 16 * s * VS + 64 * b;
          const s16x4 lo = __builtin_amdgcn_ds_read_tr16_b64_v4i16((LAS s16x4*)(lds + a0)), hi = __builtin_amdgcn_ds_read_tr16_b64_v4i16((LAS s16x4*)(lds + a0 + 8 * VS));
          const bf16x8 vf = __builtin_shufflevector(lo, hi, 0, 1, 2, 3, 4, 5, 6, 7);
          O[b] = MFMA32(vf, pf, O[b]); } }
    }
    if (MODE == 1) { if (lane == 0) flags[wave] = (active && !done && kt > 0 && (kt - 1) * 64 <= q0w + 30) ? 1u : 0u; }
    if (kt == kt_last) break;
  }
  bf16_t* Ob = (bf16_t*)(p.ws + WS_O);
  const int ocol = MODE == 0 ? hb : MODE == 1 ? 512 + hb : 1024 + hb;
  if (MODE != 2) {
    if (active) { float sc = 1.f; if (MODE == 0) { const float lt = l_run + __shfl_xor(l_run, 32); sc = fast_rcp(lt); }
      bf16_t* op = Ob + (size_t)(it.tok0 + q0w + qi - it.past) * OW + ocol + 4 * h2;
#pragma unroll
      for (int b = 0; b < NDV; ++b)
#pragma unroll
        for (int g = 0; g < 4; ++g) { const f32x4 v = {O[b][4 * g] * sc, O[b][4 * g + 1] * sc, O[b][4 * g + 2] * sc, O[b][4 * g + 3] * sc}; *(u32x2*)(op + 32 * b + 8 * g) = pack4(v); } }
    __syncthreads();
  } else {
    const float lam = ((const float*)(p.ws + WS_CTL))[CW_LAM + layer];
    const float sub_scale = 1.0f - (0.8f - 0.6f * expf(-0.3f * (float)layer));
    LAS float* xch = (LAS float*)(lds + L_XCH);
    __syncthreads();
    if (active && mp == 1) { const float lt = l_run + __shfl_xor(l_run, 32), sc = lam * fast_rcp(lt);
#pragma unroll
      for (int b = 0; b < NDV; ++b)
#pragma unroll
        for (int i = 0; i < 16; ++i) xch[((wave & 3) * 64 + b * 16 + i) * 64 + lane] = O[b][i] * sc; }
    __syncthreads();
    if (active && mp == 0) { const float lt = l_run + __shfl_xor(l_run, 32), sc = fast_rcp(lt); float q = 0.f;
#pragma unroll
      for (int b = 0; b < NDV; ++b)
#pragma unroll
        for (int i = 0; i < 16; ++i) { const float o = O[b][i] * sc - xch[((wave & 3) * 64 + b * 16 + i) * 64 + lane]; O[b][i] = o; q += o * o; }
      q += __shfl_xor(q, 32);
      const float rstd = __builtin_amdgcn_rsqf(q * (1.0f / 128.0f) + EPS) * sub_scale;
      const float* gain = p.c_subln + layer * 128 + 4 * h2;
      bf16_t* op = Ob + (size_t)(it.tok0 + q0w + qi - it.past) * OW + ocol + 4 * h2;
#pragma unroll
      for (int b = 0; b < NDV; ++b)
#pragma unroll
        for (int g = 0; g < 4; ++g) { const f32x4 gn = *(const f32x4*)(gain + 32 * b + 8 * g);
          const f32x4 v = {O[b][4 * g] * rstd * gn[0], O[b][4 * g + 1] * rstd * gn[1], O[b][4 * g + 2] * rstd * gn[2], O[b][4 * g + 3] * rstd * gn[3]}; *(u32x2*)(op + 32 * b + 8 * g) = pack4(v); } }
    __syncthreads();
  }
}

DI void attn_phase(const Params& p, int qidx, LAS unsigned char* lds) {
  const int layer = qidx & 1;
  unsigned* head = (unsigned*)(p.ws + WS_CTL) + CW_QUEUE + 64 * qidx;
  LAS unsigned* slot = (LAS unsigned*)(lds + L_FLAGS + 64);
  for (;;) {
    if (threadIdx.x == 0) slot[0] = atomicAdd(head, 1u);
    __syncthreads();
    const int idx = (int)slot[0];
    __syncthreads();
    if (idx >= NITEMS) break;
    const Item it = decode(p, layer, idx);
    if (it.mode == 0) run_item<0>(p, layer, it, lds); else if (it.mode == 1) run_item<1>(p, layer, it, lds); else run_item<2>(p, layer, it, lds);
  }
}
}
#define XB_TMO      128
#define XB_XCNT(j)  (256  + 64 * (j))
#define XB_XSUB(j)  (1280 + 64 * (j))
#define XB_XGEN(j)  (2304 + 64 * (j))
#define XB_TOP      3328
#define XB_TOPGEN   3392
#define XCD_BAR_WORDS 3456
#define XB_SPIN_CAP (1u << 18)
DI unsigned xb_ld(unsigned* p)              { return __hip_atomic_load(p, __ATOMIC_RELAXED, __HIP_MEMORY_SCOPE_AGENT); }
DI unsigned xb_add(unsigned* p, unsigned v) { return __hip_atomic_fetch_add(p, v, __ATOMIC_RELAXED, __HIP_MEMORY_SCOPE_AGENT); }
DI unsigned xb_xcc_id() { return (unsigned)__builtin_amdgcn_s_getreg((3 << 11) | 20) & 0xFu; }
#define XB_SPIN(cond, bar) do { unsigned _sp = 0; while (cond) { __builtin_amdgcn_s_sleep(1); \
    if ((++_sp & 255u) == 0u) { if (xb_ld(&(bar)[XB_TMO])) break; if (_sp > XB_SPIN_CAP) { atomicAdd(&(bar)[XB_TMO], 1u); break; } } } } while (0)
struct XcdBarrier { unsigned* bar; unsigned x; volatile LAS unsigned* st; };
DI XcdBarrier xcd_barrier_post(unsigned* bar, volatile LAS unsigned* st) {
  XcdBarrier b; b.bar = bar; b.x = xb_xcc_id(); b.st = st;
  if (threadIdx.x == 0) (void)xb_add(&bar[XB_XCNT(b.x)], 1u);
  return b;
}
DI void xcd_barrier_complete(unsigned* bar, unsigned x, unsigned& nloc, unsigned& nx) {
  const unsigned G = gridDim.x * gridDim.y * gridDim.z;
  unsigned sum, cnt, mine, sp = 0u;
  for (;;) {
    sum = 0u; cnt = 0u; mine = 0u;
#pragma unroll
    for (unsigned j = 0; j < 16; ++j) { const unsigned c = xb_ld(&bar[XB_XCNT(j)]); sum += c; cnt += (c > 0u) ? 1u : 0u; mine = (j == x) ? c : mine; }
    if (sum == G) break;
    __builtin_amdgcn_s_sleep(1);
    if ((++sp & 255u) == 0u) { if (xb_ld(&bar[XB_TMO])) break; if (sp > XB_SPIN_CAP) { atomicAdd(&bar[XB_TMO], 1u); break; } }
  }
  nloc = mine > 0u ? mine : 1u; nx = cnt > 0u ? cnt : 1u;
}
DI void xcd_barrier(const XcdBarrier& b) {
  asm volatile("s_waitcnt vmcnt(0)" ::: "memory");
  __syncthreads();
  if (threadIdx.x == 0) {
    unsigned* bar = b.bar;
    __builtin_amdgcn_s_waitcnt(0);
    unsigned nloc = b.st[0], nx = b.st[1];
    if (nloc == 0u) { xcd_barrier_complete(bar, b.x, nloc, nx); b.st[0] = nloc; b.st[1] = nx; }
    const unsigned old = xb_add(&bar[XB_XSUB(b.x)], 1u);
    const unsigned gen = old / nloc;
    if (old + 1u == (gen + 1u) * nloc) {
      __builtin_amdgcn_fence(__ATOMIC_RELEASE, "agent");
      asm volatile("s_waitcnt vmcnt(0)" ::: "memory");
      const unsigned og = xb_add(&bar[XB_TOP], 1u);
      const unsigned tg = og / nx;
      if (og + 1u == (tg + 1u) * nx) xb_add(&bar[XB_TOPGEN], 1u);
      else XB_SPIN(xb_ld(&bar[XB_TOPGEN]) == tg, bar);
      __builtin_amdgcn_fence(__ATOMIC_ACQUIRE, "agent");
      xb_add(&bar[XB_XGEN(b.x)], 1u);
      asm volatile("s_waitcnt vmcnt(0)" ::: "memory");
    } else {
      XB_SPIN(xb_ld(&bar[XB_XGEN(b.x)]) == gen, bar);
      __builtin_amdgcn_fence(__ATOMIC_ACQUIRE, "agent");
      asm volatile("s_waitcnt vmcnt(0)" ::: "memory");
    }
  }
  __syncthreads();
}
constexpr int L_BARST = LDS_BYTES - 64;

#ifndef PROBE_MASK
#define PROBE_MASK 0
#endif
#define REPEAT(k) for (int rep_ = 0; rep_ < (((PROBE_MASK >> (k)) & 1) ? 2 : 1); ++rep_)
constexpr int NPHASE = 2 + 7 * NLAYER;
__global__ void __launch_bounds__(NTHREADS, 2) fwd_megakernel(Params p) {
  extern __shared__ __attribute__((aligned(16))) unsigned char lds_raw[];
  LAS unsigned char* lds = (LAS unsigned char*)lds_raw;
  cg::grid_group grid = cg::this_grid();
  const int lo = p.ph_lo, hi = p.ph_hi;
#define IN(k) (lo <= (k) && (k) < hi)
#define SEAM(k) do { if (IN(k) && IN((k) + 1)) xcd_barrier(bar); } while (0)
  unsigned char* ws = p.ws;
  const int G = gridDim.x, c = blockIdx.x;
  if (threadIdx.x < 2) ((LAS unsigned*)(lds + L_BARST))[threadIdx.x] = 0u;
  if (IN(0)) { p0_prologue(p, lds); }
  XcdBarrier bar; bar.bar = (unsigned*)(ws + WS_CTL) + CW_BAR; bar.x = 0; bar.st = (volatile LAS unsigned*)(lds + L_BARST);
  if (IN(0) && IN(1)) { grid.sync(); bar = xcd_barrier_post((unsigned*)(ws + WS_CTL) + CW_BAR, (volatile LAS unsigned*)(lds + L_BARST)); }
  for (int l = 0; l < NLAYER; ++l) {
    const int pb = 1 + 7 * l;
    if (IN(pb + 0)) REPEAT(0) {
      pg8::GemmDesc g{(const char*)(ws + WS_XB), (const char*)(ws + WS_WIN) + (size_t)l * INC * D * 2, D, D, D / 64, (size_t)256 * D * 2, (size_t)128 * D * 2};
      pg8::StaticOrder S; S.init(TOK / 256, INC / 256, G, c);
      EpiP1 E{(const float*)(ws + WS_SS), (bf16_t*)(ws + WS_QKV), (bf16_t*)(ws + WS_GATE), p.b_gate + (size_t)l * 3 * D, p.out, l};
      pg8::gemm_phase<EpiP1>(lds, g, S, E);
    }
    SEAM(pb + 0);
    if (IN(pb + 1)) REPEAT(1) { attn::attn_phase(p, l + 2 * rep_, lds); }
    SEAM(pb + 1);
    if (IN(pb + 2)) REPEAT(2) {
      pg8::GemmDesc g{(const char*)(ws + WS_O), (const char*)(ws + WS_WBR) + (size_t)l * D * OW * 2, OW, OW, OW / 64, (size_t)256 * OW * 2, (size_t)128 * OW * 2};
      pg8::StaticOrder S; S.init(TOK / 256, D / 256, G, c);
      EpiP3 E{(const bf16_t*)(ws + WS_GATE), (bf16_t*)(ws + WS_H)};
      pg8::gemm_phase<EpiP3>(lds, g, S, E);
    }
    SEAM(pb + 2);
    if (IN(pb + 3)) {
      pg8::GemmDesc g{(const char*)(ws + WS_H), (const char*)(ws + WS_WOUT) + (size_t)l * D * D * 2, D, D, D / 64, (size_t)256 * D * 2, (size_t)128 * D * 2};
      pg8::StaticOrder S; S.init(TOK / 256, D / 256, G, c);
      EpiRes E{(float*)(ws + WS_X32), (bf16_t*)(ws + WS_XB), (float*)(ws + WS_SS)};
      pg8::gemm_phase<EpiRes>(lds, g, S, E);
    }
    SEAM(pb + 3);
    if (IN(pb + 4)) REPEAT(4) {
      pg8::GemmDesc g{(const char*)(ws + WS_XB), (const char*)(ws + WS_WUP) + (size_t)l * 2 * DFF * D * 2, D, D, D / 64, (size_t)128 * D * 2, (size_t)DFF * D * 2};
      pg8::StaticOrder S; S.init(TOK / 256, DFF / 128, G, c);
      EpiP5 E{(const float*)(ws + WS_SS), (bf16_t*)(ws + WS_GU), p.out, l};
      pg8::gemm_phase<EpiP5>(lds, g, S, E);
    }
    SEAM(pb + 4);
    if (IN(pb + 5)) REPEAT(5) { p5b_ffn_act(p, l); }
    SEAM(pb + 5);
    if (IN(pb + 6)) {
      pg8::GemmDesc g{(const char*)(ws + WS_HF), (const char*)(ws + WS_WDN) + (size_t)l * D * DFF * 2, DFF, DFF, DFF / 64, (size_t)256 * DFF * 2, (size_t)128 * DFF * 2};
      pg8::StaticOrder S; S.init(TOK / 256, D / 256, G, c);
      EpiRes E{(float*)(ws + WS_X32), (bf16_t*)(ws + WS_XB), (float*)(ws + WS_SS)};
      pg8::gemm_phase<EpiRes>(lds, g, S, E);
    }
    SEAM(pb + 6);
  }
  if (IN(NPHASE - 1)) { pfinal_norm(p); }
#undef IN
#undef SEAM
}

#ifndef MK_ONE_LAUNCH
#define MK_ONE_LAUNCH 1
#endif
extern "C" void kernel_launch(void* const* d_in, const int* in_sizes, int n_in, void* d_out, int out_size, void* d_ws, size_t ws_size, hipStream_t stream) {
  static int grid_blocks = 0;
  if (grid_blocks == 0) {
    int dev = 0, cus = 0, per_cu = 0;
    (void)hipGetDevice(&dev);
    (void)hipDeviceGetAttribute(&cus, hipDeviceAttributeMultiprocessorCount, dev);
    (void)hipFuncSetAttribute((const void*)fwd_megakernel, hipFuncAttributeMaxDynamicSharedMemorySize, LDS_BYTES);
    (void)hipOccupancyMaxActiveBlocksPerMultiprocessor(&per_cu, (const void*)fwd_megakernel, NTHREADS, LDS_BYTES);
    if (per_cu < 1) { fprintf(stderr, "kernel_launch: occupancy query says %d blocks/CU\n", per_cu); per_cu = 1; }
    grid_blocks = cus * per_cu;
    if (n_in != 24 || (size_t)out_size != O_END || ws_size < WS_END) { fprintf(stderr, "kernel_launch: unexpected problem (n_in %d out %d ws %zu, need %zu)\n", n_in, out_size, ws_size, (size_t)WS_END); grid_blocks = -1; }
  }
  if (grid_blocks < 0) return;
  Params p{};
  const float** f = (const float**)&p;
  for (int i = 0; i < 24; ++i) f[i] = (const float*)d_in[i];
  p.out = (float*)d_out; p.ws = (unsigned char*)d_ws;
#if MK_ONE_LAUNCH
  p.ph_lo = 0; p.ph_hi = NPHASE;
  { void* args[] = {&p};
    hipError_t e = hipLaunchCooperativeKernel((void*)fwd_megakernel, dim3(grid_blocks), dim3(NTHREADS), args, LDS_BYTES, stream);
    if (e != hipSuccess) fprintf(stderr, "cooperative launch failed: %s (grid %d)\n", hipGetErrorString(e), grid_blocks); }
#else
  for (int k = 0; k < NPHASE; ++k) { p.ph_lo = k; p.ph_hi = k + 1; void* args[] = {&p};
    hipError_t e = hipLaunchCooperativeKernel((void*)fwd_megakernel, dim3(grid_blocks), dim3(NTHREADS), args, LDS_BYTES, stream);
    if (e != hipSuccess) { fprintf(stderr, "launch %d failed: %s (grid %d)\n", k, hipGetErrorString(e), grid_blocks); break; } }
#endif
}
```

```cpp
#include <hip/hip_runtime.h>
#include <hip/hip_cooperative_groups.h>
#include <cstdio>
#include <cstdint>
namespace cg = cooperative_groups;

#define DI __device__ __forceinline__
#define LAS __attribute__((address_space(3)))
typedef unsigned short bf16_t;
typedef short bf16x8 __attribute__((ext_vector_type(8)));
typedef short s16x4 __attribute__((ext_vector_type(4)));
typedef float f32x2 __attribute__((ext_vector_type(2)));
typedef float f32x4 __attribute__((ext_vector_type(4)));
typedef float f32x8 __attribute__((ext_vector_type(8)));
typedef float f32x16 __attribute__((ext_vector_type(16)));
typedef unsigned u32x2 __attribute__((ext_vector_type(2)));
typedef unsigned u32x4 __attribute__((ext_vector_type(4)));
typedef __bf16 bfv4 __attribute__((ext_vector_type(4)));
typedef __bf16 bfv8 __attribute__((ext_vector_type(8)));

constexpr int D = 1024, SEQ = 4096, NB = 4, TOKP = NB * SEQ, DB = 32, DSEQ = 64, TOKS = DB * DSEQ, TOK = TOKP + TOKS;
constexpr int PAST = 1024, ALEN = 512, INC = 7680, DFF = 2816, NLAYER = 2;
constexpr int QKVW = 4608, GATEW = 3072, OW = 1536;
constexpr float EPS = 1e-6f, LOG2E = 1.4426950408889634f;

constexpr size_t O_YP = 0, O_YS = O_YP + (size_t)TOKP * D, O_PAK = O_YS + (size_t)TOKS * D, O_PAV = O_PAK + (size_t)2 * 4 * 512 * 512,
                 O_PBK = O_PAV + (size_t)2 * 4 * 512 * 512, O_PBV = O_PBK + (size_t)2 * TOKP * 512, O_PCK = O_PBV + (size_t)2 * TOKP * 512,
                 O_PCV = O_PCK + (size_t)2 * TOKP * 512, O_PCONV = O_PCV + (size_t)2 * TOKP * 512, O_SAK = O_PCONV + (size_t)2 * 4 * 2 * DFF,
                 O_SAV = O_SAK + (size_t)2 * DB * 512 * 512, O_SBK = O_SAV + (size_t)2 * DB * 512 * 512, O_SBV = O_SBK + (size_t)2 * TOKS * 512,
                 O_SCK = O_SBV + (size_t)2 * TOKS * 512, O_SCV = O_SCK + (size_t)2 * TOKS * 512, O_SCONV = O_SCV + (size_t)2 * TOKS * 512,
                 O_END = O_SCONV + (size_t)2 * DB * 2 * DFF;

constexpr size_t MiB = 1u << 20;
constexpr size_t WS_CTL = 0;
constexpr size_t WS_WIN = 1 * MiB;
constexpr size_t WS_WBR = WS_WIN + (size_t)2 * INC * D * 2;
constexpr size_t WS_WOUT = WS_WBR + (size_t)2 * D * OW * 2;
constexpr size_t WS_WUP = WS_WOUT + (size_t)2 * D * D * 2;
constexpr size_t WS_WDN = WS_WUP + (size_t)2 * 2 * DFF * D * 2;
constexpr size_t WS_XB = WS_WDN + (size_t)2 * D * DFF * 2;
constexpr size_t WS_X32 = WS_XB + (size_t)TOK * D * 2;
constexpr size_t WS_SS = WS_X32 + (size_t)TOK * D * 4;
constexpr size_t WS_SIDE = WS_SS + (size_t)TOK * 4 * 4;
constexpr size_t WS_O = WS_SIDE + (size_t)3 * 72 * 2 * DFF * 4;
constexpr size_t WS_H = WS_O + (size_t)TOK * OW * 2;
constexpr size_t WS_HF = WS_H + (size_t)TOK * D * 2;
constexpr size_t WS_QKV = WS_HF + (size_t)TOK * DFF * 2;
constexpr size_t WS_GATE = WS_QKV + (size_t)TOK * QKVW * 2;
constexpr size_t WS_END = WS_GATE + (size_t)TOK * GATEW * 2;
constexpr int CW_QUEUE = 64;
constexpr int CW_LAM = 1024;
constexpr int CW_T5 = 2048;
constexpr int CW_BAR = 8192;

constexpr int LDS_BYTES = 160 * 1024;
constexpr int NTHREADS = 512;

DI u32x4 pack8(f32x4 a, f32x4 b) { f32x8 v = {a[0], a[1], a[2], a[3], b[0], b[1], b[2], b[3]}; return __builtin_bit_cast(u32x4, __builtin_convertvector(v, bfv8)); }
DI u32x2 pack4(f32x4 a) { return __builtin_bit_cast(u32x2, __builtin_convertvector(a, bfv4)); }
DI float bflo(unsigned w) { return __uint_as_float(w << 16); }
DI float bfhi(unsigned w) { return __uint_as_float(w & 0xffff0000u); }
DI float wave_sum(float v) {
#pragma unroll
  for (int o = 1; o < 64; o <<= 1) v += __shfl_xor(v, o);
  return v;
}
DI float fast_rcp(float x) { return __builtin_amdgcn_rcpf(x); }
DI float fast_exp2(float x) { return __builtin_amdgcn_exp2f(x); }
DI float fast_log2(float x) { return __builtin_amdgcn_logf(x); }

struct Params {
  const float* x_prompt; const float* x_sample;
  const float* cache_a_k; const float* cache_a_v; const float* cache_b_k; const float* cache_b_v; const float* cache_c_k; const float* cache_c_v;
  const float* state_conv; const float* norm_mix; const float* w_in; const float* b_gate; const float* a_rel_bias; const float* t5_bias;
  const float* c_lambda; const float* c_subln; const float* w_branch; const float* w_out; const float* norm_ffn; const float* w_up;
  const float* conv_w; const float* conv_b; const float* w_down; const float* norm_final;
  float* out; unsigned char* ws;
  int ph_lo, ph_hi;
};

DI void p0_transpose_item(const float* W, int N, const float* kscale, bf16_t* WT, int dst_ld, int dst_col, LAS float* scr, int item, int lane) {
  const int nblk = N / 32, kb = item / nblk, nb = item % nblk, k0 = 64 * kb, n0 = 32 * nb;
#pragma unroll 8
  for (int i = 0; i < 32; ++i) { const int kk = 2 * i + (lane >> 5); float v = W[(size_t)(k0 + kk) * N + n0 + (lane & 31)]; if (kscale) v *= kscale[k0 + kk]; scr[kk * 33 + (lane & 31)] = v; }
  asm volatile("s_waitcnt lgkmcnt(0)" ::: "memory");
  const int c = lane & 7;
#pragma unroll
  for (int j = 0; j < 4; ++j) { const int n = (lane >> 3) + 8 * j; const LAS float* s = scr + (8 * c) * 33 + n;
    f32x4 a = {s[0 * 33], s[1 * 33], s[2 * 33], s[3 * 33]}, b = {s[4 * 33], s[5 * 33], s[6 * 33], s[7 * 33]};
    *(u32x4*)(WT + (size_t)(n0 + n) * dst_ld + dst_col + k0 + 8 * c) = pack8(a, b); }
  asm volatile("s_waitcnt lgkmcnt(0)" ::: "memory");
}

DI int t5_bucket_of(int rel) {
  const int n = rel < 0 ? -rel : rel; int f;
  if (n < 8) f = n; else if (n < 12) f = 8; else if (n < 16) f = 9; else if (n < 23) f = 10; else if (n < 32) f = 11; else if (n < 46) f = 12; else if (n < 64) f = 13; else if (n < 91) f = 14; else f = 15;
  return (rel > 0 ? 16 : 0) + f;
}

DI void p0_prologue(const Params& p, LAS unsigned char* lds) {
  int tid_ = threadIdx.x; asm volatile("" : "+v"(tid_));
  const int tid = tid_, lane = tid & 63, wave = tid >> 6;
  const int gw = blockIdx.x * 8 + wave, NGW = gridDim.x * 8;
  unsigned* ctl = (unsigned*)(p.ws + WS_CTL);
  if (blockIdx.x == 0) {
    if (tid < 4) ctl[CW_QUEUE + 64 * tid] = 0u;
    for (int i = tid; i < 3456; i += NTHREADS) ctl[CW_BAR + i] = 0u;
    if (wave == 1) {
      for (int l = 0; l < NLAYER; ++l) { const float* lp = p.c_lambda + l * 256; const float a = wave_sum(lp[lane] * lp[64 + lane]), b = wave_sum(lp[128 + lane] * lp[192 + lane]);
        const float lam_init = 0.8f - 0.6f * expf(-0.3f * (float)l);
        if (lane == 0) ((float*)ctl)[CW_LAM + l] = expf(a) - expf(b) + lam_init; }
    }
    for (int i = tid; i < 4 * 192; i += NTHREADS) { const int h = i / 192, idx = i % 192; int rel = idx - 127; if (rel > 63) rel = 63;
      ((float*)ctl)[CW_T5 + i] = p.t5_bias[t5_bucket_of(rel) * 4 + h] * LOG2E; }
  }
  LAS float* scr = (LAS float*)(lds + wave * 8448);
  constexpr int I_IN = (D / 64) * (INC / 32), I_BR = (512 / 64) * (D / 32), I_OUT = (D / 64) * (D / 32), I_UP = (D / 64) * (2 * DFF / 32), I_DN = (DFF / 64) * (D / 32);
  constexpr int PER_LAYER = I_IN + 3 * I_BR + I_OUT + I_UP + I_DN;
  for (int it = gw; it < NLAYER * PER_LAYER; it += NGW) {
    const int l = it / PER_LAYER; int r = it % PER_LAYER;
    if (r < I_IN) { p0_transpose_item(p.w_in + (size_t)l * D * INC, INC, p.norm_mix + l * D, (bf16_t*)(p.ws + WS_WIN) + (size_t)l * INC * D, D, 0, scr, r, lane); continue; } r -= I_IN;
    if (r < 3 * I_BR) { const int n = r / I_BR; p0_transpose_item(p.w_branch + ((size_t)l * 3 + n) * 512 * D, D, nullptr, (bf16_t*)(p.ws + WS_WBR) + (size_t)l * D * OW, OW, 512 * n, scr, r % I_BR, lane); continue; } r -= 3 * I_BR;
    if (r < I_OUT) { p0_transpose_item(p.w_out + (size_t)l * D * D, D, nullptr, (bf16_t*)(p.ws + WS_WOUT) + (size_t)l * D * D, D, 0, scr, r, lane); continue; } r -= I_OUT;
    if (r < I_UP) { p0_transpose_item(p.w_up + (size_t)l * D * 2 * DFF, 2 * DFF, p.norm_ffn + l * D, (bf16_t*)(p.ws + WS_WUP) + (size_t)l * 2 * DFF * D, D, 0, scr, r, lane); continue; } r -= I_UP;
    p0_transpose_item(p.w_down + (size_t)l * DFF * D, D, nullptr, (bf16_t*)(p.ws + WS_WDN) + (size_t)l * D * DFF, DFF, 0, scr, r, lane);
  }
  float* X32 = (float*)(p.ws + WS_X32); bf16_t* XB = (bf16_t*)(p.ws + WS_XB); float* SS = (float*)(p.ws + WS_SS);
  for (int m = gw; m < TOK; m += NGW) {
    const float* src = m < TOKP ? p.x_prompt + (size_t)m * D : p.x_sample + (size_t)(m - TOKP) * D;
    float s = 0.f;
#pragma unroll
    for (int j = 0; j < 4; ++j) { const f32x4 v = ((const f32x4*)src)[lane + 64 * j]; ((f32x4*)(X32 + (size_t)m * D))[lane + 64 * j] = v; ((u32x2*)(XB + (size_t)m * D))[lane + 64 * j] = pack4(v);
      s += (v[0] * v[0] + v[1] * v[1]) + (v[2] * v[2] + v[3] * v[3]); }
    s = wave_sum(s);
    if (lane < 4) SS[(size_t)m * 4 + lane] = lane == 0 ? s : 0.f;
  }
  { const size_t gt = (size_t)blockIdx.x * NTHREADS + tid, gs = (size_t)gridDim.x * NTHREADS; constexpr size_t PER = (size_t)448 * 128, TOT = (size_t)NLAYER * DB * PER;
    for (size_t i = gt; i < 2 * TOT; i += gs) { const int which = i >= TOT; const size_t j = which ? i - TOT : i; const size_t lb = j / PER, rem = j % PER;
      const f32x4* src = (const f32x4*)((which ? p.cache_a_v : p.cache_a_k) + lb * 512 * 512 + 64 * 512) + rem;
      f32x4* dst = (f32x4*)(p.out + (which ? O_SAV : O_SAK) + lb * 512 * 512) + rem; *dst = *src; } }
}

namespace pg8 {
constexpr int BM = 256, BK = 64, HALF = 128, HTB = HALF * BK * 2, STAGE_BYTES = 8 * HTB, NXCD = 8, WGM = 8;
DI int lds_byte(int r, int c) { const int st = (r >> 4) * 2 + (c >> 5), rr = r & 15, cc = c & 31, ob = rr * 64 + cc * 2; return st * 1024 + (ob ^ (((ob >> 9) & 1) << 5)); }
DI void stage_rc(int b, int& R, int& C) { const int st = b / 1024, sb = b % 1024, swz = sb ^ (((sb >> 9) & 1) << 5); R = (st >> 1) * 16 + swz / 64; C = (st & 1) * 32 + (swz % 64) / 2; }
DI int perm32(int rho) { const int n = rho >> 4, i = rho & 15; return 8 * (i >> 2) + 4 * n + (i & 3); }
struct Unit { int pm, pn; };
struct GemmDesc { const char* A; const char* B; int lda, ldb, nt; size_t b_tile, b_half; };
struct StaticOrder {
  int nM, nN, nwg, G, c;
  DI void init(int nM_, int nN_, int G_, int c_) { nM = nM_; nN = nN_; nwg = nM * nN; G = G_; c = c_; }
  DI bool next(int i, Unit& u) const {
    const long L = (long)i * G + c; if (L >= nwg) return false;
    int wgid = (int)L; { const int q = nwg / NXCD, r = nwg % NXCD, xcd = wgid % NXCD, off = wgid / NXCD; wgid = (xcd < r ? xcd * (q + 1) : r * (q + 1) + (xcd - r) * q) + off; }
    const int nig = WGM * nN, gid = wgid / nig, fm = gid * WGM, gsz = (nM - fm) < WGM ? (nM - fm) : WGM;
    u.pm = fm + ((wgid % nig) % gsz); u.pn = (wgid % nig) / gsz; return true;
  }
};
template <class Epi>
DI void gemm_phase(LAS unsigned char* lds, const GemmDesc g, const StaticOrder& S, const Epi& E) {
  int tid_ = threadIdx.x; asm volatile("" : "+v"(tid_));
  const int tid = tid_, wid = __builtin_amdgcn_readfirstlane(tid >> 6), lane = tid & 63, wr = wid >> 2, wc = wid & 3, fr = lane & 15, fq = lane >> 4;
  const int nt = g.nt;
  unsigned voffA[2], voffB[2];
#pragma unroll
  for (int i = 0; i < 2; ++i) { int R, C; stage_rc(tid * 16 + i * 8192, R, C); const int Rb = Epi::PERM ? ((R & ~31) + perm32(R & 31)) : R;
    voffA[i] = (unsigned)(R * g.lda + C) * 2u; voffB[i] = (unsigned)(Rb * g.ldb + C) * 2u; }
  const size_t kstep = (size_t)(BK * 2);
  const size_t hsA = (size_t)HALF * g.lda * 2, tsA = 2 * hsA, hsB = g.b_half, tsB = g.b_tile;
  const unsigned ldsw = (unsigned)wid * 1024u;
  const int aoff = lds_byte(wr * 64 + fr, fq * 8), boff = lds_byte(wc * 32 + fr, fq * 8);
#define PG8_SA(b, h) (((b) * 2 + (h)) * HTB)
#define PG8_SB(b, h) ((4 + (b) * 2 + (h)) * HTB)
#define PG8_STAGE(bufoff, gbase, voff) do { _Pragma("unroll") for (int _i = 0; _i < 2; ++_i) \
    __builtin_amdgcn_global_load_lds((const unsigned*)((const char*)(gbase) + (voff)[_i]), (LAS unsigned*)(lds + (bufoff) + ldsw + _i * 8192), 16, 0, 0); } while (0)
#define PG8_LDA(dst, b, h) do { _Pragma("unroll") for (int m = 0; m < 4; ++m) _Pragma("unroll") for (int k = 0; k < 2; ++k) dst[m][k] = *(const LAS bf16x8*)(lds + PG8_SA(b, h) + aoff + m * 2048 + k * 1024); } while (0)
#define PG8_LDB(dst, b, h) do { _Pragma("unroll") for (int n = 0; n < 2; ++n) _Pragma("unroll") for (int k = 0; k < 2; ++k) dst[n][k] = *(const LAS bf16x8*)(lds + PG8_SB(b, h) + boff + n * 2048 + k * 1024); } while (0)
#define PG8_MMA(ai, bj, At, Bt) do { __builtin_amdgcn_s_setprio(1); _Pragma("unroll") for (int m = 0; m < 4; ++m) _Pragma("unroll") for (int n = 0; n < 2; ++n) _Pragma("unroll") for (int k = 0; k < 2; ++k) \
    acc[ai][bj][m][n] = __builtin_amdgcn_mfma_f32_16x16x32_bf16(Bt[n][k], At[m][k], acc[ai][bj][m][n], 0, 0, 0); __builtin_amdgcn_s_setprio(0); } while (0)
#define PG8_WAIT_V(n) asm volatile("s_waitcnt vmcnt(" #n ")" ::: "memory")
#define PG8_WAIT_L(n) asm volatile("s_waitcnt lgkmcnt(" #n ")" ::: "memory")
#define PG8_BAR __builtin_amdgcn_s_barrier()
#define PG8_SCHED __builtin_amdgcn_sched_barrier(0)
  Unit cur, nxt; int ui = 0;
  if (!S.next(0, cur)) return;
  f32x4 acc[2][2][4][2];
#pragma unroll
  for (int a = 0; a < 2; ++a)
#pragma unroll
    for (int b = 0; b < 2; ++b)
#pragma unroll
      for (int m = 0; m < 4; ++m)
#pragma unroll
        for (int n = 0; n < 2; ++n) acc[a][b][m][n] = (f32x4){0.f, 0.f, 0.f, 0.f};
  bf16x8 At[4][2], B0[2][2], B1[2][2];
  const char* cA = g.A + (size_t)cur.pm * tsA; const char* cB = g.B + (size_t)cur.pn * tsB;
  PG8_STAGE(PG8_SB(0, 0), cB, voffB); PG8_STAGE(PG8_SB(0, 1), cB + hsB, voffB); PG8_STAGE(PG8_SA(0, 0), cA, voffA); PG8_STAGE(PG8_SA(0, 1), cA + hsA, voffA);
  if (wr == 1) PG8_BAR;
  PG8_WAIT_V(2); PG8_BAR;
  PG8_STAGE(PG8_SB(1, 0), cB + kstep, voffB); PG8_STAGE(PG8_SA(1, 0), cA + kstep, voffA); PG8_STAGE(PG8_SB(1, 1), cB + hsB + kstep, voffB);
  PG8_WAIT_V(6); PG8_BAR;
  for (;;) {
    const bool has_next = S.next(ui + 1, nxt);
    const char* nA = has_next ? g.A + (size_t)nxt.pm * tsA : cA; const char* nB = has_next ? g.B + (size_t)nxt.pn * tsB : cB;
    for (int t = 0; t < nt; t += 2) {
      const bool last = (t == nt - 2);
      const char* a1 = cA + (size_t)(t + 1) * kstep;
      const char* a2 = last ? nA : cA + (size_t)(t + 2) * kstep; const char* b2 = last ? nB : cB + (size_t)(t + 2) * kstep;
      const char* a3 = a2 + kstep; const char* b3 = b2 + kstep;
      if constexpr (Epi::HAS_MID) { if (t == 8 || t == 16) E.mid(acc, cur, t, wr, wc, fr, fq); }
      PG8_LDB(B0, 0, 0); PG8_LDB(B1, 0, 1); PG8_SCHED; PG8_LDA(At, 0, 0); PG8_STAGE(PG8_SA(1, 1), a1 + hsA, voffA);
      PG8_WAIT_V(8); PG8_WAIT_L(0); PG8_BAR; PG8_MMA(0, 0, At, B0); PG8_MMA(0, 1, At, B1); PG8_BAR; PG8_SCHED;
      PG8_LDA(At, 0, 1); PG8_STAGE(PG8_SB(0, 0), b2, voffB); PG8_STAGE(PG8_SB(0, 1), b2 + hsB, voffB); PG8_STAGE(PG8_SA(0, 0), a2, voffA);
      PG8_WAIT_V(8); PG8_WAIT_L(0); PG8_BAR; PG8_MMA(1, 0, At, B0); PG8_MMA(1, 1, At, B1); PG8_BAR; PG8_SCHED;
      PG8_LDB(B0, 1, 0); PG8_LDB(B1, 1, 1); PG8_SCHED; PG8_LDA(At, 1, 0); PG8_STAGE(PG8_SA(0, 1), a2 + hsA, voffA);
      PG8_WAIT_V(8); PG8_WAIT_L(0); PG8_BAR; PG8_MMA(0, 0, At, B0); PG8_MMA(0, 1, At, B1); PG8_BAR; PG8_SCHED;
      PG8_LDA(At, 1, 1); PG8_STAGE(PG8_SB(1, 0), b3, voffB); PG8_STAGE(PG8_SB(1, 1), b3 + hsB, voffB); PG8_STAGE(PG8_SA(1, 0), a3, voffA);
      PG8_WAIT_V(8); PG8_WAIT_L(0); PG8_BAR; PG8_MMA(1, 0, At, B0); PG8_MMA(1, 1, At, B1); PG8_BAR; PG8_SCHED;
    }
    if (wr == 0) PG8_BAR;
    E(acc, cur, wr, wc, fr, fq);
    if (!has_next) break;
#pragma unroll
    for (int a = 0; a < 2; ++a)
#pragma unroll
      for (int b = 0; b < 2; ++b)
#pragma unroll
        for (int m = 0; m < 4; ++m)
#pragma unroll
          for (int n = 0; n < 2; ++n) acc[a][b][m][n] = (f32x4){0.f, 0.f, 0.f, 0.f};
    cur = nxt; cA = nA; cB = nB; ++ui;
    if (wr == 1) PG8_BAR;
  }
  PG8_WAIT_V(0);
  PG8_BAR;
#undef PG8_SA
#undef PG8_SB
#undef PG8_STAGE
#undef PG8_LDA
#undef PG8_LDB
#undef PG8_MMA
#undef PG8_WAIT_V
#undef PG8_WAIT_L
#undef PG8_BAR
#undef PG8_SCHED
}
}
using pg8::Unit;
DI float row_rs(const float* SS, int r) {
  const f32x4 a = *(const f32x4*)(SS + (size_t)r * 4);
  return __builtin_amdgcn_rsqf(((a[0] + a[1]) + (a[2] + a[3])) * (1.0f / D) + EPS);
}
DI float sigmoidf_(float x) { return fast_rcp(1.0f + fast_exp2(-x * LOG2E)); }

struct EpiP1 {
  static constexpr bool PERM = true, HAS_MID = false;
  const float* SS; bf16_t* QKV; bf16_t* GATE; const float* bgate; float* out; int layer;
  DI void mid(f32x4 (&)[2][2][4][2], const Unit&, int, int, int, int, int) const {}
  DI void operator()(f32x4 (&acc)[2][2][4][2], const Unit& u, int wr, int wc, int fr, int fq) const {
    const int pn = u.pn, rin0 = wr * 64 + fr, row0 = u.pm * 256 + rin0;
    float rs[2][4];
#pragma unroll
    for (int ai = 0; ai < 2; ++ai)
#pragma unroll
      for (int m = 0; m < 4; ++m) rs[ai][m] = row_rs(SS, row0 + ai * 128 + m * 16);
    if (pn < 18) {
      const int colq = pn * 256 + wc * 32 + 8 * fq;
      const int kind = (pn >> 1) % 3, br = pn / 6, tcol = (pn & 1) * 256 + wc * 32 + 8 * fq;
      float* sbase = nullptr; size_t srow_stride = 512; int rowshift = 0; bool prompt = u.pm < 64; bool do_state = kind != 0;
      int b = 0, t0 = 0;
      if (do_state) {
        const bool isv = kind == 2;
        if (prompt) { b = u.pm >> 4; t0 = (u.pm & 15) * 256;
          if (br == 0) { if ((u.pm & 15) < 14) do_state = false; else { sbase = out + (isv ? O_PAV : O_PAK) + (size_t)(layer * 4 + b) * 512 * 512; rowshift = t0 - 3584; } }
          else { sbase = out + (br == 1 ? (isv ? O_PBV : O_PBK) : (isv ? O_PCV : O_PCK)) + (size_t)(layer * 4 + b) * SEQ * 512; rowshift = t0; }
        }
      }
#pragma unroll
      for (int ai = 0; ai < 2; ++ai)
#pragma unroll
        for (int m = 0; m < 4; ++m) {
          const int rin = rin0 + ai * 128 + m * 16, r = u.pm * 256 + rin; const float s = rs[ai][m];
          bf16_t* rowp = QKV + (size_t)r * QKVW + colq;
          float* sp = nullptr;
          if (do_state) {
            if (prompt) sp = sbase + (size_t)(rowshift + rin) * 512 + tcol;
            else { const int sidx = (u.pm - 64) * 256 + rin, bd = sidx >> 6, t = sidx & 63; const bool isv = kind == 2;
              if (br == 0) sp = out + (isv ? O_SAV : O_SAK) + ((size_t)(layer * DB + bd) * 512 + 448 + t) * 512 + tcol;
              else sp = out + (br == 1 ? (isv ? O_SBV : O_SBK) : (isv ? O_SCV : O_SCK)) + ((size_t)(layer * DB + bd) * 64 + t) * 512 + tcol; }
          }
#pragma unroll
          for (int bj = 0; bj < 2; ++bj) { const f32x4 v0 = acc[ai][bj][m][0] * s, v1 = acc[ai][bj][m][1] * s;
            *(u32x4*)(rowp + bj * 128) = pack8(v0, v1);
            if (do_state) { *(f32x4*)(sp + bj * 128) = v0; *(f32x4*)(sp + bj * 128 + 4) = v1; } }
        }
    } else {
      const int gi = pn - 18, nb = gi >> 2, colg = (gi & 3) * 256 + wc * 32 + 8 * fq;
      f32x4 bv[2][2];
#pragma unroll
      for (int bj = 0; bj < 2; ++bj) { bv[bj][0] = *(const f32x4*)(bgate + nb * D + colg + bj * 128); bv[bj][1] = *(const f32x4*)(bgate + nb * D + colg + bj * 128 + 4); }
#pragma unroll
      for (int ai = 0; ai < 2; ++ai)
#pragma unroll
        for (int m = 0; m < 4; ++m) { const int r = row0 + ai * 128 + m * 16; const float s = rs[ai][m];
          bf16_t* rowp = GATE + (size_t)r * GATEW + gi * 256 + wc * 32 + 8 * fq;
#pragma unroll
          for (int bj = 0; bj < 2; ++bj) { f32x4 v0 = acc[ai][bj][m][0] * s + bv[bj][0], v1 = acc[ai][bj][m][1] * s + bv[bj][1];
#pragma unroll
            for (int j = 0; j < 4; ++j) { v0[j] = sigmoidf_(v0[j]); v1[j] = sigmoidf_(v1[j]); }
            *(u32x4*)(rowp + bj * 128) = pack8(v0, v1); } }
    }
  }
};

struct EpiP3 {
  static constexpr bool PERM = true, HAS_MID = true;
  const bf16_t* GATE; bf16_t* H;
  DI void mid(f32x4 (&acc)[2][2][4][2], const Unit& u, int t, int wr, int wc, int fr, int fq) const {
    const int nb = (t >> 3) - 1;
    const bf16_t* gp = GATE + (size_t)(u.pm * 256 + wr * 64 + fr) * GATEW + nb * D + u.pn * 256 + wc * 32 + 8 * fq;
#pragma unroll
    for (int ai = 0; ai < 2; ++ai)
#pragma unroll
      for (int m = 0; m < 4; ++m) {
#pragma unroll
        for (int bj = 0; bj < 2; ++bj)
#pragma unroll
          for (int n = 0; n < 2; ++n) { const bf16_t* q = gp + (size_t)(ai * 128 + m * 16) * GATEW + bj * 128 + 4 * n;
            const u32x2 ga = *(const u32x2*)q, gb = *(const u32x2*)(q + D);
            acc[ai][bj][m][n][0] *= bflo(ga[0]) * fast_rcp(bflo(gb[0])); acc[ai][bj][m][n][1] *= bfhi(ga[0]) * fast_rcp(bfhi(gb[0]));
            acc[ai][bj][m][n][2] *= bflo(ga[1]) * fast_rcp(bflo(gb[1])); acc[ai][bj][m][n][3] *= bfhi(ga[1]) * fast_rcp(bfhi(gb[1])); }
        asm volatile("" ::: "memory"); }
  }
  DI void operator()(f32x4 (&acc)[2][2][4][2], const Unit& u, int wr, int wc, int fr, int fq) const {
    const int row0 = u.pm * 256 + wr * 64 + fr, col0 = u.pn * 256 + wc * 32 + 8 * fq;
#pragma unroll
    for (int ai = 0; ai < 2; ++ai)
#pragma unroll
      for (int m = 0; m < 4; ++m) { const int r = row0 + ai * 128 + m * 16; const bf16_t* gp = GATE + (size_t)r * GATEW + 2 * D + col0; bf16_t* hp = H + (size_t)r * D + col0;
#pragma unroll
        for (int bj = 0; bj < 2; ++bj) { const u32x4 g = *(const u32x4*)(gp + bj * 128); f32x4 v0 = acc[ai][bj][m][0], v1 = acc[ai][bj][m][1];
          v0[0] *= bflo(g[0]); v0[1] *= bfhi(g[0]); v0[2] *= bflo(g[1]); v0[3] *= bfhi(g[1]); v1[0] *= bflo(g[2]); v1[1] *= bfhi(g[2]); v1[2] *= bflo(g[3]); v1[3] *= bfhi(g[3]);
          *(u32x4*)(hp + bj * 128) = pack8(v0, v1); } }
  }
};

struct EpiRes {
  static constexpr bool PERM = false, HAS_MID = false;
  float* X32; bf16_t* XB; float* SS; LAS unsigned char* lds;
  DI void mid(f32x4 (&)[2][2][4][2], const Unit&, int, int, int, int, int) const {}
  DI void operator()(f32x4 (&acc)[2][2][4][2], const Unit& u, int wr, int wc, int fr, int fq) const {
    const int rin0 = wr * 64 + fr, row0 = u.pm * 256 + rin0, col0 = u.pn * 256 + wc * 32 + 4 * fq;
    LAS float* red = (LAS float*)(lds + 131072 + 8192);
#pragma unroll
    for (int ai = 0; ai < 2; ++ai)
#pragma unroll
      for (int m = 0; m < 4; ++m) { const int r = row0 + ai * 128 + m * 16; float* xp = X32 + (size_t)r * D + col0; bf16_t* bp = XB + (size_t)r * D + col0; float q = 0.f;
#pragma unroll
        for (int bj = 0; bj < 2; ++bj)
#pragma unroll
          for (int n = 0; n < 2; ++n) { const f32x4 xo = *(const f32x4*)(xp + bj * 128 + n * 16); const f32x4 xn = xo + acc[ai][bj][m][n];
            *(f32x4*)(xp + bj * 128 + n * 16) = xn; *(u32x2*)(bp + bj * 128 + n * 16) = pack4(xn); q += (xn[0] * xn[0] + xn[1] * xn[1]) + (xn[2] * xn[2] + xn[3] * xn[3]); }
        q += __shfl_xor(q, 16); q += __shfl_xor(q, 32);
        if (fq == 0) red[(rin0 + ai * 128 + m * 16) * 4 + wc] = q; }
    asm volatile("s_waitcnt lgkmcnt(0)" ::: "memory"); __builtin_amdgcn_s_barrier(); asm volatile("" ::: "memory");
    const int t = threadIdx.x;
    if (t < 256) { const f32x4 v = *(const LAS f32x4*)(red + t * 4); SS[(size_t)(u.pm * 256 + t) * 4 + u.pn] = (v[0] + v[1]) + (v[2] + v[3]); }
  }
};

DI float dpp_ror1(float v) { return __builtin_bit_cast(float, __builtin_amdgcn_update_dpp(0, __builtin_bit_cast(int, v), 0x121, 0xf, 0xf, false)); }
DI float dpp_ror2(float v) { return __builtin_bit_cast(float, __builtin_amdgcn_update_dpp(0, __builtin_bit_cast(int, v), 0x122, 0xf, 0xf, false)); }
DI float gelu_mul(float x, float uv) {
  const float t = __builtin_fmaf(x * x, 2.0f * LOG2E * 0.7978845608028654f * 0.044715f, 2.0f * LOG2E * 0.7978845608028654f);
  const float r = fast_rcp(fast_exp2(x * t) + 1.0f);
  return __builtin_fmaf(-x, r, x) * uv;
}
constexpr size_t SIDE_ROWS = (size_t)72 * 2 * DFF;
struct EpiP5F {
  static constexpr bool PERM = true, HAS_MID = false;
  const float* SS; bf16_t* HF; float* out; const float* cw; const float* cb; const float* st; float* side; LAS unsigned char* lds; int layer;
  DI void mid(f32x4 (&)[2][2][4][2], const Unit&, int, int, int, int, int) const {}
  DI void operator()(f32x4 (&acc)[2][2][4][2], const Unit& u, int wr, int wc, int fr, int fq) const {
    const int rin0 = wr * 64 + fr, col0 = u.pn * 128 + wc * 32 + 8 * fq;
    const bool sample = u.pm >= 64, cont = !sample && (u.pm & 15) != 0;
    LAS float* xh = (LAS float*)(lds + 131072);
    float* TAILG = side; float* HEADC = side + SIDE_ROWS; float* HEADU = side + 2 * SIDE_ROWS;
#pragma unroll
    for (int ai = 0; ai < 2; ++ai)
#pragma unroll
      for (int m = 0; m < 4; ++m) { const float s = row_rs(SS, u.pm * 256 + rin0 + ai * 128 + m * 16);
#pragma unroll
        for (int n = 0; n < 2; ++n) { acc[ai][0][m][n] *= s; acc[ai][1][m][n] *= s; } }
    if (fr >= 14) {
#pragma unroll
      for (int ai = 0; ai < 2; ++ai) { const int gidx = 2 * ai + wr; LAS float* xp = xh + ((gidx * 4 + wc) * 2 + (fr - 14)) * 32 + fq * 8;
        *(LAS f32x4*)xp = acc[ai][0][3][0]; *(LAS f32x4*)(xp + 4) = acc[ai][0][3][1];
        float* cp = nullptr;
        if (sample) cp = out + O_SCONV + ((size_t)(layer * DB + (u.pm - 64) * 4 + gidx) * 2 + (fr - 14)) * DFF + col0;
        else if (gidx == 3) { float* tp = TAILG + ((size_t)u.pm * 2 + (fr - 14)) * DFF + col0; *(f32x4*)tp = acc[ai][0][3][0]; *(f32x4*)(tp + 4) = acc[ai][0][3][1];
          if ((u.pm & 15) == 15) cp = out + O_PCONV + ((size_t)(layer * 4 + (u.pm >> 4)) * 2 + (fr - 14)) * DFF + col0; }
        if (cp) { *(f32x4*)cp = acc[ai][0][3][0]; *(f32x4*)(cp + 4) = acc[ai][0][3][1]; } }
    }
    asm volatile("s_waitcnt lgkmcnt(0)" ::: "memory"); __builtin_amdgcn_s_barrier(); asm volatile("" ::: "memory");
#pragma unroll
    for (int n = 0; n < 2; ++n) {
      const f32x4 w0 = *(const f32x4*)(cw + col0 + 4 * n), w1 = *(const f32x4*)(cw + DFF + col0 + 4 * n), w2 = *(const f32x4*)(cw + 2 * DFF + col0 + 4 * n), bb = *(const f32x4*)(cb + col0 + 4 * n);
#pragma unroll
      for (int ai = 0; ai < 2; ++ai) { const int gidx = 2 * ai + wr;
        f32x4 gp = {0.f, 0.f, 0.f, 0.f};
        if (fr >= 14) {
          if (sample) gp = *(const f32x4*)(st + ((size_t)((u.pm - 64) * 4 + gidx) * 2 + (fr - 14)) * DFF + col0 + 4 * n);
          else if (gidx > 0) gp = *(const LAS f32x4*)(xh + (((gidx - 1) * 4 + wc) * 2 + (fr - 14)) * 32 + fq * 8 + 4 * n);
        }
#pragma unroll
        for (int m = 0; m < 4; ++m) { const int rin = rin0 + ai * 128 + m * 16; f32x4 o, cc;
#pragma unroll
          for (int j = 0; j < 4; ++j) { const float g = acc[ai][0][m][n][j], gq = gp[j];
            const float r1g = dpp_ror1(g), r1q = dpp_ror1(gq), r2g = dpp_ror2(g), r2q = dpp_ror2(gq);
            const float p1 = fr >= 1 ? r1g : r1q, p2 = fr >= 2 ? r2g : r2q;
            const float c = __builtin_fmaf(w2[j], g, __builtin_fmaf(w1[j], p1, __builtin_fmaf(w0[j], p2, bb[j])));
            cc[j] = c; o[j] = gelu_mul(c, acc[ai][1][m][n][j]); }
          *(u32x2*)(HF + (size_t)(u.pm * 256 + rin) * DFF + col0 + 4 * n) = pack4(o);
          if (cont && gidx == 0 && m == 0 && fr < 2) { *(f32x4*)(HEADC + ((size_t)u.pm * 2 + fr) * DFF + col0 + 4 * n) = cc; *(f32x4*)(HEADU + ((size_t)u.pm * 2 + fr) * DFF + col0 + 4 * n) = acc[ai][1][m][n]; }
          gp = acc[ai][0][m][n]; }
      }
    }
  }
};
DI void p6_fixup_panel(int pm, const float* side, const float* cw, bf16_t* HF) {
  const float* TAILG = side + (size_t)(pm - 1) * 2 * DFF; const float* HEADC = side + SIDE_ROWS + (size_t)pm * 2 * DFF; const float* HEADU = side + 2 * SIDE_ROWS + (size_t)pm * 2 * DFF;
  for (int k = threadIdx.x; k < DFF; k += NTHREADS) { const float t0 = TAILG[k], t1 = TAILG[DFF + k], a0 = cw[k], a1 = cw[DFF + k];
    const float c0 = HEADC[k] + a0 * t0 + a1 * t1, c1 = HEADC[DFF + k] + a0 * t1;
    const float h0 = gelu_mul(c0, HEADU[k]), h1 = gelu_mul(c1, HEADU[DFF + k]);
    f32x4 v = {h0, h1, 0.f, 0.f}; const u32x2 pk = pack4(v);
    HF[(size_t)(pm * 256) * DFF + k] = (bf16_t)(pk[0] & 0xffffu); HF[(size_t)(pm * 256 + 1) * DFF + k] = (bf16_t)(pk[0] >> 16); }
}

struct EpiNull {
  static constexpr bool PERM = true, HAS_MID = false;
  DI void mid(f32x4 (&)[2][2][4][2], const Unit&, int, int, int, int, int) const {}
  DI void operator()(f32x4 (&acc)[2][2][4][2], const Unit& u, int wr, int wc, int fr, int fq) const {
#pragma unroll
    for (int ai = 0; ai < 2; ++ai)
#pragma unroll
      for (int bj = 0; bj < 2; ++bj)
#pragma unroll
        for (int m = 0; m < 4; ++m)
#pragma unroll
          for (int n = 0; n < 2; ++n) asm volatile("" :: "v"(acc[ai][bj][m][n]));
  }
};

DI float gelu_tanh(float x) {
  const float y = 0.7978845608028654f * (x + 0.044715f * x * x * x);
  const float e = fast_exp2(2.0f * LOG2E * y);
  const float th = 1.0f - 2.0f * fast_rcp(e + 1.0f);
  return 0.5f * x * (1.0f + th);
}
DI void pfinal_norm(const Params& p) {
  const float* X32 = (const float*)(p.ws + WS_X32); const float* SS = (const float*)(p.ws + WS_SS);
  int tid_ = threadIdx.x; asm volatile("" : "+v"(tid_));
  const int lane = tid_ & 63, gw = blockIdx.x * 8 + (tid_ >> 6), NGW = gridDim.x * 8;
  for (int m = gw; m < TOK; m += NGW) { const float s = row_rs(SS, m);
#pragma unroll
    for (int j = 0; j < 4; ++j) { const f32x4 v = ((const f32x4*)(X32 + (size_t)m * D))[lane + 64 * j], g = ((const f32x4*)p.norm_final)[lane + 64 * j];
      ((f32x4*)(p.out + (size_t)m * D))[lane + 64 * j] = v * s * g; } }
}
namespace attn {
constexpr int L_K1 = 0, L_K2 = 8192, L_V = 16384, L_LUT = 40960, L_FLAGS = 43008, L_XCH = 49152;
constexpr int N_CS = 128, N_CP = 512, N_AP = 512, N_BP = 512, N_AS = 256, N_BS = 256, NITEMS = N_CS + N_CP + N_AP + N_BP + N_AS + N_BS;
constexpr float STICK_DONE2 = -60.0f * LOG2E;

struct Item { int mode, h, tok0, past, q0, nqv; const float* cK; const float* cV; };

DI Item decode(const Params& p, int layer, int idx) {
  Item it; it.cK = nullptr; it.cV = nullptr; it.past = 0;
  if (idx < N_CS) { const int bd = idx >> 2, h = idx & 3; it.mode = 2; it.h = h; it.tok0 = TOKP + bd * 64; it.past = PAST; it.q0 = PAST; it.nqv = 64;
    it.cK = p.cache_c_k + (size_t)(layer * DB + bd) * PAST * 512 + h * 128; it.cV = p.cache_c_v + (size_t)(layer * DB + bd) * PAST * 512 + h * 128; return it; }
  idx -= N_CS;
  if (idx < N_CP) { const int jj = 31 - (idx >> 4), rem = idx & 15; it.mode = 2; it.h = rem & 3; it.tok0 = (rem >> 2) * SEQ; it.q0 = jj * 128; it.nqv = 128; return it; }
  idx -= N_CP;
  if (idx < N_AP + N_BP) { const int isb = idx >= N_AP; if (isb) idx -= N_AP; const int qt = 15 - (idx >> 5), rem = idx & 31; it.mode = isb; it.h = rem & 7; it.tok0 = (rem >> 3) * SEQ; it.q0 = qt * 256; it.nqv = 256; return it; }
  idx -= N_AP + N_BP;
  if (idx < N_AS) { const int bd = idx >> 3, h = idx & 7; it.mode = 0; it.h = h; it.tok0 = TOKP + bd * 64; it.past = ALEN; it.q0 = ALEN; it.nqv = 64;
    it.cK = p.cache_a_k + (size_t)(layer * DB + bd) * ALEN * 512 + h * 64; it.cV = p.cache_a_v + (size_t)(layer * DB + bd) * ALEN * 512 + h * 64; return it; }
  idx -= N_AS;
  { const int bd = idx >> 3, h = idx & 7; it.mode = 1; it.h = h; it.tok0 = TOKP + bd * 64; it.past = PAST; it.q0 = PAST; it.nqv = 64;
    it.cK = p.cache_b_k + (size_t)(layer * DB + bd) * PAST * 512 + h * 64; it.cV = p.cache_b_v + (size_t)(layer * DB + bd) * PAST * 512 + h * 64; return it; }
}


template <int MODE>
DI void load_tile(u32x4& k0, u32x4& k1, u32x4& k2, u32x4& k3, u32x4& v0, u32x4& v1, u32x4& v2, u32x4& v3, const Item& it, const bf16_t* QKV, int kcol, int vcol, int kt, int tid) {
  constexpr int CPR = MODE == 2 ? 16 : 8;
  const int j0 = kt * 64;
  const int r0 = tid / CPR, c0 = tid % CPR, r1 = (tid + NTHREADS) / CPR, c1 = (tid + NTHREADS) % CPR;
  if (j0 < it.past) {
    { const u32x4* kp = (const u32x4*)(it.cK + (size_t)(j0 + r0) * 512 + c0 * 8); const u32x4* vp = (const u32x4*)(it.cV + (size_t)(j0 + r0) * 512 + c0 * 8);
      k0 = kp[0]; k1 = kp[1]; v0 = vp[0]; v1 = vp[1]; }
    if constexpr (MODE == 2) { const u32x4* kp = (const u32x4*)(it.cK + (size_t)(j0 + r1) * 512 + c1 * 8); const u32x4* vp = (const u32x4*)(it.cV + (size_t)(j0 + r1) * 512 + c1 * 8);
      k2 = kp[0]; k3 = kp[1]; v2 = vp[0]; v3 = vp[1]; }
  } else {
    { const bf16_t* base = QKV + (size_t)(it.tok0 + j0 + r0 - it.past) * QKVW + c0 * 8; k0 = *(const u32x4*)(base + kcol); v0 = *(const u32x4*)(base + vcol); }
    if constexpr (MODE == 2) { const bf16_t* base = QKV + (size_t)(it.tok0 + j0 + r1 - it.past) * QKVW + c1 * 8; k2 = *(const u32x4*)(base + kcol); v2 = *(const u32x4*)(base + vcol); }
  }
}
DI u32x4 cvt8(u32x4 a, u32x4 b) { return pack8(__builtin_bit_cast(f32x4, a), __builtin_bit_cast(f32x4, b)); }
template <int MODE>
DI void write_tile(const u32x4& k0, const u32x4& k1, const u32x4& k2, const u32x4& k3, const u32x4& v0, const u32x4& v1, const u32x4& v2, const u32x4& v3, const Item& it, LAS unsigned char* lds, int kt, int tid) {
  constexpr int CPR = MODE == 2 ? 16 : 8, VS = MODE == 2 ? 320 : 192;
  const bool f32src = kt * 64 < it.past;
  const int r0 = tid / CPR, c0 = tid % CPR, r1 = (tid + NTHREADS) / CPR, c1 = (tid + NTHREADS) % CPR;
  { const u32x4 kk = f32src ? cvt8(k0, k1) : k0, vv = f32src ? cvt8(v0, v1) : v0;
    const int kreg = (MODE == 2 && c0 >= 8) ? L_K2 : L_K1;
    *(LAS u32x4*)(lds + kreg + r0 * 128 + (((c0 & 7) ^ ((r0 >> 1) & 7)) << 4)) = kk;
    *(LAS u32x4*)(lds + L_V + r0 * VS + c0 * 16) = vv; }
  if constexpr (MODE == 2) { const u32x4 kk = f32src ? cvt8(k2, k3) : k2, vv = f32src ? cvt8(v2, v3) : v2;
    const int kreg = (c1 >= 8) ? L_K2 : L_K1;
    *(LAS u32x4*)(lds + kreg + r1 * 128 + (((c1 & 7) ^ ((r1 >> 1) & 7)) << 4)) = kk;
    *(LAS u32x4*)(lds + L_V + r1 * VS + c1 * 16) = vv; }
}

DI bf16x8 pack_p(const f32x16& x, int s) {
  const f32x4 a = {x[8 * s], x[8 * s + 1], x[8 * s + 2], x[8 * s + 3]}, b = {x[8 * s + 4], x[8 * s + 5], x[8 * s + 6], x[8 * s + 7]};
  return __builtin_bit_cast(bf16x8, pack8(a, b));
}
#define MFMA32(a, b, c) __builtin_amdgcn_mfma_f32_32x32x16_bf16((a), (b), (c), 0, 0, 0)

template <int MODE>
DI void run_item(const Params& p, int layer, const Item& it, LAS unsigned char* lds) {
  constexpr int NDV = MODE == 2 ? 4 : 2, VS = MODE == 2 ? 320 : 192;
  int tid_ = threadIdx.x; asm volatile("" : "+v"(tid_));
  const int tid = tid_, lane = tid & 63, wave = __builtin_amdgcn_readfirstlane(tid >> 6);
  const int qi = lane & 31, h2 = lane >> 5;
  const int mp = MODE == 2 ? (wave >> 2) : 0, wrow = MODE == 2 ? (wave & 3) : wave;
  const int q0w = it.q0 + 32 * wrow;
  const bool active = 32 * wrow < it.nqv;
  const bf16_t* QKV = (const bf16_t*)(p.ws + WS_QKV);
  const int hb = MODE == 2 ? it.h * 128 : it.h * 64;
  const int qcol = (MODE == 0 ? 0 : MODE == 1 ? 1536 : 3072) + hb + 64 * mp, kcol = (MODE == 0 ? 512 : MODE == 1 ? 2048 : 3584) + hb, vcol = (MODE == 0 ? 1024 : MODE == 1 ? 2560 : 4096) + hb;
  LAS float* lut = (LAS float*)(lds + L_LUT);
  LAS unsigned* flags = (LAS unsigned*)(lds + L_FLAGS);
  if (MODE == 0) { for (int i = tid; i < 257; i += NTHREADS) lut[i] = p.a_rel_bias[((size_t)layer * 257 + i) * 8 + it.h] * LOG2E; }
  if (MODE == 2) { if (tid < 192) lut[tid] = ((const float*)(p.ws + WS_CTL))[CW_T5 + it.h * 192 + tid]; }
  bf16x8 qf[4];
  if (active) { const bf16_t* qp = QKV + (size_t)(it.tok0 + q0w + qi - it.past) * QKVW + qcol + 8 * h2;
#pragma unroll
    for (int s = 0; s < 4; ++s) { const u32x4 w = *(const u32x4*)(qp + 16 * s);
      const f32x4 a = {bflo(w[0]) * 0.125f, bfhi(w[0]) * 0.125f, bflo(w[1]) * 0.125f, bfhi(w[1]) * 0.125f}, b = {bflo(w[2]) * 0.125f, bfhi(w[2]) * 0.125f, bflo(w[3]) * 0.125f, bfhi(w[3]) * 0.125f};
      qf[s] = __builtin_bit_cast(bf16x8, pack8(a, b)); } }
  const int cw = q0w >> 6;
  int kt_first, kt_last, step;
  if (MODE == 0) { kt_first = (it.q0 >> 6) - 8; if (kt_first < 0) kt_first = 0; kt_last = (it.q0 + it.nqv - 1) >> 6; step = 1; }
  else if (MODE == 2) { kt_first = 0; kt_last = (it.q0 + it.nqv - 1) >> 6; step = 1; }
  else { kt_first = (it.q0 + it.nqv - 2) >> 6; kt_last = 0; step = -1; }
  f32x16 O[NDV];
#pragma unroll
  for (int b = 0; b < NDV; ++b)
#pragma unroll
    for (int i = 0; i < 16; ++i) O[b][i] = 0.f;
  float m_run = -1e30f, l_run = 0.f, R2 = 0.f; bool done = false;
  const int krow_off = qi * 128, kswz = (qi >> 1) & 7;
  const int g16 = lane >> 4, trq = (lane & 15) >> 2, trp = lane & 3;
  const int vtr_off = L_V + (4 * (g16 >> 1) + trq) * VS + (16 * (g16 & 1) + 4 * trp) * 2;

  u32x4 sk0 = {}, sk1 = {}, sk2 = {}, sk3 = {}, sv0 = {}, sv1 = {}, sv2 = {}, sv3 = {};
  load_tile<MODE>(sk0, sk1, sk2, sk3, sv0, sv1, sv2, sv3, it, QKV, kcol, vcol, kt_first, tid);
  for (int kt = kt_first;; kt += step) {
    __syncthreads();
    if (MODE == 1 && kt != kt_first) { const unsigned any = flags[0] | flags[1] | flags[2] | flags[3] | flags[4] | flags[5] | flags[6] | flags[7]; if (!any) break; }
    write_tile<MODE>(sk0, sk1, sk2, sk3, sv0, sv1, sv2, sv3, it, lds, kt, tid);
    __syncthreads();
    if (kt != kt_last) load_tile<MODE>(sk0, sk1, sk2, sk3, sv0, sv1, sv2, sv3, it, QKV, kcol, vcol, kt + step, tid);
    bool mine;
    if (MODE == 0) mine = active && kt >= cw - 8 && kt <= cw;
    else if (MODE == 2) mine = active && kt <= cw;
    else mine = active && !done && kt * 64 <= q0w + 30;
    if (mine) {
      f32x16 sA, sB;
#pragma unroll
      for (int i = 0; i < 16; ++i) { sA[i] = 0.f; sB[i] = 0.f; }
      const int kreg = (MODE == 2 && mp) ? L_K2 : L_K1;
#pragma unroll
      for (int s = 0; s < 4; ++s) { const int cs = ((2 * s + h2) ^ kswz) << 4;
        const bf16x8 ka = *(const LAS bf16x8*)(lds + kreg + krow_off + cs), kb = *(const LAS bf16x8*)(lds + kreg + 4096 + krow_off + cs);
        sA = MFMA32(ka, qf[s], sA); sB = MFMA32(kb, qf[s], sB); }
      const int kbase = kt * 64 + 4 * h2;
      if (MODE != 1) {
        bool cst; float cbias = 0.f;
        if (MODE == 0) { cst = q0w - (kt * 64 + 63) >= 128; if (cst) cbias = lut[256]; } else { cst = kt * 64 + 63 - q0w <= -127; if (cst) cbias = lut[0]; }
        if (cst) {
#pragma unroll
          for (int i = 0; i < 16; ++i) { sA[i] = sA[i] * LOG2E + cbias; sB[i] = sB[i] * LOG2E + cbias; }
        } else {
#pragma unroll
          for (int i = 0; i < 16; ++i) { const int ko = (i & 3) + 8 * (i >> 2);
            int ia, ib;
            if (MODE == 0) { const int d = (q0w + qi) - (kbase + ko); ia = d; ib = d - 32; ia = (ia < -128 ? -128 : ia > 128 ? 128 : ia) + 128; ib = (ib < -128 ? -128 : ib > 128 ? 128 : ib) + 128; }
            else { const int d = (kbase + ko) - (q0w + qi); ia = d; ib = d + 32; ia = (ia < -127 ? -127 : ia > 63 ? 63 : ia) + 127; ib = (ib < -127 ? -127 : ib > 63 ? 63 : ib) + 127; }
            sA[i] = sA[i] * LOG2E + lut[ia]; sB[i] = sB[i] * LOG2E + lut[ib]; }
        }
        float mx = sA[0];
#pragma unroll
        for (int i = 1; i < 16; ++i) mx = fmaxf(mx, sA[i]);
#pragma unroll
        for (int i = 0; i < 16; ++i) mx = fmaxf(mx, sB[i]);
        mx = fmaxf(mx, __shfl_xor(mx, 32));
        const float mnew = fmaxf(m_run, mx), alpha = fast_exp2(m_run - mnew); m_run = mnew;
        float ls = 0.f;
#pragma unroll
        for (int i = 0; i < 16; ++i) { sA[i] = fast_exp2(sA[i] - mnew); sB[i] = fast_exp2(sB[i] - mnew); ls += sA[i] + sB[i]; }
        l_run = l_run * alpha + ls;
#pragma unroll
        for (int b = 0; b < NDV; ++b)
#pragma unroll
          for (int i = 0; i < 16; ++i) O[b][i] *= alpha;
      } else {
        const bool diag = kt * 64 + 63 >= q0w;
        float lkA[16], lkB[16];
#pragma unroll
        for (int i = 0; i < 16; ++i) { const int ko = (i & 3) + 8 * (i >> 2);
          { const float z2 = sA[i] * LOG2E, e = fast_exp2(-fabsf(z2)), sp = fmaxf(z2, 0.f) + fast_log2(1.0f + e); const bool ok = !diag || (kbase + ko) < (q0w + qi);
            lkA[i] = ok ? -sp : 0.f; sA[i] = ok ? z2 - sp : -1e30f; }
          { const float z2 = sB[i] * LOG2E, e = fast_exp2(-fabsf(z2)), sp = fmaxf(z2, 0.f) + fast_log2(1.0f + e); const bool ok = !diag || (kbase + 32 + ko) < (q0w + qi);
            lkB[i] = ok ? -sp : 0.f; sB[i] = ok ? z2 - sp : -1e30f; } }
        float gs[8], pg[8];
#pragma unroll
        for (int g = 0; g < 4; ++g) { gs[g] = (lkA[4 * g] + lkA[4 * g + 1]) + (lkA[4 * g + 2] + lkA[4 * g + 3]); gs[4 + g] = (lkB[4 * g] + lkB[4 * g + 1]) + (lkB[4 * g + 2] + lkB[4 * g + 3]); }
#pragma unroll
        for (int g = 0; g < 8; ++g) pg[g] = __shfl_xor(gs[g], 32);
        float suf = R2;
#pragma unroll
        for (int g = 7; g >= 0; --g) { const float off = suf + (h2 == 0 ? pg[g] : 0.f);
          if (g >= 4) { const int b = 4 * (g - 4); float a3 = off, a2 = a3 + lkB[b + 3], a1 = a2 + lkB[b + 2], a0 = a1 + lkB[b + 1];
            sB[b + 3] = fast_exp2(sB[b + 3] + a3); sB[b + 2] = fast_exp2(sB[b + 2] + a2); sB[b + 1] = fast_exp2(sB[b + 1] + a1); sB[b] = fast_exp2(sB[b] + a0); }
          else { const int b = 4 * g; float a3 = off, a2 = a3 + lkA[b + 3], a1 = a2 + lkA[b + 2], a0 = a1 + lkA[b + 1];
            sA[b + 3] = fast_exp2(sA[b + 3] + a3); sA[b + 2] = fast_exp2(sA[b + 2] + a2); sA[b + 1] = fast_exp2(sA[b + 1] + a1); sA[b] = fast_exp2(sA[b] + a0); }
          suf += gs[g] + pg[g]; }
        R2 = suf;
        done = __all(R2 < STICK_DONE2) != 0;
      }
#pragma unroll
      for (int s = 0; s < 4; ++s) { const bf16x8 pf = s < 2 ? pack_p(sA, s) : pack_p(sB, s - 2);
#pragma unroll
        for (int b = 0; b < NDV; ++b) { const int a0 = vtr_off + 16 * s * VS + 64 * b;
          const s16x4 lo = __builtin_amdgcn_ds_read_tr16_b64_v4i16((LAS s16x4*)(lds + a0)), hi = __builtin_amdgcn_ds_read_tr16_b64_v4i16((LAS s16x4*)(lds + a0 + 8 * VS));
          const bf16x8 vf = __builtin_shufflevector(lo, hi, 0, 1, 2, 3, 4, 5, 6, 7);
          O[b] = MFMA32(vf, pf, O[b]); } }
    }
    if (MODE == 1) { if (lane == 0) flags[wave] = (active && !done && kt > 0 && (kt - 1) * 64 <= q0w + 30) ? 1u : 0u; }
    if (kt == kt_last) break;
  }
  bf16_t* Ob = (bf16_t*)(p.ws + WS_O);
  const int ocol = MODE == 0 ? hb : MODE == 1 ? 512 + hb : 1024 + hb;
  if (MODE != 2) {
    if (active) { float sc = 1.f; if (MODE == 0) { const float lt = l_run + __shfl_xor(l_run, 32); sc = fast_rcp(lt); }
      bf16_t* op = Ob + (size_t)(it.tok0 + q0w + qi - it.past) * OW + ocol + 4 * h2;
#pragma unroll
      for (int b = 0; b < NDV; ++b)
#pragma unroll
        for (int g = 0; g < 4; ++g) { const f32x4 v = {O[b][4 * g] * sc, O[b][4 * g + 1] * sc, O[b][4 * g + 2] * sc, O[b][4 * g + 3] * sc}; *(u32x2*)(op + 32 * b + 8 * g) = pack4(v); } }
    __syncthreads();
  } else {
    const float lam = ((const float*)(p.ws + WS_CTL))[CW_LAM + layer];
    const float sub_scale = 1.0f - (0.8f - 0.6f * expf(-0.3f * (float)layer));
    LAS float* xch = (LAS float*)(lds + L_XCH);
    __syncthreads();
    if (active && mp == 1) { const float lt = l_run + __shfl_xor(l_run, 32), sc = lam * fast_rcp(lt);
#pragma unroll
      for (int b = 0; b < NDV; ++b)
#pragma unroll
        for (int i = 0; i < 16; ++i) xch[((wave & 3) * 64 + b * 16 + i) * 64 + lane] = O[b][i] * sc; }
    __syncthreads();
    if (active && mp == 0) { const float lt = l_run + __shfl_xor(l_run, 32), sc = fast_rcp(lt); float q = 0.f;
#pragma unroll
      for (int b = 0; b < NDV; ++b)
#pragma unroll
        for (int i = 0; i < 16; ++i) { const float o = O[b][i] * sc - xch[((wave & 3) * 64 + b * 16 + i) * 64 + lane]; O[b][i] = o; q += o * o; }
      q += __shfl_xor(q, 32);
      const float rstd = __builtin_amdgcn_rsqf(q * (1.0f / 128.0f) + EPS) * sub_scale;
      const float* gain = p.c_subln + layer * 128 + 4 * h2;
      bf16_t* op = Ob + (size_t)(it.tok0 + q0w + qi - it.past) * OW + ocol + 4 * h2;
#pragma unroll
      for (int b = 0; b < NDV; ++b)
#pragma unroll
        for (int g = 0; g < 4; ++g) { const f32x4 gn = *(const f32x4*)(gain + 32 * b + 8 * g);
          const f32x4 v = {O[b][4 * g] * rstd * gn[0], O[b][4 * g + 1] * rstd * gn[1], O[b][4 * g + 2] * rstd * gn[2], O[b][4 * g + 3] * rstd * gn[3]}; *(u32x2*)(op + 32 * b + 8 * g) = pack4(v); } }
    __syncthreads();
  }
}

DI void attn_phase(const Params& p, int qidx, LAS unsigned char* lds) {
  const int layer = qidx & 1;
  unsigned* head = (unsigned*)(p.ws + WS_CTL) + CW_QUEUE + 64 * qidx;
  LAS unsigned* slot = (LAS unsigned*)(lds + L_FLAGS + 64);
  for (;;) {
    if (threadIdx.x == 0) slot[0] = atomicAdd(head, 1u);
    __syncthreads();
    const int idx = (int)slot[0];
    __syncthreads();
    if (idx >= NITEMS) break;
    const Item it = decode(p, layer, idx);
    if (it.mode == 0) run_item<0>(p, layer, it, lds); else if (it.mode == 1) run_item<1>(p, layer, it, lds); else run_item<2>(p, layer, it, lds);
  }
}
}
#define XB_TMO      128
#define XB_XCNT(j)  (256  + 64 * (j))
#define XB_XSUB(j)  (1280 + 64 * (j))
#define XB_XGEN(j)  (2304 + 64 * (j))
#define XB_TOP      3328
#define XB_TOPGEN   3392
#define XCD_BAR_WORDS 3456
#define XB_SPIN_CAP (1u << 18)
DI unsigned xb_ld(unsigned* p)              { return __hip_atomic_load(p, __ATOMIC_RELAXED, __HIP_MEMORY_SCOPE_AGENT); }
DI unsigned xb_add(unsigned* p, unsigned v) { return __hip_atomic_fetch_add(p, v, __ATOMIC_RELAXED, __HIP_MEMORY_SCOPE_AGENT); }
DI unsigned xb_xcc_id() { return (unsigned)__builtin_amdgcn_s_getreg((3 << 11) | 20) & 0xFu; }
#define XB_SPIN(cond, bar) do { unsigned _sp = 0; while (cond) { __builtin_amdgcn_s_sleep(1); \
    if ((++_sp & 255u) == 0u) { if (xb_ld(&(bar)[XB_TMO])) break; if (_sp > XB_SPIN_CAP) { atomicAdd(&(bar)[XB_TMO], 1u); break; } } } } while (0)
struct XcdBarrier { unsigned* bar; unsigned x; volatile LAS unsigned* st; };
DI XcdBarrier xcd_barrier_post(unsigned* bar, volatile LAS unsigned* st) {
  XcdBarrier b; b.bar = bar; b.x = xb_xcc_id(); b.st = st;
  if (threadIdx.x == 0) (void)xb_add(&bar[XB_XCNT(b.x)], 1u);
  return b;
}
DI void xcd_barrier_complete(unsigned* bar, unsigned x, unsigned& nloc, unsigned& nx) {
  const unsigned G = gridDim.x * gridDim.y * gridDim.z;
  unsigned sum, cnt, mine, sp = 0u;
  for (;;) {
    sum = 0u; cnt = 0u; mine = 0u;
#pragma unroll
    for (unsigned j = 0; j < 16; ++j) { const unsigned c = xb_ld(&bar[XB_XCNT(j)]); sum += c; cnt += (c > 0u) ? 1u : 0u; mine = (j == x) ? c : mine; }
    if (sum == G) break;
    __builtin_amdgcn_s_sleep(1);
    if ((++sp & 255u) == 0u) { if (xb_ld(&bar[XB_TMO])) break; if (sp > XB_SPIN_CAP) { atomicAdd(&bar[XB_TMO], 1u); break; } }
  }
  nloc = mine > 0u ? mine : 1u; nx = cnt > 0u ? cnt : 1u;
}
DI void xcd_barrier(const XcdBarrier& b) {
  asm volatile("s_waitcnt vmcnt(0)" ::: "memory");
  __syncthreads();
  if (threadIdx.x == 0) {
    unsigned* bar = b.bar;
    __builtin_amdgcn_s_waitcnt(0);
    unsigned nloc = b.st[0], nx = b.st[1];
    if (nloc == 0u) { xcd_barrier_complete(bar, b.x, nloc, nx); b.st[0] = nloc; b.st[1] = nx; }
    const unsigned old = xb_add(&bar[XB_XSUB(b.x)], 1u);
    const unsigned gen = old / nloc;
    if (old + 1u == (gen + 1u) * nloc) {
      __builtin_amdgcn_fence(__ATOMIC_RELEASE, "agent");
      asm volatile("s_waitcnt vmcnt(0)" ::: "memory");
      const unsigned og = xb_add(&bar[XB_TOP], 1u);
      const unsigned tg = og / nx;
      if (og + 1u == (tg + 1u) * nx) xb_add(&bar[XB_TOPGEN], 1u);
      else XB_SPIN(xb_ld(&bar[XB_TOPGEN]) == tg, bar);
      __builtin_amdgcn_fence(__ATOMIC_ACQUIRE, "agent");
      xb_add(&bar[XB_XGEN(b.x)], 1u);
      asm volatile("s_waitcnt vmcnt(0)" ::: "memory");
    } else {
      XB_SPIN(xb_ld(&bar[XB_XGEN(b.x)]) == gen, bar);
      __builtin_amdgcn_fence(__ATOMIC_ACQUIRE, "agent");
      asm volatile("s_waitcnt vmcnt(0)" ::: "memory");
    }
  }
  __syncthreads();
}
constexpr int L_BARST = LDS_BYTES - 64;

#ifndef PROBE_NULL_EPI
#define PROBE_NULL_EPI 0
#endif
#ifndef PROBE_MASK
#define PROBE_MASK 0
#endif
#define REPEAT(k) for (int rep_ = 0; rep_ < (((PROBE_MASK >> (k)) & 1) ? 2 : 1); ++rep_)
constexpr int NPHASE = 2 + 6 * NLAYER;
__global__ void __launch_bounds__(NTHREADS, 2) fwd_megakernel(Params p) {
  extern __shared__ __attribute__((aligned(16))) unsigned char lds_raw[];
  LAS unsigned char* lds = (LAS unsigned char*)lds_raw;
  cg::grid_group grid = cg::this_grid();
  const int lo = p.ph_lo, hi = p.ph_hi;
#define IN(k) (lo <= (k) && (k) < hi)
#define SEAM(k) do { if (IN(k) && IN((k) + 1)) xcd_barrier(bar); } while (0)
  unsigned char* ws = p.ws;
  const int G = gridDim.x, c = blockIdx.x;
  if (threadIdx.x < 2) ((LAS unsigned*)(lds + L_BARST))[threadIdx.x] = 0u;
  if (IN(0)) { p0_prologue(p, lds); }
  XcdBarrier bar; bar.bar = (unsigned*)(ws + WS_CTL) + CW_BAR; bar.x = 0; bar.st = (volatile LAS unsigned*)(lds + L_BARST);
  if (IN(0) && IN(1)) { grid.sync(); bar = xcd_barrier_post((unsigned*)(ws + WS_CTL) + CW_BAR, (volatile LAS unsigned*)(lds + L_BARST)); }
  for (int l = 0; l < NLAYER; ++l) {
    const int pb = 1 + 6 * l;
    if (IN(pb + 0)) REPEAT(0) {
      pg8::GemmDesc g{(const char*)(ws + WS_XB), (const char*)(ws + WS_WIN) + (size_t)l * INC * D * 2, D, D, D / 64, (size_t)256 * D * 2, (size_t)128 * D * 2};
      pg8::StaticOrder S; S.init(TOK / 256, INC / 256, G, c);
      EpiP1 E{(const float*)(ws + WS_SS), (bf16_t*)(ws + WS_QKV), (bf16_t*)(ws + WS_GATE), p.b_gate + (size_t)l * 3 * D, p.out, l};
#if PROBE_NULL_EPI
      if (rep_ == 1) { EpiNull EN; pg8::gemm_phase<EpiNull>(lds, g, S, EN); } else
#endif
      pg8::gemm_phase<EpiP1>(lds, g, S, E);
    }
    SEAM(pb + 0);
    if (IN(pb + 1)) REPEAT(1) { attn::attn_phase(p, l + 2 * rep_, lds); }
    SEAM(pb + 1);
    if (IN(pb + 2)) REPEAT(2) {
      pg8::GemmDesc g{(const char*)(ws + WS_O), (const char*)(ws + WS_WBR) + (size_t)l * D * OW * 2, OW, OW, OW / 64, (size_t)256 * OW * 2, (size_t)128 * OW * 2};
      pg8::StaticOrder S; S.init(TOK / 256, D / 256, G, c);
      EpiP3 E{(const bf16_t*)(ws + WS_GATE), (bf16_t*)(ws + WS_H)};
      pg8::gemm_phase<EpiP3>(lds, g, S, E);
    }
    SEAM(pb + 2);
    if (IN(pb + 3)) {
      pg8::GemmDesc g{(const char*)(ws + WS_H), (const char*)(ws + WS_WOUT) + (size_t)l * D * D * 2, D, D, D / 64, (size_t)256 * D * 2, (size_t)128 * D * 2};
      pg8::StaticOrder S; S.init(TOK / 256, D / 256, G, c);
      EpiRes E{(float*)(ws + WS_X32), (bf16_t*)(ws + WS_XB), (float*)(ws + WS_SS), lds};
      pg8::gemm_phase<EpiRes>(lds, g, S, E);
    }
    SEAM(pb + 3);
    if (IN(pb + 4)) REPEAT(4) {
      pg8::GemmDesc g{(const char*)(ws + WS_XB), (const char*)(ws + WS_WUP) + (size_t)l * 2 * DFF * D * 2, D, D, D / 64, (size_t)128 * D * 2, (size_t)DFF * D * 2};
      pg8::StaticOrder S; S.init(TOK / 256, DFF / 128, G, c);
      EpiP5F E{(const float*)(ws + WS_SS), (bf16_t*)(ws + WS_HF), p.out, p.conv_w + (size_t)l * 3 * DFF, p.conv_b + (size_t)l * DFF, p.state_conv + (size_t)l * DB * 2 * DFF, (float*)(ws + WS_SIDE), lds, l};
      pg8::gemm_phase<EpiP5F>(lds, g, S, E);
    }
    SEAM(pb + 4);
    if (IN(pb + 5)) {
      pg8::GemmDesc g{(const char*)(ws + WS_HF), (const char*)(ws + WS_WDN) + (size_t)l * D * DFF * 2, DFF, DFF, DFF / 64, (size_t)256 * DFF * 2, (size_t)128 * DFF * 2};
      pg8::StaticOrder S; S.init(TOK / 256, D / 256, G, c);
      { pg8::Unit uu; for (int i = 0; S.next(i, uu); ++i) if (uu.pm < 64 && (uu.pm & 15) != 0) p6_fixup_panel(uu.pm, (const float*)(ws + WS_SIDE), p.conv_w + (size_t)l * 3 * DFF, (bf16_t*)(ws + WS_HF));
        asm volatile("s_waitcnt vmcnt(0)" ::: "memory"); __syncthreads(); }
      EpiRes E{(float*)(ws + WS_X32), (bf16_t*)(ws + WS_XB), (float*)(ws + WS_SS), lds};
      pg8::gemm_phase<EpiRes>(lds, g, S, E);
    }
    SEAM(pb + 5);
  }
  if (IN(NPHASE - 1)) { pfinal_norm(p); }
#undef IN
#undef SEAM
}

#ifndef MK_ONE_LAUNCH
#define MK_ONE_LAUNCH 1
#endif
extern "C" void kernel_launch(void* const* d_in, const int* in_sizes, int n_in, void* d_out, int out_size, void* d_ws, size_t ws_size, hipStream_t stream) {
  static int grid_blocks = 0;
  if (grid_blocks == 0) {
    int dev = 0, cus = 0, per_cu = 0;
    (void)hipGetDevice(&dev);
    (void)hipDeviceGetAttribute(&cus, hipDeviceAttributeMultiprocessorCount, dev);
    (void)hipFuncSetAttribute((const void*)fwd_megakernel, hipFuncAttributeMaxDynamicSharedMemorySize, LDS_BYTES);
    (void)hipOccupancyMaxActiveBlocksPerMultiprocessor(&per_cu, (const void*)fwd_megakernel, NTHREADS, LDS_BYTES);
    if (per_cu < 1) { fprintf(stderr, "kernel_launch: occupancy query says %d blocks/CU\n", per_cu); per_cu = 1; }
    grid_blocks = cus * per_cu;
    if (n_in != 24 || (size_t)out_size != O_END || ws_size < WS_END) { fprintf(stderr, "kernel_launch: unexpected problem (n_in %d out %d ws %zu, need %zu)\n", n_in, out_size, ws_size, (size_t)WS_END); grid_blocks = -1; }
  }
  if (grid_blocks < 0) return;
  Params p{};
  const float** f = (const float**)&p;
  for (int i = 0; i < 24; ++i) f[i] = (const float*)d_in[i];
  p.out = (float*)d_out; p.ws = (unsigned char*)d_ws;
#if MK_ONE_LAUNCH
  p.ph_lo = 0; p.ph_hi = NPHASE;
  { void* args[] = {&p};
    hipError_t e = hipLaunchCooperativeKernel((void*)fwd_megakernel, dim3(grid_blocks), dim3(NTHREADS), args, LDS_BYTES, stream);
    if (e != hipSuccess) fprintf(stderr, "cooperative launch failed: %s (grid %d)\n", hipGetErrorString(e), grid_blocks); }
#else
  for (int k = 0; k < NPHASE; ++k) { p.ph_lo = k; p.ph_hi = k + 1; void* args[] = {&p};
    hipError_t e = hipLaunchCooperativeKernel((void*)fwd_megakernel, dim3(grid_blocks), dim3(NTHREADS), args, LDS_BYTES, stream);
    if (e != hipSuccess) { fprintf(stderr, "launch %d failed: %s (grid %d)\n", k, hipGetErrorString(e), grid_blocks); break; } }
#endif
}
```

```cpp
#include <hip/hip_runtime.h>
#include <hip/hip_cooperative_groups.h>
#include <cstdio>
#include <cstdint>
namespace cg = cooperative_groups;

#define DI __device__ __forceinline__
#define LAS __attribute__((address_space(3)))
typedef unsigned short bf16_t;
typedef short bf16x8 __attribute__((ext_vector_type(8)));
typedef short s16x4 __attribute__((ext_vector_type(4)));
typedef float f32x2 __attribute__((ext_vector_type(2)));
typedef float f32x4 __attribute__((ext_vector_type(4)));
typedef float f32x8 __attribute__((ext_vector_type(8)));
typedef float f32x16 __attribute__((ext_vector_type(16)));
typedef unsigned u32x2 __attribute__((ext_vector_type(2)));
typedef unsigned u32x4 __attribute__((ext_vector_type(4)));
typedef __bf16 bfv4 __attribute__((ext_vector_type(4)));
typedef __bf16 bfv8 __attribute__((ext_vector_type(8)));

constexpr int D = 1024, SEQ = 4096, NB = 4, TOKP = NB * SEQ, DB = 32, DSEQ = 64, TOKS = DB * DSEQ, TOK = TOKP + TOKS;
constexpr int PAST = 1024, ALEN = 512, INC = 7680, DFF = 2816, NLAYER = 2;
constexpr int QKVW = 4608, GATEW = 3072, OW = 1536;
constexpr float EPS = 1e-6f, LOG2E = 1.4426950408889634f;

constexpr size_t O_YP = 0, O_YS = O_YP + (size_t)TOKP * D, O_PAK = O_YS + (size_t)TOKS * D, O_PAV = O_PAK + (size_t)2 * 4 * 512 * 512,
                 O_PBK = O_PAV + (size_t)2 * 4 * 512 * 512, O_PBV = O_PBK + (size_t)2 * TOKP * 512, O_PCK = O_PBV + (size_t)2 * TOKP * 512,
                 O_PCV = O_PCK + (size_t)2 * TOKP * 512, O_PCONV = O_PCV + (size_t)2 * TOKP * 512, O_SAK = O_PCONV + (size_t)2 * 4 * 2 * DFF,
                 O_SAV = O_SAK + (size_t)2 * DB * 512 * 512, O_SBK = O_SAV + (size_t)2 * DB * 512 * 512, O_SBV = O_SBK + (size_t)2 * TOKS * 512,
                 O_SCK = O_SBV + (size_t)2 * TOKS * 512, O_SCV = O_SCK + (size_t)2 * TOKS * 512, O_SCONV = O_SCV + (size_t)2 * TOKS * 512,
                 O_END = O_SCONV + (size_t)2 * DB * 2 * DFF;

constexpr size_t MiB = 1u << 20;
constexpr size_t WS_CTL = 0;
constexpr size_t WS_WIN = 1 * MiB;
constexpr size_t WS_WBR = WS_WIN + (size_t)2 * INC * D * 2;
constexpr size_t WS_WOUT = WS_WBR + (size_t)2 * D * OW * 2;
constexpr size_t WS_WUP = WS_WOUT + (size_t)2 * D * D * 2;
constexpr size_t WS_WDN = WS_WUP + (size_t)2 * 2 * DFF * D * 2;
constexpr size_t WS_XB = WS_WDN + (size_t)2 * D * DFF * 2;
constexpr size_t WS_X32 = WS_XB + (size_t)TOK * D * 2;
constexpr size_t WS_SS = WS_X32 + (size_t)TOK * D * 4;
constexpr size_t WS_SIDE = WS_SS + (size_t)TOK * 8 * 4;
constexpr size_t WS_O = WS_SIDE + (size_t)3 * 72 * 2 * DFF * 4;
constexpr size_t WS_H = WS_O + (size_t)TOK * OW * 2;
constexpr size_t WS_HF = WS_H + (size_t)TOK * D * 2;
constexpr size_t WS_QKV = WS_HF + (size_t)TOK * DFF * 2;
constexpr size_t WS_GATE = WS_QKV + (size_t)TOK * QKVW * 2;
constexpr size_t WS_END = WS_GATE + (size_t)TOK * GATEW * 2;
constexpr int CW_QUEUE = 64;
constexpr int CW_LAM = 1024;
constexpr int CW_T5 = 2048;
constexpr int CW_BAR = 8192;

constexpr int LDS_BYTES = 160 * 1024;
constexpr int NTHREADS = 512;

DI u32x4 pack8(f32x4 a, f32x4 b) { f32x8 v = {a[0], a[1], a[2], a[3], b[0], b[1], b[2], b[3]}; return __builtin_bit_cast(u32x4, __builtin_convertvector(v, bfv8)); }
DI u32x2 pack4(f32x4 a) { return __builtin_bit_cast(u32x2, __builtin_convertvector(a, bfv4)); }
DI float bflo(unsigned w) { return __uint_as_float(w << 16); }
DI float bfhi(unsigned w) { return __uint_as_float(w & 0xffff0000u); }
DI float wave_sum(float v) {
#pragma unroll
  for (int o = 1; o < 64; o <<= 1) v += __shfl_xor(v, o);
  return v;
}
DI float fast_rcp(float x) { return __builtin_amdgcn_rcpf(x); }
DI float fast_exp2(float x) { return __builtin_amdgcn_exp2f(x); }
DI float fast_log2(float x) { return __builtin_amdgcn_logf(x); }

DI LAS unsigned char* opaque_lds(LAS unsigned char* p) { unsigned v = (unsigned)(__UINTPTR_TYPE__)p; asm volatile("" : "+s"(v)); return (LAS unsigned char*)(__UINTPTR_TYPE__)v; }

struct Params {
  const float* x_prompt; const float* x_sample;
  const float* cache_a_k; const float* cache_a_v; const float* cache_b_k; const float* cache_b_v; const float* cache_c_k; const float* cache_c_v;
  const float* state_conv; const float* norm_mix; const float* w_in; const float* b_gate; const float* a_rel_bias; const float* t5_bias;
  const float* c_lambda; const float* c_subln; const float* w_branch; const float* w_out; const float* norm_ffn; const float* w_up;
  const float* conv_w; const float* conv_b; const float* w_down; const float* norm_final;
  float* out; unsigned char* ws;
  int ph_lo, ph_hi;
};

DI void p0_transpose_item(const float* W, int N, const float* kscale, bf16_t* WT, int dst_ld, int dst_col, LAS float* scr, int item, int lane) {
  const int nblk = N / 32, kb = item / nblk, nb = item % nblk, k0 = 64 * kb, n0 = 32 * nb;
  float wv[32];
#pragma unroll
  for (int i = 0; i < 32; ++i) wv[i] = W[(size_t)(k0 + 2 * i + (lane >> 5)) * N + n0 + (lane & 31)];
#pragma unroll
  for (int i = 0; i < 32; ++i) { const int kk = 2 * i + (lane >> 5); float v = wv[i]; if (kscale) v *= kscale[k0 + kk]; scr[kk * 33 + (lane & 31)] = v; }
  asm volatile("s_waitcnt lgkmcnt(0)" ::: "memory");
  const int c = lane & 7;
#pragma unroll
  for (int j = 0; j < 4; ++j) { const int n = (lane >> 3) + 8 * j; const LAS float* s = scr + (8 * c) * 33 + n;
    f32x4 a = {s[0 * 33], s[1 * 33], s[2 * 33], s[3 * 33]}, b = {s[4 * 33], s[5 * 33], s[6 * 33], s[7 * 33]};
    *(u32x4*)(WT + (size_t)(n0 + n) * dst_ld + dst_col + k0 + 8 * c) = pack8(a, b); }
  asm volatile("s_waitcnt lgkmcnt(0)" ::: "memory");
}

DI int t5_bucket_of(int rel) {
  const int n = rel < 0 ? -rel : rel; int f;
  if (n < 8) f = n; else if (n < 12) f = 8; else if (n < 16) f = 9; else if (n < 23) f = 10; else if (n < 32) f = 11; else if (n < 46) f = 12; else if (n < 64) f = 13; else if (n < 91) f = 14; else f = 15;
  return (rel > 0 ? 16 : 0) + f;
}

DI void p0_prologue(const Params& p, LAS unsigned char* lds_in) {
  LAS unsigned char* lds = opaque_lds(lds_in);
  int tid_ = threadIdx.x; asm volatile("" : "+v"(tid_));
  const int tid = tid_, lane = tid & 63, wave = tid >> 6;
  const int gw = blockIdx.x * 8 + wave, NGW = gridDim.x * 8;
  unsigned* ctl = (unsigned*)(p.ws + WS_CTL);
  if (blockIdx.x == 0) {
    if (tid < 4) ctl[CW_QUEUE + 64 * tid] = 0u;
    if (wave == 1) {
      for (int l = 0; l < NLAYER; ++l) { const float* lp = p.c_lambda + l * 256; const float a = wave_sum(lp[lane] * lp[64 + lane]), b = wave_sum(lp[128 + lane] * lp[192 + lane]);
        const float lam_init = 0.8f - 0.6f * expf(-0.3f * (float)l);
        if (lane == 0) ((float*)ctl)[CW_LAM + l] = expf(a) - expf(b) + lam_init; }
    }
    for (int i = tid; i < 4 * 192; i += NTHREADS) { const int h = i / 192, idx = i % 192; int rel = idx - 127; if (rel > 63) rel = 63;
      ((float*)ctl)[CW_T5 + i] = p.t5_bias[t5_bucket_of(rel) * 4 + h] - p.t5_bias[15 * 4 + h]; }
  }
  LAS float* scr = (LAS float*)(lds + wave * 8448);
  constexpr int I_IN = (D / 64) * (INC / 32), I_BR = (512 / 64) * (D / 32), I_OUT = (D / 64) * (D / 32), I_UP = (D / 64) * (2 * DFF / 32), I_DN = (DFF / 64) * (D / 32);
  constexpr int PER_LAYER = I_IN + 3 * I_BR + I_OUT + I_UP + I_DN;
  for (int it = gw; it < NLAYER * PER_LAYER; it += NGW) {
    const int l = it / PER_LAYER; int r = it % PER_LAYER;
    if (r < I_IN) { p0_transpose_item(p.w_in + (size_t)l * D * INC, INC, p.norm_mix + l * D, (bf16_t*)(p.ws + WS_WIN) + (size_t)l * INC * D, D, 0, scr, r, lane); continue; } r -= I_IN;
    if (r < 3 * I_BR) { const int n = r / I_BR; p0_transpose_item(p.w_branch + ((size_t)l * 3 + n) * 512 * D, D, nullptr, (bf16_t*)(p.ws + WS_WBR) + (size_t)l * D * OW, OW, 512 * n, scr, r % I_BR, lane); continue; } r -= 3 * I_BR;
    if (r < I_OUT) { p0_transpose_item(p.w_out + (size_t)l * D * D, D, nullptr, (bf16_t*)(p.ws + WS_WOUT) + (size_t)l * D * D, D, 0, scr, r, lane); continue; } r -= I_OUT;
    if (r < I_UP) { p0_transpose_item(p.w_up + (size_t)l * D * 2 * DFF, 2 * DFF, p.norm_ffn + l * D, (bf16_t*)(p.ws + WS_WUP) + (size_t)l * 2 * DFF * D, D, 0, scr, r, lane); continue; } r -= I_UP;
    p0_transpose_item(p.w_down + (size_t)l * DFF * D, D, nullptr, (bf16_t*)(p.ws + WS_WDN) + (size_t)l * D * DFF, DFF, 0, scr, r, lane);
  }
  bf16_t* XB = (bf16_t*)(p.ws + WS_XB); float* SS = (float*)(p.ws + WS_SS);
#pragma unroll 3
  for (int m = gw; m < TOK; m += NGW) {
    const float* src = m < TOKP ? p.x_prompt + (size_t)m * D : p.x_sample + (size_t)(m - TOKP) * D;
    float s = 0.f;
#pragma unroll
    for (int j = 0; j < 4; ++j) { const f32x4 v = ((const f32x4*)src)[lane + 64 * j]; ((u32x2*)(XB + (size_t)m * D))[lane + 64 * j] = pack4(v);
      s += (v[0] * v[0] + v[1] * v[1]) + (v[2] * v[2] + v[3] * v[3]); }
    s = wave_sum(s);
    if (lane < 8) SS[(size_t)m * 8 + lane] = lane == 0 ? s : 0.f;
  }
}

namespace pg8 {
constexpr int BM = 256, BK = 64, HALF = 128, HTB = HALF * BK * 2, STAGE_BYTES = 8 * HTB, NXCD = 8, WGM = 8;
DI int lds_byte(int r, int c) { const int st = (r >> 4) * 2 + (c >> 5), rr = r & 15, cc = c & 31, ob = rr * 64 + cc * 2; return st * 1024 + (ob ^ (((ob >> 9) & 1) << 5)); }
DI void stage_rc(int b, int& R, int& C) { const int st = b / 1024, sb = b % 1024, swz = sb ^ (((sb >> 9) & 1) << 5); R = (st >> 1) * 16 + swz / 64; C = (st & 1) * 32 + (swz % 64) / 2; }
DI int perm32(int rho) { const int n = rho >> 4, i = rho & 15; return 8 * (i >> 2) + 4 * n + (i & 3); }
struct Unit { int pm, pn; };
struct GemmDesc { const char* A; const char* B; int lda, ldb, nt; size_t b_tile, b_half; };
struct StaticOrder {
  int nM, nN, nwg, G, c, pm0;
  DI void init(int nM_, int nN_, int G_, int c_, int pm0_ = 0) { nM = nM_; nN = nN_; nwg = nM * nN; G = G_; c = c_; pm0 = pm0_; }
  DI bool next(int i, Unit& u) const {
    const long L = (long)i * G + c; if (L >= nwg) return false;
    int wgid = (int)L; { const int q = nwg / NXCD, r = nwg % NXCD, xcd = wgid % NXCD, off = wgid / NXCD; wgid = (xcd < r ? xcd * (q + 1) : r * (q + 1) + (xcd - r) * q) + off; }
    const int nig = WGM * nN, gid = wgid / nig, fm = gid * WGM, gsz = (nM - fm) < WGM ? (nM - fm) : WGM;
    u.pm = pm0 + fm + ((wgid % nig) % gsz); u.pn = (wgid % nig) / gsz; return true;
  }
};
constexpr int P1_NN = 28, P1_EXTRA = 32, P1_DEFER = 72 + (72 - P1_EXTRA);
struct P1Order {
  StaticOrder R1;
  DI bool next(int i, Unit& u) const {
    if (R1.next(i, u)) return true;
    const long L = (long)i * R1.G + R1.c - R1.nwg; if (L >= P1_EXTRA) return false;
    u.pm = (int)L; u.pn = P1_NN; return true;
  }
};
DI Unit p1_deferred_unit(int j) { Unit u; if (j < 72) { u.pm = j; u.pn = P1_NN + 1; } else { u.pm = P1_EXTRA + (j - 72); u.pn = P1_NN; } return u; }
struct OneUnit { Unit u; DI bool next(int i, Unit& o) const { if (i != 0) return false; o = u; return true; } };
template <class Epi, bool HALFN = false, bool HALFM = false, class Sched = StaticOrder>
DI void gemm_phase(LAS unsigned char* lds_in, const GemmDesc g, const Sched& S, const Epi& E) {
  LAS unsigned char* lds = opaque_lds(lds_in);
  int tid_ = threadIdx.x; asm volatile("" : "+v"(tid_));
  const int tid = tid_, wid = __builtin_amdgcn_readfirstlane(tid >> 6), lane = tid & 63, wr = wid >> 2, wc = wid & 3, fr = lane & 15, fq = lane >> 4;
  const int nt = g.nt;
  unsigned voffA[2], voffB[2];
#pragma unroll
  for (int i = 0; i < 2; ++i) { int R, C; stage_rc(tid * 16 + i * 8192, R, C); const int Rb = Epi::PERM ? ((R & ~31) + perm32(R & 31)) : R;
    voffA[i] = (unsigned)(R * g.lda + C) * 2u; voffB[i] = (unsigned)(Rb * g.ldb + C) * 2u; }
  const size_t kstep = (size_t)(BK * 2);
  const size_t hsA = (size_t)HALF * g.lda * 2, tsA = HALFM ? hsA : 2 * hsA, hsB = g.b_half, tsB = g.b_tile;
  const unsigned ldsw = (unsigned)wid * 1024u;
  const int aoff = lds_byte(wr * 64 + fr, fq * 8), boff = lds_byte(wc * 32 + fr, fq * 8);
#define PG8_SA(b, h) (((b) * 2 + (h)) * HTB)
#define PG8_SB(b, h) ((4 + (b) * 2 + (h)) * HTB)
#define PG8_STAGE(bufoff, gbase, voff) do { _Pragma("unroll") for (int _i = 0; _i < 2; ++_i) \
    __builtin_amdgcn_global_load_lds((const unsigned*)((const char*)(gbase) + (voff)[_i]), (LAS unsigned*)(lds + (bufoff) + ldsw + _i * 8192), 16, 0, 0); } while (0)
#define PG8_LDA(dst, b, h) do { _Pragma("unroll") for (int m = 0; m < 4; ++m) _Pragma("unroll") for (int k = 0; k < 2; ++k) dst[m][k] = *(const LAS bf16x8*)(lds + PG8_SA(b, h) + aoff + m * 2048 + k * 1024); } while (0)
#define PG8_LDB(dst, b, h) do { _Pragma("unroll") for (int n = 0; n < 2; ++n) _Pragma("unroll") for (int k = 0; k < 2; ++k) dst[n][k] = *(const LAS bf16x8*)(lds + PG8_SB(b, h) + boff + n * 2048 + k * 1024); } while (0)
#define PG8_MMA(ai, bj, At, Bt) do { __builtin_amdgcn_s_setprio(1); _Pragma("unroll") for (int m = 0; m < 4; ++m) _Pragma("unroll") for (int n = 0; n < 2; ++n) _Pragma("unroll") for (int k = 0; k < 2; ++k) \
    acc[ai][bj][m][n] = __builtin_amdgcn_mfma_f32_16x16x32_bf16(Bt[n][k], At[m][k], acc[ai][bj][m][n], 0, 0, 0); __builtin_amdgcn_s_setprio(0); } while (0)
#define PG8_WAIT_V(n) asm volatile("s_waitcnt vmcnt(" #n ")" ::: "memory")
#define PG8_WAIT_LOOP do { if constexpr (HALFM && HALFN) PG8_WAIT_V(4); else if constexpr (HALFM || HALFN) PG8_WAIT_V(6); else PG8_WAIT_V(8); } while (0)
#define PG8_WAIT_L(n) asm volatile("s_waitcnt lgkmcnt(" #n ")" ::: "memory")
#define PG8_BAR __builtin_amdgcn_s_barrier()
#define PG8_SCHED __builtin_amdgcn_sched_barrier(0)
  Unit cur, nxt; int ui = 0;
  if (!S.next(0, cur)) return;
  f32x4 acc[2][2][4][2];
#pragma unroll
  for (int a = 0; a < 2; ++a)
#pragma unroll
    for (int b = 0; b < 2; ++b)
#pragma unroll
      for (int m = 0; m < 4; ++m)
#pragma unroll
        for (int n = 0; n < 2; ++n) acc[a][b][m][n] = (f32x4){0.f, 0.f, 0.f, 0.f};
  bf16x8 At[4][2], B0[2][2], B1[2][2];
  const char* cA = g.A + (size_t)cur.pm * tsA; const char* cB = g.B + (size_t)cur.pn * tsB;
  f32x4 ssv = {0.f, 0.f, 0.f, 0.f};
  if constexpr (Epi::HAS_RS) ssv = E.prefetch(cur, tid);
  PG8_STAGE(PG8_SB(0, 0), cB, voffB); if constexpr (!HALFN) PG8_STAGE(PG8_SB(0, 1), cB + hsB, voffB); PG8_STAGE(PG8_SA(0, 0), cA, voffA); if constexpr (!HALFM) PG8_STAGE(PG8_SA(0, 1), cA + hsA, voffA);
  if (wr == 1) PG8_BAR;
  if constexpr (HALFM) PG8_WAIT_V(0); else PG8_WAIT_V(2);
  PG8_BAR;
  PG8_STAGE(PG8_SB(1, 0), cB + kstep, voffB); PG8_STAGE(PG8_SA(1, 0), cA + kstep, voffA); if constexpr (!HALFN) PG8_STAGE(PG8_SB(1, 1), cB + hsB + kstep, voffB);
  if constexpr (HALFN) PG8_WAIT_V(4); else PG8_WAIT_V(6);
  PG8_BAR;
  for (;;) {
    const bool has_next = S.next(ui + 1, nxt);
    const char* nA = has_next ? g.A + (size_t)nxt.pm * tsA : cA; const char* nB = has_next ? g.B + (size_t)nxt.pn * tsB : cB;
    for (int t = 0; t < nt; t += 2) {
      const bool last = (t == nt - 2);
      const char* a1 = cA + (size_t)(t + 1) * kstep;
      const char* a2 = last ? nA : cA + (size_t)(t + 2) * kstep; const char* b2 = last ? nB : cB + (size_t)(t + 2) * kstep;
      const char* a3 = a2 + kstep; const char* b3 = b2 + kstep;
      if constexpr (Epi::HAS_MID) { if (t == 8 || t == 16) E.mid(acc, cur, t, wr, wc, fr, fq); }
      PG8_LDB(B0, 0, 0); if constexpr (!HALFN) PG8_LDB(B1, 0, 1); PG8_SCHED; PG8_LDA(At, 0, 0); if constexpr (!HALFM) PG8_STAGE(PG8_SA(1, 1), a1 + hsA, voffA);
      PG8_WAIT_LOOP; PG8_WAIT_L(0); PG8_BAR; PG8_MMA(0, 0, At, B0); if constexpr (!HALFN) PG8_MMA(0, 1, At, B1); PG8_BAR; PG8_SCHED;
      if constexpr (!HALFM) PG8_LDA(At, 0, 1); PG8_STAGE(PG8_SB(0, 0), b2, voffB); if constexpr (!HALFN) PG8_STAGE(PG8_SB(0, 1), b2 + hsB, voffB); PG8_STAGE(PG8_SA(0, 0), a2, voffA);
      PG8_WAIT_LOOP; PG8_WAIT_L(0); PG8_BAR; if constexpr (!HALFM) { PG8_MMA(1, 0, At, B0); if constexpr (!HALFN) PG8_MMA(1, 1, At, B1); } PG8_BAR; PG8_SCHED;
      PG8_LDB(B0, 1, 0); if constexpr (!HALFN) PG8_LDB(B1, 1, 1); PG8_SCHED; PG8_LDA(At, 1, 0); if constexpr (!HALFM) PG8_STAGE(PG8_SA(0, 1), a2 + hsA, voffA);
      PG8_WAIT_LOOP; PG8_WAIT_L(0); PG8_BAR; PG8_MMA(0, 0, At, B0); if constexpr (!HALFN) PG8_MMA(0, 1, At, B1); PG8_BAR; PG8_SCHED;
      if constexpr (!HALFM) PG8_LDA(At, 1, 1); PG8_STAGE(PG8_SB(1, 0), b3, voffB); if constexpr (!HALFN) PG8_STAGE(PG8_SB(1, 1), b3 + hsB, voffB); PG8_STAGE(PG8_SA(1, 0), a3, voffA);
      PG8_WAIT_LOOP; PG8_WAIT_L(0); PG8_BAR; if constexpr (!HALFM) { PG8_MMA(1, 0, At, B0); if constexpr (!HALFN) PG8_MMA(1, 1, At, B1); } PG8_BAR; PG8_SCHED;
    }
    if (wr == 0) PG8_BAR;
    if constexpr (Epi::HAS_RS) { E.stash(ssv, cur, tid, lds); PG8_WAIT_L(0); PG8_BAR; asm volatile("" ::: "memory"); }
    E(acc, cur, wr, wc, fr, fq);
    if (!has_next) break;
#pragma unroll
    for (int a = 0; a < 2; ++a)
#pragma unroll
      for (int b = 0; b < 2; ++b)
#pragma unroll
        for (int m = 0; m < 4; ++m)
#pragma unroll
          for (int n = 0; n < 2; ++n) acc[a][b][m][n] = (f32x4){0.f, 0.f, 0.f, 0.f};
    cur = nxt; cA = nA; cB = nB; ++ui;
    if constexpr (Epi::HAS_RS) ssv = E.prefetch(cur, tid);
    if (wr == 1) PG8_BAR;
  }
  PG8_WAIT_V(0);
  PG8_BAR;
#undef PG8_SA
#undef PG8_SB
#undef PG8_STAGE
#undef PG8_LDA
#undef PG8_LDB
#undef PG8_MMA
#undef PG8_WAIT_V
#undef PG8_WAIT_LOOP
#undef PG8_WAIT_L
#undef PG8_BAR
#undef PG8_SCHED
}
}
using pg8::Unit;
DI f32x4 ss_load(const float* SS, int r) { const f32x4* q = (const f32x4*)(SS + (size_t)r * 8); return q[0] + q[1]; }
DI float ss_to_rs(const f32x4& a) { return __builtin_amdgcn_rsqf(((a[0] + a[1]) + (a[2] + a[3])) * (1.0f / D) + EPS); }
DI float row_rs(const float* SS, int r) { return ss_to_rs(ss_load(SS, r)); }
DI float sigmoidf_(float x) { return fast_rcp(1.0f + fast_exp2(-x * LOG2E)); }

struct EpiP1 {
  static constexpr bool PERM = true, HAS_MID = false, HAS_RS = true;
  const float* SS; bf16_t* QKV; bf16_t* GATE; const float* bgate; float* out; int layer; int probe_flags; LAS unsigned char* lds;
  DI void mid(f32x4 (&)[2][2][4][2], const Unit&, int, int, int, int, int) const {}
  DI f32x4 prefetch(const Unit& u, int tid) const {
    f32x4 v = {0.f, 0.f, 0.f, 0.f};
    if (tid < 256) v = ss_load(SS, u.pm * 256 + tid);
    return v;
  }
  DI void stash(const f32x4& v, const Unit& u, int tid, LAS unsigned char* l) const {
    if (tid < 256) *(LAS float*)(l + 131072 + 12288 + tid * 4) = ss_to_rs(v);
  }
  DI void operator()(f32x4 (&acc)[2][2][4][2], const Unit& u, int wr, int wc, int fr, int fq) const {
    const int pn = u.pn, rin0 = wr * 64 + fr, row0 = u.pm * 256 + rin0;
    float rs[2][4];
#pragma unroll
    for (int ai = 0; ai < 2; ++ai)
#pragma unroll
      for (int m = 0; m < 4; ++m) rs[ai][m] = *(const LAS float*)(lds + 131072 + 12288 + (rin0 + ai * 128 + m * 16) * 4);
    if (pn < 18) {
      const int colq = pn * 256 + wc * 32 + 8 * fq;
#pragma unroll
      for (int ai = 0; ai < 2; ++ai)
#pragma unroll
        for (int m = 0; m < 4; ++m) {
          const int rin = rin0 + ai * 128 + m * 16, r = u.pm * 256 + rin; const float s = rs[ai][m];
          bf16_t* rowp = QKV + (size_t)r * QKVW + colq;
#pragma unroll
          for (int bj = 0; bj < 2; ++bj) { const f32x4 v0 = acc[ai][bj][m][0] * s, v1 = acc[ai][bj][m][1] * s;
            { const u32x4 pk = pack8(v0, v1); if (!(probe_flags & 2)) *(u32x4*)(rowp + bj * 128) = pk; else asm volatile("" :: "v"(pk)); }
            }
        }
    } else {
      const int gi = pn - 18, nb = gi >> 2, colg = (gi & 3) * 256 + wc * 32 + 8 * fq;
      f32x4 bv[2][2];
#pragma unroll
      for (int bj = 0; bj < 2; ++bj) { bv[bj][0] = *(const f32x4*)(bgate + nb * D + colg + bj * 128); bv[bj][1] = *(const f32x4*)(bgate + nb * D + colg + bj * 128 + 4); }
#pragma unroll
      for (int ai = 0; ai < 2; ++ai)
#pragma unroll
        for (int m = 0; m < 4; ++m) { const int r = row0 + ai * 128 + m * 16; const float s = rs[ai][m];
          bf16_t* rowp = GATE + (size_t)r * GATEW + gi * 256 + wc * 32 + 8 * fq;
#pragma unroll
          for (int bj = 0; bj < 2; ++bj) { f32x4 v0 = acc[ai][bj][m][0] * s + bv[bj][0], v1 = acc[ai][bj][m][1] * s + bv[bj][1];
#pragma unroll
            for (int j = 0; j < 4; ++j) { v0[j] = 1.0f + fast_exp2(fminf(-v0[j] * LOG2E, 100.0f)); v1[j] = 1.0f + fast_exp2(fminf(-v1[j] * LOG2E, 100.0f)); }
            { const u32x4 pk = pack8(v0, v1); if (!(probe_flags & 2)) *(u32x4*)(rowp + bj * 128) = pk; else asm volatile("" :: "v"(pk)); } } }
    }
  }
};

template <bool HALFN, bool HALFM = false> struct EpiP3T {
  static constexpr bool PERM = true, HAS_MID = true, HAS_RS = false;
  const bf16_t* GATE; bf16_t* H;
  DI void mid(f32x4 (&acc)[2][2][4][2], const Unit& u, int t, int wr, int wc, int fr, int fq) const {
    const int nb = (t >> 3) - 1;
    const bf16_t* gp = GATE + (size_t)(u.pm * (HALFM ? 128 : 256) + wr * 64 + fr) * GATEW + nb * D + u.pn * (HALFN ? 128 : 256) + wc * 32 + 8 * fq;
#pragma unroll
    for (int ai = 0; ai < (HALFM ? 1 : 2); ++ai) {
        u32x4 ga[4][2] = {}, gb[4][2] = {};
#pragma unroll
        for (int m = 0; m < 4; ++m)
#pragma unroll
          for (int bj = 0; bj < (HALFN ? 1 : 2); ++bj) { const bf16_t* q = gp + (size_t)(ai * 128 + m * 16) * GATEW + bj * 128; ga[m][bj] = *(const u32x4*)q; gb[m][bj] = *(const u32x4*)(q + D); }
#pragma unroll
        for (int m = 0; m < 4; ++m)
#pragma unroll
          for (int bj = 0; bj < (HALFN ? 1 : 2); ++bj)
#pragma unroll
            for (int n = 0; n < 2; ++n) { const unsigned a0 = ga[m][bj][2 * n], a1 = ga[m][bj][2 * n + 1], b0 = gb[m][bj][2 * n], b1 = gb[m][bj][2 * n + 1];
              acc[ai][bj][m][n][0] *= bflo(b0) * fast_rcp(bflo(a0)); acc[ai][bj][m][n][1] *= bfhi(b0) * fast_rcp(bfhi(a0));
              acc[ai][bj][m][n][2] *= bflo(b1) * fast_rcp(bflo(a1)); acc[ai][bj][m][n][3] *= bfhi(b1) * fast_rcp(bfhi(a1)); }
        asm volatile("" ::: "memory"); }
  }
  DI void operator()(f32x4 (&acc)[2][2][4][2], const Unit& u, int wr, int wc, int fr, int fq) const {
    const int row0 = u.pm * (HALFM ? 128 : 256) + wr * 64 + fr, col0 = u.pn * (HALFN ? 128 : 256) + wc * 32 + 8 * fq;
#pragma unroll
    for (int ai = 0; ai < (HALFM ? 1 : 2); ++ai)
#pragma unroll
      for (int m = 0; m < 4; ++m) { const int r = row0 + ai * 128 + m * 16; const bf16_t* gp = GATE + (size_t)r * GATEW + 2 * D + col0; bf16_t* hp = H + (size_t)r * D + col0;
#pragma unroll
        for (int bj = 0; bj < (HALFN ? 1 : 2); ++bj) { const u32x4 g = *(const u32x4*)(gp + bj * 128); f32x4 v0 = acc[ai][bj][m][0], v1 = acc[ai][bj][m][1];
          v0[0] *= fast_rcp(bflo(g[0])); v0[1] *= fast_rcp(bfhi(g[0])); v0[2] *= fast_rcp(bflo(g[1])); v0[3] *= fast_rcp(bfhi(g[1])); v1[0] *= fast_rcp(bflo(g[2])); v1[1] *= fast_rcp(bfhi(g[2])); v1[2] *= fast_rcp(bflo(g[3])); v1[3] *= fast_rcp(bfhi(g[3]));
          *(u32x4*)(hp + bj * 128) = pack8(v0, v1); } }
  }
};

typedef EpiP3T<false> EpiP3;

template <bool HALFN, bool HALFM = false> struct EpiResT {
  static constexpr bool PERM = true, HAS_MID = false, HAS_RS = false;
  float* X32; bf16_t* XB; float* SS; LAS unsigned char* lds; const float* xin_p; const float* xin_s;
  DI void mid(f32x4 (&)[2][2][4][2], const Unit&, int, int, int, int, int) const {}
  DI void operator()(f32x4 (&acc)[2][2][4][2], const Unit& u, int wr, int wc, int fr, int fq) const {
    const int rin0 = wr * 64 + fr, row0 = u.pm * (HALFM ? 128 : 256) + rin0, col0 = u.pn * (HALFN ? 128 : 256) + wc * 32 + 8 * fq;
    LAS float* red = (LAS float*)(lds + 131072 + 8192);
#pragma unroll
    for (int ai = 0; ai < (HALFM ? 1 : 2); ++ai) {
      f32x4 xo[4][2][2] = {};
#pragma unroll
      for (int m = 0; m < 4; ++m) { const int r = row0 + ai * 128 + m * 16;
        const float* xr = xin_p ? (r < TOKP ? xin_p + (size_t)r * D : xin_s + (size_t)(r - TOKP) * D) + col0 : X32 + (size_t)r * D + col0;
#pragma unroll
        for (int bj = 0; bj < (HALFN ? 1 : 2); ++bj)
#pragma unroll
          for (int n = 0; n < 2; ++n) xo[m][bj][n] = *(const f32x4*)(xr + bj * 128 + n * 4); }
#pragma unroll
      for (int m = 0; m < 4; ++m) { const int r = row0 + ai * 128 + m * 16; float* xp = X32 + (size_t)r * D + col0; bf16_t* bp = XB + (size_t)r * D + col0; float q = 0.f;
#pragma unroll
        for (int bj = 0; bj < (HALFN ? 1 : 2); ++bj)
          { const f32x4 x0 = xo[m][bj][0] + acc[ai][bj][m][0], x1 = xo[m][bj][1] + acc[ai][bj][m][1];
            *(f32x4*)(xp + bj * 128) = x0; *(f32x4*)(xp + bj * 128 + 4) = x1; *(u32x4*)(bp + bj * 128) = pack8(x0, x1);
            q += ((x0[0] * x0[0] + x0[1] * x0[1]) + (x0[2] * x0[2] + x0[3] * x0[3])) + ((x1[0] * x1[0] + x1[1] * x1[1]) + (x1[2] * x1[2] + x1[3] * x1[3])); }
        q += __shfl_xor(q, 16); q += __shfl_xor(q, 32);
        if (fq == 0) red[(rin0 + ai * 128 + m * 16) * 4 + wc] = q; }
      asm volatile("" ::: "memory"); }
    asm volatile("s_waitcnt lgkmcnt(0)" ::: "memory"); __builtin_amdgcn_s_barrier(); asm volatile("" ::: "memory");
    int t = threadIdx.x; asm volatile("" : "+v"(t));
    if (t < (HALFM ? 128 : 256)) { const f32x4 v = *(const LAS f32x4*)(red + t * 4); const float q = (v[0] + v[1]) + (v[2] + v[3]); float* sp = SS + (size_t)(u.pm * (HALFM ? 128 : 256) + t) * 8;
      if (HALFN) sp[u.pn] = q; else *(f32x2*)(sp + 2 * u.pn) = (f32x2){q, 0.f}; }
  }
};

typedef EpiResT<false> EpiRes;

DI float dpp_ror1(float v) { return __builtin_bit_cast(float, __builtin_amdgcn_update_dpp(0, __builtin_bit_cast(int, v), 0x121, 0xf, 0xf, false)); }
DI float dpp_ror2(float v) { return __builtin_bit_cast(float, __builtin_amdgcn_update_dpp(0, __builtin_bit_cast(int, v), 0x122, 0xf, 0xf, false)); }
DI float gelu_mul(float x, float uv) {
  const float t = __builtin_fmaf(x * x, 2.0f * LOG2E * 0.7978845608028654f * 0.044715f, 2.0f * LOG2E * 0.7978845608028654f);
  const float r = fast_rcp(fast_exp2(x * t) + 1.0f);
  return __builtin_fmaf(-x, r, x) * uv;
}
constexpr size_t SIDE_ROWS = (size_t)72 * 2 * DFF;
template <bool HALFM> struct EpiP5FT {
  static constexpr bool PERM = true, HAS_MID = false, HAS_RS = true;
  const float* SS; bf16_t* HF; float* out; const float* cw; const float* cb; const float* st; float* side; LAS unsigned char* lds; int layer;
  DI void mid(f32x4 (&)[2][2][4][2], const Unit&, int, int, int, int, int) const {}
  DI f32x4 prefetch(const Unit& u, int tid) const {
    f32x4 v = {0.f, 0.f, 0.f, 0.f};
    if (tid < (HALFM ? 128 : 256)) v = ss_load(SS, u.pm * (HALFM ? 128 : 256) + tid);
    else if (tid >= 256 && tid < 384) { int j = tid - 256; asm volatile("" : "+v"(j));
      const int arr = j >> 5, c4 = (j & 31) * 4; v = *(const f32x4*)((arr < 3 ? cw + arr * DFF : cb) + u.pn * 128 + c4); }
    return v;
  }
  DI void stash(const f32x4& v, const Unit& u, int tid, LAS unsigned char* l) const {
    if (tid < (HALFM ? 128 : 256)) *(LAS float*)(l + 131072 + 12288 + tid * 4) = ss_to_rs(v);
    else if (tid >= 256 && tid < 384) *(LAS f32x4*)(l + 131072 + 13312 + (tid - 256) * 16) = v;
  }
  DI void operator()(f32x4 (&acc)[2][2][4][2], const Unit& u, int wr, int wc, int fr_in, int fq_in) const {
    int fr = fr_in, fq = fq_in; asm volatile("" : "+v"(fr), "+v"(fq));
    const int rin0 = wr * 64 + fr, col0 = u.pn * 128 + wc * 32 + 8 * fq;
    const bool sample = HALFM ? true : u.pm >= 64, cont = !sample && (u.pm & 15) != 0;
    const int bd0 = HALFM ? (u.pm - TOKP / 128) * 2 : (u.pm - 64) * 4;
    LAS float* xh = (LAS float*)(lds + 131072);
    float* TAILG = side; float* HEADC = side + SIDE_ROWS; float* HEADU = side + 2 * SIDE_ROWS;
#pragma unroll
    for (int ai = 0; ai < (HALFM ? 1 : 2); ++ai)
#pragma unroll
      for (int m = 0; m < 4; ++m) { const float s = *(const LAS float*)(lds + 131072 + 12288 + (rin0 + ai * 128 + m * 16) * 4);
#pragma unroll
        for (int n = 0; n < 2; ++n) { acc[ai][0][m][n] *= s; acc[ai][1][m][n] *= s; } }
    if (fr >= 14) {
#pragma unroll
      for (int ai = 0; ai < (HALFM ? 1 : 2); ++ai) { const int gidx = 2 * ai + wr; LAS float* xp = xh + ((gidx * 4 + wc) * 2 + (fr - 14)) * 32 + fq * 8;
        *(LAS f32x4*)xp = acc[ai][0][3][0]; *(LAS f32x4*)(xp + 4) = acc[ai][0][3][1];
        float* cp = nullptr;
        if (sample) cp = out + O_SCONV + ((size_t)(layer * DB + bd0 + gidx) * 2 + (fr - 14)) * DFF + col0;
        else if (gidx == 3) { float* tp = TAILG + ((size_t)u.pm * 2 + (fr - 14)) * DFF + col0; *(f32x4*)tp = acc[ai][0][3][0]; *(f32x4*)(tp + 4) = acc[ai][0][3][1];
          if ((u.pm & 15) == 15) cp = out + O_PCONV + ((size_t)(layer * 4 + (u.pm >> 4)) * 2 + (fr - 14)) * DFF + col0; }
        if (cp) { *(f32x4*)cp = acc[ai][0][3][0]; *(f32x4*)(cp + 4) = acc[ai][0][3][1]; } }
    }
    asm volatile("s_waitcnt lgkmcnt(0)" ::: "memory"); __builtin_amdgcn_s_barrier(); asm volatile("" ::: "memory");
#pragma unroll
    for (int n = 0; n < 2; ++n) {
      const LAS float* cl = (const LAS float*)(lds + 131072 + 13312) + wc * 32 + 8 * fq + 4 * n;
      const f32x4 w0 = *(const LAS f32x4*)cl, w1 = *(const LAS f32x4*)(cl + 128), w2 = *(const LAS f32x4*)(cl + 256), bb = *(const LAS f32x4*)(cl + 384);
#pragma unroll
      for (int ai = 0; ai < (HALFM ? 1 : 2); ++ai) { const int gidx = 2 * ai + wr;
        f32x4 gp = {0.f, 0.f, 0.f, 0.f};
        if (fr >= 14) {
          if (sample) gp = *(const f32x4*)(st + ((size_t)(bd0 + gidx) * 2 + (fr - 14)) * DFF + col0 + 4 * n);
          else if (gidx > 0) gp = *(const LAS f32x4*)(xh + (((gidx - 1) * 4 + wc) * 2 + (fr - 14)) * 32 + fq * 8 + 4 * n);
        }
#pragma unroll
        for (int m = 0; m < 4; ++m) { const int rin = rin0 + ai * 128 + m * 16; f32x4 o, cc;
#pragma unroll
          for (int j = 0; j < 4; ++j) { const float g = acc[ai][0][m][n][j], gq = gp[j];
            const float r1g = dpp_ror1(g), r1q = dpp_ror1(gq), r2g = dpp_ror2(g), r2q = dpp_ror2(gq);
            const float p1 = fr >= 1 ? r1g : r1q, p2 = fr >= 2 ? r2g : r2q;
            const float c = __builtin_fmaf(w2[j], g, __builtin_fmaf(w1[j], p1, __builtin_fmaf(w0[j], p2, bb[j])));
            cc[j] = c; o[j] = gelu_mul(c, acc[ai][1][m][n][j]); }
          *(u32x2*)(HF + (size_t)(u.pm * (HALFM ? 128 : 256) + rin) * DFF + col0 + 4 * n) = pack4(o);
          if (cont && gidx == 0 && m == 0 && fr < 2) { *(f32x4*)(HEADC + ((size_t)u.pm * 2 + fr) * DFF + col0 + 4 * n) = cc; *(f32x4*)(HEADU + ((size_t)u.pm * 2 + fr) * DFF + col0 + 4 * n) = acc[ai][1][m][n]; }
          gp = acc[ai][0][m][n]; }
      }
    }
  }
};
typedef EpiP5FT<false> EpiP5F;
DI void p6_fixup_panel(int pm, const float* side, const float* cw, bf16_t* HF) {
  const float* TAILG = side + (size_t)(pm - 1) * 2 * DFF; const float* HEADC = side + SIDE_ROWS + (size_t)pm * 2 * DFF; const float* HEADU = side + 2 * SIDE_ROWS + (size_t)pm * 2 * DFF;
  int tid_ = threadIdx.x; asm volatile("" : "+v"(tid_));
  constexpr int NIT = (DFF + NTHREADS - 1) / NTHREADS;
  float t0[NIT], t1[NIT], a0[NIT], a1[NIT], hc0[NIT], hc1[NIT], hu0[NIT], hu1[NIT];
#pragma unroll
  for (int i = 0; i < NIT; ++i) { const int k = tid_ + i * NTHREADS; const int kk = k < DFF ? k : 0;
    t0[i] = TAILG[kk]; t1[i] = TAILG[DFF + kk]; a0[i] = cw[kk]; a1[i] = cw[DFF + kk]; hc0[i] = HEADC[kk]; hc1[i] = HEADC[DFF + kk]; hu0[i] = HEADU[kk]; hu1[i] = HEADU[DFF + kk]; }
#pragma unroll
  for (int i = 0; i < NIT; ++i) { const int k = tid_ + i * NTHREADS;
    const float c0 = hc0[i] + a0[i] * t0[i] + a1[i] * t1[i], c1 = hc1[i] + a0[i] * t1[i];
    const float h0 = gelu_mul(c0, hu0[i]), h1 = gelu_mul(c1, hu1[i]);
    f32x4 v = {h0, h1, 0.f, 0.f}; const u32x2 pk = pack4(v);
    if (k < DFF) { HF[(size_t)(pm * 256) * DFF + k] = (bf16_t)(pk[0] & 0xffffu); HF[(size_t)(pm * 256 + 1) * DFF + k] = (bf16_t)(pk[0] >> 16); } }
}

struct EpiNull {
  static constexpr bool PERM = true, HAS_MID = false, HAS_RS = false;
  DI void mid(f32x4 (&)[2][2][4][2], const Unit&, int, int, int, int, int) const {}
  DI void operator()(f32x4 (&acc)[2][2][4][2], const Unit& u, int wr, int wc, int fr, int fq) const {
#pragma unroll
    for (int ai = 0; ai < 2; ++ai)
#pragma unroll
      for (int bj = 0; bj < 2; ++bj)
#pragma unroll
        for (int m = 0; m < 4; ++m)
#pragma unroll
          for (int n = 0; n < 2; ++n) asm volatile("" :: "v"(acc[ai][bj][m][n]));
  }
};

DI float gelu_tanh(float x) {
  const float y = 0.7978845608028654f * (x + 0.044715f * x * x * x);
  const float e = fast_exp2(2.0f * LOG2E * y);
  const float th = 1.0f - 2.0f * fast_rcp(e + 1.0f);
  return 0.5f * x * (1.0f + th);
}
DI void pfinal_norm(const Params& p) {
  const float* X32 = (const float*)(p.ws + WS_X32); const float* SS = (const float*)(p.ws + WS_SS);
  int tid_ = threadIdx.x; asm volatile("" : "+v"(tid_));
  const int lane = tid_ & 63, gw = blockIdx.x * 8 + (tid_ >> 6), NGW = gridDim.x * 8;
#pragma unroll 3
  for (int m = gw; m < TOK; m += NGW) { const float s = row_rs(SS, m);
#pragma unroll
    for (int j = 0; j < 4; ++j) { const f32x4 v = ((const f32x4*)(X32 + (size_t)m * D))[lane + 64 * j], g = ((const f32x4*)p.norm_final)[lane + 64 * j];
      __builtin_nontemporal_store(v * s * g, (f32x4*)(p.out + (size_t)m * D) + lane + 64 * j); } }
}

DI pg8::GemmDesc p1_desc(unsigned char* ws, int l) {
  return pg8::GemmDesc{(const char*)(ws + WS_XB), (const char*)(ws + WS_WIN) + (size_t)l * INC * D * 2, D, D, D / 64, (size_t)256 * D * 2, (size_t)128 * D * 2};
}
DI EpiP1 p1_epi(const Params& p, int l, LAS unsigned char* lds) {
  return EpiP1{(const float*)(p.ws + WS_SS), (bf16_t*)(p.ws + WS_QKV), (bf16_t*)(p.ws + WS_GATE), p.b_gate + (size_t)l * 3 * D, p.out, l, 0, lds};
}
namespace attn {
constexpr int N_CPY = 64, N_CS = 128, N_CP = 512, N_AP = 512, N_BP = 512, N_AS = 256, N_BS = 256, NITEMS = N_CPY + N_CS + N_CP + N_AP + N_BP + N_AS + N_BS;
constexpr float STICK_DONE = 8.75651e-27f;

struct Item { int mode, h, tok0, past, q0, nqv, pflags; const float* cK; const float* cV; };

DI Item decode(const Params& p, int layer, int idx) {
  Item it; it.cK = nullptr; it.cV = nullptr; it.past = 0; it.pflags = 0;
  if (idx < N_CPY) { it.mode = 3; it.h = idx; return it; }
  idx -= N_CPY;
  if (idx < N_CS) { const int bd = idx >> 2, h = idx & 3; it.mode = 2; it.h = h; it.tok0 = TOKP + bd * 64; it.past = PAST; it.q0 = PAST; it.nqv = 64;
    it.cK = p.cache_c_k + (size_t)(layer * DB + bd) * PAST * 512 + h * 128; it.cV = p.cache_c_v + (size_t)(layer * DB + bd) * PAST * 512 + h * 128; return it; }
  idx -= N_CS;
  if (idx < N_CP) { const int jj = 31 - (idx >> 4), rem = idx & 15; it.mode = 2; it.h = rem & 3; it.tok0 = (rem >> 2) * SEQ; it.q0 = jj * 128; it.nqv = 128; return it; }
  idx -= N_CP;
  if (idx < N_AP + N_BP) { const int isb = idx >= N_AP; if (isb) idx -= N_AP; const int qt = 15 - (idx >> 5), rem = idx & 31; it.mode = isb; it.h = rem & 7; it.tok0 = (rem >> 3) * SEQ; it.q0 = qt * 256; it.nqv = 256; return it; }
  idx -= N_AP + N_BP;
  if (idx < N_AS) { const int bd = idx >> 3, h = idx & 7; it.mode = 0; it.h = h; it.tok0 = TOKP + bd * 64; it.past = ALEN; it.q0 = ALEN; it.nqv = 64;
    it.cK = p.cache_a_k + (size_t)(layer * DB + bd) * ALEN * 512 + h * 64; it.cV = p.cache_a_v + (size_t)(layer * DB + bd) * ALEN * 512 + h * 64; return it; }
  idx -= N_AS;
  { const int bd = idx >> 3, h = idx & 7; it.mode = 1; it.h = h; it.tok0 = TOKP + bd * 64; it.past = PAST; it.q0 = PAST; it.nqv = 64;
    it.cK = p.cache_b_k + (size_t)(layer * DB + bd) * PAST * 512 + h * 64; it.cV = p.cache_b_v + (size_t)(layer * DB + bd) * PAST * 512 + h * 64; return it; }
}


template <int MODE, bool SAMPLE>
DI void load_piece(u32x4& r0, u32x4& r1, u32x4& r2, u32x4& r3, const Item& it, const float* cache, const bf16_t* QKV, int col, int kt, int tid) {
  constexpr int CPR = MODE == 2 ? 16 : 8;
  const int j0 = kt * 64;
  const int ra = tid / CPR, ca = tid % CPR;
  if (SAMPLE && j0 < it.past) {
    const unsigned lo = (unsigned)(ra * 512 + ca * 8) * 4u; const char* b = (const char*)(cache + (size_t)j0 * 512);
    { const u32x4* q = (const u32x4*)(b + lo); r0 = q[0]; r1 = q[1]; }
    if constexpr (MODE == 2) { const u32x4* q = (const u32x4*)(b + (size_t)32 * 512 * 4 + lo); r2 = q[0]; r3 = q[1]; }
  } else {
    const unsigned lo = (unsigned)(ra * QKVW + ca * 8) * 2u; const char* b = (const char*)(QKV + (size_t)(it.tok0 + j0 - it.past) * QKVW + col);
    r0 = *(const u32x4*)(b + lo);
    if constexpr (MODE == 2) r2 = *(const u32x4*)(b + (size_t)32 * QKVW * 2 + lo);
  }
}
DI u32x4 cvt8(u32x4 a, u32x4 b) { return pack8(__builtin_bit_cast(f32x4, a), __builtin_bit_cast(f32x4, b)); }
template <int MODE, bool ISK, bool SAMPLE>
DI void write_piece(const u32x4& r0, const u32x4& r1, const u32x4& r2, const u32x4& r3, const Item& it, LAS unsigned char* buf, int kt, int tid) {
  constexpr int CPR = MODE == 2 ? 16 : 8, VS = MODE == 2 ? 320 : 192;
  const bool f32src = SAMPLE && kt * 64 < it.past;
  const int ra = tid / CPR, ca = tid % CPR, rb = (tid + NTHREADS) / CPR, cb = (tid + NTHREADS) % CPR;
  { const u32x4 x = f32src ? cvt8(r0, r1) : r0;
    if (ISK) *(LAS u32x4*)(buf + ((MODE == 2 && ca >= 8) ? 8192 : 0) + ra * 128 + (((ca & 7) ^ ((ra >> 1) & 7)) << 4)) = x;
    else *(LAS u32x4*)(buf + ra * VS + ca * 16) = x; }
  if constexpr (MODE == 2) { const u32x4 x = f32src ? cvt8(r2, r3) : r2;
    if (ISK) *(LAS u32x4*)(buf + (cb >= 8 ? 8192 : 0) + rb * 128 + (((cb & 7) ^ ((rb >> 1) & 7)) << 4)) = x;
    else *(LAS u32x4*)(buf + rb * VS + cb * 16) = x; }
}

template <int MODE>
DI void state_store(const u32x4& r0, const u32x4& r2, float* dst, int tid) {
  constexpr int CPR = MODE == 2 ? 16 : 8;
  const int ra = tid / CPR, ca = tid % CPR, rb = (tid + NTHREADS) / CPR, cb = (tid + NTHREADS) % CPR;
  { float* q = dst + (size_t)ra * 512 + ca * 8;
    __builtin_nontemporal_store((f32x4){bflo(r0[0]), bfhi(r0[0]), bflo(r0[1]), bfhi(r0[1])}, (f32x4*)q); __builtin_nontemporal_store((f32x4){bflo(r0[2]), bfhi(r0[2]), bflo(r0[3]), bfhi(r0[3])}, (f32x4*)(q + 4)); }
  if constexpr (MODE == 2) { float* q = dst + (size_t)rb * 512 + cb * 8;
    __builtin_nontemporal_store((f32x4){bflo(r2[0]), bfhi(r2[0]), bflo(r2[1]), bfhi(r2[1])}, (f32x4*)q); __builtin_nontemporal_store((f32x4){bflo(r2[2]), bfhi(r2[2]), bflo(r2[3]), bfhi(r2[3])}, (f32x4*)(q + 4)); }
}
template <int MODE>
DI float* state_dst(const Params& p, int layer, const Item& it, int kt, int isv) {
  const int hoff = MODE == 2 ? it.h * 128 : it.h * 64;
  if (it.past == 0) {
    const int t0 = kt * 64; if (t0 < it.q0 || t0 >= it.q0 + it.nqv) return nullptr;
    const int b = it.tok0 / SEQ;
    if (MODE == 0) { if (t0 < SEQ - 512) return nullptr; return p.out + (isv ? O_PAV : O_PAK) + ((size_t)(layer * 4 + b) * 512 + (t0 - (SEQ - 512))) * 512 + hoff; }
    return p.out + (MODE == 1 ? (isv ? O_PBV : O_PBK) : (isv ? O_PCV : O_PCK)) + ((size_t)(layer * 4 + b) * SEQ + t0) * 512 + hoff;
  } else {
    if (kt * 64 != it.past) return nullptr;
    const int bd = (it.tok0 - TOKP) / 64;
    if (MODE == 0) return p.out + (isv ? O_SAV : O_SAK) + ((size_t)(layer * DB + bd) * 512 + 448) * 512 + hoff;
    return p.out + (MODE == 1 ? (isv ? O_SBV : O_SBK) : (isv ? O_SCV : O_SCK)) + ((size_t)(layer * DB + bd) * 64) * 512 + hoff;
  }
}

DI bf16x8 pack_p(const f32x16& x, int s) {
  const f32x4 a = {x[8 * s], x[8 * s + 1], x[8 * s + 2], x[8 * s + 3]}, b = {x[8 * s + 4], x[8 * s + 5], x[8 * s + 6], x[8 * s + 7]};
  return __builtin_bit_cast(bf16x8, pack8(a, b));
}
#define MFMA32(a, b, c) __builtin_amdgcn_mfma_f32_32x32x16_bf16((a), (b), (c), 0, 0, 0)

constexpr int L_KB = 0, KB_BYTES = 16384, L_VB = 32768, VB_BYTES = 20480, L_LUT = 73728, L_FLAGS = 75776, L_XCH = 81920;

template <int MODE, bool SAMPLE>
DI void run_item(const Params& p, int layer, const Item& it, LAS unsigned char* lds_in) {
  LAS unsigned char* lds = opaque_lds(lds_in);
  constexpr int NDV = MODE == 2 ? 4 : 2, VS = MODE == 2 ? 320 : 192;
  int tid_ = threadIdx.x; asm volatile("" : "+v"(tid_));
  const int tid = tid_, lane = tid & 63, wave = __builtin_amdgcn_readfirstlane(tid >> 6);
  const int qi = lane & 31, h2 = lane >> 5;
  const int mp = MODE == 2 ? (wave >> 2) : 0, wrow = MODE == 2 ? (wave & 3) : wave;
  const int q0w = it.q0 + 32 * wrow;
  const bool active = 32 * wrow < it.nqv;
  const bf16_t* QKV = (const bf16_t*)(p.ws + WS_QKV);
  const int hb = MODE == 2 ? it.h * 128 : it.h * 64;
  const int qcol = (MODE == 0 ? 0 : MODE == 1 ? 1536 : 3072) + hb + 64 * mp, kcol = (MODE == 0 ? 512 : MODE == 1 ? 2048 : 3584) + hb, vcol = (MODE == 0 ? 1024 : MODE == 1 ? 2560 : 4096) + hb;
  const int cw = q0w >> 6;
  int kt_first, step, NT;
  if (MODE == 0) { kt_first = (it.q0 >> 6) - 8; if (kt_first < 0) kt_first = 0; step = 1; NT = ((it.q0 + it.nqv - 1) >> 6) - kt_first + 1; }
  else if (MODE == 2) { kt_first = 0; step = 1; NT = ((it.q0 + it.nqv - 1) >> 6) + 1; }
  else { kt_first = (it.q0 + it.nqv - 2) >> 6; step = -1; NT = kt_first + 1; }
  const bool wr_state = it.pflags == 0;
  u32x4 k0 = {}, k1 = {}, k2 = {}, k3 = {}, v0 = {}, v1 = {}, v2 = {}, v3 = {};
  load_piece<MODE, SAMPLE>(k0, k1, k2, k3, it, it.cK, QKV, kcol, kt_first, tid);
  load_piece<MODE, SAMPLE>(v0, v1, v2, v3, it, it.cV, QKV, vcol, kt_first, tid);
  LAS float* lut = (LAS float*)(lds + L_LUT);
  LAS unsigned* flags = (LAS unsigned*)(lds + L_FLAGS);
  if (MODE == 0) { const float bfar = p.a_rel_bias[((size_t)layer * 257 + 256) * 8 + it.h]; for (int i = tid; i < 257; i += NTHREADS) lut[i] = p.a_rel_bias[((size_t)layer * 257 + i) * 8 + it.h] - bfar; }
  if (MODE == 2) { if (tid < 192) lut[tid] = ((const float*)(p.ws + WS_CTL))[CW_T5 + it.h * 192 + tid]; }
  bf16x8 qf[4];
  if (active) { const bf16_t* qp = QKV + (size_t)(it.tok0 + q0w + qi - it.past) * QKVW + qcol + 8 * h2;
#pragma unroll
    for (int s = 0; s < 4; ++s) { const u32x4 w = *(const u32x4*)(qp + 16 * s);
      const f32x4 a = {bflo(w[0]) * 0.125f, bfhi(w[0]) * 0.125f, bflo(w[1]) * 0.125f, bfhi(w[1]) * 0.125f}, b = {bflo(w[2]) * 0.125f, bfhi(w[2]) * 0.125f, bflo(w[3]) * 0.125f, bfhi(w[3]) * 0.125f};
      qf[s] = __builtin_bit_cast(bf16x8, pack8(a, b)); } }
  f32x16 O[NDV];
#pragma unroll
  for (int b = 0; b < NDV; ++b)
#pragma unroll
    for (int i = 0; i < 16; ++i) O[b][i] = 0.f;
  float m_run = -1e30f, l_run = 0.f, R2 = 1.0f; bool done = false, have_p = false;
  bf16x8 pf[4];
#pragma unroll
  for (int s = 0; s < 4; ++s) pf[s] = (bf16x8){0, 0, 0, 0, 0, 0, 0, 0};
  const int krow_off = qi * 128, kswz = (qi >> 1) & 7;
  const int g16 = lane >> 4, trq = (lane & 15) >> 2, trp = lane & 3;
  const int vtr_off = (4 * (g16 >> 1) + trq) * VS + (16 * (g16 & 1) + 4 * trp) * 2;

  write_piece<MODE, true, SAMPLE>(k0, k1, k2, k3, it, lds + L_KB, kt_first, tid);
  if (wr_state) { float* d = state_dst<MODE>(p, layer, it, kt_first, 0); if (d) state_store<MODE>(k0, k2, d, tid); }
  if (NT > 1) load_piece<MODE, SAMPLE>(k0, k1, k2, k3, it, it.cK, QKV, kcol, kt_first + step, tid);
  for (int t = 0;; ++t) {
    __syncthreads();
    if (MODE == 1 && t > 0 && t < NT) { const unsigned any = flags[0] | flags[1] | flags[2] | flags[3] | flags[4] | flags[5] | flags[6] | flags[7]; if (!any) NT = t; }
    const int kt = kt_first + step * t;
    bool mine = false;
    if (t < NT && !(it.pflags & 2)) {
      if (MODE == 0) mine = active && kt >= cw - 8 && kt <= cw;
      else if (MODE == 2) mine = active && kt <= cw;
      else mine = active && !done && kt * 64 <= q0w + 30;
    }
    LAS unsigned char* vb = lds + L_VB + ((t - 1) & 1) * VB_BYTES + vtr_off;
    LAS unsigned char* kb = lds + L_KB + (t & 1) * KB_BYTES + ((MODE == 2 && mp) ? 8192 : 0);
    constexpr int HB = NDV / 2, NST = 4 * HB;
    bf16x8 kfa[4], vfa[2], vfb[2];
    const bool do_pv = have_p && !(it.pflags & 8);
#define V_LOAD(dst, j_) do { if (do_pv) { _Pragma("unroll") for (int bb = 0; bb < 2; ++bb) { const int a0 = 16 * ((j_) / HB) * VS + 64 * (2 * ((j_) % HB) + bb); \
      const s16x4 lo = __builtin_amdgcn_ds_read_tr16_b64_v4i16((LAS s16x4*)(vb + a0)), hi = __builtin_amdgcn_ds_read_tr16_b64_v4i16((LAS s16x4*)(vb + a0 + 8 * VS)); \
      dst[bb] = __builtin_shufflevector(lo, hi, 0, 1, 2, 3, 4, 5, 6, 7); } } } while (0)
#define V_MMA(src, j_) do { if (do_pv) { _Pragma("unroll") for (int bb = 0; bb < 2; ++bb) O[2 * ((j_) % HB) + bb] = MFMA32(src[bb], pf[(j_) / HB], O[2 * ((j_) % HB) + bb]); } } while (0)
#define STG(j_, cur, nxt) do { if (SAMPLE) { V_LOAD(cur, j_); V_MMA(cur, j_); } else { if ((j_) + 1 < NST) V_LOAD(nxt, (j_) + 1); V_MMA(cur, j_); } } while (0)
    if (!SAMPLE) {
      if (mine) {
#pragma unroll
        for (int s = 0; s < 4; ++s) kfa[s] = *(const LAS bf16x8*)(kb + krow_off + (((2 * s + h2) ^ kswz) << 4)); }
      V_LOAD(vfa, 0);
      __builtin_amdgcn_sched_barrier(0);
    }
    if (t < NT && !(it.pflags & 1)) { write_piece<MODE, false, SAMPLE>(v0, v1, v2, v3, it, lds + L_VB + (t & 1) * VB_BYTES, kt_first + step * t, tid);
      if (wr_state) { float* d = state_dst<MODE>(p, layer, it, kt_first + step * t, 1); if (d) state_store<MODE>(v0, v2, d, tid); }
      if (t + 1 < NT) { write_piece<MODE, true, SAMPLE>(k0, k1, k2, k3, it, lds + L_KB + ((t + 1) & 1) * KB_BYTES, kt_first + step * (t + 1), tid);
        if (wr_state) { float* d = state_dst<MODE>(p, layer, it, kt_first + step * (t + 1), 0); if (d) state_store<MODE>(k0, k2, d, tid); }
        load_piece<MODE, SAMPLE>(v0, v1, v2, v3, it, it.cV, QKV, vcol, kt_first + step * (t + 1), tid);
        if (t + 2 < NT) load_piece<MODE, SAMPLE>(k0, k1, k2, k3, it, it.cK, QKV, kcol, kt_first + step * (t + 2), tid); } }
    __builtin_amdgcn_sched_barrier(0);
    f32x16 sA, sB;
#pragma unroll
    for (int i = 0; i < 16; ++i) { sA[i] = 0.f; sB[i] = 0.f; }
    if (mine) {
      bf16x8 kfc[4];
      if (SAMPLE) {
#pragma unroll
        for (int s = 0; s < 4; ++s) kfa[s] = *(const LAS bf16x8*)(kb + krow_off + (((2 * s + h2) ^ kswz) << 4)); }
#pragma unroll
      for (int s = 0; s < 4; ++s) kfc[s] = *(const LAS bf16x8*)(kb + 4096 + krow_off + (((2 * s + h2) ^ kswz) << 4));
#pragma unroll
      for (int s = 0; s < 4; ++s) sA = MFMA32(kfa[s], qf[s], sA);
#pragma unroll
      for (int s = 0; s < 4; ++s) sB = MFMA32(kfc[s], qf[s], sB);
    }
    const int kbase = kt * 64 + 4 * h2;
    if (MODE != 1) {
      float mx = -1e30f, alpha = 1.0f, lsa = 0.f, lsb = 0.f; bool resc = false;
      const bool smx = mine && !(it.pflags & 4);
      STG(0, vfa, vfb);
      if (NST == 8) STG(1, vfb, vfa);
      if (smx) {
        bool cst;
        if (MODE == 0) cst = q0w - (kt * 64 + 63) >= 128; else cst = kt * 64 + 63 - q0w <= -127;
        if (!cst) {
#pragma unroll
          for (int i = 0; i < 16; ++i) { const int ko = (i & 3) + 8 * (i >> 2);
            int ia, ib;
            if (MODE == 0) { const int d = (q0w + qi) - (kbase + ko); ia = d; ib = d - 32; ia = (ia < -128 ? -128 : ia > 128 ? 128 : ia) + 128; ib = (ib < -128 ? -128 : ib > 128 ? 128 : ib) + 128; }
            else { const int d = (kbase + ko) - (q0w + qi); ia = d; ib = d + 32; ia = (ia < -127 ? -127 : ia > 63 ? 63 : ia) + 127; ib = (ib < -127 ? -127 : ib > 63 ? 63 : ib) + 127; }
            sA[i] += lut[ia]; sB[i] += lut[ib]; }
        }
        float m0 = fmaxf(fmaxf(sA[0], sA[1]), sA[2]), m1 = fmaxf(fmaxf(sB[0], sB[1]), sB[2]);
#pragma unroll
        for (int i = 3; i < 15; i += 2) { m0 = fmaxf(fmaxf(m0, sA[i]), sA[i + 1]); m1 = fmaxf(fmaxf(m1, sB[i]), sB[i + 1]); }
        mx = fmaxf(fmaxf(m0, m1), fmaxf(sA[15], sB[15]));
      }
      __builtin_amdgcn_sched_barrier(0);
      if (NST == 8) { STG(2, vfa, vfb); STG(3, vfb, vfa); } else STG(1, vfb, vfa);
      if (smx) {
        mx = fmaxf(mx, __shfl_xor(mx, 32)) * LOG2E;
        resc = !__all(mx <= m_run + 8.0f);
        if (resc) { const float mnew = fmaxf(m_run, mx); alpha = fast_exp2(m_run - mnew); m_run = mnew; l_run *= alpha; }
#pragma unroll
        for (int i = 0; i < 16; ++i) { sA[i] = fast_exp2(__builtin_fmaf(sA[i], LOG2E, -m_run)); lsa += sA[i]; }
      }
      __builtin_amdgcn_sched_barrier(0);
      if (NST == 8) { STG(4, vfa, vfb); STG(5, vfb, vfa); } else STG(2, vfa, vfb);
      if (smx) {
#pragma unroll
        for (int i = 0; i < 16; ++i) { sB[i] = fast_exp2(__builtin_fmaf(sB[i], LOG2E, -m_run)); lsb += sB[i]; }
        l_run += lsa + lsb;
      }
      __builtin_amdgcn_sched_barrier(0);
      if (NST == 8) { STG(6, vfa, vfb); STG(7, vfb, vfa); } else STG(3, vfb, vfa);
      __builtin_amdgcn_sched_barrier(0);
      if (mine) {
        if (resc) {
#pragma unroll
        for (int b = 0; b < NDV; ++b)
#pragma unroll
          for (int i = 0; i < 16; ++i) O[b][i] *= alpha;
        }
        pf[0] = pack_p(sA, 0); pf[1] = pack_p(sA, 1); pf[2] = pack_p(sB, 0); pf[3] = pack_p(sB, 1);
      }
    } else {
      STG(0, vfa, vfb); STG(1, vfb, vfa); STG(2, vfa, vfb); STG(3, vfb, vfa);
      if (mine) {
        const bool diag = kt * 64 + 63 >= q0w;
        float kpA[16], kpB[16];
#pragma unroll
        for (int i = 0; i < 16; ++i) { const int ko = (i & 3) + 8 * (i >> 2);
          { const float r = fast_rcp(1.0f + fast_exp2(sA[i] * LOG2E)); const bool ok = !diag || (kbase + ko) < (q0w + qi); kpA[i] = ok ? r : 1.0f; sA[i] = ok ? 1.0f - r : 0.0f; }
          { const float r = fast_rcp(1.0f + fast_exp2(sB[i] * LOG2E)); const bool ok = !diag || (kbase + 32 + ko) < (q0w + qi); kpB[i] = ok ? r : 1.0f; sB[i] = ok ? 1.0f - r : 0.0f; } }
        float gs[8], pg[8];
#pragma unroll
        for (int g = 0; g < 4; ++g) { gs[g] = (kpA[4 * g] * kpA[4 * g + 1]) * (kpA[4 * g + 2] * kpA[4 * g + 3]); gs[4 + g] = (kpB[4 * g] * kpB[4 * g + 1]) * (kpB[4 * g + 2] * kpB[4 * g + 3]); }
#pragma unroll
        for (int g = 0; g < 8; ++g) pg[g] = __shfl_xor(gs[g], 32);
        float suf = R2;
#pragma unroll
        for (int g = 7; g >= 0; --g) { const float off = suf * (h2 == 0 ? pg[g] : 1.0f);
          if (g >= 4) { const int b = 4 * (g - 4); const float a3 = off, a2 = a3 * kpB[b + 3], a1 = a2 * kpB[b + 2], a0 = a1 * kpB[b + 1];
            sB[b + 3] *= a3; sB[b + 2] *= a2; sB[b + 1] *= a1; sB[b] *= a0; }
          else { const int b = 4 * g; const float a3 = off, a2 = a3 * kpA[b + 3], a1 = a2 * kpA[b + 2], a0 = a1 * kpA[b + 1];
            sA[b + 3] *= a3; sA[b + 2] *= a2; sA[b + 1] *= a1; sA[b] *= a0; }
          suf *= gs[g] * pg[g]; }
        R2 = suf;
        done = __all(R2 < STICK_DONE) != 0;
        pf[0] = pack_p(sA, 0); pf[1] = pack_p(sA, 1); pf[2] = pack_p(sB, 0); pf[3] = pack_p(sB, 1);
      }
    }
#undef V_LOAD
#undef V_MMA
#undef STG
    have_p = mine;
    if (MODE == 1 && t < NT) { if (lane == 0) flags[wave] = (active && !done && kt > 0 && (kt - 1) * 64 <= q0w + 30) ? 1u : 0u; }
    if (t >= NT) break;
  }
  int lane_e = lane; asm volatile("" : "+v"(lane_e));
  const int qi_e = lane_e & 31, h2_e = lane_e >> 5;
  bf16_t* Ob = (bf16_t*)(p.ws + WS_O);
  const int ocol = MODE == 0 ? hb : MODE == 1 ? 512 + hb : 1024 + hb;
  const bool wr_out = it.pflags == 0;
  if (MODE != 2) {
    if (active && wr_out) { float sc = 1.f; if (MODE == 0) { const float lt = l_run + __shfl_xor(l_run, 32); sc = fast_rcp(lt); }
      bf16_t* op = Ob + (size_t)(it.tok0 + q0w + qi_e - it.past) * OW + ocol + 4 * h2_e;
#pragma unroll
      for (int b = 0; b < NDV; ++b)
#pragma unroll
        for (int g = 0; g < 4; ++g) { const f32x4 v = {O[b][4 * g] * sc, O[b][4 * g + 1] * sc, O[b][4 * g + 2] * sc, O[b][4 * g + 3] * sc}; *(u32x2*)(op + 32 * b + 8 * g) = pack4(v); } }
    __syncthreads();
  } else {
    const float lam = ((const float*)(p.ws + WS_CTL))[CW_LAM + layer];
    const float sub_scale = 1.0f - (0.8f - 0.6f * expf(-0.3f * (float)layer));
    LAS float* xch = (LAS float*)(lds + L_XCH);
    if (active && mp == 1) { const float lt = l_run + __shfl_xor(l_run, 32), sc = lam * fast_rcp(lt);
#pragma unroll
      for (int b = 0; b < NDV; ++b)
#pragma unroll
        for (int i = 0; i < 16; ++i) xch[((wave & 3) * 64 + b * 16 + i) * 64 + lane_e] = O[b][i] * sc; }
    __syncthreads();
    if (active && mp == 0 && wr_out) { const float lt = l_run + __shfl_xor(l_run, 32), sc = fast_rcp(lt); float q = 0.f;
#pragma unroll
      for (int b = 0; b < NDV; ++b)
#pragma unroll
        for (int i = 0; i < 16; ++i) { const float o = O[b][i] * sc - xch[((wave & 3) * 64 + b * 16 + i) * 64 + lane_e]; O[b][i] = o; q += o * o; if ((i & 7) == 7) __builtin_amdgcn_sched_barrier(0); }
      q += __shfl_xor(q, 32);
      const float rstd = __builtin_amdgcn_rsqf(q * (1.0f / 128.0f) + EPS) * sub_scale;
      const float* gain = p.c_subln + layer * 128 + 4 * h2_e;
      bf16_t* op = Ob + (size_t)(it.tok0 + q0w + qi_e - it.past) * OW + ocol + 4 * h2_e;
#pragma unroll
      for (int b = 0; b < NDV; ++b)
#pragma unroll
        for (int g = 0; g < 4; ++g) { const f32x4 gn = *(const f32x4*)(gain + 32 * b + 8 * g);
          const f32x4 v = {O[b][4 * g] * rstd * gn[0], O[b][4 * g + 1] * rstd * gn[1], O[b][4 * g + 2] * rstd * gn[2], O[b][4 * g + 3] * rstd * gn[3]}; *(u32x2*)(op + 32 * b + 8 * g) = pack4(v); } }
    __syncthreads();
  }
}

DI void copy_item(const Params& p, int layer, int idx) {
  const int which = idx >> 5, bd = idx & 31;
  const size_t lb = (size_t)layer * DB + bd;
  const f32x4* src = (const f32x4*)((which ? p.cache_a_v : p.cache_a_k) + lb * 512 * 512 + 64 * 512);
  f32x4* dst = (f32x4*)(p.out + (which ? O_SAV : O_SAK) + lb * 512 * 512);
  int tid_ = threadIdx.x; asm volatile("" : "+v"(tid_));
#pragma unroll 4
  for (int i = tid_; i < 448 * 128; i += NTHREADS) __builtin_nontemporal_store(__builtin_nontemporal_load(src + i), dst + i);
}
#ifndef PROBE_ATT_FLAGS
#define PROBE_ATT_FLAGS 0
#endif
#ifndef PROBE_ATT_LO
#define PROBE_ATT_LO 0
#define PROBE_ATT_HI NITEMS
#endif
DI void attn_phase(const Params& p, int qidx, LAS unsigned char* lds) {
  const int layer = qidx & 1; const int i_lo = qidx >= 2 ? PROBE_ATT_LO : 0, i_hi = qidx >= 2 ? PROBE_ATT_HI : NITEMS;
  unsigned* head = (unsigned*)(p.ws + WS_CTL) + CW_QUEUE + 64 * qidx;
  LAS unsigned* slot = (LAS unsigned*)(lds + LDS_BYTES - 48);
  if (threadIdx.x == 0) slot[0] = atomicAdd(head, 1u);
  for (int k = 0;; ++k) {
    __syncthreads();
    const int idx = __builtin_amdgcn_readfirstlane((int)slot[k & 1]) + i_lo;
    if (threadIdx.x == 0) slot[(k + 1) & 1] = atomicAdd(head, 1u);
    if (idx >= i_hi) break;
    Item it = decode(p, layer, idx); it.pflags = qidx >= 2 ? PROBE_ATT_FLAGS : 0;
    if (it.mode == 3) { if (qidx < 2) copy_item(p, layer, it.h); continue; }
    if (it.past == 0) { if (it.mode == 0) run_item<0, false>(p, layer, it, lds); else if (it.mode == 1) run_item<1, false>(p, layer, it, lds); else run_item<2, false>(p, layer, it, lds); }
    else { if (it.mode == 0) run_item<0, true>(p, layer, it, lds); else if (it.mode == 1) run_item<1, true>(p, layer, it, lds); else run_item<2, true>(p, layer, it, lds); }
  }
}
}
#define XB_TMO      128
#define XB_XCNT(j)  (256  + 64 * (j))
#define XB_XSUB(j)  (1280 + 64 * (j))
#define XB_XGEN(j)  (2304 + 64 * (j))
#define XB_TOP      3328
#define XB_TOPGEN   3392
#define XCD_BAR_WORDS 3456
#define XB_SPIN_CAP (1u << 18)
DI unsigned xb_ld(unsigned* p)              { return __hip_atomic_load(p, __ATOMIC_RELAXED, __HIP_MEMORY_SCOPE_AGENT); }
DI unsigned xb_add(unsigned* p, unsigned v) { return __hip_atomic_fetch_add(p, v, __ATOMIC_RELAXED, __HIP_MEMORY_SCOPE_AGENT); }
DI unsigned xb_xcc_id() { return (unsigned)__builtin_amdgcn_s_getreg((3 << 11) | 20) & 0xFu; }
#define XB_SPIN(cond, bar) do { unsigned _sp = 0; while (cond) { __builtin_amdgcn_s_sleep(1); \
    if ((++_sp & 255u) == 0u) { if (xb_ld(&(bar)[XB_TMO])) break; if (_sp > XB_SPIN_CAP) { atomicAdd(&(bar)[XB_TMO], 1u); break; } } } } while (0)
struct XcdBarrier { unsigned* bar; unsigned x; volatile LAS unsigned* st; };
DI XcdBarrier xcd_barrier_post(unsigned* bar, volatile LAS unsigned* st) {
  XcdBarrier b; b.bar = bar; b.x = xb_xcc_id(); b.st = st;
  if (threadIdx.x == 0) (void)xb_add(&bar[XB_XCNT(b.x)], 1u);
  return b;
}
DI void xcd_barrier_complete(unsigned* bar, unsigned x, unsigned& nloc, unsigned& nx) {
  const unsigned G = gridDim.x * gridDim.y * gridDim.z;
  unsigned sum, cnt, mine, sp = 0u;
  for (;;) {
    sum = 0u; cnt = 0u; mine = 0u;
#pragma unroll
    for (unsigned j = 0; j < 16; ++j) { const unsigned c = xb_ld(&bar[XB_XCNT(j)]); sum += c; cnt += (c > 0u) ? 1u : 0u; mine = (j == x) ? c : mine; }
    if (sum == G) break;
    __builtin_amdgcn_s_sleep(1);
    if ((++sp & 255u) == 0u) { if (xb_ld(&bar[XB_TMO])) break; if (sp > XB_SPIN_CAP) { atomicAdd(&bar[XB_TMO], 1u); break; } }
  }
  nloc = mine > 0u ? mine : 1u; nx = cnt > 0u ? cnt : 1u;
}
DI void xcd_barrier(const XcdBarrier& b) {
  asm volatile("s_waitcnt vmcnt(0)" ::: "memory");
  __syncthreads();
  if (threadIdx.x == 0) {
    unsigned* bar = b.bar;
    __builtin_amdgcn_s_waitcnt(0);
    unsigned nloc = b.st[0], nx = b.st[1];
    if (nloc == 0u) { xcd_barrier_complete(bar, b.x, nloc, nx); b.st[0] = nloc; b.st[1] = nx; }
    const unsigned old = xb_add(&bar[XB_XSUB(b.x)], 1u);
    const unsigned gen = old / nloc;
    if (old + 1u == (gen + 1u) * nloc) {
      __builtin_amdgcn_fence(__ATOMIC_RELEASE, "agent");
      asm volatile("s_waitcnt vmcnt(0)" ::: "memory");
      const unsigned og = xb_add(&bar[XB_TOP], 1u);
      const unsigned tg = og / nx;
      if (og + 1u == (tg + 1u) * nx) xb_add(&bar[XB_TOPGEN], 1u);
      else XB_SPIN(xb_ld(&bar[XB_TOPGEN]) == tg, bar);
      __builtin_amdgcn_fence(__ATOMIC_ACQUIRE, "agent");
      xb_add(&bar[XB_XGEN(b.x)], 1u);
      asm volatile("s_waitcnt vmcnt(0)" ::: "memory");
    } else {
      XB_SPIN(xb_ld(&bar[XB_XGEN(b.x)]) == gen, bar);
      __builtin_amdgcn_fence(__ATOMIC_ACQUIRE, "agent");
      asm volatile("s_waitcnt vmcnt(0)" ::: "memory");
    }
  }
  __syncthreads();
}
constexpr int L_BARST = LDS_BYTES - 64;

#ifndef PROBE_P1_FLAGS
#define PROBE_P1_FLAGS 0
#endif
#ifndef PROBE_NULL_EPI
#define PROBE_NULL_EPI 0
#endif
#ifndef PROBE_MASK
#define PROBE_MASK 0
#endif
#define REPEAT(k) for (int rep_ = 0; rep_ < (((PROBE_MASK >> (k)) & 1) ? 2 : 1); ++rep_)
constexpr int NPHASE = 2 + 6 * NLAYER;
__global__ void __launch_bounds__(NTHREADS, 2) fwd_megakernel(Params p_k) {
  extern __shared__ __attribute__((aligned(16))) unsigned char lds_raw[];
  LAS unsigned char* lds = (LAS unsigned char*)lds_raw;
  cg::grid_group grid = cg::this_grid();
  const int lo = p_k.ph_lo, hi = p_k.ph_hi;
#define IN(k) (lo <= (k) && (k) < hi)
#define SEAM(k) do { if (IN(k) && IN((k) + 1)) xcd_barrier(bar); } while (0)
  const int G = gridDim.x, c = blockIdx.x;
  if (threadIdx.x < 2) ((LAS unsigned*)(lds + L_BARST))[threadIdx.x] = 0u;
  XcdBarrier bar; bar.bar = (unsigned*)(p_k.ws + WS_CTL) + CW_BAR; bar.x = 0; bar.st = (volatile LAS unsigned*)(lds + L_BARST);
  if (p_k.ph_lo < 0) grid.sync();
  bar = xcd_barrier_post((unsigned*)(p_k.ws + WS_CTL) + CW_BAR, (volatile LAS unsigned*)(lds + L_BARST));
  if (IN(0)) { p0_prologue(p_k, lds); if ((PROBE_MASK >> 6) & 1) { __syncthreads(); p0_prologue(p_k, lds); } }
  SEAM(0);
  for (int l = 0; l < NLAYER; ++l) {
    const int pb = 1 + 6 * l;
    const Params& p = p_k; unsigned char* ws = p.ws;
    if (IN(pb + 0)) REPEAT(0) {
      pg8::GemmDesc g{(const char*)(ws + WS_XB), (const char*)(ws + WS_WIN) + (size_t)l * INC * D * 2, D, D, D / 64, (size_t)256 * D * 2, (size_t)128 * D * 2};
      pg8::P1Order S; S.R1.init(TOK / 256, pg8::P1_NN, G, c);
      EpiP1 E{(const float*)(ws + WS_SS), (bf16_t*)(ws + WS_QKV), (bf16_t*)(ws + WS_GATE), p.b_gate + (size_t)l * 3 * D, p.out, l, rep_ == 1 ? PROBE_P1_FLAGS : 0, lds};
#if PROBE_NULL_EPI
      if (rep_ == 1) { EpiNull EN; pg8::gemm_phase<EpiNull, false, false, pg8::P1Order>(lds, g, S, EN); } else
#endif
      pg8::gemm_phase<EpiP1, false, false, pg8::P1Order>(lds, g, S, E);
    }
    SEAM(pb + 0);
    if (IN(pb + 1)) REPEAT(1) {
      for (int j = G - 1 - c; j < pg8::P1_DEFER; j += G) { pg8::OneUnit S1; S1.u = pg8::p1_deferred_unit(j);
        pg8::gemm_phase<EpiP1, false, false, pg8::OneUnit>(lds, p1_desc(ws, l), S1, p1_epi(p, l, lds)); }
      attn::attn_phase(p, l + 2 * rep_, lds); }
    SEAM(pb + 1);
    if (IN(pb + 2)) REPEAT(2) {
      pg8::GemmDesc g{(const char*)(ws + WS_O), (const char*)(ws + WS_WBR) + (size_t)l * D * OW * 2, OW, OW, OW / 64, (size_t)256 * OW * 2, (size_t)128 * OW * 2};
      pg8::StaticOrder S; S.init(TOKP / 256, D / 256, G, c);
      EpiP3 E{(const bf16_t*)(ws + WS_GATE), (bf16_t*)(ws + WS_H)};
      pg8::gemm_phase<EpiP3>(lds, g, S, E);
      pg8::GemmDesc gh = g; gh.b_tile = (size_t)128 * OW * 2;
      pg8::StaticOrder S2; S2.init(TOKS / 128, D / 128, G, c, TOKP / 128);
      EpiP3T<true, true> E2{(const bf16_t*)(ws + WS_GATE), (bf16_t*)(ws + WS_H)};
      pg8::gemm_phase<EpiP3T<true, true>, true, true>(lds, gh, S2, E2);
    }
    SEAM(pb + 2);
    if (IN(pb + 3)) {
      pg8::GemmDesc g{(const char*)(ws + WS_H), (const char*)(ws + WS_WOUT) + (size_t)l * D * D * 2, D, D, D / 64, (size_t)256 * D * 2, (size_t)128 * D * 2};
      pg8::StaticOrder S; S.init(TOKP / 256, D / 256, G, c);
      EpiRes E{(float*)(ws + WS_X32), (bf16_t*)(ws + WS_XB), (float*)(ws + WS_SS), lds, l == 0 ? p.x_prompt : nullptr, l == 0 ? p.x_sample : nullptr};
      pg8::gemm_phase<EpiRes>(lds, g, S, E);
      pg8::GemmDesc gh = g; gh.b_tile = (size_t)128 * D * 2;
      pg8::StaticOrder S2; S2.init(TOKS / 128, D / 128, G, c, TOKP / 128);
      EpiResT<true, true> E2{(float*)(ws + WS_X32), (bf16_t*)(ws + WS_XB), (float*)(ws + WS_SS), lds, l == 0 ? p.x_prompt : nullptr, l == 0 ? p.x_sample : nullptr};
      pg8::gemm_phase<EpiResT<true, true>, true, true>(lds, gh, S2, E2);
    }
    SEAM(pb + 3);
    if (IN(pb + 4)) REPEAT(4) {
      pg8::GemmDesc g{(const char*)(ws + WS_XB), (const char*)(ws + WS_WUP) + (size_t)l * 2 * DFF * D * 2, D, D, D / 64, (size_t)128 * D * 2, (size_t)DFF * D * 2};
      pg8::StaticOrder S; S.init(TOKP / 256, DFF / 128, G, c);
      EpiP5F E{(const float*)(ws + WS_SS), (bf16_t*)(ws + WS_HF), p.out, p.conv_w + (size_t)l * 3 * DFF, p.conv_b + (size_t)l * DFF, p.state_conv + (size_t)l * DB * 2 * DFF, (float*)(ws + WS_SIDE), lds, l};
      pg8::gemm_phase<EpiP5F>(lds, g, S, E);
      pg8::StaticOrder S2; S2.init(TOKS / 128, DFF / 128, G, (c + G / 2) % G, TOKP / 128);
      EpiP5FT<true> E2{(const float*)(ws + WS_SS), (bf16_t*)(ws + WS_HF), p.out, p.conv_w + (size_t)l * 3 * DFF, p.conv_b + (size_t)l * DFF, p.state_conv + (size_t)l * DB * 2 * DFF, (float*)(ws + WS_SIDE), lds, l};
      pg8::gemm_phase<EpiP5FT<true>, false, true>(lds, g, S2, E2);
    }
    SEAM(pb + 4);
    if (IN(pb + 5)) {
      pg8::GemmDesc g{(const char*)(ws + WS_HF), (const char*)(ws + WS_WDN) + (size_t)l * D * DFF * 2, DFF, DFF, DFF / 64, (size_t)256 * DFF * 2, (size_t)128 * DFF * 2};
      pg8::StaticOrder S; S.init(TOKP / 256, D / 256, G, c);
      { pg8::Unit uu; for (int i = 0; S.next(i, uu); ++i) if (uu.pm < 64 && (uu.pm & 15) != 0) p6_fixup_panel(uu.pm, (const float*)(ws + WS_SIDE), p.conv_w + (size_t)l * 3 * DFF, (bf16_t*)(ws + WS_HF));
        asm volatile("s_waitcnt vmcnt(0)" ::: "memory"); __syncthreads(); }
      EpiRes E{(float*)(ws + WS_X32), (bf16_t*)(ws + WS_XB), (float*)(ws + WS_SS), lds, nullptr, nullptr};
      pg8::gemm_phase<EpiRes>(lds, g, S, E);
      pg8::GemmDesc gh = g; gh.b_tile = (size_t)128 * DFF * 2;
      pg8::StaticOrder S2; S2.init(TOKS / 128, D / 128, G, c, TOKP / 128);
      EpiResT<true, true> E2{(float*)(ws + WS_X32), (bf16_t*)(ws + WS_XB), (float*)(ws + WS_SS), lds, nullptr, nullptr};
      pg8::gemm_phase<EpiResT<true, true>, true, true>(lds, gh, S2, E2);
    }
    SEAM(pb + 5);
  }
  if (IN(NPHASE - 1)) { pfinal_norm(p_k); }
#undef IN
#undef SEAM
}

#ifndef MK_ONE_LAUNCH
#define MK_ONE_LAUNCH 1
#endif
extern "C" void kernel_launch(void* const* d_in, const int* in_sizes, int n_in, void* d_out, int out_size, void* d_ws, size_t ws_size, hipStream_t stream) {
  static int grid_blocks = 0;
  if (grid_blocks == 0) {
    int dev = 0, cus = 0, per_cu = 0;
    (void)hipGetDevice(&dev);
    (void)hipDeviceGetAttribute(&cus, hipDeviceAttributeMultiprocessorCount, dev);
    (void)hipFuncSetAttribute((const void*)fwd_megakernel, hipFuncAttributeMaxDynamicSharedMemorySize, LDS_BYTES);
    (void)hipOccupancyMaxActiveBlocksPerMultiprocessor(&per_cu, (const void*)fwd_megakernel, NTHREADS, LDS_BYTES);
    if (per_cu < 1) { fprintf(stderr, "kernel_launch: occupancy query says %d blocks/CU\n", per_cu); per_cu = 1; }
    grid_blocks = cus * per_cu;
    if (n_in != 24 || (size_t)out_size != O_END || ws_size < WS_END) { fprintf(stderr, "kernel_launch: unexpected problem (n_in %d out %d ws %zu, need %zu)\n", n_in, out_size, ws_size, (size_t)WS_END); grid_blocks = -1; }
  }
  if (grid_blocks < 0) return;
  Params p{};
  const float** f = (const float**)&p;
  for (int i = 0; i < 24; ++i) f[i] = (const float*)d_in[i];
  p.out = (float*)d_out; p.ws = (unsigned char*)d_ws;
#if MK_ONE_LAUNCH
  p.ph_lo = 0; p.ph_hi = NPHASE;
  (void)hipMemsetAsync((unsigned char*)d_ws + WS_CTL + (size_t)CW_BAR * 4, 0, (size_t)XCD_BAR_WORDS * 4, stream);
  { void* args[] = {&p};
    hipError_t e = hipLaunchCooperativeKernel((void*)fwd_megakernel, dim3(grid_blocks), dim3(NTHREADS), args, LDS_BYTES, stream);
    if (e != hipSuccess) fprintf(stderr, "cooperative launch failed: %s (grid %d)\n", hipGetErrorString(e), grid_blocks); }
#else
  for (int k = 0; k < NPHASE; ++k) { p.ph_lo = k; p.ph_hi = k + 1; void* args[] = {&p};
    hipError_t e = hipLaunchCooperativeKernel((void*)fwd_megakernel, dim3(grid_blocks), dim3(NTHREADS), args, LDS_BYTES, stream);
    if (e != hipSuccess) { fprintf(stderr, "launch %d failed: %s (grid %d)\n", k, hipGetErrorString(e), grid_blocks); break; } }
#endif
}
```

```cpp
#include <hip/hip_runtime.h>
#include <hip/hip_cooperative_groups.h>
#include <cstdio>
#include <cstdint>
namespace cg = cooperative_groups;

#define DI __device__ __forceinline__
#define LAS __attribute__((address_space(3)))
typedef unsigned short bf16_t;
typedef short bf16x8 __attribute__((ext_vector_type(8)));
typedef short s16x4 __attribute__((ext_vector_type(4)));
typedef float f32x2 __attribute__((ext_vector_type(2)));
typedef float f32x4 __attribute__((ext_vector_type(4)));
typedef float f32x8 __attribute__((ext_vector_type(8)));
typedef float f32x16 __attribute__((ext_vector_type(16)));
typedef unsigned u32x2 __attribute__((ext_vector_type(2)));
typedef unsigned u32x4 __attribute__((ext_vector_type(4)));
typedef __bf16 bfv4 __attribute__((ext_vector_type(4)));
typedef __bf16 bfv8 __attribute__((ext_vector_type(8)));

constexpr int D = 1024, SEQ = 4096, NB = 4, TOKP = NB * SEQ, DB = 32, DSEQ = 64, TOKS = DB * DSEQ, TOK = TOKP + TOKS;
constexpr int PAST = 1024, ALEN = 512, INC = 7680, DFF = 2816, NLAYER = 2;
constexpr int QKVW = 4608, GATEW = 3072, OW = 1536;
constexpr float EPS = 1e-6f, LOG2E = 1.4426950408889634f;

constexpr size_t O_YP = 0, O_YS = O_YP + (size_t)TOKP * D, O_PAK = O_YS + (size_t)TOKS * D, O_PAV = O_PAK + (size_t)2 * 4 * 512 * 512,
                 O_PBK = O_PAV + (size_t)2 * 4 * 512 * 512, O_PBV = O_PBK + (size_t)2 * TOKP * 512, O_PCK = O_PBV + (size_t)2 * TOKP * 512,
                 O_PCV = O_PCK + (size_t)2 * TOKP * 512, O_PCONV = O_PCV + (size_t)2 * TOKP * 512, O_SAK = O_PCONV + (size_t)2 * 4 * 2 * DFF,
                 O_SAV = O_SAK + (size_t)2 * DB * 512 * 512, O_SBK = O_SAV + (size_t)2 * DB * 512 * 512, O_SBV = O_SBK + (size_t)2 * TOKS * 512,
                 O_SCK = O_SBV + (size_t)2 * TOKS * 512, O_SCV = O_SCK + (size_t)2 * TOKS * 512, O_SCONV = O_SCV + (size_t)2 * TOKS * 512,
                 O_END = O_SCONV + (size_t)2 * DB * 2 * DFF;

constexpr size_t MiB = 1u << 20;
constexpr size_t WS_CTL = 0;
constexpr size_t WS_WIN = 1 * MiB;
constexpr size_t WS_WBR = WS_WIN + (size_t)2 * INC * D * 2;
constexpr size_t WS_WOUT = WS_WBR + (size_t)2 * D * OW * 2;
constexpr size_t WS_WUP = WS_WOUT + (size_t)2 * D * D * 2;
constexpr size_t WS_WDN = WS_WUP + (size_t)2 * 2 * DFF * D * 2;
constexpr size_t WS_XB = WS_WDN + (size_t)2 * D * DFF * 2;
constexpr size_t WS_X32 = WS_XB + (size_t)TOK * D * 2;
constexpr size_t WS_SS = WS_X32 + (size_t)TOK * D * 4;
constexpr size_t WS_SIDE = WS_SS + (size_t)TOK * 8 * 4;
constexpr size_t WS_O = WS_SIDE + (size_t)3 * 72 * 2 * DFF * 4;
constexpr size_t WS_H = WS_O + (size_t)TOK * OW * 2;
constexpr size_t WS_HF = WS_H + (size_t)TOK * D * 2;
constexpr size_t WS_QKV = WS_HF + (size_t)TOK * DFF * 2;
constexpr size_t WS_GATE = WS_QKV + (size_t)TOK * QKVW * 2;
constexpr size_t WS_END = WS_GATE + (size_t)TOK * GATEW * 2;
constexpr int CW_QUEUE = 64;
constexpr int CW_LAM = 1024;
constexpr int CW_T5 = 2048;
constexpr int CW_BAR = 8192;

constexpr int LDS_BYTES = 160 * 1024;
constexpr int NTHREADS = 512;

DI u32x4 pack8(f32x4 a, f32x4 b) { f32x8 v = {a[0], a[1], a[2], a[3], b[0], b[1], b[2], b[3]}; return __builtin_bit_cast(u32x4, __builtin_convertvector(v, bfv8)); }
DI u32x2 pack4(f32x4 a) { return __builtin_bit_cast(u32x2, __builtin_convertvector(a, bfv4)); }
DI float bflo(unsigned w) { return __uint_as_float(w << 16); }
DI float bfhi(unsigned w) { return __uint_as_float(w & 0xffff0000u); }
DI float wave_sum(float v) {
#pragma unroll
  for (int o = 1; o < 64; o <<= 1) v += __shfl_xor(v, o);
  return v;
}
DI float fast_rcp(float x) { return __builtin_amdgcn_rcpf(x); }
DI float fast_exp2(float x) { return __builtin_amdgcn_exp2f(x); }
DI float fast_log2(float x) { return __builtin_amdgcn_logf(x); }

DI LAS unsigned char* opaque_lds(LAS unsigned char* p) { unsigned v = (unsigned)(__UINTPTR_TYPE__)p; asm volatile("" : "+s"(v)); return (LAS unsigned char*)(__UINTPTR_TYPE__)v; }

struct Params {
  const float* x_prompt; const float* x_sample;
  const float* cache_a_k; const float* cache_a_v; const float* cache_b_k; const float* cache_b_v; const float* cache_c_k; const float* cache_c_v;
  const float* state_conv; const float* norm_mix; const float* w_in; const float* b_gate; const float* a_rel_bias; const float* t5_bias;
  const float* c_lambda; const float* c_subln; const float* w_branch; const float* w_out; const float* norm_ffn; const float* w_up;
  const float* conv_w; const float* conv_b; const float* w_down; const float* norm_final;
  float* out; unsigned char* ws;
  int ph_lo, ph_hi;
};

DI void p0_transpose_item(const float* W, int N, const float* kscale, bf16_t* WT, int dst_ld, int dst_col, LAS float* scr, int item, int lane) {
  const int nblk = N / 32, kb = item / nblk, nb = item % nblk, k0 = 64 * kb, n0 = 32 * nb;
  float wv[32];
#pragma unroll
  for (int i = 0; i < 32; ++i) wv[i] = __builtin_nontemporal_load(&W[(size_t)(k0 + 2 * i + (lane >> 5)) * N + n0 + (lane & 31)]);
#pragma unroll
  for (int i = 0; i < 32; ++i) { const int kk = 2 * i + (lane >> 5); float v = wv[i]; if (kscale) v *= kscale[k0 + kk]; scr[kk * 33 + (lane & 31)] = v; }
  asm volatile("s_waitcnt lgkmcnt(0)" ::: "memory");
  const int c = lane & 7;
#pragma unroll
  for (int j = 0; j < 4; ++j) { const int n = (lane >> 3) + 8 * j; const LAS float* s = scr + (8 * c) * 33 + n;
    f32x4 a = {s[0 * 33], s[1 * 33], s[2 * 33], s[3 * 33]}, b = {s[4 * 33], s[5 * 33], s[6 * 33], s[7 * 33]};
    *(u32x4*)(WT + (size_t)(n0 + n) * dst_ld + dst_col + k0 + 8 * c) = pack8(a, b); }
  asm volatile("s_waitcnt lgkmcnt(0)" ::: "memory");
}

DI int t5_bucket_of(int rel) {
  const int n = rel < 0 ? -rel : rel; int f;
  if (n < 8) f = n; else if (n < 12) f = 8; else if (n < 16) f = 9; else if (n < 23) f = 10; else if (n < 32) f = 11; else if (n < 46) f = 12; else if (n < 64) f = 13; else if (n < 91) f = 14; else f = 15;
  return (rel > 0 ? 16 : 0) + f;
}

DI void p0_prologue(const Params& p, LAS unsigned char* lds_in) {
  LAS unsigned char* lds = opaque_lds(lds_in);
  int tid_ = threadIdx.x; asm volatile("" : "+v"(tid_));
  const int tid = tid_, lane = tid & 63, wave = tid >> 6;
  const int gw = blockIdx.x * 8 + wave, NGW = gridDim.x * 8;
  unsigned* ctl = (unsigned*)(p.ws + WS_CTL);
  if (blockIdx.x == 0) {
    if (tid < 4) ctl[CW_QUEUE + 64 * tid] = 0u;
    if (wave == 1) {
      for (int l = 0; l < NLAYER; ++l) { const float* lp = p.c_lambda + l * 256; const float a = wave_sum(lp[lane] * lp[64 + lane]), b = wave_sum(lp[128 + lane] * lp[192 + lane]);
        const float lam_init = 0.8f - 0.6f * expf(-0.3f * (float)l);
        if (lane == 0) ((float*)ctl)[CW_LAM + l] = expf(a) - expf(b) + lam_init; }
    }
    for (int i = tid; i < 4 * 192; i += NTHREADS) { const int h = i / 192, idx = i % 192; int rel = idx - 127; if (rel > 63) rel = 63;
      ((float*)ctl)[CW_T5 + i] = p.t5_bias[t5_bucket_of(rel) * 4 + h] - p.t5_bias[15 * 4 + h]; }
  }
  LAS float* scr = (LAS float*)(lds + wave * 8448);
  constexpr int I_IN = (D / 64) * (INC / 32), I_BR = (512 / 64) * (D / 32), I_OUT = (D / 64) * (D / 32), I_UP = (D / 64) * (2 * DFF / 32), I_DN = (DFF / 64) * (D / 32);
  constexpr int PER_LAYER = I_IN + 3 * I_BR + I_OUT + I_UP + I_DN;
  for (int it = gw; it < NLAYER * PER_LAYER; it += NGW) {
    const int l = it / PER_LAYER; int r = it % PER_LAYER;
    if (r < I_IN) { p0_transpose_item(p.w_in + (size_t)l * D * INC, INC, p.norm_mix + l * D, (bf16_t*)(p.ws + WS_WIN) + (size_t)l * INC * D, D, 0, scr, r, lane); continue; } r -= I_IN;
    if (r < 3 * I_BR) { const int n = r / I_BR; p0_transpose_item(p.w_branch + ((size_t)l * 3 + n) * 512 * D, D, nullptr, (bf16_t*)(p.ws + WS_WBR) + (size_t)l * D * OW, OW, 512 * n, scr, r % I_BR, lane); continue; } r -= 3 * I_BR;
    if (r < I_OUT) { p0_transpose_item(p.w_out + (size_t)l * D * D, D, nullptr, (bf16_t*)(p.ws + WS_WOUT) + (size_t)l * D * D, D, 0, scr, r, lane); continue; } r -= I_OUT;
    if (r < I_UP) { p0_transpose_item(p.w_up + (size_t)l * D * 2 * DFF, 2 * DFF, p.norm_ffn + l * D, (bf16_t*)(p.ws + WS_WUP) + (size_t)l * 2 * DFF * D, D, 0, scr, r, lane); continue; } r -= I_UP;
    p0_transpose_item(p.w_down + (size_t)l * DFF * D, D, nullptr, (bf16_t*)(p.ws + WS_WDN) + (size_t)l * D * DFF, DFF, 0, scr, r, lane);
  }
  bf16_t* XB = (bf16_t*)(p.ws + WS_XB); float* SS = (float*)(p.ws + WS_SS);
#pragma unroll 3
  for (int m = gw; m < TOK; m += NGW) {
    const float* src = m < TOKP ? p.x_prompt + (size_t)m * D : p.x_sample + (size_t)(m - TOKP) * D;
    float s = 0.f;
#pragma unroll
    for (int j = 0; j < 4; ++j) { const f32x4 v = __builtin_nontemporal_load(&((const f32x4*)src)[lane + 64 * j]); ((u32x2*)(XB + (size_t)m * D))[lane + 64 * j] = pack4(v);
      s += (v[0] * v[0] + v[1] * v[1]) + (v[2] * v[2] + v[3] * v[3]); }
    s = wave_sum(s);
    if (lane < 8) SS[(size_t)m * 8 + lane] = lane == 0 ? s : 0.f;
  }
}

namespace pg8 {
constexpr int BM = 256, BK = 64, HALF = 128, HTB = HALF * BK * 2, STAGE_BYTES = 8 * HTB, NXCD = 8, WGM = 8;
DI int lds_byte(int r, int c) { const int st = (r >> 4) * 2 + (c >> 5), rr = r & 15, cc = c & 31, ob = rr * 64 + cc * 2; return st * 1024 + (ob ^ (((ob >> 9) & 1) << 5)); }
DI void stage_rc(int b, int& R, int& C) { const int st = b / 1024, sb = b % 1024, swz = sb ^ (((sb >> 9) & 1) << 5); R = (st >> 1) * 16 + swz / 64; C = (st & 1) * 32 + (swz % 64) / 2; }
DI int perm32(int rho) { const int n = rho >> 4, i = rho & 15; return 8 * (i >> 2) + 4 * n + (i & 3); }
struct Unit { int pm, pn; };
struct GemmDesc { const char* A; const char* B; int lda, ldb, nt; size_t b_tile, b_half; };
struct StaticOrder {
  int nM, nN, nwg, G, c, pm0;
  DI void init(int nM_, int nN_, int G_, int c_, int pm0_ = 0) { nM = nM_; nN = nN_; nwg = nM * nN; G = G_; c = c_; pm0 = pm0_; }
  DI bool next(int i, Unit& u) const {
    const long L = (long)i * G + c; if (L >= nwg) return false;
    int wgid = (int)L; { const int q = nwg / NXCD, r = nwg % NXCD, xcd = wgid % NXCD, off = wgid / NXCD; wgid = (xcd < r ? xcd * (q + 1) : r * (q + 1) + (xcd - r) * q) + off; }
    const int nig = WGM * nN, gid = wgid / nig, fm = gid * WGM, gsz = (nM - fm) < WGM ? (nM - fm) : WGM;
    u.pm = pm0 + fm + ((wgid % nig) % gsz); u.pn = (wgid % nig) / gsz; return true;
  }
};
constexpr int P1_NN = 28, P1_EXTRA = 32, P1_DEFER = 72 + (72 - P1_EXTRA);
struct P1Order {
  StaticOrder R1;
  DI bool next(int i, Unit& u) const {
    if (R1.next(i, u)) return true;
    const long L = (long)i * R1.G + R1.c - R1.nwg; if (L >= P1_EXTRA) return false;
    u.pm = (int)L; u.pn = P1_NN; return true;
  }
};
DI Unit p1_deferred_unit(int j) { Unit u; if (j < 72) { u.pm = j; u.pn = P1_NN + 1; } else { u.pm = P1_EXTRA + (j - 72); u.pn = P1_NN; } return u; }
struct OneUnit { Unit u; DI bool next(int i, Unit& o) const { if (i != 0) return false; o = u; return true; } };
template <class Epi, bool HALFN = false, bool HALFM = false, class Sched = StaticOrder>
DI void gemm_phase(LAS unsigned char* lds_in, const GemmDesc g, const Sched& S, const Epi& E) {
  LAS unsigned char* lds = opaque_lds(lds_in);
  int tid_ = threadIdx.x; asm volatile("" : "+v"(tid_));
  const int tid = tid_, wid = __builtin_amdgcn_readfirstlane(tid >> 6), lane = tid & 63, wr = wid >> 2, wc = wid & 3, fr = lane & 15, fq = lane >> 4;
  const int nt = g.nt;
  unsigned voffA[2], voffB[2];
#pragma unroll
  for (int i = 0; i < 2; ++i) { int R, C; stage_rc(tid * 16 + i * 8192, R, C); const int Rb = Epi::PERM ? ((R & ~31) + perm32(R & 31)) : R;
    voffA[i] = (unsigned)(R * g.lda + C) * 2u; voffB[i] = (unsigned)(Rb * g.ldb + C) * 2u; }
  const size_t kstep = (size_t)(BK * 2);
  const size_t hsA = (size_t)HALF * g.lda * 2, tsA = HALFM ? hsA : 2 * hsA, hsB = g.b_half, tsB = g.b_tile;
  const unsigned ldsw = (unsigned)wid * 1024u;
  const int aoff = lds_byte(wr * 64 + fr, fq * 8), boff = lds_byte(wc * 32 + fr, fq * 8);
#define PG8_SA(b, h) (((b) * 2 + (h)) * HTB)
#define PG8_SB(b, h) ((4 + (b) * 2 + (h)) * HTB)
#define PG8_STAGE(bufoff, gbase, voff) do { _Pragma("unroll") for (int _i = 0; _i < 2; ++_i) \
    __builtin_amdgcn_global_load_lds((const unsigned*)((const char*)(gbase) + (voff)[_i]), (LAS unsigned*)(lds + (bufoff) + ldsw + _i * 8192), 16, 0, 0); } while (0)
#define PG8_LDA(dst, b, h) do { _Pragma("unroll") for (int m = 0; m < 4; ++m) _Pragma("unroll") for (int k = 0; k < 2; ++k) dst[m][k] = *(const LAS bf16x8*)(lds + PG8_SA(b, h) + aoff + m * 2048 + k * 1024); } while (0)
#define PG8_LDB(dst, b, h) do { _Pragma("unroll") for (int n = 0; n < 2; ++n) _Pragma("unroll") for (int k = 0; k < 2; ++k) dst[n][k] = *(const LAS bf16x8*)(lds + PG8_SB(b, h) + boff + n * 2048 + k * 1024); } while (0)
#define PG8_MMA(ai, bj, At, Bt) do { __builtin_amdgcn_s_setprio(1); _Pragma("unroll") for (int m = 0; m < 4; ++m) _Pragma("unroll") for (int n = 0; n < 2; ++n) _Pragma("unroll") for (int k = 0; k < 2; ++k) \
    acc[ai][bj][m][n] = __builtin_amdgcn_mfma_f32_16x16x32_bf16(Bt[n][k], At[m][k], acc[ai][bj][m][n], 0, 0, 0); __builtin_amdgcn_s_setprio(0); } while (0)
#define PG8_WAIT_V(n) asm volatile("s_waitcnt vmcnt(" #n ")" ::: "memory")
#define PG8_WAIT_LOOP do { if constexpr (HALFM && HALFN) PG8_WAIT_V(4); else if constexpr (HALFM || HALFN) PG8_WAIT_V(6); else PG8_WAIT_V(8); } while (0)
#define PG8_WAIT_L(n) asm volatile("s_waitcnt lgkmcnt(" #n ")" ::: "memory")
#define PG8_BAR __builtin_amdgcn_s_barrier()
#define PG8_SCHED __builtin_amdgcn_sched_barrier(0)
  Unit cur, nxt; int ui = 0;
  if (!S.next(0, cur)) return;
  f32x4 acc[2][2][4][2];
#pragma unroll
  for (int a = 0; a < 2; ++a)
#pragma unroll
    for (int b = 0; b < 2; ++b)
#pragma unroll
      for (int m = 0; m < 4; ++m)
#pragma unroll
        for (int n = 0; n < 2; ++n) acc[a][b][m][n] = (f32x4){0.f, 0.f, 0.f, 0.f};
  bf16x8 At[4][2], B0[2][2], B1[2][2];
  const char* cA = g.A + (size_t)cur.pm * tsA; const char* cB = g.B + (size_t)cur.pn * tsB;
  f32x4 ssv = {0.f, 0.f, 0.f, 0.f};
  if constexpr (Epi::HAS_RS) ssv = E.prefetch(cur, tid);
  PG8_STAGE(PG8_SB(0, 0), cB, voffB); if constexpr (!HALFN) PG8_STAGE(PG8_SB(0, 1), cB + hsB, voffB); PG8_STAGE(PG8_SA(0, 0), cA, voffA); if constexpr (!HALFM) PG8_STAGE(PG8_SA(0, 1), cA + hsA, voffA);
  if (wr == 1) PG8_BAR;
  if constexpr (HALFM) PG8_WAIT_V(0); else PG8_WAIT_V(2);
  PG8_BAR;
  PG8_STAGE(PG8_SB(1, 0), cB + kstep, voffB); PG8_STAGE(PG8_SA(1, 0), cA + kstep, voffA); if constexpr (!HALFN) PG8_STAGE(PG8_SB(1, 1), cB + hsB + kstep, voffB);
  if constexpr (HALFN) PG8_WAIT_V(4); else PG8_WAIT_V(6);
  PG8_BAR;
  for (;;) {
    const bool has_next = S.next(ui + 1, nxt);
    const char* nA = has_next ? g.A + (size_t)nxt.pm * tsA : cA; const char* nB = has_next ? g.B + (size_t)nxt.pn * tsB : cB;
    for (int t = 0; t < nt; t += 2) {
      const bool last = (t == nt - 2);
      const char* a1 = cA + (size_t)(t + 1) * kstep;
      const char* a2 = last ? nA : cA + (size_t)(t + 2) * kstep; const char* b2 = last ? nB : cB + (size_t)(t + 2) * kstep;
      const char* a3 = a2 + kstep; const char* b3 = b2 + kstep;
      if constexpr (Epi::HAS_MID) { if (t == 8 || t == 16) E.mid(acc, cur, t, wr, wc, fr, fq); }
      PG8_LDB(B0, 0, 0); if constexpr (!HALFN) PG8_LDB(B1, 0, 1); PG8_SCHED; PG8_LDA(At, 0, 0); if constexpr (!HALFM) PG8_STAGE(PG8_SA(1, 1), a1 + hsA, voffA);
      PG8_WAIT_LOOP; PG8_WAIT_L(0); PG8_BAR; PG8_MMA(0, 0, At, B0); if constexpr (!HALFN) PG8_MMA(0, 1, At, B1); PG8_BAR; PG8_SCHED;
      if constexpr (!HALFM) PG8_LDA(At, 0, 1); PG8_STAGE(PG8_SB(0, 0), b2, voffB); if constexpr (!HALFN) PG8_STAGE(PG8_SB(0, 1), b2 + hsB, voffB); PG8_STAGE(PG8_SA(0, 0), a2, voffA);
      PG8_WAIT_LOOP; PG8_WAIT_L(0); PG8_BAR; if constexpr (!HALFM) { PG8_MMA(1, 0, At, B0); if constexpr (!HALFN) PG8_MMA(1, 1, At, B1); } PG8_BAR; PG8_SCHED;
      PG8_LDB(B0, 1, 0); if constexpr (!HALFN) PG8_LDB(B1, 1, 1); PG8_SCHED; PG8_LDA(At, 1, 0); if constexpr (!HALFM) PG8_STAGE(PG8_SA(0, 1), a2 + hsA, voffA);
      PG8_WAIT_LOOP; PG8_WAIT_L(0); PG8_BAR; PG8_MMA(0, 0, At, B0); if constexpr (!HALFN) PG8_MMA(0, 1, At, B1); PG8_BAR; PG8_SCHED;
      if constexpr (!HALFM) PG8_LDA(At, 1, 1); PG8_STAGE(PG8_SB(1, 0), b3, voffB); if constexpr (!HALFN) PG8_STAGE(PG8_SB(1, 1), b3 + hsB, voffB); PG8_STAGE(PG8_SA(1, 0), a3, voffA);
      PG8_WAIT_LOOP; PG8_WAIT_L(0); PG8_BAR; if constexpr (!HALFM) { PG8_MMA(1, 0, At, B0); if constexpr (!HALFN) PG8_MMA(1, 1, At, B1); } PG8_BAR; PG8_SCHED;
    }
    if (wr == 0) PG8_BAR;
    if constexpr (Epi::HAS_RS) { E.stash(ssv, cur, tid, lds); PG8_WAIT_L(0); PG8_BAR; asm volatile("" ::: "memory"); }
    E(acc, cur, wr, wc, fr, fq);
    if (!has_next) break;
#pragma unroll
    for (int a = 0; a < 2; ++a)
#pragma unroll
      for (int b = 0; b < 2; ++b)
#pragma unroll
        for (int m = 0; m < 4; ++m)
#pragma unroll
          for (int n = 0; n < 2; ++n) acc[a][b][m][n] = (f32x4){0.f, 0.f, 0.f, 0.f};
    cur = nxt; cA = nA; cB = nB; ++ui;
    if constexpr (Epi::HAS_RS) ssv = E.prefetch(cur, tid);
    if (wr == 1) PG8_BAR;
  }
  PG8_WAIT_V(0);
  PG8_BAR;
#undef PG8_SA
#undef PG8_SB
#undef PG8_STAGE
#undef PG8_LDA
#undef PG8_LDB
#undef PG8_MMA
#undef PG8_WAIT_V
#undef PG8_WAIT_LOOP
#undef PG8_WAIT_L
#undef PG8_BAR
#undef PG8_SCHED
}
}
using pg8::Unit;
DI f32x4 ss_load(const float* SS, int r) { const f32x4* q = (const f32x4*)(SS + (size_t)r * 8); return q[0] + q[1]; }
DI float ss_to_rs(const f32x4& a) { return __builtin_amdgcn_rsqf(((a[0] + a[1]) + (a[2] + a[3])) * (1.0f / D) + EPS); }
DI float row_rs(const float* SS, int r) { return ss_to_rs(ss_load(SS, r)); }
DI float sigmoidf_(float x) { return fast_rcp(1.0f + fast_exp2(-x * LOG2E)); }

struct EpiP1 {
  static constexpr bool PERM = true, HAS_MID = false, HAS_RS = true;
  const float* SS; bf16_t* QKV; bf16_t* GATE; const float* bgate; float* out; int layer; int probe_flags; LAS unsigned char* lds;
  DI void mid(f32x4 (&)[2][2][4][2], const Unit&, int, int, int, int, int) const {}
  DI f32x4 prefetch(const Unit& u, int tid) const {
    f32x4 v = {0.f, 0.f, 0.f, 0.f};
    if (tid < 256) v = ss_load(SS, u.pm * 256 + tid);
    return v;
  }
  DI void stash(const f32x4& v, const Unit& u, int tid, LAS unsigned char* l) const {
    if (tid < 256) *(LAS float*)(l + 131072 + 12288 + tid * 4) = ss_to_rs(v);
  }
  DI void operator()(f32x4 (&acc)[2][2][4][2], const Unit& u, int wr, int wc, int fr, int fq) const {
    const int pn = u.pn, rin0 = wr * 64 + fr, row0 = u.pm * 256 + rin0;
    float rs[2][4];
#pragma unroll
    for (int ai = 0; ai < 2; ++ai)
#pragma unroll
      for (int m = 0; m < 4; ++m) rs[ai][m] = *(const LAS float*)(lds + 131072 + 12288 + (rin0 + ai * 128 + m * 16) * 4);
    if (pn < 18) {
      const int colq = pn * 256 + wc * 32 + 8 * fq;
#pragma unroll
      for (int ai = 0; ai < 2; ++ai)
#pragma unroll
        for (int m = 0; m < 4; ++m) {
          const int rin = rin0 + ai * 128 + m * 16, r = u.pm * 256 + rin; const float s = rs[ai][m];
          bf16_t* rowp = QKV + (size_t)r * QKVW + colq;
#pragma unroll
          for (int bj = 0; bj < 2; ++bj) { const f32x4 v0 = acc[ai][bj][m][0] * s, v1 = acc[ai][bj][m][1] * s;
            { const u32x4 pk = pack8(v0, v1); if (!(probe_flags & 2)) *(u32x4*)(rowp + bj * 128) = pk; else asm volatile("" :: "v"(pk)); }
            }
        }
    } else {
      const int gi = pn - 18, nb = gi >> 2, colg = (gi & 3) * 256 + wc * 32 + 8 * fq;
      f32x4 bv[2][2];
#pragma unroll
      for (int bj = 0; bj < 2; ++bj) { bv[bj][0] = *(const f32x4*)(bgate + nb * D + colg + bj * 128); bv[bj][1] = *(const f32x4*)(bgate + nb * D + colg + bj * 128 + 4); }
#pragma unroll
      for (int ai = 0; ai < 2; ++ai)
#pragma unroll
        for (int m = 0; m < 4; ++m) { const int r = row0 + ai * 128 + m * 16; const float s = rs[ai][m];
          bf16_t* rowp = GATE + (size_t)r * GATEW + gi * 256 + wc * 32 + 8 * fq;
#pragma unroll
          for (int bj = 0; bj < 2; ++bj) { f32x4 v0 = acc[ai][bj][m][0] * s + bv[bj][0], v1 = acc[ai][bj][m][1] * s + bv[bj][1];
#pragma unroll
            for (int j = 0; j < 4; ++j) { v0[j] = 1.0f + fast_exp2(fminf(-v0[j] * LOG2E, 100.0f)); v1[j] = 1.0f + fast_exp2(fminf(-v1[j] * LOG2E, 100.0f)); }
            { const u32x4 pk = pack8(v0, v1); if (!(probe_flags & 2)) *(u32x4*)(rowp + bj * 128) = pk; else asm volatile("" :: "v"(pk)); } } }
    }
  }
};

template <bool HALFN, bool HALFM = false> struct EpiP3T {
  static constexpr bool PERM = true, HAS_MID = true, HAS_RS = false;
  const bf16_t* GATE; bf16_t* H;
  DI void mid(f32x4 (&acc)[2][2][4][2], const Unit& u, int t, int wr, int wc, int fr, int fq) const {
    const int nb = (t >> 3) - 1;
    const bf16_t* gp = GATE + (size_t)(u.pm * (HALFM ? 128 : 256) + wr * 64 + fr) * GATEW + nb * D + u.pn * (HALFN ? 128 : 256) + wc * 32 + 8 * fq;
#pragma unroll
    for (int ai = 0; ai < (HALFM ? 1 : 2); ++ai) {
        u32x4 ga[4][2] = {}, gb[4][2] = {};
#pragma unroll
        for (int m = 0; m < 4; ++m)
#pragma unroll
          for (int bj = 0; bj < (HALFN ? 1 : 2); ++bj) { const bf16_t* q = gp + (size_t)(ai * 128 + m * 16) * GATEW + bj * 128; ga[m][bj] = *(const u32x4*)q; gb[m][bj] = *(const u32x4*)(q + D); }
#pragma unroll
        for (int m = 0; m < 4; ++m)
#pragma unroll
          for (int bj = 0; bj < (HALFN ? 1 : 2); ++bj)
#pragma unroll
            for (int n = 0; n < 2; ++n) { const unsigned a0 = ga[m][bj][2 * n], a1 = ga[m][bj][2 * n + 1], b0 = gb[m][bj][2 * n], b1 = gb[m][bj][2 * n + 1];
              acc[ai][bj][m][n][0] *= bflo(b0) * fast_rcp(bflo(a0)); acc[ai][bj][m][n][1] *= bfhi(b0) * fast_rcp(bfhi(a0));
              acc[ai][bj][m][n][2] *= bflo(b1) * fast_rcp(bflo(a1)); acc[ai][bj][m][n][3] *= bfhi(b1) * fast_rcp(bfhi(a1)); }
        asm volatile("" ::: "memory"); }
  }
  DI void operator()(f32x4 (&acc)[2][2][4][2], const Unit& u, int wr, int wc, int fr, int fq) const {
    const int row0 = u.pm * (HALFM ? 128 : 256) + wr * 64 + fr, col0 = u.pn * (HALFN ? 128 : 256) + wc * 32 + 8 * fq;
#pragma unroll
    for (int ai = 0; ai < (HALFM ? 1 : 2); ++ai)
#pragma unroll
      for (int m = 0; m < 4; ++m) { const int r = row0 + ai * 128 + m * 16; const bf16_t* gp = GATE + (size_t)r * GATEW + 2 * D + col0; bf16_t* hp = H + (size_t)r * D + col0;
#pragma unroll
        for (int bj = 0; bj < (HALFN ? 1 : 2); ++bj) { const u32x4 g = *(const u32x4*)(gp + bj * 128); f32x4 v0 = acc[ai][bj][m][0], v1 = acc[ai][bj][m][1];
          v0[0] *= fast_rcp(bflo(g[0])); v0[1] *= fast_rcp(bfhi(g[0])); v0[2] *= fast_rcp(bflo(g[1])); v0[3] *= fast_rcp(bfhi(g[1])); v1[0] *= fast_rcp(bflo(g[2])); v1[1] *= fast_rcp(bfhi(g[2])); v1[2] *= fast_rcp(bflo(g[3])); v1[3] *= fast_rcp(bfhi(g[3]));
          *(u32x4*)(hp + bj * 128) = pack8(v0, v1); } }
  }
};

typedef EpiP3T<false> EpiP3;

template <bool HALFN, bool HALFM = false> struct EpiResT {
  static constexpr bool PERM = true, HAS_MID = false, HAS_RS = false;
  float* X32; bf16_t* XB; float* SS; LAS unsigned char* lds; const float* xin_p; const float* xin_s;
  DI void mid(f32x4 (&)[2][2][4][2], const Unit&, int, int, int, int, int) const {}
  DI void operator()(f32x4 (&acc)[2][2][4][2], const Unit& u, int wr, int wc, int fr, int fq) const {
    const int rin0 = wr * 64 + fr, row0 = u.pm * (HALFM ? 128 : 256) + rin0, col0 = u.pn * (HALFN ? 128 : 256) + wc * 32 + 8 * fq;
    LAS float* red = (LAS float*)(lds + 131072 + 8192);
#pragma unroll
    for (int ai = 0; ai < (HALFM ? 1 : 2); ++ai) {
      f32x4 xo[4][2][2] = {};
#pragma unroll
      for (int m = 0; m < 4; ++m) { const int r = row0 + ai * 128 + m * 16;
        const float* xr = xin_p ? (r < TOKP ? xin_p + (size_t)r * D : xin_s + (size_t)(r - TOKP) * D) + col0 : X32 + (size_t)r * D + col0;
#pragma unroll
        for (int bj = 0; bj < (HALFN ? 1 : 2); ++bj)
#pragma unroll
          for (int n = 0; n < 2; ++n) xo[m][bj][n] = *(const f32x4*)(xr + bj * 128 + n * 4); }
#pragma unroll
      for (int m = 0; m < 4; ++m) { const int r = row0 + ai * 128 + m * 16; float* xp = X32 + (size_t)r * D + col0; bf16_t* bp = XB + (size_t)r * D + col0; float q = 0.f;
#pragma unroll
        for (int bj = 0; bj < (HALFN ? 1 : 2); ++bj)
          { const f32x4 x0 = xo[m][bj][0] + acc[ai][bj][m][0], x1 = xo[m][bj][1] + acc[ai][bj][m][1];
            *(f32x4*)(xp + bj * 128) = x0; *(f32x4*)(xp + bj * 128 + 4) = x1; *(u32x4*)(bp + bj * 128) = pack8(x0, x1);
            q += ((x0[0] * x0[0] + x0[1] * x0[1]) + (x0[2] * x0[2] + x0[3] * x0[3])) + ((x1[0] * x1[0] + x1[1] * x1[1]) + (x1[2] * x1[2] + x1[3] * x1[3])); }
        q += __shfl_xor(q, 16); q += __shfl_xor(q, 32);
        if (fq == 0) red[(rin0 + ai * 128 + m * 16) * 4 + wc] = q; }
      asm volatile("" ::: "memory"); }
    asm volatile("s_waitcnt lgkmcnt(0)" ::: "memory"); __builtin_amdgcn_s_barrier(); asm volatile("" ::: "memory");
    int t = threadIdx.x; asm volatile("" : "+v"(t));
    if (t < (HALFM ? 128 : 256)) { const f32x4 v = *(const LAS f32x4*)(red + t * 4); const float q = (v[0] + v[1]) + (v[2] + v[3]); float* sp = SS + (size_t)(u.pm * (HALFM ? 128 : 256) + t) * 8;
      if (HALFN) sp[u.pn] = q; else *(f32x2*)(sp + 2 * u.pn) = (f32x2){q, 0.f}; }
  }
};

typedef EpiResT<false> EpiRes;

DI float dpp_ror1(float v) { return __builtin_bit_cast(float, __builtin_amdgcn_update_dpp(0, __builtin_bit_cast(int, v), 0x121, 0xf, 0xf, false)); }
DI float dpp_ror2(float v) { return __builtin_bit_cast(float, __builtin_amdgcn_update_dpp(0, __builtin_bit_cast(int, v), 0x122, 0xf, 0xf, false)); }
DI float gelu_mul(float x, float uv) {
  const float t = __builtin_fmaf(x * x, 2.0f * LOG2E * 0.7978845608028654f * 0.044715f, 2.0f * LOG2E * 0.7978845608028654f);
  const float r = fast_rcp(fast_exp2(x * t) + 1.0f);
  return __builtin_fmaf(-x, r, x) * uv;
}
constexpr size_t SIDE_ROWS = (size_t)72 * 2 * DFF;
template <bool HALFM> struct EpiP5FT {
  static constexpr bool PERM = true, HAS_MID = false, HAS_RS = true;
  const float* SS; bf16_t* HF; float* out; const float* cw; const float* cb; const float* st; float* side; LAS unsigned char* lds; int layer;
  DI void mid(f32x4 (&)[2][2][4][2], const Unit&, int, int, int, int, int) const {}
  DI f32x4 prefetch(const Unit& u, int tid) const {
    f32x4 v = {0.f, 0.f, 0.f, 0.f};
    if (tid < (HALFM ? 128 : 256)) v = ss_load(SS, u.pm * (HALFM ? 128 : 256) + tid);
    else if (tid >= 256 && tid < 384) { int j = tid - 256; asm volatile("" : "+v"(j));
      const int arr = j >> 5, c4 = (j & 31) * 4; v = *(const f32x4*)((arr < 3 ? cw + arr * DFF : cb) + u.pn * 128 + c4); }
    return v;
  }
  DI void stash(const f32x4& v, const Unit& u, int tid, LAS unsigned char* l) const {
    if (tid < (HALFM ? 128 : 256)) *(LAS float*)(l + 131072 + 12288 + tid * 4) = ss_to_rs(v);
    else if (tid >= 256 && tid < 384) *(LAS f32x4*)(l + 131072 + 13312 + (tid - 256) * 16) = v;
  }
  DI void operator()(f32x4 (&acc)[2][2][4][2], const Unit& u, int wr, int wc, int fr_in, int fq_in) const {
    int fr = fr_in, fq = fq_in; asm volatile("" : "+v"(fr), "+v"(fq));
    const int rin0 = wr * 64 + fr, col0 = u.pn * 128 + wc * 32 + 8 * fq;
    const bool sample = HALFM ? true : u.pm >= 64, cont = !sample && (u.pm & 15) != 0;
    const int bd0 = HALFM ? (u.pm - TOKP / 128) * 2 : (u.pm - 64) * 4;
    LAS float* xh = (LAS float*)(lds + 131072);
    float* TAILG = side; float* HEADC = side + SIDE_ROWS; float* HEADU = side + 2 * SIDE_ROWS;
#pragma unroll
    for (int ai = 0; ai < (HALFM ? 1 : 2); ++ai)
#pragma unroll
      for (int m = 0; m < 4; ++m) { const float s = *(const LAS float*)(lds + 131072 + 12288 + (rin0 + ai * 128 + m * 16) * 4);
#pragma unroll
        for (int n = 0; n < 2; ++n) { acc[ai][0][m][n] *= s; acc[ai][1][m][n] *= s; } }
    if (fr >= 14) {
#pragma unroll
      for (int ai = 0; ai < (HALFM ? 1 : 2); ++ai) { const int gidx = 2 * ai + wr; LAS float* xp = xh + ((gidx * 4 + wc) * 2 + (fr - 14)) * 32 + fq * 8;
        *(LAS f32x4*)xp = acc[ai][0][3][0]; *(LAS f32x4*)(xp + 4) = acc[ai][0][3][1];
        float* cp = nullptr;
        if (sample) cp = out + O_SCONV + ((size_t)(layer * DB + bd0 + gidx) * 2 + (fr - 14)) * DFF + col0;
        else if (gidx == 3) { float* tp = TAILG + ((size_t)u.pm * 2 + (fr - 14)) * DFF + col0; *(f32x4*)tp = acc[ai][0][3][0]; *(f32x4*)(tp + 4) = acc[ai][0][3][1];
          if ((u.pm & 15) == 15) cp = out + O_PCONV + ((size_t)(layer * 4 + (u.pm >> 4)) * 2 + (fr - 14)) * DFF + col0; }
        if (cp) { *(f32x4*)cp = acc[ai][0][3][0]; *(f32x4*)(cp + 4) = acc[ai][0][3][1]; } }
    }
    asm volatile("s_waitcnt lgkmcnt(0)" ::: "memory"); __builtin_amdgcn_s_barrier(); asm volatile("" ::: "memory");
#pragma unroll
    for (int n = 0; n < 2; ++n) {
      const LAS float* cl = (const LAS float*)(lds + 131072 + 13312) + wc * 32 + 8 * fq + 4 * n;
      const f32x4 w0 = *(const LAS f32x4*)cl, w1 = *(const LAS f32x4*)(cl + 128), w2 = *(const LAS f32x4*)(cl + 256), bb = *(const LAS f32x4*)(cl + 384);
#pragma unroll
      for (int ai = 0; ai < (HALFM ? 1 : 2); ++ai) { const int gidx = 2 * ai + wr;
        f32x4 gp = {0.f, 0.f, 0.f, 0.f};
        if (fr >= 14) {
          if (sample) gp = *(const f32x4*)(st + ((size_t)(bd0 + gidx) * 2 + (fr - 14)) * DFF + col0 + 4 * n);
          else if (gidx > 0) gp = *(const LAS f32x4*)(xh + (((gidx - 1) * 4 + wc) * 2 + (fr - 14)) * 32 + fq * 8 + 4 * n);
        }
#pragma unroll
        for (int m = 0; m < 4; ++m) { const int rin = rin0 + ai * 128 + m * 16; f32x4 o, cc;
#pragma unroll
          for (int j = 0; j < 4; ++j) { const float g = acc[ai][0][m][n][j], gq = gp[j];
            const float r1g = dpp_ror1(g), r1q = dpp_ror1(gq), r2g = dpp_ror2(g), r2q = dpp_ror2(gq);
            const float p1 = fr >= 1 ? r1g : r1q, p2 = fr >= 2 ? r2g : r2q;
            const float c = __builtin_fmaf(w2[j], g, __builtin_fmaf(w1[j], p1, __builtin_fmaf(w0[j], p2, bb[j])));
            cc[j] = c; o[j] = gelu_mul(c, acc[ai][1][m][n][j]); }
          *(u32x2*)(HF + (size_t)(u.pm * (HALFM ? 128 : 256) + rin) * DFF + col0 + 4 * n) = pack4(o);
          if (cont && gidx == 0 && m == 0 && fr < 2) { *(f32x4*)(HEADC + ((size_t)u.pm * 2 + fr) * DFF + col0 + 4 * n) = cc; *(f32x4*)(HEADU + ((size_t)u.pm * 2 + fr) * DFF + col0 + 4 * n) = acc[ai][1][m][n]; }
          gp = acc[ai][0][m][n]; }
      }
    }
  }
};
typedef EpiP5FT<false> EpiP5F;
DI void p6_fixup_panel(int pm, const float* side, const float* cw, bf16_t* HF) {
  const float* TAILG = side + (size_t)(pm - 1) * 2 * DFF; const float* HEADC = side + SIDE_ROWS + (size_t)pm * 2 * DFF; const float* HEADU = side + 2 * SIDE_ROWS + (size_t)pm * 2 * DFF;
  int tid_ = threadIdx.x; asm volatile("" : "+v"(tid_));
  constexpr int NIT = (DFF + NTHREADS - 1) / NTHREADS;
  float t0[NIT], t1[NIT], a0[NIT], a1[NIT], hc0[NIT], hc1[NIT], hu0[NIT], hu1[NIT];
#pragma unroll
  for (int i = 0; i < NIT; ++i) { const int k = tid_ + i * NTHREADS; const int kk = k < DFF ? k : 0;
    t0[i] = TAILG[kk]; t1[i] = TAILG[DFF + kk]; a0[i] = cw[kk]; a1[i] = cw[DFF + kk]; hc0[i] = HEADC[kk]; hc1[i] = HEADC[DFF + kk]; hu0[i] = HEADU[kk]; hu1[i] = HEADU[DFF + kk]; }
#pragma unroll
  for (int i = 0; i < NIT; ++i) { const int k = tid_ + i * NTHREADS;
    const float c0 = hc0[i] + a0[i] * t0[i] + a1[i] * t1[i], c1 = hc1[i] + a0[i] * t1[i];
    const float h0 = gelu_mul(c0, hu0[i]), h1 = gelu_mul(c1, hu1[i]);
    f32x4 v = {h0, h1, 0.f, 0.f}; const u32x2 pk = pack4(v);
    if (k < DFF) { HF[(size_t)(pm * 256) * DFF + k] = (bf16_t)(pk[0] & 0xffffu); HF[(size_t)(pm * 256 + 1) * DFF + k] = (bf16_t)(pk[0] >> 16); } }
}

struct EpiNull {
  static constexpr bool PERM = true, HAS_MID = false, HAS_RS = false;
  DI void mid(f32x4 (&)[2][2][4][2], const Unit&, int, int, int, int, int) const {}
  DI void operator()(f32x4 (&acc)[2][2][4][2], const Unit& u, int wr, int wc, int fr, int fq) const {
#pragma unroll
    for (int ai = 0; ai < 2; ++ai)
#pragma unroll
      for (int bj = 0; bj < 2; ++bj)
#pragma unroll
        for (int m = 0; m < 4; ++m)
#pragma unroll
          for (int n = 0; n < 2; ++n) asm volatile("" :: "v"(acc[ai][bj][m][n]));
  }
};

DI float gelu_tanh(float x) {
  const float y = 0.7978845608028654f * (x + 0.044715f * x * x * x);
  const float e = fast_exp2(2.0f * LOG2E * y);
  const float th = 1.0f - 2.0f * fast_rcp(e + 1.0f);
  return 0.5f * x * (1.0f + th);
}
DI void pfinal_norm(const Params& p) {
  const float* X32 = (const float*)(p.ws + WS_X32); const float* SS = (const float*)(p.ws + WS_SS);
  int tid_ = threadIdx.x; asm volatile("" : "+v"(tid_));
  const int lane = tid_ & 63, gw = blockIdx.x * 8 + (tid_ >> 6), NGW = gridDim.x * 8;
#pragma unroll 3
  for (int m = gw; m < TOK; m += NGW) { const float s = row_rs(SS, m);
#pragma unroll
    for (int j = 0; j < 4; ++j) { const f32x4 v = ((const f32x4*)(X32 + (size_t)m * D))[lane + 64 * j], g = ((const f32x4*)p.norm_final)[lane + 64 * j];
      __builtin_nontemporal_store(v * s * g, (f32x4*)(p.out + (size_t)m * D) + lane + 64 * j); } }
}

DI pg8::GemmDesc p1_desc(unsigned char* ws, int l) {
  return pg8::GemmDesc{(const char*)(ws + WS_XB), (const char*)(ws + WS_WIN) + (size_t)l * INC * D * 2, D, D, D / 64, (size_t)256 * D * 2, (size_t)128 * D * 2};
}
DI EpiP1 p1_epi(const Params& p, int l, LAS unsigned char* lds) {
  return EpiP1{(const float*)(p.ws + WS_SS), (bf16_t*)(p.ws + WS_QKV), (bf16_t*)(p.ws + WS_GATE), p.b_gate + (size_t)l * 3 * D, p.out, l, 0, lds};
}
namespace attn {
constexpr int N_CPY = 64, N_CS = 128, N_CP = 512, N_AP = 512, N_BP = 512, N_AS = 256, N_BS = 256, NITEMS = N_CPY + N_CS + N_CP + N_AP + N_BP + N_AS + N_BS;
constexpr float STICK_DONE = 8.75651e-27f;

struct Item { int mode, h, tok0, past, q0, nqv, pflags; const float* cK; const float* cV; };

DI Item decode(const Params& p, int layer, int idx) {
  Item it; it.cK = nullptr; it.cV = nullptr; it.past = 0; it.pflags = 0;
  if (idx < N_CPY) { it.mode = 3; it.h = idx; return it; }
  idx -= N_CPY;
  if (idx < N_CS) { const int bd = idx >> 2, h = idx & 3; it.mode = 2; it.h = h; it.tok0 = TOKP + bd * 64; it.past = PAST; it.q0 = PAST; it.nqv = 64;
    it.cK = p.cache_c_k + (size_t)(layer * DB + bd) * PAST * 512 + h * 128; it.cV = p.cache_c_v + (size_t)(layer * DB + bd) * PAST * 512 + h * 128; return it; }
  idx -= N_CS;
  if (idx < N_CP) { const int jj = 31 - (idx >> 4), rem = idx & 15; it.mode = 2; it.h = rem & 3; it.tok0 = (rem >> 2) * SEQ; it.q0 = jj * 128; it.nqv = 128; return it; }
  idx -= N_CP;
  if (idx < N_AP + N_BP) { const int isb = idx >= N_AP; if (isb) idx -= N_AP; const int qt = 15 - (idx >> 5), rem = idx & 31; it.mode = isb; it.h = rem & 7; it.tok0 = (rem >> 3) * SEQ; it.q0 = qt * 256; it.nqv = 256; return it; }
  idx -= N_AP + N_BP;
  if (idx < N_AS) { const int bd = idx >> 3, h = idx & 7; it.mode = 0; it.h = h; it.tok0 = TOKP + bd * 64; it.past = ALEN; it.q0 = ALEN; it.nqv = 64;
    it.cK = p.cache_a_k + (size_t)(layer * DB + bd) * ALEN * 512 + h * 64; it.cV = p.cache_a_v + (size_t)(layer * DB + bd) * ALEN * 512 + h * 64; return it; }
  idx -= N_AS;
  { const int bd = idx >> 3, h = idx & 7; it.mode = 1; it.h = h; it.tok0 = TOKP + bd * 64; it.past = PAST; it.q0 = PAST; it.nqv = 64;
    it.cK = p.cache_b_k + (size_t)(layer * DB + bd) * PAST * 512 + h * 64; it.cV = p.cache_b_v + (size_t)(layer * DB + bd) * PAST * 512 + h * 64; return it; }
}


template <int MODE, bool SAMPLE>
DI void load_piece(u32x4& r0, u32x4& r1, u32x4& r2, u32x4& r3, const Item& it, const float* cache, const bf16_t* QKV, int col, int kt, int tid) {
  constexpr int CPR = MODE == 2 ? 16 : 8;
  const int j0 = kt * 64;
  const int ra = tid / CPR, ca = tid % CPR;
  if (SAMPLE && j0 < it.past) {
    const unsigned lo = (unsigned)(ra * 512 + ca * 8) * 4u; const char* b = (const char*)(cache + (size_t)j0 * 512);
    { const u32x4* q = (const u32x4*)(b + lo); r0 = q[0]; r1 = q[1]; }
    if constexpr (MODE == 2) { const u32x4* q = (const u32x4*)(b + (size_t)32 * 512 * 4 + lo); r2 = q[0]; r3 = q[1]; }
  } else {
    const unsigned lo = (unsigned)(ra * QKVW + ca * 8) * 2u; const char* b = (const char*)(QKV + (size_t)(it.tok0 + j0 - it.past) * QKVW + col);
    r0 = *(const u32x4*)(b + lo);
    if constexpr (MODE == 2) r2 = *(const u32x4*)(b + (size_t)32 * QKVW * 2 + lo);
  }
}
DI u32x4 cvt8(u32x4 a, u32x4 b) { return pack8(__builtin_bit_cast(f32x4, a), __builtin_bit_cast(f32x4, b)); }
template <int MODE, bool ISK, bool SAMPLE>
DI void write_piece(const u32x4& r0, const u32x4& r1, const u32x4& r2, const u32x4& r3, const Item& it, LAS unsigned char* buf, int kt, int tid) {
  constexpr int CPR = MODE == 2 ? 16 : 8, VS = MODE == 2 ? 320 : 192;
  const bool f32src = SAMPLE && kt * 64 < it.past;
  const int ra = tid / CPR, ca = tid % CPR, rb = (tid + NTHREADS) / CPR, cb = (tid + NTHREADS) % CPR;
  { const u32x4 x = f32src ? cvt8(r0, r1) : r0;
    if (ISK) *(LAS u32x4*)(buf + ((MODE == 2 && ca >= 8) ? 8192 : 0) + ra * 128 + (((ca & 7) ^ ((ra >> 1) & 7)) << 4)) = x;
    else *(LAS u32x4*)(buf + ra * VS + ca * 16) = x; }
  if constexpr (MODE == 2) { const u32x4 x = f32src ? cvt8(r2, r3) : r2;
    if (ISK) *(LAS u32x4*)(buf + (cb >= 8 ? 8192 : 0) + rb * 128 + (((cb & 7) ^ ((rb >> 1) & 7)) << 4)) = x;
    else *(LAS u32x4*)(buf + rb * VS + cb * 16) = x; }
}

template <int MODE>
DI void state_store(const u32x4& r0, const u32x4& r2, float* dst, int tid) {
  constexpr int CPR = MODE == 2 ? 16 : 8;
  const int ra = tid / CPR, ca = tid % CPR, rb = (tid + NTHREADS) / CPR, cb = (tid + NTHREADS) % CPR;
  { float* q = dst + (size_t)ra * 512 + ca * 8;
    __builtin_nontemporal_store((f32x4){bflo(r0[0]), bfhi(r0[0]), bflo(r0[1]), bfhi(r0[1])}, (f32x4*)q); __builtin_nontemporal_store((f32x4){bflo(r0[2]), bfhi(r0[2]), bflo(r0[3]), bfhi(r0[3])}, (f32x4*)(q + 4)); }
  if constexpr (MODE == 2) { float* q = dst + (size_t)rb * 512 + cb * 8;
    __builtin_nontemporal_store((f32x4){bflo(r2[0]), bfhi(r2[0]), bflo(r2[1]), bfhi(r2[1])}, (f32x4*)q); __builtin_nontemporal_store((f32x4){bflo(r2[2]), bfhi(r2[2]), bflo(r2[3]), bfhi(r2[3])}, (f32x4*)(q + 4)); }
}
template <int MODE>
DI float* state_dst(const Params& p, int layer, const Item& it, int kt, int isv) {
  const int hoff = MODE == 2 ? it.h * 128 : it.h * 64;
  if (it.past == 0) {
    const int t0 = kt * 64; if (t0 < it.q0 || t0 >= it.q0 + it.nqv) return nullptr;
    const int b = it.tok0 / SEQ;
    if (MODE == 0) { if (t0 < SEQ - 512) return nullptr; return p.out + (isv ? O_PAV : O_PAK) + ((size_t)(layer * 4 + b) * 512 + (t0 - (SEQ - 512))) * 512 + hoff; }
    return p.out + (MODE == 1 ? (isv ? O_PBV : O_PBK) : (isv ? O_PCV : O_PCK)) + ((size_t)(layer * 4 + b) * SEQ + t0) * 512 + hoff;
  } else {
    if (kt * 64 != it.past) return nullptr;
    const int bd = (it.tok0 - TOKP) / 64;
    if (MODE == 0) return p.out + (isv ? O_SAV : O_SAK) + ((size_t)(layer * DB + bd) * 512 + 448) * 512 + hoff;
    return p.out + (MODE == 1 ? (isv ? O_SBV : O_SBK) : (isv ? O_SCV : O_SCK)) + ((size_t)(layer * DB + bd) * 64) * 512 + hoff;
  }
}

DI bf16x8 pack_p(const f32x16& x, int s) {
  const f32x4 a = {x[8 * s], x[8 * s + 1], x[8 * s + 2], x[8 * s + 3]}, b = {x[8 * s + 4], x[8 * s + 5], x[8 * s + 6], x[8 * s + 7]};
  return __builtin_bit_cast(bf16x8, pack8(a, b));
}
#define MFMA32(a, b, c) __builtin_amdgcn_mfma_f32_32x32x16_bf16((a), (b), (c), 0, 0, 0)

constexpr int L_KB = 0, KB_BYTES = 16384, L_VB = 32768, VB_BYTES = 20480, L_LUT = 73728, L_FLAGS = 75776, L_XCH = 81920;

template <int MODE, bool SAMPLE>
DI void run_item(const Params& p, int layer, const Item& it, LAS unsigned char* lds_in) {
  LAS unsigned char* lds = opaque_lds(lds_in);
  constexpr int NDV = MODE == 2 ? 4 : 2, VS = MODE == 2 ? 320 : 192;
  int tid_ = threadIdx.x; asm volatile("" : "+v"(tid_));
  const int tid = tid_, lane = tid & 63, wave = __builtin_amdgcn_readfirstlane(tid >> 6);
  const int qi = lane & 31, h2 = lane >> 5;
  const int mp = MODE == 2 ? (wave >> 2) : 0, wrow = MODE == 2 ? (wave & 3) : wave;
  const int q0w = it.q0 + 32 * wrow;
  const bool active = 32 * wrow < it.nqv;
  const bf16_t* QKV = (const bf16_t*)(p.ws + WS_QKV);
  const int hb = MODE == 2 ? it.h * 128 : it.h * 64;
  const int qcol = (MODE == 0 ? 0 : MODE == 1 ? 1536 : 3072) + hb + 64 * mp, kcol = (MODE == 0 ? 512 : MODE == 1 ? 2048 : 3584) + hb, vcol = (MODE == 0 ? 1024 : MODE == 1 ? 2560 : 4096) + hb;
  const int cw = q0w >> 6;
  int kt_first, step, NT;
  if (MODE == 0) { kt_first = (it.q0 >> 6) - 8; if (kt_first < 0) kt_first = 0; step = 1; NT = ((it.q0 + it.nqv - 1) >> 6) - kt_first + 1; }
  else if (MODE == 2) { kt_first = 0; step = 1; NT = ((it.q0 + it.nqv - 1) >> 6) + 1; }
  else { kt_first = (it.q0 + it.nqv - 2) >> 6; step = -1; NT = kt_first + 1; }
  const bool wr_state = it.pflags == 0;
  u32x4 k0 = {}, k1 = {}, k2 = {}, k3 = {}, v0 = {}, v1 = {}, v2 = {}, v3 = {};
  load_piece<MODE, SAMPLE>(k0, k1, k2, k3, it, it.cK, QKV, kcol, kt_first, tid);
  load_piece<MODE, SAMPLE>(v0, v1, v2, v3, it, it.cV, QKV, vcol, kt_first, tid);
  LAS float* lut = (LAS float*)(lds + L_LUT);
  LAS unsigned* flags = (LAS unsigned*)(lds + L_FLAGS);
  if (MODE == 0) { const float bfar = p.a_rel_bias[((size_t)layer * 257 + 256) * 8 + it.h]; for (int i = tid; i < 257; i += NTHREADS) lut[i] = p.a_rel_bias[((size_t)layer * 257 + i) * 8 + it.h] - bfar; }
  if (MODE == 2) { if (tid < 192) lut[tid] = ((const float*)(p.ws + WS_CTL))[CW_T5 + it.h * 192 + tid]; }
  bf16x8 qf[4];
  if (active) { const bf16_t* qp = QKV + (size_t)(it.tok0 + q0w + qi - it.past) * QKVW + qcol + 8 * h2;
#pragma unroll
    for (int s = 0; s < 4; ++s) { const u32x4 w = *(const u32x4*)(qp + 16 * s);
      const f32x4 a = {bflo(w[0]) * 0.125f, bfhi(w[0]) * 0.125f, bflo(w[1]) * 0.125f, bfhi(w[1]) * 0.125f}, b = {bflo(w[2]) * 0.125f, bfhi(w[2]) * 0.125f, bflo(w[3]) * 0.125f, bfhi(w[3]) * 0.125f};
      qf[s] = __builtin_bit_cast(bf16x8, pack8(a, b)); } }
  f32x16 O[NDV];
#pragma unroll
  for (int b = 0; b < NDV; ++b)
#pragma unroll
    for (int i = 0; i < 16; ++i) O[b][i] = 0.f;
  float m_run = -1e30f, l_run = 0.f, R2 = 1.0f; bool done = false, have_p = false;
  bf16x8 pf[4];
#pragma unroll
  for (int s = 0; s < 4; ++s) pf[s] = (bf16x8){0, 0, 0, 0, 0, 0, 0, 0};
  const int krow_off = qi * 128, kswz = (qi >> 1) & 7;
  const int g16 = lane >> 4, trq = (lane & 15) >> 2, trp = lane & 3;
  const int vtr_off = (4 * (g16 >> 1) + trq) * VS + (16 * (g16 & 1) + 4 * trp) * 2;

  write_piece<MODE, true, SAMPLE>(k0, k1, k2, k3, it, lds + L_KB, kt_first, tid);
  if (wr_state) { float* d = state_dst<MODE>(p, layer, it, kt_first, 0); if (d) state_store<MODE>(k0, k2, d, tid); }
  if (NT > 1) load_piece<MODE, SAMPLE>(k0, k1, k2, k3, it, it.cK, QKV, kcol, kt_first + step, tid);
  for (int t = 0;; ++t) {
    __syncthreads();
    if (MODE == 1 && t > 0 && t < NT) { const unsigned any = flags[0] | flags[1] | flags[2] | flags[3] | flags[4] | flags[5] | flags[6] | flags[7]; if (!any) NT = t; }
    const int kt = kt_first + step * t;
    bool mine = false;
    if (t < NT && !(it.pflags & 2)) {
      if (MODE == 0) mine = active && kt >= cw - 8 && kt <= cw;
      else if (MODE == 2) mine = active && kt <= cw;
      else mine = active && !done && kt * 64 <= q0w + 30;
    }
    LAS unsigned char* vb = lds + L_VB + ((t - 1) & 1) * VB_BYTES + vtr_off;
    LAS unsigned char* kb = lds + L_KB + (t & 1) * KB_BYTES + ((MODE == 2 && mp) ? 8192 : 0);
    constexpr int HB = NDV / 2, NST = 4 * HB;
    bf16x8 kfa[4], vfa[2], vfb[2];
    const bool do_pv = have_p && !(it.pflags & 8);
#define V_LOAD(dst, j_) do { if (do_pv) { _Pragma("unroll") for (int bb = 0; bb < 2; ++bb) { const int a0 = 16 * ((j_) / HB) * VS + 64 * (2 * ((j_) % HB) + bb); \
      const s16x4 lo = __builtin_amdgcn_ds_read_tr16_b64_v4i16((LAS s16x4*)(vb + a0)), hi = __builtin_amdgcn_ds_read_tr16_b64_v4i16((LAS s16x4*)(vb + a0 + 8 * VS)); \
      dst[bb] = __builtin_shufflevector(lo, hi, 0, 1, 2, 3, 4, 5, 6, 7); } } } while (0)
#define V_MMA(src, j_) do { if (do_pv) { _Pragma("unroll") for (int bb = 0; bb < 2; ++bb) O[2 * ((j_) % HB) + bb] = MFMA32(src[bb], pf[(j_) / HB], O[2 * ((j_) % HB) + bb]); } } while (0)
#define STG(j_, cur, nxt) do { if (SAMPLE) { V_LOAD(cur, j_); V_MMA(cur, j_); } else { if ((j_) + 1 < NST) V_LOAD(nxt, (j_) + 1); V_MMA(cur, j_); } } while (0)
    if (!SAMPLE) {
      if (mine) {
#pragma unroll
        for (int s = 0; s < 4; ++s) kfa[s] = *(const LAS bf16x8*)(kb + krow_off + (((2 * s + h2) ^ kswz) << 4)); }
      V_LOAD(vfa, 0);
      __builtin_amdgcn_sched_barrier(0);
    }
    if (t < NT && !(it.pflags & 1)) { write_piece<MODE, false, SAMPLE>(v0, v1, v2, v3, it, lds + L_VB + (t & 1) * VB_BYTES, kt_first + step * t, tid);
      if (wr_state) { float* d = state_dst<MODE>(p, layer, it, kt_first + step * t, 1); if (d) state_store<MODE>(v0, v2, d, tid); }
      if (t + 1 < NT) { write_piece<MODE, true, SAMPLE>(k0, k1, k2, k3, it, lds + L_KB + ((t + 1) & 1) * KB_BYTES, kt_first + step * (t + 1), tid);
        if (wr_state) { float* d = state_dst<MODE>(p, layer, it, kt_first + step * (t + 1), 0); if (d) state_store<MODE>(k0, k2, d, tid); }
        load_piece<MODE, SAMPLE>(v0, v1, v2, v3, it, it.cV, QKV, vcol, kt_first + step * (t + 1), tid);
        if (t + 2 < NT) load_piece<MODE, SAMPLE>(k0, k1, k2, k3, it, it.cK, QKV, kcol, kt_first + step * (t + 2), tid); } }
    __builtin_amdgcn_sched_barrier(0);
    f32x16 sA, sB;
#pragma unroll
    for (int i = 0; i < 16; ++i) { sA[i] = 0.f; sB[i] = 0.f; }
    if (mine) {
      bf16x8 kfc[4];
      if (SAMPLE) {
#pragma unroll
        for (int s = 0; s < 4; ++s) kfa[s] = *(const LAS bf16x8*)(kb + krow_off + (((2 * s + h2) ^ kswz) << 4)); }
#pragma unroll
      for (int s = 0; s < 4; ++s) kfc[s] = *(const LAS bf16x8*)(kb + 4096 + krow_off + (((2 * s + h2) ^ kswz) << 4));
#pragma unroll
      for (int s = 0; s < 4; ++s) sA = MFMA32(kfa[s], qf[s], sA);
#pragma unroll
      for (int s = 0; s < 4; ++s) sB = MFMA32(kfc[s], qf[s], sB);
    }
    const int kbase = kt * 64 + 4 * h2;
    if (MODE != 1) {
      float mx = -1e30f, alpha = 1.0f, lsa = 0.f, lsb = 0.f; bool resc = false;
      const bool smx = mine && !(it.pflags & 4);
      STG(0, vfa, vfb);
      if (NST == 8) STG(1, vfb, vfa);
      if (smx) {
        bool cst;
        if (MODE == 0) cst = q0w - (kt * 64 + 63) >= 128; else cst = kt * 64 + 63 - q0w <= -127;
        if (!cst) {
#pragma unroll
          for (int i = 0; i < 16; ++i) { const int ko = (i & 3) + 8 * (i >> 2);
            int ia, ib;
            if (MODE == 0) { const int d = (q0w + qi) - (kbase + ko); ia = d; ib = d - 32; ia = (ia < -128 ? -128 : ia > 128 ? 128 : ia) + 128; ib = (ib < -128 ? -128 : ib > 128 ? 128 : ib) + 128; }
            else { const int d = (kbase + ko) - (q0w + qi); ia = d; ib = d + 32; ia = (ia < -127 ? -127 : ia > 63 ? 63 : ia) + 127; ib = (ib < -127 ? -127 : ib > 63 ? 63 : ib) + 127; }
            sA[i] += lut[ia]; sB[i] += lut[ib]; }
        }
        float m0 = fmaxf(fmaxf(sA[0], sA[1]), sA[2]), m1 = fmaxf(fmaxf(sB[0], sB[1]), sB[2]);
#pragma unroll
        for (int i = 3; i < 15; i += 2) { m0 = fmaxf(fmaxf(m0, sA[i]), sA[i + 1]); m1 = fmaxf(fmaxf(m1, sB[i]), sB[i + 1]); }
        mx = fmaxf(fmaxf(m0, m1), fmaxf(sA[15], sB[15]));
      }
      __builtin_amdgcn_sched_barrier(0);
      if (NST == 8) { STG(2, vfa, vfb); STG(3, vfb, vfa); } else STG(1, vfb, vfa);
      if (smx) {
        mx = fmaxf(mx, __shfl_xor(mx, 32)) * LOG2E;
        resc = !__all(mx <= m_run + 8.0f);
        if (resc) { const float mnew = fmaxf(m_run, mx); alpha = fast_exp2(m_run - mnew); m_run = mnew; l_run *= alpha; }
#pragma unroll
        for (int i = 0; i < 16; ++i) { sA[i] = fast_exp2(__builtin_fmaf(sA[i], LOG2E, -m_run)); lsa += sA[i]; }
      }
      __builtin_amdgcn_sched_barrier(0);
      if (NST == 8) { STG(4, vfa, vfb); STG(5, vfb, vfa); } else STG(2, vfa, vfb);
      if (smx) {
#pragma unroll
        for (int i = 0; i < 16; ++i) { sB[i] = fast_exp2(__builtin_fmaf(sB[i], LOG2E, -m_run)); lsb += sB[i]; }
        l_run += lsa + lsb;
      }
      __builtin_amdgcn_sched_barrier(0);
      if (NST == 8) { STG(6, vfa, vfb); STG(7, vfb, vfa); } else STG(3, vfb, vfa);
      __builtin_amdgcn_sched_barrier(0);
      if (mine) {
        if (resc) {
#pragma unroll
        for (int b = 0; b < NDV; ++b)
#pragma unroll
          for (int i = 0; i < 16; ++i) O[b][i] *= alpha;
        }
        pf[0] = pack_p(sA, 0); pf[1] = pack_p(sA, 1); pf[2] = pack_p(sB, 0); pf[3] = pack_p(sB, 1);
      }
    } else {
      STG(0, vfa, vfb); STG(1, vfb, vfa); STG(2, vfa, vfb); STG(3, vfb, vfa);
      if (mine) {
        const bool diag = kt * 64 + 63 >= q0w;
        float kpA[16], kpB[16];
#pragma unroll
        for (int i = 0; i < 16; ++i) { const int ko = (i & 3) + 8 * (i >> 2);
          { const float r = fast_rcp(1.0f + fast_exp2(sA[i] * LOG2E)); const bool ok = !diag || (kbase + ko) < (q0w + qi); kpA[i] = ok ? r : 1.0f; sA[i] = ok ? 1.0f - r : 0.0f; }
          { const float r = fast_rcp(1.0f + fast_exp2(sB[i] * LOG2E)); const bool ok = !diag || (kbase + 32 + ko) < (q0w + qi); kpB[i] = ok ? r : 1.0f; sB[i] = ok ? 1.0f - r : 0.0f; } }
        float gs[8], pg[8];
#pragma unroll
        for (int g = 0; g < 4; ++g) { gs[g] = (kpA[4 * g] * kpA[4 * g + 1]) * (kpA[4 * g + 2] * kpA[4 * g + 3]); gs[4 + g] = (kpB[4 * g] * kpB[4 * g + 1]) * (kpB[4 * g + 2] * kpB[4 * g + 3]); }
#pragma unroll
        for (int g = 0; g < 8; ++g) pg[g] = __shfl_xor(gs[g], 32);
        float suf = R2;
#pragma unroll
        for (int g = 7; g >= 0; --g) { const float off = suf * (h2 == 0 ? pg[g] : 1.0f);
          if (g >= 4) { const int b = 4 * (g - 4); const float a3 = off, a2 = a3 * kpB[b + 3], a1 = a2 * kpB[b + 2], a0 = a1 * kpB[b + 1];
            sB[b + 3] *= a3; sB[b + 2] *= a2; sB[b + 1] *= a1; sB[b] *= a0; }
          else { const int b = 4 * g; const float a3 = off, a2 = a3 * kpA[b + 3], a1 = a2 * kpA[b + 2], a0 = a1 * kpA[b + 1];
            sA[b + 3] *= a3; sA[b + 2] *= a2; sA[b + 1] *= a1; sA[b] *= a0; }
          suf *= gs[g] * pg[g]; }
        R2 = suf;
        done = __all(R2 < STICK_DONE) != 0;
        pf[0] = pack_p(sA, 0); pf[1] = pack_p(sA, 1); pf[2] = pack_p(sB, 0); pf[3] = pack_p(sB, 1);
      }
    }
#undef V_LOAD
#undef V_MMA
#undef STG
    have_p = mine;
    if (MODE == 1 && t < NT) { if (lane == 0) flags[wave] = (active && !done && kt > 0 && (kt - 1) * 64 <= q0w + 30) ? 1u : 0u; }
    if (t >= NT) break;
  }
  int lane_e = lane; asm volatile("" : "+v"(lane_e));
  const int qi_e = lane_e & 31, h2_e = lane_e >> 5;
  bf16_t* Ob = (bf16_t*)(p.ws + WS_O);
  const int ocol = MODE == 0 ? hb : MODE == 1 ? 512 + hb : 1024 + hb;
  const bool wr_out = it.pflags == 0;
  if (MODE != 2) {
    if (active && wr_out) { float sc = 1.f; if (MODE == 0) { const float lt = l_run + __shfl_xor(l_run, 32); sc = fast_rcp(lt); }
      bf16_t* op = Ob + (size_t)(it.tok0 + q0w + qi_e - it.past) * OW + ocol + 4 * h2_e;
#pragma unroll
      for (int b = 0; b < NDV; ++b)
#pragma unroll
        for (int g = 0; g < 4; ++g) { const f32x4 v = {O[b][4 * g] * sc, O[b][4 * g + 1] * sc, O[b][4 * g + 2] * sc, O[b][4 * g + 3] * sc}; *(u32x2*)(op + 32 * b + 8 * g) = pack4(v); } }
    __syncthreads();
  } else {
    const float lam = ((const float*)(p.ws + WS_CTL))[CW_LAM + layer];
    const float sub_scale = 1.0f - (0.8f - 0.6f * expf(-0.3f * (float)layer));
    LAS float* xch = (LAS float*)(lds + L_XCH);
    if (active && mp == 1) { const float lt = l_run + __shfl_xor(l_run, 32), sc = lam * fast_rcp(lt);
#pragma unroll
      for (int b = 0; b < NDV; ++b)
#pragma unroll
        for (int i = 0; i < 16; ++i) xch[((wave & 3) * 64 + b * 16 + i) * 64 + lane_e] = O[b][i] * sc; }
    __syncthreads();
    if (active && mp == 0 && wr_out) { const float lt = l_run + __shfl_xor(l_run, 32), sc = fast_rcp(lt); float q = 0.f;
#pragma unroll
      for (int b = 0; b < NDV; ++b)
#pragma unroll
        for (int i = 0; i < 16; ++i) { const float o = O[b][i] * sc - xch[((wave & 3) * 64 + b * 16 + i) * 64 + lane_e]; O[b][i] = o; q += o * o; if ((i & 7) == 7) __builtin_amdgcn_sched_barrier(0); }
      q += __shfl_xor(q, 32);
      const float rstd = __builtin_amdgcn_rsqf(q * (1.0f / 128.0f) + EPS) * sub_scale;
      const float* gain = p.c_subln + layer * 128 + 4 * h2_e;
      bf16_t* op = Ob + (size_t)(it.tok0 + q0w + qi_e - it.past) * OW + ocol + 4 * h2_e;
#pragma unroll
      for (int b = 0; b < NDV; ++b)
#pragma unroll
        for (int g = 0; g < 4; ++g) { const f32x4 gn = *(const f32x4*)(gain + 32 * b + 8 * g);
          const f32x4 v = {O[b][4 * g] * rstd * gn[0], O[b][4 * g + 1] * rstd * gn[1], O[b][4 * g + 2] * rstd * gn[2], O[b][4 * g + 3] * rstd * gn[3]}; *(u32x2*)(op + 32 * b + 8 * g) = pack4(v); } }
    __syncthreads();
  }
}

DI void copy_item(const Params& p, int layer, int idx) {
  const int which = idx >> 5, bd = idx & 31;
  const size_t lb = (size_t)layer * DB + bd;
  const f32x4* src = (const f32x4*)((which ? p.cache_a_v : p.cache_a_k) + lb * 512 * 512 + 64 * 512);
  f32x4* dst = (f32x4*)(p.out + (which ? O_SAV : O_SAK) + lb * 512 * 512);
  int tid_ = threadIdx.x; asm volatile("" : "+v"(tid_));
#pragma unroll 4
  for (int i = tid_; i < 448 * 128; i += NTHREADS) __builtin_nontemporal_store(__builtin_nontemporal_load(src + i), dst + i);
}
#ifndef PROBE_ATT_FLAGS
#define PROBE_ATT_FLAGS 0
#endif
#ifndef PROBE_ATT_LO
#define PROBE_ATT_LO 0
#define PROBE_ATT_HI NITEMS
#endif
DI void attn_phase(const Params& p, int qidx, LAS unsigned char* lds) {
  const int layer = qidx & 1; const int i_lo = qidx >= 2 ? PROBE_ATT_LO : 0, i_hi = qidx >= 2 ? PROBE_ATT_HI : NITEMS;
  unsigned* head = (unsigned*)(p.ws + WS_CTL) + CW_QUEUE + 64 * qidx;
  LAS unsigned* slot = (LAS unsigned*)(lds + LDS_BYTES - 48);
  if (threadIdx.x == 0) slot[0] = atomicAdd(head, 1u);
  for (int k = 0;; ++k) {
    __syncthreads();
    const int idx = __builtin_amdgcn_readfirstlane((int)slot[k & 1]) + i_lo;
    if (threadIdx.x == 0) slot[(k + 1) & 1] = atomicAdd(head, 1u);
    if (idx >= i_hi) break;
    Item it = decode(p, layer, idx); it.pflags = qidx >= 2 ? PROBE_ATT_FLAGS : 0;
    if (it.mode == 3) { if (qidx < 2) copy_item(p, layer, it.h); continue; }
    if (it.past == 0) { if (it.mode == 0) run_item<0, false>(p, layer, it, lds); else if (it.mode == 1) run_item<1, false>(p, layer, it, lds); else run_item<2, false>(p, layer, it, lds); }
    else { if (it.mode == 0) run_item<0, true>(p, layer, it, lds); else if (it.mode == 1) run_item<1, true>(p, layer, it, lds); else run_item<2, true>(p, layer, it, lds); }
  }
}
}
#define XB_TMO      128
#define XB_XCNT(j)  (256  + 64 * (j))
#define XB_XSUB(j)  (1280 + 64 * (j))
#define XB_XGEN(j)  (2304 + 64 * (j))
#define XB_TOP      3328
#define XB_TOPGEN   3392
#define XCD_BAR_WORDS 3456
#define XB_SPIN_CAP (1u << 18)
DI unsigned xb_ld(unsigned* p)              { return __hip_atomic_load(p, __ATOMIC_RELAXED, __HIP_MEMORY_SCOPE_AGENT); }
DI unsigned xb_add(unsigned* p, unsigned v) { return __hip_atomic_fetch_add(p, v, __ATOMIC_RELAXED, __HIP_MEMORY_SCOPE_AGENT); }
DI unsigned xb_xcc_id() { return (unsigned)__builtin_amdgcn_s_getreg((3 << 11) | 20) & 0xFu; }
#define XB_SPIN(cond, bar) do { unsigned _sp = 0; while (cond) { __builtin_amdgcn_s_sleep(1); \
    if ((++_sp & 255u) == 0u) { if (xb_ld(&(bar)[XB_TMO])) break; if (_sp > XB_SPIN_CAP) { atomicAdd(&(bar)[XB_TMO], 1u); break; } } } } while (0)
struct XcdBarrier { unsigned* bar; unsigned x; volatile LAS unsigned* st; };
DI XcdBarrier xcd_barrier_post(unsigned* bar, volatile LAS unsigned* st) {
  XcdBarrier b; b.bar = bar; b.x = xb_xcc_id(); b.st = st;
  if (threadIdx.x == 0) (void)xb_add(&bar[XB_XCNT(b.x)], 1u);
  return b;
}
DI void xcd_barrier_complete(unsigned* bar, unsigned x, unsigned& nloc, unsigned& nx) {
  const unsigned G = gridDim.x * gridDim.y * gridDim.z;
  unsigned sum, cnt, mine, sp = 0u;
  for (;;) {
    sum = 0u; cnt = 0u; mine = 0u;
#pragma unroll
    for (unsigned j = 0; j < 16; ++j) { const unsigned c = xb_ld(&bar[XB_XCNT(j)]); sum += c; cnt += (c > 0u) ? 1u : 0u; mine = (j == x) ? c : mine; }
    if (sum == G) break;
    __builtin_amdgcn_s_sleep(1);
    if ((++sp & 255u) == 0u) { if (xb_ld(&bar[XB_TMO])) break; if (sp > XB_SPIN_CAP) { atomicAdd(&bar[XB_TMO], 1u); break; } }
  }
  nloc = mine > 0u ? mine : 1u; nx = cnt > 0u ? cnt : 1u;
}
DI void xcd_barrier(const XcdBarrier& b) {
  asm volatile("s_waitcnt vmcnt(0)" ::: "memory");
  __syncthreads();
  if (threadIdx.x == 0) {
    unsigned* bar = b.bar;
    __builtin_amdgcn_s_waitcnt(0);
    unsigned nloc = b.st[0], nx = b.st[1];
    if (nloc == 0u) { xcd_barrier_complete(bar, b.x, nloc, nx); b.st[0] = nloc; b.st[1] = nx; }
    const unsigned old = xb_add(&bar[XB_XSUB(b.x)], 1u);
    const unsigned gen = old / nloc;
    if (old + 1u == (gen + 1u) * nloc) {
      __builtin_amdgcn_fence(__ATOMIC_RELEASE, "agent");
      asm volatile("s_waitcnt vmcnt(0)" ::: "memory");
      const unsigned og = xb_add(&bar[XB_TOP], 1u);
      const unsigned tg = og / nx;
      if (og + 1u == (tg + 1u) * nx) xb_add(&bar[XB_TOPGEN], 1u);
      else XB_SPIN(xb_ld(&bar[XB_TOPGEN]) == tg, bar);
      __builtin_amdgcn_fence(__ATOMIC_ACQUIRE, "agent");
      xb_add(&bar[XB_XGEN(b.x)], 1u);
      asm volatile("s_waitcnt vmcnt(0)" ::: "memory");
    } else {
      XB_SPIN(xb_ld(&bar[XB_XGEN(b.x)]) == gen, bar);
      __builtin_amdgcn_fence(__ATOMIC_ACQUIRE, "agent");
      asm volatile("s_waitcnt vmcnt(0)" ::: "memory");
    }
  }
  __syncthreads();
}
constexpr int L_BARST = LDS_BYTES - 64;

#ifndef PROBE_P1_FLAGS
#define PROBE_P1_FLAGS 0
#endif
#ifndef PROBE_NULL_EPI
#define PROBE_NULL_EPI 0
#endif
#ifndef PROBE_MASK
#define PROBE_MASK 0
#endif
#define REPEAT(k) for (int rep_ = 0; rep_ < (((PROBE_MASK >> (k)) & 1) ? 2 : 1); ++rep_)
constexpr int NPHASE = 2 + 6 * NLAYER;
__global__ void __launch_bounds__(NTHREADS, 2) fwd_megakernel(Params p_k) {
  extern __shared__ __attribute__((aligned(16))) unsigned char lds_raw[];
  LAS unsigned char* lds = (LAS unsigned char*)lds_raw;
  cg::grid_group grid = cg::this_grid();
  const int lo = p_k.ph_lo, hi = p_k.ph_hi;
#define IN(k) (lo <= (k) && (k) < hi)
#define SEAM(k) do { if (IN(k) && IN((k) + 1)) xcd_barrier(bar); } while (0)
  const int G = gridDim.x, c = blockIdx.x;
  if (threadIdx.x < 2) ((LAS unsigned*)(lds + L_BARST))[threadIdx.x] = 0u;
  XcdBarrier bar; bar.bar = (unsigned*)(p_k.ws + WS_CTL) + CW_BAR; bar.x = 0; bar.st = (volatile LAS unsigned*)(lds + L_BARST);
  if (p_k.ph_lo < 0) grid.sync();
  bar = xcd_barrier_post((unsigned*)(p_k.ws + WS_CTL) + CW_BAR, (volatile LAS unsigned*)(lds + L_BARST));
  if (IN(0)) { p0_prologue(p_k, lds); if ((PROBE_MASK >> 6) & 1) { __syncthreads(); p0_prologue(p_k, lds); } }
  SEAM(0);
  for (int l = 0; l < NLAYER; ++l) {
    const int pb = 1 + 6 * l;
    const Params& p = p_k; unsigned char* ws = p.ws;
    if (IN(pb + 0)) REPEAT(0) {
      pg8::GemmDesc g{(const char*)(ws + WS_XB), (const char*)(ws + WS_WIN) + (size_t)l * INC * D * 2, D, D, D / 64, (size_t)256 * D * 2, (size_t)128 * D * 2};
      pg8::P1Order S; S.R1.init(TOK / 256, pg8::P1_NN, G, c);
      EpiP1 E{(const float*)(ws + WS_SS), (bf16_t*)(ws + WS_QKV), (bf16_t*)(ws + WS_GATE), p.b_gate + (size_t)l * 3 * D, p.out, l, rep_ == 1 ? PROBE_P1_FLAGS : 0, lds};
#if PROBE_NULL_EPI
      if (rep_ == 1) { EpiNull EN; pg8::gemm_phase<EpiNull, false, false, pg8::P1Order>(lds, g, S, EN); } else
#endif
      pg8::gemm_phase<EpiP1, false, false, pg8::P1Order>(lds, g, S, E);
    }
    SEAM(pb + 0);
    if (IN(pb + 1)) REPEAT(1) {
      for (int j = G - 1 - c; j < pg8::P1_DEFER; j += G) { pg8::OneUnit S1; S1.u = pg8::p1_deferred_unit(j);
        pg8::gemm_phase<EpiP1, false, false, pg8::OneUnit>(lds, p1_desc(ws, l), S1, p1_epi(p, l, lds)); }
      attn::attn_phase(p, l + 2 * rep_, lds); }
    SEAM(pb + 1);
    if (IN(pb + 2)) REPEAT(2) {
      pg8::GemmDesc g{(const char*)(ws + WS_O), (const char*)(ws + WS_WBR) + (size_t)l * D * OW * 2, OW, OW, OW / 64, (size_t)256 * OW * 2, (size_t)128 * OW * 2};
      pg8::StaticOrder S; S.init(TOKP / 256, D / 256, G, c);
      EpiP3 E{(const bf16_t*)(ws + WS_GATE), (bf16_t*)(ws + WS_H)};
      pg8::gemm_phase<EpiP3>(lds, g, S, E);
      pg8::GemmDesc gh = g; gh.b_tile = (size_t)128 * OW * 2;
      pg8::StaticOrder S2; S2.init(TOKS / 128, D / 128, G, c, TOKP / 128);
      EpiP3T<true, true> E2{(const bf16_t*)(ws + WS_GATE), (bf16_t*)(ws + WS_H)};
      pg8::gemm_phase<EpiP3T<true, true>, true, true>(lds, gh, S2, E2);
    }
    SEAM(pb + 2);
    if (IN(pb + 3)) {
      pg8::GemmDesc g{(const char*)(ws + WS_H), (const char*)(ws + WS_WOUT) + (size_t)l * D * D * 2, D, D, D / 64, (size_t)256 * D * 2, (size_t)128 * D * 2};
      pg8::StaticOrder S; S.init(TOKP / 256, D / 256, G, c);
      EpiRes E{(float*)(ws + WS_X32), (bf16_t*)(ws + WS_XB), (float*)(ws + WS_SS), lds, l == 0 ? p.x_prompt : nullptr, l == 0 ? p.x_sample : nullptr};
      pg8::gemm_phase<EpiRes>(lds, g, S, E);
      pg8::GemmDesc gh = g; gh.b_tile = (size_t)128 * D * 2;
      pg8::StaticOrder S2; S2.init(TOKS / 128, D / 128, G, c, TOKP / 128);
      EpiResT<true, true> E2{(float*)(ws + WS_X32), (bf16_t*)(ws + WS_XB), (float*)(ws + WS_SS), lds, l == 0 ? p.x_prompt : nullptr, l == 0 ? p.x_sample : nullptr};
      pg8::gemm_phase<EpiResT<true, true>, true, true>(lds, gh, S2, E2);
    }
    SEAM(pb + 3);
    if (IN(pb + 4)) REPEAT(4) {
      pg8::GemmDesc g{(const char*)(ws + WS_XB), (const char*)(ws + WS_WUP) + (size_t)l * 2 * DFF * D * 2, D, D, D / 64, (size_t)128 * D * 2, (size_t)DFF * D * 2};
      pg8::StaticOrder S; S.init(TOKP / 256, DFF / 128, G, c);
      EpiP5F E{(const float*)(ws + WS_SS), (bf16_t*)(ws + WS_HF), p.out, p.conv_w + (size_t)l * 3 * DFF, p.conv_b + (size_t)l * DFF, p.state_conv + (size_t)l * DB * 2 * DFF, (float*)(ws + WS_SIDE), lds, l};
      pg8::gemm_phase<EpiP5F>(lds, g, S, E);
      pg8::StaticOrder S2; S2.init(TOKS / 128, DFF / 128, G, (c + G / 2) % G, TOKP / 128);
      EpiP5FT<true> E2{(const float*)(ws + WS_SS), (bf16_t*)(ws + WS_HF), p.out, p.conv_w + (size_t)l * 3 * DFF, p.conv_b + (size_t)l * DFF, p.state_conv + (size_t)l * DB * 2 * DFF, (float*)(ws + WS_SIDE), lds, l};
      pg8::gemm_phase<EpiP5FT<true>, false, true>(lds, g, S2, E2);
    }
    SEAM(pb + 4);
    if (IN(pb + 5)) {
      pg8::GemmDesc g{(const char*)(ws + WS_HF), (const char*)(ws + WS_WDN) + (size_t)l * D * DFF * 2, DFF, DFF, DFF / 64, (size_t)256 * DFF * 2, (size_t)128 * DFF * 2};
      pg8::StaticOrder S; S.init(TOKP / 256, D / 256, G, c);
      { pg8::Unit uu; for (int i = 0; S.next(i, uu); ++i) if (uu.pm < 64 && (uu.pm & 15) != 0) p6_fixup_panel(uu.pm, (const float*)(ws + WS_SIDE), p.conv_w + (size_t)l * 3 * DFF, (bf16_t*)(ws + WS_HF));
        asm volatile("s_waitcnt vmcnt(0)" ::: "memory"); __syncthreads(); }
      EpiRes E{(float*)(ws + WS_X32), (bf16_t*)(ws + WS_XB), (float*)(ws + WS_SS), lds, nullptr, nullptr};
      pg8::gemm_phase<EpiRes>(lds, g, S, E);
      pg8::GemmDesc gh = g; gh.b_tile = (size_t)128 * DFF * 2;
      pg8::StaticOrder S2; S2.init(TOKS / 128, D / 128, G, c, TOKP / 128);
      EpiResT<true, true> E2{(float*)(ws + WS_X32), (bf16_t*)(ws + WS_XB), (float*)(ws + WS_SS), lds, nullptr, nullptr};
      pg8::gemm_phase<EpiResT<true, true>, true, true>(lds, gh, S2, E2);
    }
    SEAM(pb + 5);
  }
  if (IN(NPHASE - 1)) { pfinal_norm(p_k); }
#undef IN
#undef SEAM
}

#ifndef MK_ONE_LAUNCH
#define MK_ONE_LAUNCH 1
#endif
extern "C" void kernel_launch(void* const* d_in, const int* in_sizes, int n_in, void* d_out, int out_size, void* d_ws, size_t ws_size, hipStream_t stream) {
  static int grid_blocks = 0;
  if (grid_blocks == 0) {
    int dev = 0, cus = 0, per_cu = 0;
    (void)hipGetDevice(&dev);
    (void)hipDeviceGetAttribute(&cus, hipDeviceAttributeMultiprocessorCount, dev);
    (void)hipFuncSetAttribute((const void*)fwd_megakernel, hipFuncAttributeMaxDynamicSharedMemorySize, LDS_BYTES);
    (void)hipOccupancyMaxActiveBlocksPerMultiprocessor(&per_cu, (const void*)fwd_megakernel, NTHREADS, LDS_BYTES);
    if (per_cu < 1) { fprintf(stderr, "kernel_launch: occupancy query says %d blocks/CU\n", per_cu); per_cu = 1; }
    grid_blocks = cus * per_cu;
    if (n_in != 24 || (size_t)out_size != O_END || ws_size < WS_END) { fprintf(stderr, "kernel_launch: unexpected problem (n_in %d out %d ws %zu, need %zu)\n", n_in, out_size, ws_size, (size_t)WS_END); grid_blocks = -1; }
  }
  if (grid_blocks < 0) return;
  Params p{};
  const float** f = (const float**)&p;
  for (int i = 0; i < 24; ++i) f[i] = (const float*)d_in[i];
  p.out = (float*)d_out; p.ws = (unsigned char*)d_ws;
#if MK_ONE_LAUNCH
  p.ph_lo = 0; p.ph_hi = NPHASE;
  (void)hipMemsetAsync((unsigned char*)d_ws + WS_CTL + (size_t)CW_BAR * 4, 0, (size_t)XCD_BAR_WORDS * 4, stream);
  { void* args[] = {&p};
    hipError_t e = hipLaunchCooperativeKernel((void*)fwd_megakernel, dim3(grid_blocks), dim3(NTHREADS), args, LDS_BYTES, stream);
    if (e != hipSuccess) fprintf(stderr, "cooperative launch failed: %s (grid %d)\n", hipGetErrorString(e), grid_blocks); }
#else
  for (int k = 0; k < NPHASE; ++k) { p.ph_lo = k; p.ph_hi = k + 1; void* args[] = {&p};
    hipError_t e = hipLaunchCooperativeKernel((void*)fwd_megakernel, dim3(grid_blocks), dim3(NTHREADS), args, LDS_BYTES, stream);
    if (e != hipSuccess) { fprintf(stderr, "launch %d failed: %s (grid %d)\n", k, hipGetErrorString(e), grid_blocks); break; } }
#endif
}
```

```cpp
#include <hip/hip_runtime.h>
#include <hip/hip_cooperative_groups.h>
#include <cstdio>
#include <cstdint>
namespace cg = cooperative_groups;

#define DI __device__ __forceinline__
#define LAS __attribute__((address_space(3)))
typedef unsigned short bf16_t;
typedef short bf16x8 __attribute__((ext_vector_type(8)));
typedef short s16x4 __attribute__((ext_vector_type(4)));
typedef float f32x2 __attribute__((ext_vector_type(2)));
typedef float f32x4 __attribute__((ext_vector_type(4)));
typedef float f32x8 __attribute__((ext_vector_type(8)));
typedef float f32x16 __attribute__((ext_vector_type(16)));
typedef unsigned u32x2 __attribute__((ext_vector_type(2)));
typedef unsigned u32x4 __attribute__((ext_vector_type(4)));
typedef __bf16 bfv4 __attribute__((ext_vector_type(4)));
typedef __bf16 bfv8 __attribute__((ext_vector_type(8)));

constexpr int D = 1024, SEQ = 4096, NB = 4, TOKP = NB * SEQ, DB = 32, DSEQ = 64, TOKS = DB * DSEQ, TOK = TOKP + TOKS;
constexpr int PAST = 1024, ALEN = 512, INC = 7680, DFF = 2816, NLAYER = 2;
constexpr int QKVW = 4608, GATEW = 3072, OW = 1536;
constexpr float EPS = 1e-6f, LOG2E = 1.4426950408889634f;

constexpr size_t O_YP = 0, O_YS = O_YP + (size_t)TOKP * D, O_PAK = O_YS + (size_t)TOKS * D, O_PAV = O_PAK + (size_t)2 * 4 * 512 * 512,
                 O_PBK = O_PAV + (size_t)2 * 4 * 512 * 512, O_PBV = O_PBK + (size_t)2 * TOKP * 512, O_PCK = O_PBV + (size_t)2 * TOKP * 512,
                 O_PCV = O_PCK + (size_t)2 * TOKP * 512, O_PCONV = O_PCV + (size_t)2 * TOKP * 512, O_SAK = O_PCONV + (size_t)2 * 4 * 2 * DFF,
                 O_SAV = O_SAK + (size_t)2 * DB * 512 * 512, O_SBK = O_SAV + (size_t)2 * DB * 512 * 512, O_SBV = O_SBK + (size_t)2 * TOKS * 512,
                 O_SCK = O_SBV + (size_t)2 * TOKS * 512, O_SCV = O_SCK + (size_t)2 * TOKS * 512, O_SCONV = O_SCV + (size_t)2 * TOKS * 512,
                 O_END = O_SCONV + (size_t)2 * DB * 2 * DFF;

constexpr size_t MiB = 1u << 20;
constexpr size_t WS_CTL = 0;
constexpr size_t WS_WIN = 1 * MiB;
constexpr size_t WS_WBR = WS_WIN + (size_t)2 * INC * D * 2;
constexpr size_t WS_WOUT = WS_WBR + (size_t)2 * D * OW * 2;
constexpr size_t WS_WUP = WS_WOUT + (size_t)2 * D * D * 2;
constexpr size_t WS_WDN = WS_WUP + (size_t)2 * 2 * DFF * D * 2;
constexpr size_t WS_XB = WS_WDN + (size_t)2 * D * DFF * 2;
constexpr size_t WS_X32 = WS_XB + (size_t)TOK * D * 2;
constexpr size_t WS_SS = WS_X32 + (size_t)TOK * D * 4;
constexpr size_t WS_SIDE = WS_SS + (size_t)TOK * 8 * 4;
constexpr size_t WS_O = WS_SIDE + (size_t)3 * 72 * 2 * DFF * 4;
constexpr size_t WS_H = WS_O + (size_t)TOK * OW * 2;
constexpr size_t WS_HF = WS_H + (size_t)TOK * D * 2;
constexpr size_t WS_QKV = WS_HF + (size_t)TOK * DFF * 2;
constexpr size_t WS_GATE = WS_QKV + (size_t)TOK * QKVW * 2;
constexpr size_t WS_END = WS_GATE + (size_t)TOK * GATEW * 2;
constexpr int CW_QUEUE = 64;
constexpr int CW_LAM = 1024;
constexpr int CW_T5 = 2048;
constexpr int CW_BAR = 8192;

constexpr int LDS_BYTES = 160 * 1024;
constexpr int NTHREADS = 512;

DI u32x4 pack8(f32x4 a, f32x4 b) { f32x8 v = {a[0], a[1], a[2], a[3], b[0], b[1], b[2], b[3]}; return __builtin_bit_cast(u32x4, __builtin_convertvector(v, bfv8)); }
DI u32x2 pack4(f32x4 a) { return __builtin_bit_cast(u32x2, __builtin_convertvector(a, bfv4)); }
DI float bflo(unsigned w) { return __uint_as_float(w << 16); }
DI float bfhi(unsigned w) { return __uint_as_float(w & 0xffff0000u); }
DI float wave_sum(float v) {
#pragma unroll
  for (int o = 1; o < 64; o <<= 1) v += __shfl_xor(v, o);
  return v;
}
DI float fast_rcp(float x) { return __builtin_amdgcn_rcpf(x); }
DI float fast_exp2(float x) { return __builtin_amdgcn_exp2f(x); }
DI float fast_log2(float x) { return __builtin_amdgcn_logf(x); }

DI LAS unsigned char* opaque_lds(LAS unsigned char* p) { unsigned v = (unsigned)(__UINTPTR_TYPE__)p; asm volatile("" : "+s"(v)); return (LAS unsigned char*)(__UINTPTR_TYPE__)v; }

struct Params {
  const float* x_prompt; const float* x_sample;
  const float* cache_a_k; const float* cache_a_v; const float* cache_b_k; const float* cache_b_v; const float* cache_c_k; const float* cache_c_v;
  const float* state_conv; const float* norm_mix; const float* w_in; const float* b_gate; const float* a_rel_bias; const float* t5_bias;
  const float* c_lambda; const float* c_subln; const float* w_branch; const float* w_out; const float* norm_ffn; const float* w_up;
  const float* conv_w; const float* conv_b; const float* w_down; const float* norm_final;
  float* out; unsigned char* ws;
  int ph_lo, ph_hi;
};

DI void p0_transpose_item(const float* W, int N, const float* kscale, bf16_t* WT, int dst_ld, int dst_col, LAS float* scr, int item, int lane) {
  const int nblk = N / 32, kb = item / nblk, nb = item % nblk, k0 = 64 * kb, n0 = 32 * nb;
  float wv[32];
#pragma unroll
  for (int i = 0; i < 32; ++i) wv[i] = __builtin_nontemporal_load(&W[(size_t)(k0 + 2 * i + (lane >> 5)) * N + n0 + (lane & 31)]);
#pragma unroll
  for (int i = 0; i < 32; ++i) { const int kk = 2 * i + (lane >> 5); float v = wv[i]; if (kscale) v *= kscale[k0 + kk]; scr[kk * 33 + (lane & 31)] = v; }
  asm volatile("s_waitcnt lgkmcnt(0)" ::: "memory");
  const int c = lane & 7;
#pragma unroll
  for (int j = 0; j < 4; ++j) { const int n = (lane >> 3) + 8 * j; const LAS float* s = scr + (8 * c) * 33 + n;
    f32x4 a = {s[0 * 33], s[1 * 33], s[2 * 33], s[3 * 33]}, b = {s[4 * 33], s[5 * 33], s[6 * 33], s[7 * 33]};
    *(u32x4*)(WT + (size_t)(n0 + n) * dst_ld + dst_col + k0 + 8 * c) = pack8(a, b); }
  asm volatile("s_waitcnt lgkmcnt(0)" ::: "memory");
}

DI int t5_bucket_of(int rel) {
  const int n = rel < 0 ? -rel : rel; int f;
  if (n < 8) f = n; else if (n < 12) f = 8; else if (n < 16) f = 9; else if (n < 23) f = 10; else if (n < 32) f = 11; else if (n < 46) f = 12; else if (n < 64) f = 13; else if (n < 91) f = 14; else f = 15;
  return (rel > 0 ? 16 : 0) + f;
}

DI void p0_prologue(const Params& p, LAS unsigned char* lds_in) {
  LAS unsigned char* lds = opaque_lds(lds_in);
  int tid_ = threadIdx.x; asm volatile("" : "+v"(tid_));
  const int tid = tid_, lane = tid & 63, wave = tid >> 6;
  const int gw = blockIdx.x * 8 + wave, NGW = gridDim.x * 8;
  unsigned* ctl = (unsigned*)(p.ws + WS_CTL);
  if (blockIdx.x == 0) {
    if (tid < 4) ctl[CW_QUEUE + 64 * tid] = 0u;
    if (wave == 1) {
      for (int l = 0; l < NLAYER; ++l) { const float* lp = p.c_lambda + l * 256; const float a = wave_sum(lp[lane] * lp[64 + lane]), b = wave_sum(lp[128 + lane] * lp[192 + lane]);
        const float lam_init = 0.8f - 0.6f * expf(-0.3f * (float)l);
        if (lane == 0) ((float*)ctl)[CW_LAM + l] = expf(a) - expf(b) + lam_init; }
    }
    for (int i = tid; i < 4 * 192; i += NTHREADS) { const int h = i / 192, idx = i % 192; int rel = idx - 127; if (rel > 63) rel = 63;
      ((float*)ctl)[CW_T5 + i] = p.t5_bias[t5_bucket_of(rel) * 4 + h] - p.t5_bias[15 * 4 + h]; }
  }
  LAS float* scr = (LAS float*)(lds + wave * 8448);
  constexpr int I_IN = (D / 64) * (INC / 32), I_BR = (512 / 64) * (D / 32), I_OUT = (D / 64) * (D / 32), I_UP = (D / 64) * (2 * DFF / 32), I_DN = (DFF / 64) * (D / 32);
  constexpr int PER_LAYER = I_IN + 3 * I_BR + I_OUT + I_UP + I_DN;
  for (int it = gw; it < NLAYER * PER_LAYER; it += NGW) {
    const int l = it / PER_LAYER; int r = it % PER_LAYER;
    if (r < I_IN) { p0_transpose_item(p.w_in + (size_t)l * D * INC, INC, p.norm_mix + l * D, (bf16_t*)(p.ws + WS_WIN) + (size_t)l * INC * D, D, 0, scr, r, lane); continue; } r -= I_IN;
    if (r < 3 * I_BR) { const int n = r / I_BR; p0_transpose_item(p.w_branch + ((size_t)l * 3 + n) * 512 * D, D, nullptr, (bf16_t*)(p.ws + WS_WBR) + (size_t)l * D * OW, OW, 512 * n, scr, r % I_BR, lane); continue; } r -= 3 * I_BR;
    if (r < I_OUT) { p0_transpose_item(p.w_out + (size_t)l * D * D, D, nullptr, (bf16_t*)(p.ws + WS_WOUT) + (size_t)l * D * D, D, 0, scr, r, lane); continue; } r -= I_OUT;
    if (r < I_UP) { p0_transpose_item(p.w_up + (size_t)l * D * 2 * DFF, 2 * DFF, p.norm_ffn + l * D, (bf16_t*)(p.ws + WS_WUP) + (size_t)l * 2 * DFF * D, D, 0, scr, r, lane); continue; } r -= I_UP;
    p0_transpose_item(p.w_down + (size_t)l * DFF * D, D, nullptr, (bf16_t*)(p.ws + WS_WDN) + (size_t)l * D * DFF, DFF, 0, scr, r, lane);
  }
  bf16_t* XB = (bf16_t*)(p.ws + WS_XB); float* SS = (float*)(p.ws + WS_SS);
#pragma unroll 3
  for (int m = gw; m < TOK; m += NGW) {
    const float* src = m < TOKP ? p.x_prompt + (size_t)m * D : p.x_sample + (size_t)(m - TOKP) * D;
    float s = 0.f;
#pragma unroll
    for (int j = 0; j < 4; ++j) { const f32x4 v = __builtin_nontemporal_load(&((const f32x4*)src)[lane + 64 * j]); ((u32x2*)(XB + (size_t)m * D))[lane + 64 * j] = pack4(v);
      s += (v[0] * v[0] + v[1] * v[1]) + (v[2] * v[2] + v[3] * v[3]); }
    s = wave_sum(s);
    if (lane < 8) SS[(size_t)m * 8 + lane] = lane == 0 ? s : 0.f;
  }
}

namespace pg8 {
constexpr int BM = 256, BK = 64, HALF = 128, HTB = HALF * BK * 2, STAGE_BYTES = 8 * HTB, NXCD = 8, WGM = 8;
DI int lds_byte(int r, int c) { const int st = (r >> 4) * 2 + (c >> 5), rr = r & 15, cc = c & 31, ob = rr * 64 + cc * 2; return st * 1024 + (ob ^ (((ob >> 9) & 1) << 5)); }
DI void stage_rc(int b, int& R, int& C) { const int st = b / 1024, sb = b % 1024, swz = sb ^ (((sb >> 9) & 1) << 5); R = (st >> 1) * 16 + swz / 64; C = (st & 1) * 32 + (swz % 64) / 2; }
DI int perm32(int rho) { const int n = rho >> 4, i = rho & 15; return 8 * (i >> 2) + 4 * n + (i & 3); }
struct Unit { int pm, pn; };
struct GemmDesc { const char* A; const char* B; int lda, ldb, nt; size_t b_tile, b_half; };
struct StaticOrder {
  int nM, nN, nwg, G, c, pm0;
  DI void init(int nM_, int nN_, int G_, int c_, int pm0_ = 0) { nM = nM_; nN = nN_; nwg = nM * nN; G = G_; c = c_; pm0 = pm0_; }
  DI bool next(int i, Unit& u) const {
    const long L = (long)i * G + c; if (L >= nwg) return false;
    int wgid = (int)L; { const int q = nwg / NXCD, r = nwg % NXCD, xcd = wgid % NXCD, off = wgid / NXCD; wgid = (xcd < r ? xcd * (q + 1) : r * (q + 1) + (xcd - r) * q) + off; }
    const int nig = WGM * nN, gid = wgid / nig, fm = gid * WGM, gsz = (nM - fm) < WGM ? (nM - fm) : WGM;
    u.pm = pm0 + fm + ((wgid % nig) % gsz); u.pn = (wgid % nig) / gsz; return true;
  }
};
constexpr int P1_NN = 28, P1_EXTRA = 32, P1_DEFER = 72 + (72 - P1_EXTRA);
struct P1Order {
  StaticOrder R1;
  DI bool next(int i, Unit& u) const {
    if (R1.next(i, u)) return true;
    const long L = (long)i * R1.G + R1.c - R1.nwg; if (L >= P1_EXTRA) return false;
    u.pm = (int)L; u.pn = P1_NN; return true;
  }
};
DI Unit p1_deferred_unit(int j) { Unit u; if (j < 72) { u.pm = j; u.pn = P1_NN + 1; } else { u.pm = P1_EXTRA + (j - 72); u.pn = P1_NN; } return u; }
struct OneUnit { Unit u; DI bool next(int i, Unit& o) const { if (i != 0) return false; o = u; return true; } };
template <class Epi, bool HALFN = false, bool HALFM = false, class Sched = StaticOrder>
DI void gemm_phase(LAS unsigned char* lds_in, const GemmDesc g, const Sched& S, const Epi& E) {
  LAS unsigned char* lds = opaque_lds(lds_in);
  int tid_ = threadIdx.x; asm volatile("" : "+v"(tid_));
  const int tid = tid_, wid = __builtin_amdgcn_readfirstlane(tid >> 6), lane = tid & 63, wr = wid >> 2, wc = wid & 3, fr = lane & 15, fq = lane >> 4;
  const int nt = g.nt;
  unsigned voffA[2], voffB[2];
#pragma unroll
  for (int i = 0; i < 2; ++i) { int R, C; stage_rc(tid * 16 + i * 8192, R, C); const int Rb = Epi::PERM ? ((R & ~31) + perm32(R & 31)) : R;
    voffA[i] = (unsigned)(R * g.lda + C) * 2u; voffB[i] = (unsigned)(Rb * g.ldb + C) * 2u; }
  const size_t kstep = (size_t)(BK * 2);
  const size_t hsA = (size_t)HALF * g.lda * 2, tsA = HALFM ? hsA : 2 * hsA, hsB = g.b_half, tsB = g.b_tile;
  const unsigned ldsw = (unsigned)wid * 1024u;
  const int aoff = lds_byte(wr * 64 + fr, fq * 8), boff = lds_byte(wc * 32 + fr, fq * 8);
#define PG8_SA(b, h) (((b) * 2 + (h)) * HTB)
#define PG8_SB(b, h) ((4 + (b) * 2 + (h)) * HTB)
#define PG8_STAGE(bufoff, gbase, voff) do { _Pragma("unroll") for (int _i = 0; _i < 2; ++_i) \
    __builtin_amdgcn_global_load_lds((const unsigned*)((const char*)(gbase) + (voff)[_i]), (LAS unsigned*)(lds + (bufoff) + ldsw + _i * 8192), 16, 0, 0); } while (0)
#define PG8_LDA(dst, b, h) do { _Pragma("unroll") for (int m = 0; m < 4; ++m) _Pragma("unroll") for (int k = 0; k < 2; ++k) dst[m][k] = *(const LAS bf16x8*)(lds + PG8_SA(b, h) + aoff + m * 2048 + k * 1024); } while (0)
#define PG8_LDB(dst, b, h) do { _Pragma("unroll") for (int n = 0; n < 2; ++n) _Pragma("unroll") for (int k = 0; k < 2; ++k) dst[n][k] = *(const LAS bf16x8*)(lds + PG8_SB(b, h) + boff + n * 2048 + k * 1024); } while (0)
#define PG8_MMA(ai, bj, At, Bt) do { __builtin_amdgcn_s_setprio(1); _Pragma("unroll") for (int m = 0; m < 4; ++m) _Pragma("unroll") for (int n = 0; n < 2; ++n) _Pragma("unroll") for (int k = 0; k < 2; ++k) \
    acc[ai][bj][m][n] = __builtin_amdgcn_mfma_f32_16x16x32_bf16(Bt[n][k], At[m][k], acc[ai][bj][m][n], 0, 0, 0); __builtin_amdgcn_s_setprio(0); } while (0)
#define PG8_WAIT_V(n) asm volatile("s_waitcnt vmcnt(" #n ")" ::: "memory")
#define PG8_WAIT_LOOP do { if constexpr (HALFM && HALFN) PG8_WAIT_V(4); else if constexpr (HALFM || HALFN) PG8_WAIT_V(6); else PG8_WAIT_V(8); } while (0)
#define PG8_WAIT_L(n) asm volatile("s_waitcnt lgkmcnt(" #n ")" ::: "memory")
#define PG8_BAR __builtin_amdgcn_s_barrier()
#define PG8_SCHED __builtin_amdgcn_sched_barrier(0)
  Unit cur, nxt; int ui = 0;
  if (!S.next(0, cur)) return;
  f32x4 acc[2][2][4][2];
#pragma unroll
  for (int a = 0; a < 2; ++a)
#pragma unroll
    for (int b = 0; b < 2; ++b)
#pragma unroll
      for (int m = 0; m < 4; ++m)
#pragma unroll
        for (int n = 0; n < 2; ++n) acc[a][b][m][n] = (f32x4){0.f, 0.f, 0.f, 0.f};
  bf16x8 At[4][2], B0[2][2], B1[2][2];
  const char* cA = g.A + (size_t)cur.pm * tsA; const char* cB = g.B + (size_t)cur.pn * tsB;
  f32x4 ssv = {0.f, 0.f, 0.f, 0.f};
  if constexpr (Epi::HAS_RS) ssv = E.prefetch(cur, tid);
  PG8_STAGE(PG8_SB(0, 0), cB, voffB); if constexpr (!HALFN) PG8_STAGE(PG8_SB(0, 1), cB + hsB, voffB); PG8_STAGE(PG8_SA(0, 0), cA, voffA); if constexpr (!HALFM) PG8_STAGE(PG8_SA(0, 1), cA + hsA, voffA);
  if (wr == 1) PG8_BAR;
  if constexpr (HALFM) PG8_WAIT_V(0); else PG8_WAIT_V(2);
  PG8_BAR;
  PG8_STAGE(PG8_SB(1, 0), cB + kstep, voffB); PG8_STAGE(PG8_SA(1, 0), cA + kstep, voffA); if constexpr (!HALFN) PG8_STAGE(PG8_SB(1, 1), cB + hsB + kstep, voffB);
  if constexpr (HALFN) PG8_WAIT_V(4); else PG8_WAIT_V(6);
  PG8_BAR;
  for (;;) {
    const bool has_next = S.next(ui + 1, nxt);
    const char* nA = has_next ? g.A + (size_t)nxt.pm * tsA : cA; const char* nB = has_next ? g.B + (size_t)nxt.pn * tsB : cB;
    for (int t = 0; t < nt; t += 2) {
      const bool last = (t == nt - 2);
      const char* a1 = cA + (size_t)(t + 1) * kstep;
      const char* a2 = last ? nA : cA + (size_t)(t + 2) * kstep; const char* b2 = last ? nB : cB + (size_t)(t + 2) * kstep;
      const char* a3 = a2 + kstep; const char* b3 = b2 + kstep;
      if constexpr (Epi::HAS_MID) { if (t == 8 || t == 16) E.mid(acc, cur, t, wr, wc, fr, fq); }
      PG8_LDB(B0, 0, 0); if constexpr (!HALFN) PG8_LDB(B1, 0, 1); PG8_SCHED; PG8_LDA(At, 0, 0); if constexpr (!HALFM) PG8_STAGE(PG8_SA(1, 1), a1 + hsA, voffA);
      PG8_WAIT_LOOP; PG8_WAIT_L(0); PG8_BAR; PG8_MMA(0, 0, At, B0); if constexpr (!HALFN) PG8_MMA(0, 1, At, B1); PG8_BAR; PG8_SCHED;
      if constexpr (!HALFM) PG8_LDA(At, 0, 1); PG8_STAGE(PG8_SB(0, 0), b2, voffB); if constexpr (!HALFN) PG8_STAGE(PG8_SB(0, 1), b2 + hsB, voffB); PG8_STAGE(PG8_SA(0, 0), a2, voffA);
      PG8_WAIT_LOOP; PG8_WAIT_L(0); PG8_BAR; if constexpr (!HALFM) { PG8_MMA(1, 0, At, B0); if constexpr (!HALFN) PG8_MMA(1, 1, At, B1); } PG8_BAR; PG8_SCHED;
      PG8_LDB(B0, 1, 0); if constexpr (!HALFN) PG8_LDB(B1, 1, 1); PG8_SCHED; PG8_LDA(At, 1, 0); if constexpr (!HALFM) PG8_STAGE(PG8_SA(0, 1), a2 + hsA, voffA);
      PG8_WAIT_LOOP; PG8_WAIT_L(0); PG8_BAR; PG8_MMA(0, 0, At, B0); if constexpr (!HALFN) PG8_MMA(0, 1, At, B1); PG8_BAR; PG8_SCHED;
      if constexpr (!HALFM) PG8_LDA(At, 1, 1); PG8_STAGE(PG8_SB(1, 0), b3, voffB); if constexpr (!HALFN) PG8_STAGE(PG8_SB(1, 1), b3 + hsB, voffB); PG8_STAGE(PG8_SA(1, 0), a3, voffA);
      PG8_WAIT_LOOP; PG8_WAIT_L(0); PG8_BAR; if constexpr (!HALFM) { PG8_MMA(1, 0, At, B0); if constexpr (!HALFN) PG8_MMA(1, 1, At, B1); } PG8_BAR; PG8_SCHED;
    }
    if (wr == 0) PG8_BAR;
    if constexpr (Epi::HAS_RS) { E.stash(ssv, cur, tid, lds); PG8_WAIT_L(0); PG8_BAR; asm volatile("" ::: "memory"); }
    E(acc, cur, wr, wc, fr, fq);
    if (!has_next) break;
#pragma unroll
    for (int a = 0; a < 2; ++a)
#pragma unroll
      for (int b = 0; b < 2; ++b)
#pragma unroll
        for (int m = 0; m < 4; ++m)
#pragma unroll
          for (int n = 0; n < 2; ++n) acc[a][b][m][n] = (f32x4){0.f, 0.f, 0.f, 0.f};
    cur = nxt; cA = nA; cB = nB; ++ui;
    if constexpr (Epi::HAS_RS) ssv = E.prefetch(cur, tid);
    if (wr == 1) PG8_BAR;
  }
  PG8_WAIT_V(0);
  PG8_BAR;
#undef PG8_SA
#undef PG8_SB
#undef PG8_STAGE
#undef PG8_LDA
#undef PG8_LDB
#undef PG8_MMA
#undef PG8_WAIT_V
#undef PG8_WAIT_LOOP
#undef PG8_WAIT_L
#undef PG8_BAR
#undef PG8_SCHED
}
}
using pg8::Unit;
DI f32x4 ss_load(const float* SS, int r) { const f32x4* q = (const f32x4*)(SS + (size_t)r * 8); return q[0] + q[1]; }
DI float ss_to_rs(const f32x4& a) { return __builtin_amdgcn_rsqf(((a[0] + a[1]) + (a[2] + a[3])) * (1.0f / D) + EPS); }
DI float row_rs(const float* SS, int r) { return ss_to_rs(ss_load(SS, r)); }
DI float sigmoidf_(float x) { return fast_rcp(1.0f + fast_exp2(-x * LOG2E)); }

struct EpiP1 {
  static constexpr bool PERM = true, HAS_MID = false, HAS_RS = true;
  const float* SS; bf16_t* QKV; bf16_t* GATE; const float* bgate; float* out; int layer; int probe_flags; LAS unsigned char* lds;
  DI void mid(f32x4 (&)[2][2][4][2], const Unit&, int, int, int, int, int) const {}
  DI f32x4 prefetch(const Unit& u, int tid) const {
    f32x4 v = {0.f, 0.f, 0.f, 0.f};
    if (tid < 256) v = ss_load(SS, u.pm * 256 + tid);
    return v;
  }
  DI void stash(const f32x4& v, const Unit& u, int tid, LAS unsigned char* l) const {
    if (tid < 256) *(LAS float*)(l + 131072 + 12288 + tid * 4) = ss_to_rs(v);
  }
  DI void operator()(f32x4 (&acc)[2][2][4][2], const Unit& u, int wr, int wc, int fr, int fq) const {
    const int pn = u.pn, rin0 = wr * 64 + fr, row0 = u.pm * 256 + rin0;
    float rs[2][4];
#pragma unroll
    for (int ai = 0; ai < 2; ++ai)
#pragma unroll
      for (int m = 0; m < 4; ++m) rs[ai][m] = *(const LAS float*)(lds + 131072 + 12288 + (rin0 + ai * 128 + m * 16) * 4);
    if (pn < 18) {
      const int colq = pn * 256 + wc * 32 + 8 * fq;
#pragma unroll
      for (int ai = 0; ai < 2; ++ai)
#pragma unroll
        for (int m = 0; m < 4; ++m) {
          const int rin = rin0 + ai * 128 + m * 16, r = u.pm * 256 + rin; const float s = rs[ai][m];
          bf16_t* rowp = QKV + (size_t)r * QKVW + colq;
#pragma unroll
          for (int bj = 0; bj < 2; ++bj) { const f32x4 v0 = acc[ai][bj][m][0] * s, v1 = acc[ai][bj][m][1] * s;
            { const u32x4 pk = pack8(v0, v1); if (!(probe_flags & 2)) *(u32x4*)(rowp + bj * 128) = pk; else asm volatile("" :: "v"(pk)); }
            }
        }
    } else {
      const int gi = pn - 18, nb = gi >> 2, colg = (gi & 3) * 256 + wc * 32 + 8 * fq;
      f32x4 bv[2][2];
#pragma unroll
      for (int bj = 0; bj < 2; ++bj) { bv[bj][0] = *(const f32x4*)(bgate + nb * D + colg + bj * 128); bv[bj][1] = *(const f32x4*)(bgate + nb * D + colg + bj * 128 + 4); }
#pragma unroll
      for (int ai = 0; ai < 2; ++ai)
#pragma unroll
        for (int m = 0; m < 4; ++m) { const int r = row0 + ai * 128 + m * 16; const float s = rs[ai][m];
          bf16_t* rowp = GATE + (size_t)r * GATEW + gi * 256 + wc * 32 + 8 * fq;
#pragma unroll
          for (int bj = 0; bj < 2; ++bj) { f32x4 v0 = acc[ai][bj][m][0] * s + bv[bj][0], v1 = acc[ai][bj][m][1] * s + bv[bj][1];
#pragma unroll
            for (int j = 0; j < 4; ++j) { v0[j] = 1.0f + fast_exp2(fminf(-v0[j] * LOG2E, 100.0f)); v1[j] = 1.0f + fast_exp2(fminf(-v1[j] * LOG2E, 100.0f)); }
            { const u32x4 pk = pack8(v0, v1); if (!(probe_flags & 2)) *(u32x4*)(rowp + bj * 128) = pk; else asm volatile("" :: "v"(pk)); } } }
    }
  }
};

template <bool HALFN, bool HALFM = false> struct EpiP3T {
  static constexpr bool PERM = true, HAS_MID = true, HAS_RS = false;
  const bf16_t* GATE; bf16_t* H;
  DI void mid(f32x4 (&acc)[2][2][4][2], const Unit& u, int t, int wr, int wc, int fr, int fq) const {
    const int nb = (t >> 3) - 1;
    const bf16_t* gp = GATE + (size_t)(u.pm * (HALFM ? 128 : 256) + wr * 64 + fr) * GATEW + nb * D + u.pn * (HALFN ? 128 : 256) + wc * 32 + 8 * fq;
#pragma unroll
    for (int ai = 0; ai < (HALFM ? 1 : 2); ++ai) {
        u32x4 ga[4][2] = {}, gb[4][2] = {};
#pragma unroll
        for (int m = 0; m < 4; ++m)
#pragma unroll
          for (int bj = 0; bj < (HALFN ? 1 : 2); ++bj) { const bf16_t* q = gp + (size_t)(ai * 128 + m * 16) * GATEW + bj * 128; ga[m][bj] = *(const u32x4*)q; gb[m][bj] = *(const u32x4*)(q + D); }
#pragma unroll
        for (int m = 0; m < 4; ++m)
#pragma unroll
          for (int bj = 0; bj < (HALFN ? 1 : 2); ++bj)
#pragma unroll
            for (int n = 0; n < 2; ++n) { const unsigned a0 = ga[m][bj][2 * n], a1 = ga[m][bj][2 * n + 1], b0 = gb[m][bj][2 * n], b1 = gb[m][bj][2 * n + 1];
              acc[ai][bj][m][n][0] *= bflo(b0) * fast_rcp(bflo(a0)); acc[ai][bj][m][n][1] *= bfhi(b0) * fast_rcp(bfhi(a0));
              acc[ai][bj][m][n][2] *= bflo(b1) * fast_rcp(bflo(a1)); acc[ai][bj][m][n][3] *= bfhi(b1) * fast_rcp(bfhi(a1)); }
        asm volatile("" ::: "memory"); }
  }
  DI void operator()(f32x4 (&acc)[2][2][4][2], const Unit& u, int wr, int wc, int fr, int fq) const {
    const int row0 = u.pm * (HALFM ? 128 : 256) + wr * 64 + fr, col0 = u.pn * (HALFN ? 128 : 256) + wc * 32 + 8 * fq;
#pragma unroll
    for (int ai = 0; ai < (HALFM ? 1 : 2); ++ai)
#pragma unroll
      for (int m = 0; m < 4; ++m) { const int r = row0 + ai * 128 + m * 16; const bf16_t* gp = GATE + (size_t)r * GATEW + 2 * D + col0; bf16_t* hp = H + (size_t)r * D + col0;
#pragma unroll
        for (int bj = 0; bj < (HALFN ? 1 : 2); ++bj) { const u32x4 g = *(const u32x4*)(gp + bj * 128); f32x4 v0 = acc[ai][bj][m][0], v1 = acc[ai][bj][m][1];
          v0[0] *= fast_rcp(bflo(g[0])); v0[1] *= fast_rcp(bfhi(g[0])); v0[2] *= fast_rcp(bflo(g[1])); v0[3] *= fast_rcp(bfhi(g[1])); v1[0] *= fast_rcp(bflo(g[2])); v1[1] *= fast_rcp(bfhi(g[2])); v1[2] *= fast_rcp(bflo(g[3])); v1[3] *= fast_rcp(bfhi(g[3]));
          *(u32x4*)(hp + bj * 128) = pack8(v0, v1); } }
  }
};

typedef EpiP3T<false> EpiP3;

template <bool HALFN, bool HALFM = false> struct EpiResT {
  static constexpr bool PERM = true, HAS_MID = false, HAS_RS = false;
  float* X32; bf16_t* XB; float* SS; LAS unsigned char* lds; const float* xin_p; const float* xin_s;
  DI void mid(f32x4 (&)[2][2][4][2], const Unit&, int, int, int, int, int) const {}
  DI void operator()(f32x4 (&acc)[2][2][4][2], const Unit& u, int wr, int wc, int fr, int fq) const {
    const int rin0 = wr * 64 + fr, row0 = u.pm * (HALFM ? 128 : 256) + rin0, col0 = u.pn * (HALFN ? 128 : 256) + wc * 32 + 8 * fq;
    LAS float* red = (LAS float*)(lds + 131072 + 8192);
#pragma unroll
    for (int ai = 0; ai < (HALFM ? 1 : 2); ++ai) {
      f32x4 xo[4][2][2] = {};
#pragma unroll
      for (int m = 0; m < 4; ++m) { const int r = row0 + ai * 128 + m * 16;
        const float* xr = xin_p ? (r < TOKP ? xin_p + (size_t)r * D : xin_s + (size_t)(r - TOKP) * D) + col0 : X32 + (size_t)r * D + col0;
#pragma unroll
        for (int bj = 0; bj < (HALFN ? 1 : 2); ++bj)
#pragma unroll
          for (int n = 0; n < 2; ++n) xo[m][bj][n] = *(const f32x4*)(xr + bj * 128 + n * 4); }
#pragma unroll
      for (int m = 0; m < 4; ++m) { const int r = row0 + ai * 128 + m * 16; float* xp = X32 + (size_t)r * D + col0; bf16_t* bp = XB + (size_t)r * D + col0; float q = 0.f;
#pragma unroll
        for (int bj = 0; bj < (HALFN ? 1 : 2); ++bj)
          { const f32x4 x0 = xo[m][bj][0] + acc[ai][bj][m][0], x1 = xo[m][bj][1] + acc[ai][bj][m][1];
            *(f32x4*)(xp + bj * 128) = x0; *(f32x4*)(xp + bj * 128 + 4) = x1; *(u32x4*)(bp + bj * 128) = pack8(x0, x1);
            q += ((x0[0] * x0[0] + x0[1] * x0[1]) + (x0[2] * x0[2] + x0[3] * x0[3])) + ((x1[0] * x1[0] + x1[1] * x1[1]) + (x1[2] * x1[2] + x1[3] * x1[3])); }
        q += __shfl_xor(q, 16); q += __shfl_xor(q, 32);
        if (fq == 0) red[(rin0 + ai * 128 + m * 16) * 4 + wc] = q; }
      asm volatile("" ::: "memory"); }
    asm volatile("s_waitcnt lgkmcnt(0)" ::: "memory"); __builtin_amdgcn_s_barrier(); asm volatile("" ::: "memory");
    int t = threadIdx.x; asm volatile("" : "+v"(t));
    if (t < (HALFM ? 128 : 256)) { const f32x4 v = *(const LAS f32x4*)(red + t * 4); const float q = (v[0] + v[1]) + (v[2] + v[3]); float* sp = SS + (size_t)(u.pm * (HALFM ? 128 : 256) + t) * 8;
      if (HALFN) sp[u.pn] = q; else *(f32x2*)(sp + 2 * u.pn) = (f32x2){q, 0.f}; }
  }
};

typedef EpiResT<false> EpiRes;

DI float dpp_ror1(float v) { return __builtin_bit_cast(float, __builtin_amdgcn_update_dpp(0, __builtin_bit_cast(int, v), 0x121, 0xf, 0xf, false)); }
DI float dpp_ror2(float v) { return __builtin_bit_cast(float, __builtin_amdgcn_update_dpp(0, __builtin_bit_cast(int, v), 0x122, 0xf, 0xf, false)); }
DI float gelu_mul(float x, float uv) {
  const float t = __builtin_fmaf(x * x, 2.0f * LOG2E * 0.7978845608028654f * 0.044715f, 2.0f * LOG2E * 0.7978845608028654f);
  const float r = fast_rcp(fast_exp2(x * t) + 1.0f);
  return __builtin_fmaf(-x, r, x) * uv;
}
constexpr size_t SIDE_ROWS = (size_t)72 * 2 * DFF;
template <bool HALFM> struct EpiP5FT {
  static constexpr bool PERM = true, HAS_MID = false, HAS_RS = true;
  const float* SS; bf16_t* HF; float* out; const float* cw; const float* cb; const float* st; float* side; LAS unsigned char* lds; int layer;
  DI void mid(f32x4 (&)[2][2][4][2], const Unit&, int, int, int, int, int) const {}
  DI f32x4 prefetch(const Unit& u, int tid) const {
    f32x4 v = {0.f, 0.f, 0.f, 0.f};
    if (tid < (HALFM ? 128 : 256)) v = ss_load(SS, u.pm * (HALFM ? 128 : 256) + tid);
    else if (tid >= 256 && tid < 384) { int j = tid - 256; asm volatile("" : "+v"(j));
      const int arr = j >> 5, c4 = (j & 31) * 4; v = *(const f32x4*)((arr < 3 ? cw + arr * DFF : cb) + u.pn * 128 + c4); }
    return v;
  }
  DI void stash(const f32x4& v, const Unit& u, int tid, LAS unsigned char* l) const {
    if (tid < (HALFM ? 128 : 256)) *(LAS float*)(l + 131072 + 12288 + tid * 4) = ss_to_rs(v);
    else if (tid >= 256 && tid < 384) *(LAS f32x4*)(l + 131072 + 13312 + (tid - 256) * 16) = v;
  }
  DI void operator()(f32x4 (&acc)[2][2][4][2], const Unit& u, int wr, int wc, int fr_in, int fq_in) const {
    int fr = fr_in, fq = fq_in; asm volatile("" : "+v"(fr), "+v"(fq));
    const int rin0 = wr * 64 + fr, col0 = u.pn * 128 + wc * 32 + 8 * fq;
    const bool sample = HALFM ? true : u.pm >= 64, cont = !sample && (u.pm & 15) != 0;
    const int bd0 = HALFM ? (u.pm - TOKP / 128) * 2 : (u.pm - 64) * 4;
    LAS float* xh = (LAS float*)(lds + 131072);
    float* TAILG = side; float* HEADC = side + SIDE_ROWS; float* HEADU = side + 2 * SIDE_ROWS;
#pragma unroll
    for (int ai = 0; ai < (HALFM ? 1 : 2); ++ai)
#pragma unroll
      for (int m = 0; m < 4; ++m) { const float s = *(const LAS float*)(lds + 131072 + 12288 + (rin0 + ai * 128 + m * 16) * 4);
#pragma unroll
        for (int n = 0; n < 2; ++n) { acc[ai][0][m][n] *= s; acc[ai][1][m][n] *= s; } }
    if (fr >= 14) {
#pragma unroll
      for (int ai = 0; ai < (HALFM ? 1 : 2); ++ai) { const int gidx = 2 * ai + wr; LAS float* xp = xh + ((gidx * 4 + wc) * 2 + (fr - 14)) * 32 + fq * 8;
        *(LAS f32x4*)xp = acc[ai][0][3][0]; *(LAS f32x4*)(xp + 4) = acc[ai][0][3][1];
        float* cp = nullptr;
        if (sample) cp = out + O_SCONV + ((size_t)(layer * DB + bd0 + gidx) * 2 + (fr - 14)) * DFF + col0;
        else if (gidx == 3) { float* tp = TAILG + ((size_t)u.pm * 2 + (fr - 14)) * DFF + col0; *(f32x4*)tp = acc[ai][0][3][0]; *(f32x4*)(tp + 4) = acc[ai][0][3][1];
          if ((u.pm & 15) == 15) cp = out + O_PCONV + ((size_t)(layer * 4 + (u.pm >> 4)) * 2 + (fr - 14)) * DFF + col0; }
        if (cp) { *(f32x4*)cp = acc[ai][0][3][0]; *(f32x4*)(cp + 4) = acc[ai][0][3][1]; } }
    }
    asm volatile("s_waitcnt lgkmcnt(0)" ::: "memory"); __builtin_amdgcn_s_barrier(); asm volatile("" ::: "memory");
#pragma unroll
    for (int n = 0; n < 2; ++n) {
      const LAS float* cl = (const LAS float*)(lds + 131072 + 13312) + wc * 32 + 8 * fq + 4 * n;
      const f32x4 w0 = *(const LAS f32x4*)cl, w1 = *(const LAS f32x4*)(cl + 128), w2 = *(const LAS f32x4*)(cl + 256), bb = *(const LAS f32x4*)(cl + 384);
#pragma unroll
      for (int ai = 0; ai < (HALFM ? 1 : 2); ++ai) { const int gidx = 2 * ai + wr;
        f32x4 gp = {0.f, 0.f, 0.f, 0.f};
        if (fr >= 14) {
          if (sample) gp = *(const f32x4*)(st + ((size_t)(bd0 + gidx) * 2 + (fr - 14)) * DFF + col0 + 4 * n);
          else if (gidx > 0) gp = *(const LAS f32x4*)(xh + (((gidx - 1) * 4 + wc) * 2 + (fr - 14)) * 32 + fq * 8 + 4 * n);
        }
#pragma unroll
        for (int m = 0; m < 4; ++m) { const int rin = rin0 + ai * 128 + m * 16; f32x4 o, cc;
#pragma unroll
          for (int j = 0; j < 4; ++j) { const float g = acc[ai][0][m][n][j], gq = gp[j];
            const float r1g = dpp_ror1(g), r1q = dpp_ror1(gq), r2g = dpp_ror2(g), r2q = dpp_ror2(gq);
            const float p1 = fr >= 1 ? r1g : r1q, p2 = fr >= 2 ? r2g : r2q;
            const float c = __builtin_fmaf(w2[j], g, __builtin_fmaf(w1[j], p1, __builtin_fmaf(w0[j], p2, bb[j])));
            cc[j] = c; o[j] = gelu_mul(c, acc[ai][1][m][n][j]); }
          *(u32x2*)(HF + (size_t)(u.pm * (HALFM ? 128 : 256) + rin) * DFF + col0 + 4 * n) = pack4(o);
          if (cont && gidx == 0 && m == 0 && fr < 2) { *(f32x4*)(HEADC + ((size_t)u.pm * 2 + fr) * DFF + col0 + 4 * n) = cc; *(f32x4*)(HEADU + ((size_t)u.pm * 2 + fr) * DFF + col0 + 4 * n) = acc[ai][1][m][n]; }
          gp = acc[ai][0][m][n]; }
      }
    }
  }
};
typedef EpiP5FT<false> EpiP5F;
DI void p6_fixup_panel(int pm, const float* side, const float* cw, bf16_t* HF) {
  const float* TAILG = side + (size_t)(pm - 1) * 2 * DFF; const float* HEADC = side + SIDE_ROWS + (size_t)pm * 2 * DFF; const float* HEADU = side + 2 * SIDE_ROWS + (size_t)pm * 2 * DFF;
  int tid_ = threadIdx.x; asm volatile("" : "+v"(tid_));
  constexpr int NIT = (DFF + NTHREADS - 1) / NTHREADS;
  float t0[NIT], t1[NIT], a0[NIT], a1[NIT], hc0[NIT], hc1[NIT], hu0[NIT], hu1[NIT];
#pragma unroll
  for (int i = 0; i < NIT; ++i) { const int k = tid_ + i * NTHREADS; const int kk = k < DFF ? k : 0;
    t0[i] = TAILG[kk]; t1[i] = TAILG[DFF + kk]; a0[i] = cw[kk]; a1[i] = cw[DFF + kk]; hc0[i] = HEADC[kk]; hc1[i] = HEADC[DFF + kk]; hu0[i] = HEADU[kk]; hu1[i] = HEADU[DFF + kk]; }
#pragma unroll
  for (int i = 0; i < NIT; ++i) { const int k = tid_ + i * NTHREADS;
    const float c0 = hc0[i] + a0[i] * t0[i] + a1[i] * t1[i], c1 = hc1[i] + a0[i] * t1[i];
    const float h0 = gelu_mul(c0, hu0[i]), h1 = gelu_mul(c1, hu1[i]);
    f32x4 v = {h0, h1, 0.f, 0.f}; const u32x2 pk = pack4(v);
    if (k < DFF) { HF[(size_t)(pm * 256) * DFF + k] = (bf16_t)(pk[0] & 0xffffu); HF[(size_t)(pm * 256 + 1) * DFF + k] = (bf16_t)(pk[0] >> 16); } }
}

struct EpiNull {
  static constexpr bool PERM = true, HAS_MID = false, HAS_RS = false;
  DI void mid(f32x4 (&)[2][2][4][2], const Unit&, int, int, int, int, int) const {}
  DI void operator()(f32x4 (&acc)[2][2][4][2], const Unit& u, int wr, int wc, int fr, int fq) const {
#pragma unroll
    for (int ai = 0; ai < 2; ++ai)
#pragma unroll
      for (int bj = 0; bj < 2; ++bj)
#pragma unroll
        for (int m = 0; m < 4; ++m)
#pragma unroll
          for (int n = 0; n < 2; ++n) asm volatile("" :: "v"(acc[ai][bj][m][n]));
  }
};

DI float gelu_tanh(float x) {
  const float y = 0.7978845608028654f * (x + 0.044715f * x * x * x);
  const float e = fast_exp2(2.0f * LOG2E * y);
  const float th = 1.0f - 2.0f * fast_rcp(e + 1.0f);
  return 0.5f * x * (1.0f + th);
}
DI void pfinal_norm(const Params& p) {
  const float* X32 = (const float*)(p.ws + WS_X32); const float* SS = (const float*)(p.ws + WS_SS);
  int tid_ = threadIdx.x; asm volatile("" : "+v"(tid_));
  const int lane = tid_ & 63, gw = blockIdx.x * 8 + (tid_ >> 6), NGW = gridDim.x * 8;
#pragma unroll 3
  for (int m = gw; m < TOK; m += NGW) { const float s = row_rs(SS, m);
#pragma unroll
    for (int j = 0; j < 4; ++j) { const f32x4 v = ((const f32x4*)(X32 + (size_t)m * D))[lane + 64 * j], g = ((const f32x4*)p.norm_final)[lane + 64 * j];
      __builtin_nontemporal_store(v * s * g, (f32x4*)(p.out + (size_t)m * D) + lane + 64 * j); } }
}

DI pg8::GemmDesc p1_desc(unsigned char* ws, int l) {
  return pg8::GemmDesc{(const char*)(ws + WS_XB), (const char*)(ws + WS_WIN) + (size_t)l * INC * D * 2, D, D, D / 64, (size_t)256 * D * 2, (size_t)128 * D * 2};
}
DI EpiP1 p1_epi(const Params& p, int l, LAS unsigned char* lds) {
  return EpiP1{(const float*)(p.ws + WS_SS), (bf16_t*)(p.ws + WS_QKV), (bf16_t*)(p.ws + WS_GATE), p.b_gate + (size_t)l * 3 * D, p.out, l, 0, lds};
}
namespace attn {
constexpr int N_CPY = 64, N_CS = 128, N_CP = 512, N_AP = 512, N_BP = 512, N_AS = 256, N_BS = 256, NITEMS = N_CPY + N_CS + N_CP + N_AP + N_BP + N_AS + N_BS;
constexpr float STICK_DONE = 8.75651e-27f;

struct Item { int mode, h, tok0, past, q0, nqv, pflags; const float* cK; const float* cV; };

DI Item decode(const Params& p, int layer, int idx) {
  Item it; it.cK = nullptr; it.cV = nullptr; it.past = 0; it.pflags = 0;
  if (idx < N_CPY) { it.mode = 3; it.h = idx; return it; }
  idx -= N_CPY;
  if (idx < N_CS) { const int bd = idx >> 2, h = idx & 3; it.mode = 2; it.h = h; it.tok0 = TOKP + bd * 64; it.past = PAST; it.q0 = PAST; it.nqv = 64;
    it.cK = p.cache_c_k + (size_t)(layer * DB + bd) * PAST * 512 + h * 128; it.cV = p.cache_c_v + (size_t)(layer * DB + bd) * PAST * 512 + h * 128; return it; }
  idx -= N_CS;
  if (idx < N_CP) { const int jj = 31 - (idx >> 4), rem = idx & 15; it.mode = 2; it.h = rem & 3; it.tok0 = (rem >> 2) * SEQ; it.q0 = jj * 128; it.nqv = 128; return it; }
  idx -= N_CP;
  if (idx < N_AP + N_BP) { const int isb = idx >= N_AP; if (isb) idx -= N_AP; const int qt = 15 - (idx >> 5), rem = idx & 31; it.mode = isb; it.h = rem & 7; it.tok0 = (rem >> 3) * SEQ; it.q0 = qt * 256; it.nqv = 256; return it; }
  idx -= N_AP + N_BP;
  if (idx < N_AS) { const int bd = idx >> 3, h = idx & 7; it.mode = 0; it.h = h; it.tok0 = TOKP + bd * 64; it.past = ALEN; it.q0 = ALEN; it.nqv = 64;
    it.cK = p.cache_a_k + (size_t)(layer * DB + bd) * ALEN * 512 + h * 64; it.cV = p.cache_a_v + (size_t)(layer * DB + bd) * ALEN * 512 + h * 64; return it; }
  idx -= N_AS;
  { const int bd = idx >> 3, h = idx & 7; it.mode = 1; it.h = h; it.tok0 = TOKP + bd * 64; it.past = PAST; it.q0 = PAST; it.nqv = 64;
    it.cK = p.cache_b_k + (size_t)(layer * DB + bd) * PAST * 512 + h * 64; it.cV = p.cache_b_v + (size_t)(layer * DB + bd) * PAST * 512 + h * 64; return it; }
}


template <int MODE, bool SAMPLE>
DI void load_piece(u32x4& r0, u32x4& r1, u32x4& r2, u32x4& r3, const Item& it, const float* cache, const bf16_t* QKV, int col, int kt, int tid) {
  constexpr int CPR = MODE == 2 ? 16 : 8;
  const int j0 = kt * 64;
  const int ra = tid / CPR, ca = tid % CPR;
  if (SAMPLE && j0 < it.past) {
    const unsigned lo = (unsigned)(ra * 512 + ca * 8) * 4u; const char* b = (const char*)(cache + (size_t)j0 * 512);
    { const u32x4* q = (const u32x4*)(b + lo); r0 = __builtin_nontemporal_load(q); r1 = __builtin_nontemporal_load(q + 1); }
    if constexpr (MODE == 2) { const u32x4* q = (const u32x4*)(b + (size_t)32 * 512 * 4 + lo); r2 = __builtin_nontemporal_load(q); r3 = __builtin_nontemporal_load(q + 1); }
  } else {
    const unsigned lo = (unsigned)(ra * QKVW + ca * 8) * 2u; const char* b = (const char*)(QKV + (size_t)(it.tok0 + j0 - it.past) * QKVW + col);
    r0 = *(const u32x4*)(b + lo);
    if constexpr (MODE == 2) r2 = *(const u32x4*)(b + (size_t)32 * QKVW * 2 + lo);
  }
}
DI u32x4 cvt8(u32x4 a, u32x4 b) { return pack8(__builtin_bit_cast(f32x4, a), __builtin_bit_cast(f32x4, b)); }
template <int MODE, bool ISK, bool SAMPLE>
DI void write_piece(const u32x4& r0, const u32x4& r1, const u32x4& r2, const u32x4& r3, const Item& it, LAS unsigned char* buf, int kt, int tid) {
  constexpr int CPR = MODE == 2 ? 16 : 8, VS = MODE == 2 ? 320 : 192;
  const bool f32src = SAMPLE && kt * 64 < it.past;
  const int ra = tid / CPR, ca = tid % CPR, rb = (tid + NTHREADS) / CPR, cb = (tid + NTHREADS) % CPR;
  { const u32x4 x = f32src ? cvt8(r0, r1) : r0;
    if (ISK) *(LAS u32x4*)(buf + ((MODE == 2 && ca >= 8) ? 8192 : 0) + ra * 128 + (((ca & 7) ^ ((ra >> 1) & 7)) << 4)) = x;
    else *(LAS u32x4*)(buf + ra * VS + ca * 16) = x; }
  if constexpr (MODE == 2) { const u32x4 x = f32src ? cvt8(r2, r3) : r2;
    if (ISK) *(LAS u32x4*)(buf + (cb >= 8 ? 8192 : 0) + rb * 128 + (((cb & 7) ^ ((rb >> 1) & 7)) << 4)) = x;
    else *(LAS u32x4*)(buf + rb * VS + cb * 16) = x; }
}

template <int MODE>
DI void state_store(const u32x4& r0, const u32x4& r2, float* dst, int tid) {
  constexpr int CPR = MODE == 2 ? 16 : 8;
  const int ra = tid / CPR, ca = tid % CPR, rb = (tid + NTHREADS) / CPR, cb = (tid + NTHREADS) % CPR;
  { float* q = dst + (size_t)ra * 512 + ca * 8;
    __builtin_nontemporal_store((f32x4){bflo(r0[0]), bfhi(r0[0]), bflo(r0[1]), bfhi(r0[1])}, (f32x4*)q); __builtin_nontemporal_store((f32x4){bflo(r0[2]), bfhi(r0[2]), bflo(r0[3]), bfhi(r0[3])}, (f32x4*)(q + 4)); }
  if constexpr (MODE == 2) { float* q = dst + (size_t)rb * 512 + cb * 8;
    __builtin_nontemporal_store((f32x4){bflo(r2[0]), bfhi(r2[0]), bflo(r2[1]), bfhi(r2[1])}, (f32x4*)q); __builtin_nontemporal_store((f32x4){bflo(r2[2]), bfhi(r2[2]), bflo(r2[3]), bfhi(r2[3])}, (f32x4*)(q + 4)); }
}
template <int MODE>
DI float* state_dst(const Params& p, int layer, const Item& it, int kt, int isv) {
  const int hoff = MODE == 2 ? it.h * 128 : it.h * 64;
  if (it.past == 0) {
    const int t0 = kt * 64; if (t0 < it.q0 || t0 >= it.q0 + it.nqv) return nullptr;
    const int b = it.tok0 / SEQ;
    if (MODE == 0) { if (t0 < SEQ - 512) return nullptr; return p.out + (isv ? O_PAV : O_PAK) + ((size_t)(layer * 4 + b) * 512 + (t0 - (SEQ - 512))) * 512 + hoff; }
    return p.out + (MODE == 1 ? (isv ? O_PBV : O_PBK) : (isv ? O_PCV : O_PCK)) + ((size_t)(layer * 4 + b) * SEQ + t0) * 512 + hoff;
  } else {
    if (kt * 64 != it.past) return nullptr;
    const int bd = (it.tok0 - TOKP) / 64;
    if (MODE == 0) return p.out + (isv ? O_SAV : O_SAK) + ((size_t)(layer * DB + bd) * 512 + 448) * 512 + hoff;
    return p.out + (MODE == 1 ? (isv ? O_SBV : O_SBK) : (isv ? O_SCV : O_SCK)) + ((size_t)(layer * DB + bd) * 64) * 512 + hoff;
  }
}

DI bf16x8 pack_p(const f32x16& x, int s) {
  const f32x4 a = {x[8 * s], x[8 * s + 1], x[8 * s + 2], x[8 * s + 3]}, b = {x[8 * s + 4], x[8 * s + 5], x[8 * s + 6], x[8 * s + 7]};
  return __builtin_bit_cast(bf16x8, pack8(a, b));
}
#define MFMA32(a, b, c) __builtin_amdgcn_mfma_f32_32x32x16_bf16((a), (b), (c), 0, 0, 0)

constexpr int L_KB = 0, KB_BYTES = 16384, L_VB = 32768, VB_BYTES = 20480, L_LUT = 73728, L_FLAGS = 75776, L_XCH = 81920;

template <int MODE, bool SAMPLE>
DI void run_item(const Params& p, int layer, const Item& it, LAS unsigned char* lds_in) {
  LAS unsigned char* lds = opaque_lds(lds_in);
  constexpr int NDV = MODE == 2 ? 4 : 2, VS = MODE == 2 ? 320 : 192;
  int tid_ = threadIdx.x; asm volatile("" : "+v"(tid_));
  const int tid = tid_, lane = tid & 63, wave = __builtin_amdgcn_readfirstlane(tid >> 6);
  const int qi = lane & 31, h2 = lane >> 5;
  const int mp = MODE == 2 ? (wave >> 2) : 0, wrow = MODE == 2 ? (wave & 3) : wave;
  const int q0w = it.q0 + 32 * wrow;
  const bool active = 32 * wrow < it.nqv;
  const bf16_t* QKV = (const bf16_t*)(p.ws + WS_QKV);
  const int hb = MODE == 2 ? it.h * 128 : it.h * 64;
  const int qcol = (MODE == 0 ? 0 : MODE == 1 ? 1536 : 3072) + hb + 64 * mp, kcol = (MODE == 0 ? 512 : MODE == 1 ? 2048 : 3584) + hb, vcol = (MODE == 0 ? 1024 : MODE == 1 ? 2560 : 4096) + hb;
  const int cw = q0w >> 6;
  int kt_first, step, NT;
  if (MODE == 0) { kt_first = (it.q0 >> 6) - 8; if (kt_first < 0) kt_first = 0; step = 1; NT = ((it.q0 + it.nqv - 1) >> 6) - kt_first + 1; }
  else if (MODE == 2) { kt_first = 0; step = 1; NT = ((it.q0 + it.nqv - 1) >> 6) + 1; }
  else { kt_first = (it.q0 + it.nqv - 2) >> 6; step = -1; NT = kt_first + 1; }
  const bool wr_state = it.pflags == 0;
  u32x4 k0 = {}, k1 = {}, k2 = {}, k3 = {}, v0 = {}, v1 = {}, v2 = {}, v3 = {};
  load_piece<MODE, SAMPLE>(k0, k1, k2, k3, it, it.cK, QKV, kcol, kt_first, tid);
  load_piece<MODE, SAMPLE>(v0, v1, v2, v3, it, it.cV, QKV, vcol, kt_first, tid);
  LAS float* lut = (LAS float*)(lds + L_LUT);
  LAS unsigned* flags = (LAS unsigned*)(lds + L_FLAGS);
  if (MODE == 0) { const float bfar = p.a_rel_bias[((size_t)layer * 257 + 256) * 8 + it.h]; for (int i = tid; i < 257; i += NTHREADS) lut[i] = p.a_rel_bias[((size_t)layer * 257 + i) * 8 + it.h] - bfar; }
  if (MODE == 2) { if (tid < 192) lut[tid] = ((const float*)(p.ws + WS_CTL))[CW_T5 + it.h * 192 + tid]; }
  bf16x8 qf[4];
  if (active) { const bf16_t* qp = QKV + (size_t)(it.tok0 + q0w + qi - it.past) * QKVW + qcol + 8 * h2;
#pragma unroll
    for (int s = 0; s < 4; ++s) { const u32x4 w = *(const u32x4*)(qp + 16 * s);
      const f32x4 a = {bflo(w[0]) * 0.125f, bfhi(w[0]) * 0.125f, bflo(w[1]) * 0.125f, bfhi(w[1]) * 0.125f}, b = {bflo(w[2]) * 0.125f, bfhi(w[2]) * 0.125f, bflo(w[3]) * 0.125f, bfhi(w[3]) * 0.125f};
      qf[s] = __builtin_bit_cast(bf16x8, pack8(a, b)); } }
  f32x16 O[NDV];
#pragma unroll
  for (int b = 0; b < NDV; ++b)
#pragma unroll
    for (int i = 0; i < 16; ++i) O[b][i] = 0.f;
  float m_run = -1e30f, l_run = 0.f, R2 = 1.0f; bool done = false, have_p = false;
  bf16x8 pf[4];
#pragma unroll
  for (int s = 0; s < 4; ++s) pf[s] = (bf16x8){0, 0, 0, 0, 0, 0, 0, 0};
  const int krow_off = qi * 128, kswz = (qi >> 1) & 7;
  const int g16 = lane >> 4, trq = (lane & 15) >> 2, trp = lane & 3;
  const int vtr_off = (4 * (g16 >> 1) + trq) * VS + (16 * (g16 & 1) + 4 * trp) * 2;

  write_piece<MODE, true, SAMPLE>(k0, k1, k2, k3, it, lds + L_KB, kt_first, tid);
  if (wr_state) { float* d = state_dst<MODE>(p, layer, it, kt_first, 0); if (d) state_store<MODE>(k0, k2, d, tid); }
  if (NT > 1) load_piece<MODE, SAMPLE>(k0, k1, k2, k3, it, it.cK, QKV, kcol, kt_first + step, tid);
  for (int t = 0;; ++t) {
    __syncthreads();
    if (MODE == 1 && t > 0 && t < NT) { const unsigned any = flags[0] | flags[1] | flags[2] | flags[3] | flags[4] | flags[5] | flags[6] | flags[7]; if (!any) NT = t; }
    const int kt = kt_first + step * t;
    bool mine = false;
    if (t < NT && !(it.pflags & 2)) {
      if (MODE == 0) mine = active && kt >= cw - 8 && kt <= cw;
      else if (MODE == 2) mine = active && kt <= cw;
      else mine = active && !done && kt * 64 <= q0w + 30;
    }
    LAS unsigned char* vb = lds + L_VB + ((t - 1) & 1) * VB_BYTES + vtr_off;
    LAS unsigned char* kb = lds + L_KB + (t & 1) * KB_BYTES + ((MODE == 2 && mp) ? 8192 : 0);
    constexpr int HB = NDV / 2, NST = 4 * HB;
    bf16x8 kfa[4], vfa[2], vfb[2];
    const bool do_pv = have_p && !(it.pflags & 8);
#define V_LOAD(dst, j_) do { if (do_pv) { _Pragma("unroll") for (int bb = 0; bb < 2; ++bb) { const int a0 = 16 * ((j_) / HB) * VS + 64 * (2 * ((j_) % HB) + bb); \
      const s16x4 lo = __builtin_amdgcn_ds_read_tr16_b64_v4i16((LAS s16x4*)(vb + a0)), hi = __builtin_amdgcn_ds_read_tr16_b64_v4i16((LAS s16x4*)(vb + a0 + 8 * VS)); \
      dst[bb] = __builtin_shufflevector(lo, hi, 0, 1, 2, 3, 4, 5, 6, 7); } } } while (0)
#define V_MMA(src, j_) do { if (do_pv) { _Pragma("unroll") for (int bb = 0; bb < 2; ++bb) O[2 * ((j_) % HB) + bb] = MFMA32(src[bb], pf[(j_) / HB], O[2 * ((j_) % HB) + bb]); } } while (0)
#define STG(j_, cur, nxt) do { if (SAMPLE) { V_LOAD(cur, j_); V_MMA(cur, j_); } else { if ((j_) + 1 < NST) V_LOAD(nxt, (j_) + 1); V_MMA(cur, j_); } } while (0)
    if (!SAMPLE) {
      if (mine) {
#pragma unroll
        for (int s = 0; s < 4; ++s) kfa[s] = *(const LAS bf16x8*)(kb + krow_off + (((2 * s + h2) ^ kswz) << 4)); }
      V_LOAD(vfa, 0);
      __builtin_amdgcn_sched_barrier(0);
    }
    if (t < NT && !(it.pflags & 1)) { write_piece<MODE, false, SAMPLE>(v0, v1, v2, v3, it, lds + L_VB + (t & 1) * VB_BYTES, kt_first + step * t, tid);
      if (wr_state) { float* d = state_dst<MODE>(p, layer, it, kt_first + step * t, 1); if (d) state_store<MODE>(v0, v2, d, tid); }
      if (t + 1 < NT) { write_piece<MODE, true, SAMPLE>(k0, k1, k2, k3, it, lds + L_KB + ((t + 1) & 1) * KB_BYTES, kt_first + step * (t + 1), tid);
        if (wr_state) { float* d = state_dst<MODE>(p, layer, it, kt_first + step * (t + 1), 0); if (d) state_store<MODE>(k0, k2, d, tid); }
        load_piece<MODE, SAMPLE>(v0, v1, v2, v3, it, it.cV, QKV, vcol, kt_first + step * (t + 1), tid);
        if (t + 2 < NT) load_piece<MODE, SAMPLE>(k0, k1, k2, k3, it, it.cK, QKV, kcol, kt_first + step * (t + 2), tid); } }
    __builtin_amdgcn_sched_barrier(0);
    f32x16 sA, sB;
#pragma unroll
    for (int i = 0; i < 16; ++i) { sA[i] = 0.f; sB[i] = 0.f; }
    if (mine) {
      bf16x8 kfc[4];
      if (SAMPLE) {
#pragma unroll
        for (int s = 0; s < 4; ++s) kfa[s] = *(const LAS bf16x8*)(kb + krow_off + (((2 * s + h2) ^ kswz) << 4)); }
#pragma unroll
      for (int s = 0; s < 4; ++s) kfc[s] = *(const LAS bf16x8*)(kb + 4096 + krow_off + (((2 * s + h2) ^ kswz) << 4));
#pragma unroll
      for (int s = 0; s < 4; ++s) sA = MFMA32(kfa[s], qf[s], sA);
#pragma unroll
      for (int s = 0; s < 4; ++s) sB = MFMA32(kfc[s], qf[s], sB);
    }
    const int kbase = kt * 64 + 4 * h2;
    if (MODE != 1) {
      float mx = -1e30f, alpha = 1.0f, lsa = 0.f, lsb = 0.f; bool resc = false;
      const bool smx = mine && !(it.pflags & 4);
      STG(0, vfa, vfb);
      if (NST == 8) STG(1, vfb, vfa);
      if (smx) {
        bool cst;
        if (MODE == 0) cst = q0w - (kt * 64 + 63) >= 128; else cst = kt * 64 + 63 - q0w <= -127;
        if (!cst) {
#pragma unroll
          for (int i = 0; i < 16; ++i) { const int ko = (i & 3) + 8 * (i >> 2);
            int ia, ib;
            if (MODE == 0) { const int d = (q0w + qi) - (kbase + ko); ia = d; ib = d - 32; ia = (ia < -128 ? -128 : ia > 128 ? 128 : ia) + 128; ib = (ib < -128 ? -128 : ib > 128 ? 128 : ib) + 128; }
            else { const int d = (kbase + ko) - (q0w + qi); ia = d; ib = d + 32; ia = (ia < -127 ? -127 : ia > 63 ? 63 : ia) + 127; ib = (ib < -127 ? -127 : ib > 63 ? 63 : ib) + 127; }
            sA[i] += lut[ia]; sB[i] += lut[ib]; }
        }
        float m0 = fmaxf(fmaxf(sA[0], sA[1]), sA[2]), m1 = fmaxf(fmaxf(sB[0], sB[1]), sB[2]);
#pragma unroll
        for (int i = 3; i < 15; i += 2) { m0 = fmaxf(fmaxf(m0, sA[i]), sA[i + 1]); m1 = fmaxf(fmaxf(m1, sB[i]), sB[i + 1]); }
        mx = fmaxf(fmaxf(m0, m1), fmaxf(sA[15], sB[15]));
      }
      __builtin_amdgcn_sched_barrier(0);
      if (NST == 8) { STG(2, vfa, vfb); STG(3, vfb, vfa); } else STG(1, vfb, vfa);
      if (smx) {
        mx = fmaxf(mx, __shfl_xor(mx, 32)) * LOG2E;
        resc = !__all(mx <= m_run + 8.0f);
        if (resc) { const float mnew = fmaxf(m_run, mx); alpha = fast_exp2(m_run - mnew); m_run = mnew; l_run *= alpha; }
#pragma unroll
        for (int i = 0; i < 16; ++i) { sA[i] = fast_exp2(__builtin_fmaf(sA[i], LOG2E, -m_run)); lsa += sA[i]; }
      }
      __builtin_amdgcn_sched_barrier(0);
      if (NST == 8) { STG(4, vfa, vfb); STG(5, vfb, vfa); } else STG(2, vfa, vfb);
      if (smx) {
#pragma unroll
        for (int i = 0; i < 16; ++i) { sB[i] = fast_exp2(__builtin_fmaf(sB[i], LOG2E, -m_run)); lsb += sB[i]; }
        l_run += lsa + lsb;
      }
      __builtin_amdgcn_sched_barrier(0);
      if (NST == 8) { STG(6, vfa, vfb); STG(7, vfb, vfa); } else STG(3, vfb, vfa);
      __builtin_amdgcn_sched_barrier(0);
      if (mine) {
        if (resc) {
#pragma unroll
        for (int b = 0; b < NDV; ++b)
#pragma unroll
          for (int i = 0; i < 16; ++i) O[b][i] *= alpha;
        }
        pf[0] = pack_p(sA, 0); pf[1] = pack_p(sA, 1); pf[2] = pack_p(sB, 0); pf[3] = pack_p(sB, 1);
      }
    } else {
      STG(0, vfa, vfb); STG(1, vfb, vfa); STG(2, vfa, vfb); STG(3, vfb, vfa);
      if (mine) {
        const bool diag = kt * 64 + 63 >= q0w;
        float kpA[16], kpB[16];
#pragma unroll
        for (int i = 0; i < 16; ++i) { const int ko = (i & 3) + 8 * (i >> 2);
          { const float r = fast_rcp(1.0f + fast_exp2(sA[i] * LOG2E)); const bool ok = !diag || (kbase + ko) < (q0w + qi); kpA[i] = ok ? r : 1.0f; sA[i] = ok ? 1.0f - r : 0.0f; }
          { const float r = fast_rcp(1.0f + fast_exp2(sB[i] * LOG2E)); const bool ok = !diag || (kbase + 32 + ko) < (q0w + qi); kpB[i] = ok ? r : 1.0f; sB[i] = ok ? 1.0f - r : 0.0f; } }
        float gs[8], pg[8];
#pragma unroll
        for (int g = 0; g < 4; ++g) { gs[g] = (kpA[4 * g] * kpA[4 * g + 1]) * (kpA[4 * g + 2] * kpA[4 * g + 3]); gs[4 + g] = (kpB[4 * g] * kpB[4 * g + 1]) * (kpB[4 * g + 2] * kpB[4 * g + 3]); }
#pragma unroll
        for (int g = 0; g < 8; ++g) pg[g] = __shfl_xor(gs[g], 32);
        float suf = R2;
#pragma unroll
        for (int g = 7; g >= 0; --g) { const float off = suf * (h2 == 0 ? pg[g] : 1.0f);
          if (g >= 4) { const int b = 4 * (g - 4); const float a3 = off, a2 = a3 * kpB[b + 3], a1 = a2 * kpB[b + 2], a0 = a1 * kpB[b + 1];
            sB[b + 3] *= a3; sB[b + 2] *= a2; sB[b + 1] *= a1; sB[b] *= a0; }
          else { const int b = 4 * g; const float a3 = off, a2 = a3 * kpA[b + 3], a1 = a2 * kpA[b + 2], a0 = a1 * kpA[b + 1];
            sA[b + 3] *= a3; sA[b + 2] *= a2; sA[b + 1] *= a1; sA[b] *= a0; }
          suf *= gs[g] * pg[g]; }
        R2 = suf;
        done = __all(R2 < STICK_DONE) != 0;
        pf[0] = pack_p(sA, 0); pf[1] = pack_p(sA, 1); pf[2] = pack_p(sB, 0); pf[3] = pack_p(sB, 1);
      }
    }
#undef V_LOAD
#undef V_MMA
#undef STG
    have_p = mine;
    if (MODE == 1 && t < NT) { if (lane == 0) flags[wave] = (active && !done && kt > 0 && (kt - 1) * 64 <= q0w + 30) ? 1u : 0u; }
    if (t >= NT) break;
  }
  int lane_e = lane; asm volatile("" : "+v"(lane_e));
  const int qi_e = lane_e & 31, h2_e = lane_e >> 5;
  bf16_t* Ob = (bf16_t*)(p.ws + WS_O);
  const int ocol = MODE == 0 ? hb : MODE == 1 ? 512 + hb : 1024 + hb;
  const bool wr_out = it.pflags == 0;
  if (MODE != 2) {
    if (active && wr_out) { float sc = 1.f; if (MODE == 0) { const float lt = l_run + __shfl_xor(l_run, 32); sc = fast_rcp(lt); }
      bf16_t* op = Ob + (size_t)(it.tok0 + q0w + qi_e - it.past) * OW + ocol + 4 * h2_e;
#pragma unroll
      for (int b = 0; b < NDV; ++b)
#pragma unroll
        for (int g = 0; g < 4; ++g) { const f32x4 v = {O[b][4 * g] * sc, O[b][4 * g + 1] * sc, O[b][4 * g + 2] * sc, O[b][4 * g + 3] * sc}; *(u32x2*)(op + 32 * b + 8 * g) = pack4(v); } }
    __syncthreads();
  } else {
    const float lam = ((const float*)(p.ws + WS_CTL))[CW_LAM + layer];
    const float sub_scale = 1.0f - (0.8f - 0.6f * expf(-0.3f * (float)layer));
    LAS float* xch = (LAS float*)(lds + L_XCH);
    if (active && mp == 1) { const float lt = l_run + __shfl_xor(l_run, 32), sc = lam * fast_rcp(lt);
#pragma unroll
      for (int b = 0; b < NDV; ++b)
#pragma unroll
        for (int i = 0; i < 16; ++i) xch[((wave & 3) * 64 + b * 16 + i) * 64 + lane_e] = O[b][i] * sc; }
    __syncthreads();
    if (active && mp == 0 && wr_out) { const float lt = l_run + __shfl_xor(l_run, 32), sc = fast_rcp(lt); float q = 0.f;
#pragma unroll
      for (int b = 0; b < NDV; ++b)
#pragma unroll
        for (int i = 0; i < 16; ++i) { const float o = O[b][i] * sc - xch[((wave & 3) * 64 + b * 16 + i) * 64 + lane_e]; O[b][i] = o; q += o * o; if ((i & 7) == 7) __builtin_amdgcn_sched_barrier(0); }
      q += __shfl_xor(q, 32);
      const float rstd = __builtin_amdgcn_rsqf(q * (1.0f / 128.0f) + EPS) * sub_scale;
      const float* gain = p.c_subln + layer * 128 + 4 * h2_e;
      bf16_t* op = Ob + (size_t)(it.tok0 + q0w + qi_e - it.past) * OW + ocol + 4 * h2_e;
#pragma unroll
      for (int b = 0; b < NDV; ++b)
#pragma unroll
        for (int g = 0; g < 4; ++g) { const f32x4 gn = *(const f32x4*)(gain + 32 * b + 8 * g);
          const f32x4 v = {O[b][4 * g] * rstd * gn[0], O[b][4 * g + 1] * rstd * gn[1], O[b][4 * g + 2] * rstd * gn[2], O[b][4 * g + 3] * rstd * gn[3]}; *(u32x2*)(op + 32 * b + 8 * g) = pack4(v); } }
    __syncthreads();
  }
}

DI void copy_item(const Params& p, int layer, int idx) {
  const int which = idx >> 5, bd = idx & 31;
  const size_t lb = (size_t)layer * DB + bd;
  const f32x4* src = (const f32x4*)((which ? p.cache_a_v : p.cache_a_k) + lb * 512 * 512 + 64 * 512);
  f32x4* dst = (f32x4*)(p.out + (which ? O_SAV : O_SAK) + lb * 512 * 512);
  int tid_ = threadIdx.x; asm volatile("" : "+v"(tid_));
#pragma unroll 4
  for (int i = tid_; i < 448 * 128; i += NTHREADS) __builtin_nontemporal_store(__builtin_nontemporal_load(src + i), dst + i);
}
#ifndef PROBE_ATT_FLAGS
#define PROBE_ATT_FLAGS 0
#endif
#ifndef PROBE_ATT_LO
#define PROBE_ATT_LO 0
#define PROBE_ATT_HI NITEMS
#endif
DI void attn_phase(const Params& p, int qidx, LAS unsigned char* lds) {
  const int layer = qidx & 1; const int i_lo = qidx >= 2 ? PROBE_ATT_LO : 0, i_hi = qidx >= 2 ? PROBE_ATT_HI : NITEMS;
  unsigned* head = (unsigned*)(p.ws + WS_CTL) + CW_QUEUE + 64 * qidx;
  LAS unsigned* slot = (LAS unsigned*)(lds + LDS_BYTES - 48);
  if (threadIdx.x == 0) slot[0] = atomicAdd(head, 1u);
  for (int k = 0;; ++k) {
    __syncthreads();
    const int idx = __builtin_amdgcn_readfirstlane((int)slot[k & 1]) + i_lo;
    if (threadIdx.x == 0) slot[(k + 1) & 1] = atomicAdd(head, 1u);
    if (idx >= i_hi) break;
    Item it = decode(p, layer, idx); it.pflags = qidx >= 2 ? PROBE_ATT_FLAGS : 0;
    if (it.mode == 3) { if (qidx < 2) copy_item(p, layer, it.h); continue; }
    if (it.past == 0) { if (it.mode == 0) run_item<0, false>(p, layer, it, lds); else if (it.mode == 1) run_item<1, false>(p, layer, it, lds); else run_item<2, false>(p, layer, it, lds); }
    else { if (it.mode == 0) run_item<0, true>(p, layer, it, lds); else if (it.mode == 1) run_item<1, true>(p, layer, it, lds); else run_item<2, true>(p, layer, it, lds); }
  }
}
}
#define XB_TMO      128
#define XB_XCNT(j)  (256  + 64 * (j))
#define XB_XSUB(j)  (1280 + 64 * (j))
#define XB_XGEN(j)  (2304 + 64 * (j))
#define XB_TOP      3328
#define XB_TOPGEN   3392
#define XCD_BAR_WORDS 3456
#define XB_SPIN_CAP (1u << 18)
DI unsigned xb_ld(unsigned* p)              { return __hip_atomic_load(p, __ATOMIC_RELAXED, __HIP_MEMORY_SCOPE_AGENT); }
DI unsigned xb_add(unsigned* p, unsigned v) { return __hip_atomic_fetch_add(p, v, __ATOMIC_RELAXED, __HIP_MEMORY_SCOPE_AGENT); }
DI unsigned xb_xcc_id() { return (unsigned)__builtin_amdgcn_s_getreg((3 << 11) | 20) & 0xFu; }
#define XB_SPIN(cond, bar) do { unsigned _sp = 0; while (cond) { __builtin_amdgcn_s_sleep(1); \
    if ((++_sp & 255u) == 0u) { if (xb_ld(&(bar)[XB_TMO])) break; if (_sp > XB_SPIN_CAP) { atomicAdd(&(bar)[XB_TMO], 1u); break; } } } } while (0)
struct XcdBarrier { unsigned* bar; unsigned x; volatile LAS unsigned* st; };
DI XcdBarrier xcd_barrier_post(unsigned* bar, volatile LAS unsigned* st) {
  XcdBarrier b; b.bar = bar; b.x = xb_xcc_id(); b.st = st;
  if (threadIdx.x == 0) (void)xb_add(&bar[XB_XCNT(b.x)], 1u);
  return b;
}
DI void xcd_barrier_complete(unsigned* bar, unsigned x, unsigned& nloc, unsigned& nx) {
  const unsigned G = gridDim.x * gridDim.y * gridDim.z;
  unsigned sum, cnt, mine, sp = 0u;
  for (;;) {
    sum = 0u; cnt = 0u; mine = 0u;
#pragma unroll
    for (unsigned j = 0; j < 16; ++j) { const unsigned c = xb_ld(&bar[XB_XCNT(j)]); sum += c; cnt += (c > 0u) ? 1u : 0u; mine = (j == x) ? c : mine; }
    if (sum == G) break;
    __builtin_amdgcn_s_sleep(1);
    if ((++sp & 255u) == 0u) { if (xb_ld(&bar[XB_TMO])) break; if (sp > XB_SPIN_CAP) { atomicAdd(&bar[XB_TMO], 1u); break; } }
  }
  nloc = mine > 0u ? mine : 1u; nx = cnt > 0u ? cnt : 1u;
}
DI void xcd_barrier(const XcdBarrier& b) {
  asm volatile("s_waitcnt vmcnt(0)" ::: "memory");
  __syncthreads();
  if (threadIdx.x == 0) {
    unsigned* bar = b.bar;
    __builtin_amdgcn_s_waitcnt(0);
    unsigned nloc = b.st[0], nx = b.st[1];
    if (nloc == 0u) { xcd_barrier_complete(bar, b.x, nloc, nx); b.st[0] = nloc; b.st[1] = nx; }
    const unsigned old = xb_add(&bar[XB_XSUB(b.x)], 1u);
    const unsigned gen = old / nloc;
    if (old + 1u == (gen + 1u) * nloc) {
      __builtin_amdgcn_fence(__ATOMIC_RELEASE, "agent");
      asm volatile("s_waitcnt vmcnt(0)" ::: "memory");
      const unsigned og = xb_add(&bar[XB_TOP], 1u);
      const unsigned tg = og / nx;
      if (og + 1u == (tg + 1u) * nx) xb_add(&bar[XB_TOPGEN], 1u);
      else XB_SPIN(xb_ld(&bar[XB_TOPGEN]) == tg, bar);
      __builtin_amdgcn_fence(__ATOMIC_ACQUIRE, "agent");
      xb_add(&bar[XB_XGEN(b.x)], 1u);
      asm volatile("s_waitcnt vmcnt(0)" ::: "memory");
    } else {
      XB_SPIN(xb_ld(&bar[XB_XGEN(b.x)]) == gen, bar);
      __builtin_amdgcn_fence(__ATOMIC_ACQUIRE, "agent");
      asm volatile("s_waitcnt vmcnt(0)" ::: "memory");
    }
  }
  __syncthreads();
}
constexpr int L_BARST = LDS_BYTES - 64;

#ifndef PROBE_P1_FLAGS
#define PROBE_P1_FLAGS 0
#endif
#ifndef PROBE_NULL_EPI
#define PROBE_NULL_EPI 0
#endif
#ifndef PROBE_MASK
#define PROBE_MASK 0
#endif
#define REPEAT(k) for (int rep_ = 0; rep_ < (((PROBE_MASK >> (k)) & 1) ? 2 : 1); ++rep_)
constexpr int NPHASE = 2 + 6 * NLAYER;
__global__ void __launch_bounds__(NTHREADS, 2) fwd_megakernel(Params p_k) {
  extern __shared__ __attribute__((aligned(16))) unsigned char lds_raw[];
  LAS unsigned char* lds = (LAS unsigned char*)lds_raw;
  cg::grid_group grid = cg::this_grid();
  const int lo = p_k.ph_lo, hi = p_k.ph_hi;
#define IN(k) (lo <= (k) && (k) < hi)
#define SEAM(k) do { if (IN(k) && IN((k) + 1)) xcd_barrier(bar); } while (0)
  const int G = gridDim.x, c = blockIdx.x;
  if (threadIdx.x < 2) ((LAS unsigned*)(lds + L_BARST))[threadIdx.x] = 0u;
  XcdBarrier bar; bar.bar = (unsigned*)(p_k.ws + WS_CTL) + CW_BAR; bar.x = 0; bar.st = (volatile LAS unsigned*)(lds + L_BARST);
  if (p_k.ph_lo < 0) grid.sync();
  bar = xcd_barrier_post((unsigned*)(p_k.ws + WS_CTL) + CW_BAR, (volatile LAS unsigned*)(lds + L_BARST));
  if (IN(0)) { p0_prologue(p_k, lds); if ((PROBE_MASK >> 6) & 1) { __syncthreads(); p0_prologue(p_k, lds); } }
  SEAM(0);
  for (int l = 0; l < NLAYER; ++l) {
    const int pb = 1 + 6 * l;
    const Params& p = p_k; unsigned char* ws = p.ws;
    if (IN(pb + 0)) REPEAT(0) {
      pg8::GemmDesc g{(const char*)(ws + WS_XB), (const char*)(ws + WS_WIN) + (size_t)l * INC * D * 2, D, D, D / 64, (size_t)256 * D * 2, (size_t)128 * D * 2};
      pg8::P1Order S; S.R1.init(TOK / 256, pg8::P1_NN, G, c);
      EpiP1 E{(const float*)(ws + WS_SS), (bf16_t*)(ws + WS_QKV), (bf16_t*)(ws + WS_GATE), p.b_gate + (size_t)l * 3 * D, p.out, l, rep_ == 1 ? PROBE_P1_FLAGS : 0, lds};
#if PROBE_NULL_EPI
      if (rep_ == 1) { EpiNull EN; pg8::gemm_phase<EpiNull, false, false, pg8::P1Order>(lds, g, S, EN); } else
#endif
      pg8::gemm_phase<EpiP1, false, false, pg8::P1Order>(lds, g, S, E);
    }
    SEAM(pb + 0);
    if (IN(pb + 1)) REPEAT(1) {
      for (int j = G - 1 - c; j < pg8::P1_DEFER; j += G) { pg8::OneUnit S1; S1.u = pg8::p1_deferred_unit(j);
        pg8::gemm_phase<EpiP1, false, false, pg8::OneUnit>(lds, p1_desc(ws, l), S1, p1_epi(p, l, lds)); }
      attn::attn_phase(p, l + 2 * rep_, lds); }
    SEAM(pb + 1);
    if (IN(pb + 2)) REPEAT(2) {
      pg8::GemmDesc g{(const char*)(ws + WS_O), (const char*)(ws + WS_WBR) + (size_t)l * D * OW * 2, OW, OW, OW / 64, (size_t)256 * OW * 2, (size_t)128 * OW * 2};
      pg8::StaticOrder S; S.init(TOKP / 256, D / 256, G, c);
      EpiP3 E{(const bf16_t*)(ws + WS_GATE), (bf16_t*)(ws + WS_H)};
      pg8::gemm_phase<EpiP3>(lds, g, S, E);
      pg8::GemmDesc gh = g; gh.b_tile = (size_t)128 * OW * 2;
      pg8::StaticOrder S2; S2.init(TOKS / 128, D / 128, G, c, TOKP / 128);
      EpiP3T<true, true> E2{(const bf16_t*)(ws + WS_GATE), (bf16_t*)(ws + WS_H)};
      pg8::gemm_phase<EpiP3T<true, true>, true, true>(lds, gh, S2, E2);
    }
    SEAM(pb + 2);
    if (IN(pb + 3)) {
      pg8::GemmDesc g{(const char*)(ws + WS_H), (const char*)(ws + WS_WOUT) + (size_t)l * D * D * 2, D, D, D / 64, (size_t)256 * D * 2, (size_t)128 * D * 2};
      pg8::StaticOrder S; S.init(TOKP / 256, D / 256, G, c);
      EpiRes E{(float*)(ws + WS_X32), (bf16_t*)(ws + WS_XB), (float*)(ws + WS_SS), lds, l == 0 ? p.x_prompt : nullptr, l == 0 ? p.x_sample : nullptr};
      pg8::gemm_phase<EpiRes>(lds, g, S, E);
      pg8::GemmDesc gh = g; gh.b_tile = (size_t)128 * D * 2;
      pg8::StaticOrder S2; S2.init(TOKS / 128, D / 128, G, c, TOKP / 128);
      EpiResT<true, true> E2{(float*)(ws + WS_X32), (bf16_t*)(ws + WS_XB), (float*)(ws + WS_SS), lds, l == 0 ? p.x_prompt : nullptr, l == 0 ? p.x_sample : nullptr};
      pg8::gemm_phase<EpiResT<true, true>, true, true>(lds, gh, S2, E2);
    }
    SEAM(pb + 3);
    if (IN(pb + 4)) REPEAT(4) {
      pg8::GemmDesc g{(const char*)(ws + WS_XB), (const char*)(ws + WS_WUP) + (size_t)l * 2 * DFF * D * 2, D, D, D / 64, (size_t)128 * D * 2, (size_t)DFF * D * 2};
      pg8::StaticOrder S; S.init(TOKP / 256, DFF / 128, G, c);
      EpiP5F E{(const float*)(ws + WS_SS), (bf16_t*)(ws + WS_HF), p.out, p.conv_w + (size_t)l * 3 * DFF, p.conv_b + (size_t)l * DFF, p.state_conv + (size_t)l * DB * 2 * DFF, (float*)(ws + WS_SIDE), lds, l};
      pg8::gemm_phase<EpiP5F>(lds, g, S, E);
      pg8::StaticOrder S2; S2.init(TOKS / 128, DFF / 128, G, (c + G / 2) % G, TOKP / 128);
      EpiP5FT<true> E2{(const float*)(ws + WS_SS), (bf16_t*)(ws + WS_HF), p.out, p.conv_w + (size_t)l * 3 * DFF, p.conv_b + (size_t)l * DFF, p.state_conv + (size_t)l * DB * 2 * DFF, (float*)(ws + WS_SIDE), lds, l};
      pg8::gemm_phase<EpiP5FT<true>, false, true>(lds, g, S2, E2);
    }
    SEAM(pb + 4);
    if (IN(pb + 5)) {
      pg8::GemmDesc g{(const char*)(ws + WS_HF), (const char*)(ws + WS_WDN) + (size_t)l * D * DFF * 2, DFF, DFF, DFF / 64, (size_t)256 * DFF * 2, (size_t)128 * DFF * 2};
      pg8::StaticOrder S; S.init(TOKP / 256, D / 256, G, c);
      { pg8::Unit uu; for (int i = 0; S.next(i, uu); ++i) if (uu.pm < 64 && (uu.pm & 15) != 0) p6_fixup_panel(uu.pm, (const float*)(ws + WS_SIDE), p.conv_w + (size_t)l * 3 * DFF, (bf16_t*)(ws + WS_HF));
        asm volatile("s_waitcnt vmcnt(0)" ::: "memory"); __syncthreads(); }
      EpiRes E{(float*)(ws + WS_X32), (bf16_t*)(ws + WS_XB), (float*)(ws + WS_SS), lds, nullptr, nullptr};
      pg8::gemm_phase<EpiRes>(lds, g, S, E);
      pg8::GemmDesc gh = g; gh.b_tile = (size_t)128 * DFF * 2;
      pg8::StaticOrder S2; S2.init(TOKS / 128, D / 128, G, c, TOKP / 128);
      EpiResT<true, true> E2{(float*)(ws + WS_X32), (bf16_t*)(ws + WS_XB), (float*)(ws + WS_SS), lds, nullptr, nullptr};
      pg8::gemm_phase<EpiResT<true, true>, true, true>(lds, gh, S2, E2);
    }
    SEAM(pb + 5);
  }
  if (IN(NPHASE - 1)) { pfinal_norm(p_k); }
#undef IN
#undef SEAM
}

#ifndef MK_ONE_LAUNCH
#define MK_ONE_LAUNCH 1
#endif
extern "C" void kernel_launch(void* const* d_in, const int* in_sizes, int n_in, void* d_out, int out_size, void* d_ws, size_t ws_size, hipStream_t stream) {
  static int grid_blocks = 0;
  if (grid_blocks == 0) {
    int dev = 0, cus = 0, per_cu = 0;
    (void)hipGetDevice(&dev);
    (void)hipDeviceGetAttribute(&cus, hipDeviceAttributeMultiprocessorCount, dev);
    (void)hipFuncSetAttribute((const void*)fwd_megakernel, hipFuncAttributeMaxDynamicSharedMemorySize, LDS_BYTES);
    (void)hipOccupancyMaxActiveBlocksPerMultiprocessor(&per_cu, (const void*)fwd_megakernel, NTHREADS, LDS_BYTES);
    if (per_cu < 1) { fprintf(stderr, "kernel_launch: occupancy query says %d blocks/CU\n", per_cu); per_cu = 1; }
    grid_blocks = cus * per_cu;
    if (n_in != 24 || (size_t)out_size != O_END || ws_size < WS_END) { fprintf(stderr, "kernel_launch: unexpected problem (n_in %d out %d ws %zu, need %zu)\n", n_in, out_size, ws_size, (size_t)WS_END); grid_blocks = -1; }
  }
  if (grid_blocks < 0) return;
  Params p{};
  const float** f = (const float**)&p;
  for (int i = 0; i < 24; ++i) f[i] = (const float*)d_in[i];
  p.out = (float*)d_out; p.ws = (unsigned char*)d_ws;
#if MK_ONE_LAUNCH
  p.ph_lo = 0; p.ph_hi = NPHASE;
  (void)hipMemsetAsync((unsigned char*)d_ws + WS_CTL + (size_t)CW_BAR * 4, 0, (size_t)XCD_BAR_WORDS * 4, stream);
  { void* args[] = {&p};
    hipError_t e = hipLaunchCooperativeKernel((void*)fwd_megakernel, dim3(grid_blocks), dim3(NTHREADS), args, LDS_BYTES, stream);
    if (e != hipSuccess) fprintf(stderr, "cooperative launch failed: %s (grid %d)\n", hipGetErrorString(e), grid_blocks); }
#else
  for (int k = 0; k < NPHASE; ++k) { p.ph_lo = k; p.ph_hi = k + 1; void* args[] = {&p};
    hipError_t e = hipLaunchCooperativeKernel((void*)fwd_megakernel, dim3(grid_blocks), dim3(NTHREADS), args, LDS_BYTES, stream);
    if (e != hipSuccess) { fprintf(stderr, "launch %d failed: %s (grid %d)\n", k, hipGetErrorString(e), grid_blocks); break; } }
#endif
}
```

```cpp
#include <hip/hip_runtime.h>
#include <hip/hip_cooperative_groups.h>
#include <cstdio>
#include <cstdint>
namespace cg = cooperative_groups;

#define DI __device__ __forceinline__
#define LAS __attribute__((address_space(3)))
typedef unsigned short bf16_t;
typedef short bf16x8 __attribute__((ext_vector_type(8)));
typedef short s16x4 __attribute__((ext_vector_type(4)));
typedef float f32x2 __attribute__((ext_vector_type(2)));
typedef float f32x4 __attribute__((ext_vector_type(4)));
typedef float f32x8 __attribute__((ext_vector_type(8)));
typedef float f32x16 __attribute__((ext_vector_type(16)));
typedef unsigned u32x2 __attribute__((ext_vector_type(2)));
typedef unsigned u32x4 __attribute__((ext_vector_type(4)));
typedef __bf16 bfv4 __attribute__((ext_vector_type(4)));
typedef __bf16 bfv8 __attribute__((ext_vector_type(8)));

constexpr int D = 1024, SEQ = 4096, NB = 4, TOKP = NB * SEQ, DB = 32, DSEQ = 64, TOKS = DB * DSEQ, TOK = TOKP + TOKS;
constexpr int PAST = 1024, ALEN = 512, INC = 7680, DFF = 2816, NLAYER = 2;
constexpr int QKVW = 4608, GATEW = 3072, OW = 1536;
constexpr float EPS = 1e-6f, LOG2E = 1.4426950408889634f;

constexpr size_t O_YP = 0, O_YS = O_YP + (size_t)TOKP * D, O_PAK = O_YS + (size_t)TOKS * D, O_PAV = O_PAK + (size_t)2 * 4 * 512 * 512,
                 O_PBK = O_PAV + (size_t)2 * 4 * 512 * 512, O_PBV = O_PBK + (size_t)2 * TOKP * 512, O_PCK = O_PBV + (size_t)2 * TOKP * 512,
                 O_PCV = O_PCK + (size_t)2 * TOKP * 512, O_PCONV = O_PCV + (size_t)2 * TOKP * 512, O_SAK = O_PCONV + (size_t)2 * 4 * 2 * DFF,
                 O_SAV = O_SAK + (size_t)2 * DB * 512 * 512, O_SBK = O_SAV + (size_t)2 * DB * 512 * 512, O_SBV = O_SBK + (size_t)2 * TOKS * 512,
                 O_SCK = O_SBV + (size_t)2 * TOKS * 512, O_SCV = O_SCK + (size_t)2 * TOKS * 512, O_SCONV = O_SCV + (size_t)2 * TOKS * 512,
                 O_END = O_SCONV + (size_t)2 * DB * 2 * DFF;

constexpr size_t MiB = 1u << 20;
constexpr size_t WS_CTL = 0;
constexpr size_t WS_WIN = 1 * MiB;
constexpr size_t WS_WBR = WS_WIN + (size_t)2 * INC * D * 2;
constexpr size_t WS_WOUT = WS_WBR + (size_t)2 * D * OW * 2;
constexpr size_t WS_WUP = WS_WOUT + (size_t)2 * D * D * 2;
constexpr size_t WS_WDN = WS_WUP + (size_t)2 * 2 * DFF * D * 2;
constexpr size_t WS_XB = WS_WDN + (size_t)2 * D * DFF * 2;
constexpr size_t WS_X32 = WS_XB + (size_t)TOK * D * 2;
constexpr size_t WS_SS = WS_X32 + (size_t)TOK * D * 4;
constexpr size_t WS_SIDE = WS_SS + (size_t)TOK * 8 * 4;
constexpr size_t WS_O = WS_SIDE + (size_t)3 * 72 * 2 * DFF * 4;
constexpr size_t WS_H = WS_O + (size_t)TOK * OW * 2;
constexpr size_t WS_HF = WS_H + (size_t)TOK * D * 2;
constexpr size_t WS_QKV = WS_HF + (size_t)TOK * DFF * 2;
constexpr size_t WS_GATE = WS_QKV + (size_t)TOK * QKVW * 2;
constexpr size_t WS_END = WS_GATE + (size_t)TOK * GATEW * 2;
constexpr int CW_QUEUE = 64;
constexpr int CW_LAM = 1024;
constexpr int CW_T5 = 2048;
constexpr int CW_BAR = 8192;

constexpr int LDS_BYTES = 160 * 1024;
constexpr int NTHREADS = 512;

DI u32x4 pack8(f32x4 a, f32x4 b) { f32x8 v = {a[0], a[1], a[2], a[3], b[0], b[1], b[2], b[3]}; return __builtin_bit_cast(u32x4, __builtin_convertvector(v, bfv8)); }
DI u32x2 pack4(f32x4 a) { return __builtin_bit_cast(u32x2, __builtin_convertvector(a, bfv4)); }
DI float bflo(unsigned w) { return __uint_as_float(w << 16); }
DI float bfhi(unsigned w) { return __uint_as_float(w & 0xffff0000u); }
DI float wave_sum(float v) {
#pragma unroll
  for (int o = 1; o < 64; o <<= 1) v += __shfl_xor(v, o);
  return v;
}
DI float fast_rcp(float x) { return __builtin_amdgcn_rcpf(x); }
DI float fast_exp2(float x) { return __builtin_amdgcn_exp2f(x); }
DI float fast_log2(float x) { return __builtin_amdgcn_logf(x); }

DI LAS unsigned char* opaque_lds(LAS unsigned char* p) { unsigned v = (unsigned)(__UINTPTR_TYPE__)p; asm volatile("" : "+s"(v)); return (LAS unsigned char*)(__UINTPTR_TYPE__)v; }

struct Params {
  const float* x_prompt; const float* x_sample;
  const float* cache_a_k; const float* cache_a_v; const float* cache_b_k; const float* cache_b_v; const float* cache_c_k; const float* cache_c_v;
  const float* state_conv; const float* norm_mix; const float* w_in; const float* b_gate; const float* a_rel_bias; const float* t5_bias;
  const float* c_lambda; const float* c_subln; const float* w_branch; const float* w_out; const float* norm_ffn; const float* w_up;
  const float* conv_w; const float* conv_b; const float* w_down; const float* norm_final;
  float* out; unsigned char* ws;
  int ph_lo, ph_hi;
};

DI void p0_transpose_item(const float* W, int N, const float* kscale, bf16_t* WT, int dst_ld, int dst_col, LAS float* scr, int item, int lane) {
  const int nblk = N / 32, kb = item / nblk, nb = item % nblk, k0 = 64 * kb, n0 = 32 * nb;
  float wv[32];
#pragma unroll
  for (int i = 0; i < 32; ++i) wv[i] = __builtin_nontemporal_load(&W[(size_t)(k0 + 2 * i + (lane >> 5)) * N + n0 + (lane & 31)]);
#pragma unroll
  for (int i = 0; i < 32; ++i) { const int kk = 2 * i + (lane >> 5); float v = wv[i]; if (kscale) v *= kscale[k0 + kk]; scr[kk * 33 + (lane & 31)] = v; }
  asm volatile("s_waitcnt lgkmcnt(0)" ::: "memory");
  const int c = lane & 7;
#pragma unroll
  for (int j = 0; j < 4; ++j) { const int n = (lane >> 3) + 8 * j; const LAS float* s = scr + (8 * c) * 33 + n;
    f32x4 a = {s[0 * 33], s[1 * 33], s[2 * 33], s[3 * 33]}, b = {s[4 * 33], s[5 * 33], s[6 * 33], s[7 * 33]};
    *(u32x4*)(WT + (size_t)(n0 + n) * dst_ld + dst_col + k0 + 8 * c) = pack8(a, b); }
  asm volatile("s_waitcnt lgkmcnt(0)" ::: "memory");
}

DI int t5_bucket_of(int rel) {
  const int n = rel < 0 ? -rel : rel; int f;
  if (n < 8) f = n; else if (n < 12) f = 8; else if (n < 16) f = 9; else if (n < 23) f = 10; else if (n < 32) f = 11; else if (n < 46) f = 12; else if (n < 64) f = 13; else if (n < 91) f = 14; else f = 15;
  return (rel > 0 ? 16 : 0) + f;
}

DI void p0_prologue(const Params& p, LAS unsigned char* lds_in) {
  LAS unsigned char* lds = opaque_lds(lds_in);
  int tid_ = threadIdx.x; asm volatile("" : "+v"(tid_));
  const int tid = tid_, lane = tid & 63, wave = tid >> 6;
  const int gw = blockIdx.x * 8 + wave, NGW = gridDim.x * 8;
  unsigned* ctl = (unsigned*)(p.ws + WS_CTL);
  if (blockIdx.x == 0) {
    if (tid < 4) ctl[CW_QUEUE + 64 * tid] = 0u;
    if (wave == 1) {
      for (int l = 0; l < NLAYER; ++l) { const float* lp = p.c_lambda + l * 256; const float a = wave_sum(lp[lane] * lp[64 + lane]), b = wave_sum(lp[128 + lane] * lp[192 + lane]);
        const float lam_init = 0.8f - 0.6f * expf(-0.3f * (float)l);
        if (lane == 0) ((float*)ctl)[CW_LAM + l] = expf(a) - expf(b) + lam_init; }
    }
    for (int i = tid; i < 4 * 192; i += NTHREADS) { const int h = i / 192, idx = i % 192; int rel = idx - 127; if (rel > 63) rel = 63;
      ((float*)ctl)[CW_T5 + i] = p.t5_bias[t5_bucket_of(rel) * 4 + h] - p.t5_bias[15 * 4 + h]; }
  }
  LAS float* scr = (LAS float*)(lds + wave * 8448);
  constexpr int I_IN = (D / 64) * (INC / 32), I_BR = (512 / 64) * (D / 32), I_OUT = (D / 64) * (D / 32), I_UP = (D / 64) * (2 * DFF / 32), I_DN = (DFF / 64) * (D / 32);
  constexpr int PER_LAYER = I_IN + 3 * I_BR + I_OUT + I_UP + I_DN;
  for (int it = gw; it < NLAYER * PER_LAYER; it += NGW) {
    const int l = it / PER_LAYER; int r = it % PER_LAYER;
    if (r < I_IN) { p0_transpose_item(p.w_in + (size_t)l * D * INC, INC, p.norm_mix + l * D, (bf16_t*)(p.ws + WS_WIN) + (size_t)l * INC * D, D, 0, scr, r, lane); continue; } r -= I_IN;
    if (r < 3 * I_BR) { const int n = r / I_BR; p0_transpose_item(p.w_branch + ((size_t)l * 3 + n) * 512 * D, D, nullptr, (bf16_t*)(p.ws + WS_WBR) + (size_t)l * D * OW, OW, 512 * n, scr, r % I_BR, lane); continue; } r -= 3 * I_BR;
    if (r < I_OUT) { p0_transpose_item(p.w_out + (size_t)l * D * D, D, nullptr, (bf16_t*)(p.ws + WS_WOUT) + (size_t)l * D * D, D, 0, scr, r, lane); continue; } r -= I_OUT;
    if (r < I_UP) { p0_transpose_item(p.w_up + (size_t)l * D * 2 * DFF, 2 * DFF, p.norm_ffn + l * D, (bf16_t*)(p.ws + WS_WUP) + (size_t)l * 2 * DFF * D, D, 0, scr, r, lane); continue; } r -= I_UP;
    p0_transpose_item(p.w_down + (size_t)l * DFF * D, D, nullptr, (bf16_t*)(p.ws + WS_WDN) + (size_t)l * D * DFF, DFF, 0, scr, r, lane);
  }
  bf16_t* XB = (bf16_t*)(p.ws + WS_XB); float* SS = (float*)(p.ws + WS_SS);
#pragma unroll 3
  for (int m = gw; m < TOK; m += NGW) {
    const float* src = m < TOKP ? p.x_prompt + (size_t)m * D : p.x_sample + (size_t)(m - TOKP) * D;
    float s = 0.f;
#pragma unroll
    for (int j = 0; j < 4; ++j) { const f32x4 v = __builtin_nontemporal_load(&((const f32x4*)src)[lane + 64 * j]); ((u32x2*)(XB + (size_t)m * D))[lane + 64 * j] = pack4(v);
      s += (v[0] * v[0] + v[1] * v[1]) + (v[2] * v[2] + v[3] * v[3]); }
    s = wave_sum(s);
    if (lane < 8) SS[(size_t)m * 8 + lane] = lane == 0 ? s : 0.f;
  }
}

namespace pg8 {
constexpr int BM = 256, BK = 64, HALF = 128, HTB = HALF * BK * 2, STAGE_BYTES = 8 * HTB, NXCD = 8, WGM = 8;
DI int lds_byte(int r, int c) { const int st = (r >> 4) * 2 + (c >> 5), rr = r & 15, cc = c & 31, ob = rr * 64 + cc * 2; return st * 1024 + (ob ^ (((ob >> 9) & 1) << 5)); }
DI void stage_rc(int b, int& R, int& C) { const int st = b / 1024, sb = b % 1024, swz = sb ^ (((sb >> 9) & 1) << 5); R = (st >> 1) * 16 + swz / 64; C = (st & 1) * 32 + (swz % 64) / 2; }
DI int perm32(int rho) { const int n = rho >> 4, i = rho & 15; return 8 * (i >> 2) + 4 * n + (i & 3); }
struct Unit { int pm, pn; };
struct GemmDesc { const char* A; const char* B; int lda, ldb, nt; size_t b_tile, b_half; };
struct StaticOrder {
  int nM, nN, nwg, G, c, pm0;
  DI void init(int nM_, int nN_, int G_, int c_, int pm0_ = 0) { nM = nM_; nN = nN_; nwg = nM * nN; G = G_; c = c_; pm0 = pm0_; }
  DI bool next(int i, Unit& u) const {
    const long L = (long)i * G + c; if (L >= nwg) return false;
    int wgid = (int)L; { const int q = nwg / NXCD, r = nwg % NXCD, xcd = wgid % NXCD, off = wgid / NXCD; wgid = (xcd < r ? xcd * (q + 1) : r * (q + 1) + (xcd - r) * q) + off; }
    const int nig = WGM * nN, gid = wgid / nig, fm = gid * WGM, gsz = (nM - fm) < WGM ? (nM - fm) : WGM;
    u.pm = pm0 + fm + ((wgid % nig) % gsz); u.pn = (wgid % nig) / gsz; return true;
  }
};
constexpr int P1_NN = 28, P1_EXTRA = 32, P1_DEFER = 72 + (72 - P1_EXTRA);
struct P1Order {
  StaticOrder R1;
  DI bool next(int i, Unit& u) const {
    if (R1.next(i, u)) return true;
    const long L = (long)i * R1.G + R1.c - R1.nwg; if (L >= P1_EXTRA) return false;
    u.pm = (int)L; u.pn = P1_NN; return true;
  }
};
DI Unit p1_deferred_unit(int j) { Unit u; if (j < 72) { u.pm = j; u.pn = P1_NN + 1; } else { u.pm = P1_EXTRA + (j - 72); u.pn = P1_NN; } return u; }
struct OneUnit { Unit u; DI bool next(int i, Unit& o) const { if (i != 0) return false; o = u; return true; } };
template <class Epi, bool HALFN = false, bool HALFM = false, class Sched = StaticOrder>
DI void gemm_phase(LAS unsigned char* lds_in, const GemmDesc g, const Sched& S, const Epi& E) {
  LAS unsigned char* lds = opaque_lds(lds_in);
  int tid_ = threadIdx.x; asm volatile("" : "+v"(tid_));
  const int tid = tid_, wid = __builtin_amdgcn_readfirstlane(tid >> 6), lane = tid & 63, wr = wid >> 2, wc = wid & 3, fr = lane & 15, fq = lane >> 4;
  const int nt = g.nt;
  unsigned voffA[2], voffB[2];
#pragma unroll
  for (int i = 0; i < 2; ++i) { int R, C; stage_rc(tid * 16 + i * 8192, R, C); const int Rb = Epi::PERM ? ((R & ~31) + perm32(R & 31)) : R;
    voffA[i] = (unsigned)(R * g.lda + C) * 2u; voffB[i] = (unsigned)(Rb * g.ldb + C) * 2u; }
  const size_t kstep = (size_t)(BK * 2);
  const size_t hsA = (size_t)HALF * g.lda * 2, tsA = HALFM ? hsA : 2 * hsA, hsB = g.b_half, tsB = g.b_tile;
  const unsigned ldsw = (unsigned)wid * 1024u;
  const int aoff = lds_byte(wr * 64 + fr, fq * 8), boff = lds_byte(wc * 32 + fr, fq * 8);
#define PG8_SA(b, h) (((b) * 2 + (h)) * HTB)
#define PG8_SB(b, h) ((4 + (b) * 2 + (h)) * HTB)
#define PG8_STAGE(bufoff, gbase, voff) do { _Pragma("unroll") for (int _i = 0; _i < 2; ++_i) \
    __builtin_amdgcn_global_load_lds((const unsigned*)((const char*)(gbase) + (voff)[_i]), (LAS unsigned*)(lds + (bufoff) + ldsw + _i * 8192), 16, 0, 0); } while (0)
#define PG8_LDA(dst, b, h) do { _Pragma("unroll") for (int m = 0; m < 4; ++m) _Pragma("unroll") for (int k = 0; k < 2; ++k) dst[m][k] = *(const LAS bf16x8*)(lds + PG8_SA(b, h) + aoff + m * 2048 + k * 1024); } while (0)
#define PG8_LDB(dst, b, h) do { _Pragma("unroll") for (int n = 0; n < 2; ++n) _Pragma("unroll") for (int k = 0; k < 2; ++k) dst[n][k] = *(const LAS bf16x8*)(lds + PG8_SB(b, h) + boff + n * 2048 + k * 1024); } while (0)
#define PG8_MMA(ai, bj, At, Bt) do { __builtin_amdgcn_s_setprio(1); _Pragma("unroll") for (int m = 0; m < 4; ++m) _Pragma("unroll") for (int n = 0; n < 2; ++n) _Pragma("unroll") for (int k = 0; k < 2; ++k) \
    acc[ai][bj][m][n] = __builtin_amdgcn_mfma_f32_16x16x32_bf16(Bt[n][k], At[m][k], acc[ai][bj][m][n], 0, 0, 0); __builtin_amdgcn_s_setprio(0); } while (0)
#define PG8_WAIT_V(n) asm volatile("s_waitcnt vmcnt(" #n ")" ::: "memory")
#define PG8_WAIT_LOOP do { if constexpr (HALFM && HALFN) PG8_WAIT_V(4); else if constexpr (HALFM || HALFN) PG8_WAIT_V(6); else PG8_WAIT_V(8); } while (0)
#define PG8_WAIT_L(n) asm volatile("s_waitcnt lgkmcnt(" #n ")" ::: "memory")
#define PG8_BAR __builtin_amdgcn_s_barrier()
#define PG8_SCHED __builtin_amdgcn_sched_barrier(0)
  Unit cur, nxt; int ui = 0;
  if (!S.next(0, cur)) return;
  f32x4 acc[2][2][4][2];
#pragma unroll
  for (int a = 0; a < 2; ++a)
#pragma unroll
    for (int b = 0; b < 2; ++b)
#pragma unroll
      for (int m = 0; m < 4; ++m)
#pragma unroll
        for (int n = 0; n < 2; ++n) acc[a][b][m][n] = (f32x4){0.f, 0.f, 0.f, 0.f};
  bf16x8 At[4][2], B0[2][2], B1[2][2];
  const char* cA = g.A + (size_t)cur.pm * tsA; const char* cB = g.B + (size_t)cur.pn * tsB;
  f32x4 ssv = {0.f, 0.f, 0.f, 0.f};
  if constexpr (Epi::HAS_RS) ssv = E.prefetch(cur, tid);
  PG8_STAGE(PG8_SB(0, 0), cB, voffB); if constexpr (!HALFN) PG8_STAGE(PG8_SB(0, 1), cB + hsB, voffB); PG8_STAGE(PG8_SA(0, 0), cA, voffA); if constexpr (!HALFM) PG8_STAGE(PG8_SA(0, 1), cA + hsA, voffA);
  if (wr == 1) PG8_BAR;
  if constexpr (HALFM) PG8_WAIT_V(0); else PG8_WAIT_V(2);
  PG8_BAR;
  PG8_STAGE(PG8_SB(1, 0), cB + kstep, voffB); PG8_STAGE(PG8_SA(1, 0), cA + kstep, voffA); if constexpr (!HALFN) PG8_STAGE(PG8_SB(1, 1), cB + hsB + kstep, voffB);
  if constexpr (HALFN) PG8_WAIT_V(4); else PG8_WAIT_V(6);
  PG8_BAR;
  for (;;) {
    const bool has_next = S.next(ui + 1, nxt);
    const char* nA = has_next ? g.A + (size_t)nxt.pm * tsA : cA; const char* nB = has_next ? g.B + (size_t)nxt.pn * tsB : cB;
    for (int t = 0; t < nt; t += 2) {
      const bool last = (t == nt - 2);
      const char* a1 = cA + (size_t)(t + 1) * kstep;
      const char* a2 = last ? nA : cA + (size_t)(t + 2) * kstep; const char* b2 = last ? nB : cB + (size_t)(t + 2) * kstep;
      const char* a3 = a2 + kstep; const char* b3 = b2 + kstep;
      if constexpr (Epi::HAS_MID) { if (t == 8 || t == 16) E.mid(acc, cur, t, wr, wc, fr, fq); }
      PG8_LDB(B0, 0, 0); if constexpr (!HALFN) PG8_LDB(B1, 0, 1); PG8_SCHED; PG8_LDA(At, 0, 0); if constexpr (!HALFM) PG8_STAGE(PG8_SA(1, 1), a1 + hsA, voffA);
      PG8_WAIT_LOOP; PG8_WAIT_L(0); PG8_BAR; PG8_MMA(0, 0, At, B0); if constexpr (!HALFN) PG8_MMA(0, 1, At, B1); PG8_BAR; PG8_SCHED;
      if constexpr (!HALFM) PG8_LDA(At, 0, 1); PG8_STAGE(PG8_SB(0, 0), b2, voffB); if constexpr (!HALFN) PG8_STAGE(PG8_SB(0, 1), b2 + hsB, voffB); PG8_STAGE(PG8_SA(0, 0), a2, voffA);
      PG8_WAIT_LOOP; PG8_WAIT_L(0); PG8_BAR; if constexpr (!HALFM) { PG8_MMA(1, 0, At, B0); if constexpr (!HALFN) PG8_MMA(1, 1, At, B1); } PG8_BAR; PG8_SCHED;
      PG8_LDB(B0, 1, 0); if constexpr (!HALFN) PG8_LDB(B1, 1, 1); PG8_SCHED; PG8_LDA(At, 1, 0); if constexpr (!HALFM) PG8_STAGE(PG8_SA(0, 1), a2 + hsA, voffA);
      PG8_WAIT_LOOP; PG8_WAIT_L(0); PG8_BAR; PG8_MMA(0, 0, At, B0); if constexpr (!HALFN) PG8_MMA(0, 1, At, B1); PG8_BAR; PG8_SCHED;
      if constexpr (!HALFM) PG8_LDA(At, 1, 1); PG8_STAGE(PG8_SB(1, 0), b3, voffB); if constexpr (!HALFN) PG8_STAGE(PG8_SB(1, 1), b3 + hsB, voffB); PG8_STAGE(PG8_SA(1, 0), a3, voffA);
      PG8_WAIT_LOOP; PG8_WAIT_L(0); PG8_BAR; if constexpr (!HALFM) { PG8_MMA(1, 0, At, B0); if constexpr (!HALFN) PG8_MMA(1, 1, At, B1); } PG8_BAR; PG8_SCHED;
    }
    if (wr == 0) PG8_BAR;
    if constexpr (Epi::HAS_RS) { E.stash(ssv, cur, tid, lds); PG8_WAIT_L(0); PG8_BAR; asm volatile("" ::: "memory"); }
    E(acc, cur, wr, wc, fr, fq);
    if (!has_next) break;
#pragma unroll
    for (int a = 0; a < 2; ++a)
#pragma unroll
      for (int b = 0; b < 2; ++b)
#pragma unroll
        for (int m = 0; m < 4; ++m)
#pragma unroll
          for (int n = 0; n < 2; ++n) acc[a][b][m][n] = (f32x4){0.f, 0.f, 0.f, 0.f};
    cur = nxt; cA = nA; cB = nB; ++ui;
    if constexpr (Epi::HAS_RS) ssv = E.prefetch(cur, tid);
    if (wr == 1) PG8_BAR;
  }
  PG8_WAIT_V(0);
  PG8_BAR;
#undef PG8_SA
#undef PG8_SB
#undef PG8_STAGE
#undef PG8_LDA
#undef PG8_LDB
#undef PG8_MMA
#undef PG8_WAIT_V
#undef PG8_WAIT_LOOP
#undef PG8_WAIT_L
#undef PG8_BAR
#undef PG8_SCHED
}
}
using pg8::Unit;
DI f32x4 ss_load(const float* SS, int r) { const f32x4* q = (const f32x4*)(SS + (size_t)r * 8); return q[0] + q[1]; }
DI float ss_to_rs(const f32x4& a) { return __builtin_amdgcn_rsqf(((a[0] + a[1]) + (a[2] + a[3])) * (1.0f / D) + EPS); }
DI float row_rs(const float* SS, int r) { return ss_to_rs(ss_load(SS, r)); }
DI float sigmoidf_(float x) { return fast_rcp(1.0f + fast_exp2(-x * LOG2E)); }

struct EpiP1 {
  static constexpr bool PERM = true, HAS_MID = false, HAS_RS = true;
  const float* SS; bf16_t* QKV; bf16_t* GATE; const float* bgate; float* out; int layer; int probe_flags; LAS unsigned char* lds;
  DI void mid(f32x4 (&)[2][2][4][2], const Unit&, int, int, int, int, int) const {}
  DI f32x4 prefetch(const Unit& u, int tid) const {
    f32x4 v = {0.f, 0.f, 0.f, 0.f};
    if (tid < 256) v = ss_load(SS, u.pm * 256 + tid);
    return v;
  }
  DI void stash(const f32x4& v, const Unit& u, int tid, LAS unsigned char* l) const {
    if (tid < 256) *(LAS float*)(l + 131072 + 12288 + tid * 4) = ss_to_rs(v);
  }
  DI void operator()(f32x4 (&acc)[2][2][4][2], const Unit& u, int wr, int wc, int fr, int fq) const {
    const int pn = u.pn, rin0 = wr * 64 + fr, row0 = u.pm * 256 + rin0;
    float rs[2][4];
#pragma unroll
    for (int ai = 0; ai < 2; ++ai)
#pragma unroll
      for (int m = 0; m < 4; ++m) rs[ai][m] = *(const LAS float*)(lds + 131072 + 12288 + (rin0 + ai * 128 + m * 16) * 4);
    if (pn < 18) {
      const int colq = pn * 256 + wc * 32 + 8 * fq;
#pragma unroll
      for (int ai = 0; ai < 2; ++ai)
#pragma unroll
        for (int m = 0; m < 4; ++m) {
          const int rin = rin0 + ai * 128 + m * 16, r = u.pm * 256 + rin; const float s = rs[ai][m];
          bf16_t* rowp = QKV + (size_t)r * QKVW + colq;
#pragma unroll
          for (int bj = 0; bj < 2; ++bj) { const f32x4 v0 = acc[ai][bj][m][0] * s, v1 = acc[ai][bj][m][1] * s;
            { const u32x4 pk = pack8(v0, v1); if (!(probe_flags & 2)) *(u32x4*)(rowp + bj * 128) = pk; else asm volatile("" :: "v"(pk)); }
            }
        }
    } else {
      const int gi = pn - 18, nb = gi >> 2, colg = (gi & 3) * 256 + wc * 32 + 8 * fq;
      f32x4 bv[2][2];
#pragma unroll
      for (int bj = 0; bj < 2; ++bj) { bv[bj][0] = *(const f32x4*)(bgate + nb * D + colg + bj * 128); bv[bj][1] = *(const f32x4*)(bgate + nb * D + colg + bj * 128 + 4); }
#pragma unroll
      for (int ai = 0; ai < 2; ++ai)
#pragma unroll
        for (int m = 0; m < 4; ++m) { const int r = row0 + ai * 128 + m * 16; const float s = rs[ai][m];
          bf16_t* rowp = GATE + (size_t)r * GATEW + gi * 256 + wc * 32 + 8 * fq;
#pragma unroll
          for (int bj = 0; bj < 2; ++bj) { f32x4 v0 = acc[ai][bj][m][0] * s + bv[bj][0], v1 = acc[ai][bj][m][1] * s + bv[bj][1];
#pragma unroll
            for (int j = 0; j < 4; ++j) { v0[j] = 1.0f + fast_exp2(fminf(-v0[j] * LOG2E, 100.0f)); v1[j] = 1.0f + fast_exp2(fminf(-v1[j] * LOG2E, 100.0f)); }
            { const u32x4 pk = pack8(v0, v1); if (!(probe_flags & 2)) *(u32x4*)(rowp + bj * 128) = pk; else asm volatile("" :: "v"(pk)); } } }
    }
  }
};

template <bool HALFN, bool HALFM = false> struct EpiP3T {
  static constexpr bool PERM = true, HAS_MID = true, HAS_RS = false;
  const bf16_t* GATE; bf16_t* H;
  DI void mid(f32x4 (&acc)[2][2][4][2], const Unit& u, int t, int wr, int wc, int fr, int fq) const {
    const int nb = (t >> 3) - 1;
    const bf16_t* gp = GATE + (size_t)(u.pm * (HALFM ? 128 : 256) + wr * 64 + fr) * GATEW + nb * D + u.pn * (HALFN ? 128 : 256) + wc * 32 + 8 * fq;
#pragma unroll
    for (int ai = 0; ai < (HALFM ? 1 : 2); ++ai) {
        u32x4 ga[4][2] = {}, gb[4][2] = {};
#pragma unroll
        for (int m = 0; m < 4; ++m)
#pragma unroll
          for (int bj = 0; bj < (HALFN ? 1 : 2); ++bj) { const bf16_t* q = gp + (size_t)(ai * 128 + m * 16) * GATEW + bj * 128; ga[m][bj] = *(const u32x4*)q; gb[m][bj] = *(const u32x4*)(q + D); }
#pragma unroll
        for (int m = 0; m < 4; ++m)
#pragma unroll
          for (int bj = 0; bj < (HALFN ? 1 : 2); ++bj)
#pragma unroll
            for (int n = 0; n < 2; ++n) { const unsigned a0 = ga[m][bj][2 * n], a1 = ga[m][bj][2 * n + 1], b0 = gb[m][bj][2 * n], b1 = gb[m][bj][2 * n + 1];
              acc[ai][bj][m][n][0] *= bflo(b0) * fast_rcp(bflo(a0)); acc[ai][bj][m][n][1] *= bfhi(b0) * fast_rcp(bfhi(a0));
              acc[ai][bj][m][n][2] *= bflo(b1) * fast_rcp(bflo(a1)); acc[ai][bj][m][n][3] *= bfhi(b1) * fast_rcp(bfhi(a1)); }
        asm volatile("" ::: "memory"); }
  }
  DI void operator()(f32x4 (&acc)[2][2][4][2], const Unit& u, int wr, int wc, int fr, int fq) const {
    const int row0 = u.pm * (HALFM ? 128 : 256) + wr * 64 + fr, col0 = u.pn * (HALFN ? 128 : 256) + wc * 32 + 8 * fq;
#pragma unroll
    for (int ai = 0; ai < (HALFM ? 1 : 2); ++ai)
#pragma unroll
      for (int m = 0; m < 4; ++m) { const int r = row0 + ai * 128 + m * 16; const bf16_t* gp = GATE + (size_t)r * GATEW + 2 * D + col0; bf16_t* hp = H + (size_t)r * D + col0;
#pragma unroll
        for (int bj = 0; bj < (HALFN ? 1 : 2); ++bj) { const u32x4 g = *(const u32x4*)(gp + bj * 128); f32x4 v0 = acc[ai][bj][m][0], v1 = acc[ai][bj][m][1];
          v0[0] *= fast_rcp(bflo(g[0])); v0[1] *= fast_rcp(bfhi(g[0])); v0[2] *= fast_rcp(bflo(g[1])); v0[3] *= fast_rcp(bfhi(g[1])); v1[0] *= fast_rcp(bflo(g[2])); v1[1] *= fast_rcp(bfhi(g[2])); v1[2] *= fast_rcp(bflo(g[3])); v1[3] *= fast_rcp(bfhi(g[3]));
          *(u32x4*)(hp + bj * 128) = pack8(v0, v1); } }
  }
};

typedef EpiP3T<false> EpiP3;

template <bool HALFN, bool HALFM = false> struct EpiResT {
  static constexpr bool PERM = true, HAS_MID = false, HAS_RS = false;
  float* X32; bf16_t* XB; float* SS; LAS unsigned char* lds; const float* xin_p; const float* xin_s;
  DI void mid(f32x4 (&)[2][2][4][2], const Unit&, int, int, int, int, int) const {}
  DI void operator()(f32x4 (&acc)[2][2][4][2], const Unit& u, int wr, int wc, int fr, int fq) const {
    const int rin0 = wr * 64 + fr, row0 = u.pm * (HALFM ? 128 : 256) + rin0, col0 = u.pn * (HALFN ? 128 : 256) + wc * 32 + 8 * fq;
    LAS float* red = (LAS float*)(lds + 131072 + 8192);
#pragma unroll
    for (int ai = 0; ai < (HALFM ? 1 : 2); ++ai) {
      f32x4 xo[4][2][2] = {};
#pragma unroll
      for (int m = 0; m < 4; ++m) { const int r = row0 + ai * 128 + m * 16;
        if (xin_p) { const float* xr = (r < TOKP ? xin_p + (size_t)r * D : xin_s + (size_t)(r - TOKP) * D) + col0;
#pragma unroll
          for (int bj = 0; bj < (HALFN ? 1 : 2); ++bj)
#pragma unroll
            for (int n = 0; n < 2; ++n) xo[m][bj][n] = *(const f32x4*)(xr + bj * 128 + n * 4);
        } else {
#pragma unroll
          for (int bj = 0; bj < (HALFN ? 1 : 2); ++bj) { const u32x4 w = *(const u32x4*)(XB + (size_t)r * D + col0 + bj * 128);
            xo[m][bj][0] = (f32x4){bflo(w[0]), bfhi(w[0]), bflo(w[1]), bfhi(w[1])}; xo[m][bj][1] = (f32x4){bflo(w[2]), bfhi(w[2]), bflo(w[3]), bfhi(w[3])}; } } }
#pragma unroll
      for (int m = 0; m < 4; ++m) { const int r = row0 + ai * 128 + m * 16; bf16_t* bp = XB + (size_t)r * D + col0; float q = 0.f;
#pragma unroll
        for (int bj = 0; bj < (HALFN ? 1 : 2); ++bj)
          { const f32x4 x0 = xo[m][bj][0] + acc[ai][bj][m][0], x1 = xo[m][bj][1] + acc[ai][bj][m][1];
            *(u32x4*)(bp + bj * 128) = pack8(x0, x1);
            q += ((x0[0] * x0[0] + x0[1] * x0[1]) + (x0[2] * x0[2] + x0[3] * x0[3])) + ((x1[0] * x1[0] + x1[1] * x1[1]) + (x1[2] * x1[2] + x1[3] * x1[3])); }
        q += __shfl_xor(q, 16); q += __shfl_xor(q, 32);
        if (fq == 0) red[(rin0 + ai * 128 + m * 16) * 4 + wc] = q; }
      asm volatile("" ::: "memory"); }
    asm volatile("s_waitcnt lgkmcnt(0)" ::: "memory"); __builtin_amdgcn_s_barrier(); asm volatile("" ::: "memory");
    int t = threadIdx.x; asm volatile("" : "+v"(t));
    if (t < (HALFM ? 128 : 256)) { const f32x4 v = *(const LAS f32x4*)(red + t * 4); const float q = (v[0] + v[1]) + (v[2] + v[3]); float* sp = SS + (size_t)(u.pm * (HALFM ? 128 : 256) + t) * 8;
      if (HALFN) sp[u.pn] = q; else *(f32x2*)(sp + 2 * u.pn) = (f32x2){q, 0.f}; }
  }
};

typedef EpiResT<false> EpiRes;

DI float dpp_ror1(float v) { return __builtin_bit_cast(float, __builtin_amdgcn_update_dpp(0, __builtin_bit_cast(int, v), 0x121, 0xf, 0xf, false)); }
DI float dpp_ror2(float v) { return __builtin_bit_cast(float, __builtin_amdgcn_update_dpp(0, __builtin_bit_cast(int, v), 0x122, 0xf, 0xf, false)); }
DI float gelu_mul(float x, float uv) {
  const float t = __builtin_fmaf(x * x, 2.0f * LOG2E * 0.7978845608028654f * 0.044715f, 2.0f * LOG2E * 0.7978845608028654f);
  const float r = fast_rcp(fast_exp2(x * t) + 1.0f);
  return __builtin_fmaf(-x, r, x) * uv;
}
constexpr size_t SIDE_ROWS = (size_t)72 * 2 * DFF;
template <bool HALFM> struct EpiP5FT {
  static constexpr bool PERM = true, HAS_MID = false, HAS_RS = true;
  const float* SS; bf16_t* HF; float* out; const float* cw; const float* cb; const float* st; float* side; LAS unsigned char* lds; int layer;
  DI void mid(f32x4 (&)[2][2][4][2], const Unit&, int, int, int, int, int) const {}
  DI f32x4 prefetch(const Unit& u, int tid) const {
    f32x4 v = {0.f, 0.f, 0.f, 0.f};
    if (tid < (HALFM ? 128 : 256)) v = ss_load(SS, u.pm * (HALFM ? 128 : 256) + tid);
    else if (tid >= 256 && tid < 384) { int j = tid - 256; asm volatile("" : "+v"(j));
      const int arr = j >> 5, c4 = (j & 31) * 4; v = *(const f32x4*)((arr < 3 ? cw + arr * DFF : cb) + u.pn * 128 + c4); }
    return v;
  }
  DI void stash(const f32x4& v, const Unit& u, int tid, LAS unsigned char* l) const {
    if (tid < (HALFM ? 128 : 256)) *(LAS float*)(l + 131072 + 12288 + tid * 4) = ss_to_rs(v);
    else if (tid >= 256 && tid < 384) *(LAS f32x4*)(l + 131072 + 13312 + (tid - 256) * 16) = v;
  }
  DI void operator()(f32x4 (&acc)[2][2][4][2], const Unit& u, int wr, int wc, int fr_in, int fq_in) const {
    int fr = fr_in, fq = fq_in; asm volatile("" : "+v"(fr), "+v"(fq));
    const int rin0 = wr * 64 + fr, col0 = u.pn * 128 + wc * 32 + 8 * fq;
    const bool sample = HALFM ? true : u.pm >= 64, cont = !sample && (u.pm & 15) != 0;
    const int bd0 = HALFM ? (u.pm - TOKP / 128) * 2 : (u.pm - 64) * 4;
    LAS float* xh = (LAS float*)(lds + 131072);
    float* TAILG = side; float* HEADC = side + SIDE_ROWS; float* HEADU = side + 2 * SIDE_ROWS;
#pragma unroll
    for (int ai = 0; ai < (HALFM ? 1 : 2); ++ai)
#pragma unroll
      for (int m = 0; m < 4; ++m) { const float s = *(const LAS float*)(lds + 131072 + 12288 + (rin0 + ai * 128 + m * 16) * 4);
#pragma unroll
        for (int n = 0; n < 2; ++n) { acc[ai][0][m][n] *= s; acc[ai][1][m][n] *= s; } }
    if (fr >= 14) {
#pragma unroll
      for (int ai = 0; ai < (HALFM ? 1 : 2); ++ai) { const int gidx = 2 * ai + wr; LAS float* xp = xh + ((gidx * 4 + wc) * 2 + (fr - 14)) * 32 + fq * 8;
        *(LAS f32x4*)xp = acc[ai][0][3][0]; *(LAS f32x4*)(xp + 4) = acc[ai][0][3][1];
        float* cp = nullptr;
        if (sample) cp = out + O_SCONV + ((size_t)(layer * DB + bd0 + gidx) * 2 + (fr - 14)) * DFF + col0;
        else if (gidx == 3) { float* tp = TAILG + ((size_t)u.pm * 2 + (fr - 14)) * DFF + col0; *(f32x4*)tp = acc[ai][0][3][0]; *(f32x4*)(tp + 4) = acc[ai][0][3][1];
          if ((u.pm & 15) == 15) cp = out + O_PCONV + ((size_t)(layer * 4 + (u.pm >> 4)) * 2 + (fr - 14)) * DFF + col0; }
        if (cp) { *(f32x4*)cp = acc[ai][0][3][0]; *(f32x4*)(cp + 4) = acc[ai][0][3][1]; } }
    }
    asm volatile("s_waitcnt lgkmcnt(0)" ::: "memory"); __builtin_amdgcn_s_barrier(); asm volatile("" ::: "memory");
#pragma unroll
    for (int n = 0; n < 2; ++n) {
      const LAS float* cl = (const LAS float*)(lds + 131072 + 13312) + wc * 32 + 8 * fq + 4 * n;
      const f32x4 w0 = *(const LAS f32x4*)cl, w1 = *(const LAS f32x4*)(cl + 128), w2 = *(const LAS f32x4*)(cl + 256), bb = *(const LAS f32x4*)(cl + 384);
#pragma unroll
      for (int ai = 0; ai < (HALFM ? 1 : 2); ++ai) { const int gidx = 2 * ai + wr;
        f32x4 gp = {0.f, 0.f, 0.f, 0.f};
        if (fr >= 14) {
          if (sample) gp = *(const f32x4*)(st + ((size_t)(bd0 + gidx) * 2 + (fr - 14)) * DFF + col0 + 4 * n);
          else if (gidx > 0) gp = *(const LAS f32x4*)(xh + (((gidx - 1) * 4 + wc) * 2 + (fr - 14)) * 32 + fq * 8 + 4 * n);
        }
#pragma unroll
        for (int m = 0; m < 4; ++m) { const int rin = rin0 + ai * 128 + m * 16; f32x4 o, cc;
#pragma unroll
          for (int j = 0; j < 4; ++j) { const float g = acc[ai][0][m][n][j], gq = gp[j];
            const float r1g = dpp_ror1(g), r1q = dpp_ror1(gq), r2g = dpp_ror2(g), r2q = dpp_ror2(gq);
            const float p1 = fr >= 1 ? r1g : r1q, p2 = fr >= 2 ? r2g : r2q;
            const float c = __builtin_fmaf(w2[j], g, __builtin_fmaf(w1[j], p1, __builtin_fmaf(w0[j], p2, bb[j])));
            cc[j] = c; o[j] = gelu_mul(c, acc[ai][1][m][n][j]); }
          *(u32x2*)(HF + (size_t)(u.pm * (HALFM ? 128 : 256) + rin) * DFF + col0 + 4 * n) = pack4(o);
          if (cont && gidx == 0 && m == 0 && fr < 2) { *(f32x4*)(HEADC + ((size_t)u.pm * 2 + fr) * DFF + col0 + 4 * n) = cc; *(f32x4*)(HEADU + ((size_t)u.pm * 2 + fr) * DFF + col0 + 4 * n) = acc[ai][1][m][n]; }
          gp = acc[ai][0][m][n]; }
      }
    }
  }
};
typedef EpiP5FT<false> EpiP5F;
DI void p6_fixup_panel(int pm, const float* side, const float* cw, bf16_t* HF) {
  const float* TAILG = side + (size_t)(pm - 1) * 2 * DFF; const float* HEADC = side + SIDE_ROWS + (size_t)pm * 2 * DFF; const float* HEADU = side + 2 * SIDE_ROWS + (size_t)pm * 2 * DFF;
  int tid_ = threadIdx.x; asm volatile("" : "+v"(tid_));
  constexpr int NIT = (DFF + NTHREADS - 1) / NTHREADS;
  float t0[NIT], t1[NIT], a0[NIT], a1[NIT], hc0[NIT], hc1[NIT], hu0[NIT], hu1[NIT];
#pragma unroll
  for (int i = 0; i < NIT; ++i) { const int k = tid_ + i * NTHREADS; const int kk = k < DFF ? k : 0;
    t0[i] = TAILG[kk]; t1[i] = TAILG[DFF + kk]; a0[i] = cw[kk]; a1[i] = cw[DFF + kk]; hc0[i] = HEADC[kk]; hc1[i] = HEADC[DFF + kk]; hu0[i] = HEADU[kk]; hu1[i] = HEADU[DFF + kk]; }
#pragma unroll
  for (int i = 0; i < NIT; ++i) { const int k = tid_ + i * NTHREADS;
    const float c0 = hc0[i] + a0[i] * t0[i] + a1[i] * t1[i], c1 = hc1[i] + a0[i] * t1[i];
    const float h0 = gelu_mul(c0, hu0[i]), h1 = gelu_mul(c1, hu1[i]);
    f32x4 v = {h0, h1, 0.f, 0.f}; const u32x2 pk = pack4(v);
    if (k < DFF) { HF[(size_t)(pm * 256) * DFF + k] = (bf16_t)(pk[0] & 0xffffu); HF[(size_t)(pm * 256 + 1) * DFF + k] = (bf16_t)(pk[0] >> 16); } }
}

struct EpiNull {
  static constexpr bool PERM = true, HAS_MID = false, HAS_RS = false;
  DI void mid(f32x4 (&)[2][2][4][2], const Unit&, int, int, int, int, int) const {}
  DI void operator()(f32x4 (&acc)[2][2][4][2], const Unit& u, int wr, int wc, int fr, int fq) const {
#pragma unroll
    for (int ai = 0; ai < 2; ++ai)
#pragma unroll
      for (int bj = 0; bj < 2; ++bj)
#pragma unroll
        for (int m = 0; m < 4; ++m)
#pragma unroll
          for (int n = 0; n < 2; ++n) asm volatile("" :: "v"(acc[ai][bj][m][n]));
  }
};

DI float gelu_tanh(float x) {
  const float y = 0.7978845608028654f * (x + 0.044715f * x * x * x);
  const float e = fast_exp2(2.0f * LOG2E * y);
  const float th = 1.0f - 2.0f * fast_rcp(e + 1.0f);
  return 0.5f * x * (1.0f + th);
}
DI void pfinal_norm(const Params& p) {
  const bf16_t* XB = (const bf16_t*)(p.ws + WS_XB); const float* SS = (const float*)(p.ws + WS_SS);
  int tid_ = threadIdx.x; asm volatile("" : "+v"(tid_));
  const int lane = tid_ & 63, gw = blockIdx.x * 8 + (tid_ >> 6), NGW = gridDim.x * 8;
#pragma unroll 3
  for (int m = gw; m < TOK; m += NGW) { const float s = row_rs(SS, m);
#pragma unroll
    for (int j = 0; j < 2; ++j) { const u32x4 w = ((const u32x4*)(XB + (size_t)m * D))[lane + 64 * j];
      const f32x4 g0 = ((const f32x4*)p.norm_final)[2 * (lane + 64 * j)], g1 = ((const f32x4*)p.norm_final)[2 * (lane + 64 * j) + 1];
      const f32x4 a = {bflo(w[0]), bfhi(w[0]), bflo(w[1]), bfhi(w[1])}, b = {bflo(w[2]), bfhi(w[2]), bflo(w[3]), bfhi(w[3])};
      f32x4* o = (f32x4*)(p.out + (size_t)m * D) + 2 * (lane + 64 * j);
      __builtin_nontemporal_store(a * s * g0, o); __builtin_nontemporal_store(b * s * g1, o + 1); } }
}

DI pg8::GemmDesc p1_desc(unsigned char* ws, int l) {
  return pg8::GemmDesc{(const char*)(ws + WS_XB), (const char*)(ws + WS_WIN) + (size_t)l * INC * D * 2, D, D, D / 64, (size_t)256 * D * 2, (size_t)128 * D * 2};
}
DI EpiP1 p1_epi(const Params& p, int l, LAS unsigned char* lds) {
  return EpiP1{(const float*)(p.ws + WS_SS), (bf16_t*)(p.ws + WS_QKV), (bf16_t*)(p.ws + WS_GATE), p.b_gate + (size_t)l * 3 * D, p.out, l, 0, lds};
}
namespace attn {
constexpr int N_CPY = 64, N_CS = 128, N_CP = 512, N_AP = 512, N_BP = 512, N_AS = 256, N_BS = 256, NITEMS = N_CPY + N_CS + N_CP + N_AP + N_BP + N_AS + N_BS;
constexpr float STICK_DONE = 8.75651e-27f;

struct Item { int mode, h, tok0, past, q0, nqv, pflags; const float* cK; const float* cV; };

DI Item decode(const Params& p, int layer, int idx) {
  Item it; it.cK = nullptr; it.cV = nullptr; it.past = 0; it.pflags = 0;
  if (idx < N_CPY) { it.mode = 3; it.h = idx; return it; }
  idx -= N_CPY;
  if (idx < N_CS) { const int bd = idx >> 2, h = idx & 3; it.mode = 2; it.h = h; it.tok0 = TOKP + bd * 64; it.past = PAST; it.q0 = PAST; it.nqv = 64;
    it.cK = p.cache_c_k + (size_t)(layer * DB + bd) * PAST * 512 + h * 128; it.cV = p.cache_c_v + (size_t)(layer * DB + bd) * PAST * 512 + h * 128; return it; }
  idx -= N_CS;
  if (idx < N_CP) { const int jj = 31 - (idx >> 4), rem = idx & 15; it.mode = 2; it.h = rem & 3; it.tok0 = (rem >> 2) * SEQ; it.q0 = jj * 128; it.nqv = 128; return it; }
  idx -= N_CP;
  if (idx < N_AP + N_BP) { const int isb = idx >= N_AP; if (isb) idx -= N_AP; const int qt = 15 - (idx >> 5), rem = idx & 31; it.mode = isb; it.h = rem & 7; it.tok0 = (rem >> 3) * SEQ; it.q0 = qt * 256; it.nqv = 256; return it; }
  idx -= N_AP + N_BP;
  if (idx < N_AS) { const int bd = idx >> 3, h = idx & 7; it.mode = 0; it.h = h; it.tok0 = TOKP + bd * 64; it.past = ALEN; it.q0 = ALEN; it.nqv = 64;
    it.cK = p.cache_a_k + (size_t)(layer * DB + bd) * ALEN * 512 + h * 64; it.cV = p.cache_a_v + (size_t)(layer * DB + bd) * ALEN * 512 + h * 64; return it; }
  idx -= N_AS;
  { const int bd = idx >> 3, h = idx & 7; it.mode = 1; it.h = h; it.tok0 = TOKP + bd * 64; it.past = PAST; it.q0 = PAST; it.nqv = 64;
    it.cK = p.cache_b_k + (size_t)(layer * DB + bd) * PAST * 512 + h * 64; it.cV = p.cache_b_v + (size_t)(layer * DB + bd) * PAST * 512 + h * 64; return it; }
}


template <int MODE, bool SAMPLE>
DI void load_piece(u32x4& r0, u32x4& r1, u32x4& r2, u32x4& r3, const Item& it, const float* cache, const bf16_t* QKV, int col, int kt, int tid) {
  constexpr int CPR = MODE == 2 ? 16 : 8;
  const int j0 = kt * 64;
  const int ra = tid / CPR, ca = tid % CPR;
  if (SAMPLE && j0 < it.past) {
    const unsigned lo = (unsigned)(ra * 512 + ca * 8) * 4u; const char* b = (const char*)(cache + (size_t)j0 * 512);
    { const u32x4* q = (const u32x4*)(b + lo); r0 = __builtin_nontemporal_load(q); r1 = __builtin_nontemporal_load(q + 1); }
    if constexpr (MODE == 2) { const u32x4* q = (const u32x4*)(b + (size_t)32 * 512 * 4 + lo); r2 = __builtin_nontemporal_load(q); r3 = __builtin_nontemporal_load(q + 1); }
  } else {
    const unsigned lo = (unsigned)(ra * QKVW + ca * 8) * 2u; const char* b = (const char*)(QKV + (size_t)(it.tok0 + j0 - it.past) * QKVW + col);
    r0 = *(const u32x4*)(b + lo);
    if constexpr (MODE == 2) r2 = *(const u32x4*)(b + (size_t)32 * QKVW * 2 + lo);
  }
}
DI u32x4 cvt8(u32x4 a, u32x4 b) { return pack8(__builtin_bit_cast(f32x4, a), __builtin_bit_cast(f32x4, b)); }
template <int MODE, bool ISK, bool SAMPLE>
DI void write_piece(const u32x4& r0, const u32x4& r1, const u32x4& r2, const u32x4& r3, const Item& it, LAS unsigned char* buf, int kt, int tid) {
  constexpr int CPR = MODE == 2 ? 16 : 8, VS = MODE == 2 ? 320 : 192;
  const bool f32src = SAMPLE && kt * 64 < it.past;
  const int ra = tid / CPR, ca = tid % CPR, rb = (tid + NTHREADS) / CPR, cb = (tid + NTHREADS) % CPR;
  { const u32x4 x = f32src ? cvt8(r0, r1) : r0;
    if (ISK) *(LAS u32x4*)(buf + ((MODE == 2 && ca >= 8) ? 8192 : 0) + ra * 128 + (((ca & 7) ^ ((ra >> 1) & 7)) << 4)) = x;
    else *(LAS u32x4*)(buf + ra * VS + ca * 16) = x; }
  if constexpr (MODE == 2) { const u32x4 x = f32src ? cvt8(r2, r3) : r2;
    if (ISK) *(LAS u32x4*)(buf + (cb >= 8 ? 8192 : 0) + rb * 128 + (((cb & 7) ^ ((rb >> 1) & 7)) << 4)) = x;
    else *(LAS u32x4*)(buf + rb * VS + cb * 16) = x; }
}

template <int MODE>
DI void state_store(const u32x4& r0, const u32x4& r2, float* dst, int tid) {
  constexpr int CPR = MODE == 2 ? 16 : 8;
  const int ra = tid / CPR, ca = tid % CPR, rb = (tid + NTHREADS) / CPR, cb = (tid + NTHREADS) % CPR;
  { float* q = dst + (size_t)ra * 512 + ca * 8;
    __builtin_nontemporal_store((f32x4){bflo(r0[0]), bfhi(r0[0]), bflo(r0[1]), bfhi(r0[1])}, (f32x4*)q); __builtin_nontemporal_store((f32x4){bflo(r0[2]), bfhi(r0[2]), bflo(r0[3]), bfhi(r0[3])}, (f32x4*)(q + 4)); }
  if constexpr (MODE == 2) { float* q = dst + (size_t)rb * 512 + cb * 8;
    __builtin_nontemporal_store((f32x4){bflo(r2[0]), bfhi(r2[0]), bflo(r2[1]), bfhi(r2[1])}, (f32x4*)q); __builtin_nontemporal_store((f32x4){bflo(r2[2]), bfhi(r2[2]), bflo(r2[3]), bfhi(r2[3])}, (f32x4*)(q + 4)); }
}
template <int MODE>
DI float* state_dst(const Params& p, int layer, const Item& it, int kt, int isv) {
  const int hoff = MODE == 2 ? it.h * 128 : it.h * 64;
  if (it.past == 0) {
    const int t0 = kt * 64; if (t0 < it.q0 || t0 >= it.q0 + it.nqv) return nullptr;
    const int b = it.tok0 / SEQ;
    if (MODE == 0) { if (t0 < SEQ - 512) return nullptr; return p.out + (isv ? O_PAV : O_PAK) + ((size_t)(layer * 4 + b) * 512 + (t0 - (SEQ - 512))) * 512 + hoff; }
    return p.out + (MODE == 1 ? (isv ? O_PBV : O_PBK) : (isv ? O_PCV : O_PCK)) + ((size_t)(layer * 4 + b) * SEQ + t0) * 512 + hoff;
  } else {
    if (kt * 64 != it.past) return nullptr;
    const int bd = (it.tok0 - TOKP) / 64;
    if (MODE == 0) return p.out + (isv ? O_SAV : O_SAK) + ((size_t)(layer * DB + bd) * 512 + 448) * 512 + hoff;
    return p.out + (MODE == 1 ? (isv ? O_SBV : O_SBK) : (isv ? O_SCV : O_SCK)) + ((size_t)(layer * DB + bd) * 64) * 512 + hoff;
  }
}

DI bf16x8 pack_p(const f32x16& x, int s) {
  const f32x4 a = {x[8 * s], x[8 * s + 1], x[8 * s + 2], x[8 * s + 3]}, b = {x[8 * s + 4], x[8 * s + 5], x[8 * s + 6], x[8 * s + 7]};
  return __builtin_bit_cast(bf16x8, pack8(a, b));
}
#define MFMA32(a, b, c) __builtin_amdgcn_mfma_f32_32x32x16_bf16((a), (b), (c), 0, 0, 0)

constexpr int L_KB = 0, KB_BYTES = 16384, L_VB = 32768, VB_BYTES = 20480, L_LUT = 73728, L_FLAGS = 75776, L_XCH = 81920;

template <int MODE, bool SAMPLE>
DI void run_item(const Params& p, int layer, const Item& it, LAS unsigned char* lds_in) {
  LAS unsigned char* lds = opaque_lds(lds_in);
  constexpr int NDV = MODE == 2 ? 4 : 2, VS = MODE == 2 ? 320 : 192;
  int tid_ = threadIdx.x; asm volatile("" : "+v"(tid_));
  const int tid = tid_, lane = tid & 63, wave = __builtin_amdgcn_readfirstlane(tid >> 6);
  const int qi = lane & 31, h2 = lane >> 5;
  const int mp = MODE == 2 ? (wave >> 2) : 0, wrow = MODE == 2 ? (wave & 3) : wave;
  const int q0w = it.q0 + 32 * wrow;
  const bool active = 32 * wrow < it.nqv;
  const bf16_t* QKV = (const bf16_t*)(p.ws + WS_QKV);
  const int hb = MODE == 2 ? it.h * 128 : it.h * 64;
  const int qcol = (MODE == 0 ? 0 : MODE == 1 ? 1536 : 3072) + hb + 64 * mp, kcol = (MODE == 0 ? 512 : MODE == 1 ? 2048 : 3584) + hb, vcol = (MODE == 0 ? 1024 : MODE == 1 ? 2560 : 4096) + hb;
  const int cw = q0w >> 6;
  int kt_first, step, NT;
  if (MODE == 0) { kt_first = (it.q0 >> 6) - 8; if (kt_first < 0) kt_first = 0; step = 1; NT = ((it.q0 + it.nqv - 1) >> 6) - kt_first + 1; }
  else if (MODE == 2) { kt_first = 0; step = 1; NT = ((it.q0 + it.nqv - 1) >> 6) + 1; }
  else { kt_first = (it.q0 + it.nqv - 2) >> 6; step = -1; NT = kt_first + 1; }
  const bool wr_state = it.pflags == 0;
  u32x4 k0 = {}, k1 = {}, k2 = {}, k3 = {}, v0 = {}, v1 = {}, v2 = {}, v3 = {};
  load_piece<MODE, SAMPLE>(k0, k1, k2, k3, it, it.cK, QKV, kcol, kt_first, tid);
  load_piece<MODE, SAMPLE>(v0, v1, v2, v3, it, it.cV, QKV, vcol, kt_first, tid);
  LAS float* lut = (LAS float*)(lds + L_LUT);
  LAS unsigned* flags = (LAS unsigned*)(lds + L_FLAGS);
  if (MODE == 0) { const float bfar = p.a_rel_bias[((size_t)layer * 257 + 256) * 8 + it.h]; for (int i = tid; i < 257; i += NTHREADS) lut[i] = p.a_rel_bias[((size_t)layer * 257 + i) * 8 + it.h] - bfar; }
  if (MODE == 2) { if (tid < 192) lut[tid] = ((const float*)(p.ws + WS_CTL))[CW_T5 + it.h * 192 + tid]; }
  bf16x8 qf[4];
  if (active) { const bf16_t* qp = QKV + (size_t)(it.tok0 + q0w + qi - it.past) * QKVW + qcol + 8 * h2;
#pragma unroll
    for (int s = 0; s < 4; ++s) { const u32x4 w = *(const u32x4*)(qp + 16 * s);
      const f32x4 a = {bflo(w[0]) * 0.125f, bfhi(w[0]) * 0.125f, bflo(w[1]) * 0.125f, bfhi(w[1]) * 0.125f}, b = {bflo(w[2]) * 0.125f, bfhi(w[2]) * 0.125f, bflo(w[3]) * 0.125f, bfhi(w[3]) * 0.125f};
      qf[s] = __builtin_bit_cast(bf16x8, pack8(a, b)); } }
  f32x16 O[NDV];
#pragma unroll
  for (int b = 0; b < NDV; ++b)
#pragma unroll
    for (int i = 0; i < 16; ++i) O[b][i] = 0.f;
  float m_run = -1e30f, l_run = 0.f, R2 = 1.0f; bool done = false, have_p = false;
  bf16x8 pf[4];
#pragma unroll
  for (int s = 0; s < 4; ++s) pf[s] = (bf16x8){0, 0, 0, 0, 0, 0, 0, 0};
  const int krow_off = qi * 128, kswz = (qi >> 1) & 7;
  const int g16 = lane >> 4, trq = (lane & 15) >> 2, trp = lane & 3;
  const int vtr_off = (4 * (g16 >> 1) + trq) * VS + (16 * (g16 & 1) + 4 * trp) * 2;

  write_piece<MODE, true, SAMPLE>(k0, k1, k2, k3, it, lds + L_KB, kt_first, tid);
  if (wr_state) { float* d = state_dst<MODE>(p, layer, it, kt_first, 0); if (d) state_store<MODE>(k0, k2, d, tid); }
  if (NT > 1) load_piece<MODE, SAMPLE>(k0, k1, k2, k3, it, it.cK, QKV, kcol, kt_first + step, tid);
  for (int t = 0;; ++t) {
    __syncthreads();
    if (MODE == 1 && t > 0 && t < NT) { const unsigned any = flags[0] | flags[1] | flags[2] | flags[3] | flags[4] | flags[5] | flags[6] | flags[7]; if (!any) NT = t; }
    const int kt = kt_first + step * t;
    bool mine = false;
    if (t < NT && !(it.pflags & 2)) {
      if (MODE == 0) mine = active && kt >= cw - 8 && kt <= cw;
      else if (MODE == 2) mine = active && kt <= cw;
      else mine = active && !done && kt * 64 <= q0w + 30;
    }
    LAS unsigned char* vb = lds + L_VB + ((t - 1) & 1) * VB_BYTES + vtr_off;
    LAS unsigned char* kb = lds + L_KB + (t & 1) * KB_BYTES + ((MODE == 2 && mp) ? 8192 : 0);
    constexpr int HB = NDV / 2, NST = 4 * HB;
    bf16x8 kfa[4], vfa[2], vfb[2];
    const bool do_pv = have_p && !(it.pflags & 8);
#define V_LOAD(dst, j_) do { if (do_pv) { _Pragma("unroll") for (int bb = 0; bb < 2; ++bb) { const int a0 = 16 * ((j_) / HB) * VS + 64 * (2 * ((j_) % HB) + bb); \
      const s16x4 lo = __builtin_amdgcn_ds_read_tr16_b64_v4i16((LAS s16x4*)(vb + a0)), hi = __builtin_amdgcn_ds_read_tr16_b64_v4i16((LAS s16x4*)(vb + a0 + 8 * VS)); \
      dst[bb] = __builtin_shufflevector(lo, hi, 0, 1, 2, 3, 4, 5, 6, 7); } } } while (0)
#define V_MMA(src, j_) do { if (do_pv) { _Pragma("unroll") for (int bb = 0; bb < 2; ++bb) O[2 * ((j_) % HB) + bb] = MFMA32(src[bb], pf[(j_) / HB], O[2 * ((j_) % HB) + bb]); } } while (0)
#define STG(j_, cur, nxt) do { if (SAMPLE) { V_LOAD(cur, j_); V_MMA(cur, j_); } else { if ((j_) + 1 < NST) V_LOAD(nxt, (j_) + 1); V_MMA(cur, j_); } } while (0)
    if (!SAMPLE) {
      if (mine) {
#pragma unroll
        for (int s = 0; s < 4; ++s) kfa[s] = *(const LAS bf16x8*)(kb + krow_off + (((2 * s + h2) ^ kswz) << 4)); }
      V_LOAD(vfa, 0);
      __builtin_amdgcn_sched_barrier(0);
    }
    if (t < NT && !(it.pflags & 1)) { write_piece<MODE, false, SAMPLE>(v0, v1, v2, v3, it, lds + L_VB + (t & 1) * VB_BYTES, kt_first + step * t, tid);
      if (wr_state) { float* d = state_dst<MODE>(p, layer, it, kt_first + step * t, 1); if (d) state_store<MODE>(v0, v2, d, tid); }
      if (t + 1 < NT) { write_piece<MODE, true, SAMPLE>(k0, k1, k2, k3, it, lds + L_KB + ((t + 1) & 1) * KB_BYTES, kt_first + step * (t + 1), tid);
        if (wr_state) { float* d = state_dst<MODE>(p, layer, it, kt_first + step * (t + 1), 0); if (d) state_store<MODE>(k0, k2, d, tid); }
        load_piece<MODE, SAMPLE>(v0, v1, v2, v3, it, it.cV, QKV, vcol, kt_first + step * (t + 1), tid);
        if (t + 2 < NT) load_piece<MODE, SAMPLE>(k0, k1, k2, k3, it, it.cK, QKV, kcol, kt_first + step * (t + 2), tid); } }
    __builtin_amdgcn_sched_barrier(0);
    f32x16 sA, sB;
#pragma unroll
    for (int i = 0; i < 16; ++i) { sA[i] = 0.f; sB[i] = 0.f; }
    if (mine) {
      bf16x8 kfc[4];
      if (SAMPLE) {
#pragma unroll
        for (int s = 0; s < 4; ++s) kfa[s] = *(const LAS bf16x8*)(kb + krow_off + (((2 * s + h2) ^ kswz) << 4)); }
#pragma unroll
      for (int s = 0; s < 4; ++s) kfc[s] = *(const LAS bf16x8*)(kb + 4096 + krow_off + (((2 * s + h2) ^ kswz) << 4));
#pragma unroll
      for (int s = 0; s < 4; ++s) sA = MFMA32(kfa[s], qf[s], sA);
#pragma unroll
      for (int s = 0; s < 4; ++s) sB = MFMA32(kfc[s], qf[s], sB);
    }
    const int kbase = kt * 64 + 4 * h2;
    if (MODE != 1) {
      float mx = -1e30f, alpha = 1.0f, lsa = 0.f, lsb = 0.f; bool resc = false;
      const bool smx = mine && !(it.pflags & 4);
      STG(0, vfa, vfb);
      if (NST == 8) STG(1, vfb, vfa);
      if (smx) {
        bool cst;
        if (MODE == 0) cst = q0w - (kt * 64 + 63) >= 128; else cst = kt * 64 + 63 - q0w <= -127;
        if (!cst) {
#pragma unroll
          for (int i = 0; i < 16; ++i) { const int ko = (i & 3) + 8 * (i >> 2);
            int ia, ib;
            if (MODE == 0) { const int d = (q0w + qi) - (kbase + ko); ia = d; ib = d - 32; ia = (ia < -128 ? -128 : ia > 128 ? 128 : ia) + 128; ib = (ib < -128 ? -128 : ib > 128 ? 128 : ib) + 128; }
            else { const int d = (kbase + ko) - (q0w + qi); ia = d; ib = d + 32; ia = (ia < -127 ? -127 : ia > 63 ? 63 : ia) + 127; ib = (ib < -127 ? -127 : ib > 63 ? 63 : ib) + 127; }
            sA[i] += lut[ia]; sB[i] += lut[ib]; }
        }
        float m0 = fmaxf(fmaxf(sA[0], sA[1]), sA[2]), m1 = fmaxf(fmaxf(sB[0], sB[1]), sB[2]);
#pragma unroll
        for (int i = 3; i < 15; i += 2) { m0 = fmaxf(fmaxf(m0, sA[i]), sA[i + 1]); m1 = fmaxf(fmaxf(m1, sB[i]), sB[i + 1]); }
        mx = fmaxf(fmaxf(m0, m1), fmaxf(sA[15], sB[15]));
      }
      __builtin_amdgcn_sched_barrier(0);
      if (NST == 8) { STG(2, vfa, vfb); STG(3, vfb, vfa); } else STG(1, vfb, vfa);
      if (smx) {
        mx = fmaxf(mx, __shfl_xor(mx, 32)) * LOG2E;
        resc = !__all(mx <= m_run + 8.0f);
        if (resc) { const float mnew = fmaxf(m_run, mx); alpha = fast_exp2(m_run - mnew); m_run = mnew; l_run *= alpha; }
#pragma unroll
        for (int i = 0; i < 16; ++i) { sA[i] = fast_exp2(__builtin_fmaf(sA[i], LOG2E, -m_run)); lsa += sA[i]; }
      }
      __builtin_amdgcn_sched_barrier(0);
      if (NST == 8) { STG(4, vfa, vfb); STG(5, vfb, vfa); } else STG(2, vfa, vfb);
      if (smx) {
#pragma unroll
        for (int i = 0; i < 16; ++i) { sB[i] = fast_exp2(__builtin_fmaf(sB[i], LOG2E, -m_run)); lsb += sB[i]; }
        l_run += lsa + lsb;
      }
      __builtin_amdgcn_sched_barrier(0);
      if (NST == 8) { STG(6, vfa, vfb); STG(7, vfb, vfa); } else STG(3, vfb, vfa);
      __builtin_amdgcn_sched_barrier(0);
      if (mine) {
        if (resc) {
#pragma unroll
        for (int b = 0; b < NDV; ++b)
#pragma unroll
          for (int i = 0; i < 16; ++i) O[b][i] *= alpha;
        }
        pf[0] = pack_p(sA, 0); pf[1] = pack_p(sA, 1); pf[2] = pack_p(sB, 0); pf[3] = pack_p(sB, 1);
      }
    } else {
      STG(0, vfa, vfb); STG(1, vfb, vfa); STG(2, vfa, vfb); STG(3, vfb, vfa);
      if (mine) {
        const bool diag = kt * 64 + 63 >= q0w;
        float kpA[16], kpB[16];
#pragma unroll
        for (int i = 0; i < 16; ++i) { const int ko = (i & 3) + 8 * (i >> 2);
          { const float r = fast_rcp(1.0f + fast_exp2(sA[i] * LOG2E)); const bool ok = !diag || (kbase + ko) < (q0w + qi); kpA[i] = ok ? r : 1.0f; sA[i] = ok ? 1.0f - r : 0.0f; }
          { const float r = fast_rcp(1.0f + fast_exp2(sB[i] * LOG2E)); const bool ok = !diag || (kbase + 32 + ko) < (q0w + qi); kpB[i] = ok ? r : 1.0f; sB[i] = ok ? 1.0f - r : 0.0f; } }
        float gs[8], pg[8];
#pragma unroll
        for (int g = 0; g < 4; ++g) { gs[g] = (kpA[4 * g] * kpA[4 * g + 1]) * (kpA[4 * g + 2] * kpA[4 * g + 3]); gs[4 + g] = (kpB[4 * g] * kpB[4 * g + 1]) * (kpB[4 * g + 2] * kpB[4 * g + 3]); }
#pragma unroll
        for (int g = 0; g < 8; ++g) pg[g] = __shfl_xor(gs[g], 32);
        float suf = R2;
#pragma unroll
        for (int g = 7; g >= 0; --g) { const float off = suf * (h2 == 0 ? pg[g] : 1.0f);
          if (g >= 4) { const int b = 4 * (g - 4); const float a3 = off, a2 = a3 * kpB[b + 3], a1 = a2 * kpB[b + 2], a0 = a1 * kpB[b + 1];
            sB[b + 3] *= a3; sB[b + 2] *= a2; sB[b + 1] *= a1; sB[b] *= a0; }
          else { const int b = 4 * g; const float a3 = off, a2 = a3 * kpA[b + 3], a1 = a2 * kpA[b + 2], a0 = a1 * kpA[b + 1];
            sA[b + 3] *= a3; sA[b + 2] *= a2; sA[b + 1] *= a1; sA[b] *= a0; }
          suf *= gs[g] * pg[g]; }
        R2 = suf;
        done = __all(R2 < STICK_DONE) != 0;
        pf[0] = pack_p(sA, 0); pf[1] = pack_p(sA, 1); pf[2] = pack_p(sB, 0); pf[3] = pack_p(sB, 1);
      }
    }
#undef V_LOAD
#undef V_MMA
#undef STG
    have_p = mine;
    if (MODE == 1 && t < NT) { if (lane == 0) flags[wave] = (active && !done && kt > 0 && (kt - 1) * 64 <= q0w + 30) ? 1u : 0u; }
    if (t >= NT) break;
  }
  int lane_e = lane; asm volatile("" : "+v"(lane_e));
  const int qi_e = lane_e & 31, h2_e = lane_e >> 5;
  bf16_t* Ob = (bf16_t*)(p.ws + WS_O);
  const int ocol = MODE == 0 ? hb : MODE == 1 ? 512 + hb : 1024 + hb;
  const bool wr_out = it.pflags == 0;
  if (MODE != 2) {
    if (active && wr_out) { float sc = 1.f; if (MODE == 0) { const float lt = l_run + __shfl_xor(l_run, 32); sc = fast_rcp(lt); }
      bf16_t* op = Ob + (size_t)(it.tok0 + q0w + qi_e - it.past) * OW + ocol + 4 * h2_e;
#pragma unroll
      for (int b = 0; b < NDV; ++b)
#pragma unroll
        for (int g = 0; g < 4; ++g) { const f32x4 v = {O[b][4 * g] * sc, O[b][4 * g + 1] * sc, O[b][4 * g + 2] * sc, O[b][4 * g + 3] * sc}; *(u32x2*)(op + 32 * b + 8 * g) = pack4(v); } }
    __syncthreads();
  } else {
    const float lam = ((const float*)(p.ws + WS_CTL))[CW_LAM + layer];
    const float sub_scale = 1.0f - (0.8f - 0.6f * expf(-0.3f * (float)layer));
    LAS float* xch = (LAS float*)(lds + L_XCH);
    if (active && mp == 1) { const float lt = l_run + __shfl_xor(l_run, 32), sc = lam * fast_rcp(lt);
#pragma unroll
      for (int b = 0; b < NDV; ++b)
#pragma unroll
        for (int i = 0; i < 16; ++i) xch[((wave & 3) * 64 + b * 16 + i) * 64 + lane_e] = O[b][i] * sc; }
    __syncthreads();
    if (active && mp == 0 && wr_out) { const float lt = l_run + __shfl_xor(l_run, 32), sc = fast_rcp(lt); float q = 0.f;
#pragma unroll
      for (int b = 0; b < NDV; ++b)
#pragma unroll
        for (int i = 0; i < 16; ++i) { const float o = O[b][i] * sc - xch[((wave & 3) * 64 + b * 16 + i) * 64 + lane_e]; O[b][i] = o; q += o * o; if ((i & 7) == 7) __builtin_amdgcn_sched_barrier(0); }
      q += __shfl_xor(q, 32);
      const float rstd = __builtin_amdgcn_rsqf(q * (1.0f / 128.0f) + EPS) * sub_scale;
      const float* gain = p.c_subln + layer * 128 + 4 * h2_e;
      bf16_t* op = Ob + (size_t)(it.tok0 + q0w + qi_e - it.past) * OW + ocol + 4 * h2_e;
#pragma unroll
      for (int b = 0; b < NDV; ++b)
#pragma unroll
        for (int g = 0; g < 4; ++g) { const f32x4 gn = *(const f32x4*)(gain + 32 * b + 8 * g);
          const f32x4 v = {O[b][4 * g] * rstd * gn[0], O[b][4 * g + 1] * rstd * gn[1], O[b][4 * g + 2] * rstd * gn[2], O[b][4 * g + 3] * rstd * gn[3]}; *(u32x2*)(op + 32 * b + 8 * g) = pack4(v); } }
    __syncthreads();
  }
}

DI void copy_item(const Params& p, int layer, int idx) {
  const int which = idx >> 5, bd = idx & 31;
  const size_t lb = (size_t)layer * DB + bd;
  const f32x4* src = (const f32x4*)((which ? p.cache_a_v : p.cache_a_k) + lb * 512 * 512 + 64 * 512);
  f32x4* dst = (f32x4*)(p.out + (which ? O_SAV : O_SAK) + lb * 512 * 512);
  int tid_ = threadIdx.x; asm volatile("" : "+v"(tid_));
#pragma unroll 4
  for (int i = tid_; i < 448 * 128; i += NTHREADS) __builtin_nontemporal_store(__builtin_nontemporal_load(src + i), dst + i);
}
#ifndef PROBE_ATT_FLAGS
#define PROBE_ATT_FLAGS 0
#endif
#ifndef PROBE_ATT_LO
#define PROBE_ATT_LO 0
#define PROBE_ATT_HI NITEMS
#endif
DI void attn_phase(const Params& p, int qidx, LAS unsigned char* lds) {
  const int layer = qidx & 1; const int i_lo = qidx >= 2 ? PROBE_ATT_LO : 0, i_hi = qidx >= 2 ? PROBE_ATT_HI : NITEMS;
  unsigned* head = (unsigned*)(p.ws + WS_CTL) + CW_QUEUE + 64 * qidx;
  LAS unsigned* slot = (LAS unsigned*)(lds + LDS_BYTES - 48);
  if (threadIdx.x == 0) slot[0] = atomicAdd(head, 1u);
  for (int k = 0;; ++k) {
    __syncthreads();
    const int idx = __builtin_amdgcn_readfirstlane((int)slot[k & 1]) + i_lo;
    if (threadIdx.x == 0) slot[(k + 1) & 1] = atomicAdd(head, 1u);
    if (idx >= i_hi) break;
    Item it = decode(p, layer, idx); it.pflags = qidx >= 2 ? PROBE_ATT_FLAGS : 0;
    if (it.mode == 3) { if (qidx < 2) copy_item(p, layer, it.h); continue; }
    if (it.past == 0) { if (it.mode == 0) run_item<0, false>(p, layer, it, lds); else if (it.mode == 1) run_item<1, false>(p, layer, it, lds); else run_item<2, false>(p, layer, it, lds); }
    else { if (it.mode == 0) run_item<0, true>(p, layer, it, lds); else if (it.mode == 1) run_item<1, true>(p, layer, it, lds); else run_item<2, true>(p, layer, it, lds); }
  }
}
}
#define XB_TMO      128
#define XB_XCNT(j)  (256  + 64 * (j))
#define XB_XSUB(j)  (1280 + 64 * (j))
#define XB_XGEN(j)  (2304 + 64 * (j))
#define XB_TOP      3328
#define XB_TOPGEN   3392
#define XCD_BAR_WORDS 3456
#define XB_SPIN_CAP (1u << 18)
DI unsigned xb_ld(unsigned* p)              { return __hip_atomic_load(p, __ATOMIC_RELAXED, __HIP_MEMORY_SCOPE_AGENT); }
DI unsigned xb_add(unsigned* p, unsigned v) { return __hip_atomic_fetch_add(p, v, __ATOMIC_RELAXED, __HIP_MEMORY_SCOPE_AGENT); }
DI unsigned xb_xcc_id() { return (unsigned)__builtin_amdgcn_s_getreg((3 << 11) | 20) & 0xFu; }
#define XB_SPIN(cond, bar) do { unsigned _sp = 0; while (cond) { __builtin_amdgcn_s_sleep(1); \
    if ((++_sp & 255u) == 0u) { if (xb_ld(&(bar)[XB_TMO])) break; if (_sp > XB_SPIN_CAP) { atomicAdd(&(bar)[XB_TMO], 1u); break; } } } } while (0)
struct XcdBarrier { unsigned* bar; unsigned x; volatile LAS unsigned* st; };
DI XcdBarrier xcd_barrier_post(unsigned* bar, volatile LAS unsigned* st) {
  XcdBarrier b; b.bar = bar; b.x = xb_xcc_id(); b.st = st;
  if (threadIdx.x == 0) (void)xb_add(&bar[XB_XCNT(b.x)], 1u);
  return b;
}
DI void xcd_barrier_complete(unsigned* bar, unsigned x, unsigned& nloc, unsigned& nx) {
  const unsigned G = gridDim.x * gridDim.y * gridDim.z;
  unsigned sum, cnt, mine, sp = 0u;
  for (;;) {
    sum = 0u; cnt = 0u; mine = 0u;
#pragma unroll
    for (unsigned j = 0; j < 16; ++j) { const unsigned c = xb_ld(&bar[XB_XCNT(j)]); sum += c; cnt += (c > 0u) ? 1u : 0u; mine = (j == x) ? c : mine; }
    if (sum == G) break;
    __builtin_amdgcn_s_sleep(1);
    if ((++sp & 255u) == 0u) { if (xb_ld(&bar[XB_TMO])) break; if (sp > XB_SPIN_CAP) { atomicAdd(&bar[XB_TMO], 1u); break; } }
  }
  nloc = mine > 0u ? mine : 1u; nx = cnt > 0u ? cnt : 1u;
}
DI void xcd_barrier(const XcdBarrier& b) {
  asm volatile("s_waitcnt vmcnt(0)" ::: "memory");
  __syncthreads();
  if (threadIdx.x == 0) {
    unsigned* bar = b.bar;
    __builtin_amdgcn_s_waitcnt(0);
    unsigned nloc = b.st[0], nx = b.st[1];
    if (nloc == 0u) { xcd_barrier_complete(bar, b.x, nloc, nx); b.st[0] = nloc; b.st[1] = nx; }
    const unsigned old = xb_add(&bar[XB_XSUB(b.x)], 1u);
    const unsigned gen = old / nloc;
    if (old + 1u == (gen + 1u) * nloc) {
      __builtin_amdgcn_fence(__ATOMIC_RELEASE, "agent");
      asm volatile("s_waitcnt vmcnt(0)" ::: "memory");
      const unsigned og = xb_add(&bar[XB_TOP], 1u);
      const unsigned tg = og / nx;
      if (og + 1u == (tg + 1u) * nx) xb_add(&bar[XB_TOPGEN], 1u);
      else XB_SPIN(xb_ld(&bar[XB_TOPGEN]) == tg, bar);
      __builtin_amdgcn_fence(__ATOMIC_ACQUIRE, "agent");
      xb_add(&bar[XB_XGEN(b.x)], 1u);
      asm volatile("s_waitcnt vmcnt(0)" ::: "memory");
    } else {
      XB_SPIN(xb_ld(&bar[XB_XGEN(b.x)]) == gen, bar);
      __builtin_amdgcn_fence(__ATOMIC_ACQUIRE, "agent");
      asm volatile("s_waitcnt vmcnt(0)" ::: "memory");
    }
  }
  __syncthreads();
}
constexpr int L_BARST = LDS_BYTES - 64;

#ifndef PROBE_P1_FLAGS
#define PROBE_P1_FLAGS 0
#endif
#ifndef PROBE_NULL_EPI
#define PROBE_NULL_EPI 0
#endif
#ifndef PROBE_MASK
#define PROBE_MASK 0
#endif
#define REPEAT(k) for (int rep_ = 0; rep_ < (((PROBE_MASK >> (k)) & 1) ? 2 : 1); ++rep_)
constexpr int NPHASE = 2 + 6 * NLAYER;
__global__ void __launch_bounds__(NTHREADS, 2) fwd_megakernel(Params p_k) {
  extern __shared__ __attribute__((aligned(16))) unsigned char lds_raw[];
  LAS unsigned char* lds = (LAS unsigned char*)lds_raw;
  cg::grid_group grid = cg::this_grid();
  const int lo = p_k.ph_lo, hi = p_k.ph_hi;
#define IN(k) (lo <= (k) && (k) < hi)
#define SEAM(k) do { if (IN(k) && IN((k) + 1)) xcd_barrier(bar); } while (0)
  const int G = gridDim.x, c = blockIdx.x;
  if (threadIdx.x < 2) ((LAS unsigned*)(lds + L_BARST))[threadIdx.x] = 0u;
  XcdBarrier bar; bar.bar = (unsigned*)(p_k.ws + WS_CTL) + CW_BAR; bar.x = 0; bar.st = (volatile LAS unsigned*)(lds + L_BARST);
  if (p_k.ph_lo < 0) grid.sync();
  bar = xcd_barrier_post((unsigned*)(p_k.ws + WS_CTL) + CW_BAR, (volatile LAS unsigned*)(lds + L_BARST));
  if (IN(0)) { p0_prologue(p_k, lds); if ((PROBE_MASK >> 6) & 1) { __syncthreads(); p0_prologue(p_k, lds); } }
  SEAM(0);
  for (int l = 0; l < NLAYER; ++l) {
    const int pb = 1 + 6 * l;
    const Params& p = p_k; unsigned char* ws = p.ws;
    if (IN(pb + 0)) REPEAT(0) {
      pg8::GemmDesc g{(const char*)(ws + WS_XB), (const char*)(ws + WS_WIN) + (size_t)l * INC * D * 2, D, D, D / 64, (size_t)256 * D * 2, (size_t)128 * D * 2};
      pg8::P1Order S; S.R1.init(TOK / 256, pg8::P1_NN, G, c);
      EpiP1 E{(const float*)(ws + WS_SS), (bf16_t*)(ws + WS_QKV), (bf16_t*)(ws + WS_GATE), p.b_gate + (size_t)l * 3 * D, p.out, l, rep_ == 1 ? PROBE_P1_FLAGS : 0, lds};
#if PROBE_NULL_EPI
      if (rep_ == 1) { EpiNull EN; pg8::gemm_phase<EpiNull, false, false, pg8::P1Order>(lds, g, S, EN); } else
#endif
      pg8::gemm_phase<EpiP1, false, false, pg8::P1Order>(lds, g, S, E);
    }
    SEAM(pb + 0);
    if (IN(pb + 1)) REPEAT(1) {
      for (int j = G - 1 - c; j < pg8::P1_DEFER; j += G) { pg8::OneUnit S1; S1.u = pg8::p1_deferred_unit(j);
        pg8::gemm_phase<EpiP1, false, false, pg8::OneUnit>(lds, p1_desc(ws, l), S1, p1_epi(p, l, lds)); }
      attn::attn_phase(p, l + 2 * rep_, lds); }
    SEAM(pb + 1);
    if (IN(pb + 2)) REPEAT(2) {
      pg8::GemmDesc g{(const char*)(ws + WS_O), (const char*)(ws + WS_WBR) + (size_t)l * D * OW * 2, OW, OW, OW / 64, (size_t)256 * OW * 2, (size_t)128 * OW * 2};
      pg8::StaticOrder S; S.init(TOKP / 256, D / 256, G, c);
      EpiP3 E{(const bf16_t*)(ws + WS_GATE), (bf16_t*)(ws + WS_H)};
      pg8::gemm_phase<EpiP3>(lds, g, S, E);
      pg8::GemmDesc gh = g; gh.b_tile = (size_t)128 * OW * 2;
      pg8::StaticOrder S2; S2.init(TOKS / 128, D / 128, G, c, TOKP / 128);
      EpiP3T<true, true> E2{(const bf16_t*)(ws + WS_GATE), (bf16_t*)(ws + WS_H)};
      pg8::gemm_phase<EpiP3T<true, true>, true, true>(lds, gh, S2, E2);
    }
    SEAM(pb + 2);
    if (IN(pb + 3)) {
      pg8::GemmDesc g{(const char*)(ws + WS_H), (const char*)(ws + WS_WOUT) + (size_t)l * D * D * 2, D, D, D / 64, (size_t)256 * D * 2, (size_t)128 * D * 2};
      pg8::StaticOrder S; S.init(TOKP / 256, D / 256, G, c);
      EpiRes E{(float*)(ws + WS_X32), (bf16_t*)(ws + WS_XB), (float*)(ws + WS_SS), lds, l == 0 ? p.x_prompt : nullptr, l == 0 ? p.x_sample : nullptr};
      pg8::gemm_phase<EpiRes>(lds, g, S, E);
      pg8::GemmDesc gh = g; gh.b_tile = (size_t)128 * D * 2;
      pg8::StaticOrder S2; S2.init(TOKS / 128, D / 128, G, c, TOKP / 128);
      EpiResT<true, true> E2{(float*)(ws + WS_X32), (bf16_t*)(ws + WS_XB), (float*)(ws + WS_SS), lds, l == 0 ? p.x_prompt : nullptr, l == 0 ? p.x_sample : nullptr};
      pg8::gemm_phase<EpiResT<true, true>, true, true>(lds, gh, S2, E2);
    }
    SEAM(pb + 3);
    if (IN(pb + 4)) REPEAT(4) {
      pg8::GemmDesc g{(const char*)(ws + WS_XB), (const char*)(ws + WS_WUP) + (size_t)l * 2 * DFF * D * 2, D, D, D / 64, (size_t)128 * D * 2, (size_t)DFF * D * 2};
      pg8::StaticOrder S; S.init(TOKP / 256, DFF / 128, G, c);
      EpiP5F E{(const float*)(ws + WS_SS), (bf16_t*)(ws + WS_HF), p.out, p.conv_w + (size_t)l * 3 * DFF, p.conv_b + (size_t)l * DFF, p.state_conv + (size_t)l * DB * 2 * DFF, (float*)(ws + WS_SIDE), lds, l};
      pg8::gemm_phase<EpiP5F>(lds, g, S, E);
      pg8::StaticOrder S2; S2.init(TOKS / 128, DFF / 128, G, (c + G / 2) % G, TOKP / 128);
      EpiP5FT<true> E2{(const float*)(ws + WS_SS), (bf16_t*)(ws + WS_HF), p.out, p.conv_w + (size_t)l * 3 * DFF, p.conv_b + (size_t)l * DFF, p.state_conv + (size_t)l * DB * 2 * DFF, (float*)(ws + WS_SIDE), lds, l};
      pg8::gemm_phase<EpiP5FT<true>, false, true>(lds, g, S2, E2);
    }
    SEAM(pb + 4);
    if (IN(pb + 5)) {
      pg8::GemmDesc g{(const char*)(ws + WS_HF), (const char*)(ws + WS_WDN) + (size_t)l * D * DFF * 2, DFF, DFF, DFF / 64, (size_t)256 * DFF * 2, (size_t)128 * DFF * 2};
      pg8::StaticOrder S; S.init(TOKP / 256, D / 256, G, c);
      { pg8::Unit uu; for (int i = 0; S.next(i, uu); ++i) if (uu.pm < 64 && (uu.pm & 15) != 0) p6_fixup_panel(uu.pm, (const float*)(ws + WS_SIDE), p.conv_w + (size_t)l * 3 * DFF, (bf16_t*)(ws + WS_HF));
        asm volatile("s_waitcnt vmcnt(0)" ::: "memory"); __syncthreads(); }
      EpiRes E{(float*)(ws + WS_X32), (bf16_t*)(ws + WS_XB), (float*)(ws + WS_SS), lds, nullptr, nullptr};
      pg8::gemm_phase<EpiRes>(lds, g, S, E);
      pg8::GemmDesc gh = g; gh.b_tile = (size_t)128 * DFF * 2;
      pg8::StaticOrder S2; S2.init(TOKS / 128, D / 128, G, c, TOKP / 128);
      EpiResT<true, true> E2{(float*)(ws + WS_X32), (bf16_t*)(ws + WS_XB), (float*)(ws + WS_SS), lds, nullptr, nullptr};
      pg8::gemm_phase<EpiResT<true, true>, true, true>(lds, gh, S2, E2);
    }
    SEAM(pb + 5);
  }
  if (IN(NPHASE - 1)) { pfinal_norm(p_k); }
#undef IN
#undef SEAM
}

#ifndef MK_ONE_LAUNCH
#define MK_ONE_LAUNCH 1
#endif
extern "C" void kernel_launch(void* const* d_in, const int* in_sizes, int n_in, void* d_out, int out_size, void* d_ws, size_t ws_size, hipStream_t stream) {
  static int grid_blocks = 0;
  if (grid_blocks == 0) {
    int dev = 0, cus = 0, per_cu = 0;
    (void)hipGetDevice(&dev);
    (void)hipDeviceGetAttribute(&cus, hipDeviceAttributeMultiprocessorCount, dev);
    (void)hipFuncSetAttribute((const void*)fwd_megakernel, hipFuncAttributeMaxDynamicSharedMemorySize, LDS_BYTES);
    (void)hipOccupancyMaxActiveBlocksPerMultiprocessor(&per_cu, (const void*)fwd_megakernel, NTHREADS, LDS_BYTES);
    if (per_cu < 1) { fprintf(stderr, "kernel_launch: occupancy query says %d blocks/CU\n", per_cu); per_cu = 1; }
    grid_blocks = cus * per_cu;
    if (n_in != 24 || (size_t)out_size != O_END || ws_size < WS_END) { fprintf(stderr, "kernel_launch: unexpected problem (n_in %d out %d ws %zu, need %zu)\n", n_in, out_size, ws_size, (size_t)WS_END); grid_blocks = -1; }
  }
  if (grid_blocks < 0) return;
  Params p{};
  const float** f = (const float**)&p;
  for (int i = 0; i < 24; ++i) f[i] = (const float*)d_in[i];
  p.out = (float*)d_out; p.ws = (unsigned char*)d_ws;
#if MK_ONE_LAUNCH
  p.ph_lo = 0; p.ph_hi = NPHASE;
  (void)hipMemsetAsync((unsigned char*)d_ws + WS_CTL + (size_t)CW_BAR * 4, 0, (size_t)XCD_BAR_WORDS * 4, stream);
  { void* args[] = {&p};
    hipError_t e = hipLaunchCooperativeKernel((void*)fwd_megakernel, dim3(grid_blocks), dim3(NTHREADS), args, LDS_BYTES, stream);
    if (e != hipSuccess) fprintf(stderr, "cooperative launch failed: %s (grid %d)\n", hipGetErrorString(e), grid_blocks); }
#else
  for (int k = 0; k < NPHASE; ++k) { p.ph_lo = k; p.ph_hi = k + 1; void* args[] = {&p};
    hipError_t e = hipLaunchCooperativeKernel((void*)fwd_megakernel, dim3(grid_blocks), dim3(NTHREADS), args, LDS_BYTES, stream);
    if (e != hipSuccess) { fprintf(stderr, "launch %d failed: %s (grid %d)\n", k, hipGetErrorString(e), grid_blocks); break; } }
#endif
}
```

```cpp
#include <hip/hip_runtime.h>
#include <hip/hip_cooperative_groups.h>
#include <cstdio>
#include <cstdint>
namespace cg = cooperative_groups;

#define DI __device__ __forceinline__
#define LAS __attribute__((address_space(3)))
typedef unsigned short bf16_t;
typedef short bf16x8 __attribute__((ext_vector_type(8)));
typedef short s16x4 __attribute__((ext_vector_type(4)));
typedef float f32x2 __attribute__((ext_vector_type(2)));
typedef float f32x4 __attribute__((ext_vector_type(4)));
typedef float f32x8 __attribute__((ext_vector_type(8)));
typedef float f32x16 __attribute__((ext_vector_type(16)));
typedef unsigned u32x2 __attribute__((ext_vector_type(2)));
typedef unsigned u32x4 __attribute__((ext_vector_type(4)));
typedef __bf16 bfv4 __attribute__((ext_vector_type(4)));
typedef __bf16 bfv8 __attribute__((ext_vector_type(8)));

constexpr int D = 1024, SEQ = 4096, NB = 4, TOKP = NB * SEQ, DB = 32, DSEQ = 64, TOKS = DB * DSEQ, TOK = TOKP + TOKS;
constexpr int PAST = 1024, ALEN = 512, INC = 7680, DFF = 2816, NLAYER = 2;
constexpr int QKVW = 4608, GATEW = 3072, OW = 1536;
constexpr float EPS = 1e-6f, LOG2E = 1.4426950408889634f;

constexpr size_t O_YP = 0, O_YS = O_YP + (size_t)TOKP * D, O_PAK = O_YS + (size_t)TOKS * D, O_PAV = O_PAK + (size_t)2 * 4 * 512 * 512,
                 O_PBK = O_PAV + (size_t)2 * 4 * 512 * 512, O_PBV = O_PBK + (size_t)2 * TOKP * 512, O_PCK = O_PBV + (size_t)2 * TOKP * 512,
                 O_PCV = O_PCK + (size_t)2 * TOKP * 512, O_PCONV = O_PCV + (size_t)2 * TOKP * 512, O_SAK = O_PCONV + (size_t)2 * 4 * 2 * DFF,
                 O_SAV = O_SAK + (size_t)2 * DB * 512 * 512, O_SBK = O_SAV + (size_t)2 * DB * 512 * 512, O_SBV = O_SBK + (size_t)2 * TOKS * 512,
                 O_SCK = O_SBV + (size_t)2 * TOKS * 512, O_SCV = O_SCK + (size_t)2 * TOKS * 512, O_SCONV = O_SCV + (size_t)2 * TOKS * 512,
                 O_END = O_SCONV + (size_t)2 * DB * 2 * DFF;

constexpr size_t MiB = 1u << 20;
constexpr size_t WS_CTL = 0;
constexpr size_t WS_WIN = 1 * MiB;
constexpr size_t WS_WBR = WS_WIN + (size_t)2 * INC * D * 2;
constexpr size_t WS_WOUT = WS_WBR + (size_t)2 * D * OW * 2;
constexpr size_t WS_WUP = WS_WOUT + (size_t)2 * D * D * 2;
constexpr size_t WS_WDN = WS_WUP + (size_t)2 * 2 * DFF * D * 2;
constexpr size_t WS_XB = WS_WDN + (size_t)2 * D * DFF * 2;
constexpr size_t WS_X32 = WS_XB + (size_t)TOK * D * 2;
constexpr size_t WS_SS = WS_X32 + (size_t)TOK * D * 4;
constexpr size_t WS_SIDE = WS_SS + (size_t)TOK * 8 * 4;
constexpr size_t WS_O = WS_SIDE + (size_t)3 * 72 * 2 * DFF * 4;
constexpr size_t WS_H = WS_O + (size_t)TOK * OW * 2;
constexpr size_t WS_HF = WS_H + (size_t)TOK * D * 2;
constexpr size_t WS_QKV = WS_HF + (size_t)TOK * DFF * 2;
constexpr size_t WS_GATE = WS_QKV + (size_t)TOK * QKVW * 2;
constexpr size_t WS_END = WS_GATE + (size_t)TOK * GATEW * 2;
constexpr int CW_QUEUE = 64;
constexpr int CW_LAM = 1024;
constexpr int CW_T5 = 2048;
constexpr int CW_BAR = 8192;

constexpr int LDS_BYTES = 160 * 1024;
constexpr int NTHREADS = 512;

DI u32x4 pack8(f32x4 a, f32x4 b) { f32x8 v = {a[0], a[1], a[2], a[3], b[0], b[1], b[2], b[3]}; return __builtin_bit_cast(u32x4, __builtin_convertvector(v, bfv8)); }
DI u32x2 pack4(f32x4 a) { return __builtin_bit_cast(u32x2, __builtin_convertvector(a, bfv4)); }
DI float bflo(unsigned w) { return __uint_as_float(w << 16); }
DI float bfhi(unsigned w) { return __uint_as_float(w & 0xffff0000u); }
DI float wave_sum(float v) {
#pragma unroll
  for (int o = 1; o < 64; o <<= 1) v += __shfl_xor(v, o);
  return v;
}
DI float fast_rcp(float x) { return __builtin_amdgcn_rcpf(x); }
DI float fast_exp2(float x) { return __builtin_amdgcn_exp2f(x); }
DI float fast_log2(float x) { return __builtin_amdgcn_logf(x); }

DI LAS unsigned char* opaque_lds(LAS unsigned char* p) { unsigned v = (unsigned)(__UINTPTR_TYPE__)p; asm volatile("" : "+s"(v)); return (LAS unsigned char*)(__UINTPTR_TYPE__)v; }

struct Params {
  const float* x_prompt; const float* x_sample;
  const float* cache_a_k; const float* cache_a_v; const float* cache_b_k; const float* cache_b_v; const float* cache_c_k; const float* cache_c_v;
  const float* state_conv; const float* norm_mix; const float* w_in; const float* b_gate; const float* a_rel_bias; const float* t5_bias;
  const float* c_lambda; const float* c_subln; const float* w_branch; const float* w_out; const float* norm_ffn; const float* w_up;
  const float* conv_w; const float* conv_b; const float* w_down; const float* norm_final;
  float* out; unsigned char* ws;
  int ph_lo, ph_hi;
};

DI void p0_transpose_item(const float* W, int N, const float* kscale, bf16_t* WT, int dst_ld, int dst_col, LAS float* scr, int item, int lane) {
  const int nblk = N / 32, kb = item / nblk, nb = item % nblk, k0 = 64 * kb, n0 = 32 * nb;
  float wv[32];
#pragma unroll
  for (int i = 0; i < 32; ++i) wv[i] = __builtin_nontemporal_load(&W[(size_t)(k0 + 2 * i + (lane >> 5)) * N + n0 + (lane & 31)]);
#pragma unroll
  for (int i = 0; i < 32; ++i) { const int kk = 2 * i + (lane >> 5); float v = wv[i]; if (kscale) v *= kscale[k0 + kk]; scr[kk * 33 + (lane & 31)] = v; }
  asm volatile("s_waitcnt lgkmcnt(0)" ::: "memory");
  const int c = lane & 7;
#pragma unroll
  for (int j = 0; j < 4; ++j) { const int n = (lane >> 3) + 8 * j; const LAS float* s = scr + (8 * c) * 33 + n;
    f32x4 a = {s[0 * 33], s[1 * 33], s[2 * 33], s[3 * 33]}, b = {s[4 * 33], s[5 * 33], s[6 * 33], s[7 * 33]};
    *(u32x4*)(WT + (size_t)(n0 + n) * dst_ld + dst_col + k0 + 8 * c) = pack8(a, b); }
  asm volatile("s_waitcnt lgkmcnt(0)" ::: "memory");
}

DI int t5_bucket_of(int rel) {
  const int n = rel < 0 ? -rel : rel; int f;
  if (n < 8) f = n; else if (n < 12) f = 8; else if (n < 16) f = 9; else if (n < 23) f = 10; else if (n < 32) f = 11; else if (n < 46) f = 12; else if (n < 64) f = 13; else if (n < 91) f = 14; else f = 15;
  return (rel > 0 ? 16 : 0) + f;
}

DI void p0_prologue(const Params& p, LAS unsigned char* lds_in) {
  LAS unsigned char* lds = opaque_lds(lds_in);
  int tid_ = threadIdx.x; asm volatile("" : "+v"(tid_));
  const int tid = tid_, lane = tid & 63, wave = tid >> 6;
  const int gw = blockIdx.x * 8 + wave, NGW = gridDim.x * 8;
  unsigned* ctl = (unsigned*)(p.ws + WS_CTL);
  if (blockIdx.x == 0) {
    if (tid < 4) ctl[CW_QUEUE + 64 * tid] = 0u;
    if (wave == 1) {
      for (int l = 0; l < NLAYER; ++l) { const float* lp = p.c_lambda + l * 256; const float a = wave_sum(lp[lane] * lp[64 + lane]), b = wave_sum(lp[128 + lane] * lp[192 + lane]);
        const float lam_init = 0.8f - 0.6f * expf(-0.3f * (float)l);
        if (lane == 0) ((float*)ctl)[CW_LAM + l] = expf(a) - expf(b) + lam_init; }
    }
    for (int i = tid; i < 4 * 192; i += NTHREADS) { const int h = i / 192, idx = i % 192; int rel = idx - 127; if (rel > 63) rel = 63;
      ((float*)ctl)[CW_T5 + i] = p.t5_bias[t5_bucket_of(rel) * 4 + h] - p.t5_bias[15 * 4 + h]; }
  }
  LAS float* scr = (LAS float*)(lds + wave * 8448);
  constexpr int I_IN = (D / 64) * (INC / 32), I_BR = (512 / 64) * (D / 32), I_OUT = (D / 64) * (D / 32), I_UP = (D / 64) * (2 * DFF / 32), I_DN = (DFF / 64) * (D / 32);
  constexpr int PER_LAYER = I_IN + 3 * I_BR + I_OUT + I_UP + I_DN;
  for (int it = gw; it < NLAYER * PER_LAYER; it += NGW) {
    const int l = it / PER_LAYER; int r = it % PER_LAYER;
    if (r < I_IN) { p0_transpose_item(p.w_in + (size_t)l * D * INC, INC, p.norm_mix + l * D, (bf16_t*)(p.ws + WS_WIN) + (size_t)l * INC * D, D, 0, scr, r, lane); continue; } r -= I_IN;
    if (r < 3 * I_BR) { const int n = r / I_BR; p0_transpose_item(p.w_branch + ((size_t)l * 3 + n) * 512 * D, D, nullptr, (bf16_t*)(p.ws + WS_WBR) + (size_t)l * D * OW, OW, 512 * n, scr, r % I_BR, lane); continue; } r -= 3 * I_BR;
    if (r < I_OUT) { p0_transpose_item(p.w_out + (size_t)l * D * D, D, nullptr, (bf16_t*)(p.ws + WS_WOUT) + (size_t)l * D * D, D, 0, scr, r, lane); continue; } r -= I_OUT;
    if (r < I_UP) { p0_transpose_item(p.w_up + (size_t)l * D * 2 * DFF, 2 * DFF, p.norm_ffn + l * D, (bf16_t*)(p.ws + WS_WUP) + (size_t)l * 2 * DFF * D, D, 0, scr, r, lane); continue; } r -= I_UP;
    p0_transpose_item(p.w_down + (size_t)l * DFF * D, D, nullptr, (bf16_t*)(p.ws + WS_WDN) + (size_t)l * D * DFF, DFF, 0, scr, r, lane);
  }
  bf16_t* XB = (bf16_t*)(p.ws + WS_XB); float* SS = (float*)(p.ws + WS_SS);
#pragma unroll 3
  for (int m = gw; m < TOK; m += NGW) {
    const float* src = m < TOKP ? p.x_prompt + (size_t)m * D : p.x_sample + (size_t)(m - TOKP) * D;
    float s = 0.f;
#pragma unroll
    for (int j = 0; j < 4; ++j) { const f32x4 v = __builtin_nontemporal_load(&((const f32x4*)src)[lane + 64 * j]); ((u32x2*)(XB + (size_t)m * D))[lane + 64 * j] = pack4(v);
      s += (v[0] * v[0] + v[1] * v[1]) + (v[2] * v[2] + v[3] * v[3]); }
    s = wave_sum(s);
    if (lane < 8) SS[(size_t)m * 8 + lane] = lane == 0 ? s : 0.f;
  }
}

namespace pg8 {
constexpr int BM = 256, BK = 64, HALF = 128, HTB = HALF * BK * 2, STAGE_BYTES = 8 * HTB, NXCD = 8, WGM = 8;
DI int lds_byte(int r, int c) { const int st = (r >> 4) * 2 + (c >> 5), rr = r & 15, cc = c & 31, ob = rr * 64 + cc * 2; return st * 1024 + (ob ^ (((ob >> 9) & 1) << 5)); }
DI void stage_rc(int b, int& R, int& C) { const int st = b / 1024, sb = b % 1024, swz = sb ^ (((sb >> 9) & 1) << 5); R = (st >> 1) * 16 + swz / 64; C = (st & 1) * 32 + (swz % 64) / 2; }
DI int perm32(int rho) { const int n = rho >> 4, i = rho & 15; return 8 * (i >> 2) + 4 * n + (i & 3); }
struct Unit { int pm, pn; };
struct GemmDesc { const char* A; const char* B; int lda, ldb, nt; size_t b_tile, b_half; };
struct StaticOrder {
  int nM, nN, nwg, G, c, pm0;
  DI void init(int nM_, int nN_, int G_, int c_, int pm0_ = 0) { nM = nM_; nN = nN_; nwg = nM * nN; G = G_; c = c_; pm0 = pm0_; }
  DI bool next(int i, Unit& u) const {
    const long L = (long)i * G + c; if (L >= nwg) return false;
    int wgid = (int)L; { const int q = nwg / NXCD, r = nwg % NXCD, xcd = wgid % NXCD, off = wgid / NXCD; wgid = (xcd < r ? xcd * (q + 1) : r * (q + 1) + (xcd - r) * q) + off; }
    const int nig = WGM * nN, gid = wgid / nig, fm = gid * WGM, gsz = (nM - fm) < WGM ? (nM - fm) : WGM;
    u.pm = pm0 + fm + ((wgid % nig) % gsz); u.pn = (wgid % nig) / gsz; return true;
  }
};
constexpr int P1_NN = 28, P1_EXTRA = 32, P1_DEFER = 72 + (72 - P1_EXTRA);
struct P1Order {
  StaticOrder R1;
  DI bool next(int i, Unit& u) const {
    if (R1.next(i, u)) return true;
    const long L = (long)i * R1.G + R1.c - R1.nwg; if (L >= P1_EXTRA) return false;
    u.pm = (int)L; u.pn = P1_NN; return true;
  }
};
DI Unit p1_deferred_unit(int j) { Unit u; if (j < 72) { u.pm = j; u.pn = P1_NN + 1; } else { u.pm = P1_EXTRA + (j - 72); u.pn = P1_NN; } return u; }
struct OneUnit { Unit u; DI bool next(int i, Unit& o) const { if (i != 0) return false; o = u; return true; } };
template <class Epi, bool HALFN = false, bool HALFM = false, class Sched = StaticOrder>
DI void gemm_phase(LAS unsigned char* lds_in, const GemmDesc g, const Sched& S, const Epi& E) {
  LAS unsigned char* lds = opaque_lds(lds_in);
  int tid_ = threadIdx.x; asm volatile("" : "+v"(tid_));
  const int tid = tid_, wid = __builtin_amdgcn_readfirstlane(tid >> 6), lane = tid & 63, wr = wid >> 2, wc = wid & 3, fr = lane & 15, fq = lane >> 4;
  const int nt = g.nt;
  unsigned voffA[2], voffB[2];
#pragma unroll
  for (int i = 0; i < 2; ++i) { int R, C; stage_rc(tid * 16 + i * 8192, R, C); const int Rb = Epi::PERM ? ((R & ~31) + perm32(R & 31)) : R;
    voffA[i] = (unsigned)(R * g.lda + C) * 2u; voffB[i] = (unsigned)(Rb * g.ldb + C) * 2u; }
  const size_t kstep = (size_t)(BK * 2);
  const size_t hsA = (size_t)HALF * g.lda * 2, tsA = HALFM ? hsA : 2 * hsA, hsB = g.b_half, tsB = g.b_tile;
  const unsigned ldsw = (unsigned)wid * 1024u;
  const int aoff = lds_byte(wr * 64 + fr, fq * 8), boff = lds_byte(wc * 32 + fr, fq * 8);
#define PG8_SA(b, h) (((b) * 2 + (h)) * HTB)
#define PG8_SB(b, h) ((4 + (b) * 2 + (h)) * HTB)
#define PG8_STAGE(bufoff, gbase, voff) do { _Pragma("unroll") for (int _i = 0; _i < 2; ++_i) \
    __builtin_amdgcn_global_load_lds((const unsigned*)((const char*)(gbase) + (voff)[_i]), (LAS unsigned*)(lds + (bufoff) + ldsw + _i * 8192), 16, 0, 0); } while (0)
#define PG8_LDA(dst, b, h) do { _Pragma("unroll") for (int m = 0; m < 4; ++m) _Pragma("unroll") for (int k = 0; k < 2; ++k) dst[m][k] = *(const LAS bf16x8*)(lds + PG8_SA(b, h) + aoff + m * 2048 + k * 1024); } while (0)
#define PG8_LDB(dst, b, h) do { _Pragma("unroll") for (int n = 0; n < 2; ++n) _Pragma("unroll") for (int k = 0; k < 2; ++k) dst[n][k] = *(const LAS bf16x8*)(lds + PG8_SB(b, h) + boff + n * 2048 + k * 1024); } while (0)
#define PG8_MMA(ai, bj, At, Bt) do { __builtin_amdgcn_s_setprio(1); _Pragma("unroll") for (int m = 0; m < 4; ++m) _Pragma("unroll") for (int n = 0; n < 2; ++n) _Pragma("unroll") for (int k = 0; k < 2; ++k) \
    acc[ai][bj][m][n] = __builtin_amdgcn_mfma_f32_16x16x32_bf16(Bt[n][k], At[m][k], acc[ai][bj][m][n], 0, 0, 0); __builtin_amdgcn_s_setprio(0); } while (0)
#define PG8_WAIT_V(n) asm volatile("s_waitcnt vmcnt(" #n ")" ::: "memory")
#define PG8_WAIT_LOOP do { if constexpr (HALFM && HALFN) PG8_WAIT_V(4); else if constexpr (HALFM || HALFN) PG8_WAIT_V(6); else PG8_WAIT_V(8); } while (0)
#define PG8_WAIT_L(n) asm volatile("s_waitcnt lgkmcnt(" #n ")" ::: "memory")
#define PG8_BAR __builtin_amdgcn_s_barrier()
#define PG8_SCHED __builtin_amdgcn_sched_barrier(0)
  Unit cur, nxt; int ui = 0;
  if (!S.next(0, cur)) return;
  f32x4 acc[2][2][4][2];
#pragma unroll
  for (int a = 0; a < 2; ++a)
#pragma unroll
    for (int b = 0; b < 2; ++b)
#pragma unroll
      for (int m = 0; m < 4; ++m)
#pragma unroll
        for (int n = 0; n < 2; ++n) acc[a][b][m][n] = (f32x4){0.f, 0.f, 0.f, 0.f};
  bf16x8 At[4][2], B0[2][2], B1[2][2];
  const char* cA = g.A + (size_t)cur.pm * tsA; const char* cB = g.B + (size_t)cur.pn * tsB;
  f32x4 ssv = {0.f, 0.f, 0.f, 0.f};
  if constexpr (Epi::HAS_RS) ssv = E.prefetch(cur, tid);
  PG8_STAGE(PG8_SB(0, 0), cB, voffB); if constexpr (!HALFN) PG8_STAGE(PG8_SB(0, 1), cB + hsB, voffB); PG8_STAGE(PG8_SA(0, 0), cA, voffA); if constexpr (!HALFM) PG8_STAGE(PG8_SA(0, 1), cA + hsA, voffA);
  if (wr == 1) PG8_BAR;
  if constexpr (HALFM) PG8_WAIT_V(0); else PG8_WAIT_V(2);
  PG8_BAR;
  PG8_STAGE(PG8_SB(1, 0), cB + kstep, voffB); PG8_STAGE(PG8_SA(1, 0), cA + kstep, voffA); if constexpr (!HALFN) PG8_STAGE(PG8_SB(1, 1), cB + hsB + kstep, voffB);
  if constexpr (HALFN) PG8_WAIT_V(4); else PG8_WAIT_V(6);
  PG8_BAR;
  for (;;) {
    const bool has_next = S.next(ui + 1, nxt);
    const char* nA = has_next ? g.A + (size_t)nxt.pm * tsA : cA; const char* nB = has_next ? g.B + (size_t)nxt.pn * tsB : cB;
    for (int t = 0; t < nt; t += 2) {
      const bool last = (t == nt - 2);
      const char* a1 = cA + (size_t)(t + 1) * kstep;
      const char* a2 = last ? nA : cA + (size_t)(t + 2) * kstep; const char* b2 = last ? nB : cB + (size_t)(t + 2) * kstep;
      const char* a3 = a2 + kstep; const char* b3 = b2 + kstep;
      if constexpr (Epi::HAS_MID) { if (t == 8 || t == 16) E.mid(acc, cur, t, wr, wc, fr, fq); }
      PG8_LDB(B0, 0, 0); if constexpr (!HALFN) PG8_LDB(B1, 0, 1); PG8_SCHED; PG8_LDA(At, 0, 0); if constexpr (!HALFM) PG8_STAGE(PG8_SA(1, 1), a1 + hsA, voffA);
      PG8_WAIT_LOOP; PG8_WAIT_L(0); PG8_BAR; PG8_MMA(0, 0, At, B0); if constexpr (!HALFN) PG8_MMA(0, 1, At, B1); PG8_BAR; PG8_SCHED;
      if constexpr (!HALFM) PG8_LDA(At, 0, 1); PG8_STAGE(PG8_SB(0, 0), b2, voffB); if constexpr (!HALFN) PG8_STAGE(PG8_SB(0, 1), b2 + hsB, voffB); PG8_STAGE(PG8_SA(0, 0), a2, voffA);
      PG8_WAIT_LOOP; PG8_WAIT_L(0); PG8_BAR; if constexpr (!HALFM) { PG8_MMA(1, 0, At, B0); if constexpr (!HALFN) PG8_MMA(1, 1, At, B1); } PG8_BAR; PG8_SCHED;
      PG8_LDB(B0, 1, 0); if constexpr (!HALFN) PG8_LDB(B1, 1, 1); PG8_SCHED; PG8_LDA(At, 1, 0); if constexpr (!HALFM) PG8_STAGE(PG8_SA(0, 1), a2 + hsA, voffA);
      PG8_WAIT_LOOP; PG8_WAIT_L(0); PG8_BAR; PG8_MMA(0, 0, At, B0); if constexpr (!HALFN) PG8_MMA(0, 1, At, B1); PG8_BAR; PG8_SCHED;
      if constexpr (!HALFM) PG8_LDA(At, 1, 1); PG8_STAGE(PG8_SB(1, 0), b3, voffB); if constexpr (!HALFN) PG8_STAGE(PG8_SB(1, 1), b3 + hsB, voffB); PG8_STAGE(PG8_SA(1, 0), a3, voffA);
      PG8_WAIT_LOOP; PG8_WAIT_L(0); PG8_BAR; if constexpr (!HALFM) { PG8_MMA(1, 0, At, B0); if constexpr (!HALFN) PG8_MMA(1, 1, At, B1); } PG8_BAR; PG8_SCHED;
    }
    if (wr == 0) PG8_BAR;
    if constexpr (Epi::HAS_RS) { E.stash(ssv, cur, tid, lds); PG8_WAIT_L(0); PG8_BAR; asm volatile("" ::: "memory"); }
    E(acc, cur, wr, wc, fr, fq);
    if (!has_next) break;
#pragma unroll
    for (int a = 0; a < 2; ++a)
#pragma unroll
      for (int b = 0; b < 2; ++b)
#pragma unroll
        for (int m = 0; m < 4; ++m)
#pragma unroll
          for (int n = 0; n < 2; ++n) acc[a][b][m][n] = (f32x4){0.f, 0.f, 0.f, 0.f};
    cur = nxt; cA = nA; cB = nB; ++ui;
    if constexpr (Epi::HAS_RS) ssv = E.prefetch(cur, tid);
    if (wr == 1) PG8_BAR;
  }
  PG8_WAIT_V(0);
  PG8_BAR;
#undef PG8_SA
#undef PG8_SB
#undef PG8_STAGE
#undef PG8_LDA
#undef PG8_LDB
#undef PG8_MMA
#undef PG8_WAIT_V
#undef PG8_WAIT_LOOP
#undef PG8_WAIT_L
#undef PG8_BAR
#undef PG8_SCHED
}
}
using pg8::Unit;
DI f32x4 ss_load(const float* SS, int r) { const f32x4* q = (const f32x4*)(SS + (size_t)r * 8); return q[0] + q[1]; }
DI float ss_to_rs(const f32x4& a) { return __builtin_amdgcn_rsqf(((a[0] + a[1]) + (a[2] + a[3])) * (1.0f / D) + EPS); }
DI float row_rs(const float* SS, int r) { return ss_to_rs(ss_load(SS, r)); }
DI float sigmoidf_(float x) { return fast_rcp(1.0f + fast_exp2(-x * LOG2E)); }

struct EpiP1 {
  static constexpr bool PERM = true, HAS_MID = false, HAS_RS = true;
  const float* SS; bf16_t* QKV; bf16_t* GATE; const float* bgate; float* out; int layer; int probe_flags; LAS unsigned char* lds;
  DI void mid(f32x4 (&)[2][2][4][2], const Unit&, int, int, int, int, int) const {}
  DI f32x4 prefetch(const Unit& u, int tid) const {
    f32x4 v = {0.f, 0.f, 0.f, 0.f};
    if (tid < 256) v = ss_load(SS, u.pm * 256 + tid);
    return v;
  }
  DI void stash(const f32x4& v, const Unit& u, int tid, LAS unsigned char* l) const {
    if (tid < 256) *(LAS float*)(l + 131072 + 12288 + tid * 4) = ss_to_rs(v);
  }
  DI void operator()(f32x4 (&acc)[2][2][4][2], const Unit& u, int wr, int wc, int fr, int fq) const {
    const int pn = u.pn, rin0 = wr * 64 + fr, row0 = u.pm * 256 + rin0;
    float rs[2][4];
#pragma unroll
    for (int ai = 0; ai < 2; ++ai)
#pragma unroll
      for (int m = 0; m < 4; ++m) rs[ai][m] = *(const LAS float*)(lds + 131072 + 12288 + (rin0 + ai * 128 + m * 16) * 4);
    if (pn < 18) {
      const int colq = pn * 256 + wc * 32 + 8 * fq;
#pragma unroll
      for (int ai = 0; ai < 2; ++ai)
#pragma unroll
        for (int m = 0; m < 4; ++m) {
          const int rin = rin0 + ai * 128 + m * 16, r = u.pm * 256 + rin; const float s = rs[ai][m];
          bf16_t* rowp = QKV + (size_t)r * QKVW + colq;
#pragma unroll
          for (int bj = 0; bj < 2; ++bj) { const f32x4 v0 = acc[ai][bj][m][0] * s, v1 = acc[ai][bj][m][1] * s;
            { const u32x4 pk = pack8(v0, v1); if (!(probe_flags & 2)) *(u32x4*)(rowp + bj * 128) = pk; else asm volatile("" :: "v"(pk)); }
            }
        }
    } else {
      const int gi = pn - 18, nb = gi >> 2, colg = (gi & 3) * 256 + wc * 32 + 8 * fq;
      f32x4 bv[2][2];
#pragma unroll
      for (int bj = 0; bj < 2; ++bj) { bv[bj][0] = *(const f32x4*)(bgate + nb * D + colg + bj * 128); bv[bj][1] = *(const f32x4*)(bgate + nb * D + colg + bj * 128 + 4); }
#pragma unroll
      for (int ai = 0; ai < 2; ++ai)
#pragma unroll
        for (int m = 0; m < 4; ++m) { const int r = row0 + ai * 128 + m * 16; const float s = rs[ai][m];
          bf16_t* rowp = GATE + (size_t)r * GATEW + gi * 256 + wc * 32 + 8 * fq;
#pragma unroll
          for (int bj = 0; bj < 2; ++bj) { f32x4 v0 = acc[ai][bj][m][0] * s + bv[bj][0], v1 = acc[ai][bj][m][1] * s + bv[bj][1];
#pragma unroll
            for (int j = 0; j < 4; ++j) { v0[j] = 1.0f + fast_exp2(fminf(-v0[j] * LOG2E, 100.0f)); v1[j] = 1.0f + fast_exp2(fminf(-v1[j] * LOG2E, 100.0f)); }
            { const u32x4 pk = pack8(v0, v1); if (!(probe_flags & 2)) *(u32x4*)(rowp + bj * 128) = pk; else asm volatile("" :: "v"(pk)); } } }
    }
  }
};

template <bool HALFN, bool HALFM = false> struct EpiP3T {
  static constexpr bool PERM = true, HAS_MID = true, HAS_RS = false;
  const bf16_t* GATE; bf16_t* H;
  DI void mid(f32x4 (&acc)[2][2][4][2], const Unit& u, int t, int wr, int wc, int fr, int fq) const {
    const int nb = (t >> 3) - 1;
    const bf16_t* gp = GATE + (size_t)(u.pm * (HALFM ? 128 : 256) + wr * 64 + fr) * GATEW + nb * D + u.pn * (HALFN ? 128 : 256) + wc * 32 + 8 * fq;
#pragma unroll
    for (int ai = 0; ai < (HALFM ? 1 : 2); ++ai) {
        u32x4 ga[4][2] = {}, gb[4][2] = {};
#pragma unroll
        for (int m = 0; m < 4; ++m)
#pragma unroll
          for (int bj = 0; bj < (HALFN ? 1 : 2); ++bj) { const bf16_t* q = gp + (size_t)(ai * 128 + m * 16) * GATEW + bj * 128; ga[m][bj] = *(const u32x4*)q; gb[m][bj] = *(const u32x4*)(q + D); }
#pragma unroll
        for (int m = 0; m < 4; ++m)
#pragma unroll
          for (int bj = 0; bj < (HALFN ? 1 : 2); ++bj)
#pragma unroll
            for (int n = 0; n < 2; ++n) { const unsigned a0 = ga[m][bj][2 * n], a1 = ga[m][bj][2 * n + 1], b0 = gb[m][bj][2 * n], b1 = gb[m][bj][2 * n + 1];
              acc[ai][bj][m][n][0] *= bflo(b0) * fast_rcp(bflo(a0)); acc[ai][bj][m][n][1] *= bfhi(b0) * fast_rcp(bfhi(a0));
              acc[ai][bj][m][n][2] *= bflo(b1) * fast_rcp(bflo(a1)); acc[ai][bj][m][n][3] *= bfhi(b1) * fast_rcp(bfhi(a1)); }
        asm volatile("" ::: "memory"); }
  }
  DI void operator()(f32x4 (&acc)[2][2][4][2], const Unit& u, int wr, int wc, int fr, int fq) const {
    const int row0 = u.pm * (HALFM ? 128 : 256) + wr * 64 + fr, col0 = u.pn * (HALFN ? 128 : 256) + wc * 32 + 8 * fq;
#pragma unroll
    for (int ai = 0; ai < (HALFM ? 1 : 2); ++ai)
#pragma unroll
      for (int m = 0; m < 4; ++m) { const int r = row0 + ai * 128 + m * 16; const bf16_t* gp = GATE + (size_t)r * GATEW + 2 * D + col0; bf16_t* hp = H + (size_t)r * D + col0;
#pragma unroll
        for (int bj = 0; bj < (HALFN ? 1 : 2); ++bj) { const u32x4 g = *(const u32x4*)(gp + bj * 128); f32x4 v0 = acc[ai][bj][m][0], v1 = acc[ai][bj][m][1];
          v0[0] *= fast_rcp(bflo(g[0])); v0[1] *= fast_rcp(bfhi(g[0])); v0[2] *= fast_rcp(bflo(g[1])); v0[3] *= fast_rcp(bfhi(g[1])); v1[0] *= fast_rcp(bflo(g[2])); v1[1] *= fast_rcp(bfhi(g[2])); v1[2] *= fast_rcp(bflo(g[3])); v1[3] *= fast_rcp(bfhi(g[3]));
          *(u32x4*)(hp + bj * 128) = pack8(v0, v1); } }
  }
};

typedef EpiP3T<false> EpiP3;

template <bool HALFN, bool HALFM = false> struct EpiResT {
  static constexpr bool PERM = true, HAS_MID = false, HAS_RS = false;
  float* X32; bf16_t* XB; float* SS; LAS unsigned char* lds; const float* xin_p; const float* xin_s;
  DI void mid(f32x4 (&)[2][2][4][2], const Unit&, int, int, int, int, int) const {}
  DI void operator()(f32x4 (&acc)[2][2][4][2], const Unit& u, int wr, int wc, int fr, int fq) const {
    const int rin0 = wr * 64 + fr, row0 = u.pm * (HALFM ? 128 : 256) + rin0, col0 = u.pn * (HALFN ? 128 : 256) + wc * 32 + 8 * fq;
    LAS float* red = (LAS float*)(lds + 131072 + 8192);
#pragma unroll
    for (int ai = 0; ai < (HALFM ? 1 : 2); ++ai) {
      f32x4 xo[4][2][2] = {};
#pragma unroll
      for (int m = 0; m < 4; ++m) { const int r = row0 + ai * 128 + m * 16;
        if (xin_p) { const float* xr = (r < TOKP ? xin_p + (size_t)r * D : xin_s + (size_t)(r - TOKP) * D) + col0;
#pragma unroll
          for (int bj = 0; bj < (HALFN ? 1 : 2); ++bj)
#pragma unroll
            for (int n = 0; n < 2; ++n) xo[m][bj][n] = *(const f32x4*)(xr + bj * 128 + n * 4);
        } else {
#pragma unroll
          for (int bj = 0; bj < (HALFN ? 1 : 2); ++bj) { const u32x4 w = *(const u32x4*)(XB + (size_t)r * D + col0 + bj * 128);
            xo[m][bj][0] = (f32x4){bflo(w[0]), bfhi(w[0]), bflo(w[1]), bfhi(w[1])}; xo[m][bj][1] = (f32x4){bflo(w[2]), bfhi(w[2]), bflo(w[3]), bfhi(w[3])}; } } }
#pragma unroll
      for (int m = 0; m < 4; ++m) { const int r = row0 + ai * 128 + m * 16; bf16_t* bp = XB + (size_t)r * D + col0; float q = 0.f;
#pragma unroll
        for (int bj = 0; bj < (HALFN ? 1 : 2); ++bj)
          { const f32x4 x0 = xo[m][bj][0] + acc[ai][bj][m][0], x1 = xo[m][bj][1] + acc[ai][bj][m][1];
            *(u32x4*)(bp + bj * 128) = pack8(x0, x1);
            q += ((x0[0] * x0[0] + x0[1] * x0[1]) + (x0[2] * x0[2] + x0[3] * x0[3])) + ((x1[0] * x1[0] + x1[1] * x1[1]) + (x1[2] * x1[2] + x1[3] * x1[3])); }
        q += __shfl_xor(q, 16); q += __shfl_xor(q, 32);
        if (fq == 0) red[(rin0 + ai * 128 + m * 16) * 4 + wc] = q; }
      asm volatile("" ::: "memory"); }
    asm volatile("s_waitcnt lgkmcnt(0)" ::: "memory"); __builtin_amdgcn_s_barrier(); asm volatile("" ::: "memory");
    int t = threadIdx.x; asm volatile("" : "+v"(t));
    if (t < (HALFM ? 128 : 256)) { const f32x4 v = *(const LAS f32x4*)(red + t * 4); const float q = (v[0] + v[1]) + (v[2] + v[3]); float* sp = SS + (size_t)(u.pm * (HALFM ? 128 : 256) + t) * 8;
      if (HALFN) sp[u.pn] = q; else *(f32x2*)(sp + 2 * u.pn) = (f32x2){q, 0.f}; }
  }
};

typedef EpiResT<false> EpiRes;

DI float dpp_ror1(float v) { return __builtin_bit_cast(float, __builtin_amdgcn_update_dpp(0, __builtin_bit_cast(int, v), 0x121, 0xf, 0xf, false)); }
DI float dpp_ror2(float v) { return __builtin_bit_cast(float, __builtin_amdgcn_update_dpp(0, __builtin_bit_cast(int, v), 0x122, 0xf, 0xf, false)); }
DI float gelu_mul(float x, float uv) {
  const float t = __builtin_fmaf(x * x, 2.0f * LOG2E * 0.7978845608028654f * 0.044715f, 2.0f * LOG2E * 0.7978845608028654f);
  const float r = fast_rcp(fast_exp2(x * t) + 1.0f);
  return __builtin_fmaf(-x, r, x) * uv;
}
constexpr size_t SIDE_ROWS = (size_t)72 * 2 * DFF;
template <bool HALFM> struct EpiP5FT {
  static constexpr bool PERM = true, HAS_MID = false, HAS_RS = true;
  const float* SS; bf16_t* HF; float* out; const float* cw; const float* cb; const float* st; float* side; LAS unsigned char* lds; int layer;
  DI void mid(f32x4 (&)[2][2][4][2], const Unit&, int, int, int, int, int) const {}
  DI f32x4 prefetch(const Unit& u, int tid) const {
    f32x4 v = {0.f, 0.f, 0.f, 0.f};
    if (tid < (HALFM ? 128 : 256)) v = ss_load(SS, u.pm * (HALFM ? 128 : 256) + tid);
    else if (tid >= 256 && tid < 384) { int j = tid - 256; asm volatile("" : "+v"(j));
      const int arr = j >> 5, c4 = (j & 31) * 4; v = *(const f32x4*)((arr < 3 ? cw + arr * DFF : cb) + u.pn * 128 + c4); }
    return v;
  }
  DI void stash(const f32x4& v, const Unit& u, int tid, LAS unsigned char* l) const {
    if (tid < (HALFM ? 128 : 256)) *(LAS float*)(l + 131072 + 12288 + tid * 4) = ss_to_rs(v);
    else if (tid >= 256 && tid < 384) *(LAS f32x4*)(l + 131072 + 13312 + (tid - 256) * 16) = v;
  }
  DI void operator()(f32x4 (&acc)[2][2][4][2], const Unit& u, int wr, int wc, int fr_in, int fq_in) const {
    int fr = fr_in, fq = fq_in; asm volatile("" : "+v"(fr), "+v"(fq));
    const int rin0 = wr * 64 + fr, col0 = u.pn * 128 + wc * 32 + 8 * fq;
    const bool sample = HALFM ? true : u.pm >= 64, cont = !sample && (u.pm & 15) != 0;
    const int bd0 = HALFM ? (u.pm - TOKP / 128) * 2 : (u.pm - 64) * 4;
    LAS float* xh = (LAS float*)(lds + 131072);
    float* TAILG = side; float* HEADC = side + SIDE_ROWS; float* HEADU = side + 2 * SIDE_ROWS;
#pragma unroll
    for (int ai = 0; ai < (HALFM ? 1 : 2); ++ai)
#pragma unroll
      for (int m = 0; m < 4; ++m) { const float s = *(const LAS float*)(lds + 131072 + 12288 + (rin0 + ai * 128 + m * 16) * 4);
#pragma unroll
        for (int n = 0; n < 2; ++n) { acc[ai][0][m][n] *= s; acc[ai][1][m][n] *= s; } }
    if (fr >= 14) {
#pragma unroll
      for (int ai = 0; ai < (HALFM ? 1 : 2); ++ai) { const int gidx = 2 * ai + wr; LAS float* xp = xh + ((gidx * 4 + wc) * 2 + (fr - 14)) * 32 + fq * 8;
        *(LAS f32x4*)xp = acc[ai][0][3][0]; *(LAS f32x4*)(xp + 4) = acc[ai][0][3][1];
        float* cp = nullptr;
        if (sample) cp = out + O_SCONV + ((size_t)(layer * DB + bd0 + gidx) * 2 + (fr - 14)) * DFF + col0;
        else if (gidx == 3) { float* tp = TAILG + ((size_t)u.pm * 2 + (fr - 14)) * DFF + col0; *(f32x4*)tp = acc[ai][0][3][0]; *(f32x4*)(tp + 4) = acc[ai][0][3][1];
          if ((u.pm & 15) == 15) cp = out + O_PCONV + ((size_t)(layer * 4 + (u.pm >> 4)) * 2 + (fr - 14)) * DFF + col0; }
        if (cp) { *(f32x4*)cp = acc[ai][0][3][0]; *(f32x4*)(cp + 4) = acc[ai][0][3][1]; } }
    }
    asm volatile("s_waitcnt lgkmcnt(0)" ::: "memory"); __builtin_amdgcn_s_barrier(); asm volatile("" ::: "memory");
#pragma unroll
    for (int n = 0; n < 2; ++n) {
      const LAS float* cl = (const LAS float*)(lds + 131072 + 13312) + wc * 32 + 8 * fq + 4 * n;
      const f32x4 w0 = *(const LAS f32x4*)cl, w1 = *(const LAS f32x4*)(cl + 128), w2 = *(const LAS f32x4*)(cl + 256), bb = *(const LAS f32x4*)(cl + 384);
#pragma unroll
      for (int ai = 0; ai < (HALFM ? 1 : 2); ++ai) { const int gidx = 2 * ai + wr;
        f32x4 gp = {0.f, 0.f, 0.f, 0.f};
        if (fr >= 14) {
          if (sample) gp = *(const f32x4*)(st + ((size_t)(bd0 + gidx) * 2 + (fr - 14)) * DFF + col0 + 4 * n);
          else if (gidx > 0) gp = *(const LAS f32x4*)(xh + (((gidx - 1) * 4 + wc) * 2 + (fr - 14)) * 32 + fq * 8 + 4 * n);
        }
#pragma unroll
        for (int m = 0; m < 4; ++m) { const int rin = rin0 + ai * 128 + m * 16; f32x4 o, cc;
#pragma unroll
          for (int j = 0; j < 4; ++j) { const float g = acc[ai][0][m][n][j], gq = gp[j];
            const float r1g = dpp_ror1(g), r1q = dpp_ror1(gq), r2g = dpp_ror2(g), r2q = dpp_ror2(gq);
            const float p1 = fr >= 1 ? r1g : r1q, p2 = fr >= 2 ? r2g : r2q;
            const float c = __builtin_fmaf(w2[j], g, __builtin_fmaf(w1[j], p1, __builtin_fmaf(w0[j], p2, bb[j])));
            cc[j] = c; o[j] = gelu_mul(c, acc[ai][1][m][n][j]); }
          *(u32x2*)(HF + (size_t)(u.pm * (HALFM ? 128 : 256) + rin) * DFF + col0 + 4 * n) = pack4(o);
          if (cont && gidx == 0 && m == 0 && fr < 2) { *(f32x4*)(HEADC + ((size_t)u.pm * 2 + fr) * DFF + col0 + 4 * n) = cc; *(f32x4*)(HEADU + ((size_t)u.pm * 2 + fr) * DFF + col0 + 4 * n) = acc[ai][1][m][n]; }
          gp = acc[ai][0][m][n]; }
      }
    }
  }
};
typedef EpiP5FT<false> EpiP5F;
DI void p6_fixup_panel(int pm, const float* side, const float* cw, bf16_t* HF) {
  const float* TAILG = side + (size_t)(pm - 1) * 2 * DFF; const float* HEADC = side + SIDE_ROWS + (size_t)pm * 2 * DFF; const float* HEADU = side + 2 * SIDE_ROWS + (size_t)pm * 2 * DFF;
  int tid_ = threadIdx.x; asm volatile("" : "+v"(tid_));
  constexpr int NIT = (DFF + NTHREADS - 1) / NTHREADS;
  float t0[NIT], t1[NIT], a0[NIT], a1[NIT], hc0[NIT], hc1[NIT], hu0[NIT], hu1[NIT];
#pragma unroll
  for (int i = 0; i < NIT; ++i) { const int k = tid_ + i * NTHREADS; const int kk = k < DFF ? k : 0;
    t0[i] = TAILG[kk]; t1[i] = TAILG[DFF + kk]; a0[i] = cw[kk]; a1[i] = cw[DFF + kk]; hc0[i] = HEADC[kk]; hc1[i] = HEADC[DFF + kk]; hu0[i] = HEADU[kk]; hu1[i] = HEADU[DFF + kk]; }
#pragma unroll
  for (int i = 0; i < NIT; ++i) { const int k = tid_ + i * NTHREADS;
    const float c0 = hc0[i] + a0[i] * t0[i] + a1[i] * t1[i], c1 = hc1[i] + a0[i] * t1[i];
    const float h0 = gelu_mul(c0, hu0[i]), h1 = gelu_mul(c1, hu1[i]);
    f32x4 v = {h0, h1, 0.f, 0.f}; const u32x2 pk = pack4(v);
    if (k < DFF) { HF[(size_t)(pm * 256) * DFF + k] = (bf16_t)(pk[0] & 0xffffu); HF[(size_t)(pm * 256 + 1) * DFF + k] = (bf16_t)(pk[0] >> 16); } }
}

struct EpiNull {
  static constexpr bool PERM = true, HAS_MID = false, HAS_RS = false;
  DI void mid(f32x4 (&)[2][2][4][2], const Unit&, int, int, int, int, int) const {}
  DI void operator()(f32x4 (&acc)[2][2][4][2], const Unit& u, int wr, int wc, int fr, int fq) const {
#pragma unroll
    for (int ai = 0; ai < 2; ++ai)
#pragma unroll
      for (int bj = 0; bj < 2; ++bj)
#pragma unroll
        for (int m = 0; m < 4; ++m)
#pragma unroll
          for (int n = 0; n < 2; ++n) asm volatile("" :: "v"(acc[ai][bj][m][n]));
  }
};

DI float gelu_tanh(float x) {
  const float y = 0.7978845608028654f * (x + 0.044715f * x * x * x);
  const float e = fast_exp2(2.0f * LOG2E * y);
  const float th = 1.0f - 2.0f * fast_rcp(e + 1.0f);
  return 0.5f * x * (1.0f + th);
}
DI void pfinal_norm(const Params& p) {
  const bf16_t* XB = (const bf16_t*)(p.ws + WS_XB); const float* SS = (const float*)(p.ws + WS_SS);
  int tid_ = threadIdx.x; asm volatile("" : "+v"(tid_));
  const int lane = tid_ & 63, gw = blockIdx.x * 8 + (tid_ >> 6), NGW = gridDim.x * 8;
#pragma unroll 3
  for (int m = gw; m < TOK; m += NGW) { const float s = row_rs(SS, m);
#pragma unroll
    for (int j = 0; j < 2; ++j) { const u32x4 w = ((const u32x4*)(XB + (size_t)m * D))[lane + 64 * j];
      const f32x4 g0 = ((const f32x4*)p.norm_final)[2 * (lane + 64 * j)], g1 = ((const f32x4*)p.norm_final)[2 * (lane + 64 * j) + 1];
      const f32x4 a = {bflo(w[0]), bfhi(w[0]), bflo(w[1]), bfhi(w[1])}, b = {bflo(w[2]), bfhi(w[2]), bflo(w[3]), bfhi(w[3])};
      f32x4* o = (f32x4*)(p.out + (size_t)m * D) + 2 * (lane + 64 * j);
      __builtin_nontemporal_store(a * s * g0, o); __builtin_nontemporal_store(b * s * g1, o + 1); } }
}

DI pg8::GemmDesc p1_desc(unsigned char* ws, int l) {
  return pg8::GemmDesc{(const char*)(ws + WS_XB), (const char*)(ws + WS_WIN) + (size_t)l * INC * D * 2, D, D, D / 64, (size_t)256 * D * 2, (size_t)128 * D * 2};
}
DI EpiP1 p1_epi(const Params& p, int l, LAS unsigned char* lds) {
  return EpiP1{(const float*)(p.ws + WS_SS), (bf16_t*)(p.ws + WS_QKV), (bf16_t*)(p.ws + WS_GATE), p.b_gate + (size_t)l * 3 * D, p.out, l, 0, lds};
}
namespace attn {
constexpr int N_CPY = 0, N_CS = 128, N_CP = 512, N_AP = 512, N_BP = 512, N_AS = 256, N_BS = 256, NITEMS = N_CPY + N_CS + N_CP + N_AP + N_BP + N_AS + N_BS;
constexpr float STICK_DONE = 8.75651e-27f;

struct Item { int mode, h, tok0, past, q0, nqv, pflags; const float* cK; const float* cV; };

DI Item decode(const Params& p, int layer, int idx) {
  Item it; it.cK = nullptr; it.cV = nullptr; it.past = 0; it.pflags = 0;
  if (idx < N_CPY) { it.mode = 3; it.h = idx; return it; }
  idx -= N_CPY;
  if (idx < N_CS) { const int bd = idx >> 2, h = idx & 3; it.mode = 2; it.h = h; it.tok0 = TOKP + bd * 64; it.past = PAST; it.q0 = PAST; it.nqv = 64;
    it.cK = p.cache_c_k + (size_t)(layer * DB + bd) * PAST * 512 + h * 128; it.cV = p.cache_c_v + (size_t)(layer * DB + bd) * PAST * 512 + h * 128; return it; }
  idx -= N_CS;
  if (idx < N_CP) { const int jj = 31 - (idx >> 4), rem = idx & 15; it.mode = 2; it.h = rem & 3; it.tok0 = (rem >> 2) * SEQ; it.q0 = jj * 128; it.nqv = 128; return it; }
  idx -= N_CP;
  if (idx < N_AP + N_BP) { const int isb = idx >= N_AP; if (isb) idx -= N_AP; const int qt = 15 - (idx >> 5), rem = idx & 31; it.mode = isb; it.h = rem & 7; it.tok0 = (rem >> 3) * SEQ; it.q0 = qt * 256; it.nqv = 256; return it; }
  idx -= N_AP + N_BP;
  if (idx < N_AS) { const int bd = idx >> 3, h = idx & 7; it.mode = 0; it.h = h; it.tok0 = TOKP + bd * 64; it.past = ALEN; it.q0 = ALEN; it.nqv = 64;
    it.cK = p.cache_a_k + (size_t)(layer * DB + bd) * ALEN * 512 + h * 64; it.cV = p.cache_a_v + (size_t)(layer * DB + bd) * ALEN * 512 + h * 64; return it; }
  idx -= N_AS;
  { const int bd = idx >> 3, h = idx & 7; it.mode = 1; it.h = h; it.tok0 = TOKP + bd * 64; it.past = PAST; it.q0 = PAST; it.nqv = 64;
    it.cK = p.cache_b_k + (size_t)(layer * DB + bd) * PAST * 512 + h * 64; it.cV = p.cache_b_v + (size_t)(layer * DB + bd) * PAST * 512 + h * 64; return it; }
}


template <int MODE, bool SAMPLE>
DI void load_piece(u32x4& r0, u32x4& r1, u32x4& r2, u32x4& r3, const Item& it, const float* cache, const bf16_t* QKV, int col, int kt, int tid) {
  constexpr int CPR = MODE == 2 ? 16 : 8;
  const int j0 = kt * 64;
  const int ra = tid / CPR, ca = tid % CPR;
  if (SAMPLE && j0 < it.past) {
    const unsigned lo = (unsigned)(ra * 512 + ca * 8) * 4u; const char* b = (const char*)(cache + (size_t)j0 * 512);
    { const u32x4* q = (const u32x4*)(b + lo); r0 = __builtin_nontemporal_load(q); r1 = __builtin_nontemporal_load(q + 1); }
    if constexpr (MODE == 2) { const u32x4* q = (const u32x4*)(b + (size_t)32 * 512 * 4 + lo); r2 = __builtin_nontemporal_load(q); r3 = __builtin_nontemporal_load(q + 1); }
  } else {
    const unsigned lo = (unsigned)(ra * QKVW + ca * 8) * 2u; const char* b = (const char*)(QKV + (size_t)(it.tok0 + j0 - it.past) * QKVW + col);
    r0 = *(const u32x4*)(b + lo);
    if constexpr (MODE == 2) r2 = *(const u32x4*)(b + (size_t)32 * QKVW * 2 + lo);
  }
}
DI u32x4 cvt8(u32x4 a, u32x4 b) { return pack8(__builtin_bit_cast(f32x4, a), __builtin_bit_cast(f32x4, b)); }
template <int MODE, bool ISK, bool SAMPLE>
DI void write_piece(const u32x4& r0, const u32x4& r1, const u32x4& r2, const u32x4& r3, const Item& it, LAS unsigned char* buf, int kt, int tid) {
  constexpr int CPR = MODE == 2 ? 16 : 8, VS = MODE == 2 ? 320 : 192;
  const bool f32src = SAMPLE && kt * 64 < it.past;
  const int ra = tid / CPR, ca = tid % CPR, rb = (tid + NTHREADS) / CPR, cb = (tid + NTHREADS) % CPR;
  { const u32x4 x = f32src ? cvt8(r0, r1) : r0;
    if (ISK) *(LAS u32x4*)(buf + ((MODE == 2 && ca >= 8) ? 8192 : 0) + ra * 128 + (((ca & 7) ^ ((ra >> 1) & 7)) << 4)) = x;
    else *(LAS u32x4*)(buf + ra * VS + ca * 16) = x; }
  if constexpr (MODE == 2) { const u32x4 x = f32src ? cvt8(r2, r3) : r2;
    if (ISK) *(LAS u32x4*)(buf + (cb >= 8 ? 8192 : 0) + rb * 128 + (((cb & 7) ^ ((rb >> 1) & 7)) << 4)) = x;
    else *(LAS u32x4*)(buf + rb * VS + cb * 16) = x; }
}

template <int MODE>
DI void state_store(const u32x4& r0, const u32x4& r2, float* dst, int tid) {
  constexpr int CPR = MODE == 2 ? 16 : 8;
  const int ra = tid / CPR, ca = tid % CPR, rb = (tid + NTHREADS) / CPR, cb = (tid + NTHREADS) % CPR;
  { float* q = dst + (size_t)ra * 512 + ca * 8;
    __builtin_nontemporal_store((f32x4){bflo(r0[0]), bfhi(r0[0]), bflo(r0[1]), bfhi(r0[1])}, (f32x4*)q); __builtin_nontemporal_store((f32x4){bflo(r0[2]), bfhi(r0[2]), bflo(r0[3]), bfhi(r0[3])}, (f32x4*)(q + 4)); }
  if constexpr (MODE == 2) { float* q = dst + (size_t)rb * 512 + cb * 8;
    __builtin_nontemporal_store((f32x4){bflo(r2[0]), bfhi(r2[0]), bflo(r2[1]), bfhi(r2[1])}, (f32x4*)q); __builtin_nontemporal_store((f32x4){bflo(r2[2]), bfhi(r2[2]), bflo(r2[3]), bfhi(r2[3])}, (f32x4*)(q + 4)); }
}
template <int MODE>
DI float* state_dst(const Params& p, int layer, const Item& it, int kt, int isv) {
  const int hoff = MODE == 2 ? it.h * 128 : it.h * 64;
  if (it.past == 0) {
    const int t0 = kt * 64; if (t0 < it.q0 || t0 >= it.q0 + it.nqv) return nullptr;
    const int b = it.tok0 / SEQ;
    if (MODE == 0) { if (t0 < SEQ - 512) return nullptr; return p.out + (isv ? O_PAV : O_PAK) + ((size_t)(layer * 4 + b) * 512 + (t0 - (SEQ - 512))) * 512 + hoff; }
    return p.out + (MODE == 1 ? (isv ? O_PBV : O_PBK) : (isv ? O_PCV : O_PCK)) + ((size_t)(layer * 4 + b) * SEQ + t0) * 512 + hoff;
  } else {
    if (kt * 64 != it.past) return nullptr;
    const int bd = (it.tok0 - TOKP) / 64;
    if (MODE == 0) return p.out + (isv ? O_SAV : O_SAK) + ((size_t)(layer * DB + bd) * 512 + 448) * 512 + hoff;
    return p.out + (MODE == 1 ? (isv ? O_SBV : O_SBK) : (isv ? O_SCV : O_SCK)) + ((size_t)(layer * DB + bd) * 64) * 512 + hoff;
  }
}

DI void roll_store(const u32x4& r0, const u32x4& r1, const Params& p, int layer, const Item& it, int kt, int isv, int tid) {
  if (kt < 1 || kt * 64 >= it.past) return;
  const int bd = (it.tok0 - TOKP) / 64, ra = tid >> 3, ca = tid & 7;
  float* q = p.out + (isv ? O_SAV : O_SAK) + ((size_t)(layer * DB + bd) * 512 + (kt - 1) * 64 + ra) * 512 + it.h * 64 + ca * 8;
  __builtin_nontemporal_store(__builtin_bit_cast(f32x4, r0), (f32x4*)q); __builtin_nontemporal_store(__builtin_bit_cast(f32x4, r1), (f32x4*)(q + 4));
}
DI bf16x8 pack_p(const f32x16& x, int s) {
  const f32x4 a = {x[8 * s], x[8 * s + 1], x[8 * s + 2], x[8 * s + 3]}, b = {x[8 * s + 4], x[8 * s + 5], x[8 * s + 6], x[8 * s + 7]};
  return __builtin_bit_cast(bf16x8, pack8(a, b));
}
#define MFMA32(a, b, c) __builtin_amdgcn_mfma_f32_32x32x16_bf16((a), (b), (c), 0, 0, 0)

constexpr int L_KB = 0, KB_BYTES = 16384, L_VB = 32768, VB_BYTES = 20480, L_LUT = 73728, L_FLAGS = 75776, L_XCH = 81920;

template <int MODE, bool SAMPLE>
DI void run_item(const Params& p, int layer, const Item& it, LAS unsigned char* lds_in) {
  LAS unsigned char* lds = opaque_lds(lds_in);
  constexpr int NDV = MODE == 2 ? 4 : 2, VS = MODE == 2 ? 320 : 192;
  int tid_ = threadIdx.x; asm volatile("" : "+v"(tid_));
  const int tid = tid_, lane = tid & 63, wave = __builtin_amdgcn_readfirstlane(tid >> 6);
  const int qi = lane & 31, h2 = lane >> 5;
  const int mp = MODE == 2 ? (wave >> 2) : 0, wrow = MODE == 2 ? (wave & 3) : wave;
  const int q0w = it.q0 + 32 * wrow;
  const bool active = 32 * wrow < it.nqv;
  const bf16_t* QKV = (const bf16_t*)(p.ws + WS_QKV);
  const int hb = MODE == 2 ? it.h * 128 : it.h * 64;
  const int qcol = (MODE == 0 ? 0 : MODE == 1 ? 1536 : 3072) + hb + 64 * mp, kcol = (MODE == 0 ? 512 : MODE == 1 ? 2048 : 3584) + hb, vcol = (MODE == 0 ? 1024 : MODE == 1 ? 2560 : 4096) + hb;
  const int cw = q0w >> 6;
  int kt_first, step, NT;
  if (MODE == 0) { kt_first = (it.q0 >> 6) - 8; if (kt_first < 0) kt_first = 0; step = 1; NT = ((it.q0 + it.nqv - 1) >> 6) - kt_first + 1; }
  else if (MODE == 2) { kt_first = 0; step = 1; NT = ((it.q0 + it.nqv - 1) >> 6) + 1; }
  else { kt_first = (it.q0 + it.nqv - 2) >> 6; step = -1; NT = kt_first + 1; }
  const bool wr_state = it.pflags == 0;
  u32x4 k0 = {}, k1 = {}, k2 = {}, k3 = {}, v0 = {}, v1 = {}, v2 = {}, v3 = {};
  load_piece<MODE, SAMPLE>(k0, k1, k2, k3, it, it.cK, QKV, kcol, kt_first, tid);
  load_piece<MODE, SAMPLE>(v0, v1, v2, v3, it, it.cV, QKV, vcol, kt_first, tid);
  LAS float* lut = (LAS float*)(lds + L_LUT);
  LAS unsigned* flags = (LAS unsigned*)(lds + L_FLAGS);
  if (MODE == 0) { const float bfar = p.a_rel_bias[((size_t)layer * 257 + 256) * 8 + it.h]; for (int i = tid; i < 257; i += NTHREADS) lut[i] = p.a_rel_bias[((size_t)layer * 257 + i) * 8 + it.h] - bfar; }
  if (MODE == 2) { if (tid < 192) lut[tid] = ((const float*)(p.ws + WS_CTL))[CW_T5 + it.h * 192 + tid]; }
  bf16x8 qf[4];
  if (active) { const bf16_t* qp = QKV + (size_t)(it.tok0 + q0w + qi - it.past) * QKVW + qcol + 8 * h2;
#pragma unroll
    for (int s = 0; s < 4; ++s) { const u32x4 w = *(const u32x4*)(qp + 16 * s);
      const f32x4 a = {bflo(w[0]) * 0.125f, bfhi(w[0]) * 0.125f, bflo(w[1]) * 0.125f, bfhi(w[1]) * 0.125f}, b = {bflo(w[2]) * 0.125f, bfhi(w[2]) * 0.125f, bflo(w[3]) * 0.125f, bfhi(w[3]) * 0.125f};
      qf[s] = __builtin_bit_cast(bf16x8, pack8(a, b)); } }
  f32x16 O[NDV];
#pragma unroll
  for (int b = 0; b < NDV; ++b)
#pragma unroll
    for (int i = 0; i < 16; ++i) O[b][i] = 0.f;
  float m_run = -1e30f, l_run = 0.f, R2 = 1.0f; bool done = false, have_p = false;
  bf16x8 pf[4];
#pragma unroll
  for (int s = 0; s < 4; ++s) pf[s] = (bf16x8){0, 0, 0, 0, 0, 0, 0, 0};
  const int krow_off = qi * 128, kswz = (qi >> 1) & 7;
  const int g16 = lane >> 4, trq = (lane & 15) >> 2, trp = lane & 3;
  const int vtr_off = (4 * (g16 >> 1) + trq) * VS + (16 * (g16 & 1) + 4 * trp) * 2;

  write_piece<MODE, true, SAMPLE>(k0, k1, k2, k3, it, lds + L_KB, kt_first, tid);
  if (wr_state) { float* d = state_dst<MODE>(p, layer, it, kt_first, 0); if (d) state_store<MODE>(k0, k2, d, tid); }
  if (MODE == 0 && SAMPLE && wr_state) roll_store(k0, k1, p, layer, it, kt_first, 0, tid);
  if (NT > 1) load_piece<MODE, SAMPLE>(k0, k1, k2, k3, it, it.cK, QKV, kcol, kt_first + step, tid);
  for (int t = 0;; ++t) {
    __syncthreads();
    if (MODE == 1 && t > 0 && t < NT) { const unsigned any = flags[0] | flags[1] | flags[2] | flags[3] | flags[4] | flags[5] | flags[6] | flags[7]; if (!any) NT = t; }
    const int kt = kt_first + step * t;
    bool mine = false;
    if (t < NT && !(it.pflags & 2)) {
      if (MODE == 0) mine = active && kt >= cw - 8 && kt <= cw;
      else if (MODE == 2) mine = active && kt <= cw;
      else mine = active && !done && kt * 64 <= q0w + 30;
    }
    LAS unsigned char* vb = lds + L_VB + ((t - 1) & 1) * VB_BYTES + vtr_off;
    LAS unsigned char* kb = lds + L_KB + (t & 1) * KB_BYTES + ((MODE == 2 && mp) ? 8192 : 0);
    constexpr int HB = NDV / 2, NST = 4 * HB;
    bf16x8 kfa[4], vfa[2], vfb[2];
    const bool do_pv = have_p && !(it.pflags & 8);
#define V_LOAD(dst, j_) do { if (do_pv) { _Pragma("unroll") for (int bb = 0; bb < 2; ++bb) { const int a0 = 16 * ((j_) / HB) * VS + 64 * (2 * ((j_) % HB) + bb); \
      const s16x4 lo = __builtin_amdgcn_ds_read_tr16_b64_v4i16((LAS s16x4*)(vb + a0)), hi = __builtin_amdgcn_ds_read_tr16_b64_v4i16((LAS s16x4*)(vb + a0 + 8 * VS)); \
      dst[bb] = __builtin_shufflevector(lo, hi, 0, 1, 2, 3, 4, 5, 6, 7); } } } while (0)
#define V_MMA(src, j_) do { if (do_pv) { _Pragma("unroll") for (int bb = 0; bb < 2; ++bb) O[2 * ((j_) % HB) + bb] = MFMA32(src[bb], pf[(j_) / HB], O[2 * ((j_) % HB) + bb]); } } while (0)
#define STG(j_, cur, nxt) do { if (SAMPLE) { V_LOAD(cur, j_); V_MMA(cur, j_); } else { if ((j_) + 1 < NST) V_LOAD(nxt, (j_) + 1); V_MMA(cur, j_); } } while (0)
    if (!SAMPLE) {
      if (mine) {
#pragma unroll
        for (int s = 0; s < 4; ++s) kfa[s] = *(const LAS bf16x8*)(kb + krow_off + (((2 * s + h2) ^ kswz) << 4)); }
      V_LOAD(vfa, 0);
      __builtin_amdgcn_sched_barrier(0);
    }
    if (t < NT && !(it.pflags & 1)) { write_piece<MODE, false, SAMPLE>(v0, v1, v2, v3, it, lds + L_VB + (t & 1) * VB_BYTES, kt_first + step * t, tid);
      if (wr_state) { float* d = state_dst<MODE>(p, layer, it, kt_first + step * t, 1); if (d) state_store<MODE>(v0, v2, d, tid); }
      if (MODE == 0 && SAMPLE && wr_state) roll_store(v0, v1, p, layer, it, kt_first + step * t, 1, tid);
      if (t + 1 < NT) { write_piece<MODE, true, SAMPLE>(k0, k1, k2, k3, it, lds + L_KB + ((t + 1) & 1) * KB_BYTES, kt_first + step * (t + 1), tid);
        if (wr_state) { float* d = state_dst<MODE>(p, layer, it, kt_first + step * (t + 1), 0); if (d) state_store<MODE>(k0, k2, d, tid); }
        if (MODE == 0 && SAMPLE && wr_state) roll_store(k0, k1, p, layer, it, kt_first + step * (t + 1), 0, tid);
        load_piece<MODE, SAMPLE>(v0, v1, v2, v3, it, it.cV, QKV, vcol, kt_first + step * (t + 1), tid);
        if (t + 2 < NT) load_piece<MODE, SAMPLE>(k0, k1, k2, k3, it, it.cK, QKV, kcol, kt_first + step * (t + 2), tid); } }
    __builtin_amdgcn_sched_barrier(0);
    f32x16 sA, sB;
#pragma unroll
    for (int i = 0; i < 16; ++i) { sA[i] = 0.f; sB[i] = 0.f; }
    if (mine) {
      bf16x8 kfc[4];
      if (SAMPLE) {
#pragma unroll
        for (int s = 0; s < 4; ++s) kfa[s] = *(const LAS bf16x8*)(kb + krow_off + (((2 * s + h2) ^ kswz) << 4)); }
#pragma unroll
      for (int s = 0; s < 4; ++s) kfc[s] = *(const LAS bf16x8*)(kb + 4096 + krow_off + (((2 * s + h2) ^ kswz) << 4));
#pragma unroll
      for (int s = 0; s < 4; ++s) sA = MFMA32(kfa[s], qf[s], sA);
#pragma unroll
      for (int s = 0; s < 4; ++s) sB = MFMA32(kfc[s], qf[s], sB);
    }
    const int kbase = kt * 64 + 4 * h2;
    if (MODE != 1) {
      float mx = -1e30f, alpha = 1.0f, lsa = 0.f, lsb = 0.f; bool resc = false;
      const bool smx = mine && !(it.pflags & 4);
      STG(0, vfa, vfb);
      if (NST == 8) STG(1, vfb, vfa);
      if (smx) {
        bool cst;
        if (MODE == 0) cst = q0w - (kt * 64 + 63) >= 128; else cst = kt * 64 + 63 - q0w <= -127;
        if (!cst) {
#pragma unroll
          for (int i = 0; i < 16; ++i) { const int ko = (i & 3) + 8 * (i >> 2);
            int ia, ib;
            if (MODE == 0) { const int d = (q0w + qi) - (kbase + ko); ia = d; ib = d - 32; ia = (ia < -128 ? -128 : ia > 128 ? 128 : ia) + 128; ib = (ib < -128 ? -128 : ib > 128 ? 128 : ib) + 128; }
            else { const int d = (kbase + ko) - (q0w + qi); ia = d; ib = d + 32; ia = (ia < -127 ? -127 : ia > 63 ? 63 : ia) + 127; ib = (ib < -127 ? -127 : ib > 63 ? 63 : ib) + 127; }
            sA[i] += lut[ia]; sB[i] += lut[ib]; }
        }
        float m0 = fmaxf(fmaxf(sA[0], sA[1]), sA[2]), m1 = fmaxf(fmaxf(sB[0], sB[1]), sB[2]);
#pragma unroll
        for (int i = 3; i < 15; i += 2) { m0 = fmaxf(fmaxf(m0, sA[i]), sA[i + 1]); m1 = fmaxf(fmaxf(m1, sB[i]), sB[i + 1]); }
        mx = fmaxf(fmaxf(m0, m1), fmaxf(sA[15], sB[15]));
      }
      __builtin_amdgcn_sched_barrier(0);
      if (NST == 8) { STG(2, vfa, vfb); STG(3, vfb, vfa); } else STG(1, vfb, vfa);
      if (smx) {
        mx = fmaxf(mx, __shfl_xor(mx, 32)) * LOG2E;
        resc = !__all(mx <= m_run + 8.0f);
        if (resc) { const float mnew = fmaxf(m_run, mx); alpha = fast_exp2(m_run - mnew); m_run = mnew; l_run *= alpha; }
#pragma unroll
        for (int i = 0; i < 16; ++i) { sA[i] = fast_exp2(__builtin_fmaf(sA[i], LOG2E, -m_run)); lsa += sA[i]; }
      }
      __builtin_amdgcn_sched_barrier(0);
      if (NST == 8) { STG(4, vfa, vfb); STG(5, vfb, vfa); } else STG(2, vfa, vfb);
      if (smx) {
#pragma unroll
        for (int i = 0; i < 16; ++i) { sB[i] = fast_exp2(__builtin_fmaf(sB[i], LOG2E, -m_run)); lsb += sB[i]; }
        l_run += lsa + lsb;
      }
      __builtin_amdgcn_sched_barrier(0);
      if (NST == 8) { STG(6, vfa, vfb); STG(7, vfb, vfa); } else STG(3, vfb, vfa);
      __builtin_amdgcn_sched_barrier(0);
      if (mine) {
        if (resc) {
#pragma unroll
        for (int b = 0; b < NDV; ++b)
#pragma unroll
          for (int i = 0; i < 16; ++i) O[b][i] *= alpha;
        }
        pf[0] = pack_p(sA, 0); pf[1] = pack_p(sA, 1); pf[2] = pack_p(sB, 0); pf[3] = pack_p(sB, 1);
      }
    } else {
      STG(0, vfa, vfb); STG(1, vfb, vfa); STG(2, vfa, vfb); STG(3, vfb, vfa);
      if (mine) {
        const bool diag = kt * 64 + 63 >= q0w;
        float kpA[16], kpB[16];
#pragma unroll
        for (int i = 0; i < 16; ++i) { const int ko = (i & 3) + 8 * (i >> 2);
          { const float r = fast_rcp(1.0f + fast_exp2(sA[i] * LOG2E)); const bool ok = !diag || (kbase + ko) < (q0w + qi); kpA[i] = ok ? r : 1.0f; sA[i] = ok ? 1.0f - r : 0.0f; }
          { const float r = fast_rcp(1.0f + fast_exp2(sB[i] * LOG2E)); const bool ok = !diag || (kbase + 32 + ko) < (q0w + qi); kpB[i] = ok ? r : 1.0f; sB[i] = ok ? 1.0f - r : 0.0f; } }
        float gs[8], pg[8];
#pragma unroll
        for (int g = 0; g < 4; ++g) { gs[g] = (kpA[4 * g] * kpA[4 * g + 1]) * (kpA[4 * g + 2] * kpA[4 * g + 3]); gs[4 + g] = (kpB[4 * g] * kpB[4 * g + 1]) * (kpB[4 * g + 2] * kpB[4 * g + 3]); }
#pragma unroll
        for (int g = 0; g < 8; ++g) pg[g] = __shfl_xor(gs[g], 32);
        float suf = R2;
#pragma unroll
        for (int g = 7; g >= 0; --g) { const float off = suf * (h2 == 0 ? pg[g] : 1.0f);
          if (g >= 4) { const int b = 4 * (g - 4); const float a3 = off, a2 = a3 * kpB[b + 3], a1 = a2 * kpB[b + 2], a0 = a1 * kpB[b + 1];
            sB[b + 3] *= a3; sB[b + 2] *= a2; sB[b + 1] *= a1; sB[b] *= a0; }
          else { const int b = 4 * g; const float a3 = off, a2 = a3 * kpA[b + 3], a1 = a2 * kpA[b + 2], a0 = a1 * kpA[b + 1];
            sA[b + 3] *= a3; sA[b + 2] *= a2; sA[b + 1] *= a1; sA[b] *= a0; }
          suf *= gs[g] * pg[g]; }
        R2 = suf;
        done = __all(R2 < STICK_DONE) != 0;
        pf[0] = pack_p(sA, 0); pf[1] = pack_p(sA, 1); pf[2] = pack_p(sB, 0); pf[3] = pack_p(sB, 1);
      }
    }
#undef V_LOAD
#undef V_MMA
#undef STG
    have_p = mine;
    if (MODE == 1 && t < NT) { if (lane == 0) flags[wave] = (active && !done && kt > 0 && (kt - 1) * 64 <= q0w + 30) ? 1u : 0u; }
    if (t >= NT) break;
  }
  int lane_e = lane; asm volatile("" : "+v"(lane_e));
  const int qi_e = lane_e & 31, h2_e = lane_e >> 5;
  bf16_t* Ob = (bf16_t*)(p.ws + WS_O);
  const int ocol = MODE == 0 ? hb : MODE == 1 ? 512 + hb : 1024 + hb;
  const bool wr_out = it.pflags == 0;
  if (MODE != 2) {
    if (active && wr_out) { float sc = 1.f; if (MODE == 0) { const float lt = l_run + __shfl_xor(l_run, 32); sc = fast_rcp(lt); }
      bf16_t* op = Ob + (size_t)(it.tok0 + q0w + qi_e - it.past) * OW + ocol + 4 * h2_e;
#pragma unroll
      for (int b = 0; b < NDV; ++b)
#pragma unroll
        for (int g = 0; g < 4; ++g) { const f32x4 v = {O[b][4 * g] * sc, O[b][4 * g + 1] * sc, O[b][4 * g + 2] * sc, O[b][4 * g + 3] * sc}; *(u32x2*)(op + 32 * b + 8 * g) = pack4(v); } }
    __syncthreads();
  } else {
    const float lam = ((const float*)(p.ws + WS_CTL))[CW_LAM + layer];
    const float sub_scale = 1.0f - (0.8f - 0.6f * expf(-0.3f * (float)layer));
    LAS float* xch = (LAS float*)(lds + L_XCH);
    if (active && mp == 1) { const float lt = l_run + __shfl_xor(l_run, 32), sc = lam * fast_rcp(lt);
#pragma unroll
      for (int b = 0; b < NDV; ++b)
#pragma unroll
        for (int i = 0; i < 16; ++i) xch[((wave & 3) * 64 + b * 16 + i) * 64 + lane_e] = O[b][i] * sc; }
    __syncthreads();
    if (active && mp == 0 && wr_out) { const float lt = l_run + __shfl_xor(l_run, 32), sc = fast_rcp(lt); float q = 0.f;
#pragma unroll
      for (int b = 0; b < NDV; ++b)
#pragma unroll
        for (int i = 0; i < 16; ++i) { const float o = O[b][i] * sc - xch[((wave & 3) * 64 + b * 16 + i) * 64 + lane_e]; O[b][i] = o; q += o * o; if ((i & 7) == 7) __builtin_amdgcn_sched_barrier(0); }
      q += __shfl_xor(q, 32);
      const float rstd = __builtin_amdgcn_rsqf(q * (1.0f / 128.0f) + EPS) * sub_scale;
      const float* gain = p.c_subln + layer * 128 + 4 * h2_e;
      bf16_t* op = Ob + (size_t)(it.tok0 + q0w + qi_e - it.past) * OW + ocol + 4 * h2_e;
#pragma unroll
      for (int b = 0; b < NDV; ++b)
#pragma unroll
        for (int g = 0; g < 4; ++g) { const f32x4 gn = *(const f32x4*)(gain + 32 * b + 8 * g);
          const f32x4 v = {O[b][4 * g] * rstd * gn[0], O[b][4 * g + 1] * rstd * gn[1], O[b][4 * g + 2] * rstd * gn[2], O[b][4 * g + 3] * rstd * gn[3]}; *(u32x2*)(op + 32 * b + 8 * g) = pack4(v); } }
    __syncthreads();
  }
}

DI void copy_item(const Params& p, int layer, int idx) {
  const int which = idx >> 5, bd = idx & 31;
  const size_t lb = (size_t)layer * DB + bd;
  const f32x4* src = (const f32x4*)((which ? p.cache_a_v : p.cache_a_k) + lb * 512 * 512 + 64 * 512);
  f32x4* dst = (f32x4*)(p.out + (which ? O_SAV : O_SAK) + lb * 512 * 512);
  int tid_ = threadIdx.x; asm volatile("" : "+v"(tid_));
#pragma unroll 4
  for (int i = tid_; i < 448 * 128; i += NTHREADS) __builtin_nontemporal_store(__builtin_nontemporal_load(src + i), dst + i);
}
#ifndef PROBE_ATT_FLAGS
#define PROBE_ATT_FLAGS 0
#endif
#ifndef PROBE_ATT_LO
#define PROBE_ATT_LO 0
#define PROBE_ATT_HI NITEMS
#endif
DI void attn_phase(const Params& p, int qidx, LAS unsigned char* lds) {
  const int layer = qidx & 1; const int i_lo = qidx >= 2 ? PROBE_ATT_LO : 0, i_hi = qidx >= 2 ? PROBE_ATT_HI : NITEMS;
  unsigned* head = (unsigned*)(p.ws + WS_CTL) + CW_QUEUE + 64 * qidx;
  LAS unsigned* slot = (LAS unsigned*)(lds + LDS_BYTES - 48);
  if (threadIdx.x == 0) slot[0] = atomicAdd(head, 1u);
  for (int k = 0;; ++k) {
    __syncthreads();
    const int idx = __builtin_amdgcn_readfirstlane((int)slot[k & 1]) + i_lo;
    if (threadIdx.x == 0) slot[(k + 1) & 1] = atomicAdd(head, 1u);
    if (idx >= i_hi) break;
    Item it = decode(p, layer, idx); it.pflags = qidx >= 2 ? PROBE_ATT_FLAGS : 0;
    if (it.mode == 3) { if (qidx < 2) copy_item(p, layer, it.h); continue; }
    if (it.past == 0) { if (it.mode == 0) run_item<0, false>(p, layer, it, lds); else if (it.mode == 1) run_item<1, false>(p, layer, it, lds); else run_item<2, false>(p, layer, it, lds); }
    else { if (it.mode == 0) run_item<0, true>(p, layer, it, lds); else if (it.mode == 1) run_item<1, true>(p, layer, it, lds); else run_item<2, true>(p, layer, it, lds); }
  }
}
}
#define XB_TMO      128
#define XB_XCNT(j)  (256  + 64 * (j))
#define XB_XSUB(j)  (1280 + 64 * (j))
#define XB_XGEN(j)  (2304 + 64 * (j))
#define XB_TOP      3328
#define XB_TOPGEN   3392
#define XCD_BAR_WORDS 3456
#define XB_SPIN_CAP (1u << 18)
DI unsigned xb_ld(unsigned* p)              { return __hip_atomic_load(p, __ATOMIC_RELAXED, __HIP_MEMORY_SCOPE_AGENT); }
DI unsigned xb_add(unsigned* p, unsigned v) { return __hip_atomic_fetch_add(p, v, __ATOMIC_RELAXED, __HIP_MEMORY_SCOPE_AGENT); }
DI unsigned xb_xcc_id() { return (unsigned)__builtin_amdgcn_s_getreg((3 << 11) | 20) & 0xFu; }
#define XB_SPIN(cond, bar) do { unsigned _sp = 0; while (cond) { __builtin_amdgcn_s_sleep(1); \
    if ((++_sp & 255u) == 0u) { if (xb_ld(&(bar)[XB_TMO])) break; if (_sp > XB_SPIN_CAP) { atomicAdd(&(bar)[XB_TMO], 1u); break; } } } } while (0)
struct XcdBarrier { unsigned* bar; unsigned x; volatile LAS unsigned* st; };
DI XcdBarrier xcd_barrier_post(unsigned* bar, volatile LAS unsigned* st) {
  XcdBarrier b; b.bar = bar; b.x = xb_xcc_id(); b.st = st;
  if (threadIdx.x == 0) (void)xb_add(&bar[XB_XCNT(b.x)], 1u);
  return b;
}
DI void xcd_barrier_complete(unsigned* bar, unsigned x, unsigned& nloc, unsigned& nx) {
  const unsigned G = gridDim.x * gridDim.y * gridDim.z;
  unsigned sum, cnt, mine, sp = 0u;
  for (;;) {
    sum = 0u; cnt = 0u; mine = 0u;
#pragma unroll
    for (unsigned j = 0; j < 16; ++j) { const unsigned c = xb_ld(&bar[XB_XCNT(j)]); sum += c; cnt += (c > 0u) ? 1u : 0u; mine = (j == x) ? c : mine; }
    if (sum == G) break;
    __builtin_amdgcn_s_sleep(1);
    if ((++sp & 255u) == 0u) { if (xb_ld(&bar[XB_TMO])) break; if (sp > XB_SPIN_CAP) { atomicAdd(&bar[XB_TMO], 1u); break; } }
  }
  nloc = mine > 0u ? mine : 1u; nx = cnt > 0u ? cnt : 1u;
}
DI void xcd_barrier(const XcdBarrier& b) {
  asm volatile("s_waitcnt vmcnt(0)" ::: "memory");
  __syncthreads();
  if (threadIdx.x == 0) {
    unsigned* bar = b.bar;
    __builtin_amdgcn_s_waitcnt(0);
    unsigned nloc = b.st[0], nx = b.st[1];
    if (nloc == 0u) { xcd_barrier_complete(bar, b.x, nloc, nx); b.st[0] = nloc; b.st[1] = nx; }
    const unsigned old = xb_add(&bar[XB_XSUB(b.x)], 1u);
    const unsigned gen = old / nloc;
    if (old + 1u == (gen + 1u) * nloc) {
      __builtin_amdgcn_fence(__ATOMIC_RELEASE, "agent");
      asm volatile("s_waitcnt vmcnt(0)" ::: "memory");
      const unsigned og = xb_add(&bar[XB_TOP], 1u);
      const unsigned tg = og / nx;
      if (og + 1u == (tg + 1u) * nx) xb_add(&bar[XB_TOPGEN], 1u);
      else XB_SPIN(xb_ld(&bar[XB_TOPGEN]) == tg, bar);
      __builtin_amdgcn_fence(__ATOMIC_ACQUIRE, "agent");
      xb_add(&bar[XB_XGEN(b.x)], 1u);
      asm volatile("s_waitcnt vmcnt(0)" ::: "memory");
    } else {
      XB_SPIN(xb_ld(&bar[XB_XGEN(b.x)]) == gen, bar);
      __builtin_amdgcn_fence(__ATOMIC_ACQUIRE, "agent");
      asm volatile("s_waitcnt vmcnt(0)" ::: "memory");
    }
  }
  __syncthreads();
}
constexpr int L_BARST = LDS_BYTES - 64;

#ifndef PROBE_P1_FLAGS
#define PROBE_P1_FLAGS 0
#endif
#ifndef PROBE_NULL_EPI
#define PROBE_NULL_EPI 0
#endif
#ifndef PROBE_MASK
#define PROBE_MASK 0
#endif
#define REPEAT(k) for (int rep_ = 0; rep_ < (((PROBE_MASK >> (k)) & 1) ? 2 : 1); ++rep_)
constexpr int NPHASE = 2 + 6 * NLAYER;
__global__ void __launch_bounds__(NTHREADS, 2) fwd_megakernel(Params p_k) {
  extern __shared__ __attribute__((aligned(16))) unsigned char lds_raw[];
  LAS unsigned char* lds = (LAS unsigned char*)lds_raw;
  cg::grid_group grid = cg::this_grid();
  const int lo = p_k.ph_lo, hi = p_k.ph_hi;
#define IN(k) (lo <= (k) && (k) < hi)
#define SEAM(k) do { if (IN(k) && IN((k) + 1)) xcd_barrier(bar); } while (0)
  const int G = gridDim.x, c = blockIdx.x;
  if (threadIdx.x < 2) ((LAS unsigned*)(lds + L_BARST))[threadIdx.x] = 0u;
  XcdBarrier bar; bar.bar = (unsigned*)(p_k.ws + WS_CTL) + CW_BAR; bar.x = 0; bar.st = (volatile LAS unsigned*)(lds + L_BARST);
  if (p_k.ph_lo < 0) grid.sync();
  bar = xcd_barrier_post((unsigned*)(p_k.ws + WS_CTL) + CW_BAR, (volatile LAS unsigned*)(lds + L_BARST));
  if (IN(0)) { p0_prologue(p_k, lds); if ((PROBE_MASK >> 6) & 1) { __syncthreads(); p0_prologue(p_k, lds); } }
  SEAM(0);
  for (int l = 0; l < NLAYER; ++l) {
    const int pb = 1 + 6 * l;
    const Params& p = p_k; unsigned char* ws = p.ws;
    if (IN(pb + 0)) REPEAT(0) {
      pg8::GemmDesc g{(const char*)(ws + WS_XB), (const char*)(ws + WS_WIN) + (size_t)l * INC * D * 2, D, D, D / 64, (size_t)256 * D * 2, (size_t)128 * D * 2};
      pg8::P1Order S; S.R1.init(TOK / 256, pg8::P1_NN, G, c);
      EpiP1 E{(const float*)(ws + WS_SS), (bf16_t*)(ws + WS_QKV), (bf16_t*)(ws + WS_GATE), p.b_gate + (size_t)l * 3 * D, p.out, l, rep_ == 1 ? PROBE_P1_FLAGS : 0, lds};
#if PROBE_NULL_EPI
      if (rep_ == 1) { EpiNull EN; pg8::gemm_phase<EpiNull, false, false, pg8::P1Order>(lds, g, S, EN); } else
#endif
      pg8::gemm_phase<EpiP1, false, false, pg8::P1Order>(lds, g, S, E);
    }
    SEAM(pb + 0);
    if (IN(pb + 1)) REPEAT(1) {
      for (int j = G - 1 - c; j < pg8::P1_DEFER; j += G) { pg8::OneUnit S1; S1.u = pg8::p1_deferred_unit(j);
        pg8::gemm_phase<EpiP1, false, false, pg8::OneUnit>(lds, p1_desc(ws, l), S1, p1_epi(p, l, lds)); }
      attn::attn_phase(p, l + 2 * rep_, lds); }
    SEAM(pb + 1);
    if (IN(pb + 2)) REPEAT(2) {
      pg8::GemmDesc g{(const char*)(ws + WS_O), (const char*)(ws + WS_WBR) + (size_t)l * D * OW * 2, OW, OW, OW / 64, (size_t)256 * OW * 2, (size_t)128 * OW * 2};
      pg8::StaticOrder S; S.init(TOKP / 256, D / 256, G, c);
      EpiP3 E{(const bf16_t*)(ws + WS_GATE), (bf16_t*)(ws + WS_H)};
      pg8::gemm_phase<EpiP3>(lds, g, S, E);
      pg8::GemmDesc gh = g; gh.b_tile = (size_t)128 * OW * 2;
      pg8::StaticOrder S2; S2.init(TOKS / 128, D / 128, G, c, TOKP / 128);
      EpiP3T<true, true> E2{(const bf16_t*)(ws + WS_GATE), (bf16_t*)(ws + WS_H)};
      pg8::gemm_phase<EpiP3T<true, true>, true, true>(lds, gh, S2, E2);
    }
    SEAM(pb + 2);
    if (IN(pb + 3)) {
      pg8::GemmDesc g{(const char*)(ws + WS_H), (const char*)(ws + WS_WOUT) + (size_t)l * D * D * 2, D, D, D / 64, (size_t)256 * D * 2, (size_t)128 * D * 2};
      pg8::StaticOrder S; S.init(TOKP / 256, D / 256, G, c);
      EpiRes E{(float*)(ws + WS_X32), (bf16_t*)(ws + WS_XB), (float*)(ws + WS_SS), lds, l == 0 ? p.x_prompt : nullptr, l == 0 ? p.x_sample : nullptr};
      pg8::gemm_phase<EpiRes>(lds, g, S, E);
      pg8::GemmDesc gh = g; gh.b_tile = (size_t)128 * D * 2;
      pg8::StaticOrder S2; S2.init(TOKS / 128, D / 128, G, c, TOKP / 128);
      EpiResT<true, true> E2{(float*)(ws + WS_X32), (bf16_t*)(ws + WS_XB), (float*)(ws + WS_SS), lds, l == 0 ? p.x_prompt : nullptr, l == 0 ? p.x_sample : nullptr};
      pg8::gemm_phase<EpiResT<true, true>, true, true>(lds, gh, S2, E2);
    }
    SEAM(pb + 3);
    if (IN(pb + 4)) REPEAT(4) {
      pg8::GemmDesc g{(const char*)(ws + WS_XB), (const char*)(ws + WS_WUP) + (size_t)l * 2 * DFF * D * 2, D, D, D / 64, (size_t)128 * D * 2, (size_t)DFF * D * 2};
      pg8::StaticOrder S; S.init(TOKP / 256, DFF / 128, G, c);
      EpiP5F E{(const float*)(ws + WS_SS), (bf16_t*)(ws + WS_HF), p.out, p.conv_w + (size_t)l * 3 * DFF, p.conv_b + (size_t)l * DFF, p.state_conv + (size_t)l * DB * 2 * DFF, (float*)(ws + WS_SIDE), lds, l};
      pg8::gemm_phase<EpiP5F>(lds, g, S, E);
      pg8::StaticOrder S2; S2.init(TOKS / 128, DFF / 128, G, (c + G / 2) % G, TOKP / 128);
      EpiP5FT<true> E2{(const float*)(ws + WS_SS), (bf16_t*)(ws + WS_HF), p.out, p.conv_w + (size_t)l * 3 * DFF, p.conv_b + (size_t)l * DFF, p.state_conv + (size_t)l * DB * 2 * DFF, (float*)(ws + WS_SIDE), lds, l};
      pg8::gemm_phase<EpiP5FT<true>, false, true>(lds, g, S2, E2);
    }
    SEAM(pb + 4);
    if (IN(pb + 5)) {
      pg8::GemmDesc g{(const char*)(ws + WS_HF), (const char*)(ws + WS_WDN) + (size_t)l * D * DFF * 2, DFF, DFF, DFF / 64, (size_t)256 * DFF * 2, (size_t)128 * DFF * 2};
      pg8::StaticOrder S; S.init(TOKP / 256, D / 256, G, c);
      { pg8::Unit uu; for (int i = 0; S.next(i, uu); ++i) if (uu.pm < 64 && (uu.pm & 15) != 0) p6_fixup_panel(uu.pm, (const float*)(ws + WS_SIDE), p.conv_w + (size_t)l * 3 * DFF, (bf16_t*)(ws + WS_HF));
        asm volatile("s_waitcnt vmcnt(0)" ::: "memory"); __syncthreads(); }
      EpiRes E{(float*)(ws + WS_X32), (bf16_t*)(ws + WS_XB), (float*)(ws + WS_SS), lds, nullptr, nullptr};
      pg8::gemm_phase<EpiRes>(lds, g, S, E);
      pg8::GemmDesc gh = g; gh.b_tile = (size_t)128 * DFF * 2;
      pg8::StaticOrder S2; S2.init(TOKS / 128, D / 128, G, c, TOKP / 128);
      EpiResT<true, true> E2{(float*)(ws + WS_X32), (bf16_t*)(ws + WS_XB), (float*)(ws + WS_SS), lds, nullptr, nullptr};
      pg8::gemm_phase<EpiResT<true, true>, true, true>(lds, gh, S2, E2);
    }
    SEAM(pb + 5);
  }
  if (IN(NPHASE - 1)) { pfinal_norm(p_k); }
#undef IN
#undef SEAM
}

#ifndef MK_ONE_LAUNCH
#define MK_ONE_LAUNCH 1
#endif
extern "C" void kernel_launch(void* const* d_in, const int* in_sizes, int n_in, void* d_out, int out_size, void* d_ws, size_t ws_size, hipStream_t stream) {
  static int grid_blocks = 0;
  if (grid_blocks == 0) {
    int dev = 0, cus = 0, per_cu = 0;
    (void)hipGetDevice(&dev);
    (void)hipDeviceGetAttribute(&cus, hipDeviceAttributeMultiprocessorCount, dev);
    (void)hipFuncSetAttribute((const void*)fwd_megakernel, hipFuncAttributeMaxDynamicSharedMemorySize, LDS_BYTES);
    (void)hipOccupancyMaxActiveBlocksPerMultiprocessor(&per_cu, (const void*)fwd_megakernel, NTHREADS, LDS_BYTES);
    if (per_cu < 1) { fprintf(stderr, "kernel_launch: occupancy query says %d blocks/CU\n", per_cu); per_cu = 1; }
    grid_blocks = cus * per_cu;
    if (n_in != 24 || (size_t)out_size != O_END || ws_size < WS_END) { fprintf(stderr, "kernel_launch: unexpected problem (n_in %d out %d ws %zu, need %zu)\n", n_in, out_size, ws_size, (size_t)WS_END); grid_blocks = -1; }
  }
  if (grid_blocks < 0) return;
  Params p{};
  const float** f = (const float**)&p;
  for (int i = 0; i < 24; ++i) f[i] = (const float*)d_in[i];
  p.out = (float*)d_out; p.ws = (unsigned char*)d_ws;
#if MK_ONE_LAUNCH
  p.ph_lo = 0; p.ph_hi = NPHASE;
  (void)hipMemsetAsync((unsigned char*)d_ws + WS_CTL + (size_t)CW_BAR * 4, 0, (size_t)XCD_BAR_WORDS * 4, stream);
  { void* args[] = {&p};
    hipError_t e = hipLaunchCooperativeKernel((void*)fwd_megakernel, dim3(grid_blocks), dim3(NTHREADS), args, LDS_BYTES, stream);
    if (e != hipSuccess) fprintf(stderr, "cooperative launch failed: %s (grid %d)\n", hipGetErrorString(e), grid_blocks); }
#else
  for (int k = 0; k < NPHASE; ++k) { p.ph_lo = k; p.ph_hi = k + 1; void* args[] = {&p};
    hipError_t e = hipLaunchCooperativeKernel((void*)fwd_megakernel, dim3(grid_blocks), dim3(NTHREADS), args, LDS_BYTES, stream);
    if (e != hipSuccess) { fprintf(stderr, "launch %d failed: %s (grid %d)\n", k, hipGetErrorString(e), grid_blocks); break; } }
#endif
}
```

```cpp
#include <hip/hip_runtime.h>
#include <hip/hip_cooperative_groups.h>
#include <cstdio>
#include <cstdint>
namespace cg = cooperative_groups;

#define DI __device__ __forceinline__
#define LAS __attribute__((address_space(3)))
typedef unsigned short bf16_t;
typedef short bf16x8 __attribute__((ext_vector_type(8)));
typedef short s16x4 __attribute__((ext_vector_type(4)));
typedef float f32x2 __attribute__((ext_vector_type(2)));
typedef float f32x4 __attribute__((ext_vector_type(4)));
typedef float f32x8 __attribute__((ext_vector_type(8)));
typedef float f32x16 __attribute__((ext_vector_type(16)));
typedef unsigned u32x2 __attribute__((ext_vector_type(2)));
typedef unsigned u32x4 __attribute__((ext_vector_type(4)));
typedef __bf16 bfv4 __attribute__((ext_vector_type(4)));
typedef __bf16 bfv8 __attribute__((ext_vector_type(8)));

constexpr int D = 1024, SEQ = 4096, NB = 4, TOKP = NB * SEQ, DB = 32, DSEQ = 64, TOKS = DB * DSEQ, TOK = TOKP + TOKS;
constexpr int PAST = 1024, ALEN = 512, INC = 7680, DFF = 2816, NLAYER = 2;
constexpr int QKVW = 4608, GATEW = 3072, OW = 1536;
constexpr float EPS = 1e-6f, LOG2E = 1.4426950408889634f;

constexpr size_t O_YP = 0, O_YS = O_YP + (size_t)TOKP * D, O_PAK = O_YS + (size_t)TOKS * D, O_PAV = O_PAK + (size_t)2 * 4 * 512 * 512,
                 O_PBK = O_PAV + (size_t)2 * 4 * 512 * 512, O_PBV = O_PBK + (size_t)2 * TOKP * 512, O_PCK = O_PBV + (size_t)2 * TOKP * 512,
                 O_PCV = O_PCK + (size_t)2 * TOKP * 512, O_PCONV = O_PCV + (size_t)2 * TOKP * 512, O_SAK = O_PCONV + (size_t)2 * 4 * 2 * DFF,
                 O_SAV = O_SAK + (size_t)2 * DB * 512 * 512, O_SBK = O_SAV + (size_t)2 * DB * 512 * 512, O_SBV = O_SBK + (size_t)2 * TOKS * 512,
                 O_SCK = O_SBV + (size_t)2 * TOKS * 512, O_SCV = O_SCK + (size_t)2 * TOKS * 512, O_SCONV = O_SCV + (size_t)2 * TOKS * 512,
                 O_END = O_SCONV + (size_t)2 * DB * 2 * DFF;

constexpr size_t MiB = 1u << 20;
constexpr size_t WS_CTL = 0;
constexpr size_t WS_WIN = 1 * MiB;
constexpr size_t WS_WBR = WS_WIN + (size_t)2 * INC * D * 2;
constexpr size_t WS_WOUT = WS_WBR + (size_t)2 * D * OW * 2;
constexpr size_t WS_WUP = WS_WOUT + (size_t)2 * D * D * 2;
constexpr size_t WS_WDN = WS_WUP + (size_t)2 * 2 * DFF * D * 2;
constexpr size_t WS_XB = WS_WDN + (size_t)2 * D * DFF * 2;
constexpr size_t WS_X32 = WS_XB + (size_t)TOK * D * 2;
constexpr size_t WS_SS = WS_X32 + (size_t)TOK * D * 4;
constexpr size_t WS_SIDE = WS_SS + (size_t)TOK * 8 * 4;
constexpr size_t WS_O = WS_SIDE + (size_t)3 * 72 * 2 * DFF * 4;
constexpr size_t WS_H = WS_O + (size_t)TOK * OW * 2;
constexpr size_t WS_HF = WS_H + (size_t)TOK * D * 2;
constexpr size_t WS_QKV = WS_HF + (size_t)TOK * DFF * 2;
constexpr size_t WS_GATE = WS_QKV + (size_t)TOK * QKVW * 2;
constexpr size_t WS_END = WS_GATE + (size_t)TOK * GATEW * 2;
constexpr int CW_QUEUE = 64;
constexpr int CW_LAM = 1024;
constexpr int CW_T5 = 2048;
constexpr int CW_BAR = 8192;

constexpr int LDS_BYTES = 160 * 1024;
constexpr int NTHREADS = 512;

DI u32x4 pack8(f32x4 a, f32x4 b) { f32x8 v = {a[0], a[1], a[2], a[3], b[0], b[1], b[2], b[3]}; return __builtin_bit_cast(u32x4, __builtin_convertvector(v, bfv8)); }
DI u32x2 pack4(f32x4 a) { return __builtin_bit_cast(u32x2, __builtin_convertvector(a, bfv4)); }
DI float bflo(unsigned w) { return __uint_as_float(w << 16); }
DI float bfhi(unsigned w) { return __uint_as_float(w & 0xffff0000u); }
DI float wave_sum(float v) {
#pragma unroll
  for (int o = 1; o < 64; o <<= 1) v += __shfl_xor(v, o);
  return v;
}
DI float fast_rcp(float x) { return __builtin_amdgcn_rcpf(x); }
DI float fast_exp2(float x) { return __builtin_amdgcn_exp2f(x); }
DI float fast_log2(float x) { return __builtin_amdgcn_logf(x); }

DI LAS unsigned char* opaque_lds(LAS unsigned char* p) { unsigned v = (unsigned)(__UINTPTR_TYPE__)p; asm volatile("" : "+s"(v)); return (LAS unsigned char*)(__UINTPTR_TYPE__)v; }

struct Params {
  const float* x_prompt; const float* x_sample;
  const float* cache_a_k; const float* cache_a_v; const float* cache_b_k; const float* cache_b_v; const float* cache_c_k; const float* cache_c_v;
  const float* state_conv; const float* norm_mix; const float* w_in; const float* b_gate; const float* a_rel_bias; const float* t5_bias;
  const float* c_lambda; const float* c_subln; const float* w_branch; const float* w_out; const float* norm_ffn; const float* w_up;
  const float* conv_w; const float* conv_b; const float* w_down; const float* norm_final;
  float* out; unsigned char* ws;
  int ph_lo, ph_hi;
};

DI void p0_transpose_item(const float* W, int N, const float* kscale, bf16_t* WT, int dst_ld, int dst_col, LAS float* scr, int item, int lane) {
  const int nblk = N / 32, kb = item / nblk, nb = item % nblk, k0 = 64 * kb, n0 = 32 * nb;
  float wv[32];
#pragma unroll
  for (int i = 0; i < 32; ++i) wv[i] = __builtin_nontemporal_load(&W[(size_t)(k0 + 2 * i + (lane >> 5)) * N + n0 + (lane & 31)]);
#pragma unroll
  for (int i = 0; i < 32; ++i) { const int kk = 2 * i + (lane >> 5); float v = wv[i]; if (kscale) v *= kscale[k0 + kk]; scr[kk * 33 + (lane & 31)] = v; }
  asm volatile("s_waitcnt lgkmcnt(0)" ::: "memory");
  const int c = lane & 7;
#pragma unroll
  for (int j = 0; j < 4; ++j) { const int n = (lane >> 3) + 8 * j; const LAS float* s = scr + (8 * c) * 33 + n;
    f32x4 a = {s[0 * 33], s[1 * 33], s[2 * 33], s[3 * 33]}, b = {s[4 * 33], s[5 * 33], s[6 * 33], s[7 * 33]};
    *(u32x4*)(WT + (size_t)(n0 + n) * dst_ld + dst_col + k0 + 8 * c) = pack8(a, b); }
  asm volatile("s_waitcnt lgkmcnt(0)" ::: "memory");
}

DI int t5_bucket_of(int rel) {
  const int n = rel < 0 ? -rel : rel; int f;
  if (n < 8) f = n; else if (n < 12) f = 8; else if (n < 16) f = 9; else if (n < 23) f = 10; else if (n < 32) f = 11; else if (n < 46) f = 12; else if (n < 64) f = 13; else if (n < 91) f = 14; else f = 15;
  return (rel > 0 ? 16 : 0) + f;
}

DI void p0_prologue(const Params& p, LAS unsigned char* lds_in) {
  LAS unsigned char* lds = opaque_lds(lds_in);
  int tid_ = threadIdx.x; asm volatile("" : "+v"(tid_));
  const int tid = tid_, lane = tid & 63, wave = tid >> 6;
  const int gw = blockIdx.x * 8 + wave, NGW = gridDim.x * 8;
  unsigned* ctl = (unsigned*)(p.ws + WS_CTL);
  if (blockIdx.x == 0) {
    if (tid < 4) ctl[CW_QUEUE + 64 * tid] = 0u;
    if (wave == 1) {
      for (int l = 0; l < NLAYER; ++l) { const float* lp = p.c_lambda + l * 256; const float a = wave_sum(lp[lane] * lp[64 + lane]), b = wave_sum(lp[128 + lane] * lp[192 + lane]);
        const float lam_init = 0.8f - 0.6f * expf(-0.3f * (float)l);
        if (lane == 0) ((float*)ctl)[CW_LAM + l] = expf(a) - expf(b) + lam_init; }
    }
    for (int i = tid; i < 4 * 192; i += NTHREADS) { const int h = i / 192, idx = i % 192; int rel = idx - 127; if (rel > 63) rel = 63;
      ((float*)ctl)[CW_T5 + i] = p.t5_bias[t5_bucket_of(rel) * 4 + h] - p.t5_bias[15 * 4 + h]; }
  }
  LAS float* scr = (LAS float*)(lds + wave * 8448);
  constexpr int I_IN = (D / 64) * (INC / 32), I_BR = (512 / 64) * (D / 32), I_OUT = (D / 64) * (D / 32), I_UP = (D / 64) * (2 * DFF / 32), I_DN = (DFF / 64) * (D / 32);
  constexpr int PER_LAYER = I_IN + 3 * I_BR + I_OUT + I_UP + I_DN;
  for (int it = gw; it < NLAYER * PER_LAYER; it += NGW) {
    const int l = it / PER_LAYER; int r = it % PER_LAYER;
    if (r < I_IN) { p0_transpose_item(p.w_in + (size_t)l * D * INC, INC, p.norm_mix + l * D, (bf16_t*)(p.ws + WS_WIN) + (size_t)l * INC * D, D, 0, scr, r, lane); continue; } r -= I_IN;
    if (r < 3 * I_BR) { const int n = r / I_BR; p0_transpose_item(p.w_branch + ((size_t)l * 3 + n) * 512 * D, D, nullptr, (bf16_t*)(p.ws + WS_WBR) + (size_t)l * D * OW, OW, 512 * n, scr, r % I_BR, lane); continue; } r -= 3 * I_BR;
    if (r < I_OUT) { p0_transpose_item(p.w_out + (size_t)l * D * D, D, nullptr, (bf16_t*)(p.ws + WS_WOUT) + (size_t)l * D * D, D, 0, scr, r, lane); continue; } r -= I_OUT;
    if (r < I_UP) { p0_transpose_item(p.w_up + (size_t)l * D * 2 * DFF, 2 * DFF, p.norm_ffn + l * D, (bf16_t*)(p.ws + WS_WUP) + (size_t)l * 2 * DFF * D, D, 0, scr, r, lane); continue; } r -= I_UP;
    p0_transpose_item(p.w_down + (size_t)l * DFF * D, D, nullptr, (bf16_t*)(p.ws + WS_WDN) + (size_t)l * D * DFF, DFF, 0, scr, r, lane);
  }
  bf16_t* XB = (bf16_t*)(p.ws + WS_XB); float* SS = (float*)(p.ws + WS_SS);
#pragma unroll 3
  for (int m = gw; m < TOK; m += NGW) {
    const float* src = m < TOKP ? p.x_prompt + (size_t)m * D : p.x_sample + (size_t)(m - TOKP) * D;
    float s = 0.f;
#pragma unroll
    for (int j = 0; j < 4; ++j) { const f32x4 v = __builtin_nontemporal_load(&((const f32x4*)src)[lane + 64 * j]); ((u32x2*)(XB + (size_t)m * D))[lane + 64 * j] = pack4(v);
      s += (v[0] * v[0] + v[1] * v[1]) + (v[2] * v[2] + v[3] * v[3]); }
    s = wave_sum(s);
    if (lane < 8) SS[(size_t)m * 8 + lane] = lane == 0 ? s : 0.f;
  }
}

namespace pg8 {
constexpr int BM = 256, BK = 64, HALF = 128, HTB = HALF * BK * 2, STAGE_BYTES = 8 * HTB, NXCD = 8, WGM = 8;
DI int lds_byte(int r, int c) { const int st = (r >> 4) * 2 + (c >> 5), rr = r & 15, cc = c & 31, ob = rr * 64 + cc * 2; return st * 1024 + (ob ^ (((ob >> 9) & 1) << 5)); }
DI void stage_rc(int b, int& R, int& C) { const int st = b / 1024, sb = b % 1024, swz = sb ^ (((sb >> 9) & 1) << 5); R = (st >> 1) * 16 + swz / 64; C = (st & 1) * 32 + (swz % 64) / 2; }
DI int perm32(int rho) { const int n = rho >> 4, i = rho & 15; return 8 * (i >> 2) + 4 * n + (i & 3); }
struct Unit { int pm, pn; };
struct GemmDesc { const char* A; const char* B; int lda, ldb, nt; size_t b_tile, b_half; };
struct StaticOrder {
  int nM, nN, nwg, G, c, pm0;
  DI void init(int nM_, int nN_, int G_, int c_, int pm0_ = 0) { nM = nM_; nN = nN_; nwg = nM * nN; G = G_; c = c_; pm0 = pm0_; }
  DI bool next(int i, Unit& u) const {
    const long L = (long)i * G + c; if (L >= nwg) return false;
    int wgid = (int)L; { const int q = nwg / NXCD, r = nwg % NXCD, xcd = wgid % NXCD, off = wgid / NXCD; wgid = (xcd < r ? xcd * (q + 1) : r * (q + 1) + (xcd - r) * q) + off; }
    const int nig = WGM * nN, gid = wgid / nig, fm = gid * WGM, gsz = (nM - fm) < WGM ? (nM - fm) : WGM;
    u.pm = pm0 + fm + ((wgid % nig) % gsz); u.pn = (wgid % nig) / gsz; return true;
  }
};
constexpr int P1_NN = 28, P1_EXTRA = 32, P1_DEFER = 72 + (72 - P1_EXTRA);
struct P1Order {
  StaticOrder R1;
  DI bool next(int i, Unit& u) const {
    if (R1.next(i, u)) return true;
    const long L = (long)i * R1.G + R1.c - R1.nwg; if (L >= P1_EXTRA) return false;
    u.pm = (int)L; u.pn = P1_NN; return true;
  }
};
DI Unit p1_deferred_unit(int j) { Unit u; if (j < 72) { u.pm = j; u.pn = P1_NN + 1; } else { u.pm = P1_EXTRA + (j - 72); u.pn = P1_NN; } return u; }
struct OneUnit { Unit u; DI bool next(int i, Unit& o) const { if (i != 0) return false; o = u; return true; } };
template <class Epi, bool HALFN = false, bool HALFM = false, class Sched = StaticOrder>
DI void gemm_phase(LAS unsigned char* lds_in, const GemmDesc g, const Sched& S, const Epi& E) {
  LAS unsigned char* lds = opaque_lds(lds_in);
  int tid_ = threadIdx.x; asm volatile("" : "+v"(tid_));
  const int tid = tid_, wid = __builtin_amdgcn_readfirstlane(tid >> 6), lane = tid & 63, wr = wid >> 2, wc = wid & 3, fr = lane & 15, fq = lane >> 4;
  const int nt = g.nt;
  unsigned voffA[2], voffB[2];
#pragma unroll
  for (int i = 0; i < 2; ++i) { int R, C; stage_rc(tid * 16 + i * 8192, R, C); const int Rb = Epi::PERM ? ((R & ~31) + perm32(R & 31)) : R;
    voffA[i] = (unsigned)(R * g.lda + C) * 2u; voffB[i] = (unsigned)(Rb * g.ldb + C) * 2u; }
  const size_t kstep = (size_t)(BK * 2);
  const size_t hsA = (size_t)HALF * g.lda * 2, tsA = HALFM ? hsA : 2 * hsA, hsB = g.b_half, tsB = g.b_tile;
  const unsigned ldsw = (unsigned)wid * 1024u;
  const int aoff = lds_byte(wr * 64 + fr, fq * 8), boff = lds_byte(wc * 32 + fr, fq * 8);
#define PG8_SA(b, h) (((b) * 2 + (h)) * HTB)
#define PG8_SB(b, h) ((4 + (b) * 2 + (h)) * HTB)
#define PG8_STAGE(bufoff, gbase, voff) do { _Pragma("unroll") for (int _i = 0; _i < 2; ++_i) \
    __builtin_amdgcn_global_load_lds((const unsigned*)((const char*)(gbase) + (voff)[_i]), (LAS unsigned*)(lds + (bufoff) + ldsw + _i * 8192), 16, 0, 0); } while (0)
#define PG8_LDA(dst, b, h) do { _Pragma("unroll") for (int m = 0; m < 4; ++m) _Pragma("unroll") for (int k = 0; k < 2; ++k) dst[m][k] = *(const LAS bf16x8*)(lds + PG8_SA(b, h) + aoff + m * 2048 + k * 1024); } while (0)
#define PG8_LDB(dst, b, h) do { _Pragma("unroll") for (int n = 0; n < 2; ++n) _Pragma("unroll") for (int k = 0; k < 2; ++k) dst[n][k] = *(const LAS bf16x8*)(lds + PG8_SB(b, h) + boff + n * 2048 + k * 1024); } while (0)
#define PG8_MMA(ai, bj, At, Bt) do { __builtin_amdgcn_s_setprio(1); _Pragma("unroll") for (int m = 0; m < 4; ++m) _Pragma("unroll") for (int n = 0; n < 2; ++n) _Pragma("unroll") for (int k = 0; k < 2; ++k) \
    acc[ai][bj][m][n] = __builtin_amdgcn_mfma_f32_16x16x32_bf16(Bt[n][k], At[m][k], acc[ai][bj][m][n], 0, 0, 0); __builtin_amdgcn_s_setprio(0); } while (0)
#define PG8_WAIT_V(n) asm volatile("s_waitcnt vmcnt(" #n ")" ::: "memory")
#define PG8_WAIT_LOOP do { if constexpr (HALFM && HALFN) PG8_WAIT_V(4); else if constexpr (HALFM || HALFN) PG8_WAIT_V(6); else PG8_WAIT_V(8); } while (0)
#define PG8_WAIT_L(n) asm volatile("s_waitcnt lgkmcnt(" #n ")" ::: "memory")
#define PG8_BAR __builtin_amdgcn_s_barrier()
#define PG8_SCHED __builtin_amdgcn_sched_barrier(0)
  Unit cur, nxt; int ui = 0;
  if (!S.next(0, cur)) return;
  f32x4 acc[2][2][4][2];
#pragma unroll
  for (int a = 0; a < 2; ++a)
#pragma unroll
    for (int b = 0; b < 2; ++b)
#pragma unroll
      for (int m = 0; m < 4; ++m)
#pragma unroll
        for (int n = 0; n < 2; ++n) acc[a][b][m][n] = (f32x4){0.f, 0.f, 0.f, 0.f};
  bf16x8 At[4][2], B0[2][2], B1[2][2];
  const char* cA = g.A + (size_t)cur.pm * tsA; const char* cB = g.B + (size_t)cur.pn * tsB;
  f32x4 ssv = {0.f, 0.f, 0.f, 0.f};
  if constexpr (Epi::HAS_RS) ssv = E.prefetch(cur, tid);
  PG8_STAGE(PG8_SB(0, 0), cB, voffB); if constexpr (!HALFN) PG8_STAGE(PG8_SB(0, 1), cB + hsB, voffB); PG8_STAGE(PG8_SA(0, 0), cA, voffA); if constexpr (!HALFM) PG8_STAGE(PG8_SA(0, 1), cA + hsA, voffA);
  if (wr == 1) PG8_BAR;
  if constexpr (HALFM) PG8_WAIT_V(0); else PG8_WAIT_V(2);
  PG8_BAR;
  PG8_STAGE(PG8_SB(1, 0), cB + kstep, voffB); PG8_STAGE(PG8_SA(1, 0), cA + kstep, voffA); if constexpr (!HALFN) PG8_STAGE(PG8_SB(1, 1), cB + hsB + kstep, voffB);
  if constexpr (HALFN) PG8_WAIT_V(4); else PG8_WAIT_V(6);
  PG8_BAR;
  for (;;) {
    const bool has_next = S.next(ui + 1, nxt);
    const char* nA = has_next ? g.A + (size_t)nxt.pm * tsA : cA; const char* nB = has_next ? g.B + (size_t)nxt.pn * tsB : cB;
    for (int t = 0; t < nt; t += 2) {
      const bool last = (t == nt - 2);
      const char* a1 = cA + (size_t)(t + 1) * kstep;
      const char* a2 = last ? nA : cA + (size_t)(t + 2) * kstep; const char* b2 = last ? nB : cB + (size_t)(t + 2) * kstep;
      const char* a3 = a2 + kstep; const char* b3 = b2 + kstep;
      if constexpr (Epi::HAS_MID) { if (t == 8 || t == 16) E.mid(acc, cur, t, wr, wc, fr, fq); }
      PG8_LDB(B0, 0, 0); if constexpr (!HALFN) PG8_LDB(B1, 0, 1); PG8_SCHED; PG8_LDA(At, 0, 0); if constexpr (!HALFM) PG8_STAGE(PG8_SA(1, 1), a1 + hsA, voffA);
      PG8_WAIT_LOOP; PG8_WAIT_L(0); PG8_BAR; PG8_MMA(0, 0, At, B0); if constexpr (!HALFN) PG8_MMA(0, 1, At, B1); PG8_BAR; PG8_SCHED;
      if constexpr (!HALFM) PG8_LDA(At, 0, 1); PG8_STAGE(PG8_SB(0, 0), b2, voffB); if constexpr (!HALFN) PG8_STAGE(PG8_SB(0, 1), b2 + hsB, voffB); PG8_STAGE(PG8_SA(0, 0), a2, voffA);
      PG8_WAIT_LOOP; PG8_WAIT_L(0); PG8_BAR; if constexpr (!HALFM) { PG8_MMA(1, 0, At, B0); if constexpr (!HALFN) PG8_MMA(1, 1, At, B1); } PG8_BAR; PG8_SCHED;
      PG8_LDB(B0, 1, 0); if constexpr (!HALFN) PG8_LDB(B1, 1, 1); PG8_SCHED; PG8_LDA(At, 1, 0); if constexpr (!HALFM) PG8_STAGE(PG8_SA(0, 1), a2 + hsA, voffA);
      PG8_WAIT_LOOP; PG8_WAIT_L(0); PG8_BAR; PG8_MMA(0, 0, At, B0); if constexpr (!HALFN) PG8_MMA(0, 1, At, B1); PG8_BAR; PG8_SCHED;
      if constexpr (!HALFM) PG8_LDA(At, 1, 1); PG8_STAGE(PG8_SB(1, 0), b3, voffB); if constexpr (!HALFN) PG8_STAGE(PG8_SB(1, 1), b3 + hsB, voffB); PG8_STAGE(PG8_SA(1, 0), a3, voffA);
      PG8_WAIT_LOOP; PG8_WAIT_L(0); PG8_BAR; if constexpr (!HALFM) { PG8_MMA(1, 0, At, B0); if constexpr (!HALFN) PG8_MMA(1, 1, At, B1); } PG8_BAR; PG8_SCHED;
    }
    if (wr == 0) PG8_BAR;
    if constexpr (Epi::HAS_RS) { E.stash(ssv, cur, tid, lds); PG8_WAIT_L(0); PG8_BAR; asm volatile("" ::: "memory"); }
    E(acc, cur, wr, wc, fr, fq);
    if (!has_next) break;
#pragma unroll
    for (int a = 0; a < 2; ++a)
#pragma unroll
      for (int b = 0; b < 2; ++b)
#pragma unroll
        for (int m = 0; m < 4; ++m)
#pragma unroll
          for (int n = 0; n < 2; ++n) acc[a][b][m][n] = (f32x4){0.f, 0.f, 0.f, 0.f};
    cur = nxt; cA = nA; cB = nB; ++ui;
    if constexpr (Epi::HAS_RS) ssv = E.prefetch(cur, tid);
    if (wr == 1) PG8_BAR;
  }
  PG8_WAIT_V(0);
  PG8_BAR;
#undef PG8_SA
#undef PG8_SB
#undef PG8_STAGE
#undef PG8_LDA
#undef PG8_LDB
#undef PG8_MMA
#undef PG8_WAIT_V
#undef PG8_WAIT_LOOP
#undef PG8_WAIT_L
#undef PG8_BAR
#undef PG8_SCHED
}
}
using pg8::Unit;
DI f32x4 ss_load(const float* SS, int r) { const f32x4* q = (const f32x4*)(SS + (size_t)r * 8); return q[0] + q[1]; }
DI float ss_to_rs(const f32x4& a) { return __builtin_amdgcn_rsqf(((a[0] + a[1]) + (a[2] + a[3])) * (1.0f / D) + EPS); }
DI float row_rs(const float* SS, int r) { return ss_to_rs(ss_load(SS, r)); }
DI float sigmoidf_(float x) { return fast_rcp(1.0f + fast_exp2(-x * LOG2E)); }

struct EpiP1 {
  static constexpr bool PERM = true, HAS_MID = false, HAS_RS = true;
  const float* SS; bf16_t* QKV; bf16_t* GATE; const float* bgate; float* out; int layer; int probe_flags; LAS unsigned char* lds;
  DI void mid(f32x4 (&)[2][2][4][2], const Unit&, int, int, int, int, int) const {}
  DI f32x4 prefetch(const Unit& u, int tid) const {
    f32x4 v = {0.f, 0.f, 0.f, 0.f};
    if (tid < 256) v = ss_load(SS, u.pm * 256 + tid);
    return v;
  }
  DI void stash(const f32x4& v, const Unit& u, int tid, LAS unsigned char* l) const {
    if (tid < 256) *(LAS float*)(l + 131072 + 12288 + tid * 4) = ss_to_rs(v);
  }
  DI void operator()(f32x4 (&acc)[2][2][4][2], const Unit& u, int wr, int wc, int fr, int fq) const {
    const int pn = u.pn, rin0 = wr * 64 + fr, row0 = u.pm * 256 + rin0;
    float rs[2][4];
#pragma unroll
    for (int ai = 0; ai < 2; ++ai)
#pragma unroll
      for (int m = 0; m < 4; ++m) rs[ai][m] = *(const LAS float*)(lds + 131072 + 12288 + (rin0 + ai * 128 + m * 16) * 4);
    if (pn < 18) {
      const int colq = pn * 256 + wc * 32 + 8 * fq;
#pragma unroll
      for (int ai = 0; ai < 2; ++ai)
#pragma unroll
        for (int m = 0; m < 4; ++m) {
          const int rin = rin0 + ai * 128 + m * 16, r = u.pm * 256 + rin; const float s = rs[ai][m];
          bf16_t* rowp = QKV + (size_t)r * QKVW + colq;
#pragma unroll
          for (int bj = 0; bj < 2; ++bj) { const f32x4 v0 = acc[ai][bj][m][0] * s, v1 = acc[ai][bj][m][1] * s;
            { const u32x4 pk = pack8(v0, v1); if (!(probe_flags & 2)) *(u32x4*)(rowp + bj * 128) = pk; else asm volatile("" :: "v"(pk)); }
            }
        }
    } else {
      const int gi = pn - 18, nb = gi >> 2, colg = (gi & 3) * 256 + wc * 32 + 8 * fq;
      f32x4 bv[2][2];
#pragma unroll
      for (int bj = 0; bj < 2; ++bj) { bv[bj][0] = *(const f32x4*)(bgate + nb * D + colg + bj * 128); bv[bj][1] = *(const f32x4*)(bgate + nb * D + colg + bj * 128 + 4); }
#pragma unroll
      for (int ai = 0; ai < 2; ++ai)
#pragma unroll
        for (int m = 0; m < 4; ++m) { const int r = row0 + ai * 128 + m * 16; const float s = rs[ai][m];
          bf16_t* rowp = GATE + (size_t)r * GATEW + gi * 256 + wc * 32 + 8 * fq;
#pragma unroll
          for (int bj = 0; bj < 2; ++bj) { f32x4 v0 = acc[ai][bj][m][0] * s + bv[bj][0], v1 = acc[ai][bj][m][1] * s + bv[bj][1];
#pragma unroll
            for (int j = 0; j < 4; ++j) { v0[j] = 1.0f + fast_exp2(fminf(-v0[j] * LOG2E, 100.0f)); v1[j] = 1.0f + fast_exp2(fminf(-v1[j] * LOG2E, 100.0f)); }
            { const u32x4 pk = pack8(v0, v1); if (!(probe_flags & 2)) __builtin_nontemporal_store(pk, (u32x4*)(rowp + bj * 128)); else asm volatile("" :: "v"(pk)); } } }
    }
  }
};

template <bool HALFN, bool HALFM = false> struct EpiP3T {
  static constexpr bool PERM = true, HAS_MID = true, HAS_RS = false;
  const bf16_t* GATE; bf16_t* H;
  DI void mid(f32x4 (&acc)[2][2][4][2], const Unit& u, int t, int wr, int wc, int fr, int fq) const {
    const int nb = (t >> 3) - 1;
    const bf16_t* gp = GATE + (size_t)(u.pm * (HALFM ? 128 : 256) + wr * 64 + fr) * GATEW + nb * D + u.pn * (HALFN ? 128 : 256) + wc * 32 + 8 * fq;
#pragma unroll
    for (int ai = 0; ai < (HALFM ? 1 : 2); ++ai) {
        u32x4 ga[4][2] = {}, gb[4][2] = {};
#pragma unroll
        for (int m = 0; m < 4; ++m)
#pragma unroll
          for (int bj = 0; bj < (HALFN ? 1 : 2); ++bj) { const bf16_t* q = gp + (size_t)(ai * 128 + m * 16) * GATEW + bj * 128; ga[m][bj] = *(const u32x4*)q; gb[m][bj] = *(const u32x4*)(q + D); }
#pragma unroll
        for (int m = 0; m < 4; ++m)
#pragma unroll
          for (int bj = 0; bj < (HALFN ? 1 : 2); ++bj)
#pragma unroll
            for (int n = 0; n < 2; ++n) { const unsigned a0 = ga[m][bj][2 * n], a1 = ga[m][bj][2 * n + 1], b0 = gb[m][bj][2 * n], b1 = gb[m][bj][2 * n + 1];
              acc[ai][bj][m][n][0] *= bflo(b0) * fast_rcp(bflo(a0)); acc[ai][bj][m][n][1] *= bfhi(b0) * fast_rcp(bfhi(a0));
              acc[ai][bj][m][n][2] *= bflo(b1) * fast_rcp(bflo(a1)); acc[ai][bj][m][n][3] *= bfhi(b1) * fast_rcp(bfhi(a1)); }
        asm volatile("" ::: "memory"); }
  }
  DI void operator()(f32x4 (&acc)[2][2][4][2], const Unit& u, int wr, int wc, int fr, int fq) const {
    const int row0 = u.pm * (HALFM ? 128 : 256) + wr * 64 + fr, col0 = u.pn * (HALFN ? 128 : 256) + wc * 32 + 8 * fq;
#pragma unroll
    for (int ai = 0; ai < (HALFM ? 1 : 2); ++ai)
#pragma unroll
      for (int m = 0; m < 4; ++m) { const int r = row0 + ai * 128 + m * 16; const bf16_t* gp = GATE + (size_t)r * GATEW + 2 * D + col0; bf16_t* hp = H + (size_t)r * D + col0;
#pragma unroll
        for (int bj = 0; bj < (HALFN ? 1 : 2); ++bj) { const u32x4 g = *(const u32x4*)(gp + bj * 128); f32x4 v0 = acc[ai][bj][m][0], v1 = acc[ai][bj][m][1];
          v0[0] *= fast_rcp(bflo(g[0])); v0[1] *= fast_rcp(bfhi(g[0])); v0[2] *= fast_rcp(bflo(g[1])); v0[3] *= fast_rcp(bfhi(g[1])); v1[0] *= fast_rcp(bflo(g[2])); v1[1] *= fast_rcp(bfhi(g[2])); v1[2] *= fast_rcp(bflo(g[3])); v1[3] *= fast_rcp(bfhi(g[3]));
          *(u32x4*)(hp + bj * 128) = pack8(v0, v1); } }
  }
};

typedef EpiP3T<false> EpiP3;

template <bool HALFN, bool HALFM = false> struct EpiResT {
  static constexpr bool PERM = true, HAS_MID = false, HAS_RS = false;
  float* X32; bf16_t* XB; float* SS; LAS unsigned char* lds; const float* xin_p; const float* xin_s;
  DI void mid(f32x4 (&)[2][2][4][2], const Unit&, int, int, int, int, int) const {}
  DI void operator()(f32x4 (&acc)[2][2][4][2], const Unit& u, int wr, int wc, int fr, int fq) const {
    const int rin0 = wr * 64 + fr, row0 = u.pm * (HALFM ? 128 : 256) + rin0, col0 = u.pn * (HALFN ? 128 : 256) + wc * 32 + 8 * fq;
    LAS float* red = (LAS float*)(lds + 131072 + 8192);
#pragma unroll
    for (int ai = 0; ai < (HALFM ? 1 : 2); ++ai) {
      f32x4 xo[4][2][2] = {};
#pragma unroll
      for (int m = 0; m < 4; ++m) { const int r = row0 + ai * 128 + m * 16;
        if (xin_p) { const float* xr = (r < TOKP ? xin_p + (size_t)r * D : xin_s + (size_t)(r - TOKP) * D) + col0;
#pragma unroll
          for (int bj = 0; bj < (HALFN ? 1 : 2); ++bj)
#pragma unroll
            for (int n = 0; n < 2; ++n) xo[m][bj][n] = *(const f32x4*)(xr + bj * 128 + n * 4);
        } else {
#pragma unroll
          for (int bj = 0; bj < (HALFN ? 1 : 2); ++bj) { const u32x4 w = *(const u32x4*)(XB + (size_t)r * D + col0 + bj * 128);
            xo[m][bj][0] = (f32x4){bflo(w[0]), bfhi(w[0]), bflo(w[1]), bfhi(w[1])}; xo[m][bj][1] = (f32x4){bflo(w[2]), bfhi(w[2]), bflo(w[3]), bfhi(w[3])}; } } }
#pragma unroll
      for (int m = 0; m < 4; ++m) { const int r = row0 + ai * 128 + m * 16; bf16_t* bp = XB + (size_t)r * D + col0; float q = 0.f;
#pragma unroll
        for (int bj = 0; bj < (HALFN ? 1 : 2); ++bj)
          { const f32x4 x0 = xo[m][bj][0] + acc[ai][bj][m][0], x1 = xo[m][bj][1] + acc[ai][bj][m][1];
            *(u32x4*)(bp + bj * 128) = pack8(x0, x1);
            q += ((x0[0] * x0[0] + x0[1] * x0[1]) + (x0[2] * x0[2] + x0[3] * x0[3])) + ((x1[0] * x1[0] + x1[1] * x1[1]) + (x1[2] * x1[2] + x1[3] * x1[3])); }
        q += __shfl_xor(q, 16); q += __shfl_xor(q, 32);
        if (fq == 0) red[(rin0 + ai * 128 + m * 16) * 4 + wc] = q; }
      asm volatile("" ::: "memory"); }
    asm volatile("s_waitcnt lgkmcnt(0)" ::: "memory"); __builtin_amdgcn_s_barrier(); asm volatile("" ::: "memory");
    int t = threadIdx.x; asm volatile("" : "+v"(t));
    if (t < (HALFM ? 128 : 256)) { const f32x4 v = *(const LAS f32x4*)(red + t * 4); const float q = (v[0] + v[1]) + (v[2] + v[3]); float* sp = SS + (size_t)(u.pm * (HALFM ? 128 : 256) + t) * 8;
      if (HALFN) sp[u.pn] = q; else *(f32x2*)(sp + 2 * u.pn) = (f32x2){q, 0.f}; }
  }
};

typedef EpiResT<false> EpiRes;

DI float dpp_ror1(float v) { return __builtin_bit_cast(float, __builtin_amdgcn_update_dpp(0, __builtin_bit_cast(int, v), 0x121, 0xf, 0xf, false)); }
DI float dpp_ror2(float v) { return __builtin_bit_cast(float, __builtin_amdgcn_update_dpp(0, __builtin_bit_cast(int, v), 0x122, 0xf, 0xf, false)); }
DI float gelu_mul(float x, float uv) {
  const float t = __builtin_fmaf(x * x, 2.0f * LOG2E * 0.7978845608028654f * 0.044715f, 2.0f * LOG2E * 0.7978845608028654f);
  const float r = fast_rcp(fast_exp2(x * t) + 1.0f);
  return __builtin_fmaf(-x, r, x) * uv;
}
constexpr size_t SIDE_ROWS = (size_t)72 * 2 * DFF;
template <bool HALFM> struct EpiP5FT {
  static constexpr bool PERM = true, HAS_MID = false, HAS_RS = true;
  const float* SS; bf16_t* HF; float* out; const float* cw; const float* cb; const float* st; float* side; LAS unsigned char* lds; int layer;
  DI void mid(f32x4 (&)[2][2][4][2], const Unit&, int, int, int, int, int) const {}
  DI f32x4 prefetch(const Unit& u, int tid) const {
    f32x4 v = {0.f, 0.f, 0.f, 0.f};
    if (tid < (HALFM ? 128 : 256)) v = ss_load(SS, u.pm * (HALFM ? 128 : 256) + tid);
    else if (tid >= 256 && tid < 384) { int j = tid - 256; asm volatile("" : "+v"(j));
      const int arr = j >> 5, c4 = (j & 31) * 4; v = *(const f32x4*)((arr < 3 ? cw + arr * DFF : cb) + u.pn * 128 + c4); }
    return v;
  }
  DI void stash(const f32x4& v, const Unit& u, int tid, LAS unsigned char* l) const {
    if (tid < (HALFM ? 128 : 256)) *(LAS float*)(l + 131072 + 12288 + tid * 4) = ss_to_rs(v);
    else if (tid >= 256 && tid < 384) *(LAS f32x4*)(l + 131072 + 13312 + (tid - 256) * 16) = v;
  }
  DI void operator()(f32x4 (&acc)[2][2][4][2], const Unit& u, int wr, int wc, int fr_in, int fq_in) const {
    int fr = fr_in, fq = fq_in; asm volatile("" : "+v"(fr), "+v"(fq));
    const int rin0 = wr * 64 + fr, col0 = u.pn * 128 + wc * 32 + 8 * fq;
    const bool sample = HALFM ? true : u.pm >= 64, cont = !sample && (u.pm & 15) != 0;
    const int bd0 = HALFM ? (u.pm - TOKP / 128) * 2 : (u.pm - 64) * 4;
    LAS float* xh = (LAS float*)(lds + 131072);
    float* TAILG = side; float* HEADC = side + SIDE_ROWS; float* HEADU = side + 2 * SIDE_ROWS;
#pragma unroll
    for (int ai = 0; ai < (HALFM ? 1 : 2); ++ai)
#pragma unroll
      for (int m = 0; m < 4; ++m) { const float s = *(const LAS float*)(lds + 131072 + 12288 + (rin0 + ai * 128 + m * 16) * 4);
#pragma unroll
        for (int n = 0; n < 2; ++n) { acc[ai][0][m][n] *= s; acc[ai][1][m][n] *= s; } }
    if (fr >= 14) {
#pragma unroll
      for (int ai = 0; ai < (HALFM ? 1 : 2); ++ai) { const int gidx = 2 * ai + wr; LAS float* xp = xh + ((gidx * 4 + wc) * 2 + (fr - 14)) * 32 + fq * 8;
        *(LAS f32x4*)xp = acc[ai][0][3][0]; *(LAS f32x4*)(xp + 4) = acc[ai][0][3][1];
        float* cp = nullptr;
        if (sample) cp = out + O_SCONV + ((size_t)(layer * DB + bd0 + gidx) * 2 + (fr - 14)) * DFF + col0;
        else if (gidx == 3) { float* tp = TAILG + ((size_t)u.pm * 2 + (fr - 14)) * DFF + col0; *(f32x4*)tp = acc[ai][0][3][0]; *(f32x4*)(tp + 4) = acc[ai][0][3][1];
          if ((u.pm & 15) == 15) cp = out + O_PCONV + ((size_t)(layer * 4 + (u.pm >> 4)) * 2 + (fr - 14)) * DFF + col0; }
        if (cp) { *(f32x4*)cp = acc[ai][0][3][0]; *(f32x4*)(cp + 4) = acc[ai][0][3][1]; } }
    }
    asm volatile("s_waitcnt lgkmcnt(0)" ::: "memory"); __builtin_amdgcn_s_barrier(); asm volatile("" ::: "memory");
#pragma unroll
    for (int n = 0; n < 2; ++n) {
      const LAS float* cl = (const LAS float*)(lds + 131072 + 13312) + wc * 32 + 8 * fq + 4 * n;
      const f32x4 w0 = *(const LAS f32x4*)cl, w1 = *(const LAS f32x4*)(cl + 128), w2 = *(const LAS f32x4*)(cl + 256), bb = *(const LAS f32x4*)(cl + 384);
#pragma unroll
      for (int ai = 0; ai < (HALFM ? 1 : 2); ++ai) { const int gidx = 2 * ai + wr;
        f32x4 gp = {0.f, 0.f, 0.f, 0.f};
        if (fr >= 14) {
          if (sample) gp = *(const f32x4*)(st + ((size_t)(bd0 + gidx) * 2 + (fr - 14)) * DFF + col0 + 4 * n);
          else if (gidx > 0) gp = *(const LAS f32x4*)(xh + (((gidx - 1) * 4 + wc) * 2 + (fr - 14)) * 32 + fq * 8 + 4 * n);
        }
#pragma unroll
        for (int m = 0; m < 4; ++m) { const int rin = rin0 + ai * 128 + m * 16; f32x4 o, cc;
#pragma unroll
          for (int j = 0; j < 4; ++j) { const float g = acc[ai][0][m][n][j], gq = gp[j];
            const float r1g = dpp_ror1(g), r1q = dpp_ror1(gq), r2g = dpp_ror2(g), r2q = dpp_ror2(gq);
            const float p1 = fr >= 1 ? r1g : r1q, p2 = fr >= 2 ? r2g : r2q;
            const float c = __builtin_fmaf(w2[j], g, __builtin_fmaf(w1[j], p1, __builtin_fmaf(w0[j], p2, bb[j])));
            cc[j] = c; o[j] = gelu_mul(c, acc[ai][1][m][n][j]); }
          *(u32x2*)(HF + (size_t)(u.pm * (HALFM ? 128 : 256) + rin) * DFF + col0 + 4 * n) = pack4(o);
          if (cont && gidx == 0 && m == 0 && fr < 2) { *(f32x4*)(HEADC + ((size_t)u.pm * 2 + fr) * DFF + col0 + 4 * n) = cc; *(f32x4*)(HEADU + ((size_t)u.pm * 2 + fr) * DFF + col0 + 4 * n) = acc[ai][1][m][n]; }
          gp = acc[ai][0][m][n]; }
      }
    }
  }
};
typedef EpiP5FT<false> EpiP5F;
DI void p6_fixup_panel(int pm, const float* side, const float* cw, bf16_t* HF) {
  const float* TAILG = side + (size_t)(pm - 1) * 2 * DFF; const float* HEADC = side + SIDE_ROWS + (size_t)pm * 2 * DFF; const float* HEADU = side + 2 * SIDE_ROWS + (size_t)pm * 2 * DFF;
  int tid_ = threadIdx.x; asm volatile("" : "+v"(tid_));
  constexpr int NIT = (DFF + NTHREADS - 1) / NTHREADS;
  float t0[NIT], t1[NIT], a0[NIT], a1[NIT], hc0[NIT], hc1[NIT], hu0[NIT], hu1[NIT];
#pragma unroll
  for (int i = 0; i < NIT; ++i) { const int k = tid_ + i * NTHREADS; const int kk = k < DFF ? k : 0;
    t0[i] = TAILG[kk]; t1[i] = TAILG[DFF + kk]; a0[i] = cw[kk]; a1[i] = cw[DFF + kk]; hc0[i] = HEADC[kk]; hc1[i] = HEADC[DFF + kk]; hu0[i] = HEADU[kk]; hu1[i] = HEADU[DFF + kk]; }
#pragma unroll
  for (int i = 0; i < NIT; ++i) { const int k = tid_ + i * NTHREADS;
    const float c0 = hc0[i] + a0[i] * t0[i] + a1[i] * t1[i], c1 = hc1[i] + a0[i] * t1[i];
    const float h0 = gelu_mul(c0, hu0[i]), h1 = gelu_mul(c1, hu1[i]);
    f32x4 v = {h0, h1, 0.f, 0.f}; const u32x2 pk = pack4(v);
    if (k < DFF) { HF[(size_t)(pm * 256) * DFF + k] = (bf16_t)(pk[0] & 0xffffu); HF[(size_t)(pm * 256 + 1) * DFF + k] = (bf16_t)(pk[0] >> 16); } }
}

struct EpiNull {
  static constexpr bool PERM = true, HAS_MID = false, HAS_RS = false;
  DI void mid(f32x4 (&)[2][2][4][2], const Unit&, int, int, int, int, int) const {}
  DI void operator()(f32x4 (&acc)[2][2][4][2], const Unit& u, int wr, int wc, int fr, int fq) const {
#pragma unroll
    for (int ai = 0; ai < 2; ++ai)
#pragma unroll
      for (int bj = 0; bj < 2; ++bj)
#pragma unroll
        for (int m = 0; m < 4; ++m)
#pragma unroll
          for (int n = 0; n < 2; ++n) asm volatile("" :: "v"(acc[ai][bj][m][n]));
  }
};

DI float gelu_tanh(float x) {
  const float y = 0.7978845608028654f * (x + 0.044715f * x * x * x);
  const float e = fast_exp2(2.0f * LOG2E * y);
  const float th = 1.0f - 2.0f * fast_rcp(e + 1.0f);
  return 0.5f * x * (1.0f + th);
}
DI void pfinal_norm(const Params& p) {
  const bf16_t* XB = (const bf16_t*)(p.ws + WS_XB); const float* SS = (const float*)(p.ws + WS_SS);
  int tid_ = threadIdx.x; asm volatile("" : "+v"(tid_));
  const int lane = tid_ & 63, gw = blockIdx.x * 8 + (tid_ >> 6), NGW = gridDim.x * 8;
#pragma unroll 3
  for (int m = gw; m < TOK; m += NGW) { const float s = row_rs(SS, m);
#pragma unroll
    for (int j = 0; j < 2; ++j) { const u32x4 w = ((const u32x4*)(XB + (size_t)m * D))[lane + 64 * j];
      const f32x4 g0 = ((const f32x4*)p.norm_final)[2 * (lane + 64 * j)], g1 = ((const f32x4*)p.norm_final)[2 * (lane + 64 * j) + 1];
      const f32x4 a = {bflo(w[0]), bfhi(w[0]), bflo(w[1]), bfhi(w[1])}, b = {bflo(w[2]), bfhi(w[2]), bflo(w[3]), bfhi(w[3])};
      f32x4* o = (f32x4*)(p.out + (size_t)m * D) + 2 * (lane + 64 * j);
      __builtin_nontemporal_store(a * s * g0, o); __builtin_nontemporal_store(b * s * g1, o + 1); } }
}

DI pg8::GemmDesc p1_desc(unsigned char* ws, int l) {
  return pg8::GemmDesc{(const char*)(ws + WS_XB), (const char*)(ws + WS_WIN) + (size_t)l * INC * D * 2, D, D, D / 64, (size_t)256 * D * 2, (size_t)128 * D * 2};
}
DI EpiP1 p1_epi(const Params& p, int l, LAS unsigned char* lds) {
  return EpiP1{(const float*)(p.ws + WS_SS), (bf16_t*)(p.ws + WS_QKV), (bf16_t*)(p.ws + WS_GATE), p.b_gate + (size_t)l * 3 * D, p.out, l, 0, lds};
}
namespace attn {
constexpr int N_CPY = 0, N_CS = 128, N_CP = 512, N_AP = 512, N_BP = 512, N_AS = 256, N_BS = 256, NITEMS = N_CPY + N_CS + N_CP + N_AP + N_BP + N_AS + N_BS;
constexpr float STICK_DONE = 8.75651e-27f;

struct Item { int mode, h, tok0, past, q0, nqv, pflags; const float* cK; const float* cV; };

DI Item decode(const Params& p, int layer, int idx) {
  Item it; it.cK = nullptr; it.cV = nullptr; it.past = 0; it.pflags = 0;
  if (idx < N_CPY) { it.mode = 3; it.h = idx; return it; }
  idx -= N_CPY;
  if (idx < N_CS) { const int bd = idx >> 2, h = idx & 3; it.mode = 2; it.h = h; it.tok0 = TOKP + bd * 64; it.past = PAST; it.q0 = PAST; it.nqv = 64;
    it.cK = p.cache_c_k + (size_t)(layer * DB + bd) * PAST * 512 + h * 128; it.cV = p.cache_c_v + (size_t)(layer * DB + bd) * PAST * 512 + h * 128; return it; }
  idx -= N_CS;
  if (idx < N_CP) { const int jj = 31 - (idx >> 4), rem = idx & 15; it.mode = 2; it.h = rem & 3; it.tok0 = (rem >> 2) * SEQ; it.q0 = jj * 128; it.nqv = 128; return it; }
  idx -= N_CP;
  if (idx < N_AP + N_BP) { const int isb = idx >= N_AP; if (isb) idx -= N_AP; const int qt = 15 - (idx >> 5), rem = idx & 31; it.mode = isb; it.h = rem & 7; it.tok0 = (rem >> 3) * SEQ; it.q0 = qt * 256; it.nqv = 256; return it; }
  idx -= N_AP + N_BP;
  if (idx < N_AS) { const int bd = idx >> 3, h = idx & 7; it.mode = 0; it.h = h; it.tok0 = TOKP + bd * 64; it.past = ALEN; it.q0 = ALEN; it.nqv = 64;
    it.cK = p.cache_a_k + (size_t)(layer * DB + bd) * ALEN * 512 + h * 64; it.cV = p.cache_a_v + (size_t)(layer * DB + bd) * ALEN * 512 + h * 64; return it; }
  idx -= N_AS;
  { const int bd = idx >> 3, h = idx & 7; it.mode = 1; it.h = h; it.tok0 = TOKP + bd * 64; it.past = PAST; it.q0 = PAST; it.nqv = 64;
    it.cK = p.cache_b_k + (size_t)(layer * DB + bd) * PAST * 512 + h * 64; it.cV = p.cache_b_v + (size_t)(layer * DB + bd) * PAST * 512 + h * 64; return it; }
}


template <int MODE, bool SAMPLE>
DI void load_piece(u32x4& r0, u32x4& r1, u32x4& r2, u32x4& r3, const Item& it, const float* cache, const bf16_t* QKV, int col, int kt, int tid) {
  constexpr int CPR = MODE == 2 ? 16 : 8;
  const int j0 = kt * 64;
  const int ra = tid / CPR, ca = tid % CPR;
  if (SAMPLE && j0 < it.past) {
    const unsigned lo = (unsigned)(ra * 512 + ca * 8) * 4u; const char* b = (const char*)(cache + (size_t)j0 * 512);
    { const u32x4* q = (const u32x4*)(b + lo); r0 = __builtin_nontemporal_load(q); r1 = __builtin_nontemporal_load(q + 1); }
    if constexpr (MODE == 2) { const u32x4* q = (const u32x4*)(b + (size_t)32 * 512 * 4 + lo); r2 = __builtin_nontemporal_load(q); r3 = __builtin_nontemporal_load(q + 1); }
  } else {
    const unsigned lo = (unsigned)(ra * QKVW + ca * 8) * 2u; const char* b = (const char*)(QKV + (size_t)(it.tok0 + j0 - it.past) * QKVW + col);
    r0 = *(const u32x4*)(b + lo);
    if constexpr (MODE == 2) r2 = *(const u32x4*)(b + (size_t)32 * QKVW * 2 + lo);
  }
}
DI u32x4 cvt8(u32x4 a, u32x4 b) { return pack8(__builtin_bit_cast(f32x4, a), __builtin_bit_cast(f32x4, b)); }
template <int MODE, bool ISK, bool SAMPLE>
DI void write_piece(const u32x4& r0, const u32x4& r1, const u32x4& r2, const u32x4& r3, const Item& it, LAS unsigned char* buf, int kt, int tid) {
  constexpr int CPR = MODE == 2 ? 16 : 8, VS = MODE == 2 ? 320 : 192;
  const bool f32src = SAMPLE && kt * 64 < it.past;
  const int ra = tid / CPR, ca = tid % CPR, rb = (tid + NTHREADS) / CPR, cb = (tid + NTHREADS) % CPR;
  { const u32x4 x = f32src ? cvt8(r0, r1) : r0;
    if (ISK) *(LAS u32x4*)(buf + ((MODE == 2 && ca >= 8) ? 8192 : 0) + ra * 128 + (((ca & 7) ^ ((ra >> 1) & 7)) << 4)) = x;
    else *(LAS u32x4*)(buf + ra * VS + ca * 16) = x; }
  if constexpr (MODE == 2) { const u32x4 x = f32src ? cvt8(r2, r3) : r2;
    if (ISK) *(LAS u32x4*)(buf + (cb >= 8 ? 8192 : 0) + rb * 128 + (((cb & 7) ^ ((rb >> 1) & 7)) << 4)) = x;
    else *(LAS u32x4*)(buf + rb * VS + cb * 16) = x; }
}

template <int MODE>
DI void state_store(const u32x4& r0, const u32x4& r2, float* dst, int tid) {
  constexpr int CPR = MODE == 2 ? 16 : 8;
  const int ra = tid / CPR, ca = tid % CPR, rb = (tid + NTHREADS) / CPR, cb = (tid + NTHREADS) % CPR;
  { float* q = dst + (size_t)ra * 512 + ca * 8;
    __builtin_nontemporal_store((f32x4){bflo(r0[0]), bfhi(r0[0]), bflo(r0[1]), bfhi(r0[1])}, (f32x4*)q); __builtin_nontemporal_store((f32x4){bflo(r0[2]), bfhi(r0[2]), bflo(r0[3]), bfhi(r0[3])}, (f32x4*)(q + 4)); }
  if constexpr (MODE == 2) { float* q = dst + (size_t)rb * 512 + cb * 8;
    __builtin_nontemporal_store((f32x4){bflo(r2[0]), bfhi(r2[0]), bflo(r2[1]), bfhi(r2[1])}, (f32x4*)q); __builtin_nontemporal_store((f32x4){bflo(r2[2]), bfhi(r2[2]), bflo(r2[3]), bfhi(r2[3])}, (f32x4*)(q + 4)); }
}
template <int MODE>
DI float* state_dst(const Params& p, int layer, const Item& it, int kt, int isv) {
  const int hoff = MODE == 2 ? it.h * 128 : it.h * 64;
  if (it.past == 0) {
    const int t0 = kt * 64; if (t0 < it.q0 || t0 >= it.q0 + it.nqv) return nullptr;
    const int b = it.tok0 / SEQ;
    if (MODE == 0) { if (t0 < SEQ - 512) return nullptr; return p.out + (isv ? O_PAV : O_PAK) + ((size_t)(layer * 4 + b) * 512 + (t0 - (SEQ - 512))) * 512 + hoff; }
    return p.out + (MODE == 1 ? (isv ? O_PBV : O_PBK) : (isv ? O_PCV : O_PCK)) + ((size_t)(layer * 4 + b) * SEQ + t0) * 512 + hoff;
  } else {
    if (kt * 64 != it.past) return nullptr;
    const int bd = (it.tok0 - TOKP) / 64;
    if (MODE == 0) return p.out + (isv ? O_SAV : O_SAK) + ((size_t)(layer * DB + bd) * 512 + 448) * 512 + hoff;
    return p.out + (MODE == 1 ? (isv ? O_SBV : O_SBK) : (isv ? O_SCV : O_SCK)) + ((size_t)(layer * DB + bd) * 64) * 512 + hoff;
  }
}

DI void roll_store(const u32x4& r0, const u32x4& r1, const Params& p, int layer, const Item& it, int kt, int isv, int tid) {
  if (kt < 1 || kt * 64 >= it.past) return;
  const int bd = (it.tok0 - TOKP) / 64, ra = tid >> 3, ca = tid & 7;
  float* q = p.out + (isv ? O_SAV : O_SAK) + ((size_t)(layer * DB + bd) * 512 + (kt - 1) * 64 + ra) * 512 + it.h * 64 + ca * 8;
  __builtin_nontemporal_store(__builtin_bit_cast(f32x4, r0), (f32x4*)q); __builtin_nontemporal_store(__builtin_bit_cast(f32x4, r1), (f32x4*)(q + 4));
}
DI bf16x8 pack_p(const f32x16& x, int s) {
  const f32x4 a = {x[8 * s], x[8 * s + 1], x[8 * s + 2], x[8 * s + 3]}, b = {x[8 * s + 4], x[8 * s + 5], x[8 * s + 6], x[8 * s + 7]};
  return __builtin_bit_cast(bf16x8, pack8(a, b));
}
#define MFMA32(a, b, c) __builtin_amdgcn_mfma_f32_32x32x16_bf16((a), (b), (c), 0, 0, 0)

constexpr int L_KB = 0, KB_BYTES = 16384, L_VB = 32768, VB_BYTES = 20480, L_LUT = 73728, L_FLAGS = 75776, L_XCH = 81920;

template <int MODE, bool SAMPLE>
DI void run_item(const Params& p, int layer, const Item& it, LAS unsigned char* lds_in) {
  LAS unsigned char* lds = opaque_lds(lds_in);
  constexpr int NDV = MODE == 2 ? 4 : 2, VS = MODE == 2 ? 320 : 192;
  int tid_ = threadIdx.x; asm volatile("" : "+v"(tid_));
  const int tid = tid_, lane = tid & 63, wave = __builtin_amdgcn_readfirstlane(tid >> 6);
  const int qi = lane & 31, h2 = lane >> 5;
  const int mp = MODE == 2 ? (wave >> 2) : 0, wrow = MODE == 2 ? (wave & 3) : wave;
  const int q0w = it.q0 + 32 * wrow;
  const bool active = 32 * wrow < it.nqv;
  const bf16_t* QKV = (const bf16_t*)(p.ws + WS_QKV);
  const int hb = MODE == 2 ? it.h * 128 : it.h * 64;
  const int qcol = (MODE == 0 ? 0 : MODE == 1 ? 1536 : 3072) + hb + 64 * mp, kcol = (MODE == 0 ? 512 : MODE == 1 ? 2048 : 3584) + hb, vcol = (MODE == 0 ? 1024 : MODE == 1 ? 2560 : 4096) + hb;
  const int cw = q0w >> 6;
  int kt_first, step, NT;
  if (MODE == 0) { kt_first = (it.q0 >> 6) - 8; if (kt_first < 0) kt_first = 0; step = 1; NT = ((it.q0 + it.nqv - 1) >> 6) - kt_first + 1; }
  else if (MODE == 2) { kt_first = 0; step = 1; NT = ((it.q0 + it.nqv - 1) >> 6) + 1; }
  else { kt_first = (it.q0 + it.nqv - 2) >> 6; step = -1; NT = kt_first + 1; }
  const bool wr_state = it.pflags == 0;
  u32x4 k0 = {}, k1 = {}, k2 = {}, k3 = {}, v0 = {}, v1 = {}, v2 = {}, v3 = {};
  load_piece<MODE, SAMPLE>(k0, k1, k2, k3, it, it.cK, QKV, kcol, kt_first, tid);
  load_piece<MODE, SAMPLE>(v0, v1, v2, v3, it, it.cV, QKV, vcol, kt_first, tid);
  LAS float* lut = (LAS float*)(lds + L_LUT);
  LAS unsigned* flags = (LAS unsigned*)(lds + L_FLAGS);
  if (MODE == 0) { const float bfar = p.a_rel_bias[((size_t)layer * 257 + 256) * 8 + it.h]; for (int i = tid; i < 257; i += NTHREADS) lut[i] = p.a_rel_bias[((size_t)layer * 257 + i) * 8 + it.h] - bfar; }
  if (MODE == 2) { if (tid < 192) lut[tid] = ((const float*)(p.ws + WS_CTL))[CW_T5 + it.h * 192 + tid]; }
  bf16x8 qf[4];
  if (active) { const bf16_t* qp = QKV + (size_t)(it.tok0 + q0w + qi - it.past) * QKVW + qcol + 8 * h2;
#pragma unroll
    for (int s = 0; s < 4; ++s) { const u32x4 w = *(const u32x4*)(qp + 16 * s);
      const f32x4 a = {bflo(w[0]) * 0.125f, bfhi(w[0]) * 0.125f, bflo(w[1]) * 0.125f, bfhi(w[1]) * 0.125f}, b = {bflo(w[2]) * 0.125f, bfhi(w[2]) * 0.125f, bflo(w[3]) * 0.125f, bfhi(w[3]) * 0.125f};
      qf[s] = __builtin_bit_cast(bf16x8, pack8(a, b)); } }
  f32x16 O[NDV];
#pragma unroll
  for (int b = 0; b < NDV; ++b)
#pragma unroll
    for (int i = 0; i < 16; ++i) O[b][i] = 0.f;
  float m_run = -1e30f, l_run = 0.f, R2 = 1.0f; bool done = false, have_p = false;
  bf16x8 pf[4];
#pragma unroll
  for (int s = 0; s < 4; ++s) pf[s] = (bf16x8){0, 0, 0, 0, 0, 0, 0, 0};
  const int krow_off = qi * 128, kswz = (qi >> 1) & 7;
  const int g16 = lane >> 4, trq = (lane & 15) >> 2, trp = lane & 3;
  const int vtr_off = (4 * (g16 >> 1) + trq) * VS + (16 * (g16 & 1) + 4 * trp) * 2;

  write_piece<MODE, true, SAMPLE>(k0, k1, k2, k3, it, lds + L_KB, kt_first, tid);
  if (wr_state) { float* d = state_dst<MODE>(p, layer, it, kt_first, 0); if (d) state_store<MODE>(k0, k2, d, tid); }
  if (MODE == 0 && SAMPLE && wr_state) roll_store(k0, k1, p, layer, it, kt_first, 0, tid);
  if (NT > 1) load_piece<MODE, SAMPLE>(k0, k1, k2, k3, it, it.cK, QKV, kcol, kt_first + step, tid);
  for (int t = 0;; ++t) {
    __syncthreads();
    if (MODE == 1 && t > 0 && t < NT) { const unsigned any = flags[0] | flags[1] | flags[2] | flags[3] | flags[4] | flags[5] | flags[6] | flags[7]; if (!any) NT = t; }
    const int kt = kt_first + step * t;
    bool mine = false;
    if (t < NT && !(it.pflags & 2)) {
      if (MODE == 0) mine = active && kt >= cw - 8 && kt <= cw;
      else if (MODE == 2) mine = active && kt <= cw;
      else mine = active && !done && kt * 64 <= q0w + 30;
    }
    LAS unsigned char* vb = lds + L_VB + ((t - 1) & 1) * VB_BYTES + vtr_off;
    LAS unsigned char* kb = lds + L_KB + (t & 1) * KB_BYTES + ((MODE == 2 && mp) ? 8192 : 0);
    constexpr int HB = NDV / 2, NST = 4 * HB;
    bf16x8 kfa[4], vfa[2], vfb[2];
    const bool do_pv = have_p && !(it.pflags & 8);
#define V_LOAD(dst, j_) do { if (do_pv) { _Pragma("unroll") for (int bb = 0; bb < 2; ++bb) { const int a0 = 16 * ((j_) / HB) * VS + 64 * (2 * ((j_) % HB) + bb); \
      const s16x4 lo = __builtin_amdgcn_ds_read_tr16_b64_v4i16((LAS s16x4*)(vb + a0)), hi = __builtin_amdgcn_ds_read_tr16_b64_v4i16((LAS s16x4*)(vb + a0 + 8 * VS)); \
      dst[bb] = __builtin_shufflevector(lo, hi, 0, 1, 2, 3, 4, 5, 6, 7); } } } while (0)
#define V_MMA(src, j_) do { if (do_pv) { _Pragma("unroll") for (int bb = 0; bb < 2; ++bb) O[2 * ((j_) % HB) + bb] = MFMA32(src[bb], pf[(j_) / HB], O[2 * ((j_) % HB) + bb]); } } while (0)
#define STG(j_, cur, nxt) do { if (SAMPLE) { V_LOAD(cur, j_); V_MMA(cur, j_); } else { if ((j_) + 1 < NST) V_LOAD(nxt, (j_) + 1); V_MMA(cur, j_); } } while (0)
    if (!SAMPLE) {
      if (mine) {
#pragma unroll
        for (int s = 0; s < 4; ++s) kfa[s] = *(const LAS bf16x8*)(kb + krow_off + (((2 * s + h2) ^ kswz) << 4)); }
      V_LOAD(vfa, 0);
      __builtin_amdgcn_sched_barrier(0);
    }
    if (t < NT && !(it.pflags & 1)) { write_piece<MODE, false, SAMPLE>(v0, v1, v2, v3, it, lds + L_VB + (t & 1) * VB_BYTES, kt_first + step * t, tid);
      if (wr_state) { float* d = state_dst<MODE>(p, layer, it, kt_first + step * t, 1); if (d) state_store<MODE>(v0, v2, d, tid); }
      if (MODE == 0 && SAMPLE && wr_state) roll_store(v0, v1, p, layer, it, kt_first + step * t, 1, tid);
      if (t + 1 < NT) { write_piece<MODE, true, SAMPLE>(k0, k1, k2, k3, it, lds + L_KB + ((t + 1) & 1) * KB_BYTES, kt_first + step * (t + 1), tid);
        if (wr_state) { float* d = state_dst<MODE>(p, layer, it, kt_first + step * (t + 1), 0); if (d) state_store<MODE>(k0, k2, d, tid); }
        if (MODE == 0 && SAMPLE && wr_state) roll_store(k0, k1, p, layer, it, kt_first + step * (t + 1), 0, tid);
        load_piece<MODE, SAMPLE>(v0, v1, v2, v3, it, it.cV, QKV, vcol, kt_first + step * (t + 1), tid);
        if (t + 2 < NT) load_piece<MODE, SAMPLE>(k0, k1, k2, k3, it, it.cK, QKV, kcol, kt_first + step * (t + 2), tid); } }
    __builtin_amdgcn_sched_barrier(0);
    f32x16 sA, sB;
#pragma unroll
    for (int i = 0; i < 16; ++i) { sA[i] = 0.f; sB[i] = 0.f; }
    if (mine) {
      bf16x8 kfc[4];
      if (SAMPLE) {
#pragma unroll
        for (int s = 0; s < 4; ++s) kfa[s] = *(const LAS bf16x8*)(kb + krow_off + (((2 * s + h2) ^ kswz) << 4)); }
#pragma unroll
      for (int s = 0; s < 4; ++s) kfc[s] = *(const LAS bf16x8*)(kb + 4096 + krow_off + (((2 * s + h2) ^ kswz) << 4));
#pragma unroll
      for (int s = 0; s < 4; ++s) sA = MFMA32(kfa[s], qf[s], sA);
#pragma unroll
      for (int s = 0; s < 4; ++s) sB = MFMA32(kfc[s], qf[s], sB);
    }
    const int kbase = kt * 64 + 4 * h2;
    if (MODE != 1) {
      float mx = -1e30f, alpha = 1.0f, lsa = 0.f, lsb = 0.f; bool resc = false;
      const bool smx = mine && !(it.pflags & 4);
      STG(0, vfa, vfb);
      if (NST == 8) STG(1, vfb, vfa);
      if (smx) {
        bool cst;
        if (MODE == 0) cst = q0w - (kt * 64 + 63) >= 128; else cst = kt * 64 + 63 - q0w <= -127;
        if (!cst) {
#pragma unroll
          for (int i = 0; i < 16; ++i) { const int ko = (i & 3) + 8 * (i >> 2);
            int ia, ib;
            if (MODE == 0) { const int d = (q0w + qi) - (kbase + ko); ia = d; ib = d - 32; ia = (ia < -128 ? -128 : ia > 128 ? 128 : ia) + 128; ib = (ib < -128 ? -128 : ib > 128 ? 128 : ib) + 128; }
            else { const int d = (kbase + ko) - (q0w + qi); ia = d; ib = d + 32; ia = (ia < -127 ? -127 : ia > 63 ? 63 : ia) + 127; ib = (ib < -127 ? -127 : ib > 63 ? 63 : ib) + 127; }
            sA[i] += lut[ia]; sB[i] += lut[ib]; }
        }
        float m0 = fmaxf(fmaxf(sA[0], sA[1]), sA[2]), m1 = fmaxf(fmaxf(sB[0], sB[1]), sB[2]);
#pragma unroll
        for (int i = 3; i < 15; i += 2) { m0 = fmaxf(fmaxf(m0, sA[i]), sA[i + 1]); m1 = fmaxf(fmaxf(m1, sB[i]), sB[i + 1]); }
        mx = fmaxf(fmaxf(m0, m1), fmaxf(sA[15], sB[15]));
      }
      __builtin_amdgcn_sched_barrier(0);
      if (NST == 8) { STG(2, vfa, vfb); STG(3, vfb, vfa); } else STG(1, vfb, vfa);
      if (smx) {
        mx = fmaxf(mx, __shfl_xor(mx, 32)) * LOG2E;
        resc = !__all(mx <= m_run + 8.0f);
        if (resc) { const float mnew = fmaxf(m_run, mx); alpha = fast_exp2(m_run - mnew); m_run = mnew; l_run *= alpha; }
#pragma unroll
        for (int i = 0; i < 16; ++i) { sA[i] = fast_exp2(__builtin_fmaf(sA[i], LOG2E, -m_run)); lsa += sA[i]; }
      }
      __builtin_amdgcn_sched_barrier(0);
      if (NST == 8) { STG(4, vfa, vfb); STG(5, vfb, vfa); } else STG(2, vfa, vfb);
      if (smx) {
#pragma unroll
        for (int i = 0; i < 16; ++i) { sB[i] = fast_exp2(__builtin_fmaf(sB[i], LOG2E, -m_run)); lsb += sB[i]; }
        l_run += lsa + lsb;
      }
      __builtin_amdgcn_sched_barrier(0);
      if (NST == 8) { STG(6, vfa, vfb); STG(7, vfb, vfa); } else STG(3, vfb, vfa);
      __builtin_amdgcn_sched_barrier(0);
      if (mine) {
        if (resc) {
#pragma unroll
        for (int b = 0; b < NDV; ++b)
#pragma unroll
          for (int i = 0; i < 16; ++i) O[b][i] *= alpha;
        }
        pf[0] = pack_p(sA, 0); pf[1] = pack_p(sA, 1); pf[2] = pack_p(sB, 0); pf[3] = pack_p(sB, 1);
      }
    } else {
      STG(0, vfa, vfb); STG(1, vfb, vfa); STG(2, vfa, vfb); STG(3, vfb, vfa);
      if (mine) {
        const bool diag = kt * 64 + 63 >= q0w;
        float kpA[16], kpB[16];
#pragma unroll
        for (int i = 0; i < 16; ++i) { const int ko = (i & 3) + 8 * (i >> 2);
          { const float r = fast_rcp(1.0f + fast_exp2(sA[i] * LOG2E)); const bool ok = !diag || (kbase + ko) < (q0w + qi); kpA[i] = ok ? r : 1.0f; sA[i] = ok ? 1.0f - r : 0.0f; }
          { const float r = fast_rcp(1.0f + fast_exp2(sB[i] * LOG2E)); const bool ok = !diag || (kbase + 32 + ko) < (q0w + qi); kpB[i] = ok ? r : 1.0f; sB[i] = ok ? 1.0f - r : 0.0f; } }
        float gs[8], pg[8];
#pragma unroll
        for (int g = 0; g < 4; ++g) { gs[g] = (kpA[4 * g] * kpA[4 * g + 1]) * (kpA[4 * g + 2] * kpA[4 * g + 3]); gs[4 + g] = (kpB[4 * g] * kpB[4 * g + 1]) * (kpB[4 * g + 2] * kpB[4 * g + 3]); }
#pragma unroll
        for (int g = 0; g < 8; ++g) pg[g] = __shfl_xor(gs[g], 32);
        float suf = R2;
#pragma unroll
        for (int g = 7; g >= 0; --g) { const float off = suf * (h2 == 0 ? pg[g] : 1.0f);
          if (g >= 4) { const int b = 4 * (g - 4); const float a3 = off, a2 = a3 * kpB[b + 3], a1 = a2 * kpB[b + 2], a0 = a1 * kpB[b + 1];
            sB[b + 3] *= a3; sB[b + 2] *= a2; sB[b + 1] *= a1; sB[b] *= a0; }
          else { const int b = 4 * g; const float a3 = off, a2 = a3 * kpA[b + 3], a1 = a2 * kpA[b + 2], a0 = a1 * kpA[b + 1];
            sA[b + 3] *= a3; sA[b + 2] *= a2; sA[b + 1] *= a1; sA[b] *= a0; }
          suf *= gs[g] * pg[g]; }
        R2 = suf;
        done = __all(R2 < STICK_DONE) != 0;
        pf[0] = pack_p(sA, 0); pf[1] = pack_p(sA, 1); pf[2] = pack_p(sB, 0); pf[3] = pack_p(sB, 1);
      }
    }
#undef V_LOAD
#undef V_MMA
#undef STG
    have_p = mine;
    if (MODE == 1 && t < NT) { if (lane == 0) flags[wave] = (active && !done && kt > 0 && (kt - 1) * 64 <= q0w + 30) ? 1u : 0u; }
    if (t >= NT) break;
  }
  int lane_e = lane; asm volatile("" : "+v"(lane_e));
  const int qi_e = lane_e & 31, h2_e = lane_e >> 5;
  bf16_t* Ob = (bf16_t*)(p.ws + WS_O);
  const int ocol = MODE == 0 ? hb : MODE == 1 ? 512 + hb : 1024 + hb;
  const bool wr_out = it.pflags == 0;
  if (MODE != 2) {
    if (active && wr_out) { float sc = 1.f; if (MODE == 0) { const float lt = l_run + __shfl_xor(l_run, 32); sc = fast_rcp(lt); }
      bf16_t* op = Ob + (size_t)(it.tok0 + q0w + qi_e - it.past) * OW + ocol + 4 * h2_e;
#pragma unroll
      for (int b = 0; b < NDV; ++b)
#pragma unroll
        for (int g = 0; g < 4; ++g) { const f32x4 v = {O[b][4 * g] * sc, O[b][4 * g + 1] * sc, O[b][4 * g + 2] * sc, O[b][4 * g + 3] * sc}; *(u32x2*)(op + 32 * b + 8 * g) = pack4(v); } }
    __syncthreads();
  } else {
    const float lam = ((const float*)(p.ws + WS_CTL))[CW_LAM + layer];
    const float sub_scale = 1.0f - (0.8f - 0.6f * expf(-0.3f * (float)layer));
    LAS float* xch = (LAS float*)(lds + L_XCH);
    if (active && mp == 1) { const float lt = l_run + __shfl_xor(l_run, 32), sc = lam * fast_rcp(lt);
#pragma unroll
      for (int b = 0; b < NDV; ++b)
#pragma unroll
        for (int i = 0; i < 16; ++i) xch[((wave & 3) * 64 + b * 16 + i) * 64 + lane_e] = O[b][i] * sc; }
    __syncthreads();
    if (active && mp == 0 && wr_out) { const float lt = l_run + __shfl_xor(l_run, 32), sc = fast_rcp(lt); float q = 0.f;
#pragma unroll
      for (int b = 0; b < NDV; ++b)
#pragma unroll
        for (int i = 0; i < 16; ++i) { const float o = O[b][i] * sc - xch[((wave & 3) * 64 + b * 16 + i) * 64 + lane_e]; O[b][i] = o; q += o * o; if ((i & 7) == 7) __builtin_amdgcn_sched_barrier(0); }
      q += __shfl_xor(q, 32);
      const float rstd = __builtin_amdgcn_rsqf(q * (1.0f / 128.0f) + EPS) * sub_scale;
      const float* gain = p.c_subln + layer * 128 + 4 * h2_e;
      bf16_t* op = Ob + (size_t)(it.tok0 + q0w + qi_e - it.past) * OW + ocol + 4 * h2_e;
#pragma unroll
      for (int b = 0; b < NDV; ++b)
#pragma unroll
        for (int g = 0; g < 4; ++g) { const f32x4 gn = *(const f32x4*)(gain + 32 * b + 8 * g);
          const f32x4 v = {O[b][4 * g] * rstd * gn[0], O[b][4 * g + 1] * rstd * gn[1], O[b][4 * g + 2] * rstd * gn[2], O[b][4 * g + 3] * rstd * gn[3]}; *(u32x2*)(op + 32 * b + 8 * g) = pack4(v); } }
    __syncthreads();
  }
}

DI void copy_item(const Params& p, int layer, int idx) {
  const int which = idx >> 5, bd = idx & 31;
  const size_t lb = (size_t)layer * DB + bd;
  const f32x4* src = (const f32x4*)((which ? p.cache_a_v : p.cache_a_k) + lb * 512 * 512 + 64 * 512);
  f32x4* dst = (f32x4*)(p.out + (which ? O_SAV : O_SAK) + lb * 512 * 512);
  int tid_ = threadIdx.x; asm volatile("" : "+v"(tid_));
#pragma unroll 4
  for (int i = tid_; i < 448 * 128; i += NTHREADS) __builtin_nontemporal_store(__builtin_nontemporal_load(src + i), dst + i);
}
#ifndef PROBE_ATT_FLAGS
#define PROBE_ATT_FLAGS 0
#endif
#ifndef PROBE_ATT_LO
#define PROBE_ATT_LO 0
#define PROBE_ATT_HI NITEMS
#endif
DI void attn_phase(const Params& p, int qidx, LAS unsigned char* lds) {
  const int layer = qidx & 1; const int i_lo = qidx >= 2 ? PROBE_ATT_LO : 0, i_hi = qidx >= 2 ? PROBE_ATT_HI : NITEMS;
  unsigned* head = (unsigned*)(p.ws + WS_CTL) + CW_QUEUE + 64 * qidx;
  LAS unsigned* slot = (LAS unsigned*)(lds + LDS_BYTES - 48);
  if (threadIdx.x == 0) slot[0] = atomicAdd(head, 1u);
  for (int k = 0;; ++k) {
    __syncthreads();
    const int idx = __builtin_amdgcn_readfirstlane((int)slot[k & 1]) + i_lo;
    if (threadIdx.x == 0) slot[(k + 1) & 1] = atomicAdd(head, 1u);
    if (idx >= i_hi) break;
    Item it = decode(p, layer, idx); it.pflags = qidx >= 2 ? PROBE_ATT_FLAGS : 0;
    if (it.mode == 3) { if (qidx < 2) copy_item(p, layer, it.h); continue; }
    if (it.past == 0) { if (it.mode == 0) run_item<0, false>(p, layer, it, lds); else if (it.mode == 1) run_item<1, false>(p, layer, it, lds); else run_item<2, false>(p, layer, it, lds); }
    else { if (it.mode == 0) run_item<0, true>(p, layer, it, lds); else if (it.mode == 1) run_item<1, true>(p, layer, it, lds); else run_item<2, true>(p, layer, it, lds); }
  }
}
}
#define XB_TMO      128
#define XB_XCNT(j)  (256  + 64 * (j))
#define XB_XSUB(j)  (1280 + 64 * (j))
#define XB_XGEN(j)  (2304 + 64 * (j))
#define XB_TOP      3328
#define XB_TOPGEN   3392
#define XCD_BAR_WORDS 3456
#define XB_SPIN_CAP (1u << 18)
DI unsigned xb_ld(unsigned* p)              { return __hip_atomic_load(p, __ATOMIC_RELAXED, __HIP_MEMORY_SCOPE_AGENT); }
DI unsigned xb_add(unsigned* p, unsigned v) { return __hip_atomic_fetch_add(p, v, __ATOMIC_RELAXED, __HIP_MEMORY_SCOPE_AGENT); }
DI unsigned xb_xcc_id() { return (unsigned)__builtin_amdgcn_s_getreg((3 << 11) | 20) & 0xFu; }
#define XB_SPIN(cond, bar) do { unsigned _sp = 0; while (cond) { __builtin_amdgcn_s_sleep(1); \
    if ((++_sp & 255u) == 0u) { if (xb_ld(&(bar)[XB_TMO])) break; if (_sp > XB_SPIN_CAP) { atomicAdd(&(bar)[XB_TMO], 1u); break; } } } } while (0)
struct XcdBarrier { unsigned* bar; unsigned x; volatile LAS unsigned* st; };
DI XcdBarrier xcd_barrier_post(unsigned* bar, volatile LAS unsigned* st) {
  XcdBarrier b; b.bar = bar; b.x = xb_xcc_id(); b.st = st;
  if (threadIdx.x == 0) (void)xb_add(&bar[XB_XCNT(b.x)], 1u);
  return b;
}
DI void xcd_barrier_complete(unsigned* bar, unsigned x, unsigned& nloc, unsigned& nx) {
  const unsigned G = gridDim.x * gridDim.y * gridDim.z;
  unsigned sum, cnt, mine, sp = 0u;
  for (;;) {
    sum = 0u; cnt = 0u; mine = 0u;
#pragma unroll
    for (unsigned j = 0; j < 16; ++j) { const unsigned c = xb_ld(&bar[XB_XCNT(j)]); sum += c; cnt += (c > 0u) ? 1u : 0u; mine = (j == x) ? c : mine; }
    if (sum == G) break;
    __builtin_amdgcn_s_sleep(1);
    if ((++sp & 255u) == 0u) { if (xb_ld(&bar[XB_TMO])) break; if (sp > XB_SPIN_CAP) { atomicAdd(&bar[XB_TMO], 1u); break; } }
  }
  nloc = mine > 0u ? mine : 1u; nx = cnt > 0u ? cnt : 1u;
}
DI void xcd_barrier(const XcdBarrier& b) {
  asm volatile("s_waitcnt vmcnt(0)" ::: "memory");
  __syncthreads();
  if (threadIdx.x == 0) {
    unsigned* bar = b.bar;
    __builtin_amdgcn_s_waitcnt(0);
    unsigned nloc = b.st[0], nx = b.st[1];
    if (nloc == 0u) { xcd_barrier_complete(bar, b.x, nloc, nx); b.st[0] = nloc; b.st[1] = nx; }
    const unsigned old = xb_add(&bar[XB_XSUB(b.x)], 1u);
    const unsigned gen = old / nloc;
    if (old + 1u == (gen + 1u) * nloc) {
      __builtin_amdgcn_fence(__ATOMIC_RELEASE, "agent");
      asm volatile("s_waitcnt vmcnt(0)" ::: "memory");
      const unsigned og = xb_add(&bar[XB_TOP], 1u);
      const unsigned tg = og / nx;
      if (og + 1u == (tg + 1u) * nx) xb_add(&bar[XB_TOPGEN], 1u);
      else XB_SPIN(xb_ld(&bar[XB_TOPGEN]) == tg, bar);
      __builtin_amdgcn_fence(__ATOMIC_ACQUIRE, "agent");
      xb_add(&bar[XB_XGEN(b.x)], 1u);
      asm volatile("s_waitcnt vmcnt(0)" ::: "memory");
    } else {
      XB_SPIN(xb_ld(&bar[XB_XGEN(b.x)]) == gen, bar);
      __builtin_amdgcn_fence(__ATOMIC_ACQUIRE, "agent");
      asm volatile("s_waitcnt vmcnt(0)" ::: "memory");
    }
  }
  __syncthreads();
}
constexpr int L_BARST = LDS_BYTES - 64;

#ifndef PROBE_P1_FLAGS
#define PROBE_P1_FLAGS 0
#endif
#ifndef PROBE_NULL_EPI
#define PROBE_NULL_EPI 0
#endif
#ifndef PROBE_MASK
#define PROBE_MASK 0
#endif
#define REPEAT(k) for (int rep_ = 0; rep_ < (((PROBE_MASK >> (k)) & 1) ? 2 : 1); ++rep_)
constexpr int NPHASE = 2 + 6 * NLAYER;
__global__ void __launch_bounds__(NTHREADS, 2) fwd_megakernel(Params p_k) {
  extern __shared__ __attribute__((aligned(16))) unsigned char lds_raw[];
  LAS unsigned char* lds = (LAS unsigned char*)lds_raw;
  cg::grid_group grid = cg::this_grid();
  const int lo = p_k.ph_lo, hi = p_k.ph_hi;
#define IN(k) (lo <= (k) && (k) < hi)
#define SEAM(k) do { if (IN(k) && IN((k) + 1)) xcd_barrier(bar); } while (0)
  const int G = gridDim.x, c = blockIdx.x;
  if (threadIdx.x < 2) ((LAS unsigned*)(lds + L_BARST))[threadIdx.x] = 0u;
  XcdBarrier bar; bar.bar = (unsigned*)(p_k.ws + WS_CTL) + CW_BAR; bar.x = 0; bar.st = (volatile LAS unsigned*)(lds + L_BARST);
  if (p_k.ph_lo < 0) grid.sync();
  bar = xcd_barrier_post((unsigned*)(p_k.ws + WS_CTL) + CW_BAR, (volatile LAS unsigned*)(lds + L_BARST));
  if (IN(0)) { p0_prologue(p_k, lds); if ((PROBE_MASK >> 6) & 1) { __syncthreads(); p0_prologue(p_k, lds); } }
  SEAM(0);
  for (int l = 0; l < NLAYER; ++l) {
    const int pb = 1 + 6 * l;
    const Params& p = p_k; unsigned char* ws = p.ws;
    if (IN(pb + 0)) REPEAT(0) {
      pg8::GemmDesc g{(const char*)(ws + WS_XB), (const char*)(ws + WS_WIN) + (size_t)l * INC * D * 2, D, D, D / 64, (size_t)256 * D * 2, (size_t)128 * D * 2};
      pg8::P1Order S; S.R1.init(TOK / 256, pg8::P1_NN, G, c);
      EpiP1 E{(const float*)(ws + WS_SS), (bf16_t*)(ws + WS_QKV), (bf16_t*)(ws + WS_GATE), p.b_gate + (size_t)l * 3 * D, p.out, l, rep_ == 1 ? PROBE_P1_FLAGS : 0, lds};
#if PROBE_NULL_EPI
      if (rep_ == 1) { EpiNull EN; pg8::gemm_phase<EpiNull, false, false, pg8::P1Order>(lds, g, S, EN); } else
#endif
      pg8::gemm_phase<EpiP1, false, false, pg8::P1Order>(lds, g, S, E);
    }
    SEAM(pb + 0);
    if (IN(pb + 1)) REPEAT(1) {
      for (int j = G - 1 - c; j < pg8::P1_DEFER; j += G) { pg8::OneUnit S1; S1.u = pg8::p1_deferred_unit(j);
        pg8::gemm_phase<EpiP1, false, false, pg8::OneUnit>(lds, p1_desc(ws, l), S1, p1_epi(p, l, lds)); }
      attn::attn_phase(p, l + 2 * rep_, lds); }
    SEAM(pb + 1);
    if (IN(pb + 2)) REPEAT(2) {
      pg8::GemmDesc g{(const char*)(ws + WS_O), (const char*)(ws + WS_WBR) + (size_t)l * D * OW * 2, OW, OW, OW / 64, (size_t)256 * OW * 2, (size_t)128 * OW * 2};
      pg8::StaticOrder S; S.init(TOKP / 256, D / 256, G, c);
      EpiP3 E{(const bf16_t*)(ws + WS_GATE), (bf16_t*)(ws + WS_H)};
      pg8::gemm_phase<EpiP3>(lds, g, S, E);
      pg8::GemmDesc gh = g; gh.b_tile = (size_t)128 * OW * 2;
      pg8::StaticOrder S2; S2.init(TOKS / 128, D / 128, G, c, TOKP / 128);
      EpiP3T<true, true> E2{(const bf16_t*)(ws + WS_GATE), (bf16_t*)(ws + WS_H)};
      pg8::gemm_phase<EpiP3T<true, true>, true, true>(lds, gh, S2, E2);
    }
    SEAM(pb + 2);
    if (IN(pb + 3)) {
      pg8::GemmDesc g{(const char*)(ws + WS_H), (const char*)(ws + WS_WOUT) + (size_t)l * D * D * 2, D, D, D / 64, (size_t)256 * D * 2, (size_t)128 * D * 2};
      pg8::StaticOrder S; S.init(TOKP / 256, D / 256, G, c);
      EpiRes E{(float*)(ws + WS_X32), (bf16_t*)(ws + WS_XB), (float*)(ws + WS_SS), lds, l == 0 ? p.x_prompt : nullptr, l == 0 ? p.x_sample : nullptr};
      pg8::gemm_phase<EpiRes>(lds, g, S, E);
      pg8::GemmDesc gh = g; gh.b_tile = (size_t)128 * D * 2;
      pg8::StaticOrder S2; S2.init(TOKS / 128, D / 128, G, c, TOKP / 128);
      EpiResT<true, true> E2{(float*)(ws + WS_X32), (bf16_t*)(ws + WS_XB), (float*)(ws + WS_SS), lds, l == 0 ? p.x_prompt : nullptr, l == 0 ? p.x_sample : nullptr};
      pg8::gemm_phase<EpiResT<true, true>, true, true>(lds, gh, S2, E2);
    }
    SEAM(pb + 3);
    if (IN(pb + 4)) REPEAT(4) {
      pg8::GemmDesc g{(const char*)(ws + WS_XB), (const char*)(ws + WS_WUP) + (size_t)l * 2 * DFF * D * 2, D, D, D / 64, (size_t)128 * D * 2, (size_t)DFF * D * 2};
      pg8::StaticOrder S; S.init(TOKP / 256, DFF / 128, G, c);
      EpiP5F E{(const float*)(ws + WS_SS), (bf16_t*)(ws + WS_HF), p.out, p.conv_w + (size_t)l * 3 * DFF, p.conv_b + (size_t)l * DFF, p.state_conv + (size_t)l * DB * 2 * DFF, (float*)(ws + WS_SIDE), lds, l};
      pg8::gemm_phase<EpiP5F>(lds, g, S, E);
      pg8::StaticOrder S2; S2.init(TOKS / 128, DFF / 128, G, (c + G / 2) % G, TOKP / 128);
      EpiP5FT<true> E2{(const float*)(ws + WS_SS), (bf16_t*)(ws + WS_HF), p.out, p.conv_w + (size_t)l * 3 * DFF, p.conv_b + (size_t)l * DFF, p.state_conv + (size_t)l * DB * 2 * DFF, (float*)(ws + WS_SIDE), lds, l};
      pg8::gemm_phase<EpiP5FT<true>, false, true>(lds, g, S2, E2);
    }
    SEAM(pb + 4);
    if (IN(pb + 5)) {
      pg8::GemmDesc g{(const char*)(ws + WS_HF), (const char*)(ws + WS_WDN) + (size_t)l * D * DFF * 2, DFF, DFF, DFF / 64, (size_t)256 * DFF * 2, (size_t)128 * DFF * 2};
      pg8::StaticOrder S; S.init(TOKP / 256, D / 256, G, c);
      { pg8::Unit uu; for (int i = 0; S.next(i, uu); ++i) if (uu.pm < 64 && (uu.pm & 15) != 0) p6_fixup_panel(uu.pm, (const float*)(ws + WS_SIDE), p.conv_w + (size_t)l * 3 * DFF, (bf16_t*)(ws + WS_HF));
        asm volatile("s_waitcnt vmcnt(0)" ::: "memory"); __syncthreads(); }
      EpiRes E{(float*)(ws + WS_X32), (bf16_t*)(ws + WS_XB), (float*)(ws + WS_SS), lds, nullptr, nullptr};
      pg8::gemm_phase<EpiRes>(lds, g, S, E);
      pg8::GemmDesc gh = g; gh.b_tile = (size_t)128 * DFF * 2;
      pg8::StaticOrder S2; S2.init(TOKS / 128, D / 128, G, c, TOKP / 128);
      EpiResT<true, true> E2{(float*)(ws + WS_X32), (bf16_t*)(ws + WS_XB), (float*)(ws + WS_SS), lds, nullptr, nullptr};
      pg8::gemm_phase<EpiResT<true, true>, true, true>(lds, gh, S2, E2);
    }
    SEAM(pb + 5);
  }
  if (IN(NPHASE - 1)) { pfinal_norm(p_k); }
#undef IN
#undef SEAM
}

#ifndef MK_ONE_LAUNCH
#define MK_ONE_LAUNCH 1
#endif
extern "C" void kernel_launch(void* const* d_in, const int* in_sizes, int n_in, void* d_out, int out_size, void* d_ws, size_t ws_size, hipStream_t stream) {
  static int grid_blocks = 0;
  if (grid_blocks == 0) {
    int dev = 0, cus = 0, per_cu = 0;
    (void)hipGetDevice(&dev);
    (void)hipDeviceGetAttribute(&cus, hipDeviceAttributeMultiprocessorCount, dev);
    (void)hipFuncSetAttribute((const void*)fwd_megakernel, hipFuncAttributeMaxDynamicSharedMemorySize, LDS_BYTES);
    (void)hipOccupancyMaxActiveBlocksPerMultiprocessor(&per_cu, (const void*)fwd_megakernel, NTHREADS, LDS_BYTES);
    if (per_cu < 1) { fprintf(stderr, "kernel_launch: occupancy query says %d blocks/CU\n", per_cu); per_cu = 1; }
    grid_blocks = cus * per_cu;
    if (n_in != 24 || (size_t)out_size != O_END || ws_size < WS_END) { fprintf(stderr, "kernel_launch: unexpected problem (n_in %d out %d ws %zu, need %zu)\n", n_in, out_size, ws_size, (size_t)WS_END); grid_blocks = -1; }
  }
  if (grid_blocks < 0) return;
  Params p{};
  const float** f = (const float**)&p;
  for (int i = 0; i < 24; ++i) f[i] = (const float*)d_in[i];
  p.out = (float*)d_out; p.ws = (unsigned char*)d_ws;
#if MK_ONE_LAUNCH
  p.ph_lo = 0; p.ph_hi = NPHASE;
  (void)hipMemsetAsync((unsigned char*)d_ws + WS_CTL + (size_t)CW_BAR * 4, 0, (size_t)XCD_BAR_WORDS * 4, stream);
  { void* args[] = {&p};
    hipError_t e = hipLaunchCooperativeKernel((void*)fwd_megakernel, dim3(grid_blocks), dim3(NTHREADS), args, LDS_BYTES, stream);
    if (e != hipSuccess) fprintf(stderr, "cooperative launch failed: %s (grid %d)\n", hipGetErrorString(e), grid_blocks); }
#else
  for (int k = 0; k < NPHASE; ++k) { p.ph_lo = k; p.ph_hi = k + 1; void* args[] = {&p};
    hipError_t e = hipLaunchCooperativeKernel((void*)fwd_megakernel, dim3(grid_blocks), dim3(NTHREADS), args, LDS_BYTES, stream);
    if (e != hipSuccess) { fprintf(stderr, "launch %d failed: %s (grid %d)\n", k, hipGetErrorString(e), grid_blocks); break; } }
#endif
}
```

```cpp
#include <hip/hip_runtime.h>
#include <hip/hip_cooperative_groups.h>
#include <cstdio>
#include <cstdint>
namespace cg = cooperative_groups;

#define DI __device__ __forceinline__
#define LAS __attribute__((address_space(3)))
typedef unsigned short bf16_t;
typedef short bf16x8 __attribute__((ext_vector_type(8)));
typedef short s16x4 __attribute__((ext_vector_type(4)));
typedef float f32x2 __attribute__((ext_vector_type(2)));
typedef float f32x4 __attribute__((ext_vector_type(4)));
typedef float f32x8 __attribute__((ext_vector_type(8)));
typedef float f32x16 __attribute__((ext_vector_type(16)));
typedef unsigned u32x2 __attribute__((ext_vector_type(2)));
typedef unsigned u32x4 __attribute__((ext_vector_type(4)));
typedef __bf16 bfv4 __attribute__((ext_vector_type(4)));
typedef __bf16 bfv8 __attribute__((ext_vector_type(8)));

constexpr int D = 1024, SEQ = 4096, NB = 4, TOKP = NB * SEQ, DB = 32, DSEQ = 64, TOKS = DB * DSEQ, TOK = TOKP + TOKS;
constexpr int PAST = 1024, ALEN = 512, INC = 7680, DFF = 2816, NLAYER = 2;
constexpr int QKVW = 4608, GATEW = 3072, OW = 1536;
constexpr float EPS = 1e-6f, LOG2E = 1.4426950408889634f;

constexpr size_t O_YP = 0, O_YS = O_YP + (size_t)TOKP * D, O_PAK = O_YS + (size_t)TOKS * D, O_PAV = O_PAK + (size_t)2 * 4 * 512 * 512,
                 O_PBK = O_PAV + (size_t)2 * 4 * 512 * 512, O_PBV = O_PBK + (size_t)2 * TOKP * 512, O_PCK = O_PBV + (size_t)2 * TOKP * 512,
                 O_PCV = O_PCK + (size_t)2 * TOKP * 512, O_PCONV = O_PCV + (size_t)2 * TOKP * 512, O_SAK = O_PCONV + (size_t)2 * 4 * 2 * DFF,
                 O_SAV = O_SAK + (size_t)2 * DB * 512 * 512, O_SBK = O_SAV + (size_t)2 * DB * 512 * 512, O_SBV = O_SBK + (size_t)2 * TOKS * 512,
                 O_SCK = O_SBV + (size_t)2 * TOKS * 512, O_SCV = O_SCK + (size_t)2 * TOKS * 512, O_SCONV = O_SCV + (size_t)2 * TOKS * 512,
                 O_END = O_SCONV + (size_t)2 * DB * 2 * DFF;

constexpr size_t MiB = 1u << 20;
constexpr size_t WS_CTL = 0;
constexpr size_t WS_WIN = 1 * MiB;
constexpr size_t WS_WBR = WS_WIN + (size_t)2 * INC * D * 2;
constexpr size_t WS_WOUT = WS_WBR + (size_t)2 * D * OW * 2;
constexpr size_t WS_WUP = WS_WOUT + (size_t)2 * D * D * 2;
constexpr size_t WS_WDN = WS_WUP + (size_t)2 * 2 * DFF * D * 2;
constexpr size_t WS_XB = WS_WDN + (size_t)2 * D * DFF * 2;
constexpr size_t WS_X32 = WS_XB + (size_t)TOK * D * 2;
constexpr size_t WS_SS = WS_X32 + (size_t)TOK * D * 4;
constexpr size_t WS_SIDE = WS_SS + (size_t)TOK * 8 * 4;
constexpr size_t WS_O = WS_SIDE + (size_t)3 * 72 * 2 * DFF * 4;
constexpr size_t WS_H = WS_O + (size_t)TOK * OW * 2;
constexpr size_t WS_HF = WS_H + (size_t)TOK * D * 2;
constexpr size_t WS_QKV = WS_HF + (size_t)TOK * DFF * 2;
constexpr size_t WS_GATE = WS_QKV + (size_t)TOK * QKVW * 2;
constexpr size_t WS_END = WS_GATE + (size_t)TOK * GATEW * 2;
constexpr int CW_QUEUE = 64;
constexpr int CW_LAM = 1024;
constexpr int CW_T5 = 2048;
constexpr int CW_BAR = 8192;

constexpr int LDS_BYTES = 160 * 1024;
constexpr int NTHREADS = 512;

DI u32x4 pack8(f32x4 a, f32x4 b) { f32x8 v = {a[0], a[1], a[2], a[3], b[0], b[1], b[2], b[3]}; return __builtin_bit_cast(u32x4, __builtin_convertvector(v, bfv8)); }
DI u32x2 pack4(f32x4 a) { return __builtin_bit_cast(u32x2, __builtin_convertvector(a, bfv4)); }
DI float bflo(unsigned w) { return __uint_as_float(w << 16); }
DI float bfhi(unsigned w) { return __uint_as_float(w & 0xffff0000u); }
DI float wave_sum(float v) {
#pragma unroll
  for (int o = 1; o < 64; o <<= 1) v += __shfl_xor(v, o);
  return v;
}
DI float fast_rcp(float x) { return __builtin_amdgcn_rcpf(x); }
DI float fast_exp2(float x) { return __builtin_amdgcn_exp2f(x); }
DI float fast_log2(float x) { return __builtin_amdgcn_logf(x); }

DI LAS unsigned char* opaque_lds(LAS unsigned char* p) { unsigned v = (unsigned)(__UINTPTR_TYPE__)p; asm volatile("" : "+s"(v)); return (LAS unsigned char*)(__UINTPTR_TYPE__)v; }

struct Params {
  const float* x_prompt; const float* x_sample;
  const float* cache_a_k; const float* cache_a_v; const float* cache_b_k; const float* cache_b_v; const float* cache_c_k; const float* cache_c_v;
  const float* state_conv; const float* norm_mix; const float* w_in; const float* b_gate; const float* a_rel_bias; const float* t5_bias;
  const float* c_lambda; const float* c_subln; const float* w_branch; const float* w_out; const float* norm_ffn; const float* w_up;
  const float* conv_w; const float* conv_b; const float* w_down; const float* norm_final;
  float* out; unsigned char* ws;
  int ph_lo, ph_hi;
};

DI void p0_transpose_item(const float* W, int N, const float* kscale, bf16_t* WT, int dst_ld, int dst_col, LAS float* scr, int item, int lane) {
  const int nblk = N / 32, kb = item / nblk, nb = item % nblk, k0 = 64 * kb, n0 = 32 * nb;
  float wv[32];
#pragma unroll
  for (int i = 0; i < 32; ++i) wv[i] = __builtin_nontemporal_load(&W[(size_t)(k0 + 2 * i + (lane >> 5)) * N + n0 + (lane & 31)]);
#pragma unroll
  for (int i = 0; i < 32; ++i) { const int kk = 2 * i + (lane >> 5); float v = wv[i]; if (kscale) v *= kscale[k0 + kk]; scr[kk * 33 + (lane & 31)] = v; }
  asm volatile("s_waitcnt lgkmcnt(0)" ::: "memory");
  const int c = lane & 7;
#pragma unroll
  for (int j = 0; j < 4; ++j) { const int n = (lane >> 3) + 8 * j; const LAS float* s = scr + (8 * c) * 33 + n;
    f32x4 a = {s[0 * 33], s[1 * 33], s[2 * 33], s[3 * 33]}, b = {s[4 * 33], s[5 * 33], s[6 * 33], s[7 * 33]};
    *(u32x4*)(WT + (size_t)(n0 + n) * dst_ld + dst_col + k0 + 8 * c) = pack8(a, b); }
  asm volatile("s_waitcnt lgkmcnt(0)" ::: "memory");
}

DI int t5_bucket_of(int rel) {
  const int n = rel < 0 ? -rel : rel; int f;
  if (n < 8) f = n; else if (n < 12) f = 8; else if (n < 16) f = 9; else if (n < 23) f = 10; else if (n < 32) f = 11; else if (n < 46) f = 12; else if (n < 64) f = 13; else if (n < 91) f = 14; else f = 15;
  return (rel > 0 ? 16 : 0) + f;
}

constexpr int I_IN = (D / 64) * (INC / 32), I_BR = (512 / 64) * (D / 32), I_OUT = (D / 64) * (D / 32), I_UP = (D / 64) * (2 * DFF / 32), I_DN = (DFF / 64) * (D / 32);
constexpr int PER_LAYER = I_IN + 3 * I_BR + I_OUT + I_UP + I_DN;
constexpr int LATE_ITEMS = I_IN + 3 * I_BR + I_OUT, LATE3 = 2048, LATE4 = 1024, LATE6 = LATE_ITEMS - LATE3 - LATE4;
DI void p0_weight_item(const Params& p, int it, LAS float* scr, int lane) {
  const int l = it / PER_LAYER; int r = it % PER_LAYER;
  if (r < I_IN) { p0_transpose_item(p.w_in + (size_t)l * D * INC, INC, p.norm_mix + l * D, (bf16_t*)(p.ws + WS_WIN) + (size_t)l * INC * D, D, 0, scr, r, lane); return; } r -= I_IN;
  if (r < 3 * I_BR) { const int n = r / I_BR; p0_transpose_item(p.w_branch + ((size_t)l * 3 + n) * 512 * D, D, nullptr, (bf16_t*)(p.ws + WS_WBR) + (size_t)l * D * OW, OW, 512 * n, scr, r % I_BR, lane); return; } r -= 3 * I_BR;
  if (r < I_OUT) { p0_transpose_item(p.w_out + (size_t)l * D * D, D, nullptr, (bf16_t*)(p.ws + WS_WOUT) + (size_t)l * D * D, D, 0, scr, r, lane); return; } r -= I_OUT;
  if (r < I_UP) { p0_transpose_item(p.w_up + (size_t)l * D * 2 * DFF, 2 * DFF, p.norm_ffn + l * D, (bf16_t*)(p.ws + WS_WUP) + (size_t)l * 2 * DFF * D, D, 0, scr, r, lane); return; } r -= I_UP;
  p0_transpose_item(p.w_down + (size_t)l * DFF * D, D, nullptr, (bf16_t*)(p.ws + WS_WDN) + (size_t)l * D * DFF, DFF, 0, scr, r, lane);
}
DI void late_transposes(const Params& p, LAS unsigned char* lds_in, int first, int count, int w_block, int n_blocks) {
  LAS unsigned char* lds = opaque_lds(lds_in);
  int tid_ = threadIdx.x; asm volatile("" : "+v"(tid_));
  const int lane = tid_ & 63, wave = tid_ >> 6;
  LAS float* scr = (LAS float*)(lds + wave * 8448);
  for (int j = w_block * 8 + wave; j < count; j += n_blocks * 8) p0_weight_item(p, PER_LAYER + first + j, scr, lane);
}
DI void p0_prologue(const Params& p, LAS unsigned char* lds_in) {
  LAS unsigned char* lds = opaque_lds(lds_in);
  int tid_ = threadIdx.x; asm volatile("" : "+v"(tid_));
  const int tid = tid_, lane = tid & 63, wave = tid >> 6;
  const int gw = blockIdx.x * 8 + wave, NGW = gridDim.x * 8;
  unsigned* ctl = (unsigned*)(p.ws + WS_CTL);
  if (blockIdx.x == 0) {
    if (tid < 4) ctl[CW_QUEUE + 64 * tid] = 0u;
    if (wave == 1) {
      for (int l = 0; l < NLAYER; ++l) { const float* lp = p.c_lambda + l * 256; const float a = wave_sum(lp[lane] * lp[64 + lane]), b = wave_sum(lp[128 + lane] * lp[192 + lane]);
        const float lam_init = 0.8f - 0.6f * expf(-0.3f * (float)l);
        if (lane == 0) ((float*)ctl)[CW_LAM + l] = expf(a) - expf(b) + lam_init; }
    }
    for (int i = tid; i < 4 * 192; i += NTHREADS) { const int h = i / 192, idx = i % 192; int rel = idx - 127; if (rel > 63) rel = 63;
      ((float*)ctl)[CW_T5 + i] = p.t5_bias[t5_bucket_of(rel) * 4 + h] - p.t5_bias[15 * 4 + h]; }
  }
  LAS float* scr = (LAS float*)(lds + wave * 8448);
  for (int j = gw; j < NLAYER * PER_LAYER - LATE_ITEMS; j += NGW) p0_weight_item(p, j < PER_LAYER ? j : j + LATE_ITEMS, scr, lane);
  bf16_t* XB = (bf16_t*)(p.ws + WS_XB); float* SS = (float*)(p.ws + WS_SS);
#pragma unroll 3
  for (int m = gw; m < TOK; m += NGW) {
    const float* src = m < TOKP ? p.x_prompt + (size_t)m * D : p.x_sample + (size_t)(m - TOKP) * D;
    float s = 0.f;
#pragma unroll
    for (int j = 0; j < 4; ++j) { const f32x4 v = __builtin_nontemporal_load(&((const f32x4*)src)[lane + 64 * j]); ((u32x2*)(XB + (size_t)m * D))[lane + 64 * j] = pack4(v);
      s += (v[0] * v[0] + v[1] * v[1]) + (v[2] * v[2] + v[3] * v[3]); }
    s = wave_sum(s);
    if (lane < 8) SS[(size_t)m * 8 + lane] = lane == 0 ? s : 0.f;
  }
}

namespace pg8 {
constexpr int BM = 256, BK = 64, HALF = 128, HTB = HALF * BK * 2, STAGE_BYTES = 8 * HTB, NXCD = 8, WGM = 8;
DI int lds_byte(int r, int c) { const int st = (r >> 4) * 2 + (c >> 5), rr = r & 15, cc = c & 31, ob = rr * 64 + cc * 2; return st * 1024 + (ob ^ (((ob >> 9) & 1) << 5)); }
DI void stage_rc(int b, int& R, int& C) { const int st = b / 1024, sb = b % 1024, swz = sb ^ (((sb >> 9) & 1) << 5); R = (st >> 1) * 16 + swz / 64; C = (st & 1) * 32 + (swz % 64) / 2; }
DI int perm32(int rho) { const int n = rho >> 4, i = rho & 15; return 8 * (i >> 2) + 4 * n + (i & 3); }
struct Unit { int pm, pn; };
struct GemmDesc { const char* A; const char* B; int lda, ldb, nt; size_t b_tile, b_half; };
struct StaticOrder {
  int nM, nN, nwg, G, c, pm0;
  DI void init(int nM_, int nN_, int G_, int c_, int pm0_ = 0) { nM = nM_; nN = nN_; nwg = nM * nN; G = G_; c = c_; pm0 = pm0_; }
  DI bool next(int i, Unit& u) const {
    const long L = (long)i * G + c; if (L >= nwg) return false;
    int wgid = (int)L; { const int q = nwg / NXCD, r = nwg % NXCD, xcd = wgid % NXCD, off = wgid / NXCD; wgid = (xcd < r ? xcd * (q + 1) : r * (q + 1) + (xcd - r) * q) + off; }
    const int nig = WGM * nN, gid = wgid / nig, fm = gid * WGM, gsz = (nM - fm) < WGM ? (nM - fm) : WGM;
    u.pm = pm0 + fm + ((wgid % nig) % gsz); u.pn = (wgid % nig) / gsz; return true;
  }
};
constexpr int P1_NN = 28, P1_EXTRA = 32, P1_DEFER = 72 + (72 - P1_EXTRA);
struct P1Order {
  StaticOrder R1;
  DI bool next(int i, Unit& u) const {
    if (R1.next(i, u)) return true;
    const long L = (long)i * R1.G + R1.c - R1.nwg; if (L >= P1_EXTRA) return false;
    u.pm = (int)L; u.pn = P1_NN; return true;
  }
};
DI Unit p1_deferred_unit(int j) { Unit u; if (j < 72) { u.pm = j; u.pn = P1_NN + 1; } else { u.pm = P1_EXTRA + (j - 72); u.pn = P1_NN; } return u; }
struct OneUnit { Unit u; DI bool next(int i, Unit& o) const { if (i != 0) return false; o = u; return true; } };
template <class Epi, bool HALFN = false, bool HALFM = false, class Sched = StaticOrder>
DI void gemm_phase(LAS unsigned char* lds_in, const GemmDesc g, const Sched& S, const Epi& E) {
  LAS unsigned char* lds = opaque_lds(lds_in);
  int tid_ = threadIdx.x; asm volatile("" : "+v"(tid_));
  const int tid = tid_, wid = __builtin_amdgcn_readfirstlane(tid >> 6), lane = tid & 63, wr = wid >> 2, wc = wid & 3, fr = lane & 15, fq = lane >> 4;
  const int nt = g.nt;
  unsigned voffA[2], voffB[2];
#pragma unroll
  for (int i = 0; i < 2; ++i) { int R, C; stage_rc(tid * 16 + i * 8192, R, C); const int Rb = Epi::PERM ? ((R & ~31) + perm32(R & 31)) : R;
    voffA[i] = (unsigned)(R * g.lda + C) * 2u; voffB[i] = (unsigned)(Rb * g.ldb + C) * 2u; }
  const size_t kstep = (size_t)(BK * 2);
  const size_t hsA = (size_t)HALF * g.lda * 2, tsA = HALFM ? hsA : 2 * hsA, hsB = g.b_half, tsB = g.b_tile;
  const unsigned ldsw = (unsigned)wid * 1024u;
  const int aoff = lds_byte(wr * 64 + fr, fq * 8), boff = lds_byte(wc * 32 + fr, fq * 8);
#define PG8_SA(b, h) (((b) * 2 + (h)) * HTB)
#define PG8_SB(b, h) ((4 + (b) * 2 + (h)) * HTB)
#define PG8_STAGE(bufoff, gbase, voff) do { _Pragma("unroll") for (int _i = 0; _i < 2; ++_i) \
    __builtin_amdgcn_global_load_lds((const unsigned*)((const char*)(gbase) + (voff)[_i]), (LAS unsigned*)(lds + (bufoff) + ldsw + _i * 8192), 16, 0, 0); } while (0)
#define PG8_LDA(dst, b, h) do { _Pragma("unroll") for (int m = 0; m < 4; ++m) _Pragma("unroll") for (int k = 0; k < 2; ++k) dst[m][k] = *(const LAS bf16x8*)(lds + PG8_SA(b, h) + aoff + m * 2048 + k * 1024); } while (0)
#define PG8_LDB(dst, b, h) do { _Pragma("unroll") for (int n = 0; n < 2; ++n) _Pragma("unroll") for (int k = 0; k < 2; ++k) dst[n][k] = *(const LAS bf16x8*)(lds + PG8_SB(b, h) + boff + n * 2048 + k * 1024); } while (0)
#define PG8_MMA(ai, bj, At, Bt) do { __builtin_amdgcn_s_setprio(1); _Pragma("unroll") for (int m = 0; m < 4; ++m) _Pragma("unroll") for (int n = 0; n < 2; ++n) _Pragma("unroll") for (int k = 0; k < 2; ++k) \
    acc[ai][bj][m][n] = __builtin_amdgcn_mfma_f32_16x16x32_bf16(Bt[n][k], At[m][k], acc[ai][bj][m][n], 0, 0, 0); __builtin_amdgcn_s_setprio(0); } while (0)
#define PG8_WAIT_V(n) asm volatile("s_waitcnt vmcnt(" #n ")" ::: "memory")
#define PG8_WAIT_LOOP do { if constexpr (HALFM && HALFN) PG8_WAIT_V(4); else if constexpr (HALFM || HALFN) PG8_WAIT_V(6); else PG8_WAIT_V(8); } while (0)
#define PG8_WAIT_L(n) asm volatile("s_waitcnt lgkmcnt(" #n ")" ::: "memory")
#define PG8_BAR __builtin_amdgcn_s_barrier()
#define PG8_SCHED __builtin_amdgcn_sched_barrier(0)
  Unit cur, nxt; int ui = 0;
  if (!S.next(0, cur)) return;
  f32x4 acc[2][2][4][2];
#pragma unroll
  for (int a = 0; a < 2; ++a)
#pragma unroll
    for (int b = 0; b < 2; ++b)
#pragma unroll
      for (int m = 0; m < 4; ++m)
#pragma unroll
        for (int n = 0; n < 2; ++n) acc[a][b][m][n] = (f32x4){0.f, 0.f, 0.f, 0.f};
  bf16x8 At[4][2], B0[2][2], B1[2][2];
  const char* cA = g.A + (size_t)cur.pm * tsA; const char* cB = g.B + (size_t)cur.pn * tsB;
  f32x4 ssv = {0.f, 0.f, 0.f, 0.f};
  if constexpr (Epi::HAS_RS) ssv = E.prefetch(cur, tid);
  PG8_STAGE(PG8_SB(0, 0), cB, voffB); if constexpr (!HALFN) PG8_STAGE(PG8_SB(0, 1), cB + hsB, voffB); PG8_STAGE(PG8_SA(0, 0), cA, voffA); if constexpr (!HALFM) PG8_STAGE(PG8_SA(0, 1), cA + hsA, voffA);
  if (wr == 1) PG8_BAR;
  if constexpr (HALFM) PG8_WAIT_V(0); else PG8_WAIT_V(2);
  PG8_BAR;
  PG8_STAGE(PG8_SB(1, 0), cB + kstep, voffB); PG8_STAGE(PG8_SA(1, 0), cA + kstep, voffA); if constexpr (!HALFN) PG8_STAGE(PG8_SB(1, 1), cB + hsB + kstep, voffB);
  if constexpr (HALFN) PG8_WAIT_V(4); else PG8_WAIT_V(6);
  PG8_BAR;
  for (;;) {
    const bool has_next = S.next(ui + 1, nxt);
    const char* nA = has_next ? g.A + (size_t)nxt.pm * tsA : cA; const char* nB = has_next ? g.B + (size_t)nxt.pn * tsB : cB;
    for (int t = 0; t < nt; t += 2) {
      const bool last = (t == nt - 2);
      const char* a1 = cA + (size_t)(t + 1) * kstep;
      const char* a2 = last ? nA : cA + (size_t)(t + 2) * kstep; const char* b2 = last ? nB : cB + (size_t)(t + 2) * kstep;
      const char* a3 = a2 + kstep; const char* b3 = b2 + kstep;
      if constexpr (Epi::HAS_MID) { if (t == 8 || t == 16) E.mid(acc, cur, t, wr, wc, fr, fq); }
      PG8_LDB(B0, 0, 0); if constexpr (!HALFN) PG8_LDB(B1, 0, 1); PG8_SCHED; PG8_LDA(At, 0, 0); if constexpr (!HALFM) PG8_STAGE(PG8_SA(1, 1), a1 + hsA, voffA);
      PG8_WAIT_LOOP; PG8_WAIT_L(0); PG8_BAR; PG8_MMA(0, 0, At, B0); if constexpr (!HALFN) PG8_MMA(0, 1, At, B1); PG8_BAR; PG8_SCHED;
      if constexpr (!HALFM) PG8_LDA(At, 0, 1); PG8_STAGE(PG8_SB(0, 0), b2, voffB); if constexpr (!HALFN) PG8_STAGE(PG8_SB(0, 1), b2 + hsB, voffB); PG8_STAGE(PG8_SA(0, 0), a2, voffA);
      PG8_WAIT_LOOP; PG8_WAIT_L(0); PG8_BAR; if constexpr (!HALFM) { PG8_MMA(1, 0, At, B0); if constexpr (!HALFN) PG8_MMA(1, 1, At, B1); } PG8_BAR; PG8_SCHED;
      PG8_LDB(B0, 1, 0); if constexpr (!HALFN) PG8_LDB(B1, 1, 1); PG8_SCHED; PG8_LDA(At, 1, 0); if constexpr (!HALFM) PG8_STAGE(PG8_SA(0, 1), a2 + hsA, voffA);
      PG8_WAIT_LOOP; PG8_WAIT_L(0); PG8_BAR; PG8_MMA(0, 0, At, B0); if constexpr (!HALFN) PG8_MMA(0, 1, At, B1); PG8_BAR; PG8_SCHED;
      if constexpr (!HALFM) PG8_LDA(At, 1, 1); PG8_STAGE(PG8_SB(1, 0), b3, voffB); if constexpr (!HALFN) PG8_STAGE(PG8_SB(1, 1), b3 + hsB, voffB); PG8_STAGE(PG8_SA(1, 0), a3, voffA);
      PG8_WAIT_LOOP; PG8_WAIT_L(0); PG8_BAR; if constexpr (!HALFM) { PG8_MMA(1, 0, At, B0); if constexpr (!HALFN) PG8_MMA(1, 1, At, B1); } PG8_BAR; PG8_SCHED;
    }
    if (wr == 0) PG8_BAR;
    if constexpr (Epi::HAS_RS) { E.stash(ssv, cur, tid, lds); PG8_WAIT_L(0); PG8_BAR; asm volatile("" ::: "memory"); }
    E(acc, cur, wr, wc, fr, fq);
    if (!has_next) break;
#pragma unroll
    for (int a = 0; a < 2; ++a)
#pragma unroll
      for (int b = 0; b < 2; ++b)
#pragma unroll
        for (int m = 0; m < 4; ++m)
#pragma unroll
          for (int n = 0; n < 2; ++n) acc[a][b][m][n] = (f32x4){0.f, 0.f, 0.f, 0.f};
    cur = nxt; cA = nA; cB = nB; ++ui;
    if constexpr (Epi::HAS_RS) ssv = E.prefetch(cur, tid);
    if (wr == 1) PG8_BAR;
  }
  PG8_WAIT_V(0);
  PG8_BAR;
#undef PG8_SA
#undef PG8_SB
#undef PG8_STAGE
#undef PG8_LDA
#undef PG8_LDB
#undef PG8_MMA
#undef PG8_WAIT_V
#undef PG8_WAIT_LOOP
#undef PG8_WAIT_L
#undef PG8_BAR
#undef PG8_SCHED
}
}
using pg8::Unit;
DI f32x4 ss_load(const float* SS, int r) { const f32x4* q = (const f32x4*)(SS + (size_t)r * 8); return q[0] + q[1]; }
DI float ss_to_rs(const f32x4& a) { return __builtin_amdgcn_rsqf(((a[0] + a[1]) + (a[2] + a[3])) * (1.0f / D) + EPS); }
DI float row_rs(const float* SS, int r) { return ss_to_rs(ss_load(SS, r)); }
DI float sigmoidf_(float x) { return fast_rcp(1.0f + fast_exp2(-x * LOG2E)); }

struct EpiP1 {
  static constexpr bool PERM = true, HAS_MID = false, HAS_RS = true;
  const float* SS; bf16_t* QKV; bf16_t* GATE; const float* bgate; float* out; int layer; int probe_flags; LAS unsigned char* lds;
  DI void mid(f32x4 (&)[2][2][4][2], const Unit&, int, int, int, int, int) const {}
  DI f32x4 prefetch(const Unit& u, int tid) const {
    f32x4 v = {0.f, 0.f, 0.f, 0.f};
    if (tid < 256) v = ss_load(SS, u.pm * 256 + tid);
    return v;
  }
  DI void stash(const f32x4& v, const Unit& u, int tid, LAS unsigned char* l) const {
    if (tid < 256) *(LAS float*)(l + 131072 + 12288 + tid * 4) = ss_to_rs(v);
  }
  DI void operator()(f32x4 (&acc)[2][2][4][2], const Unit& u, int wr, int wc, int fr, int fq) const {
    const int pn = u.pn, rin0 = wr * 64 + fr, row0 = u.pm * 256 + rin0;
    float rs[2][4];
#pragma unroll
    for (int ai = 0; ai < 2; ++ai)
#pragma unroll
      for (int m = 0; m < 4; ++m) rs[ai][m] = *(const LAS float*)(lds + 131072 + 12288 + (rin0 + ai * 128 + m * 16) * 4);
    if (pn < 18) {
      const int colq = pn * 256 + wc * 32 + 8 * fq;
#pragma unroll
      for (int ai = 0; ai < 2; ++ai)
#pragma unroll
        for (int m = 0; m < 4; ++m) {
          const int rin = rin0 + ai * 128 + m * 16, r = u.pm * 256 + rin; const float s = rs[ai][m];
          bf16_t* rowp = QKV + (size_t)r * QKVW + colq;
#pragma unroll
          for (int bj = 0; bj < 2; ++bj) { const f32x4 v0 = acc[ai][bj][m][0] * s, v1 = acc[ai][bj][m][1] * s;
            { const u32x4 pk = pack8(v0, v1); if (!(probe_flags & 2)) *(u32x4*)(rowp + bj * 128) = pk; else asm volatile("" :: "v"(pk)); }
            }
        }
    } else {
      const int gi = pn - 18, nb = gi >> 2, colg = (gi & 3) * 256 + wc * 32 + 8 * fq;
      f32x4 bv[2][2];
#pragma unroll
      for (int bj = 0; bj < 2; ++bj) { bv[bj][0] = *(const f32x4*)(bgate + nb * D + colg + bj * 128); bv[bj][1] = *(const f32x4*)(bgate + nb * D + colg + bj * 128 + 4); }
#pragma unroll
      for (int ai = 0; ai < 2; ++ai)
#pragma unroll
        for (int m = 0; m < 4; ++m) { const int r = row0 + ai * 128 + m * 16; const float s = rs[ai][m];
          bf16_t* rowp = GATE + (size_t)r * GATEW + gi * 256 + wc * 32 + 8 * fq;
#pragma unroll
          for (int bj = 0; bj < 2; ++bj) { f32x4 v0 = acc[ai][bj][m][0] * s + bv[bj][0], v1 = acc[ai][bj][m][1] * s + bv[bj][1];
#pragma unroll
            for (int j = 0; j < 4; ++j) { v0[j] = 1.0f + fast_exp2(fminf(-v0[j] * LOG2E, 100.0f)); v1[j] = 1.0f + fast_exp2(fminf(-v1[j] * LOG2E, 100.0f)); }
            { const u32x4 pk = pack8(v0, v1); if (!(probe_flags & 2)) __builtin_nontemporal_store(pk, (u32x4*)(rowp + bj * 128)); else asm volatile("" :: "v"(pk)); } } }
    }
  }
};

template <bool HALFN, bool HALFM = false> struct EpiP3T {
  static constexpr bool PERM = true, HAS_MID = true, HAS_RS = false;
  const bf16_t* GATE; bf16_t* H;
  DI void mid(f32x4 (&acc)[2][2][4][2], const Unit& u, int t, int wr, int wc, int fr, int fq) const {
    const int nb = (t >> 3) - 1;
    const bf16_t* gp = GATE + (size_t)(u.pm * (HALFM ? 128 : 256) + wr * 64 + fr) * GATEW + nb * D + u.pn * (HALFN ? 128 : 256) + wc * 32 + 8 * fq;
#pragma unroll
    for (int ai = 0; ai < (HALFM ? 1 : 2); ++ai) {
        u32x4 ga[4][2] = {}, gb[4][2] = {};
#pragma unroll
        for (int m = 0; m < 4; ++m)
#pragma unroll
          for (int bj = 0; bj < (HALFN ? 1 : 2); ++bj) { const bf16_t* q = gp + (size_t)(ai * 128 + m * 16) * GATEW + bj * 128; ga[m][bj] = *(const u32x4*)q; gb[m][bj] = *(const u32x4*)(q + D); }
#pragma unroll
        for (int m = 0; m < 4; ++m)
#pragma unroll
          for (int bj = 0; bj < (HALFN ? 1 : 2); ++bj)
#pragma unroll
            for (int n = 0; n < 2; ++n) { const unsigned a0 = ga[m][bj][2 * n], a1 = ga[m][bj][2 * n + 1], b0 = gb[m][bj][2 * n], b1 = gb[m][bj][2 * n + 1];
              acc[ai][bj][m][n][0] *= bflo(b0) * fast_rcp(bflo(a0)); acc[ai][bj][m][n][1] *= bfhi(b0) * fast_rcp(bfhi(a0));
              acc[ai][bj][m][n][2] *= bflo(b1) * fast_rcp(bflo(a1)); acc[ai][bj][m][n][3] *= bfhi(b1) * fast_rcp(bfhi(a1)); }
        asm volatile("" ::: "memory"); }
  }
  DI void operator()(f32x4 (&acc)[2][2][4][2], const Unit& u, int wr, int wc, int fr, int fq) const {
    const int row0 = u.pm * (HALFM ? 128 : 256) + wr * 64 + fr, col0 = u.pn * (HALFN ? 128 : 256) + wc * 32 + 8 * fq;
#pragma unroll
    for (int ai = 0; ai < (HALFM ? 1 : 2); ++ai)
#pragma unroll
      for (int m = 0; m < 4; ++m) { const int r = row0 + ai * 128 + m * 16; const bf16_t* gp = GATE + (size_t)r * GATEW + 2 * D + col0; bf16_t* hp = H + (size_t)r * D + col0;
#pragma unroll
        for (int bj = 0; bj < (HALFN ? 1 : 2); ++bj) { const u32x4 g = *(const u32x4*)(gp + bj * 128); f32x4 v0 = acc[ai][bj][m][0], v1 = acc[ai][bj][m][1];
          v0[0] *= fast_rcp(bflo(g[0])); v0[1] *= fast_rcp(bfhi(g[0])); v0[2] *= fast_rcp(bflo(g[1])); v0[3] *= fast_rcp(bfhi(g[1])); v1[0] *= fast_rcp(bflo(g[2])); v1[1] *= fast_rcp(bfhi(g[2])); v1[2] *= fast_rcp(bflo(g[3])); v1[3] *= fast_rcp(bfhi(g[3]));
          *(u32x4*)(hp + bj * 128) = pack8(v0, v1); } }
  }
};

typedef EpiP3T<false> EpiP3;

template <bool HALFN, bool HALFM = false> struct EpiResT {
  static constexpr bool PERM = true, HAS_MID = false, HAS_RS = false;
  float* X32; bf16_t* XB; float* SS; LAS unsigned char* lds; const float* xin_p; const float* xin_s;
  DI void mid(f32x4 (&)[2][2][4][2], const Unit&, int, int, int, int, int) const {}
  DI void operator()(f32x4 (&acc)[2][2][4][2], const Unit& u, int wr, int wc, int fr, int fq) const {
    const int rin0 = wr * 64 + fr, row0 = u.pm * (HALFM ? 128 : 256) + rin0, col0 = u.pn * (HALFN ? 128 : 256) + wc * 32 + 8 * fq;
    LAS float* red = (LAS float*)(lds + 131072 + 8192);
#pragma unroll
    for (int ai = 0; ai < (HALFM ? 1 : 2); ++ai) {
      f32x4 xo[4][2][2] = {};
#pragma unroll
      for (int m = 0; m < 4; ++m) { const int r = row0 + ai * 128 + m * 16;
        if (xin_p) { const float* xr = (r < TOKP ? xin_p + (size_t)r * D : xin_s + (size_t)(r - TOKP) * D) + col0;
#pragma unroll
          for (int bj = 0; bj < (HALFN ? 1 : 2); ++bj)
#pragma unroll
            for (int n = 0; n < 2; ++n) xo[m][bj][n] = *(const f32x4*)(xr + bj * 128 + n * 4);
        } else {
#pragma unroll
          for (int bj = 0; bj < (HALFN ? 1 : 2); ++bj) { const u32x4 w = *(const u32x4*)(XB + (size_t)r * D + col0 + bj * 128);
            xo[m][bj][0] = (f32x4){bflo(w[0]), bfhi(w[0]), bflo(w[1]), bfhi(w[1])}; xo[m][bj][1] = (f32x4){bflo(w[2]), bfhi(w[2]), bflo(w[3]), bfhi(w[3])}; } } }
#pragma unroll
      for (int m = 0; m < 4; ++m) { const int r = row0 + ai * 128 + m * 16; bf16_t* bp = XB + (size_t)r * D + col0; float q = 0.f;
#pragma unroll
        for (int bj = 0; bj < (HALFN ? 1 : 2); ++bj)
          { const f32x4 x0 = xo[m][bj][0] + acc[ai][bj][m][0], x1 = xo[m][bj][1] + acc[ai][bj][m][1];
            *(u32x4*)(bp + bj * 128) = pack8(x0, x1);
            q += ((x0[0] * x0[0] + x0[1] * x0[1]) + (x0[2] * x0[2] + x0[3] * x0[3])) + ((x1[0] * x1[0] + x1[1] * x1[1]) + (x1[2] * x1[2] + x1[3] * x1[3])); }
        q += __shfl_xor(q, 16); q += __shfl_xor(q, 32);
        if (fq == 0) red[(rin0 + ai * 128 + m * 16) * 4 + wc] = q; }
      asm volatile("" ::: "memory"); }
    asm volatile("s_waitcnt lgkmcnt(0)" ::: "memory"); __builtin_amdgcn_s_barrier(); asm volatile("" ::: "memory");
    int t = threadIdx.x; asm volatile("" : "+v"(t));
    if (t < (HALFM ? 128 : 256)) { const f32x4 v = *(const LAS f32x4*)(red + t * 4); const float q = (v[0] + v[1]) + (v[2] + v[3]); float* sp = SS + (size_t)(u.pm * (HALFM ? 128 : 256) + t) * 8;
      if (HALFN) sp[u.pn] = q; else *(f32x2*)(sp + 2 * u.pn) = (f32x2){q, 0.f}; }
  }
};

typedef EpiResT<false> EpiRes;

DI float dpp_ror1(float v) { return __builtin_bit_cast(float, __builtin_amdgcn_update_dpp(0, __builtin_bit_cast(int, v), 0x121, 0xf, 0xf, false)); }
DI float dpp_ror2(float v) { return __builtin_bit_cast(float, __builtin_amdgcn_update_dpp(0, __builtin_bit_cast(int, v), 0x122, 0xf, 0xf, false)); }
DI float gelu_mul(float x, float uv) {
  const float t = __builtin_fmaf(x * x, 2.0f * LOG2E * 0.7978845608028654f * 0.044715f, 2.0f * LOG2E * 0.7978845608028654f);
  const float r = fast_rcp(fast_exp2(x * t) + 1.0f);
  return __builtin_fmaf(-x, r, x) * uv;
}
constexpr size_t SIDE_ROWS = (size_t)72 * 2 * DFF;
template <bool HALFM> struct EpiP5FT {
  static constexpr bool PERM = true, HAS_MID = false, HAS_RS = true;
  const float* SS; bf16_t* HF; float* out; const float* cw; const float* cb; const float* st; float* side; LAS unsigned char* lds; int layer;
  DI void mid(f32x4 (&)[2][2][4][2], const Unit&, int, int, int, int, int) const {}
  DI f32x4 prefetch(const Unit& u, int tid) const {
    f32x4 v = {0.f, 0.f, 0.f, 0.f};
    if (tid < (HALFM ? 128 : 256)) v = ss_load(SS, u.pm * (HALFM ? 128 : 256) + tid);
    else if (tid >= 256 && tid < 384) { int j = tid - 256; asm volatile("" : "+v"(j));
      const int arr = j >> 5, c4 = (j & 31) * 4; v = *(const f32x4*)((arr < 3 ? cw + arr * DFF : cb) + u.pn * 128 + c4); }
    return v;
  }
  DI void stash(const f32x4& v, const Unit& u, int tid, LAS unsigned char* l) const {
    if (tid < (HALFM ? 128 : 256)) *(LAS float*)(l + 131072 + 12288 + tid * 4) = ss_to_rs(v);
    else if (tid >= 256 && tid < 384) *(LAS f32x4*)(l + 131072 + 13312 + (tid - 256) * 16) = v;
  }
  DI void operator()(f32x4 (&acc)[2][2][4][2], const Unit& u, int wr, int wc, int fr_in, int fq_in) const {
    int fr = fr_in, fq = fq_in; asm volatile("" : "+v"(fr), "+v"(fq));
    const int rin0 = wr * 64 + fr, col0 = u.pn * 128 + wc * 32 + 8 * fq;
    const bool sample = HALFM ? true : u.pm >= 64, cont = !sample && (u.pm & 15) != 0;
    const int bd0 = HALFM ? (u.pm - TOKP / 128) * 2 : (u.pm - 64) * 4;
    LAS float* xh = (LAS float*)(lds + 131072);
    float* TAILG = side; float* HEADC = side + SIDE_ROWS; float* HEADU = side + 2 * SIDE_ROWS;
#pragma unroll
    for (int ai = 0; ai < (HALFM ? 1 : 2); ++ai)
#pragma unroll
      for (int m = 0; m < 4; ++m) { const float s = *(const LAS float*)(lds + 131072 + 12288 + (rin0 + ai * 128 + m * 16) * 4);
#pragma unroll
        for (int n = 0; n < 2; ++n) { acc[ai][0][m][n] *= s; acc[ai][1][m][n] *= s; } }
    if (fr >= 14) {
#pragma unroll
      for (int ai = 0; ai < (HALFM ? 1 : 2); ++ai) { const int gidx = 2 * ai + wr; LAS float* xp = xh + ((gidx * 4 + wc) * 2 + (fr - 14)) * 32 + fq * 8;
        *(LAS f32x4*)xp = acc[ai][0][3][0]; *(LAS f32x4*)(xp + 4) = acc[ai][0][3][1];
        float* cp = nullptr;
        if (sample) cp = out + O_SCONV + ((size_t)(layer * DB + bd0 + gidx) * 2 + (fr - 14)) * DFF + col0;
        else if (gidx == 3) { float* tp = TAILG + ((size_t)u.pm * 2 + (fr - 14)) * DFF + col0; *(f32x4*)tp = acc[ai][0][3][0]; *(f32x4*)(tp + 4) = acc[ai][0][3][1];
          if ((u.pm & 15) == 15) cp = out + O_PCONV + ((size_t)(layer * 4 + (u.pm >> 4)) * 2 + (fr - 14)) * DFF + col0; }
        if (cp) { *(f32x4*)cp = acc[ai][0][3][0]; *(f32x4*)(cp + 4) = acc[ai][0][3][1]; } }
    }
    asm volatile("s_waitcnt lgkmcnt(0)" ::: "memory"); __builtin_amdgcn_s_barrier(); asm volatile("" ::: "memory");
#pragma unroll
    for (int n = 0; n < 2; ++n) {
      const LAS float* cl = (const LAS float*)(lds + 131072 + 13312) + wc * 32 + 8 * fq + 4 * n;
      const f32x4 w0 = *(const LAS f32x4*)cl, w1 = *(const LAS f32x4*)(cl + 128), w2 = *(const LAS f32x4*)(cl + 256), bb = *(const LAS f32x4*)(cl + 384);
#pragma unroll
      for (int ai = 0; ai < (HALFM ? 1 : 2); ++ai) { const int gidx = 2 * ai + wr;
        f32x4 gp = {0.f, 0.f, 0.f, 0.f};
        if (fr >= 14) {
          if (sample) gp = *(const f32x4*)(st + ((size_t)(bd0 + gidx) * 2 + (fr - 14)) * DFF + col0 + 4 * n);
          else if (gidx > 0) gp = *(const LAS f32x4*)(xh + (((gidx - 1) * 4 + wc) * 2 + (fr - 14)) * 32 + fq * 8 + 4 * n);
        }
#pragma unroll
        for (int m = 0; m < 4; ++m) { const int rin = rin0 + ai * 128 + m * 16; f32x4 o, cc;
#pragma unroll
          for (int j = 0; j < 4; ++j) { const float g = acc[ai][0][m][n][j], gq = gp[j];
            const float r1g = dpp_ror1(g), r1q = dpp_ror1(gq), r2g = dpp_ror2(g), r2q = dpp_ror2(gq);
            const float p1 = fr >= 1 ? r1g : r1q, p2 = fr >= 2 ? r2g : r2q;
            const float c = __builtin_fmaf(w2[j], g, __builtin_fmaf(w1[j], p1, __builtin_fmaf(w0[j], p2, bb[j])));
            cc[j] = c; o[j] = gelu_mul(c, acc[ai][1][m][n][j]); }
          *(u32x2*)(HF + (size_t)(u.pm * (HALFM ? 128 : 256) + rin) * DFF + col0 + 4 * n) = pack4(o);
          if (cont && gidx == 0 && m == 0 && fr < 2) { *(f32x4*)(HEADC + ((size_t)u.pm * 2 + fr) * DFF + col0 + 4 * n) = cc; *(f32x4*)(HEADU + ((size_t)u.pm * 2 + fr) * DFF + col0 + 4 * n) = acc[ai][1][m][n]; }
          gp = acc[ai][0][m][n]; }
      }
    }
  }
};
typedef EpiP5FT<false> EpiP5F;
DI void p6_fixup_panel(int pm, const float* side, const float* cw, bf16_t* HF) {
  const float* TAILG = side + (size_t)(pm - 1) * 2 * DFF; const float* HEADC = side + SIDE_ROWS + (size_t)pm * 2 * DFF; const float* HEADU = side + 2 * SIDE_ROWS + (size_t)pm * 2 * DFF;
  int tid_ = threadIdx.x; asm volatile("" : "+v"(tid_));
  constexpr int NIT = (DFF + NTHREADS - 1) / NTHREADS;
  float t0[NIT], t1[NIT], a0[NIT], a1[NIT], hc0[NIT], hc1[NIT], hu0[NIT], hu1[NIT];
#pragma unroll
  for (int i = 0; i < NIT; ++i) { const int k = tid_ + i * NTHREADS; const int kk = k < DFF ? k : 0;
    t0[i] = TAILG[kk]; t1[i] = TAILG[DFF + kk]; a0[i] = cw[kk]; a1[i] = cw[DFF + kk]; hc0[i] = HEADC[kk]; hc1[i] = HEADC[DFF + kk]; hu0[i] = HEADU[kk]; hu1[i] = HEADU[DFF + kk]; }
#pragma unroll
  for (int i = 0; i < NIT; ++i) { const int k = tid_ + i * NTHREADS;
    const float c0 = hc0[i] + a0[i] * t0[i] + a1[i] * t1[i], c1 = hc1[i] + a0[i] * t1[i];
    const float h0 = gelu_mul(c0, hu0[i]), h1 = gelu_mul(c1, hu1[i]);
    f32x4 v = {h0, h1, 0.f, 0.f}; const u32x2 pk = pack4(v);
    if (k < DFF) { HF[(size_t)(pm * 256) * DFF + k] = (bf16_t)(pk[0] & 0xffffu); HF[(size_t)(pm * 256 + 1) * DFF + k] = (bf16_t)(pk[0] >> 16); } }
}

struct EpiNull {
  static constexpr bool PERM = true, HAS_MID = false, HAS_RS = false;
  DI void mid(f32x4 (&)[2][2][4][2], const Unit&, int, int, int, int, int) const {}
  DI void operator()(f32x4 (&acc)[2][2][4][2], const Unit& u, int wr, int wc, int fr, int fq) const {
#pragma unroll
    for (int ai = 0; ai < 2; ++ai)
#pragma unroll
      for (int bj = 0; bj < 2; ++bj)
#pragma unroll
        for (int m = 0; m < 4; ++m)
#pragma unroll
          for (int n = 0; n < 2; ++n) asm volatile("" :: "v"(acc[ai][bj][m][n]));
  }
};

DI float gelu_tanh(float x) {
  const float y = 0.7978845608028654f * (x + 0.044715f * x * x * x);
  const float e = fast_exp2(2.0f * LOG2E * y);
  const float th = 1.0f - 2.0f * fast_rcp(e + 1.0f);
  return 0.5f * x * (1.0f + th);
}
DI void pfinal_norm(const Params& p) {
  const bf16_t* XB = (const bf16_t*)(p.ws + WS_XB); const float* SS = (const float*)(p.ws + WS_SS);
  int tid_ = threadIdx.x; asm volatile("" : "+v"(tid_));
  const int lane = tid_ & 63, gw = blockIdx.x * 8 + (tid_ >> 6), NGW = gridDim.x * 8;
#pragma unroll 3
  for (int m = gw; m < TOK; m += NGW) { const float s = row_rs(SS, m);
#pragma unroll
    for (int j = 0; j < 2; ++j) { const u32x4 w = ((const u32x4*)(XB + (size_t)m * D))[lane + 64 * j];
      const f32x4 g0 = ((const f32x4*)p.norm_final)[2 * (lane + 64 * j)], g1 = ((const f32x4*)p.norm_final)[2 * (lane + 64 * j) + 1];
      const f32x4 a = {bflo(w[0]), bfhi(w[0]), bflo(w[1]), bfhi(w[1])}, b = {bflo(w[2]), bfhi(w[2]), bflo(w[3]), bfhi(w[3])};
      f32x4* o = (f32x4*)(p.out + (size_t)m * D) + 2 * (lane + 64 * j);
      __builtin_nontemporal_store(a * s * g0, o); __builtin_nontemporal_store(b * s * g1, o + 1); } }
}

DI pg8::GemmDesc p1_desc(unsigned char* ws, int l) {
  return pg8::GemmDesc{(const char*)(ws + WS_XB), (const char*)(ws + WS_WIN) + (size_t)l * INC * D * 2, D, D, D / 64, (size_t)256 * D * 2, (size_t)128 * D * 2};
}
DI EpiP1 p1_epi(const Params& p, int l, LAS unsigned char* lds) {
  return EpiP1{(const float*)(p.ws + WS_SS), (bf16_t*)(p.ws + WS_QKV), (bf16_t*)(p.ws + WS_GATE), p.b_gate + (size_t)l * 3 * D, p.out, l, 0, lds};
}
namespace attn {
constexpr int N_CPY = 0, N_CS = 128, N_CP = 512, N_AP = 512, N_BP = 512, N_AS = 256, N_BS = 256, NITEMS = N_CPY + N_CS + N_CP + N_AP + N_BP + N_AS + N_BS;
constexpr float STICK_DONE = 8.75651e-27f;

struct Item { int mode, h, tok0, past, q0, nqv, pflags; const float* cK; const float* cV; };

DI Item decode(const Params& p, int layer, int idx) {
  Item it; it.cK = nullptr; it.cV = nullptr; it.past = 0; it.pflags = 0;
  if (idx < N_CPY) { it.mode = 3; it.h = idx; return it; }
  idx -= N_CPY;
  if (idx < N_CS) { const int bd = idx >> 2, h = idx & 3; it.mode = 2; it.h = h; it.tok0 = TOKP + bd * 64; it.past = PAST; it.q0 = PAST; it.nqv = 64;
    it.cK = p.cache_c_k + (size_t)(layer * DB + bd) * PAST * 512 + h * 128; it.cV = p.cache_c_v + (size_t)(layer * DB + bd) * PAST * 512 + h * 128; return it; }
  idx -= N_CS;
  if (idx < N_CP) { const int jj = 31 - (idx >> 4), rem = idx & 15; it.mode = 2; it.h = rem & 3; it.tok0 = (rem >> 2) * SEQ; it.q0 = jj * 128; it.nqv = 128; return it; }
  idx -= N_CP;
  if (idx < N_AP + N_BP) { const int isb = idx >= N_AP; if (isb) idx -= N_AP; const int qt = 15 - (idx >> 5), rem = idx & 31; it.mode = isb; it.h = rem & 7; it.tok0 = (rem >> 3) * SEQ; it.q0 = qt * 256; it.nqv = 256; return it; }
  idx -= N_AP + N_BP;
  if (idx < N_AS) { const int bd = idx >> 3, h = idx & 7; it.mode = 0; it.h = h; it.tok0 = TOKP + bd * 64; it.past = ALEN; it.q0 = ALEN; it.nqv = 64;
    it.cK = p.cache_a_k + (size_t)(layer * DB + bd) * ALEN * 512 + h * 64; it.cV = p.cache_a_v + (size_t)(layer * DB + bd) * ALEN * 512 + h * 64; return it; }
  idx -= N_AS;
  { const int bd = idx >> 3, h = idx & 7; it.mode = 1; it.h = h; it.tok0 = TOKP + bd * 64; it.past = PAST; it.q0 = PAST; it.nqv = 64;
    it.cK = p.cache_b_k + (size_t)(layer * DB + bd) * PAST * 512 + h * 64; it.cV = p.cache_b_v + (size_t)(layer * DB + bd) * PAST * 512 + h * 64; return it; }
}


template <int MODE, bool SAMPLE>
DI void load_piece(u32x4& r0, u32x4& r1, u32x4& r2, u32x4& r3, const Item& it, const float* cache, const bf16_t* QKV, int col, int kt, int tid) {
  constexpr int CPR = MODE == 2 ? 16 : 8;
  const int j0 = kt * 64;
  const int ra = tid / CPR, ca = tid % CPR;
  if (SAMPLE && j0 < it.past) {
    const unsigned lo = (unsigned)(ra * 512 + ca * 8) * 4u; const char* b = (const char*)(cache + (size_t)j0 * 512);
    { const u32x4* q = (const u32x4*)(b + lo); r0 = __builtin_nontemporal_load(q); r1 = __builtin_nontemporal_load(q + 1); }
    if constexpr (MODE == 2) { const u32x4* q = (const u32x4*)(b + (size_t)32 * 512 * 4 + lo); r2 = __builtin_nontemporal_load(q); r3 = __builtin_nontemporal_load(q + 1); }
  } else {
    const unsigned lo = (unsigned)(ra * QKVW + ca * 8) * 2u; const char* b = (const char*)(QKV + (size_t)(it.tok0 + j0 - it.past) * QKVW + col);
    r0 = *(const u32x4*)(b + lo);
    if constexpr (MODE == 2) r2 = *(const u32x4*)(b + (size_t)32 * QKVW * 2 + lo);
  }
}
DI u32x4 cvt8(u32x4 a, u32x4 b) { return pack8(__builtin_bit_cast(f32x4, a), __builtin_bit_cast(f32x4, b)); }
template <int MODE, bool ISK, bool SAMPLE>
DI void write_piece(const u32x4& r0, const u32x4& r1, const u32x4& r2, const u32x4& r3, const Item& it, LAS unsigned char* buf, int kt, int tid) {
  constexpr int CPR = MODE == 2 ? 16 : 8, VS = MODE == 2 ? 320 : 192;
  const bool f32src = SAMPLE && kt * 64 < it.past;
  const int ra = tid / CPR, ca = tid % CPR, rb = (tid + NTHREADS) / CPR, cb = (tid + NTHREADS) % CPR;
  { const u32x4 x = f32src ? cvt8(r0, r1) : r0;
    if (ISK) *(LAS u32x4*)(buf + ((MODE == 2 && ca >= 8) ? 8192 : 0) + ra * 128 + (((ca & 7) ^ ((ra >> 1) & 7)) << 4)) = x;
    else *(LAS u32x4*)(buf + ra * VS + ca * 16) = x; }
  if constexpr (MODE == 2) { const u32x4 x = f32src ? cvt8(r2, r3) : r2;
    if (ISK) *(LAS u32x4*)(buf + (cb >= 8 ? 8192 : 0) + rb * 128 + (((cb & 7) ^ ((rb >> 1) & 7)) << 4)) = x;
    else *(LAS u32x4*)(buf + rb * VS + cb * 16) = x; }
}

template <int MODE>
DI void state_store(const u32x4& r0, const u32x4& r2, float* dst, int tid) {
  constexpr int CPR = MODE == 2 ? 16 : 8;
  const int ra = tid / CPR, ca = tid % CPR, rb = (tid + NTHREADS) / CPR, cb = (tid + NTHREADS) % CPR;
  { float* q = dst + (size_t)ra * 512 + ca * 8;
    __builtin_nontemporal_store((f32x4){bflo(r0[0]), bfhi(r0[0]), bflo(r0[1]), bfhi(r0[1])}, (f32x4*)q); __builtin_nontemporal_store((f32x4){bflo(r0[2]), bfhi(r0[2]), bflo(r0[3]), bfhi(r0[3])}, (f32x4*)(q + 4)); }
  if constexpr (MODE == 2) { float* q = dst + (size_t)rb * 512 + cb * 8;
    __builtin_nontemporal_store((f32x4){bflo(r2[0]), bfhi(r2[0]), bflo(r2[1]), bfhi(r2[1])}, (f32x4*)q); __builtin_nontemporal_store((f32x4){bflo(r2[2]), bfhi(r2[2]), bflo(r2[3]), bfhi(r2[3])}, (f32x4*)(q + 4)); }
}
template <int MODE>
DI float* state_dst(const Params& p, int layer, const Item& it, int kt, int isv) {
  const int hoff = MODE == 2 ? it.h * 128 : it.h * 64;
  if (it.past == 0) {
    const int t0 = kt * 64; if (t0 < it.q0 || t0 >= it.q0 + it.nqv) return nullptr;
    const int b = it.tok0 / SEQ;
    if (MODE == 0) { if (t0 < SEQ - 512) return nullptr; return p.out + (isv ? O_PAV : O_PAK) + ((size_t)(layer * 4 + b) * 512 + (t0 - (SEQ - 512))) * 512 + hoff; }
    return p.out + (MODE == 1 ? (isv ? O_PBV : O_PBK) : (isv ? O_PCV : O_PCK)) + ((size_t)(layer * 4 + b) * SEQ + t0) * 512 + hoff;
  } else {
    if (kt * 64 != it.past) return nullptr;
    const int bd = (it.tok0 - TOKP) / 64;
    if (MODE == 0) return p.out + (isv ? O_SAV : O_SAK) + ((size_t)(layer * DB + bd) * 512 + 448) * 512 + hoff;
    return p.out + (MODE == 1 ? (isv ? O_SBV : O_SBK) : (isv ? O_SCV : O_SCK)) + ((size_t)(layer * DB + bd) * 64) * 512 + hoff;
  }
}

DI void roll_store(const u32x4& r0, const u32x4& r1, const Params& p, int layer, const Item& it, int kt, int isv, int tid) {
  if (kt < 1 || kt * 64 >= it.past) return;
  const int bd = (it.tok0 - TOKP) / 64, ra = tid >> 3, ca = tid & 7;
  float* q = p.out + (isv ? O_SAV : O_SAK) + ((size_t)(layer * DB + bd) * 512 + (kt - 1) * 64 + ra) * 512 + it.h * 64 + ca * 8;
  __builtin_nontemporal_store(__builtin_bit_cast(f32x4, r0), (f32x4*)q); __builtin_nontemporal_store(__builtin_bit_cast(f32x4, r1), (f32x4*)(q + 4));
}
DI bf16x8 pack_p(const f32x16& x, int s) {
  const f32x4 a = {x[8 * s], x[8 * s + 1], x[8 * s + 2], x[8 * s + 3]}, b = {x[8 * s + 4], x[8 * s + 5], x[8 * s + 6], x[8 * s + 7]};
  return __builtin_bit_cast(bf16x8, pack8(a, b));
}
#define MFMA32(a, b, c) __builtin_amdgcn_mfma_f32_32x32x16_bf16((a), (b), (c), 0, 0, 0)

constexpr int L_KB = 0, KB_BYTES = 16384, L_VB = 32768, VB_BYTES = 20480, L_LUT = 73728, L_FLAGS = 75776, L_XCH = 81920;

template <int MODE, bool SAMPLE>
DI void run_item(const Params& p, int layer, const Item& it, LAS unsigned char* lds_in) {
  LAS unsigned char* lds = opaque_lds(lds_in);
  constexpr int NDV = MODE == 2 ? 4 : 2, VS = MODE == 2 ? 320 : 192;
  int tid_ = threadIdx.x; asm volatile("" : "+v"(tid_));
  const int tid = tid_, lane = tid & 63, wave = __builtin_amdgcn_readfirstlane(tid >> 6);
  const int qi = lane & 31, h2 = lane >> 5;
  const int mp = MODE == 2 ? (wave >> 2) : 0, wrow = MODE == 2 ? (wave & 3) : wave;
  const int q0w = it.q0 + 32 * wrow;
  const bool active = 32 * wrow < it.nqv;
  const bf16_t* QKV = (const bf16_t*)(p.ws + WS_QKV);
  const int hb = MODE == 2 ? it.h * 128 : it.h * 64;
  const int qcol = (MODE == 0 ? 0 : MODE == 1 ? 1536 : 3072) + hb + 64 * mp, kcol = (MODE == 0 ? 512 : MODE == 1 ? 2048 : 3584) + hb, vcol = (MODE == 0 ? 1024 : MODE == 1 ? 2560 : 4096) + hb;
  const int cw = q0w >> 6;
  int kt_first, step, NT;
  if (MODE == 0) { kt_first = (it.q0 >> 6) - 8; if (kt_first < 0) kt_first = 0; step = 1; NT = ((it.q0 + it.nqv - 1) >> 6) - kt_first + 1; }
  else if (MODE == 2) { kt_first = 0; step = 1; NT = ((it.q0 + it.nqv - 1) >> 6) + 1; }
  else { kt_first = (it.q0 + it.nqv - 2) >> 6; step = -1; NT = kt_first + 1; }
  const bool wr_state = it.pflags == 0;
  u32x4 k0 = {}, k1 = {}, k2 = {}, k3 = {}, v0 = {}, v1 = {}, v2 = {}, v3 = {};
  load_piece<MODE, SAMPLE>(k0, k1, k2, k3, it, it.cK, QKV, kcol, kt_first, tid);
  load_piece<MODE, SAMPLE>(v0, v1, v2, v3, it, it.cV, QKV, vcol, kt_first, tid);
  LAS float* lut = (LAS float*)(lds + L_LUT);
  LAS unsigned* flags = (LAS unsigned*)(lds + L_FLAGS);
  if (MODE == 0) { const float bfar = p.a_rel_bias[((size_t)layer * 257 + 256) * 8 + it.h]; for (int i = tid; i < 257; i += NTHREADS) lut[i] = p.a_rel_bias[((size_t)layer * 257 + i) * 8 + it.h] - bfar; }
  if (MODE == 2) { if (tid < 192) lut[tid] = ((const float*)(p.ws + WS_CTL))[CW_T5 + it.h * 192 + tid]; }
  bf16x8 qf[4];
  if (active) { const bf16_t* qp = QKV + (size_t)(it.tok0 + q0w + qi - it.past) * QKVW + qcol + 8 * h2;
#pragma unroll
    for (int s = 0; s < 4; ++s) { const u32x4 w = *(const u32x4*)(qp + 16 * s);
      const f32x4 a = {bflo(w[0]) * 0.125f, bfhi(w[0]) * 0.125f, bflo(w[1]) * 0.125f, bfhi(w[1]) * 0.125f}, b = {bflo(w[2]) * 0.125f, bfhi(w[2]) * 0.125f, bflo(w[3]) * 0.125f, bfhi(w[3]) * 0.125f};
      qf[s] = __builtin_bit_cast(bf16x8, pack8(a, b)); } }
  f32x16 O[NDV];
#pragma unroll
  for (int b = 0; b < NDV; ++b)
#pragma unroll
    for (int i = 0; i < 16; ++i) O[b][i] = 0.f;
  float m_run = -1e30f, l_run = 0.f, R2 = 1.0f; bool done = false, have_p = false;
  bf16x8 pf[4];
#pragma unroll
  for (int s = 0; s < 4; ++s) pf[s] = (bf16x8){0, 0, 0, 0, 0, 0, 0, 0};
  const int krow_off = qi * 128, kswz = (qi >> 1) & 7;
  const int g16 = lane >> 4, trq = (lane & 15) >> 2, trp = lane & 3;
  const int vtr_off = (4 * (g16 >> 1) + trq) * VS + (16 * (g16 & 1) + 4 * trp) * 2;

  write_piece<MODE, true, SAMPLE>(k0, k1, k2, k3, it, lds + L_KB, kt_first, tid);
  if (wr_state) { float* d = state_dst<MODE>(p, layer, it, kt_first, 0); if (d) state_store<MODE>(k0, k2, d, tid); }
  if (MODE == 0 && SAMPLE && wr_state) roll_store(k0, k1, p, layer, it, kt_first, 0, tid);
  if (NT > 1) load_piece<MODE, SAMPLE>(k0, k1, k2, k3, it, it.cK, QKV, kcol, kt_first + step, tid);
  for (int t = 0;; ++t) {
    __syncthreads();
    if (MODE == 1 && t > 0 && t < NT) { const unsigned any = flags[0] | flags[1] | flags[2] | flags[3] | flags[4] | flags[5] | flags[6] | flags[7]; if (!any) NT = t; }
    const int kt = kt_first + step * t;
    bool mine = false;
    if (t < NT && !(it.pflags & 2)) {
      if (MODE == 0) mine = active && kt >= cw - 8 && kt <= cw;
      else if (MODE == 2) mine = active && kt <= cw;
      else mine = active && !done && kt * 64 <= q0w + 30;
    }
    LAS unsigned char* vb = lds + L_VB + ((t - 1) & 1) * VB_BYTES + vtr_off;
    LAS unsigned char* kb = lds + L_KB + (t & 1) * KB_BYTES + ((MODE == 2 && mp) ? 8192 : 0);
    constexpr int HB = NDV / 2, NST = 4 * HB;
    bf16x8 kfa[4], vfa[2], vfb[2];
    const bool do_pv = have_p && !(it.pflags & 8);
#define V_LOAD(dst, j_) do { if (do_pv) { _Pragma("unroll") for (int bb = 0; bb < 2; ++bb) { const int a0 = 16 * ((j_) / HB) * VS + 64 * (2 * ((j_) % HB) + bb); \
      const s16x4 lo = __builtin_amdgcn_ds_read_tr16_b64_v4i16((LAS s16x4*)(vb + a0)), hi = __builtin_amdgcn_ds_read_tr16_b64_v4i16((LAS s16x4*)(vb + a0 + 8 * VS)); \
      dst[bb] = __builtin_shufflevector(lo, hi, 0, 1, 2, 3, 4, 5, 6, 7); } } } while (0)
#define V_MMA(src, j_) do { if (do_pv) { _Pragma("unroll") for (int bb = 0; bb < 2; ++bb) O[2 * ((j_) % HB) + bb] = MFMA32(src[bb], pf[(j_) / HB], O[2 * ((j_) % HB) + bb]); } } while (0)
#define STG(j_, cur, nxt) do { if (SAMPLE) { V_LOAD(cur, j_); V_MMA(cur, j_); } else { if ((j_) + 1 < NST) V_LOAD(nxt, (j_) + 1); V_MMA(cur, j_); } } while (0)
    if (!SAMPLE) {
      if (mine) {
#pragma unroll
        for (int s = 0; s < 4; ++s) kfa[s] = *(const LAS bf16x8*)(kb + krow_off + (((2 * s + h2) ^ kswz) << 4)); }
      V_LOAD(vfa, 0);
      __builtin_amdgcn_sched_barrier(0);
    }
    if (t < NT && !(it.pflags & 1)) { write_piece<MODE, false, SAMPLE>(v0, v1, v2, v3, it, lds + L_VB + (t & 1) * VB_BYTES, kt_first + step * t, tid);
      if (wr_state) { float* d = state_dst<MODE>(p, layer, it, kt_first + step * t, 1); if (d) state_store<MODE>(v0, v2, d, tid); }
      if (MODE == 0 && SAMPLE && wr_state) roll_store(v0, v1, p, layer, it, kt_first + step * t, 1, tid);
      if (t + 1 < NT) { write_piece<MODE, true, SAMPLE>(k0, k1, k2, k3, it, lds + L_KB + ((t + 1) & 1) * KB_BYTES, kt_first + step * (t + 1), tid);
        if (wr_state) { float* d = state_dst<MODE>(p, layer, it, kt_first + step * (t + 1), 0); if (d) state_store<MODE>(k0, k2, d, tid); }
        if (MODE == 0 && SAMPLE && wr_state) roll_store(k0, k1, p, layer, it, kt_first + step * (t + 1), 0, tid);
        load_piece<MODE, SAMPLE>(v0, v1, v2, v3, it, it.cV, QKV, vcol, kt_first + step * (t + 1), tid);
        if (t + 2 < NT) load_piece<MODE, SAMPLE>(k0, k1, k2, k3, it, it.cK, QKV, kcol, kt_first + step * (t + 2), tid); } }
    __builtin_amdgcn_sched_barrier(0);
    f32x16 sA, sB;
#pragma unroll
    for (int i = 0; i < 16; ++i) { sA[i] = 0.f; sB[i] = 0.f; }
    if (mine) {
      bf16x8 kfc[4];
      if (SAMPLE) {
#pragma unroll
        for (int s = 0; s < 4; ++s) kfa[s] = *(const LAS bf16x8*)(kb + krow_off + (((2 * s + h2) ^ kswz) << 4)); }
#pragma unroll
      for (int s = 0; s < 4; ++s) kfc[s] = *(const LAS bf16x8*)(kb + 4096 + krow_off + (((2 * s + h2) ^ kswz) << 4));
#pragma unroll
      for (int s = 0; s < 4; ++s) sA = MFMA32(kfa[s], qf[s], sA);
#pragma unroll
      for (int s = 0; s < 4; ++s) sB = MFMA32(kfc[s], qf[s], sB);
    }
    const int kbase = kt * 64 + 4 * h2;
    if (MODE != 1) {
      float mx = -1e30f, alpha = 1.0f, lsa = 0.f, lsb = 0.f; bool resc = false;
      const bool smx = mine && !(it.pflags & 4);
      STG(0, vfa, vfb);
      if (NST == 8) STG(1, vfb, vfa);
      if (smx) {
        bool cst;
        if (MODE == 0) cst = q0w - (kt * 64 + 63) >= 128; else cst = kt * 64 + 63 - q0w <= -127;
        if (!cst) {
#pragma unroll
          for (int i = 0; i < 16; ++i) { const int ko = (i & 3) + 8 * (i >> 2);
            int ia, ib;
            if (MODE == 0) { const int d = (q0w + qi) - (kbase + ko); ia = d; ib = d - 32; ia = (ia < -128 ? -128 : ia > 128 ? 128 : ia) + 128; ib = (ib < -128 ? -128 : ib > 128 ? 128 : ib) + 128; }
            else { const int d = (kbase + ko) - (q0w + qi); ia = d; ib = d + 32; ia = (ia < -127 ? -127 : ia > 63 ? 63 : ia) + 127; ib = (ib < -127 ? -127 : ib > 63 ? 63 : ib) + 127; }
            sA[i] += lut[ia]; sB[i] += lut[ib]; }
        }
        float m0 = fmaxf(fmaxf(sA[0], sA[1]), sA[2]), m1 = fmaxf(fmaxf(sB[0], sB[1]), sB[2]);
#pragma unroll
        for (int i = 3; i < 15; i += 2) { m0 = fmaxf(fmaxf(m0, sA[i]), sA[i + 1]); m1 = fmaxf(fmaxf(m1, sB[i]), sB[i + 1]); }
        mx = fmaxf(fmaxf(m0, m1), fmaxf(sA[15], sB[15]));
      }
      __builtin_amdgcn_sched_barrier(0);
      if (NST == 8) { STG(2, vfa, vfb); STG(3, vfb, vfa); } else STG(1, vfb, vfa);
      if (smx) {
        mx = fmaxf(mx, __shfl_xor(mx, 32)) * LOG2E;
        resc = !__all(mx <= m_run + 8.0f);
        if (resc) { const float mnew = fmaxf(m_run, mx); alpha = fast_exp2(m_run - mnew); m_run = mnew; l_run *= alpha; }
#pragma unroll
        for (int i = 0; i < 16; ++i) { sA[i] = fast_exp2(__builtin_fmaf(sA[i], LOG2E, -m_run)); lsa += sA[i]; }
      }
      __builtin_amdgcn_sched_barrier(0);
      if (NST == 8) { STG(4, vfa, vfb); STG(5, vfb, vfa); } else STG(2, vfa, vfb);
      if (smx) {
#pragma unroll
        for (int i = 0; i < 16; ++i) { sB[i] = fast_exp2(__builtin_fmaf(sB[i], LOG2E, -m_run)); lsb += sB[i]; }
        l_run += lsa + lsb;
      }
      __builtin_amdgcn_sched_barrier(0);
      if (NST == 8) { STG(6, vfa, vfb); STG(7, vfb, vfa); } else STG(3, vfb, vfa);
      __builtin_amdgcn_sched_barrier(0);
      if (mine) {
        if (resc) {
#pragma unroll
        for (int b = 0; b < NDV; ++b)
#pragma unroll
          for (int i = 0; i < 16; ++i) O[b][i] *= alpha;
        }
        pf[0] = pack_p(sA, 0); pf[1] = pack_p(sA, 1); pf[2] = pack_p(sB, 0); pf[3] = pack_p(sB, 1);
      }
    } else {
      STG(0, vfa, vfb); STG(1, vfb, vfa); STG(2, vfa, vfb); STG(3, vfb, vfa);
      if (mine) {
        const bool diag = kt * 64 + 63 >= q0w;
        float kpA[16], kpB[16];
#pragma unroll
        for (int i = 0; i < 16; ++i) { const int ko = (i & 3) + 8 * (i >> 2);
          { const float r = fast_rcp(1.0f + fast_exp2(sA[i] * LOG2E)); const bool ok = !diag || (kbase + ko) < (q0w + qi); kpA[i] = ok ? r : 1.0f; sA[i] = ok ? 1.0f - r : 0.0f; }
          { const float r = fast_rcp(1.0f + fast_exp2(sB[i] * LOG2E)); const bool ok = !diag || (kbase + 32 + ko) < (q0w + qi); kpB[i] = ok ? r : 1.0f; sB[i] = ok ? 1.0f - r : 0.0f; } }
        float gs[8], pg[8];
#pragma unroll
        for (int g = 0; g < 4; ++g) { gs[g] = (kpA[4 * g] * kpA[4 * g + 1]) * (kpA[4 * g + 2] * kpA[4 * g + 3]); gs[4 + g] = (kpB[4 * g] * kpB[4 * g + 1]) * (kpB[4 * g + 2] * kpB[4 * g + 3]); }
#pragma unroll
        for (int g = 0; g < 8; ++g) pg[g] = __shfl_xor(gs[g], 32);
        float suf = R2;
#pragma unroll
        for (int g = 7; g >= 0; --g) { const float off = suf * (h2 == 0 ? pg[g] : 1.0f);
          if (g >= 4) { const int b = 4 * (g - 4); const float a3 = off, a2 = a3 * kpB[b + 3], a1 = a2 * kpB[b + 2], a0 = a1 * kpB[b + 1];
            sB[b + 3] *= a3; sB[b + 2] *= a2; sB[b + 1] *= a1; sB[b] *= a0; }
          else { const int b = 4 * g; const float a3 = off, a2 = a3 * kpA[b + 3], a1 = a2 * kpA[b + 2], a0 = a1 * kpA[b + 1];
            sA[b + 3] *= a3; sA[b + 2] *= a2; sA[b + 1] *= a1; sA[b] *= a0; }
          suf *= gs[g] * pg[g]; }
        R2 = suf;
        done = __all(R2 < STICK_DONE) != 0;
        pf[0] = pack_p(sA, 0); pf[1] = pack_p(sA, 1); pf[2] = pack_p(sB, 0); pf[3] = pack_p(sB, 1);
      }
    }
#undef V_LOAD
#undef V_MMA
#undef STG
    have_p = mine;
    if (MODE == 1 && t < NT) { if (lane == 0) flags[wave] = (active && !done && kt > 0 && (kt - 1) * 64 <= q0w + 30) ? 1u : 0u; }
    if (t >= NT) break;
  }
  int lane_e = lane; asm volatile("" : "+v"(lane_e));
  const int qi_e = lane_e & 31, h2_e = lane_e >> 5;
  bf16_t* Ob = (bf16_t*)(p.ws + WS_O);
  const int ocol = MODE == 0 ? hb : MODE == 1 ? 512 + hb : 1024 + hb;
  const bool wr_out = it.pflags == 0;
  if (MODE != 2) {
    if (active && wr_out) { float sc = 1.f; if (MODE == 0) { const float lt = l_run + __shfl_xor(l_run, 32); sc = fast_rcp(lt); }
      bf16_t* op = Ob + (size_t)(it.tok0 + q0w + qi_e - it.past) * OW + ocol + 4 * h2_e;
#pragma unroll
      for (int b = 0; b < NDV; ++b)
#pragma unroll
        for (int g = 0; g < 4; ++g) { const f32x4 v = {O[b][4 * g] * sc, O[b][4 * g + 1] * sc, O[b][4 * g + 2] * sc, O[b][4 * g + 3] * sc}; *(u32x2*)(op + 32 * b + 8 * g) = pack4(v); } }
    __syncthreads();
  } else {
    const float lam = ((const float*)(p.ws + WS_CTL))[CW_LAM + layer];
    const float sub_scale = 1.0f - (0.8f - 0.6f * expf(-0.3f * (float)layer));
    LAS float* xch = (LAS float*)(lds + L_XCH);
    if (active && mp == 1) { const float lt = l_run + __shfl_xor(l_run, 32), sc = lam * fast_rcp(lt);
#pragma unroll
      for (int b = 0; b < NDV; ++b)
#pragma unroll
        for (int i = 0; i < 16; ++i) xch[((wave & 3) * 64 + b * 16 + i) * 64 + lane_e] = O[b][i] * sc; }
    __syncthreads();
    if (active && mp == 0 && wr_out) { const float lt = l_run + __shfl_xor(l_run, 32), sc = fast_rcp(lt); float q = 0.f;
#pragma unroll
      for (int b = 0; b < NDV; ++b)
#pragma unroll
        for (int i = 0; i < 16; ++i) { const float o = O[b][i] * sc - xch[((wave & 3) * 64 + b * 16 + i) * 64 + lane_e]; O[b][i] = o; q += o * o; if ((i & 7) == 7) __builtin_amdgcn_sched_barrier(0); }
      q += __shfl_xor(q, 32);
      const float rstd = __builtin_amdgcn_rsqf(q * (1.0f / 128.0f) + EPS) * sub_scale;
      const float* gain = p.c_subln + layer * 128 + 4 * h2_e;
      bf16_t* op = Ob + (size_t)(it.tok0 + q0w + qi_e - it.past) * OW + ocol + 4 * h2_e;
#pragma unroll
      for (int b = 0; b < NDV; ++b)
#pragma unroll
        for (int g = 0; g < 4; ++g) { const f32x4 gn = *(const f32x4*)(gain + 32 * b + 8 * g);
          const f32x4 v = {O[b][4 * g] * rstd * gn[0], O[b][4 * g + 1] * rstd * gn[1], O[b][4 * g + 2] * rstd * gn[2], O[b][4 * g + 3] * rstd * gn[3]}; *(u32x2*)(op + 32 * b + 8 * g) = pack4(v); } }
    __syncthreads();
  }
}

DI void copy_item(const Params& p, int layer, int idx) {
  const int which = idx >> 5, bd = idx & 31;
  const size_t lb = (size_t)layer * DB + bd;
  const f32x4* src = (const f32x4*)((which ? p.cache_a_v : p.cache_a_k) + lb * 512 * 512 + 64 * 512);
  f32x4* dst = (f32x4*)(p.out + (which ? O_SAV : O_SAK) + lb * 512 * 512);
  int tid_ = threadIdx.x; asm volatile("" : "+v"(tid_));
#pragma unroll 4
  for (int i = tid_; i < 448 * 128; i += NTHREADS) __builtin_nontemporal_store(__builtin_nontemporal_load(src + i), dst + i);
}
#ifndef PROBE_ATT_FLAGS
#define PROBE_ATT_FLAGS 0
#endif
#ifndef PROBE_ATT_LO
#define PROBE_ATT_LO 0
#define PROBE_ATT_HI NITEMS
#endif
DI void attn_phase(const Params& p, int qidx, LAS unsigned char* lds) {
  const int layer = qidx & 1; const int i_lo = qidx >= 2 ? PROBE_ATT_LO : 0, i_hi = qidx >= 2 ? PROBE_ATT_HI : NITEMS;
  unsigned* head = (unsigned*)(p.ws + WS_CTL) + CW_QUEUE + 64 * qidx;
  LAS unsigned* slot = (LAS unsigned*)(lds + LDS_BYTES - 48);
  if (threadIdx.x == 0) slot[0] = atomicAdd(head, 1u);
  for (int k = 0;; ++k) {
    __syncthreads();
    const int idx = __builtin_amdgcn_readfirstlane((int)slot[k & 1]) + i_lo;
    if (threadIdx.x == 0) slot[(k + 1) & 1] = atomicAdd(head, 1u);
    if (idx >= i_hi) break;
    Item it = decode(p, layer, idx); it.pflags = qidx >= 2 ? PROBE_ATT_FLAGS : 0;
    if (it.mode == 3) { if (qidx < 2) copy_item(p, layer, it.h); continue; }
    if (it.past == 0) { if (it.mode == 0) run_item<0, false>(p, layer, it, lds); else if (it.mode == 1) run_item<1, false>(p, layer, it, lds); else run_item<2, false>(p, layer, it, lds); }
    else { if (it.mode == 0) run_item<0, true>(p, layer, it, lds); else if (it.mode == 1) run_item<1, true>(p, layer, it, lds); else run_item<2, true>(p, layer, it, lds); }
  }
}
}
#define XB_TMO      128
#define XB_XCNT(j)  (256  + 64 * (j))
#define XB_XSUB(j)  (1280 + 64 * (j))
#define XB_XGEN(j)  (2304 + 64 * (j))
#define XB_TOP      3328
#define XB_TOPGEN   3392
#define XCD_BAR_WORDS 3456
#define XB_SPIN_CAP (1u << 18)
DI unsigned xb_ld(unsigned* p)              { return __hip_atomic_load(p, __ATOMIC_RELAXED, __HIP_MEMORY_SCOPE_AGENT); }
DI unsigned xb_add(unsigned* p, unsigned v) { return __hip_atomic_fetch_add(p, v, __ATOMIC_RELAXED, __HIP_MEMORY_SCOPE_AGENT); }
DI unsigned xb_xcc_id() { return (unsigned)__builtin_amdgcn_s_getreg((3 << 11) | 20) & 0xFu; }
#define XB_SPIN(cond, bar) do { unsigned _sp = 0; while (cond) { __builtin_amdgcn_s_sleep(1); \
    if ((++_sp & 255u) == 0u) { if (xb_ld(&(bar)[XB_TMO])) break; if (_sp > XB_SPIN_CAP) { atomicAdd(&(bar)[XB_TMO], 1u); break; } } } } while (0)
struct XcdBarrier { unsigned* bar; unsigned x; volatile LAS unsigned* st; };
DI XcdBarrier xcd_barrier_post(unsigned* bar, volatile LAS unsigned* st) {
  XcdBarrier b; b.bar = bar; b.x = xb_xcc_id(); b.st = st;
  if (threadIdx.x == 0) (void)xb_add(&bar[XB_XCNT(b.x)], 1u);
  return b;
}
DI void xcd_barrier_complete(unsigned* bar, unsigned x, unsigned& nloc, unsigned& nx) {
  const unsigned G = gridDim.x * gridDim.y * gridDim.z;
  unsigned sum, cnt, mine, sp = 0u;
  for (;;) {
    sum = 0u; cnt = 0u; mine = 0u;
#pragma unroll
    for (unsigned j = 0; j < 16; ++j) { const unsigned c = xb_ld(&bar[XB_XCNT(j)]); sum += c; cnt += (c > 0u) ? 1u : 0u; mine = (j == x) ? c : mine; }
    if (sum == G) break;
    __builtin_amdgcn_s_sleep(1);
    if ((++sp & 255u) == 0u) { if (xb_ld(&bar[XB_TMO])) break; if (sp > XB_SPIN_CAP) { atomicAdd(&bar[XB_TMO], 1u); break; } }
  }
  nloc = mine > 0u ? mine : 1u; nx = cnt > 0u ? cnt : 1u;
}
DI void xcd_barrier(const XcdBarrier& b) {
  asm volatile("s_waitcnt vmcnt(0)" ::: "memory");
  __syncthreads();
  if (threadIdx.x == 0) {
    unsigned* bar = b.bar;
    __builtin_amdgcn_s_waitcnt(0);
    unsigned nloc = b.st[0], nx = b.st[1];
    if (nloc == 0u) { xcd_barrier_complete(bar, b.x, nloc, nx); b.st[0] = nloc; b.st[1] = nx; }
    const unsigned old = xb_add(&bar[XB_XSUB(b.x)], 1u);
    const unsigned gen = old / nloc;
    if (old + 1u == (gen + 1u) * nloc) {
      __builtin_amdgcn_fence(__ATOMIC_RELEASE, "agent");
      asm volatile("s_waitcnt vmcnt(0)" ::: "memory");
      const unsigned og = xb_add(&bar[XB_TOP], 1u);
      const unsigned tg = og / nx;
      if (og + 1u == (tg + 1u) * nx) xb_add(&bar[XB_TOPGEN], 1u);
      else XB_SPIN(xb_ld(&bar[XB_TOPGEN]) == tg, bar);
      __builtin_amdgcn_fence(__ATOMIC_ACQUIRE, "agent");
      xb_add(&bar[XB_XGEN(b.x)], 1u);
      asm volatile("s_waitcnt vmcnt(0)" ::: "memory");
    } else {
      XB_SPIN(xb_ld(&bar[XB_XGEN(b.x)]) == gen, bar);
      __builtin_amdgcn_fence(__ATOMIC_ACQUIRE, "agent");
      asm volatile("s_waitcnt vmcnt(0)" ::: "memory");
    }
  }
  __syncthreads();
}
constexpr int L_BARST = LDS_BYTES - 64;

#ifndef PROBE_P1_FLAGS
#define PROBE_P1_FLAGS 0
#endif
#ifndef PROBE_NULL_EPI
#define PROBE_NULL_EPI 0
#endif
#ifndef PROBE_MASK
#define PROBE_MASK 0
#endif
#define REPEAT(k) for (int rep_ = 0; rep_ < (((PROBE_MASK >> (k)) & 1) ? 2 : 1); ++rep_)
constexpr int NPHASE = 2 + 6 * NLAYER;
__global__ void __launch_bounds__(NTHREADS, 2) fwd_megakernel(Params p_k) {
  extern __shared__ __attribute__((aligned(16))) unsigned char lds_raw[];
  LAS unsigned char* lds = (LAS unsigned char*)lds_raw;
  cg::grid_group grid = cg::this_grid();
  const int lo = p_k.ph_lo, hi = p_k.ph_hi;
#define IN(k) (lo <= (k) && (k) < hi)
#define SEAM(k) do { if (IN(k) && IN((k) + 1)) xcd_barrier(bar); } while (0)
  const int G = gridDim.x, c = blockIdx.x;
  if (threadIdx.x < 2) ((LAS unsigned*)(lds + L_BARST))[threadIdx.x] = 0u;
  XcdBarrier bar; bar.bar = (unsigned*)(p_k.ws + WS_CTL) + CW_BAR; bar.x = 0; bar.st = (volatile LAS unsigned*)(lds + L_BARST);
  if (p_k.ph_lo < 0) grid.sync();
  bar = xcd_barrier_post((unsigned*)(p_k.ws + WS_CTL) + CW_BAR, (volatile LAS unsigned*)(lds + L_BARST));
  if (IN(0)) { p0_prologue(p_k, lds); if ((PROBE_MASK >> 6) & 1) { __syncthreads(); p0_prologue(p_k, lds); } }
  SEAM(0);
  for (int l = 0; l < NLAYER; ++l) {
    const int pb = 1 + 6 * l;
    const Params& p = p_k; unsigned char* ws = p.ws;
    if (IN(pb + 0)) REPEAT(0) {
      pg8::GemmDesc g{(const char*)(ws + WS_XB), (const char*)(ws + WS_WIN) + (size_t)l * INC * D * 2, D, D, D / 64, (size_t)256 * D * 2, (size_t)128 * D * 2};
      pg8::P1Order S; S.R1.init(TOK / 256, pg8::P1_NN, G, c);
      EpiP1 E{(const float*)(ws + WS_SS), (bf16_t*)(ws + WS_QKV), (bf16_t*)(ws + WS_GATE), p.b_gate + (size_t)l * 3 * D, p.out, l, rep_ == 1 ? PROBE_P1_FLAGS : 0, lds};
#if PROBE_NULL_EPI
      if (rep_ == 1) { EpiNull EN; pg8::gemm_phase<EpiNull, false, false, pg8::P1Order>(lds, g, S, EN); } else
#endif
      pg8::gemm_phase<EpiP1, false, false, pg8::P1Order>(lds, g, S, E);
    }
    SEAM(pb + 0);
    if (IN(pb + 1)) REPEAT(1) {
      for (int j = G - 1 - c; j < pg8::P1_DEFER; j += G) { pg8::OneUnit S1; S1.u = pg8::p1_deferred_unit(j);
        pg8::gemm_phase<EpiP1, false, false, pg8::OneUnit>(lds, p1_desc(ws, l), S1, p1_epi(p, l, lds)); }
      attn::attn_phase(p, l + 2 * rep_, lds); }
    SEAM(pb + 1);
    if (IN(pb + 2)) REPEAT(2) {
      pg8::GemmDesc g{(const char*)(ws + WS_O), (const char*)(ws + WS_WBR) + (size_t)l * D * OW * 2, OW, OW, OW / 64, (size_t)256 * OW * 2, (size_t)128 * OW * 2};
      pg8::StaticOrder S; S.init(TOKP / 256, D / 256, G, c);
      EpiP3 E{(const bf16_t*)(ws + WS_GATE), (bf16_t*)(ws + WS_H)};
      pg8::gemm_phase<EpiP3>(lds, g, S, E);
      pg8::GemmDesc gh = g; gh.b_tile = (size_t)128 * OW * 2;
      pg8::StaticOrder S2; S2.init(TOKS / 128, D / 128, G, c, TOKP / 128);
      EpiP3T<true, true> E2{(const bf16_t*)(ws + WS_GATE), (bf16_t*)(ws + WS_H)};
      pg8::gemm_phase<EpiP3T<true, true>, true, true>(lds, gh, S2, E2);
      if (l == 0 && rep_ == 0) { const int nidle = G - S2.nwg; if (nidle <= 0) late_transposes(p, lds, 0, LATE3, c, G); else if (c >= S2.nwg) late_transposes(p, lds, 0, LATE3, c - S2.nwg, nidle); }
    }
    SEAM(pb + 2);
    if (IN(pb + 3)) {
      pg8::GemmDesc g{(const char*)(ws + WS_H), (const char*)(ws + WS_WOUT) + (size_t)l * D * D * 2, D, D, D / 64, (size_t)256 * D * 2, (size_t)128 * D * 2};
      pg8::StaticOrder S; S.init(TOKP / 256, D / 256, G, c);
      EpiRes E{(float*)(ws + WS_X32), (bf16_t*)(ws + WS_XB), (float*)(ws + WS_SS), lds, l == 0 ? p.x_prompt : nullptr, l == 0 ? p.x_sample : nullptr};
      pg8::gemm_phase<EpiRes>(lds, g, S, E);
      pg8::GemmDesc gh = g; gh.b_tile = (size_t)128 * D * 2;
      pg8::StaticOrder S2; S2.init(TOKS / 128, D / 128, G, c, TOKP / 128);
      EpiResT<true, true> E2{(float*)(ws + WS_X32), (bf16_t*)(ws + WS_XB), (float*)(ws + WS_SS), lds, l == 0 ? p.x_prompt : nullptr, l == 0 ? p.x_sample : nullptr};
      pg8::gemm_phase<EpiResT<true, true>, true, true>(lds, gh, S2, E2);
      if (l == 0) { const int nidle = G - S2.nwg; if (nidle <= 0) late_transposes(p, lds, LATE3, LATE4, c, G); else if (c >= S2.nwg) late_transposes(p, lds, LATE3, LATE4, c - S2.nwg, nidle); }
    }
    SEAM(pb + 3);
    if (IN(pb + 4)) REPEAT(4) {
      pg8::GemmDesc g{(const char*)(ws + WS_XB), (const char*)(ws + WS_WUP) + (size_t)l * 2 * DFF * D * 2, D, D, D / 64, (size_t)128 * D * 2, (size_t)DFF * D * 2};
      pg8::StaticOrder S; S.init(TOKP / 256, DFF / 128, G, c);
      EpiP5F E{(const float*)(ws + WS_SS), (bf16_t*)(ws + WS_HF), p.out, p.conv_w + (size_t)l * 3 * DFF, p.conv_b + (size_t)l * DFF, p.state_conv + (size_t)l * DB * 2 * DFF, (float*)(ws + WS_SIDE), lds, l};
      pg8::gemm_phase<EpiP5F>(lds, g, S, E);
      pg8::StaticOrder S2; S2.init(TOKS / 128, DFF / 128, G, (c + G / 2) % G, TOKP / 128);
      EpiP5FT<true> E2{(const float*)(ws + WS_SS), (bf16_t*)(ws + WS_HF), p.out, p.conv_w + (size_t)l * 3 * DFF, p.conv_b + (size_t)l * DFF, p.state_conv + (size_t)l * DB * 2 * DFF, (float*)(ws + WS_SIDE), lds, l};
      pg8::gemm_phase<EpiP5FT<true>, false, true>(lds, g, S2, E2);
    }
    SEAM(pb + 4);
    if (IN(pb + 5)) {
      pg8::GemmDesc g{(const char*)(ws + WS_HF), (const char*)(ws + WS_WDN) + (size_t)l * D * DFF * 2, DFF, DFF, DFF / 64, (size_t)256 * DFF * 2, (size_t)128 * DFF * 2};
      pg8::StaticOrder S; S.init(TOKP / 256, D / 256, G, c);
      { pg8::Unit uu; for (int i = 0; S.next(i, uu); ++i) if (uu.pm < 64 && (uu.pm & 15) != 0) p6_fixup_panel(uu.pm, (const float*)(ws + WS_SIDE), p.conv_w + (size_t)l * 3 * DFF, (bf16_t*)(ws + WS_HF));
        asm volatile("s_waitcnt vmcnt(0)" ::: "memory"); __syncthreads(); }
      EpiRes E{(float*)(ws + WS_X32), (bf16_t*)(ws + WS_XB), (float*)(ws + WS_SS), lds, nullptr, nullptr};
      pg8::gemm_phase<EpiRes>(lds, g, S, E);
      pg8::GemmDesc gh = g; gh.b_tile = (size_t)128 * DFF * 2;
      pg8::StaticOrder S2; S2.init(TOKS / 128, D / 128, G, c, TOKP / 128);
      EpiResT<true, true> E2{(float*)(ws + WS_X32), (bf16_t*)(ws + WS_XB), (float*)(ws + WS_SS), lds, nullptr, nullptr};
      pg8::gemm_phase<EpiResT<true, true>, true, true>(lds, gh, S2, E2);
      if (l == 0) { const int nidle = G - S2.nwg; if (nidle <= 0) late_transposes(p, lds, LATE3 + LATE4, LATE6, c, G); else if (c >= S2.nwg) late_transposes(p, lds, LATE3 + LATE4, LATE6, c - S2.nwg, nidle); }
    }
    SEAM(pb + 5);
  }
  if (IN(NPHASE - 1)) { pfinal_norm(p_k); }
#undef IN
#undef SEAM
}

#ifndef MK_ONE_LAUNCH
#define MK_ONE_LAUNCH 1
#endif
extern "C" void kernel_launch(void* const* d_in, const int* in_sizes, int n_in, void* d_out, int out_size, void* d_ws, size_t ws_size, hipStream_t stream) {
  static int grid_blocks = 0;
  if (grid_blocks == 0) {
    int dev = 0, cus = 0, per_cu = 0;
    (void)hipGetDevice(&dev);
    (void)hipDeviceGetAttribute(&cus, hipDeviceAttributeMultiprocessorCount, dev);
    (void)hipFuncSetAttribute((const void*)fwd_megakernel, hipFuncAttributeMaxDynamicSharedMemorySize, LDS_BYTES);
    (void)hipOccupancyMaxActiveBlocksPerMultiprocessor(&per_cu, (const void*)fwd_megakernel, NTHREADS, LDS_BYTES);
    if (per_cu < 1) { fprintf(stderr, "kernel_launch: occupancy query says %d blocks/CU\n", per_cu); per_cu = 1; }
    grid_blocks = cus * per_cu;
    if (n_in != 24 || (size_t)out_size != O_END || ws_size < WS_END) { fprintf(stderr, "kernel_launch: unexpected problem (n_in %d out %d ws %zu, need %zu)\n", n_in, out_size, ws_size, (size_t)WS_END); grid_blocks = -1; }
  }
  if (grid_blocks < 0) return;
  Params p{};
  const float** f = (const float**)&p;
  for (int i = 0; i < 24; ++i) f[i] = (const float*)d_in[i];
  p.out = (float*)d_out; p.ws = (unsigned char*)d_ws;
#if MK_ONE_LAUNCH
  p.ph_lo = 0; p.ph_hi = NPHASE;
  (void)hipMemsetAsync((unsigned char*)d_ws + WS_CTL + (size_t)CW_BAR * 4, 0, (size_t)XCD_BAR_WORDS * 4, stream);
  { void* args[] = {&p};
    hipError_t e = hipLaunchCooperativeKernel((void*)fwd_megakernel, dim3(grid_blocks), dim3(NTHREADS), args, LDS_BYTES, stream);
    if (e != hipSuccess) fprintf(stderr, "cooperative launch failed: %s (grid %d)\n", hipGetErrorString(e), grid_blocks); }
#else
  for (int k = 0; k < NPHASE; ++k) { p.ph_lo = k; p.ph_hi = k + 1; void* args[] = {&p};
    hipError_t e = hipLaunchCooperativeKernel((void*)fwd_megakernel, dim3(grid_blocks), dim3(NTHREADS), args, LDS_BYTES, stream);
    if (e != hipSuccess) { fprintf(stderr, "launch %d failed: %s (grid %d)\n", k, hipGetErrorString(e), grid_blocks); break; } }
#endif
}
```

```cpp
#include <hip/hip_runtime.h>
#include <hip/hip_cooperative_groups.h>
#include <cstdio>
#include <cstdint>
namespace cg = cooperative_groups;

#define DI __device__ __forceinline__
#define LAS __attribute__((address_space(3)))
typedef unsigned short bf16_t;
typedef short bf16x8 __attribute__((ext_vector_type(8)));
typedef short s16x4 __attribute__((ext_vector_type(4)));
typedef float f32x2 __attribute__((ext_vector_type(2)));
typedef float f32x4 __attribute__((ext_vector_type(4)));
typedef float f32x8 __attribute__((ext_vector_type(8)));
typedef float f32x16 __attribute__((ext_vector_type(16)));
typedef unsigned u32x2 __attribute__((ext_vector_type(2)));
typedef unsigned u32x4 __attribute__((ext_vector_type(4)));
typedef __bf16 bfv4 __attribute__((ext_vector_type(4)));
typedef __bf16 bfv8 __attribute__((ext_vector_type(8)));

constexpr int D = 1024, SEQ = 4096, NB = 4, TOKP = NB * SEQ, DB = 32, DSEQ = 64, TOKS = DB * DSEQ, TOK = TOKP + TOKS;
constexpr int PAST = 1024, ALEN = 512, INC = 7680, DFF = 2816, NLAYER = 2;
constexpr int QKVW = 4608, GATEW = 3072, OW = 1536;
constexpr float EPS = 1e-6f, LOG2E = 1.4426950408889634f;

constexpr size_t O_YP = 0, O_YS = O_YP + (size_t)TOKP * D, O_PAK = O_YS + (size_t)TOKS * D, O_PAV = O_PAK + (size_t)2 * 4 * 512 * 512,
                 O_PBK = O_PAV + (size_t)2 * 4 * 512 * 512, O_PBV = O_PBK + (size_t)2 * TOKP * 512, O_PCK = O_PBV + (size_t)2 * TOKP * 512,
                 O_PCV = O_PCK + (size_t)2 * TOKP * 512, O_PCONV = O_PCV + (size_t)2 * TOKP * 512, O_SAK = O_PCONV + (size_t)2 * 4 * 2 * DFF,
                 O_SAV = O_SAK + (size_t)2 * DB * 512 * 512, O_SBK = O_SAV + (size_t)2 * DB * 512 * 512, O_SBV = O_SBK + (size_t)2 * TOKS * 512,
                 O_SCK = O_SBV + (size_t)2 * TOKS * 512, O_SCV = O_SCK + (size_t)2 * TOKS * 512, O_SCONV = O_SCV + (size_t)2 * TOKS * 512,
                 O_END = O_SCONV + (size_t)2 * DB * 2 * DFF;

constexpr size_t MiB = 1u << 20;
constexpr size_t WS_CTL = 0;
constexpr size_t WS_WIN = 1 * MiB;
constexpr size_t WS_WBR = WS_WIN + (size_t)2 * INC * D * 2;
constexpr size_t WS_WOUT = WS_WBR + (size_t)2 * D * OW * 2;
constexpr size_t WS_WUP = WS_WOUT + (size_t)2 * D * D * 2;
constexpr size_t WS_WDN = WS_WUP + (size_t)2 * 2 * DFF * D * 2;
constexpr size_t WS_XB = WS_WDN + (size_t)2 * D * DFF * 2;
constexpr size_t WS_X32 = WS_XB + (size_t)TOK * D * 2;
constexpr size_t WS_SS = WS_X32 + (size_t)TOK * D * 4;
constexpr size_t WS_SIDE = WS_SS + (size_t)TOK * 8 * 4;
constexpr size_t WS_O = WS_SIDE + (size_t)3 * 72 * 2 * DFF * 4;
constexpr size_t WS_H = WS_O + (size_t)TOK * OW * 2;
constexpr size_t WS_HF = WS_H + (size_t)TOK * D * 2;
constexpr size_t WS_QKV = WS_HF + (size_t)TOK * DFF * 2;
constexpr size_t WS_GATE = WS_QKV + (size_t)TOK * QKVW * 2;
constexpr size_t WS_END = WS_GATE + (size_t)TOK * GATEW * 2;
constexpr int CW_QUEUE = 64;
constexpr int CW_LAM = 1024;
constexpr int CW_T5 = 2048;
constexpr int CW_BAR = 8192;

constexpr int LDS_BYTES = 160 * 1024;
constexpr int NTHREADS = 512;

DI u32x4 pack8(f32x4 a, f32x4 b) { f32x8 v = {a[0], a[1], a[2], a[3], b[0], b[1], b[2], b[3]}; return __builtin_bit_cast(u32x4, __builtin_convertvector(v, bfv8)); }
DI u32x2 pack4(f32x4 a) { return __builtin_bit_cast(u32x2, __builtin_convertvector(a, bfv4)); }
DI float bflo(unsigned w) { return __uint_as_float(w << 16); }
DI float bfhi(unsigned w) { return __uint_as_float(w & 0xffff0000u); }
DI float wave_sum(float v) {
#pragma unroll
  for (int o = 1; o < 64; o <<= 1) v += __shfl_xor(v, o);
  return v;
}
DI float fast_rcp(float x) { return __builtin_amdgcn_rcpf(x); }
DI float fast_exp2(float x) { return __builtin_amdgcn_exp2f(x); }
DI float fast_log2(float x) { return __builtin_amdgcn_logf(x); }

DI LAS unsigned char* opaque_lds(LAS unsigned char* p) { unsigned v = (unsigned)(__UINTPTR_TYPE__)p; asm volatile("" : "+s"(v)); return (LAS unsigned char*)(__UINTPTR_TYPE__)v; }

struct Params {
  const float* x_prompt; const float* x_sample;
  const float* cache_a_k; const float* cache_a_v; const float* cache_b_k; const float* cache_b_v; const float* cache_c_k; const float* cache_c_v;
  const float* state_conv; const float* norm_mix; const float* w_in; const float* b_gate; const float* a_rel_bias; const float* t5_bias;
  const float* c_lambda; const float* c_subln; const float* w_branch; const float* w_out; const float* norm_ffn; const float* w_up;
  const float* conv_w; const float* conv_b; const float* w_down; const float* norm_final;
  float* out; unsigned char* ws;
  int ph_lo, ph_hi;
};

struct TItem { const float* W; const float* ks; bf16_t* WT; int N, dst_ld, dst_col, item; };
DI void p0_tload(const TItem& d, float (&wv)[32], int lane) {
  const int nblk = d.N / 32, kb = d.item / nblk, nb = d.item % nblk, k0 = 64 * kb, n0 = 32 * nb;
#pragma unroll
  for (int i = 0; i < 32; ++i) wv[i] = __builtin_nontemporal_load(&d.W[(size_t)(k0 + 2 * i + (lane >> 5)) * d.N + n0 + (lane & 31)]);
}
DI void p0_tfinish(const TItem& d, const float (&wv)[32], LAS float* scr, int lane) {
  const int nblk = d.N / 32, kb = d.item / nblk, nb = d.item % nblk, k0 = 64 * kb, n0 = 32 * nb;
#pragma unroll
  for (int i = 0; i < 32; ++i) { const int kk = 2 * i + (lane >> 5); float v = wv[i]; if (d.ks) v *= d.ks[k0 + kk]; scr[kk * 33 + (lane & 31)] = v; }
  asm volatile("s_waitcnt lgkmcnt(0)" ::: "memory");
  const int c = lane & 7;
#pragma unroll
  for (int j = 0; j < 4; ++j) { const int n = (lane >> 3) + 8 * j; const LAS float* s = scr + (8 * c) * 33 + n;
    f32x4 a = {s[0 * 33], s[1 * 33], s[2 * 33], s[3 * 33]}, b = {s[4 * 33], s[5 * 33], s[6 * 33], s[7 * 33]};
    *(u32x4*)(d.WT + (size_t)(n0 + n) * d.dst_ld + d.dst_col + k0 + 8 * c) = pack8(a, b); }
  asm volatile("s_waitcnt lgkmcnt(0)" ::: "memory");
}

DI int t5_bucket_of(int rel) {
  const int n = rel < 0 ? -rel : rel; int f;
  if (n < 8) f = n; else if (n < 12) f = 8; else if (n < 16) f = 9; else if (n < 23) f = 10; else if (n < 32) f = 11; else if (n < 46) f = 12; else if (n < 64) f = 13; else if (n < 91) f = 14; else f = 15;
  return (rel > 0 ? 16 : 0) + f;
}

constexpr int I_IN = (D / 64) * (INC / 32), I_BR = (512 / 64) * (D / 32), I_OUT = (D / 64) * (D / 32), I_UP = (D / 64) * (2 * DFF / 32), I_DN = (DFF / 64) * (D / 32);
constexpr int PER_LAYER = I_IN + 3 * I_BR + I_OUT + I_UP + I_DN;
constexpr int P0_ITEMS = I_IN + 3 * I_BR;
constexpr int SL_03 = P0_ITEMS, SN_03 = I_OUT + I_UP;
constexpr int SL_05 = PER_LAYER - I_DN, SN_05 = I_DN;
constexpr int SL_04 = PER_LAYER, SN_04 = 2048;
constexpr int SL_06 = SL_04 + SN_04, SN_06 = 4096;
constexpr int SL_13 = SL_06 + SN_06, SN_13 = 2 * PER_LAYER - I_DN - SL_13;
constexpr int SL_15 = 2 * PER_LAYER - I_DN, SN_15 = I_DN;
static_assert(NLAYER == 2 && SL_06 + SN_06 >= PER_LAYER + I_IN + 3 * I_BR + I_OUT && SN_13 >= 0 && SN_13 <= 4096, "late transpose slots");
DI TItem p0_titem(const Params& p, int it) {
  const int l = it / PER_LAYER; int r = it % PER_LAYER;
  if (r < I_IN) return TItem{p.w_in + (size_t)l * D * INC, p.norm_mix + l * D, (bf16_t*)(p.ws + WS_WIN) + (size_t)l * INC * D, INC, D, 0, r};
  r -= I_IN;
  if (r < 3 * I_BR) { const int n = r / I_BR; return TItem{p.w_branch + ((size_t)l * 3 + n) * 512 * D, nullptr, (bf16_t*)(p.ws + WS_WBR) + (size_t)l * D * OW, D, OW, 512 * n, r % I_BR}; }
  r -= 3 * I_BR;
  if (r < I_OUT) return TItem{p.w_out + (size_t)l * D * D, nullptr, (bf16_t*)(p.ws + WS_WOUT) + (size_t)l * D * D, D, D, 0, r};
  r -= I_OUT;
  if (r < I_UP) return TItem{p.w_up + (size_t)l * D * 2 * DFF, p.norm_ffn + l * D, (bf16_t*)(p.ws + WS_WUP) + (size_t)l * 2 * DFF * D, 2 * DFF, D, 0, r};
  r -= I_UP;
  return TItem{p.w_down + (size_t)l * DFF * D, nullptr, (bf16_t*)(p.ws + WS_WDN) + (size_t)l * D * DFF, D, DFF, 0, r};
}
DI void p0_weight_item(const Params& p, int it, LAS float* scr, int lane) { const TItem d = p0_titem(p, it); float wv[32]; p0_tload(d, wv, lane); p0_tfinish(d, wv, scr, lane); }
DI void late_transposes(const Params& p, LAS unsigned char* lds_in, int first, int count, int w_block, int n_blocks) {
  LAS unsigned char* lds = opaque_lds(lds_in);
  int tid_ = threadIdx.x; asm volatile("" : "+v"(tid_));
  const int lane = tid_ & 63, wave = tid_ >> 6;
  LAS float* scr = (LAS float*)(lds + wave * 8448);
  const int nw = n_blocks * 8;
  for (int j = w_block * 8 + wave; j < count; j += 2 * nw) {
    const bool two = j + nw < count;
    const TItem a = p0_titem(p, first + j), b = p0_titem(p, first + (two ? j + nw : j));
    float wa[32], wb[32];
    p0_tload(a, wa, lane); p0_tload(b, wb, lane);
    p0_tfinish(a, wa, scr, lane);
    if (two) p0_tfinish(b, wb, scr, lane);
  }
}
DI void p0_prologue(const Params& p, LAS unsigned char* lds_in) {
  LAS unsigned char* lds = opaque_lds(lds_in);
  int tid_ = threadIdx.x; asm volatile("" : "+v"(tid_));
  const int tid = tid_, lane = tid & 63, wave = tid >> 6;
  const int gw = blockIdx.x * 8 + wave, NGW = gridDim.x * 8;
  unsigned* ctl = (unsigned*)(p.ws + WS_CTL);
  if (blockIdx.x == 0) {
    if (tid < 4) ctl[CW_QUEUE + 64 * tid] = 0u;
    if (wave == 1) {
      for (int l = 0; l < NLAYER; ++l) { const float* lp = p.c_lambda + l * 256; const float a = wave_sum(lp[lane] * lp[64 + lane]), b = wave_sum(lp[128 + lane] * lp[192 + lane]);
        const float lam_init = 0.8f - 0.6f * expf(-0.3f * (float)l);
        if (lane == 0) ((float*)ctl)[CW_LAM + l] = expf(a) - expf(b) + lam_init; }
    }
    for (int i = tid; i < 4 * 192; i += NTHREADS) { const int h = i / 192, idx = i % 192; int rel = idx - 127; if (rel > 63) rel = 63;
      ((float*)ctl)[CW_T5 + i] = p.t5_bias[t5_bucket_of(rel) * 4 + h] - p.t5_bias[15 * 4 + h]; }
  }
  LAS float* scr = (LAS float*)(lds + wave * 8448);
  for (int j = gw; j < P0_ITEMS; j += NGW) p0_weight_item(p, j, scr, lane);
  bf16_t* XB = (bf16_t*)(p.ws + WS_XB); float* SS = (float*)(p.ws + WS_SS);
#pragma unroll 3
  for (int m = gw; m < TOK; m += NGW) {
    const float* src = m < TOKP ? p.x_prompt + (size_t)m * D : p.x_sample + (size_t)(m - TOKP) * D;
    float s = 0.f;
#pragma unroll
    for (int j = 0; j < 4; ++j) { const f32x4 v = __builtin_nontemporal_load(&((const f32x4*)src)[lane + 64 * j]); ((u32x2*)(XB + (size_t)m * D))[lane + 64 * j] = pack4(v);
      s += (v[0] * v[0] + v[1] * v[1]) + (v[2] * v[2] + v[3] * v[3]); }
    s = wave_sum(s);
    if (lane < 8) SS[(size_t)m * 8 + lane] = lane == 0 ? s : 0.f;
  }
}

namespace pg8 {
constexpr int BM = 256, BK = 64, HALF = 128, HTB = HALF * BK * 2, STAGE_BYTES = 8 * HTB, NXCD = 8, WGM = 8;
DI int lds_byte(int r, int c) { const int st = (r >> 4) * 2 + (c >> 5), rr = r & 15, cc = c & 31, ob = rr * 64 + cc * 2; return st * 1024 + (ob ^ (((ob >> 9) & 1) << 5)); }
DI void stage_rc(int b, int& R, int& C) { const int st = b / 1024, sb = b % 1024, swz = sb ^ (((sb >> 9) & 1) << 5); R = (st >> 1) * 16 + swz / 64; C = (st & 1) * 32 + (swz % 64) / 2; }
DI int perm32(int rho) { const int n = rho >> 4, i = rho & 15; return 8 * (i >> 2) + 4 * n + (i & 3); }
struct Unit { int pm, pn; };
struct GemmDesc { const char* A; const char* B; int lda, ldb, nt; size_t b_tile, b_half; };
struct StaticOrder {
  int nM, nN, nwg, G, c, pm0;
  DI void init(int nM_, int nN_, int G_, int c_, int pm0_ = 0) { nM = nM_; nN = nN_; nwg = nM * nN; G = G_; c = c_; pm0 = pm0_; }
  DI bool next(int i, Unit& u) const {
    const long L = (long)i * G + c; if (L >= nwg) return false;
    int wgid = (int)L; { const int q = nwg / NXCD, r = nwg % NXCD, xcd = wgid % NXCD, off = wgid / NXCD; wgid = (xcd < r ? xcd * (q + 1) : r * (q + 1) + (xcd - r) * q) + off; }
    const int nig = WGM * nN, gid = wgid / nig, fm = gid * WGM, gsz = (nM - fm) < WGM ? (nM - fm) : WGM;
    u.pm = pm0 + fm + ((wgid % nig) % gsz); u.pn = (wgid % nig) / gsz; return true;
  }
};
constexpr int P1_NN = 28, P1_EXTRA = 32, P1_DEFER = 72 + (72 - P1_EXTRA);
struct P1Order {
  StaticOrder R1;
  DI bool next(int i, Unit& u) const {
    if (R1.next(i, u)) return true;
    const long L = (long)i * R1.G + R1.c - R1.nwg; if (L >= P1_EXTRA) return false;
    u.pm = (int)L; u.pn = P1_NN; return true;
  }
};
DI Unit p1_deferred_unit(int j) { Unit u; if (j < 72) { u.pm = j; u.pn = P1_NN + 1; } else { u.pm = P1_EXTRA + (j - 72); u.pn = P1_NN; } return u; }
struct OneUnit { Unit u; DI bool next(int i, Unit& o) const { if (i != 0) return false; o = u; return true; } };
template <class Epi, bool HALFN = false, bool HALFM = false, class Sched = StaticOrder>
DI void gemm_phase(LAS unsigned char* lds_in, const GemmDesc g, const Sched& S, const Epi& E) {
  LAS unsigned char* lds = opaque_lds(lds_in);
  int tid_ = threadIdx.x; asm volatile("" : "+v"(tid_));
  const int tid = tid_, wid = __builtin_amdgcn_readfirstlane(tid >> 6), lane = tid & 63, wr = wid >> 2, wc = wid & 3, fr = lane & 15, fq = lane >> 4;
  const int nt = g.nt;
  unsigned voffA[2], voffB[2];
#pragma unroll
  for (int i = 0; i < 2; ++i) { int R, C; stage_rc(tid * 16 + i * 8192, R, C); const int Rb = Epi::PERM ? ((R & ~31) + perm32(R & 31)) : R;
    voffA[i] = (unsigned)(R * g.lda + C) * 2u; voffB[i] = (unsigned)(Rb * g.ldb + C) * 2u; }
  const size_t kstep = (size_t)(BK * 2);
  const size_t hsA = (size_t)HALF * g.lda * 2, tsA = HALFM ? hsA : 2 * hsA, hsB = g.b_half, tsB = g.b_tile;
  const unsigned ldsw = (unsigned)wid * 1024u;
  const int aoff = lds_byte(wr * 64 + fr, fq * 8), boff = lds_byte(wc * 32 + fr, fq * 8);
#define PG8_SA(b, h) (((b) * 2 + (h)) * HTB)
#define PG8_SB(b, h) ((4 + (b) * 2 + (h)) * HTB)
#define PG8_STAGE(bufoff, gbase, voff) do { _Pragma("unroll") for (int _i = 0; _i < 2; ++_i) \
    __builtin_amdgcn_global_load_lds((const unsigned*)((const char*)(gbase) + (voff)[_i]), (LAS unsigned*)(lds + (bufoff) + ldsw + _i * 8192), 16, 0, 0); } while (0)
#define PG8_LDA(dst, b, h) do { _Pragma("unroll") for (int m = 0; m < 4; ++m) _Pragma("unroll") for (int k = 0; k < 2; ++k) dst[m][k] = *(const LAS bf16x8*)(lds + PG8_SA(b, h) + aoff + m * 2048 + k * 1024); } while (0)
#define PG8_LDB(dst, b, h) do { _Pragma("unroll") for (int n = 0; n < 2; ++n) _Pragma("unroll") for (int k = 0; k < 2; ++k) dst[n][k] = *(const LAS bf16x8*)(lds + PG8_SB(b, h) + boff + n * 2048 + k * 1024); } while (0)
#define PG8_MMA(ai, bj, At, Bt) do { __builtin_amdgcn_s_setprio(1); _Pragma("unroll") for (int m = 0; m < 4; ++m) _Pragma("unroll") for (int n = 0; n < 2; ++n) _Pragma("unroll") for (int k = 0; k < 2; ++k) \
    acc[ai][bj][m][n] = __builtin_amdgcn_mfma_f32_16x16x32_bf16(Bt[n][k], At[m][k], acc[ai][bj][m][n], 0, 0, 0); __builtin_amdgcn_s_setprio(0); } while (0)
#define PG8_WAIT_V(n) asm volatile("s_waitcnt vmcnt(" #n ")" ::: "memory")
#define PG8_WAIT_LOOP do { if constexpr (HALFM && HALFN) PG8_WAIT_V(4); else if constexpr (HALFM || HALFN) PG8_WAIT_V(6); else PG8_WAIT_V(8); } while (0)
#define PG8_WAIT_L(n) asm volatile("s_waitcnt lgkmcnt(" #n ")" ::: "memory")
#define PG8_BAR __builtin_amdgcn_s_barrier()
#define PG8_SCHED __builtin_amdgcn_sched_barrier(0)
  Unit cur, nxt; int ui = 0;
  if (!S.next(0, cur)) return;
  f32x4 acc[2][2][4][2];
#pragma unroll
  for (int a = 0; a < 2; ++a)
#pragma unroll
    for (int b = 0; b < 2; ++b)
#pragma unroll
      for (int m = 0; m < 4; ++m)
#pragma unroll
        for (int n = 0; n < 2; ++n) acc[a][b][m][n] = (f32x4){0.f, 0.f, 0.f, 0.f};
  bf16x8 At[4][2], B0[2][2], B1[2][2];
  const char* cA = g.A + (size_t)cur.pm * tsA; const char* cB = g.B + (size_t)cur.pn * tsB;
  f32x4 ssv = {0.f, 0.f, 0.f, 0.f};
  if constexpr (Epi::HAS_RS) ssv = E.prefetch(cur, tid);
  PG8_STAGE(PG8_SB(0, 0), cB, voffB); if constexpr (!HALFN) PG8_STAGE(PG8_SB(0, 1), cB + hsB, voffB); PG8_STAGE(PG8_SA(0, 0), cA, voffA); if constexpr (!HALFM) PG8_STAGE(PG8_SA(0, 1), cA + hsA, voffA);
  if (wr == 1) PG8_BAR;
  if constexpr (HALFM) PG8_WAIT_V(0); else PG8_WAIT_V(2);
  PG8_BAR;
  PG8_STAGE(PG8_SB(1, 0), cB + kstep, voffB); PG8_STAGE(PG8_SA(1, 0), cA + kstep, voffA); if constexpr (!HALFN) PG8_STAGE(PG8_SB(1, 1), cB + hsB + kstep, voffB);
  if constexpr (HALFN) PG8_WAIT_V(4); else PG8_WAIT_V(6);
  PG8_BAR;
  for (;;) {
    const bool has_next = S.next(ui + 1, nxt);
    const char* nA = has_next ? g.A + (size_t)nxt.pm * tsA : cA; const char* nB = has_next ? g.B + (size_t)nxt.pn * tsB : cB;
    for (int t = 0; t < nt; t += 2) {
      const bool last = (t == nt - 2);
      const char* a1 = cA + (size_t)(t + 1) * kstep;
      const char* a2 = last ? nA : cA + (size_t)(t + 2) * kstep; const char* b2 = last ? nB : cB + (size_t)(t + 2) * kstep;
      const char* a3 = a2 + kstep; const char* b3 = b2 + kstep;
      if constexpr (Epi::HAS_MID) { if (t == 8 || t == 16) E.mid(acc, cur, t, wr, wc, fr, fq); }
      PG8_LDB(B0, 0, 0); if constexpr (!HALFN) PG8_LDB(B1, 0, 1); PG8_SCHED; PG8_LDA(At, 0, 0); if constexpr (!HALFM) PG8_STAGE(PG8_SA(1, 1), a1 + hsA, voffA);
      PG8_WAIT_LOOP; PG8_WAIT_L(0); PG8_BAR; PG8_MMA(0, 0, At, B0); if constexpr (!HALFN) PG8_MMA(0, 1, At, B1); PG8_BAR; PG8_SCHED;
      if constexpr (!HALFM) PG8_LDA(At, 0, 1); PG8_STAGE(PG8_SB(0, 0), b2, voffB); if constexpr (!HALFN) PG8_STAGE(PG8_SB(0, 1), b2 + hsB, voffB); PG8_STAGE(PG8_SA(0, 0), a2, voffA);
      PG8_WAIT_LOOP; PG8_WAIT_L(0); PG8_BAR; if constexpr (!HALFM) { PG8_MMA(1, 0, At, B0); if constexpr (!HALFN) PG8_MMA(1, 1, At, B1); } PG8_BAR; PG8_SCHED;
      PG8_LDB(B0, 1, 0); if constexpr (!HALFN) PG8_LDB(B1, 1, 1); PG8_SCHED; PG8_LDA(At, 1, 0); if constexpr (!HALFM) PG8_STAGE(PG8_SA(0, 1), a2 + hsA, voffA);
      PG8_WAIT_LOOP; PG8_WAIT_L(0); PG8_BAR; PG8_MMA(0, 0, At, B0); if constexpr (!HALFN) PG8_MMA(0, 1, At, B1); PG8_BAR; PG8_SCHED;
      if constexpr (!HALFM) PG8_LDA(At, 1, 1); PG8_STAGE(PG8_SB(1, 0), b3, voffB); if constexpr (!HALFN) PG8_STAGE(PG8_SB(1, 1), b3 + hsB, voffB); PG8_STAGE(PG8_SA(1, 0), a3, voffA);
      PG8_WAIT_LOOP; PG8_WAIT_L(0); PG8_BAR; if constexpr (!HALFM) { PG8_MMA(1, 0, At, B0); if constexpr (!HALFN) PG8_MMA(1, 1, At, B1); } PG8_BAR; PG8_SCHED;
    }
    if (wr == 0) PG8_BAR;
    if constexpr (Epi::HAS_RS) { E.stash(ssv, cur, tid, lds); PG8_WAIT_L(0); PG8_BAR; asm volatile("" ::: "memory"); }
    E(acc, cur, wr, wc, fr, fq);
    if (!has_next) break;
#pragma unroll
    for (int a = 0; a < 2; ++a)
#pragma unroll
      for (int b = 0; b < 2; ++b)
#pragma unroll
        for (int m = 0; m < 4; ++m)
#pragma unroll
          for (int n = 0; n < 2; ++n) acc[a][b][m][n] = (f32x4){0.f, 0.f, 0.f, 0.f};
    cur = nxt; cA = nA; cB = nB; ++ui;
    if constexpr (Epi::HAS_RS) ssv = E.prefetch(cur, tid);
    if (wr == 1) PG8_BAR;
  }
  PG8_WAIT_V(0);
  PG8_BAR;
#undef PG8_SA
#undef PG8_SB
#undef PG8_STAGE
#undef PG8_LDA
#undef PG8_LDB
#undef PG8_MMA
#undef PG8_WAIT_V
#undef PG8_WAIT_LOOP
#undef PG8_WAIT_L
#undef PG8_BAR
#undef PG8_SCHED
}
}
using pg8::Unit;
DI f32x4 ss_load(const float* SS, int r) { const f32x4* q = (const f32x4*)(SS + (size_t)r * 8); return q[0] + q[1]; }
DI float ss_to_rs(const f32x4& a) { return __builtin_amdgcn_rsqf(((a[0] + a[1]) + (a[2] + a[3])) * (1.0f / D) + EPS); }
DI float row_rs(const float* SS, int r) { return ss_to_rs(ss_load(SS, r)); }
DI float sigmoidf_(float x) { return fast_rcp(1.0f + fast_exp2(-x * LOG2E)); }

struct EpiP1 {
  static constexpr bool PERM = true, HAS_MID = false, HAS_RS = true;
  const float* SS; bf16_t* QKV; bf16_t* GATE; const float* bgate; float* out; int layer; int probe_flags; LAS unsigned char* lds;
  DI void mid(f32x4 (&)[2][2][4][2], const Unit&, int, int, int, int, int) const {}
  DI f32x4 prefetch(const Unit& u, int tid) const {
    f32x4 v = {0.f, 0.f, 0.f, 0.f};
    if (tid < 256) v = ss_load(SS, u.pm * 256 + tid);
    return v;
  }
  DI void stash(const f32x4& v, const Unit& u, int tid, LAS unsigned char* l) const {
    if (tid < 256) *(LAS float*)(l + 131072 + 12288 + tid * 4) = ss_to_rs(v);
  }
  DI void operator()(f32x4 (&acc)[2][2][4][2], const Unit& u, int wr, int wc, int fr, int fq) const {
    const int pn = u.pn, rin0 = wr * 64 + fr, row0 = u.pm * 256 + rin0;
    float rs[2][4];
#pragma unroll
    for (int ai = 0; ai < 2; ++ai)
#pragma unroll
      for (int m = 0; m < 4; ++m) rs[ai][m] = *(const LAS float*)(lds + 131072 + 12288 + (rin0 + ai * 128 + m * 16) * 4);
    if (pn < 18) {
      const int colq = pn * 256 + wc * 32 + 8 * fq;
#pragma unroll
      for (int ai = 0; ai < 2; ++ai)
#pragma unroll
        for (int m = 0; m < 4; ++m) {
          const int rin = rin0 + ai * 128 + m * 16, r = u.pm * 256 + rin; const float s = rs[ai][m];
          bf16_t* rowp = QKV + (size_t)r * QKVW + colq;
#pragma unroll
          for (int bj = 0; bj < 2; ++bj) { const f32x4 v0 = acc[ai][bj][m][0] * s, v1 = acc[ai][bj][m][1] * s;
            { const u32x4 pk = pack8(v0, v1); if (!(probe_flags & 2)) *(u32x4*)(rowp + bj * 128) = pk; else asm volatile("" :: "v"(pk)); }
            }
        }
    } else {
      const int gi = pn - 18, nb = gi >> 2, colg = (gi & 3) * 256 + wc * 32 + 8 * fq;
      f32x4 bv[2][2];
#pragma unroll
      for (int bj = 0; bj < 2; ++bj) { bv[bj][0] = *(const f32x4*)(bgate + nb * D + colg + bj * 128); bv[bj][1] = *(const f32x4*)(bgate + nb * D + colg + bj * 128 + 4); }
#pragma unroll
      for (int ai = 0; ai < 2; ++ai)
#pragma unroll
        for (int m = 0; m < 4; ++m) { const int r = row0 + ai * 128 + m * 16; const float s = rs[ai][m];
          bf16_t* rowp = GATE + (size_t)r * GATEW + gi * 256 + wc * 32 + 8 * fq;
#pragma unroll
          for (int bj = 0; bj < 2; ++bj) { f32x4 v0 = acc[ai][bj][m][0] * s + bv[bj][0], v1 = acc[ai][bj][m][1] * s + bv[bj][1];
#pragma unroll
            for (int j = 0; j < 4; ++j) { v0[j] = 1.0f + fast_exp2(fminf(-v0[j] * LOG2E, 100.0f)); v1[j] = 1.0f + fast_exp2(fminf(-v1[j] * LOG2E, 100.0f)); }
            { const u32x4 pk = pack8(v0, v1); if (!(probe_flags & 2)) __builtin_nontemporal_store(pk, (u32x4*)(rowp + bj * 128)); else asm volatile("" :: "v"(pk)); } } }
    }
  }
};

template <bool HALFN, bool HALFM = false> struct EpiP3T {
  static constexpr bool PERM = true, HAS_MID = true, HAS_RS = false;
  const bf16_t* GATE; bf16_t* H;
  DI void mid(f32x4 (&acc)[2][2][4][2], const Unit& u, int t, int wr, int wc, int fr, int fq) const {
    const int nb = (t >> 3) - 1;
    const bf16_t* gp = GATE + (size_t)(u.pm * (HALFM ? 128 : 256) + wr * 64 + fr) * GATEW + nb * D + u.pn * (HALFN ? 128 : 256) + wc * 32 + 8 * fq;
    constexpr int NSB = (HALFM ? 1 : 2) * 2, NBJ = HALFN ? 1 : 2;
    u32x4 gA[2][2][2] = {}, gB[2][2][2] = {};
#define P3_LOAD(G_, k_) do { _Pragma("unroll") for (int mm = 0; mm < 2; ++mm) _Pragma("unroll") for (int bj = 0; bj < NBJ; ++bj) { \
      const bf16_t* q = gp + (size_t)(((k_) >> 1) * 128 + (2 * ((k_) & 1) + mm) * 16) * GATEW + bj * 128; G_[0][mm][bj] = *(const u32x4*)q; G_[1][mm][bj] = *(const u32x4*)(q + D); } asm volatile("" ::: "memory"); } while (0)
#define P3_APPLY(G_, k_) do { _Pragma("unroll") for (int mm = 0; mm < 2; ++mm) _Pragma("unroll") for (int bj = 0; bj < NBJ; ++bj) _Pragma("unroll") for (int n = 0; n < 2; ++n) { \
      const unsigned a0 = G_[0][mm][bj][2 * n], a1 = G_[0][mm][bj][2 * n + 1], b0 = G_[1][mm][bj][2 * n], b1 = G_[1][mm][bj][2 * n + 1]; f32x4& c = acc[(k_) >> 1][bj][2 * ((k_) & 1) + mm][n]; \
      c[0] *= bflo(b0) * fast_rcp(bflo(a0)); c[1] *= bfhi(b0) * fast_rcp(bfhi(a0)); c[2] *= bflo(b1) * fast_rcp(bflo(a1)); c[3] *= bfhi(b1) * fast_rcp(bfhi(a1)); } asm volatile("" ::: "memory"); } while (0)
    P3_LOAD(gA, 0); P3_LOAD(gB, 1); P3_APPLY(gA, 0);
    if (NSB == 4) { P3_LOAD(gA, 2); P3_APPLY(gB, 1); P3_LOAD(gB, 3); P3_APPLY(gA, 2); P3_APPLY(gB, 3); }
    else P3_APPLY(gB, 1);
#undef P3_LOAD
#undef P3_APPLY
  }
  DI void operator()(f32x4 (&acc)[2][2][4][2], const Unit& u, int wr, int wc, int fr, int fq) const {
    const int row0 = u.pm * (HALFM ? 128 : 256) + wr * 64 + fr, col0 = u.pn * (HALFN ? 128 : 256) + wc * 32 + 8 * fq;
    const bf16_t* gp = GATE + (size_t)row0 * GATEW + 2 * D + col0; bf16_t* hp = H + (size_t)row0 * D + col0;
    constexpr int NSB = (HALFM ? 1 : 2) * 2, NBJ = HALFN ? 1 : 2;
    u32x4 gA[2][2] = {}, gB[2][2] = {};
#define P3F_LOAD(G_, k_) do { _Pragma("unroll") for (int mm = 0; mm < 2; ++mm) _Pragma("unroll") for (int bj = 0; bj < NBJ; ++bj) \
      G_[mm][bj] = *(const u32x4*)(gp + (size_t)(((k_) >> 1) * 128 + (2 * ((k_) & 1) + mm) * 16) * GATEW + bj * 128); asm volatile("" ::: "memory"); } while (0)
#define P3F_APPLY(G_, k_) do { _Pragma("unroll") for (int mm = 0; mm < 2; ++mm) _Pragma("unroll") for (int bj = 0; bj < NBJ; ++bj) { const u32x4 g = G_[mm][bj]; \
      f32x4 v0 = acc[(k_) >> 1][bj][2 * ((k_) & 1) + mm][0], v1 = acc[(k_) >> 1][bj][2 * ((k_) & 1) + mm][1]; \
      v0[0] *= fast_rcp(bflo(g[0])); v0[1] *= fast_rcp(bfhi(g[0])); v0[2] *= fast_rcp(bflo(g[1])); v0[3] *= fast_rcp(bfhi(g[1])); v1[0] *= fast_rcp(bflo(g[2])); v1[1] *= fast_rcp(bfhi(g[2])); v1[2] *= fast_rcp(bflo(g[3])); v1[3] *= fast_rcp(bfhi(g[3])); \
      *(u32x4*)(hp + (size_t)(((k_) >> 1) * 128 + (2 * ((k_) & 1) + mm) * 16) * D + bj * 128) = pack8(v0, v1); } asm volatile("" ::: "memory"); } while (0)
    P3F_LOAD(gA, 0); P3F_LOAD(gB, 1); P3F_APPLY(gA, 0);
    if (NSB == 4) { P3F_LOAD(gA, 2); P3F_APPLY(gB, 1); P3F_LOAD(gB, 3); P3F_APPLY(gA, 2); P3F_APPLY(gB, 3); }
    else P3F_APPLY(gB, 1);
#undef P3F_LOAD
#undef P3F_APPLY
  }
};

typedef EpiP3T<false> EpiP3;

template <bool HALFN, bool HALFM = false> struct EpiResT {
  static constexpr bool PERM = true, HAS_MID = false, HAS_RS = false;
  float* X32; bf16_t* XB; float* SS; LAS unsigned char* lds; const float* xin_p; const float* xin_s;
  DI void mid(f32x4 (&)[2][2][4][2], const Unit&, int, int, int, int, int) const {}
  DI void operator()(f32x4 (&acc)[2][2][4][2], const Unit& u, int wr, int wc, int fr, int fq) const {
    const int rin0 = wr * 64 + fr, row0 = u.pm * (HALFM ? 128 : 256) + rin0, col0 = u.pn * (HALFN ? 128 : 256) + wc * 32 + 8 * fq;
    LAS float* red = (LAS float*)(lds + 131072 + 8192);
    u32x4 raw[2][4][2] = {};
#pragma unroll
    for (int ai = 0; ai < (HALFM ? 1 : 2); ++ai)
#pragma unroll
      for (int m = 0; m < 4; ++m)
#pragma unroll
        for (int bj = 0; bj < (HALFN ? 1 : 2); ++bj) raw[ai][m][bj] = *(const u32x4*)(XB + (size_t)(row0 + ai * 128 + m * 16) * D + col0 + bj * 128);
    asm volatile("" ::: "memory");
#pragma unroll
    for (int ai = 0; ai < (HALFM ? 1 : 2); ++ai) {
      f32x4 xo[4][2][2] = {};
#pragma unroll
      for (int m = 0; m < 4; ++m) { const int r = row0 + ai * 128 + m * 16;
#pragma unroll
        for (int bj = 0; bj < (HALFN ? 1 : 2); ++bj) { const u32x4 w = raw[ai][m][bj];
          xo[m][bj][0] = (f32x4){bflo(w[0]), bfhi(w[0]), bflo(w[1]), bfhi(w[1])}; xo[m][bj][1] = (f32x4){bflo(w[2]), bfhi(w[2]), bflo(w[3]), bfhi(w[3])}; } }
#pragma unroll
      for (int m = 0; m < 4; ++m) { const int r = row0 + ai * 128 + m * 16; bf16_t* bp = XB + (size_t)r * D + col0; float q = 0.f;
#pragma unroll
        for (int bj = 0; bj < (HALFN ? 1 : 2); ++bj)
          { const f32x4 x0 = xo[m][bj][0] + acc[ai][bj][m][0], x1 = xo[m][bj][1] + acc[ai][bj][m][1];
            *(u32x4*)(bp + bj * 128) = pack8(x0, x1);
            q += ((x0[0] * x0[0] + x0[1] * x0[1]) + (x0[2] * x0[2] + x0[3] * x0[3])) + ((x1[0] * x1[0] + x1[1] * x1[1]) + (x1[2] * x1[2] + x1[3] * x1[3])); }
        q += __shfl_xor(q, 16); q += __shfl_xor(q, 32);
        if (fq == 0) red[(rin0 + ai * 128 + m * 16) * 4 + wc] = q; }
      asm volatile("" ::: "memory"); }
    asm volatile("s_waitcnt lgkmcnt(0)" ::: "memory"); __builtin_amdgcn_s_barrier(); asm volatile("" ::: "memory");
    int t = threadIdx.x; asm volatile("" : "+v"(t));
    if (t < (HALFM ? 128 : 256)) { const f32x4 v = *(const LAS f32x4*)(red + t * 4); const float q = (v[0] + v[1]) + (v[2] + v[3]); float* sp = SS + (size_t)(u.pm * (HALFM ? 128 : 256) + t) * 8;
      if (HALFN) sp[u.pn] = q; else *(f32x2*)(sp + 2 * u.pn) = (f32x2){q, 0.f}; }
  }
};

typedef EpiResT<false> EpiRes;

DI float dpp_ror1(float v) { return __builtin_bit_cast(float, __builtin_amdgcn_update_dpp(0, __builtin_bit_cast(int, v), 0x121, 0xf, 0xf, false)); }
DI float dpp_ror2(float v) { return __builtin_bit_cast(float, __builtin_amdgcn_update_dpp(0, __builtin_bit_cast(int, v), 0x122, 0xf, 0xf, false)); }
DI float gelu_mul(float x, float uv) {
  const float t = __builtin_fmaf(x * x, 2.0f * LOG2E * 0.7978845608028654f * 0.044715f, 2.0f * LOG2E * 0.7978845608028654f);
  const float r = fast_rcp(fast_exp2(x * t) + 1.0f);
  return __builtin_fmaf(-x, r, x) * uv;
}
constexpr size_t SIDE_ROWS = (size_t)72 * 2 * DFF;
template <bool HALFM> struct EpiP5FT {
  static constexpr bool PERM = true, HAS_MID = false, HAS_RS = true;
  const float* SS; bf16_t* HF; float* out; const float* cw; const float* cb; const float* st; float* side; LAS unsigned char* lds; int layer;
  DI void mid(f32x4 (&)[2][2][4][2], const Unit&, int, int, int, int, int) const {}
  DI f32x4 prefetch(const Unit& u, int tid) const {
    f32x4 v = {0.f, 0.f, 0.f, 0.f};
    if (tid < (HALFM ? 128 : 256)) v = ss_load(SS, u.pm * (HALFM ? 128 : 256) + tid);
    else if (tid >= 256 && tid < 384) { int j = tid - 256; asm volatile("" : "+v"(j));
      const int arr = j >> 5, c4 = (j & 31) * 4; v = *(const f32x4*)((arr < 3 ? cw + arr * DFF : cb) + u.pn * 128 + c4); }
    return v;
  }
  DI void stash(const f32x4& v, const Unit& u, int tid, LAS unsigned char* l) const {
    if (tid < (HALFM ? 128 : 256)) *(LAS float*)(l + 131072 + 12288 + tid * 4) = ss_to_rs(v);
    else if (tid >= 256 && tid < 384) *(LAS f32x4*)(l + 131072 + 13312 + (tid - 256) * 16) = v;
  }
  DI void operator()(f32x4 (&acc)[2][2][4][2], const Unit& u, int wr, int wc, int fr_in, int fq_in) const {
    int fr = fr_in, fq = fq_in; asm volatile("" : "+v"(fr), "+v"(fq));
    const int rin0 = wr * 64 + fr, col0 = u.pn * 128 + wc * 32 + 8 * fq;
    const bool sample = HALFM ? true : u.pm >= 64, cont = !sample && (u.pm & 15) != 0;
    const int bd0 = HALFM ? (u.pm - TOKP / 128) * 2 : (u.pm - 64) * 4;
    LAS float* xh = (LAS float*)(lds + 131072);
    float* TAILG = side; float* HEADC = side + SIDE_ROWS; float* HEADU = side + 2 * SIDE_ROWS;
#pragma unroll
    for (int ai = 0; ai < (HALFM ? 1 : 2); ++ai)
#pragma unroll
      for (int m = 0; m < 4; ++m) { const float s = *(const LAS float*)(lds + 131072 + 12288 + (rin0 + ai * 128 + m * 16) * 4);
#pragma unroll
        for (int n = 0; n < 2; ++n) { acc[ai][0][m][n] *= s; acc[ai][1][m][n] *= s; } }
    if (fr >= 14) {
#pragma unroll
      for (int ai = 0; ai < (HALFM ? 1 : 2); ++ai) { const int gidx = 2 * ai + wr; LAS float* xp = xh + ((gidx * 4 + wc) * 2 + (fr - 14)) * 32 + fq * 8;
        *(LAS f32x4*)xp = acc[ai][0][3][0]; *(LAS f32x4*)(xp + 4) = acc[ai][0][3][1];
        float* cp = nullptr;
        if (sample) cp = out + O_SCONV + ((size_t)(layer * DB + bd0 + gidx) * 2 + (fr - 14)) * DFF + col0;
        else if (gidx == 3) { float* tp = TAILG + ((size_t)u.pm * 2 + (fr - 14)) * DFF + col0; *(f32x4*)tp = acc[ai][0][3][0]; *(f32x4*)(tp + 4) = acc[ai][0][3][1];
          if ((u.pm & 15) == 15) cp = out + O_PCONV + ((size_t)(layer * 4 + (u.pm >> 4)) * 2 + (fr - 14)) * DFF + col0; }
        if (cp) { *(f32x4*)cp = acc[ai][0][3][0]; *(f32x4*)(cp + 4) = acc[ai][0][3][1]; } }
    }
    asm volatile("s_waitcnt lgkmcnt(0)" ::: "memory"); __builtin_amdgcn_s_barrier(); asm volatile("" ::: "memory");
#pragma unroll
    for (int n = 0; n < 2; ++n) {
      const LAS float* cl = (const LAS float*)(lds + 131072 + 13312) + wc * 32 + 8 * fq + 4 * n;
      const f32x4 w0 = *(const LAS f32x4*)cl, w1 = *(const LAS f32x4*)(cl + 128), w2 = *(const LAS f32x4*)(cl + 256), bb = *(const LAS f32x4*)(cl + 384);
#pragma unroll
      for (int ai = 0; ai < (HALFM ? 1 : 2); ++ai) { const int gidx = 2 * ai + wr;
        f32x4 gp = {0.f, 0.f, 0.f, 0.f};
        if (fr >= 14) {
          if (sample) gp = *(const f32x4*)(st + ((size_t)(bd0 + gidx) * 2 + (fr - 14)) * DFF + col0 + 4 * n);
          else if (gidx > 0) gp = *(const LAS f32x4*)(xh + (((gidx - 1) * 4 + wc) * 2 + (fr - 14)) * 32 + fq * 8 + 4 * n);
        }
#pragma unroll
        for (int m = 0; m < 4; ++m) { const int rin = rin0 + ai * 128 + m * 16; f32x4 o, cc;
#pragma unroll
          for (int j = 0; j < 4; ++j) { const float g = acc[ai][0][m][n][j], gq = gp[j];
            const float r1g = dpp_ror1(g), r1q = dpp_ror1(gq), r2g = dpp_ror2(g), r2q = dpp_ror2(gq);
            const float p1 = fr >= 1 ? r1g : r1q, p2 = fr >= 2 ? r2g : r2q;
            const float c = __builtin_fmaf(w2[j], g, __builtin_fmaf(w1[j], p1, __builtin_fmaf(w0[j], p2, bb[j])));
            cc[j] = c; o[j] = gelu_mul(c, acc[ai][1][m][n][j]); }
          *(u32x2*)(HF + (size_t)(u.pm * (HALFM ? 128 : 256) + rin) * DFF + col0 + 4 * n) = pack4(o);
          if (cont && gidx == 0 && m == 0 && fr < 2) { *(f32x4*)(HEADC + ((size_t)u.pm * 2 + fr) * DFF + col0 + 4 * n) = cc; *(f32x4*)(HEADU + ((size_t)u.pm * 2 + fr) * DFF + col0 + 4 * n) = acc[ai][1][m][n]; }
          gp = acc[ai][0][m][n]; }
      }
    }
  }
};
typedef EpiP5FT<false> EpiP5F;
DI void p6_fixup_panel(int pm, const float* side, const float* cw, bf16_t* HF) {
  const float* TAILG = side + (size_t)(pm - 1) * 2 * DFF; const float* HEADC = side + SIDE_ROWS + (size_t)pm * 2 * DFF; const float* HEADU = side + 2 * SIDE_ROWS + (size_t)pm * 2 * DFF;
  int tid_ = threadIdx.x; asm volatile("" : "+v"(tid_));
  constexpr int NIT = (DFF + NTHREADS - 1) / NTHREADS;
  float t0[NIT], t1[NIT], a0[NIT], a1[NIT], hc0[NIT], hc1[NIT], hu0[NIT], hu1[NIT];
#pragma unroll
  for (int i = 0; i < NIT; ++i) { const int k = tid_ + i * NTHREADS; const int kk = k < DFF ? k : 0;
    t0[i] = TAILG[kk]; t1[i] = TAILG[DFF + kk]; a0[i] = cw[kk]; a1[i] = cw[DFF + kk]; hc0[i] = HEADC[kk]; hc1[i] = HEADC[DFF + kk]; hu0[i] = HEADU[kk]; hu1[i] = HEADU[DFF + kk]; }
#pragma unroll
  for (int i = 0; i < NIT; ++i) { const int k = tid_ + i * NTHREADS;
    const float c0 = hc0[i] + a0[i] * t0[i] + a1[i] * t1[i], c1 = hc1[i] + a0[i] * t1[i];
    const float h0 = gelu_mul(c0, hu0[i]), h1 = gelu_mul(c1, hu1[i]);
    f32x4 v = {h0, h1, 0.f, 0.f}; const u32x2 pk = pack4(v);
    if (k < DFF) { HF[(size_t)(pm * 256) * DFF + k] = (bf16_t)(pk[0] & 0xffffu); HF[(size_t)(pm * 256 + 1) * DFF + k] = (bf16_t)(pk[0] >> 16); } }
}

struct EpiNull {
  static constexpr bool PERM = true, HAS_MID = false, HAS_RS = false;
  DI void mid(f32x4 (&)[2][2][4][2], const Unit&, int, int, int, int, int) const {}
  DI void operator()(f32x4 (&acc)[2][2][4][2], const Unit& u, int wr, int wc, int fr, int fq) const {
#pragma unroll
    for (int ai = 0; ai < 2; ++ai)
#pragma unroll
      for (int bj = 0; bj < 2; ++bj)
#pragma unroll
        for (int m = 0; m < 4; ++m)
#pragma unroll
          for (int n = 0; n < 2; ++n) asm volatile("" :: "v"(acc[ai][bj][m][n]));
  }
};

DI float gelu_tanh(float x) {
  const float y = 0.7978845608028654f * (x + 0.044715f * x * x * x);
  const float e = fast_exp2(2.0f * LOG2E * y);
  const float th = 1.0f - 2.0f * fast_rcp(e + 1.0f);
  return 0.5f * x * (1.0f + th);
}
DI void pfinal_norm(const Params& p) {
  const bf16_t* XB = (const bf16_t*)(p.ws + WS_XB); const float* SS = (const float*)(p.ws + WS_SS);
  int tid_ = threadIdx.x; asm volatile("" : "+v"(tid_));
  const int lane = tid_ & 63, gw = blockIdx.x * 8 + (tid_ >> 6), NGW = gridDim.x * 8;
#pragma unroll 3
  for (int m = gw; m < TOK; m += NGW) { const float s = row_rs(SS, m);
#pragma unroll
    for (int j = 0; j < 2; ++j) { const u32x4 w = ((const u32x4*)(XB + (size_t)m * D))[lane + 64 * j];
      const f32x4 g0 = ((const f32x4*)p.norm_final)[2 * (lane + 64 * j)], g1 = ((const f32x4*)p.norm_final)[2 * (lane + 64 * j) + 1];
      const f32x4 a = {bflo(w[0]), bfhi(w[0]), bflo(w[1]), bfhi(w[1])}, b = {bflo(w[2]), bfhi(w[2]), bflo(w[3]), bfhi(w[3])};
      f32x4* o = (f32x4*)(p.out + (size_t)m * D) + 2 * (lane + 64 * j);
      __builtin_nontemporal_store(a * s * g0, o); __builtin_nontemporal_store(b * s * g1, o + 1); } }
}

DI pg8::GemmDesc p1_desc(unsigned char* ws, int l) {
  return pg8::GemmDesc{(const char*)(ws + WS_XB), (const char*)(ws + WS_WIN) + (size_t)l * INC * D * 2, D, D, D / 64, (size_t)256 * D * 2, (size_t)128 * D * 2};
}
DI EpiP1 p1_epi(const Params& p, int l, LAS unsigned char* lds) {
  return EpiP1{(const float*)(p.ws + WS_SS), (bf16_t*)(p.ws + WS_QKV), (bf16_t*)(p.ws + WS_GATE), p.b_gate + (size_t)l * 3 * D, p.out, l, 0, lds};
}
namespace attn {
constexpr int N_CPY = 0, N_CS = 128, N_CP = 512, N_AP = 512, N_BP = 512, N_AS = 256, N_BS = 256, NITEMS = N_CPY + N_CS + N_CP + N_AP + N_BP + N_AS + N_BS;
constexpr float STICK_DONE = 9.35762e-14f;

struct Item { int mode, h, tok0, past, q0, nqv, pflags; const float* cK; const float* cV; };

DI Item decode(const Params& p, int layer, int idx) {
  Item it; it.cK = nullptr; it.cV = nullptr; it.past = 0; it.pflags = 0;
  if (idx < N_CPY) { it.mode = 3; it.h = idx; return it; }
  idx -= N_CPY;
  if (idx < N_CS) { const int bd = idx >> 2, h = idx & 3; it.mode = 2; it.h = h; it.tok0 = TOKP + bd * 64; it.past = PAST; it.q0 = PAST; it.nqv = 64;
    it.cK = p.cache_c_k + (size_t)(layer * DB + bd) * PAST * 512 + h * 128; it.cV = p.cache_c_v + (size_t)(layer * DB + bd) * PAST * 512 + h * 128; return it; }
  idx -= N_CS;
  if (idx < N_CP) { const int jj = 31 - (idx >> 4), rem = idx & 15; it.mode = 2; it.h = rem & 3; it.tok0 = (rem >> 2) * SEQ; it.q0 = jj * 128; it.nqv = 128; return it; }
  idx -= N_CP;
  if (idx < N_AP + N_BP) { const int isb = idx >= N_AP; if (isb) idx -= N_AP; const int qt = 15 - (idx >> 5), rem = idx & 31; it.mode = isb; it.h = rem & 7; it.tok0 = (rem >> 3) * SEQ; it.q0 = qt * 256; it.nqv = 256; return it; }
  idx -= N_AP + N_BP;
  if (idx < N_AS) { const int bd = idx >> 3, h = idx & 7; it.mode = 0; it.h = h; it.tok0 = TOKP + bd * 64; it.past = ALEN; it.q0 = ALEN; it.nqv = 64;
    it.cK = p.cache_a_k + (size_t)(layer * DB + bd) * ALEN * 512 + h * 64; it.cV = p.cache_a_v + (size_t)(layer * DB + bd) * ALEN * 512 + h * 64; return it; }
  idx -= N_AS;
  { const int bd = idx >> 3, h = idx & 7; it.mode = 1; it.h = h; it.tok0 = TOKP + bd * 64; it.past = PAST; it.q0 = PAST; it.nqv = 64;
    it.cK = p.cache_b_k + (size_t)(layer * DB + bd) * PAST * 512 + h * 64; it.cV = p.cache_b_v + (size_t)(layer * DB + bd) * PAST * 512 + h * 64; return it; }
}


template <int MODE, bool SAMPLE>
DI void load_piece(u32x4& r0, u32x4& r1, u32x4& r2, u32x4& r3, const Item& it, const float* cache, const bf16_t* QKV, int col, int kt, int tid) {
  constexpr int CPR = MODE == 2 ? 16 : 8;
  const int j0 = kt * 64;
  const int ra = tid / CPR, ca = tid % CPR;
  if (SAMPLE && j0 < it.past) {
    const unsigned lo = (unsigned)(ra * 512 + ca * 8) * 4u; const char* b = (const char*)(cache + (size_t)j0 * 512);
    { const u32x4* q = (const u32x4*)(b + lo); r0 = __builtin_nontemporal_load(q); r1 = __builtin_nontemporal_load(q + 1); }
    if constexpr (MODE == 2) { const u32x4* q = (const u32x4*)(b + (size_t)32 * 512 * 4 + lo); r2 = __builtin_nontemporal_load(q); r3 = __builtin_nontemporal_load(q + 1); }
  } else {
    const unsigned lo = (unsigned)(ra * QKVW + ca * 8) * 2u; const char* b = (const char*)(QKV + (size_t)(it.tok0 + j0 - it.past) * QKVW + col);
    r0 = *(const u32x4*)(b + lo);
    if constexpr (MODE == 2) r2 = *(const u32x4*)(b + (size_t)32 * QKVW * 2 + lo);
  }
}
DI u32x4 cvt8(u32x4 a, u32x4 b) { return pack8(__builtin_bit_cast(f32x4, a), __builtin_bit_cast(f32x4, b)); }
template <int MODE, bool ISK, bool SAMPLE>
DI void write_piece(const u32x4& r0, const u32x4& r1, const u32x4& r2, const u32x4& r3, const Item& it, LAS unsigned char* buf, int kt, int tid) {
  constexpr int CPR = MODE == 2 ? 16 : 8, VS = MODE == 2 ? 320 : 192;
  const bool f32src = SAMPLE && kt * 64 < it.past;
  const int ra = tid / CPR, ca = tid % CPR, rb = (tid + NTHREADS) / CPR, cb = (tid + NTHREADS) % CPR;
  { const u32x4 x = f32src ? cvt8(r0, r1) : r0;
    if (ISK) *(LAS u32x4*)(buf + ((MODE == 2 && ca >= 8) ? 8192 : 0) + ra * 128 + (((ca & 7) ^ ((ra >> 1) & 7)) << 4)) = x;
    else *(LAS u32x4*)(buf + ra * VS + ca * 16) = x; }
  if constexpr (MODE == 2) { const u32x4 x = f32src ? cvt8(r2, r3) : r2;
    if (ISK) *(LAS u32x4*)(buf + (cb >= 8 ? 8192 : 0) + rb * 128 + (((cb & 7) ^ ((rb >> 1) & 7)) << 4)) = x;
    else *(LAS u32x4*)(buf + rb * VS + cb * 16) = x; }
}

template <int MODE>
DI void state_store(const u32x4& r0, const u32x4& r2, float* dst, int tid) {
  constexpr int CPR = MODE == 2 ? 16 : 8;
  const int ra = tid / CPR, ca = tid % CPR, rb = (tid + NTHREADS) / CPR, cb = (tid + NTHREADS) % CPR;
  { float* q = dst + (size_t)ra * 512 + ca * 8;
    __builtin_nontemporal_store((f32x4){bflo(r0[0]), bfhi(r0[0]), bflo(r0[1]), bfhi(r0[1])}, (f32x4*)q); __builtin_nontemporal_store((f32x4){bflo(r0[2]), bfhi(r0[2]), bflo(r0[3]), bfhi(r0[3])}, (f32x4*)(q + 4)); }
  if constexpr (MODE == 2) { float* q = dst + (size_t)rb * 512 + cb * 8;
    __builtin_nontemporal_store((f32x4){bflo(r2[0]), bfhi(r2[0]), bflo(r2[1]), bfhi(r2[1])}, (f32x4*)q); __builtin_nontemporal_store((f32x4){bflo(r2[2]), bfhi(r2[2]), bflo(r2[3]), bfhi(r2[3])}, (f32x4*)(q + 4)); }
}
template <int MODE>
DI float* state_dst(const Params& p, int layer, const Item& it, int kt, int isv) {
  const int hoff = MODE == 2 ? it.h * 128 : it.h * 64;
  if (it.past == 0) {
    const int t0 = kt * 64; if (t0 < it.q0 || t0 >= it.q0 + it.nqv) return nullptr;
    const int b = it.tok0 / SEQ;
    if (MODE == 0) { if (t0 < SEQ - 512) return nullptr; return p.out + (isv ? O_PAV : O_PAK) + ((size_t)(layer * 4 + b) * 512 + (t0 - (SEQ - 512))) * 512 + hoff; }
    return p.out + (MODE == 1 ? (isv ? O_PBV : O_PBK) : (isv ? O_PCV : O_PCK)) + ((size_t)(layer * 4 + b) * SEQ + t0) * 512 + hoff;
  } else {
    if (kt * 64 != it.past) return nullptr;
    const int bd = (it.tok0 - TOKP) / 64;
    if (MODE == 0) return p.out + (isv ? O_SAV : O_SAK) + ((size_t)(layer * DB + bd) * 512 + 448) * 512 + hoff;
    return p.out + (MODE == 1 ? (isv ? O_SBV : O_SBK) : (isv ? O_SCV : O_SCK)) + ((size_t)(layer * DB + bd) * 64) * 512 + hoff;
  }
}

DI void roll_store(const u32x4& r0, const u32x4& r1, const Params& p, int layer, const Item& it, int kt, int isv, int tid) {
  if (kt < 1 || kt * 64 >= it.past) return;
  const int bd = (it.tok0 - TOKP) / 64, ra = tid >> 3, ca = tid & 7;
  float* q = p.out + (isv ? O_SAV : O_SAK) + ((size_t)(layer * DB + bd) * 512 + (kt - 1) * 64 + ra) * 512 + it.h * 64 + ca * 8;
  __builtin_nontemporal_store(__builtin_bit_cast(f32x4, r0), (f32x4*)q); __builtin_nontemporal_store(__builtin_bit_cast(f32x4, r1), (f32x4*)(q + 4));
}
DI bf16x8 pack_p(const f32x16& x, int s) {
  const f32x4 a = {x[8 * s], x[8 * s + 1], x[8 * s + 2], x[8 * s + 3]}, b = {x[8 * s + 4], x[8 * s + 5], x[8 * s + 6], x[8 * s + 7]};
  return __builtin_bit_cast(bf16x8, pack8(a, b));
}
#define MFMA32(a, b, c) __builtin_amdgcn_mfma_f32_32x32x16_bf16((a), (b), (c), 0, 0, 0)

constexpr int L_KB = 0, KB_BYTES = 16384, L_VB = 32768, VB_BYTES = 20480, L_LUT = 73728, L_FLAGS = 75776, L_XCH = 81920;

template <int MODE, bool SAMPLE>
DI void run_item(const Params& p, int layer, const Item& it, LAS unsigned char* lds_in) {
  LAS unsigned char* lds = opaque_lds(lds_in);
  constexpr int NDV = MODE == 2 ? 4 : 2, VS = MODE == 2 ? 320 : 192;
  int tid_ = threadIdx.x; asm volatile("" : "+v"(tid_));
  const int tid = tid_, lane = tid & 63, wave = __builtin_amdgcn_readfirstlane(tid >> 6);
  const int qi = lane & 31, h2 = lane >> 5;
  const int mp = MODE == 2 ? (wave >> 2) : 0, wrow = MODE == 2 ? (wave & 3) : wave;
  const int q0w = it.q0 + 32 * wrow;
  const bool active = 32 * wrow < it.nqv;
  const bf16_t* QKV = (const bf16_t*)(p.ws + WS_QKV);
  const int hb = MODE == 2 ? it.h * 128 : it.h * 64;
  const int qcol = (MODE == 0 ? 0 : MODE == 1 ? 1536 : 3072) + hb + 64 * mp, kcol = (MODE == 0 ? 512 : MODE == 1 ? 2048 : 3584) + hb, vcol = (MODE == 0 ? 1024 : MODE == 1 ? 2560 : 4096) + hb;
  const int cw = q0w >> 6;
  int kt_first, step, NT;
  if (MODE == 0) { kt_first = (it.q0 >> 6) - 8; if (kt_first < 0) kt_first = 0; step = 1; NT = ((it.q0 + it.nqv - 1) >> 6) - kt_first + 1; }
  else if (MODE == 2) { kt_first = 0; step = 1; NT = ((it.q0 + it.nqv - 1) >> 6) + 1; }
  else { kt_first = (it.q0 + it.nqv - 2) >> 6; step = -1; NT = kt_first + 1; }
  const bool wr_state = it.pflags == 0;
  u32x4 k0 = {}, k1 = {}, k2 = {}, k3 = {}, v0 = {}, v1 = {}, v2 = {}, v3 = {};
  load_piece<MODE, SAMPLE>(k0, k1, k2, k3, it, it.cK, QKV, kcol, kt_first, tid);
  load_piece<MODE, SAMPLE>(v0, v1, v2, v3, it, it.cV, QKV, vcol, kt_first, tid);
  LAS float* lut = (LAS float*)(lds + L_LUT);
  LAS unsigned* flags = (LAS unsigned*)(lds + L_FLAGS);
  if (MODE == 0) { const float bfar = p.a_rel_bias[((size_t)layer * 257 + 256) * 8 + it.h]; for (int i = tid; i < 257; i += NTHREADS) lut[i] = p.a_rel_bias[((size_t)layer * 257 + i) * 8 + it.h] - bfar; }
  if (MODE == 2) { if (tid < 192) lut[tid] = ((const float*)(p.ws + WS_CTL))[CW_T5 + it.h * 192 + tid]; }
  bf16x8 qf[4];
  if (active) { const bf16_t* qp = QKV + (size_t)(it.tok0 + q0w + qi - it.past) * QKVW + qcol + 8 * h2;
#pragma unroll
    for (int s = 0; s < 4; ++s) { const u32x4 w = *(const u32x4*)(qp + 16 * s);
      const f32x4 a = {bflo(w[0]) * 0.125f, bfhi(w[0]) * 0.125f, bflo(w[1]) * 0.125f, bfhi(w[1]) * 0.125f}, b = {bflo(w[2]) * 0.125f, bfhi(w[2]) * 0.125f, bflo(w[3]) * 0.125f, bfhi(w[3]) * 0.125f};
      qf[s] = __builtin_bit_cast(bf16x8, pack8(a, b)); } }
  f32x16 O[NDV];
#pragma unroll
  for (int b = 0; b < NDV; ++b)
#pragma unroll
    for (int i = 0; i < 16; ++i) O[b][i] = 0.f;
  float m_run = -1e30f, l_run = 0.f, R2 = 1.0f; bool done = false, have_p = false;
  bf16x8 pf[4];
#pragma unroll
  for (int s = 0; s < 4; ++s) pf[s] = (bf16x8){0, 0, 0, 0, 0, 0, 0, 0};
  const int krow_off = qi * 128, kswz = (qi >> 1) & 7;
  const int g16 = lane >> 4, trq = (lane & 15) >> 2, trp = lane & 3;
  const int vtr_off = (4 * (g16 >> 1) + trq) * VS + (16 * (g16 & 1) + 4 * trp) * 2;

  write_piece<MODE, true, SAMPLE>(k0, k1, k2, k3, it, lds + L_KB, kt_first, tid);
  if (wr_state) { float* d = state_dst<MODE>(p, layer, it, kt_first, 0); if (d) state_store<MODE>(k0, k2, d, tid); }
  if (MODE == 0 && SAMPLE && wr_state) roll_store(k0, k1, p, layer, it, kt_first, 0, tid);
  if (NT > 1) load_piece<MODE, SAMPLE>(k0, k1, k2, k3, it, it.cK, QKV, kcol, kt_first + step, tid);
  for (int t = 0;; ++t) {
    __syncthreads();
    if (MODE == 1 && t > 0 && t < NT) { const unsigned any = flags[0] | flags[1] | flags[2] | flags[3] | flags[4] | flags[5] | flags[6] | flags[7]; if (!any) NT = t; }
    const int kt = kt_first + step * t;
    bool mine = false;
    if (t < NT && !(it.pflags & 2)) {
      if (MODE == 0) mine = active && kt >= cw - 8 && kt <= cw;
      else if (MODE == 2) mine = active && kt <= cw;
      else mine = active && !done && kt * 64 <= q0w + 30;
    }
    LAS unsigned char* vb = lds + L_VB + ((t - 1) & 1) * VB_BYTES + vtr_off;
    LAS unsigned char* kb = lds + L_KB + (t & 1) * KB_BYTES + ((MODE == 2 && mp) ? 8192 : 0);
    constexpr int HB = NDV / 2, NST = 4 * HB;
    bf16x8 kfa[4], vfa[2], vfb[2];
    const bool do_pv = have_p && !(it.pflags & 8);
#define V_LOAD(dst, j_) do { if (do_pv) { _Pragma("unroll") for (int bb = 0; bb < 2; ++bb) { const int a0 = 16 * ((j_) / HB) * VS + 64 * (2 * ((j_) % HB) + bb); \
      const s16x4 lo = __builtin_amdgcn_ds_read_tr16_b64_v4i16((LAS s16x4*)(vb + a0)), hi = __builtin_amdgcn_ds_read_tr16_b64_v4i16((LAS s16x4*)(vb + a0 + 8 * VS)); \
      dst[bb] = __builtin_shufflevector(lo, hi, 0, 1, 2, 3, 4, 5, 6, 7); } } } while (0)
#define V_MMA(src, j_) do { if (do_pv) { _Pragma("unroll") for (int bb = 0; bb < 2; ++bb) O[2 * ((j_) % HB) + bb] = MFMA32(src[bb], pf[(j_) / HB], O[2 * ((j_) % HB) + bb]); } } while (0)
#define STG(j_, cur, nxt) do { if (SAMPLE) { V_LOAD(cur, j_); V_MMA(cur, j_); } else { if ((j_) + 1 < NST) V_LOAD(nxt, (j_) + 1); V_MMA(cur, j_); } } while (0)
    if (!SAMPLE) {
      if (mine) {
#pragma unroll
        for (int s = 0; s < 4; ++s) kfa[s] = *(const LAS bf16x8*)(kb + krow_off + (((2 * s + h2) ^ kswz) << 4)); }
      V_LOAD(vfa, 0);
      __builtin_amdgcn_sched_barrier(0);
    }
    if (t < NT && !(it.pflags & 1)) { write_piece<MODE, false, SAMPLE>(v0, v1, v2, v3, it, lds + L_VB + (t & 1) * VB_BYTES, kt_first + step * t, tid);
      if (wr_state) { float* d = state_dst<MODE>(p, layer, it, kt_first + step * t, 1); if (d) state_store<MODE>(v0, v2, d, tid); }
      if (MODE == 0 && SAMPLE && wr_state) roll_store(v0, v1, p, layer, it, kt_first + step * t, 1, tid);
      if (t + 1 < NT) { write_piece<MODE, true, SAMPLE>(k0, k1, k2, k3, it, lds + L_KB + ((t + 1) & 1) * KB_BYTES, kt_first + step * (t + 1), tid);
        if (wr_state) { float* d = state_dst<MODE>(p, layer, it, kt_first + step * (t + 1), 0); if (d) state_store<MODE>(k0, k2, d, tid); }
        if (MODE == 0 && SAMPLE && wr_state) roll_store(k0, k1, p, layer, it, kt_first + step * (t + 1), 0, tid);
        load_piece<MODE, SAMPLE>(v0, v1, v2, v3, it, it.cV, QKV, vcol, kt_first + step * (t + 1), tid);
        if (t + 2 < NT) load_piece<MODE, SAMPLE>(k0, k1, k2, k3, it, it.cK, QKV, kcol, kt_first + step * (t + 2), tid); } }
    __builtin_amdgcn_sched_barrier(0);
    f32x16 sA, sB;
#pragma unroll
    for (int i = 0; i < 16; ++i) { sA[i] = 0.f; sB[i] = 0.f; }
    if (mine) {
      bf16x8 kfc[4];
      if (SAMPLE) {
#pragma unroll
        for (int s = 0; s < 4; ++s) kfa[s] = *(const LAS bf16x8*)(kb + krow_off + (((2 * s + h2) ^ kswz) << 4)); }
#pragma unroll
      for (int s = 0; s < 4; ++s) kfc[s] = *(const LAS bf16x8*)(kb + 4096 + krow_off + (((2 * s + h2) ^ kswz) << 4));
#pragma unroll
      for (int s = 0; s < 4; ++s) sA = MFMA32(kfa[s], qf[s], sA);
#pragma unroll
      for (int s = 0; s < 4; ++s) sB = MFMA32(kfc[s], qf[s], sB);
    }
    const int kbase = kt * 64 + 4 * h2;
    if (MODE != 1) {
      float mx = -1e30f, alpha = 1.0f, lsa = 0.f, lsb = 0.f; bool resc = false;
      const bool smx = mine && !(it.pflags & 4);
      STG(0, vfa, vfb);
      if (NST == 8) STG(1, vfb, vfa);
      if (smx) {
        bool cst;
        if (MODE == 0) cst = q0w - (kt * 64 + 63) >= 128; else cst = kt * 64 + 63 - q0w <= -127;
        if (!cst) {
#pragma unroll
          for (int i = 0; i < 16; ++i) { const int ko = (i & 3) + 8 * (i >> 2);
            int ia, ib;
            if (MODE == 0) { const int d = (q0w + qi) - (kbase + ko); ia = d; ib = d - 32; ia = (ia < -128 ? -128 : ia > 128 ? 128 : ia) + 128; ib = (ib < -128 ? -128 : ib > 128 ? 128 : ib) + 128; }
            else { const int d = (kbase + ko) - (q0w + qi); ia = d; ib = d + 32; ia = (ia < -127 ? -127 : ia > 63 ? 63 : ia) + 127; ib = (ib < -127 ? -127 : ib > 63 ? 63 : ib) + 127; }
            sA[i] += lut[ia]; sB[i] += lut[ib]; }
        }
        float m0 = fmaxf(fmaxf(sA[0], sA[1]), sA[2]), m1 = fmaxf(fmaxf(sB[0], sB[1]), sB[2]);
#pragma unroll
        for (int i = 3; i < 15; i += 2) { m0 = fmaxf(fmaxf(m0, sA[i]), sA[i + 1]); m1 = fmaxf(fmaxf(m1, sB[i]), sB[i + 1]); }
        mx = fmaxf(fmaxf(m0, m1), fmaxf(sA[15], sB[15]));
      }
      __builtin_amdgcn_sched_barrier(0);
      if (NST == 8) { STG(2, vfa, vfb); STG(3, vfb, vfa); } else STG(1, vfb, vfa);
      if (smx) {
        mx = fmaxf(mx, __shfl_xor(mx, 32)) * LOG2E;
        resc = !__all(mx <= m_run + 8.0f);
        if (resc) { const float mnew = fmaxf(m_run, mx); alpha = fast_exp2(m_run - mnew); m_run = mnew; l_run *= alpha; }
#pragma unroll
        for (int i = 0; i < 16; ++i) { sA[i] = fast_exp2(__builtin_fmaf(sA[i], LOG2E, -m_run)); lsa += sA[i]; }
      }
      __builtin_amdgcn_sched_barrier(0);
      if (NST == 8) { STG(4, vfa, vfb); STG(5, vfb, vfa); } else STG(2, vfa, vfb);
      if (smx) {
#pragma unroll
        for (int i = 0; i < 16; ++i) { sB[i] = fast_exp2(__builtin_fmaf(sB[i], LOG2E, -m_run)); lsb += sB[i]; }
        l_run += lsa + lsb;
      }
      __builtin_amdgcn_sched_barrier(0);
      if (NST == 8) { STG(6, vfa, vfb); STG(7, vfb, vfa); } else STG(3, vfb, vfa);
      __builtin_amdgcn_sched_barrier(0);
      if (mine) {
        if (resc) {
#pragma unroll
        for (int b = 0; b < NDV; ++b)
#pragma unroll
          for (int i = 0; i < 16; ++i) O[b][i] *= alpha;
        }
        pf[0] = pack_p(sA, 0); pf[1] = pack_p(sA, 1); pf[2] = pack_p(sB, 0); pf[3] = pack_p(sB, 1);
      }
    } else {
      STG(0, vfa, vfb); STG(1, vfb, vfa); STG(2, vfa, vfb); STG(3, vfb, vfa);
      if (mine) {
        const bool diag = kt * 64 + 63 >= q0w;
        float kpA[16], kpB[16];
#pragma unroll
        for (int i = 0; i < 16; ++i) { const int ko = (i & 3) + 8 * (i >> 2);
          { const float r = fast_rcp(1.0f + fast_exp2(sA[i] * LOG2E)); const bool ok = !diag || (kbase + ko) < (q0w + qi); kpA[i] = ok ? r : 1.0f; sA[i] = ok ? 1.0f - r : 0.0f; }
          { const float r = fast_rcp(1.0f + fast_exp2(sB[i] * LOG2E)); const bool ok = !diag || (kbase + 32 + ko) < (q0w + qi); kpB[i] = ok ? r : 1.0f; sB[i] = ok ? 1.0f - r : 0.0f; } }
        float gs[8], pg[8];
#pragma unroll
        for (int g = 0; g < 4; ++g) { gs[g] = (kpA[4 * g] * kpA[4 * g + 1]) * (kpA[4 * g + 2] * kpA[4 * g + 3]); gs[4 + g] = (kpB[4 * g] * kpB[4 * g + 1]) * (kpB[4 * g + 2] * kpB[4 * g + 3]); }
#pragma unroll
        for (int g = 0; g < 8; ++g) pg[g] = __shfl_xor(gs[g], 32);
        float suf = R2;
#pragma unroll
        for (int g = 7; g >= 0; --g) { const float off = suf * (h2 == 0 ? pg[g] : 1.0f);
          if (g >= 4) { const int b = 4 * (g - 4); const float a3 = off, a2 = a3 * kpB[b + 3], a1 = a2 * kpB[b + 2], a0 = a1 * kpB[b + 1];
            sB[b + 3] *= a3; sB[b + 2] *= a2; sB[b + 1] *= a1; sB[b] *= a0; }
          else { const int b = 4 * g; const float a3 = off, a2 = a3 * kpA[b + 3], a1 = a2 * kpA[b + 2], a0 = a1 * kpA[b + 1];
            sA[b + 3] *= a3; sA[b + 2] *= a2; sA[b + 1] *= a1; sA[b] *= a0; }
          suf *= gs[g] * pg[g]; }
        R2 = suf;
        done = __all(R2 < STICK_DONE) != 0;
        pf[0] = pack_p(sA, 0); pf[1] = pack_p(sA, 1); pf[2] = pack_p(sB, 0); pf[3] = pack_p(sB, 1);
      }
    }
#undef V_LOAD
#undef V_MMA
#undef STG
    have_p = mine;
    if (MODE == 1 && t < NT) { if (lane == 0) flags[wave] = (active && !done && kt > 0 && (kt - 1) * 64 <= q0w + 30) ? 1u : 0u; }
    if (t >= NT) break;
  }
  int lane_e = lane; asm volatile("" : "+v"(lane_e));
  const int qi_e = lane_e & 31, h2_e = lane_e >> 5;
  bf16_t* Ob = (bf16_t*)(p.ws + WS_O);
  const int ocol = MODE == 0 ? hb : MODE == 1 ? 512 + hb : 1024 + hb;
  const bool wr_out = it.pflags == 0;
  if (MODE != 2) {
    if (active && wr_out) { float sc = 1.f; if (MODE == 0) { const float lt = l_run + __shfl_xor(l_run, 32); sc = fast_rcp(lt); }
      bf16_t* op = Ob + (size_t)(it.tok0 + q0w + qi_e - it.past) * OW + ocol + 4 * h2_e;
#pragma unroll
      for (int b = 0; b < NDV; ++b)
#pragma unroll
        for (int g = 0; g < 4; ++g) { const f32x4 v = {O[b][4 * g] * sc, O[b][4 * g + 1] * sc, O[b][4 * g + 2] * sc, O[b][4 * g + 3] * sc}; *(u32x2*)(op + 32 * b + 8 * g) = pack4(v); } }
    __syncthreads();
  } else {
    const float lam = ((const float*)(p.ws + WS_CTL))[CW_LAM + layer];
    const float sub_scale = 1.0f - (0.8f - 0.6f * expf(-0.3f * (float)layer));
    LAS float* xch = (LAS float*)(lds + L_XCH);
    if (active && mp == 1) { const float lt = l_run + __shfl_xor(l_run, 32), sc = lam * fast_rcp(lt);
#pragma unroll
      for (int b = 0; b < NDV; ++b)
#pragma unroll
        for (int i = 0; i < 16; ++i) xch[((wave & 3) * 64 + b * 16 + i) * 64 + lane_e] = O[b][i] * sc; }
    __syncthreads();
    if (active && mp == 0 && wr_out) { const float lt = l_run + __shfl_xor(l_run, 32), sc = fast_rcp(lt); float q = 0.f;
#pragma unroll
      for (int b = 0; b < NDV; ++b)
#pragma unroll
        for (int i = 0; i < 16; ++i) { const float o = O[b][i] * sc - xch[((wave & 3) * 64 + b * 16 + i) * 64 + lane_e]; O[b][i] = o; q += o * o; if ((i & 7) == 7) __builtin_amdgcn_sched_barrier(0); }
      q += __shfl_xor(q, 32);
      const float rstd = __builtin_amdgcn_rsqf(q * (1.0f / 128.0f) + EPS) * sub_scale;
      const float* gain = p.c_subln + layer * 128 + 4 * h2_e;
      bf16_t* op = Ob + (size_t)(it.tok0 + q0w + qi_e - it.past) * OW + ocol + 4 * h2_e;
#pragma unroll
      for (int b = 0; b < NDV; ++b)
#pragma unroll
        for (int g = 0; g < 4; ++g) { const f32x4 gn = *(const f32x4*)(gain + 32 * b + 8 * g);
          const f32x4 v = {O[b][4 * g] * rstd * gn[0], O[b][4 * g + 1] * rstd * gn[1], O[b][4 * g + 2] * rstd * gn[2], O[b][4 * g + 3] * rstd * gn[3]}; *(u32x2*)(op + 32 * b + 8 * g) = pack4(v); } }
    __syncthreads();
  }
}

DI void copy_item(const Params& p, int layer, int idx) {
  const int which = idx >> 5, bd = idx & 31;
  const size_t lb = (size_t)layer * DB + bd;
  const f32x4* src = (const f32x4*)((which ? p.cache_a_v : p.cache_a_k) + lb * 512 * 512 + 64 * 512);
  f32x4* dst = (f32x4*)(p.out + (which ? O_SAV : O_SAK) + lb * 512 * 512);
  int tid_ = threadIdx.x; asm volatile("" : "+v"(tid_));
#pragma unroll 4
  for (int i = tid_; i < 448 * 128; i += NTHREADS) __builtin_nontemporal_store(__builtin_nontemporal_load(src + i), dst + i);
}
#ifndef PROBE_ATT_FLAGS
#define PROBE_ATT_FLAGS 0
#endif
#ifndef PROBE_ATT_LO
#define PROBE_ATT_LO 0
#define PROBE_ATT_HI NITEMS
#endif
DI void attn_phase(const Params& p, int qidx, LAS unsigned char* lds) {
  const int layer = qidx & 1; const int i_lo = qidx >= 2 ? PROBE_ATT_LO : 0, i_hi = qidx >= 2 ? PROBE_ATT_HI : NITEMS;
  unsigned* head = (unsigned*)(p.ws + WS_CTL) + CW_QUEUE + 64 * qidx;
  LAS unsigned* slot = (LAS unsigned*)(lds + LDS_BYTES - 48);
  if (threadIdx.x == 0) slot[0] = atomicAdd(head, 1u);
  for (int k = 0;; ++k) {
    __syncthreads();
    const int idx = __builtin_amdgcn_readfirstlane((int)slot[k & 1]) + i_lo;
    if (threadIdx.x == 0) slot[(k + 1) & 1] = atomicAdd(head, 1u);
    if (idx >= i_hi) break;
    Item it = decode(p, layer, idx); it.pflags = qidx >= 2 ? PROBE_ATT_FLAGS : 0;
    if (it.mode == 3) { if (qidx < 2) copy_item(p, layer, it.h); continue; }
    if (it.past == 0) { if (it.mode == 0) run_item<0, false>(p, layer, it, lds); else if (it.mode == 1) run_item<1, false>(p, layer, it, lds); else run_item<2, false>(p, layer, it, lds); }
    else { if (it.mode == 0) run_item<0, true>(p, layer, it, lds); else if (it.mode == 1) run_item<1, true>(p, layer, it, lds); else run_item<2, true>(p, layer, it, lds); }
  }
}
}
#define XB_TMO      128
#define XB_XCNT(j)  (256  + 64 * (j))
#define XB_XSUB(j)  (1280 + 64 * (j))
#define XB_XGEN(j)  (2304 + 64 * (j))
#define XB_TOP      3328
#define XB_TOPGEN   3392
#define XCD_BAR_WORDS 3456
#define XB_SPIN_CAP (1u << 18)
DI unsigned xb_ld(unsigned* p)              { return __hip_atomic_load(p, __ATOMIC_RELAXED, __HIP_MEMORY_SCOPE_AGENT); }
DI unsigned xb_add(unsigned* p, unsigned v) { return __hip_atomic_fetch_add(p, v, __ATOMIC_RELAXED, __HIP_MEMORY_SCOPE_AGENT); }
DI unsigned xb_xcc_id() { return (unsigned)__builtin_amdgcn_s_getreg((3 << 11) | 20) & 0xFu; }
#define XB_SPIN(cond, bar) do { unsigned _sp = 0; while (cond) { __builtin_amdgcn_s_sleep(1); \
    if ((++_sp & 255u) == 0u) { if (xb_ld(&(bar)[XB_TMO])) break; if (_sp > XB_SPIN_CAP) { atomicAdd(&(bar)[XB_TMO], 1u); break; } } } } while (0)
struct XcdBarrier { unsigned* bar; unsigned x; volatile LAS unsigned* st; };
DI XcdBarrier xcd_barrier_post(unsigned* bar, volatile LAS unsigned* st) {
  XcdBarrier b; b.bar = bar; b.x = xb_xcc_id(); b.st = st;
  if (threadIdx.x == 0) (void)xb_add(&bar[XB_XCNT(b.x)], 1u);
  return b;
}
DI void xcd_barrier_complete(unsigned* bar, unsigned x, unsigned& nloc, unsigned& nx) {
  const unsigned G = gridDim.x * gridDim.y * gridDim.z;
  unsigned sum, cnt, mine, sp = 0u;
  for (;;) {
    sum = 0u; cnt = 0u; mine = 0u;
#pragma unroll
    for (unsigned j = 0; j < 16; ++j) { const unsigned c = xb_ld(&bar[XB_XCNT(j)]); sum += c; cnt += (c > 0u) ? 1u : 0u; mine = (j == x) ? c : mine; }
    if (sum == G) break;
    __builtin_amdgcn_s_sleep(1);
    if ((++sp & 255u) == 0u) { if (xb_ld(&bar[XB_TMO])) break; if (sp > XB_SPIN_CAP) { atomicAdd(&bar[XB_TMO], 1u); break; } }
  }
  nloc = mine > 0u ? mine : 1u; nx = cnt > 0u ? cnt : 1u;
}
DI void xcd_barrier(const XcdBarrier& b) {
  asm volatile("s_waitcnt vmcnt(0)" ::: "memory");
  __syncthreads();
  if (threadIdx.x == 0) {
    unsigned* bar = b.bar;
    __builtin_amdgcn_s_waitcnt(0);
    unsigned nloc = b.st[0], nx = b.st[1];
    if (nloc == 0u) { xcd_barrier_complete(bar, b.x, nloc, nx); b.st[0] = nloc; b.st[1] = nx; }
    const unsigned old = xb_add(&bar[XB_XSUB(b.x)], 1u);
    const unsigned gen = old / nloc;
    if (old + 1u == (gen + 1u) * nloc) {
      __builtin_amdgcn_fence(__ATOMIC_RELEASE, "agent");
      asm volatile("s_waitcnt vmcnt(0)" ::: "memory");
      const unsigned og = xb_add(&bar[XB_TOP], 1u);
      const unsigned tg = og / nx;
      if (og + 1u == (tg + 1u) * nx) xb_add(&bar[XB_TOPGEN], 1u);
      else XB_SPIN(xb_ld(&bar[XB_TOPGEN]) == tg, bar);
      __builtin_amdgcn_fence(__ATOMIC_ACQUIRE, "agent");
      xb_add(&bar[XB_XGEN(b.x)], 1u);
      asm volatile("s_waitcnt vmcnt(0)" ::: "memory");
    } else {
      XB_SPIN(xb_ld(&bar[XB_XGEN(b.x)]) == gen, bar);
      __builtin_amdgcn_fence(__ATOMIC_ACQUIRE, "agent");
      asm volatile("s_waitcnt vmcnt(0)" ::: "memory");
    }
  }
  __syncthreads();
}
constexpr int L_BARST = LDS_BYTES - 64;

#ifndef PROBE_P1_FLAGS
#define PROBE_P1_FLAGS 0
#endif
#ifndef PROBE_NULL_EPI
#define PROBE_NULL_EPI 0
#endif
#ifndef PROBE_MASK
#define PROBE_MASK 0
#endif
#define REPEAT(k) for (int rep_ = 0; rep_ < (((PROBE_MASK >> (k)) & 1) ? 2 : 1); ++rep_)
constexpr int NPHASE = 2 + 6 * NLAYER;
__global__ void __launch_bounds__(NTHREADS, 2) fwd_megakernel(Params p_k) {
  extern __shared__ __attribute__((aligned(16))) unsigned char lds_raw[];
  LAS unsigned char* lds = (LAS unsigned char*)lds_raw;
  cg::grid_group grid = cg::this_grid();
  const int lo = p_k.ph_lo, hi = p_k.ph_hi;
#define IN(k) (lo <= (k) && (k) < hi)
#define SEAM(k) do { if (IN(k) && IN((k) + 1)) xcd_barrier(bar); } while (0)
  const int G = gridDim.x, c = blockIdx.x;
  if (threadIdx.x < 2) ((LAS unsigned*)(lds + L_BARST))[threadIdx.x] = 0u;
  XcdBarrier bar; bar.bar = (unsigned*)(p_k.ws + WS_CTL) + CW_BAR; bar.x = 0; bar.st = (volatile LAS unsigned*)(lds + L_BARST);
  if (p_k.ph_lo < 0) grid.sync();
  bar = xcd_barrier_post((unsigned*)(p_k.ws + WS_CTL) + CW_BAR, (volatile LAS unsigned*)(lds + L_BARST));
  if (IN(0)) { p0_prologue(p_k, lds); if ((PROBE_MASK >> 6) & 1) { __syncthreads(); p0_prologue(p_k, lds); } }
  SEAM(0);
  for (int l = 0; l < NLAYER; ++l) {
    const int pb = 1 + 6 * l;
    const Params& p = p_k; unsigned char* ws = p.ws;
    if (IN(pb + 0)) REPEAT(0) {
      pg8::GemmDesc g{(const char*)(ws + WS_XB), (const char*)(ws + WS_WIN) + (size_t)l * INC * D * 2, D, D, D / 64, (size_t)256 * D * 2, (size_t)128 * D * 2};
      pg8::P1Order S; S.R1.init(TOK / 256, pg8::P1_NN, G, c);
      EpiP1 E{(const float*)(ws + WS_SS), (bf16_t*)(ws + WS_QKV), (bf16_t*)(ws + WS_GATE), p.b_gate + (size_t)l * 3 * D, p.out, l, rep_ == 1 ? PROBE_P1_FLAGS : 0, lds};
#if PROBE_NULL_EPI
      if (rep_ == 1) { EpiNull EN; pg8::gemm_phase<EpiNull, false, false, pg8::P1Order>(lds, g, S, EN); } else
#endif
      pg8::gemm_phase<EpiP1, false, false, pg8::P1Order>(lds, g, S, E);
    }
    SEAM(pb + 0);
    if (IN(pb + 1)) REPEAT(1) {
      for (int j = G - 1 - c; j < pg8::P1_DEFER; j += G) { pg8::OneUnit S1; S1.u = pg8::p1_deferred_unit(j);
        pg8::gemm_phase<EpiP1, false, false, pg8::OneUnit>(lds, p1_desc(ws, l), S1, p1_epi(p, l, lds)); }
      attn::attn_phase(p, l + 2 * rep_, lds); }
    SEAM(pb + 1);
    if (IN(pb + 2)) REPEAT(2) {
      pg8::GemmDesc g{(const char*)(ws + WS_O), (const char*)(ws + WS_WBR) + (size_t)l * D * OW * 2, OW, OW, OW / 64, (size_t)256 * OW * 2, (size_t)128 * OW * 2};
      pg8::StaticOrder S; S.init(TOKP / 256, D / 256, G, c);
      EpiP3 E{(const bf16_t*)(ws + WS_GATE), (bf16_t*)(ws + WS_H)};
      pg8::gemm_phase<EpiP3>(lds, g, S, E);
      pg8::GemmDesc gh = g; gh.b_tile = (size_t)128 * OW * 2;
      pg8::StaticOrder S2; S2.init(TOKS / 128, D / 128, G, c, TOKP / 128);
      EpiP3T<true, true> E2{(const bf16_t*)(ws + WS_GATE), (bf16_t*)(ws + WS_H)};
      pg8::gemm_phase<EpiP3T<true, true>, true, true>(lds, gh, S2, E2);
      if (rep_ == 0) { const int nidle = G - S2.nwg, f0 = l == 0 ? SL_03 : SL_13, n0 = l == 0 ? SN_03 : SN_13; if (nidle <= 0) late_transposes(p, lds, f0, n0, c, G); else if (c >= S2.nwg) late_transposes(p, lds, f0, n0, c - S2.nwg, nidle); }
    }
    SEAM(pb + 2);
    if (IN(pb + 3)) {
      pg8::GemmDesc g{(const char*)(ws + WS_H), (const char*)(ws + WS_WOUT) + (size_t)l * D * D * 2, D, D, D / 64, (size_t)256 * D * 2, (size_t)128 * D * 2};
      pg8::StaticOrder S; S.init(TOKP / 256, D / 256, G, c);
      EpiRes E{(float*)(ws + WS_X32), (bf16_t*)(ws + WS_XB), (float*)(ws + WS_SS), lds, l == 0 ? p.x_prompt : nullptr, l == 0 ? p.x_sample : nullptr};
      pg8::gemm_phase<EpiRes>(lds, g, S, E);
      pg8::GemmDesc gh = g; gh.b_tile = (size_t)128 * D * 2;
      pg8::StaticOrder S2; S2.init(TOKS / 128, D / 128, G, c, TOKP / 128);
      EpiResT<true, true> E2{(float*)(ws + WS_X32), (bf16_t*)(ws + WS_XB), (float*)(ws + WS_SS), lds, l == 0 ? p.x_prompt : nullptr, l == 0 ? p.x_sample : nullptr};
      pg8::gemm_phase<EpiResT<true, true>, true, true>(lds, gh, S2, E2);
      { const int nidle = G - S2.nwg, f0 = SL_04, n0 = l == 0 ? SN_04 : 0; if (nidle <= 0) late_transposes(p, lds, f0, n0, c, G); else if (c >= S2.nwg) late_transposes(p, lds, f0, n0, c - S2.nwg, nidle); }
    }
    SEAM(pb + 3);
    if (IN(pb + 4)) REPEAT(4) {
      pg8::GemmDesc g{(const char*)(ws + WS_XB), (const char*)(ws + WS_WUP) + (size_t)l * 2 * DFF * D * 2, D, D, D / 64, (size_t)128 * D * 2, (size_t)DFF * D * 2};
      pg8::StaticOrder S; S.init(TOKP / 256, DFF / 128, G, c);
      EpiP5F E{(const float*)(ws + WS_SS), (bf16_t*)(ws + WS_HF), p.out, p.conv_w + (size_t)l * 3 * DFF, p.conv_b + (size_t)l * DFF, p.state_conv + (size_t)l * DB * 2 * DFF, (float*)(ws + WS_SIDE), lds, l};
      pg8::gemm_phase<EpiP5F>(lds, g, S, E);
      pg8::StaticOrder S2; S2.init(TOKS / 128, DFF / 128, G, (c + G / 2) % G, TOKP / 128);
      EpiP5FT<true> E2{(const float*)(ws + WS_SS), (bf16_t*)(ws + WS_HF), p.out, p.conv_w + (size_t)l * 3 * DFF, p.conv_b + (size_t)l * DFF, p.state_conv + (size_t)l * DB * 2 * DFF, (float*)(ws + WS_SIDE), lds, l};
      pg8::gemm_phase<EpiP5FT<true>, false, true>(lds, g, S2, E2);
      if (rep_ == 0) {
        const int nfull = S.nwg % G, f0 = l == 0 ? SL_05 : SL_15, n0 = l == 0 ? SN_05 : SN_15;
        if (nfull <= 0 || nfull >= G) late_transposes(p, lds, f0, n0, c, G); else if (c >= nfull) late_transposes(p, lds, f0, n0, c - nfull, G - nfull); }
    }
    SEAM(pb + 4);
    if (IN(pb + 5)) {
      pg8::GemmDesc g{(const char*)(ws + WS_HF), (const char*)(ws + WS_WDN) + (size_t)l * D * DFF * 2, DFF, DFF, DFF / 64, (size_t)256 * DFF * 2, (size_t)128 * DFF * 2};
      pg8::StaticOrder S; S.init(TOKP / 256, D / 256, G, c);
      { pg8::Unit uu; for (int i = 0; S.next(i, uu); ++i) if (uu.pm < 64 && (uu.pm & 15) != 0) p6_fixup_panel(uu.pm, (const float*)(ws + WS_SIDE), p.conv_w + (size_t)l * 3 * DFF, (bf16_t*)(ws + WS_HF));
        asm volatile("s_waitcnt vmcnt(0)" ::: "memory"); __syncthreads(); }
      EpiRes E{(float*)(ws + WS_X32), (bf16_t*)(ws + WS_XB), (float*)(ws + WS_SS), lds, nullptr, nullptr};
      pg8::gemm_phase<EpiRes>(lds, g, S, E);
      pg8::GemmDesc gh = g; gh.b_tile = (size_t)128 * DFF * 2;
      pg8::StaticOrder S2; S2.init(TOKS / 128, D / 128, G, c, TOKP / 128);
      EpiResT<true, true> E2{(float*)(ws + WS_X32), (bf16_t*)(ws + WS_XB), (float*)(ws + WS_SS), lds, nullptr, nullptr};
      pg8::gemm_phase<EpiResT<true, true>, true, true>(lds, gh, S2, E2);
      if (l == 0) { const int nidle = G - S2.nwg; if (nidle <= 0) late_transposes(p, lds, SL_06, SN_06, c, G); else if (c >= S2.nwg) late_transposes(p, lds, SL_06, SN_06, c - S2.nwg, nidle); }
    }
    SEAM(pb + 5);
  }
  if (IN(NPHASE - 1)) { pfinal_norm(p_k); }
#undef IN
#undef SEAM
}

#ifndef MK_ONE_LAUNCH
#define MK_ONE_LAUNCH 1
#endif
extern "C" void kernel_launch(void* const* d_in, const int* in_sizes, int n_in, void* d_out, int out_size, void* d_ws, size_t ws_size, hipStream_t stream) {
  static int grid_blocks = 0;
  if (grid_blocks == 0) {
    int dev = 0, cus = 0, per_cu = 0;
    (void)hipGetDevice(&dev);
    (void)hipDeviceGetAttribute(&cus, hipDeviceAttributeMultiprocessorCount, dev);
    (void)hipFuncSetAttribute((const void*)fwd_megakernel, hipFuncAttributeMaxDynamicSharedMemorySize, LDS_BYTES);
    (void)hipOccupancyMaxActiveBlocksPerMultiprocessor(&per_cu, (const void*)fwd_megakernel, NTHREADS, LDS_BYTES);
    if (per_cu < 1) { fprintf(stderr, "kernel_launch: occupancy query says %d blocks/CU\n", per_cu); per_cu = 1; }
    grid_blocks = cus * per_cu;
    if (n_in != 24 || (size_t)out_size != O_END || ws_size < WS_END) { fprintf(stderr, "kernel_launch: unexpected problem (n_in %d out %d ws %zu, need %zu)\n", n_in, out_size, ws_size, (size_t)WS_END); grid_blocks = -1; }
  }
  if (grid_blocks < 0) return;
  Params p{};
  const float** f = (const float**)&p;
  for (int i = 0; i < 24; ++i) f[i] = (const float*)d_in[i];
  p.out = (float*)d_out; p.ws = (unsigned char*)d_ws;
#if MK_ONE_LAUNCH
  p.ph_lo = 0; p.ph_hi = NPHASE;
  (void)hipMemsetAsync((unsigned char*)d_ws + WS_CTL + (size_t)CW_BAR * 4, 0, (size_t)XCD_BAR_WORDS * 4, stream);
  { void* args[] = {&p};
    hipError_t e = hipLaunchCooperativeKernel((void*)fwd_megakernel, dim3(grid_blocks), dim3(NTHREADS), args, LDS_BYTES, stream);
    if (e != hipSuccess) fprintf(stderr, "cooperative launch failed: %s (grid %d)\n", hipGetErrorString(e), grid_blocks); }
#else
  for (int k = 0; k < NPHASE; ++k) { p.ph_lo = k; p.ph_hi = k + 1; void* args[] = {&p};
    hipError_t e = hipLaunchCooperativeKernel((void*)fwd_megakernel, dim3(grid_blocks), dim3(NTHREADS), args, LDS_BYTES, stream);
    if (e != hipSuccess) { fprintf(stderr, "launch %d failed: %s (grid %d)\n", k, hipGetErrorString(e), grid_blocks); break; } }
#endif
}
```

```cpp
#include <hip/hip_runtime.h>
#include <hip/hip_cooperative_groups.h>
#include <cstdio>
#include <cstdint>
namespace cg = cooperative_groups;

#define DI __device__ __forceinline__
#define LAS __attribute__((address_space(3)))
typedef unsigned short bf16_t;
typedef short bf16x8 __attribute__((ext_vector_type(8)));
typedef short s16x4 __attribute__((ext_vector_type(4)));
typedef float f32x2 __attribute__((ext_vector_type(2)));
typedef float f32x4 __attribute__((ext_vector_type(4)));
typedef float f32x8 __attribute__((ext_vector_type(8)));
typedef float f32x16 __attribute__((ext_vector_type(16)));
typedef unsigned u32x2 __attribute__((ext_vector_type(2)));
typedef unsigned u32x4 __attribute__((ext_vector_type(4)));
typedef __bf16 bfv4 __attribute__((ext_vector_type(4)));
typedef __bf16 bfv8 __attribute__((ext_vector_type(8)));

constexpr int D = 1024, SEQ = 4096, NB = 4, TOKP = NB * SEQ, DB = 32, DSEQ = 64, TOKS = DB * DSEQ, TOK = TOKP + TOKS;
constexpr int PAST = 1024, ALEN = 512, INC = 7680, DFF = 2816, NLAYER = 2;
constexpr int QKVW = 4608, GATEW = 3072, OW = 1536;
constexpr float EPS = 1e-6f, LOG2E = 1.4426950408889634f;

constexpr size_t O_YP = 0, O_YS = O_YP + (size_t)TOKP * D, O_PAK = O_YS + (size_t)TOKS * D, O_PAV = O_PAK + (size_t)2 * 4 * 512 * 512,
                 O_PBK = O_PAV + (size_t)2 * 4 * 512 * 512, O_PBV = O_PBK + (size_t)2 * TOKP * 512, O_PCK = O_PBV + (size_t)2 * TOKP * 512,
                 O_PCV = O_PCK + (size_t)2 * TOKP * 512, O_PCONV = O_PCV + (size_t)2 * TOKP * 512, O_SAK = O_PCONV + (size_t)2 * 4 * 2 * DFF,
                 O_SAV = O_SAK + (size_t)2 * DB * 512 * 512, O_SBK = O_SAV + (size_t)2 * DB * 512 * 512, O_SBV = O_SBK + (size_t)2 * TOKS * 512,
                 O_SCK = O_SBV + (size_t)2 * TOKS * 512, O_SCV = O_SCK + (size_t)2 * TOKS * 512, O_SCONV = O_SCV + (size_t)2 * TOKS * 512,
                 O_END = O_SCONV + (size_t)2 * DB * 2 * DFF;

constexpr size_t MiB = 1u << 20;
constexpr size_t WS_CTL = 0;
constexpr size_t WS_WIN = 1 * MiB;
constexpr size_t WS_WBR = WS_WIN + (size_t)2 * INC * D * 2;
constexpr size_t WS_WOUT = WS_WBR + (size_t)2 * D * OW * 2;
constexpr size_t WS_WUP = WS_WOUT + (size_t)2 * D * D * 2;
constexpr size_t WS_WDN = WS_WUP + (size_t)2 * 2 * DFF * D * 2;
constexpr size_t WS_XB = WS_WDN + (size_t)2 * D * DFF * 2;
constexpr size_t WS_X32 = WS_XB + (size_t)TOK * D * 2;
constexpr size_t WS_SS = WS_X32 + (size_t)TOK * D * 4;
constexpr size_t WS_SIDE = WS_SS + (size_t)TOK * 8 * 4;
constexpr size_t WS_O = WS_SIDE + (size_t)3 * 72 * 2 * DFF * 4;
constexpr size_t WS_H = WS_O + (size_t)TOK * OW * 2;
constexpr size_t WS_HF = WS_H + (size_t)TOK * D * 2;
constexpr size_t WS_QKV = WS_HF + (size_t)TOK * DFF * 2;
constexpr size_t WS_GATE = WS_QKV + (size_t)TOK * QKVW * 2;
constexpr size_t WS_END = WS_GATE + (size_t)TOK * GATEW * 2;
constexpr int CW_QUEUE = 64;
constexpr int CW_LAM = 1024;
constexpr int CW_T5 = 2048;
constexpr int CW_BAR = 8192;

constexpr int LDS_BYTES = 160 * 1024;
constexpr int NTHREADS = 512;

DI u32x4 pack8(f32x4 a, f32x4 b) { f32x8 v = {a[0], a[1], a[2], a[3], b[0], b[1], b[2], b[3]}; return __builtin_bit_cast(u32x4, __builtin_convertvector(v, bfv8)); }
DI u32x2 pack4(f32x4 a) { return __builtin_bit_cast(u32x2, __builtin_convertvector(a, bfv4)); }
DI float bflo(unsigned w) { return __uint_as_float(w << 16); }
DI float bfhi(unsigned w) { return __uint_as_float(w & 0xffff0000u); }
DI float wave_sum(float v) {
#pragma unroll
  for (int o = 1; o < 64; o <<= 1) v += __shfl_xor(v, o);
  return v;
}
DI float fast_rcp(float x) { return __builtin_amdgcn_rcpf(x); }
DI float fast_exp2(float x) { return __builtin_amdgcn_exp2f(x); }
DI float fast_log2(float x) { return __builtin_amdgcn_logf(x); }

DI LAS unsigned char* opaque_lds(LAS unsigned char* p) { unsigned v = (unsigned)(__UINTPTR_TYPE__)p; asm volatile("" : "+s"(v)); return (LAS unsigned char*)(__UINTPTR_TYPE__)v; }

struct Params {
  const float* x_prompt; const float* x_sample;
  const float* cache_a_k; const float* cache_a_v; const float* cache_b_k; const float* cache_b_v; const float* cache_c_k; const float* cache_c_v;
  const float* state_conv; const float* norm_mix; const float* w_in; const float* b_gate; const float* a_rel_bias; const float* t5_bias;
  const float* c_lambda; const float* c_subln; const float* w_branch; const float* w_out; const float* norm_ffn; const float* w_up;
  const float* conv_w; const float* conv_b; const float* w_down; const float* norm_final;
  float* out; unsigned char* ws;
  int ph_lo, ph_hi;
};

struct TItem { const float* W; const float* ks; bf16_t* WT; int N, dst_ld, dst_col, item; };
DI void p0_tload(const TItem& d, float (&wv)[32], int lane) {
  const int nblk = d.N / 32, kb = d.item / nblk, nb = d.item % nblk, k0 = 64 * kb, n0 = 32 * nb;
#pragma unroll
  for (int i = 0; i < 32; ++i) wv[i] = __builtin_nontemporal_load(&d.W[(size_t)(k0 + 2 * i + (lane >> 5)) * d.N + n0 + (lane & 31)]);
}
DI void p0_tfinish(const TItem& d, const float (&wv)[32], LAS float* scr, int lane) {
  const int nblk = d.N / 32, kb = d.item / nblk, nb = d.item % nblk, k0 = 64 * kb, n0 = 32 * nb;
#pragma unroll
  for (int i = 0; i < 32; ++i) { const int kk = 2 * i + (lane >> 5); float v = wv[i]; if (d.ks) v *= d.ks[k0 + kk]; scr[kk * 33 + (lane & 31)] = v; }
  asm volatile("s_waitcnt lgkmcnt(0)" ::: "memory");
  const int c = lane & 7;
#pragma unroll
  for (int j = 0; j < 4; ++j) { const int n = (lane >> 3) + 8 * j; const LAS float* s = scr + (8 * c) * 33 + n;
    f32x4 a = {s[0 * 33], s[1 * 33], s[2 * 33], s[3 * 33]}, b = {s[4 * 33], s[5 * 33], s[6 * 33], s[7 * 33]};
    *(u32x4*)(d.WT + (size_t)(n0 + n) * d.dst_ld + d.dst_col + k0 + 8 * c) = pack8(a, b); }
  asm volatile("s_waitcnt lgkmcnt(0)" ::: "memory");
}

DI int t5_bucket_of(int rel) {
  const int n = rel < 0 ? -rel : rel; int f;
  if (n < 8) f = n; else if (n < 12) f = 8; else if (n < 16) f = 9; else if (n < 23) f = 10; else if (n < 32) f = 11; else if (n < 46) f = 12; else if (n < 64) f = 13; else if (n < 91) f = 14; else f = 15;
  return (rel > 0 ? 16 : 0) + f;
}

constexpr int I_IN = (D / 64) * (INC / 32), I_BR = (512 / 64) * (D / 32), I_OUT = (D / 64) * (D / 32), I_UP = (D / 64) * (2 * DFF / 32), I_DN = (DFF / 64) * (D / 32);
constexpr int PER_LAYER = I_IN + 3 * I_BR + I_OUT + I_UP + I_DN;
constexpr int P0_ITEMS = I_IN + 3 * I_BR;
constexpr int SL_03 = P0_ITEMS, SN_03 = I_OUT + I_UP;
constexpr int SL_05 = PER_LAYER - I_DN, SN_05 = I_DN;
constexpr int SL_04 = PER_LAYER, SN_04 = 2048;
constexpr int SL_06 = SL_04 + SN_04, SN_06 = 4096;
constexpr int SL_13 = SL_06 + SN_06, SN_13 = 2 * PER_LAYER - I_DN - SL_13;
constexpr int SL_15 = 2 * PER_LAYER - I_DN, SN_15 = I_DN;
static_assert(NLAYER == 2 && SL_06 + SN_06 >= PER_LAYER + I_IN + 3 * I_BR + I_OUT && SN_13 >= 0 && SN_13 <= 4096, "late transpose slots");
DI TItem p0_titem(const Params& p, int it) {
  const int l = it / PER_LAYER; int r = it % PER_LAYER;
  if (r < I_IN) return TItem{p.w_in + (size_t)l * D * INC, p.norm_mix + l * D, (bf16_t*)(p.ws + WS_WIN) + (size_t)l * INC * D, INC, D, 0, r};
  r -= I_IN;
  if (r < 3 * I_BR) { const int n = r / I_BR; return TItem{p.w_branch + ((size_t)l * 3 + n) * 512 * D, nullptr, (bf16_t*)(p.ws + WS_WBR) + (size_t)l * D * OW, D, OW, 512 * n, r % I_BR}; }
  r -= 3 * I_BR;
  if (r < I_OUT) return TItem{p.w_out + (size_t)l * D * D, nullptr, (bf16_t*)(p.ws + WS_WOUT) + (size_t)l * D * D, D, D, 0, r};
  r -= I_OUT;
  if (r < I_UP) return TItem{p.w_up + (size_t)l * D * 2 * DFF, p.norm_ffn + l * D, (bf16_t*)(p.ws + WS_WUP) + (size_t)l * 2 * DFF * D, 2 * DFF, D, 0, r};
  r -= I_UP;
  return TItem{p.w_down + (size_t)l * DFF * D, nullptr, (bf16_t*)(p.ws + WS_WDN) + (size_t)l * D * DFF, D, DFF, 0, r};
}
DI void p0_weight_item(const Params& p, int it, LAS float* scr, int lane) { const TItem d = p0_titem(p, it); float wv[32]; p0_tload(d, wv, lane); p0_tfinish(d, wv, scr, lane); }
DI void late_transposes(const Params& p, LAS unsigned char* lds_in, int first, int count, int w_block, int n_blocks) {
  LAS unsigned char* lds = opaque_lds(lds_in);
  int tid_ = threadIdx.x; asm volatile("" : "+v"(tid_));
  const int lane = tid_ & 63, wave = tid_ >> 6;
  LAS float* scr = (LAS float*)(lds + wave * 8448);
  const int nw = n_blocks * 8;
  for (int j = w_block * 8 + wave; j < count; j += 2 * nw) {
    const bool two = j + nw < count;
    const TItem a = p0_titem(p, first + j), b = p0_titem(p, first + (two ? j + nw : j));
    float wa[32], wb[32];
    p0_tload(a, wa, lane); p0_tload(b, wb, lane);
    p0_tfinish(a, wa, scr, lane);
    if (two) p0_tfinish(b, wb, scr, lane);
  }
}
DI void p0_prologue(const Params& p, LAS unsigned char* lds_in) {
  LAS unsigned char* lds = opaque_lds(lds_in);
  int tid_ = threadIdx.x; asm volatile("" : "+v"(tid_));
  const int tid = tid_, lane = tid & 63, wave = tid >> 6;
  const int gw = blockIdx.x * 8 + wave, NGW = gridDim.x * 8;
  unsigned* ctl = (unsigned*)(p.ws + WS_CTL);
  if (blockIdx.x == 0) {
    if (tid < 4) ctl[CW_QUEUE + 64 * tid] = 0u;
    if (wave == 1) {
      for (int l = 0; l < NLAYER; ++l) { const float* lp = p.c_lambda + l * 256; const float a = wave_sum(lp[lane] * lp[64 + lane]), b = wave_sum(lp[128 + lane] * lp[192 + lane]);
        const float lam_init = 0.8f - 0.6f * expf(-0.3f * (float)l);
        if (lane == 0) ((float*)ctl)[CW_LAM + l] = expf(a) - expf(b) + lam_init; }
    }
    for (int i = tid; i < 4 * 192; i += NTHREADS) { const int h = i / 192, idx = i % 192; int rel = idx - 127; if (rel > 63) rel = 63;
      ((float*)ctl)[CW_T5 + i] = p.t5_bias[t5_bucket_of(rel) * 4 + h] - p.t5_bias[15 * 4 + h]; }
  }
  LAS float* scr = (LAS float*)(lds + wave * 8448);
  for (int j = gw; j < P0_ITEMS; j += 2 * NGW) {
    const bool two = j + NGW < P0_ITEMS;
    const TItem a = p0_titem(p, j), b = p0_titem(p, two ? j + NGW : j);
    float wa[32], wb[32];
    p0_tload(a, wa, lane); p0_tload(b, wb, lane);
    p0_tfinish(a, wa, scr, lane);
    if (two) p0_tfinish(b, wb, scr, lane);
  }
  bf16_t* XB = (bf16_t*)(p.ws + WS_XB); float* SS = (float*)(p.ws + WS_SS);
#pragma unroll 3
  for (int m = gw; m < TOK; m += NGW) {
    const float* src = m < TOKP ? p.x_prompt + (size_t)m * D : p.x_sample + (size_t)(m - TOKP) * D;
    float s = 0.f;
#pragma unroll
    for (int j = 0; j < 4; ++j) { const f32x4 v = __builtin_nontemporal_load(&((const f32x4*)src)[lane + 64 * j]); ((u32x2*)(XB + (size_t)m * D))[lane + 64 * j] = pack4(v);
      s += (v[0] * v[0] + v[1] * v[1]) + (v[2] * v[2] + v[3] * v[3]); }
    s = wave_sum(s);
    if (lane < 8) SS[(size_t)m * 8 + lane] = lane == 0 ? s : 0.f;
  }
}

namespace pg8 {
constexpr int BM = 256, BK = 64, HALF = 128, HTB = HALF * BK * 2, STAGE_BYTES = 8 * HTB, NXCD = 8, WGM = 8;
DI int lds_byte(int r, int c) { const int st = (r >> 4) * 2 + (c >> 5), rr = r & 15, cc = c & 31, ob = rr * 64 + cc * 2; return st * 1024 + (ob ^ (((ob >> 9) & 1) << 5)); }
DI void stage_rc(int b, int& R, int& C) { const int st = b / 1024, sb = b % 1024, swz = sb ^ (((sb >> 9) & 1) << 5); R = (st >> 1) * 16 + swz / 64; C = (st & 1) * 32 + (swz % 64) / 2; }
DI int perm32(int rho) { const int n = rho >> 4, i = rho & 15; return 8 * (i >> 2) + 4 * n + (i & 3); }
struct Unit { int pm, pn; };
struct GemmDesc { const char* A; const char* B; int lda, ldb, nt; size_t b_tile, b_half; };
struct StaticOrder {
  int nM, nN, nwg, G, c, pm0;
  DI void init(int nM_, int nN_, int G_, int c_, int pm0_ = 0) { nM = nM_; nN = nN_; nwg = nM * nN; G = G_; c = c_; pm0 = pm0_; }
  DI bool next(int i, Unit& u) const {
    const long L = (long)i * G + c; if (L >= nwg) return false;
    int wgid = (int)L; { const int q = nwg / NXCD, r = nwg % NXCD, xcd = wgid % NXCD, off = wgid / NXCD; wgid = (xcd < r ? xcd * (q + 1) : r * (q + 1) + (xcd - r) * q) + off; }
    const int nig = WGM * nN, gid = wgid / nig, fm = gid * WGM, gsz = (nM - fm) < WGM ? (nM - fm) : WGM;
    u.pm = pm0 + fm + ((wgid % nig) % gsz); u.pn = (wgid % nig) / gsz; return true;
  }
};
constexpr int P1_NN = 28, P1_EXTRA = 32, P1_DEFER = 72 + (72 - P1_EXTRA);
struct P1Order {
  StaticOrder R1;
  DI bool next(int i, Unit& u) const {
    if (R1.next(i, u)) return true;
    const long L = (long)i * R1.G + R1.c - R1.nwg; if (L >= P1_EXTRA) return false;
    u.pm = (int)L; u.pn = P1_NN; return true;
  }
};
DI Unit p1_deferred_unit(int j) { Unit u; if (j < 72) { u.pm = j; u.pn = P1_NN + 1; } else { u.pm = P1_EXTRA + (j - 72); u.pn = P1_NN; } return u; }
struct OneUnit { Unit u; DI bool next(int i, Unit& o) const { if (i != 0) return false; o = u; return true; } };
template <class Epi, bool HALFN = false, bool HALFM = false, class Sched = StaticOrder>
DI void gemm_phase(LAS unsigned char* lds_in, const GemmDesc g, const Sched& S, const Epi& E) {
  LAS unsigned char* lds = opaque_lds(lds_in);
  int tid_ = threadIdx.x; asm volatile("" : "+v"(tid_));
  const int tid = tid_, wid = __builtin_amdgcn_readfirstlane(tid >> 6), lane = tid & 63, wr = wid >> 2, wc = wid & 3, fr = lane & 15, fq = lane >> 4;
  const int nt = g.nt;
  unsigned voffA[2], voffB[2];
#pragma unroll
  for (int i = 0; i < 2; ++i) { int R, C; stage_rc(tid * 16 + i * 8192, R, C); const int Rb = Epi::PERM ? ((R & ~31) + perm32(R & 31)) : R;
    voffA[i] = (unsigned)(R * g.lda + C) * 2u; voffB[i] = (unsigned)(Rb * g.ldb + C) * 2u; }
  const size_t kstep = (size_t)(BK * 2);
  const size_t hsA = (size_t)HALF * g.lda * 2, tsA = HALFM ? hsA : 2 * hsA, hsB = g.b_half, tsB = g.b_tile;
  const unsigned ldsw = (unsigned)wid * 1024u;
  const int aoff = lds_byte(wr * 64 + fr, fq * 8), boff = lds_byte(wc * 32 + fr, fq * 8);
#define PG8_SA(b, h) (((b) * 2 + (h)) * HTB)
#define PG8_SB(b, h) ((4 + (b) * 2 + (h)) * HTB)
#define PG8_STAGE(bufoff, gbase, voff) do { _Pragma("unroll") for (int _i = 0; _i < 2; ++_i) \
    __builtin_amdgcn_global_load_lds((const unsigned*)((const char*)(gbase) + (voff)[_i]), (LAS unsigned*)(lds + (bufoff) + ldsw + _i * 8192), 16, 0, 0); } while (0)
#define PG8_LDA(dst, b, h) do { _Pragma("unroll") for (int m = 0; m < 4; ++m) _Pragma("unroll") for (int k = 0; k < 2; ++k) dst[m][k] = *(const LAS bf16x8*)(lds + PG8_SA(b, h) + aoff + m * 2048 + k * 1024); } while (0)
#define PG8_LDB(dst, b, h) do { _Pragma("unroll") for (int n = 0; n < 2; ++n) _Pragma("unroll") for (int k = 0; k < 2; ++k) dst[n][k] = *(const LAS bf16x8*)(lds + PG8_SB(b, h) + boff + n * 2048 + k * 1024); } while (0)
#define PG8_MMA(ai, bj, At, Bt) do { __builtin_amdgcn_s_setprio(1); _Pragma("unroll") for (int m = 0; m < 4; ++m) _Pragma("unroll") for (int n = 0; n < 2; ++n) _Pragma("unroll") for (int k = 0; k < 2; ++k) \
    acc[ai][bj][m][n] = __builtin_amdgcn_mfma_f32_16x16x32_bf16(Bt[n][k], At[m][k], acc[ai][bj][m][n], 0, 0, 0); __builtin_amdgcn_s_setprio(0); } while (0)
#define PG8_WAIT_V(n) asm volatile("s_waitcnt vmcnt(" #n ")" ::: "memory")
#define PG8_WAIT_LOOP do { if constexpr (HALFM && HALFN) PG8_WAIT_V(4); else if constexpr (HALFM || HALFN) PG8_WAIT_V(6); else PG8_WAIT_V(8); } while (0)
#define PG8_WAIT_L(n) asm volatile("s_waitcnt lgkmcnt(" #n ")" ::: "memory")
#define PG8_BAR __builtin_amdgcn_s_barrier()
#define PG8_SCHED __builtin_amdgcn_sched_barrier(0)
  Unit cur, nxt; int ui = 0;
  if (!S.next(0, cur)) return;
  f32x4 acc[2][2][4][2];
#pragma unroll
  for (int a = 0; a < 2; ++a)
#pragma unroll
    for (int b = 0; b < 2; ++b)
#pragma unroll
      for (int m = 0; m < 4; ++m)
#pragma unroll
        for (int n = 0; n < 2; ++n) acc[a][b][m][n] = (f32x4){0.f, 0.f, 0.f, 0.f};
  bf16x8 At[4][2], B0[2][2], B1[2][2];
  const char* cA = g.A + (size_t)cur.pm * tsA; const char* cB = g.B + (size_t)cur.pn * tsB;
  f32x4 ssv = {0.f, 0.f, 0.f, 0.f};
  if constexpr (Epi::HAS_RS) ssv = E.prefetch(cur, tid);
  PG8_STAGE(PG8_SB(0, 0), cB, voffB); if constexpr (!HALFN) PG8_STAGE(PG8_SB(0, 1), cB + hsB, voffB); PG8_STAGE(PG8_SA(0, 0), cA, voffA); if constexpr (!HALFM) PG8_STAGE(PG8_SA(0, 1), cA + hsA, voffA);
  if (wr == 1) PG8_BAR;
  if constexpr (HALFM) PG8_WAIT_V(0); else PG8_WAIT_V(2);
  PG8_BAR;
  PG8_STAGE(PG8_SB(1, 0), cB + kstep, voffB); PG8_STAGE(PG8_SA(1, 0), cA + kstep, voffA); if constexpr (!HALFN) PG8_STAGE(PG8_SB(1, 1), cB + hsB + kstep, voffB);
  if constexpr (HALFN) PG8_WAIT_V(4); else PG8_WAIT_V(6);
  PG8_BAR;
  for (;;) {
    const bool has_next = S.next(ui + 1, nxt);
    const char* nA = has_next ? g.A + (size_t)nxt.pm * tsA : cA; const char* nB = has_next ? g.B + (size_t)nxt.pn * tsB : cB;
    for (int t = 0; t < nt; t += 2) {
      const bool last = (t == nt - 2);
      const char* a1 = cA + (size_t)(t + 1) * kstep;
      const char* a2 = last ? nA : cA + (size_t)(t + 2) * kstep; const char* b2 = last ? nB : cB + (size_t)(t + 2) * kstep;
      const char* a3 = a2 + kstep; const char* b3 = b2 + kstep;
      if constexpr (Epi::HAS_MID) { if (t == 8 || t == 16) E.mid(acc, cur, t, wr, wc, fr, fq); }
      PG8_LDB(B0, 0, 0); if constexpr (!HALFN) PG8_LDB(B1, 0, 1); PG8_SCHED; PG8_LDA(At, 0, 0); if constexpr (!HALFM) PG8_STAGE(PG8_SA(1, 1), a1 + hsA, voffA);
      PG8_WAIT_LOOP; PG8_WAIT_L(0); PG8_BAR; PG8_MMA(0, 0, At, B0); if constexpr (!HALFN) PG8_MMA(0, 1, At, B1); PG8_BAR; PG8_SCHED;
      if constexpr (!HALFM) PG8_LDA(At, 0, 1); PG8_STAGE(PG8_SB(0, 0), b2, voffB); if constexpr (!HALFN) PG8_STAGE(PG8_SB(0, 1), b2 + hsB, voffB); PG8_STAGE(PG8_SA(0, 0), a2, voffA);
      PG8_WAIT_LOOP; PG8_WAIT_L(0); PG8_BAR; if constexpr (!HALFM) { PG8_MMA(1, 0, At, B0); if constexpr (!HALFN) PG8_MMA(1, 1, At, B1); } PG8_BAR; PG8_SCHED;
      PG8_LDB(B0, 1, 0); if constexpr (!HALFN) PG8_LDB(B1, 1, 1); PG8_SCHED; PG8_LDA(At, 1, 0); if constexpr (!HALFM) PG8_STAGE(PG8_SA(0, 1), a2 + hsA, voffA);
      PG8_WAIT_LOOP; PG8_WAIT_L(0); PG8_BAR; PG8_MMA(0, 0, At, B0); if constexpr (!HALFN) PG8_MMA(0, 1, At, B1); PG8_BAR; PG8_SCHED;
      if constexpr (!HALFM) PG8_LDA(At, 1, 1); PG8_STAGE(PG8_SB(1, 0), b3, voffB); if constexpr (!HALFN) PG8_STAGE(PG8_SB(1, 1), b3 + hsB, voffB); PG8_STAGE(PG8_SA(1, 0), a3, voffA);
      PG8_WAIT_LOOP; PG8_WAIT_L(0); PG8_BAR; if constexpr (!HALFM) { PG8_MMA(1, 0, At, B0); if constexpr (!HALFN) PG8_MMA(1, 1, At, B1); } PG8_BAR; PG8_SCHED;
    }
    if (wr == 0) PG8_BAR;
    if constexpr (Epi::HAS_RS) { E.stash(ssv, cur, tid, lds); PG8_WAIT_L(0); PG8_BAR; asm volatile("" ::: "memory"); }
    E(acc, cur, wr, wc, fr, fq);
    if (!has_next) break;
#pragma unroll
    for (int a = 0; a < 2; ++a)
#pragma unroll
      for (int b = 0; b < 2; ++b)
#pragma unroll
        for (int m = 0; m < 4; ++m)
#pragma unroll
          for (int n = 0; n < 2; ++n) acc[a][b][m][n] = (f32x4){0.f, 0.f, 0.f, 0.f};
    cur = nxt; cA = nA; cB = nB; ++ui;
    if constexpr (Epi::HAS_RS) ssv = E.prefetch(cur, tid);
    if (wr == 1) PG8_BAR;
  }
  PG8_WAIT_V(0);
  PG8_BAR;
#undef PG8_SA
#undef PG8_SB
#undef PG8_STAGE
#undef PG8_LDA
#undef PG8_LDB
#undef PG8_MMA
#undef PG8_WAIT_V
#undef PG8_WAIT_LOOP
#undef PG8_WAIT_L
#undef PG8_BAR
#undef PG8_SCHED
}
}
using pg8::Unit;
DI f32x4 ss_load(const float* SS, int r) { const f32x4* q = (const f32x4*)(SS + (size_t)r * 8); return q[0] + q[1]; }
DI float ss_to_rs(const f32x4& a) { return __builtin_amdgcn_rsqf(((a[0] + a[1]) + (a[2] + a[3])) * (1.0f / D) + EPS); }
DI float row_rs(const float* SS, int r) { return ss_to_rs(ss_load(SS, r)); }
DI float sigmoidf_(float x) { return fast_rcp(1.0f + fast_exp2(-x * LOG2E)); }

struct EpiP1 {
  static constexpr bool PERM = true, HAS_MID = false, HAS_RS = true;
  const float* SS; bf16_t* QKV; bf16_t* GATE; const float* bgate; float* out; int layer; int probe_flags; LAS unsigned char* lds;
  DI void mid(f32x4 (&)[2][2][4][2], const Unit&, int, int, int, int, int) const {}
  DI f32x4 prefetch(const Unit& u, int tid) const {
    f32x4 v = {0.f, 0.f, 0.f, 0.f};
    if (tid < 256) v = ss_load(SS, u.pm * 256 + tid);
    return v;
  }
  DI void stash(const f32x4& v, const Unit& u, int tid, LAS unsigned char* l) const {
    if (tid < 256) *(LAS float*)(l + 131072 + 12288 + tid * 4) = ss_to_rs(v);
  }
  DI void operator()(f32x4 (&acc)[2][2][4][2], const Unit& u, int wr, int wc, int fr, int fq) const {
    const int pn = u.pn, rin0 = wr * 64 + fr, row0 = u.pm * 256 + rin0;
    float rs[2][4];
#pragma unroll
    for (int ai = 0; ai < 2; ++ai)
#pragma unroll
      for (int m = 0; m < 4; ++m) rs[ai][m] = *(const LAS float*)(lds + 131072 + 12288 + (rin0 + ai * 128 + m * 16) * 4);
    if (pn < 18) {
      const int colq = pn * 256 + wc * 32 + 8 * fq;
#pragma unroll
      for (int ai = 0; ai < 2; ++ai)
#pragma unroll
        for (int m = 0; m < 4; ++m) {
          const int rin = rin0 + ai * 128 + m * 16, r = u.pm * 256 + rin; const float s = rs[ai][m];
          bf16_t* rowp = QKV + (size_t)r * QKVW + colq;
#pragma unroll
          for (int bj = 0; bj < 2; ++bj) { const f32x4 v0 = acc[ai][bj][m][0] * s, v1 = acc[ai][bj][m][1] * s;
            { const u32x4 pk = pack8(v0, v1); if (!(probe_flags & 2)) *(u32x4*)(rowp + bj * 128) = pk; else asm volatile("" :: "v"(pk)); }
            }
        }
    } else {
      const int gi = pn - 18, nb = gi >> 2, colg = (gi & 3) * 256 + wc * 32 + 8 * fq;
      f32x4 bv[2][2];
#pragma unroll
      for (int bj = 0; bj < 2; ++bj) { bv[bj][0] = *(const f32x4*)(bgate + nb * D + colg + bj * 128); bv[bj][1] = *(const f32x4*)(bgate + nb * D + colg + bj * 128 + 4); }
#pragma unroll
      for (int ai = 0; ai < 2; ++ai)
#pragma unroll
        for (int m = 0; m < 4; ++m) { const int r = row0 + ai * 128 + m * 16; const float s = rs[ai][m];
          bf16_t* rowp = GATE + (size_t)r * GATEW + gi * 256 + wc * 32 + 8 * fq;
#pragma unroll
          for (int bj = 0; bj < 2; ++bj) { f32x4 v0 = acc[ai][bj][m][0] * s + bv[bj][0], v1 = acc[ai][bj][m][1] * s + bv[bj][1];
#pragma unroll
            for (int j = 0; j < 4; ++j) { v0[j] = 1.0f + fast_exp2(fminf(-v0[j] * LOG2E, 100.0f)); v1[j] = 1.0f + fast_exp2(fminf(-v1[j] * LOG2E, 100.0f)); }
            { const u32x4 pk = pack8(v0, v1); if (!(probe_flags & 2)) __builtin_nontemporal_store(pk, (u32x4*)(rowp + bj * 128)); else asm volatile("" :: "v"(pk)); } } }
    }
  }
};

template <bool HALFN, bool HALFM = false> struct EpiP3T {
  static constexpr bool PERM = true, HAS_MID = true, HAS_RS = false;
  const bf16_t* GATE; bf16_t* H;
  DI void mid(f32x4 (&acc)[2][2][4][2], const Unit& u, int t, int wr, int wc, int fr, int fq) const {
    const int nb = (t >> 3) - 1;
    const bf16_t* gp = GATE + (size_t)(u.pm * (HALFM ? 128 : 256) + wr * 64 + fr) * GATEW + nb * D + u.pn * (HALFN ? 128 : 256) + wc * 32 + 8 * fq;
    constexpr int NSB = (HALFM ? 1 : 2) * 2, NBJ = HALFN ? 1 : 2;
    u32x4 gA[2][2][2] = {}, gB[2][2][2] = {};
#define P3_LOAD(G_, k_) do { _Pragma("unroll") for (int mm = 0; mm < 2; ++mm) _Pragma("unroll") for (int bj = 0; bj < NBJ; ++bj) { \
      const bf16_t* q = gp + (size_t)(((k_) >> 1) * 128 + (2 * ((k_) & 1) + mm) * 16) * GATEW + bj * 128; G_[0][mm][bj] = *(const u32x4*)q; G_[1][mm][bj] = *(const u32x4*)(q + D); } asm volatile("" ::: "memory"); } while (0)
#define P3_APPLY(G_, k_) do { _Pragma("unroll") for (int mm = 0; mm < 2; ++mm) _Pragma("unroll") for (int bj = 0; bj < NBJ; ++bj) _Pragma("unroll") for (int n = 0; n < 2; ++n) { \
      const unsigned a0 = G_[0][mm][bj][2 * n], a1 = G_[0][mm][bj][2 * n + 1], b0 = G_[1][mm][bj][2 * n], b1 = G_[1][mm][bj][2 * n + 1]; f32x4& c = acc[(k_) >> 1][bj][2 * ((k_) & 1) + mm][n]; \
      c[0] *= bflo(b0) * fast_rcp(bflo(a0)); c[1] *= bfhi(b0) * fast_rcp(bfhi(a0)); c[2] *= bflo(b1) * fast_rcp(bflo(a1)); c[3] *= bfhi(b1) * fast_rcp(bfhi(a1)); } asm volatile("" ::: "memory"); } while (0)
    P3_LOAD(gA, 0); P3_LOAD(gB, 1); P3_APPLY(gA, 0);
    if (NSB == 4) { P3_LOAD(gA, 2); P3_APPLY(gB, 1); P3_LOAD(gB, 3); P3_APPLY(gA, 2); P3_APPLY(gB, 3); }
    else P3_APPLY(gB, 1);
#undef P3_LOAD
#undef P3_APPLY
  }
  DI void operator()(f32x4 (&acc)[2][2][4][2], const Unit& u, int wr, int wc, int fr, int fq) const {
    const int row0 = u.pm * (HALFM ? 128 : 256) + wr * 64 + fr, col0 = u.pn * (HALFN ? 128 : 256) + wc * 32 + 8 * fq;
    const bf16_t* gp = GATE + (size_t)row0 * GATEW + 2 * D + col0; bf16_t* hp = H + (size_t)row0 * D + col0;
    constexpr int NSB = (HALFM ? 1 : 2) * 2, NBJ = HALFN ? 1 : 2;
    u32x4 gA[2][2] = {}, gB[2][2] = {};
#define P3F_LOAD(G_, k_) do { _Pragma("unroll") for (int mm = 0; mm < 2; ++mm) _Pragma("unroll") for (int bj = 0; bj < NBJ; ++bj) \
      G_[mm][bj] = *(const u32x4*)(gp + (size_t)(((k_) >> 1) * 128 + (2 * ((k_) & 1) + mm) * 16) * GATEW + bj * 128); asm volatile("" ::: "memory"); } while (0)
#define P3F_APPLY(G_, k_) do { _Pragma("unroll") for (int mm = 0; mm < 2; ++mm) _Pragma("unroll") for (int bj = 0; bj < NBJ; ++bj) { const u32x4 g = G_[mm][bj]; \
      f32x4 v0 = acc[(k_) >> 1][bj][2 * ((k_) & 1) + mm][0], v1 = acc[(k_) >> 1][bj][2 * ((k_) & 1) + mm][1]; \
      v0[0] *= fast_rcp(bflo(g[0])); v0[1] *= fast_rcp(bfhi(g[0])); v0[2] *= fast_rcp(bflo(g[1])); v0[3] *= fast_rcp(bfhi(g[1])); v1[0] *= fast_rcp(bflo(g[2])); v1[1] *= fast_rcp(bfhi(g[2])); v1[2] *= fast_rcp(bflo(g[3])); v1[3] *= fast_rcp(bfhi(g[3])); \
      *(u32x4*)(hp + (size_t)(((k_) >> 1) * 128 + (2 * ((k_) & 1) + mm) * 16) * D + bj * 128) = pack8(v0, v1); } asm volatile("" ::: "memory"); } while (0)
    P3F_LOAD(gA, 0); P3F_LOAD(gB, 1); P3F_APPLY(gA, 0);
    if (NSB == 4) { P3F_LOAD(gA, 2); P3F_APPLY(gB, 1); P3F_LOAD(gB, 3); P3F_APPLY(gA, 2); P3F_APPLY(gB, 3); }
    else P3F_APPLY(gB, 1);
#undef P3F_LOAD
#undef P3F_APPLY
  }
};

typedef EpiP3T<false> EpiP3;

template <bool HALFN, bool HALFM = false> struct EpiResT {
  static constexpr bool PERM = true, HAS_MID = false, HAS_RS = false;
  float* X32; bf16_t* XB; float* SS; LAS unsigned char* lds; const float* xin_p; const float* xin_s;
  DI void mid(f32x4 (&)[2][2][4][2], const Unit&, int, int, int, int, int) const {}
  DI void operator()(f32x4 (&acc)[2][2][4][2], const Unit& u, int wr, int wc, int fr, int fq) const {
    const int rin0 = wr * 64 + fr, row0 = u.pm * (HALFM ? 128 : 256) + rin0, col0 = u.pn * (HALFN ? 128 : 256) + wc * 32 + 8 * fq;
    LAS float* red = (LAS float*)(lds + 131072 + 8192);
#pragma unroll
    for (int ai = 0; ai < (HALFM ? 1 : 2); ++ai) {
      f32x4 xo[4][2][2] = {};
#pragma unroll
      for (int m = 0; m < 4; ++m) { const int r = row0 + ai * 128 + m * 16;
        if (xin_p) { const float* xr = (r < TOKP ? xin_p + (size_t)r * D : xin_s + (size_t)(r - TOKP) * D) + col0;
#pragma unroll
          for (int bj = 0; bj < (HALFN ? 1 : 2); ++bj)
#pragma unroll
            for (int n = 0; n < 2; ++n) xo[m][bj][n] = *(const f32x4*)(xr + bj * 128 + n * 4);
        } else {
#pragma unroll
          for (int bj = 0; bj < (HALFN ? 1 : 2); ++bj) { const u32x4 w = *(const u32x4*)(XB + (size_t)r * D + col0 + bj * 128);
            xo[m][bj][0] = (f32x4){bflo(w[0]), bfhi(w[0]), bflo(w[1]), bfhi(w[1])}; xo[m][bj][1] = (f32x4){bflo(w[2]), bfhi(w[2]), bflo(w[3]), bfhi(w[3])}; } } }
#pragma unroll
      for (int m = 0; m < 4; ++m) { const int r = row0 + ai * 128 + m * 16; bf16_t* bp = XB + (size_t)r * D + col0; float q = 0.f;
#pragma unroll
        for (int bj = 0; bj < (HALFN ? 1 : 2); ++bj)
          { const f32x4 x0 = xo[m][bj][0] + acc[ai][bj][m][0], x1 = xo[m][bj][1] + acc[ai][bj][m][1];
            *(u32x4*)(bp + bj * 128) = pack8(x0, x1);
            q += ((x0[0] * x0[0] + x0[1] * x0[1]) + (x0[2] * x0[2] + x0[3] * x0[3])) + ((x1[0] * x1[0] + x1[1] * x1[1]) + (x1[2] * x1[2] + x1[3] * x1[3])); }
        q += __shfl_xor(q, 16); q += __shfl_xor(q, 32);
        if (fq == 0) red[(rin0 + ai * 128 + m * 16) * 4 + wc] = q; }
      asm volatile("" ::: "memory"); }
    asm volatile("s_waitcnt lgkmcnt(0)" ::: "memory"); __builtin_amdgcn_s_barrier(); asm volatile("" ::: "memory");
    int t = threadIdx.x; asm volatile("" : "+v"(t));
    if (t < (HALFM ? 128 : 256)) { const f32x4 v = *(const LAS f32x4*)(red + t * 4); const float q = (v[0] + v[1]) + (v[2] + v[3]); float* sp = SS + (size_t)(u.pm * (HALFM ? 128 : 256) + t) * 8;
      if (HALFN) sp[u.pn] = q; else *(f32x2*)(sp + 2 * u.pn) = (f32x2){q, 0.f}; }
  }
};

typedef EpiResT<false> EpiRes;

DI float dpp_ror1(float v) { return __builtin_bit_cast(float, __builtin_amdgcn_update_dpp(0, __builtin_bit_cast(int, v), 0x121, 0xf, 0xf, false)); }
DI float dpp_ror2(float v) { return __builtin_bit_cast(float, __builtin_amdgcn_update_dpp(0, __builtin_bit_cast(int, v), 0x122, 0xf, 0xf, false)); }
DI float gelu_mul(float x, float uv) {
  const float t = __builtin_fmaf(x * x, 2.0f * LOG2E * 0.7978845608028654f * 0.044715f, 2.0f * LOG2E * 0.7978845608028654f);
  const float r = fast_rcp(fast_exp2(x * t) + 1.0f);
  return __builtin_fmaf(-x, r, x) * uv;
}
constexpr size_t SIDE_ROWS = (size_t)72 * 2 * DFF;
template <bool HALFM> struct EpiP5FT {
  static constexpr bool PERM = true, HAS_MID = false, HAS_RS = true;
  const float* SS; bf16_t* HF; float* out; const float* cw; const float* cb; const float* st; float* side; LAS unsigned char* lds; int layer;
  DI void mid(f32x4 (&)[2][2][4][2], const Unit&, int, int, int, int, int) const {}
  DI f32x4 prefetch(const Unit& u, int tid) const {
    f32x4 v = {0.f, 0.f, 0.f, 0.f};
    if (tid < (HALFM ? 128 : 256)) v = ss_load(SS, u.pm * (HALFM ? 128 : 256) + tid);
    else if (tid >= 256 && tid < 384) { int j = tid - 256; asm volatile("" : "+v"(j));
      const int arr = j >> 5, c4 = (j & 31) * 4; v = *(const f32x4*)((arr < 3 ? cw + arr * DFF : cb) + u.pn * 128 + c4); }
    return v;
  }
  DI void stash(const f32x4& v, const Unit& u, int tid, LAS unsigned char* l) const {
    if (tid < (HALFM ? 128 : 256)) *(LAS float*)(l + 131072 + 12288 + tid * 4) = ss_to_rs(v);
    else if (tid >= 256 && tid < 384) *(LAS f32x4*)(l + 131072 + 13312 + (tid - 256) * 16) = v;
  }
  DI void operator()(f32x4 (&acc)[2][2][4][2], const Unit& u, int wr, int wc, int fr_in, int fq_in) const {
    int fr = fr_in, fq = fq_in; asm volatile("" : "+v"(fr), "+v"(fq));
    const int rin0 = wr * 64 + fr, col0 = u.pn * 128 + wc * 32 + 8 * fq;
    const bool sample = HALFM ? true : u.pm >= 64, cont = !sample && (u.pm & 15) != 0;
    const int bd0 = HALFM ? (u.pm - TOKP / 128) * 2 : (u.pm - 64) * 4;
    LAS float* xh = (LAS float*)(lds + 131072);
    float* TAILG = side; float* HEADC = side + SIDE_ROWS; float* HEADU = side + 2 * SIDE_ROWS;
#pragma unroll
    for (int ai = 0; ai < (HALFM ? 1 : 2); ++ai)
#pragma unroll
      for (int m = 0; m < 4; ++m) { const float s = *(const LAS float*)(lds + 131072 + 12288 + (rin0 + ai * 128 + m * 16) * 4);
#pragma unroll
        for (int n = 0; n < 2; ++n) { acc[ai][0][m][n] *= s; acc[ai][1][m][n] *= s; } }
    if (fr >= 14) {
#pragma unroll
      for (int ai = 0; ai < (HALFM ? 1 : 2); ++ai) { const int gidx = 2 * ai + wr; LAS float* xp = xh + ((gidx * 4 + wc) * 2 + (fr - 14)) * 32 + fq * 8;
        *(LAS f32x4*)xp = acc[ai][0][3][0]; *(LAS f32x4*)(xp + 4) = acc[ai][0][3][1];
        float* cp = nullptr;
        if (sample) cp = out + O_SCONV + ((size_t)(layer * DB + bd0 + gidx) * 2 + (fr - 14)) * DFF + col0;
        else if (gidx == 3) { float* tp = TAILG + ((size_t)u.pm * 2 + (fr - 14)) * DFF + col0; *(f32x4*)tp = acc[ai][0][3][0]; *(f32x4*)(tp + 4) = acc[ai][0][3][1];
          if ((u.pm & 15) == 15) cp = out + O_PCONV + ((size_t)(layer * 4 + (u.pm >> 4)) * 2 + (fr - 14)) * DFF + col0; }
        if (cp) { *(f32x4*)cp = acc[ai][0][3][0]; *(f32x4*)(cp + 4) = acc[ai][0][3][1]; } }
    }
    asm volatile("s_waitcnt lgkmcnt(0)" ::: "memory"); __builtin_amdgcn_s_barrier(); asm volatile("" ::: "memory");
#pragma unroll
    for (int n = 0; n < 2; ++n) {
      const LAS float* cl = (const LAS float*)(lds + 131072 + 13312) + wc * 32 + 8 * fq + 4 * n;
      const f32x4 w0 = *(const LAS f32x4*)cl, w1 = *(const LAS f32x4*)(cl + 128), w2 = *(const LAS f32x4*)(cl + 256), bb = *(const LAS f32x4*)(cl + 384);
#pragma unroll
      for (int ai = 0; ai < (HALFM ? 1 : 2); ++ai) { const int gidx = 2 * ai + wr;
        f32x4 gp = {0.f, 0.f, 0.f, 0.f};
        if (fr >= 14) {
          if (sample) gp = *(const f32x4*)(st + ((size_t)(bd0 + gidx) * 2 + (fr - 14)) * DFF + col0 + 4 * n);
          else if (gidx > 0) gp = *(const LAS f32x4*)(xh + (((gidx - 1) * 4 + wc) * 2 + (fr - 14)) * 32 + fq * 8 + 4 * n);
        }
#pragma unroll
        for (int m = 0; m < 4; ++m) { const int rin = rin0 + ai * 128 + m * 16; f32x4 o, cc;
#pragma unroll
          for (int j = 0; j < 4; ++j) { const float g = acc[ai][0][m][n][j], gq = gp[j];
            const float r1g = dpp_ror1(g), r1q = dpp_ror1(gq), r2g = dpp_ror2(g), r2q = dpp_ror2(gq);
            const float p1 = fr >= 1 ? r1g : r1q, p2 = fr >= 2 ? r2g : r2q;
            const float c = __builtin_fmaf(w2[j], g, __builtin_fmaf(w1[j], p1, __builtin_fmaf(w0[j], p2, bb[j])));
            cc[j] = c; o[j] = gelu_mul(c, acc[ai][1][m][n][j]); }
          *(u32x2*)(HF + (size_t)(u.pm * (HALFM ? 128 : 256) + rin) * DFF + col0 + 4 * n) = pack4(o);
          if (cont && gidx == 0 && m == 0 && fr < 2) { *(f32x4*)(HEADC + ((size_t)u.pm * 2 + fr) * DFF + col0 + 4 * n) = cc; *(f32x4*)(HEADU + ((size_t)u.pm * 2 + fr) * DFF + col0 + 4 * n) = acc[ai][1][m][n]; }
          gp = acc[ai][0][m][n]; }
      }
    }
  }
};
typedef EpiP5FT<false> EpiP5F;
DI void p6_fixup_panel(int pm, const float* side, const float* cw, bf16_t* HF) {
  const float* TAILG = side + (size_t)(pm - 1) * 2 * DFF; const float* HEADC = side + SIDE_ROWS + (size_t)pm * 2 * DFF; const float* HEADU = side + 2 * SIDE_ROWS + (size_t)pm * 2 * DFF;
  int tid_ = threadIdx.x; asm volatile("" : "+v"(tid_));
  constexpr int NIT = (DFF + NTHREADS - 1) / NTHREADS;
  float t0[NIT], t1[NIT], a0[NIT], a1[NIT], hc0[NIT], hc1[NIT], hu0[NIT], hu1[NIT];
#pragma unroll
  for (int i = 0; i < NIT; ++i) { const int k = tid_ + i * NTHREADS; const int kk = k < DFF ? k : 0;
    t0[i] = TAILG[kk]; t1[i] = TAILG[DFF + kk]; a0[i] = cw[kk]; a1[i] = cw[DFF + kk]; hc0[i] = HEADC[kk]; hc1[i] = HEADC[DFF + kk]; hu0[i] = HEADU[kk]; hu1[i] = HEADU[DFF + kk]; }
#pragma unroll
  for (int i = 0; i < NIT; ++i) { const int k = tid_ + i * NTHREADS;
    const float c0 = hc0[i] + a0[i] * t0[i] + a1[i] * t1[i], c1 = hc1[i] + a0[i] * t1[i];
    const float h0 = gelu_mul(c0, hu0[i]), h1 = gelu_mul(c1, hu1[i]);
    f32x4 v = {h0, h1, 0.f, 0.f}; const u32x2 pk = pack4(v);
    if (k < DFF) { HF[(size_t)(pm * 256) * DFF + k] = (bf16_t)(pk[0] & 0xffffu); HF[(size_t)(pm * 256 + 1) * DFF + k] = (bf16_t)(pk[0] >> 16); } }
}

struct EpiNull {
  static constexpr bool PERM = true, HAS_MID = false, HAS_RS = false;
  DI void mid(f32x4 (&)[2][2][4][2], const Unit&, int, int, int, int, int) const {}
  DI void operator()(f32x4 (&acc)[2][2][4][2], const Unit& u, int wr, int wc, int fr, int fq) const {
#pragma unroll
    for (int ai = 0; ai < 2; ++ai)
#pragma unroll
      for (int bj = 0; bj < 2; ++bj)
#pragma unroll
        for (int m = 0; m < 4; ++m)
#pragma unroll
          for (int n = 0; n < 2; ++n) asm volatile("" :: "v"(acc[ai][bj][m][n]));
  }
};

DI float gelu_tanh(float x) {
  const float y = 0.7978845608028654f * (x + 0.044715f * x * x * x);
  const float e = fast_exp2(2.0f * LOG2E * y);
  const float th = 1.0f - 2.0f * fast_rcp(e + 1.0f);
  return 0.5f * x * (1.0f + th);
}
DI void pfinal_norm(const Params& p) {
  const bf16_t* XB = (const bf16_t*)(p.ws + WS_XB); const float* SS = (const float*)(p.ws + WS_SS);
  int tid_ = threadIdx.x; asm volatile("" : "+v"(tid_));
  const int lane = tid_ & 63, gw = blockIdx.x * 8 + (tid_ >> 6), NGW = gridDim.x * 8;
#pragma unroll 3
  for (int m = gw; m < TOK; m += NGW) { const float s = row_rs(SS, m);
#pragma unroll
    for (int j = 0; j < 2; ++j) { const u32x4 w = ((const u32x4*)(XB + (size_t)m * D))[lane + 64 * j];
      const f32x4 g0 = ((const f32x4*)p.norm_final)[2 * (lane + 64 * j)], g1 = ((const f32x4*)p.norm_final)[2 * (lane + 64 * j) + 1];
      const f32x4 a = {bflo(w[0]), bfhi(w[0]), bflo(w[1]), bfhi(w[1])}, b = {bflo(w[2]), bfhi(w[2]), bflo(w[3]), bfhi(w[3])};
      f32x4* o = (f32x4*)(p.out + (size_t)m * D) + 2 * (lane + 64 * j);
      __builtin_nontemporal_store(a * s * g0, o); __builtin_nontemporal_store(b * s * g1, o + 1); } }
}

DI pg8::GemmDesc p1_desc(unsigned char* ws, int l) {
  return pg8::GemmDesc{(const char*)(ws + WS_XB), (const char*)(ws + WS_WIN) + (size_t)l * INC * D * 2, D, D, D / 64, (size_t)256 * D * 2, (size_t)128 * D * 2};
}
DI EpiP1 p1_epi(const Params& p, int l, LAS unsigned char* lds) {
  return EpiP1{(const float*)(p.ws + WS_SS), (bf16_t*)(p.ws + WS_QKV), (bf16_t*)(p.ws + WS_GATE), p.b_gate + (size_t)l * 3 * D, p.out, l, 0, lds};
}
namespace attn {
constexpr int N_CPY = 0, N_CS = 128, N_CP = 512, N_AP = 512, N_BP = 512, N_AS = 256, N_BS = 256, NITEMS = N_CPY + N_CS + N_CP + N_AP + N_BP + N_AS + N_BS;
constexpr float STICK_DONE = 9.35762e-14f;

struct Item { int mode, h, tok0, past, q0, nqv, pflags; const float* cK; const float* cV; };

DI Item decode(const Params& p, int layer, int idx) {
  Item it; it.cK = nullptr; it.cV = nullptr; it.past = 0; it.pflags = 0;
  if (idx < N_CPY) { it.mode = 3; it.h = idx; return it; }
  idx -= N_CPY;
  if (idx < N_CS) { const int bd = idx >> 2, h = idx & 3; it.mode = 2; it.h = h; it.tok0 = TOKP + bd * 64; it.past = PAST; it.q0 = PAST; it.nqv = 64;
    it.cK = p.cache_c_k + (size_t)(layer * DB + bd) * PAST * 512 + h * 128; it.cV = p.cache_c_v + (size_t)(layer * DB + bd) * PAST * 512 + h * 128; return it; }
  idx -= N_CS;
  if (idx < N_CP) { const int jj = 31 - (idx >> 4), rem = idx & 15; it.mode = 2; it.h = rem & 3; it.tok0 = (rem >> 2) * SEQ; it.q0 = jj * 128; it.nqv = 128; return it; }
  idx -= N_CP;
  if (idx < N_AP + N_BP) { const int isb = idx >= N_AP; if (isb) idx -= N_AP; const int qt = 15 - (idx >> 5), rem = idx & 31; it.mode = isb; it.h = rem & 7; it.tok0 = (rem >> 3) * SEQ; it.q0 = qt * 256; it.nqv = 256; return it; }
  idx -= N_AP + N_BP;
  if (idx < N_AS) { const int bd = idx >> 3, h = idx & 7; it.mode = 0; it.h = h; it.tok0 = TOKP + bd * 64; it.past = ALEN; it.q0 = ALEN; it.nqv = 64;
    it.cK = p.cache_a_k + (size_t)(layer * DB + bd) * ALEN * 512 + h * 64; it.cV = p.cache_a_v + (size_t)(layer * DB + bd) * ALEN * 512 + h * 64; return it; }
  idx -= N_AS;
  { const int bd = idx >> 3, h = idx & 7; it.mode = 1; it.h = h; it.tok0 = TOKP + bd * 64; it.past = PAST; it.q0 = PAST; it.nqv = 64;
    it.cK = p.cache_b_k + (size_t)(layer * DB + bd) * PAST * 512 + h * 64; it.cV = p.cache_b_v + (size_t)(layer * DB + bd) * PAST * 512 + h * 64; return it; }
}


template <int MODE, bool SAMPLE>
DI void load_piece(u32x4& r0, u32x4& r1, u32x4& r2, u32x4& r3, const Item& it, const float* cache, const bf16_t* QKV, int col, int kt, int tid) {
  constexpr int CPR = MODE == 2 ? 16 : 8;
  const int j0 = kt * 64;
  const int ra = tid / CPR, ca = tid % CPR;
  if (SAMPLE && j0 < it.past) {
    const unsigned lo = (unsigned)(ra * 512 + ca * 8) * 4u; const char* b = (const char*)(cache + (size_t)j0 * 512);
    { const u32x4* q = (const u32x4*)(b + lo); r0 = __builtin_nontemporal_load(q); r1 = __builtin_nontemporal_load(q + 1); }
    if constexpr (MODE == 2) { const u32x4* q = (const u32x4*)(b + (size_t)32 * 512 * 4 + lo); r2 = __builtin_nontemporal_load(q); r3 = __builtin_nontemporal_load(q + 1); }
  } else {
    const unsigned lo = (unsigned)(ra * QKVW + ca * 8) * 2u; const char* b = (const char*)(QKV + (size_t)(it.tok0 + j0 - it.past) * QKVW + col);
    r0 = *(const u32x4*)(b + lo);
    if constexpr (MODE == 2) r2 = *(const u32x4*)(b + (size_t)32 * QKVW * 2 + lo);
  }
}
DI u32x4 cvt8(u32x4 a, u32x4 b) { return pack8(__builtin_bit_cast(f32x4, a), __builtin_bit_cast(f32x4, b)); }
template <int MODE, bool ISK, bool SAMPLE>
DI void write_piece(const u32x4& r0, const u32x4& r1, const u32x4& r2, const u32x4& r3, const Item& it, LAS unsigned char* buf, int kt, int tid) {
  constexpr int CPR = MODE == 2 ? 16 : 8, VS = MODE == 2 ? 320 : 192;
  const bool f32src = SAMPLE && kt * 64 < it.past;
  const int ra = tid / CPR, ca = tid % CPR, rb = (tid + NTHREADS) / CPR, cb = (tid + NTHREADS) % CPR;
  { const u32x4 x = f32src ? cvt8(r0, r1) : r0;
    if (ISK) *(LAS u32x4*)(buf + ((MODE == 2 && ca >= 8) ? 8192 : 0) + ra * 128 + (((ca & 7) ^ ((ra >> 1) & 7)) << 4)) = x;
    else *(LAS u32x4*)(buf + ra * VS + ca * 16) = x; }
  if constexpr (MODE == 2) { const u32x4 x = f32src ? cvt8(r2, r3) : r2;
    if (ISK) *(LAS u32x4*)(buf + (cb >= 8 ? 8192 : 0) + rb * 128 + (((cb & 7) ^ ((rb >> 1) & 7)) << 4)) = x;
    else *(LAS u32x4*)(buf + rb * VS + cb * 16) = x; }
}

template <int MODE>
DI void state_store(const u32x4& r0, const u32x4& r2, float* dst, int tid) {
  constexpr int CPR = MODE == 2 ? 16 : 8;
  const int ra = tid / CPR, ca = tid % CPR, rb = (tid + NTHREADS) / CPR, cb = (tid + NTHREADS) % CPR;
  { float* q = dst + (size_t)ra * 512 + ca * 8;
    __builtin_nontemporal_store((f32x4){bflo(r0[0]), bfhi(r0[0]), bflo(r0[1]), bfhi(r0[1])}, (f32x4*)q); __builtin_nontemporal_store((f32x4){bflo(r0[2]), bfhi(r0[2]), bflo(r0[3]), bfhi(r0[3])}, (f32x4*)(q + 4)); }
  if constexpr (MODE == 2) { float* q = dst + (size_t)rb * 512 + cb * 8;
    __builtin_nontemporal_store((f32x4){bflo(r2[0]), bfhi(r2[0]), bflo(r2[1]), bfhi(r2[1])}, (f32x4*)q); __builtin_nontemporal_store((f32x4){bflo(r2[2]), bfhi(r2[2]), bflo(r2[3]), bfhi(r2[3])}, (f32x4*)(q + 4)); }
}
template <int MODE>
DI float* state_dst(const Params& p, int layer, const Item& it, int kt, int isv) {
  const int hoff = MODE == 2 ? it.h * 128 : it.h * 64;
  if (it.past == 0) {
    const int t0 = kt * 64; if (t0 < it.q0 || t0 >= it.q0 + it.nqv) return nullptr;
    const int b = it.tok0 / SEQ;
    if (MODE == 0) { if (t0 < SEQ - 512) return nullptr; return p.out + (isv ? O_PAV : O_PAK) + ((size_t)(layer * 4 + b) * 512 + (t0 - (SEQ - 512))) * 512 + hoff; }
    return p.out + (MODE == 1 ? (isv ? O_PBV : O_PBK) : (isv ? O_PCV : O_PCK)) + ((size_t)(layer * 4 + b) * SEQ + t0) * 512 + hoff;
  } else {
    if (kt * 64 != it.past) return nullptr;
    const int bd = (it.tok0 - TOKP) / 64;
    if (MODE == 0) return p.out + (isv ? O_SAV : O_SAK) + ((size_t)(layer * DB + bd) * 512 + 448) * 512 + hoff;
    return p.out + (MODE == 1 ? (isv ? O_SBV : O_SBK) : (isv ? O_SCV : O_SCK)) + ((size_t)(layer * DB + bd) * 64) * 512 + hoff;
  }
}

DI void roll_store(const u32x4& r0, const u32x4& r1, const Params& p, int layer, const Item& it, int kt, int isv, int tid) {
  if (kt < 1 || kt * 64 >= it.past) return;
  const int bd = (it.tok0 - TOKP) / 64, ra = tid >> 3, ca = tid & 7;
  float* q = p.out + (isv ? O_SAV : O_SAK) + ((size_t)(layer * DB + bd) * 512 + (kt - 1) * 64 + ra) * 512 + it.h * 64 + ca * 8;
  __builtin_nontemporal_store(__builtin_bit_cast(f32x4, r0), (f32x4*)q); __builtin_nontemporal_store(__builtin_bit_cast(f32x4, r1), (f32x4*)(q + 4));
}
DI bf16x8 pack_p(const f32x16& x, int s) {
  const f32x4 a = {x[8 * s], x[8 * s + 1], x[8 * s + 2], x[8 * s + 3]}, b = {x[8 * s + 4], x[8 * s + 5], x[8 * s + 6], x[8 * s + 7]};
  return __builtin_bit_cast(bf16x8, pack8(a, b));
}
#define MFMA32(a, b, c) __builtin_amdgcn_mfma_f32_32x32x16_bf16((a), (b), (c), 0, 0, 0)

constexpr int L_KB = 0, KB_BYTES = 16384, L_VB = 32768, VB_BYTES = 20480, L_LUT = 73728, L_FLAGS = 75776, L_XCH = 81920;

template <int MODE, bool SAMPLE>
DI void run_item(const Params& p, int layer, const Item& it, LAS unsigned char* lds_in) {
  LAS unsigned char* lds = opaque_lds(lds_in);
  constexpr int NDV = MODE == 2 ? 4 : 2, VS = MODE == 2 ? 320 : 192;
  int tid_ = threadIdx.x; asm volatile("" : "+v"(tid_));
  const int tid = tid_, lane = tid & 63, wave = __builtin_amdgcn_readfirstlane(tid >> 6);
  const int qi = lane & 31, h2 = lane >> 5;
  const int mp = MODE == 2 ? (wave >> 2) : 0, wrow = MODE == 2 ? (wave & 3) : wave;
  const int q0w = it.q0 + 32 * wrow;
  const bool active = 32 * wrow < it.nqv;
  const bf16_t* QKV = (const bf16_t*)(p.ws + WS_QKV);
  const int hb = MODE == 2 ? it.h * 128 : it.h * 64;
  const int qcol = (MODE == 0 ? 0 : MODE == 1 ? 1536 : 3072) + hb + 64 * mp, kcol = (MODE == 0 ? 512 : MODE == 1 ? 2048 : 3584) + hb, vcol = (MODE == 0 ? 1024 : MODE == 1 ? 2560 : 4096) + hb;
  const int cw = q0w >> 6;
  int kt_first, step, NT;
  if (MODE == 0) { kt_first = (it.q0 >> 6) - 8; if (kt_first < 0) kt_first = 0; step = 1; NT = ((it.q0 + it.nqv - 1) >> 6) - kt_first + 1; }
  else if (MODE == 2) { kt_first = 0; step = 1; NT = ((it.q0 + it.nqv - 1) >> 6) + 1; }
  else { kt_first = (it.q0 + it.nqv - 2) >> 6; step = -1; NT = kt_first + 1; }
  const bool wr_state = it.pflags == 0;
  u32x4 k0 = {}, k1 = {}, k2 = {}, k3 = {}, v0 = {}, v1 = {}, v2 = {}, v3 = {};
  load_piece<MODE, SAMPLE>(k0, k1, k2, k3, it, it.cK, QKV, kcol, kt_first, tid);
  load_piece<MODE, SAMPLE>(v0, v1, v2, v3, it, it.cV, QKV, vcol, kt_first, tid);
  LAS float* lut = (LAS float*)(lds + L_LUT);
  LAS unsigned* flags = (LAS unsigned*)(lds + L_FLAGS);
  if (MODE == 0) { const float bfar = p.a_rel_bias[((size_t)layer * 257 + 256) * 8 + it.h]; for (int i = tid; i < 257; i += NTHREADS) lut[i] = p.a_rel_bias[((size_t)layer * 257 + i) * 8 + it.h] - bfar; }
  if (MODE == 2) { if (tid < 192) lut[tid] = ((const float*)(p.ws + WS_CTL))[CW_T5 + it.h * 192 + tid]; }
  bf16x8 qf[4];
  if (active) { const bf16_t* qp = QKV + (size_t)(it.tok0 + q0w + qi - it.past) * QKVW + qcol + 8 * h2;
#pragma unroll
    for (int s = 0; s < 4; ++s) { const u32x4 w = *(const u32x4*)(qp + 16 * s);
      const f32x4 a = {bflo(w[0]) * 0.125f, bfhi(w[0]) * 0.125f, bflo(w[1]) * 0.125f, bfhi(w[1]) * 0.125f}, b = {bflo(w[2]) * 0.125f, bfhi(w[2]) * 0.125f, bflo(w[3]) * 0.125f, bfhi(w[3]) * 0.125f};
      qf[s] = __builtin_bit_cast(bf16x8, pack8(a, b)); } }
  f32x16 O[NDV];
#pragma unroll
  for (int b = 0; b < NDV; ++b)
#pragma unroll
    for (int i = 0; i < 16; ++i) O[b][i] = 0.f;
  float m_run = -1e30f, l_run = 0.f, R2 = 1.0f; bool done = false, have_p = false;
  bf16x8 pf[4];
#pragma unroll
  for (int s = 0; s < 4; ++s) pf[s] = (bf16x8){0, 0, 0, 0, 0, 0, 0, 0};
  const int krow_off = qi * 128, kswz = (qi >> 1) & 7;
  const int g16 = lane >> 4, trq = (lane & 15) >> 2, trp = lane & 3;
  const int vtr_off = (4 * (g16 >> 1) + trq) * VS + (16 * (g16 & 1) + 4 * trp) * 2;

  write_piece<MODE, true, SAMPLE>(k0, k1, k2, k3, it, lds + L_KB, kt_first, tid);
  if (wr_state) { float* d = state_dst<MODE>(p, layer, it, kt_first, 0); if (d) state_store<MODE>(k0, k2, d, tid); }
  if (MODE == 0 && SAMPLE && wr_state) roll_store(k0, k1, p, layer, it, kt_first, 0, tid);
  if (NT > 1) load_piece<MODE, SAMPLE>(k0, k1, k2, k3, it, it.cK, QKV, kcol, kt_first + step, tid);
  for (int t = 0;; ++t) {
    __syncthreads();
    if (MODE == 1 && t > 0 && t < NT) { const unsigned any = flags[0] | flags[1] | flags[2] | flags[3] | flags[4] | flags[5] | flags[6] | flags[7]; if (!any) NT = t; }
    const int kt = kt_first + step * t;
    bool mine = false;
    if (t < NT && !(it.pflags & 2)) {
      if (MODE == 0) mine = active && kt >= cw - 8 && kt <= cw;
      else if (MODE == 2) mine = active && kt <= cw;
      else mine = active && !done && kt * 64 <= q0w + 30;
    }
    LAS unsigned char* vb = lds + L_VB + ((t - 1) & 1) * VB_BYTES + vtr_off;
    LAS unsigned char* kb = lds + L_KB + (t & 1) * KB_BYTES + ((MODE == 2 && mp) ? 8192 : 0);
    constexpr int HB = NDV / 2, NST = 4 * HB;
    bf16x8 kfa[4], vfa[2], vfb[2];
    const bool do_pv = have_p && !(it.pflags & 8);
#define V_LOAD(dst, j_) do { if (do_pv) { _Pragma("unroll") for (int bb = 0; bb < 2; ++bb) { const int a0 = 16 * ((j_) / HB) * VS + 64 * (2 * ((j_) % HB) + bb); \
      const s16x4 lo = __builtin_amdgcn_ds_read_tr16_b64_v4i16((LAS s16x4*)(vb + a0)), hi = __builtin_amdgcn_ds_read_tr16_b64_v4i16((LAS s16x4*)(vb + a0 + 8 * VS)); \
      dst[bb] = __builtin_shufflevector(lo, hi, 0, 1, 2, 3, 4, 5, 6, 7); } } } while (0)
#define V_MMA(src, j_) do { if (do_pv) { _Pragma("unroll") for (int bb = 0; bb < 2; ++bb) O[2 * ((j_) % HB) + bb] = MFMA32(src[bb], pf[(j_) / HB], O[2 * ((j_) % HB) + bb]); } } while (0)
#define STG(j_, cur, nxt) do { if (SAMPLE) { V_LOAD(cur, j_); V_MMA(cur, j_); } else { if ((j_) + 1 < NST) V_LOAD(nxt, (j_) + 1); V_MMA(cur, j_); } } while (0)
    if (!SAMPLE) {
      if (mine) {
#pragma unroll
        for (int s = 0; s < 4; ++s) kfa[s] = *(const LAS bf16x8*)(kb + krow_off + (((2 * s + h2) ^ kswz) << 4)); }
      V_LOAD(vfa, 0);
      __builtin_amdgcn_sched_barrier(0);
    }
    if (t < NT && !(it.pflags & 1)) { write_piece<MODE, false, SAMPLE>(v0, v1, v2, v3, it, lds + L_VB + (t & 1) * VB_BYTES, kt_first + step * t, tid);
      if (wr_state) { float* d = state_dst<MODE>(p, layer, it, kt_first + step * t, 1); if (d) state_store<MODE>(v0, v2, d, tid); }
      if (MODE == 0 && SAMPLE && wr_state) roll_store(v0, v1, p, layer, it, kt_first + step * t, 1, tid);
      if (t + 1 < NT) { write_piece<MODE, true, SAMPLE>(k0, k1, k2, k3, it, lds + L_KB + ((t + 1) & 1) * KB_BYTES, kt_first + step * (t + 1), tid);
        if (wr_state) { float* d = state_dst<MODE>(p, layer, it, kt_first + step * (t + 1), 0); if (d) state_store<MODE>(k0, k2, d, tid); }
        if (MODE == 0 && SAMPLE && wr_state) roll_store(k0, k1, p, layer, it, kt_first + step * (t + 1), 0, tid);
        load_piece<MODE, SAMPLE>(v0, v1, v2, v3, it, it.cV, QKV, vcol, kt_first + step * (t + 1), tid);
        if (t + 2 < NT) load_piece<MODE, SAMPLE>(k0, k1, k2, k3, it, it.cK, QKV, kcol, kt_first + step * (t + 2), tid); } }
    __builtin_amdgcn_sched_barrier(0);
    f32x16 sA, sB;
#pragma unroll
    for (int i = 0; i < 16; ++i) { sA[i] = 0.f; sB[i] = 0.f; }
    if (mine) {
      bf16x8 kfc[4];
      if (SAMPLE) {
#pragma unroll
        for (int s = 0; s < 4; ++s) kfa[s] = *(const LAS bf16x8*)(kb + krow_off + (((2 * s + h2) ^ kswz) << 4)); }
#pragma unroll
      for (int s = 0; s < 4; ++s) kfc[s] = *(const LAS bf16x8*)(kb + 4096 + krow_off + (((2 * s + h2) ^ kswz) << 4));
#pragma unroll
      for (int s = 0; s < 4; ++s) sA = MFMA32(kfa[s], qf[s], sA);
#pragma unroll
      for (int s = 0; s < 4; ++s) sB = MFMA32(kfc[s], qf[s], sB);
    }
    const int kbase = kt * 64 + 4 * h2;
    if (MODE != 1) {
      float mx = -1e30f, alpha = 1.0f, lsa = 0.f, lsb = 0.f; bool resc = false;
      const bool smx = mine && !(it.pflags & 4);
      STG(0, vfa, vfb);
      if (NST == 8) STG(1, vfb, vfa);
      if (smx) {
        bool cst;
        if (MODE == 0) cst = q0w - (kt * 64 + 63) >= 128; else cst = kt * 64 + 63 - q0w <= -127;
        if (!cst) {
#pragma unroll
          for (int i = 0; i < 16; ++i) { const int ko = (i & 3) + 8 * (i >> 2);
            int ia, ib;
            if (MODE == 0) { const int d = (q0w + qi) - (kbase + ko); ia = d; ib = d - 32; ia = (ia < -128 ? -128 : ia > 128 ? 128 : ia) + 128; ib = (ib < -128 ? -128 : ib > 128 ? 128 : ib) + 128; }
            else { const int d = (kbase + ko) - (q0w + qi); ia = d; ib = d + 32; ia = (ia < -127 ? -127 : ia > 63 ? 63 : ia) + 127; ib = (ib < -127 ? -127 : ib > 63 ? 63 : ib) + 127; }
            sA[i] += lut[ia]; sB[i] += lut[ib]; }
        }
        float m0 = fmaxf(fmaxf(sA[0], sA[1]), sA[2]), m1 = fmaxf(fmaxf(sB[0], sB[1]), sB[2]);
#pragma unroll
        for (int i = 3; i < 15; i += 2) { m0 = fmaxf(fmaxf(m0, sA[i]), sA[i + 1]); m1 = fmaxf(fmaxf(m1, sB[i]), sB[i + 1]); }
        mx = fmaxf(fmaxf(m0, m1), fmaxf(sA[15], sB[15]));
      }
      __builtin_amdgcn_sched_barrier(0);
      if (NST == 8) { STG(2, vfa, vfb); STG(3, vfb, vfa); } else STG(1, vfb, vfa);
      if (smx) {
        mx = fmaxf(mx, __shfl_xor(mx, 32)) * LOG2E;
        resc = !__all(mx <= m_run + 8.0f);
        if (resc) { const float mnew = fmaxf(m_run, mx); alpha = fast_exp2(m_run - mnew); m_run = mnew; l_run *= alpha; }
#pragma unroll
        for (int i = 0; i < 16; ++i) { sA[i] = fast_exp2(__builtin_fmaf(sA[i], LOG2E, -m_run)); lsa += sA[i]; }
      }
      __builtin_amdgcn_sched_barrier(0);
      if (NST == 8) { STG(4, vfa, vfb); STG(5, vfb, vfa); } else STG(2, vfa, vfb);
      if (smx) {
#pragma unroll
        for (int i = 0; i < 16; ++i) { sB[i] = fast_exp2(__builtin_fmaf(sB[i], LOG2E, -m_run)); lsb += sB[i]; }
        l_run += lsa + lsb;
      }
      __builtin_amdgcn_sched_barrier(0);
      if (NST == 8) { STG(6, vfa, vfb); STG(7, vfb, vfa); } else STG(3, vfb, vfa);
      __builtin_amdgcn_sched_barrier(0);
      if (mine) {
        if (resc) {
#pragma unroll
        for (int b = 0; b < NDV; ++b)
#pragma unroll
          for (int i = 0; i < 16; ++i) O[b][i] *= alpha;
        }
        pf[0] = pack_p(sA, 0); pf[1] = pack_p(sA, 1); pf[2] = pack_p(sB, 0); pf[3] = pack_p(sB, 1);
      }
    } else {
      STG(0, vfa, vfb); STG(1, vfb, vfa); STG(2, vfa, vfb); STG(3, vfb, vfa);
      if (mine) {
        const bool diag = kt * 64 + 63 >= q0w;
        float kpA[16], kpB[16];
#pragma unroll
        for (int i = 0; i < 16; ++i) { const int ko = (i & 3) + 8 * (i >> 2);
          { const float r = fast_rcp(1.0f + fast_exp2(sA[i] * LOG2E)); const bool ok = !diag || (kbase + ko) < (q0w + qi); kpA[i] = ok ? r : 1.0f; sA[i] = ok ? 1.0f - r : 0.0f; }
          { const float r = fast_rcp(1.0f + fast_exp2(sB[i] * LOG2E)); const bool ok = !diag || (kbase + 32 + ko) < (q0w + qi); kpB[i] = ok ? r : 1.0f; sB[i] = ok ? 1.0f - r : 0.0f; } }
        float gs[8], pg[8];
#pragma unroll
        for (int g = 0; g < 4; ++g) { gs[g] = (kpA[4 * g] * kpA[4 * g + 1]) * (kpA[4 * g + 2] * kpA[4 * g + 3]); gs[4 + g] = (kpB[4 * g] * kpB[4 * g + 1]) * (kpB[4 * g + 2] * kpB[4 * g + 3]); }
#pragma unroll
        for (int g = 0; g < 8; ++g) pg[g] = __shfl_xor(gs[g], 32);
        float suf = R2;
#pragma unroll
        for (int g = 7; g >= 0; --g) { const float off = suf * (h2 == 0 ? pg[g] : 1.0f);
          if (g >= 4) { const int b = 4 * (g - 4); const float a3 = off, a2 = a3 * kpB[b + 3], a1 = a2 * kpB[b + 2], a0 = a1 * kpB[b + 1];
            sB[b + 3] *= a3; sB[b + 2] *= a2; sB[b + 1] *= a1; sB[b] *= a0; }
          else { const int b = 4 * g; const float a3 = off, a2 = a3 * kpA[b + 3], a1 = a2 * kpA[b + 2], a0 = a1 * kpA[b + 1];
            sA[b + 3] *= a3; sA[b + 2] *= a2; sA[b + 1] *= a1; sA[b] *= a0; }
          suf *= gs[g] * pg[g]; }
        R2 = suf;
        done = __all(R2 < STICK_DONE) != 0;
        pf[0] = pack_p(sA, 0); pf[1] = pack_p(sA, 1); pf[2] = pack_p(sB, 0); pf[3] = pack_p(sB, 1);
      }
    }
#undef V_LOAD
#undef V_MMA
#undef STG
    have_p = mine;
    if (MODE == 1 && t < NT) { if (lane == 0) flags[wave] = (active && !done && kt > 0 && (kt - 1) * 64 <= q0w + 30) ? 1u : 0u; }
    if (t >= NT) break;
  }
  int lane_e = lane; asm volatile("" : "+v"(lane_e));
  const int qi_e = lane_e & 31, h2_e = lane_e >> 5;
  bf16_t* Ob = (bf16_t*)(p.ws + WS_O);
  const int ocol = MODE == 0 ? hb : MODE == 1 ? 512 + hb : 1024 + hb;
  const bool wr_out = it.pflags == 0;
  if (MODE != 2) {
    if (active && wr_out) { float sc = 1.f; if (MODE == 0) { const float lt = l_run + __shfl_xor(l_run, 32); sc = fast_rcp(lt); }
      bf16_t* op = Ob + (size_t)(it.tok0 + q0w + qi_e - it.past) * OW + ocol + 4 * h2_e;
#pragma unroll
      for (int b = 0; b < NDV; ++b)
#pragma unroll
        for (int g = 0; g < 4; ++g) { const f32x4 v = {O[b][4 * g] * sc, O[b][4 * g + 1] * sc, O[b][4 * g + 2] * sc, O[b][4 * g + 3] * sc}; *(u32x2*)(op + 32 * b + 8 * g) = pack4(v); } }
    __syncthreads();
  } else {
    const float lam = ((const float*)(p.ws + WS_CTL))[CW_LAM + layer];
    const float sub_scale = 1.0f - (0.8f - 0.6f * expf(-0.3f * (float)layer));
    LAS float* xch = (LAS float*)(lds + L_XCH);
    if (active && mp == 1) { const float lt = l_run + __shfl_xor(l_run, 32), sc = lam * fast_rcp(lt);
#pragma unroll
      for (int b = 0; b < NDV; ++b)
#pragma unroll
        for (int i = 0; i < 16; ++i) xch[((wave & 3) * 64 + b * 16 + i) * 64 + lane_e] = O[b][i] * sc; }
    __syncthreads();
    if (active && mp == 0 && wr_out) { const float lt = l_run + __shfl_xor(l_run, 32), sc = fast_rcp(lt); float q = 0.f;
#pragma unroll
      for (int b = 0; b < NDV; ++b)
#pragma unroll
        for (int i = 0; i < 16; ++i) { const float o = O[b][i] * sc - xch[((wave & 3) * 64 + b * 16 + i) * 64 + lane_e]; O[b][i] = o; q += o * o; if ((i & 7) == 7) __builtin_amdgcn_sched_barrier(0); }
      q += __shfl_xor(q, 32);
      const float rstd = __builtin_amdgcn_rsqf(q * (1.0f / 128.0f) + EPS) * sub_scale;
      const float* gain = p.c_subln + layer * 128 + 4 * h2_e;
      bf16_t* op = Ob + (size_t)(it.tok0 + q0w + qi_e - it.past) * OW + ocol + 4 * h2_e;
#pragma unroll
      for (int b = 0; b < NDV; ++b)
#pragma unroll
        for (int g = 0; g < 4; ++g) { const f32x4 gn = *(const f32x4*)(gain + 32 * b + 8 * g);
          const f32x4 v = {O[b][4 * g] * rstd * gn[0], O[b][4 * g + 1] * rstd * gn[1], O[b][4 * g + 2] * rstd * gn[2], O[b][4 * g + 3] * rstd * gn[3]}; *(u32x2*)(op + 32 * b + 8 * g) = pack4(v); } }
    __syncthreads();
  }
}

DI void copy_item(const Params& p, int layer, int idx) {
  const int which = idx >> 5, bd = idx & 31;
  const size_t lb = (size_t)layer * DB + bd;
  const f32x4* src = (const f32x4*)((which ? p.cache_a_v : p.cache_a_k) + lb * 512 * 512 + 64 * 512);
  f32x4* dst = (f32x4*)(p.out + (which ? O_SAV : O_SAK) + lb * 512 * 512);
  int tid_ = threadIdx.x; asm volatile("" : "+v"(tid_));
#pragma unroll 4
  for (int i = tid_; i < 448 * 128; i += NTHREADS) __builtin_nontemporal_store(__builtin_nontemporal_load(src + i), dst + i);
}
#ifndef PROBE_ATT_FLAGS
#define PROBE_ATT_FLAGS 0
#endif
#ifndef PROBE_ATT_LO
#define PROBE_ATT_LO 0
#define PROBE_ATT_HI NITEMS
#endif
DI void attn_phase(const Params& p, int qidx, LAS unsigned char* lds) {
  const int layer = qidx & 1; const int i_lo = qidx >= 2 ? PROBE_ATT_LO : 0, i_hi = qidx >= 2 ? PROBE_ATT_HI : NITEMS;
  unsigned* head = (unsigned*)(p.ws + WS_CTL) + CW_QUEUE + 64 * qidx;
  LAS unsigned* slot = (LAS unsigned*)(lds + LDS_BYTES - 48);
  if (threadIdx.x == 0) slot[0] = atomicAdd(head, 1u);
  for (int k = 0;; ++k) {
    __syncthreads();
    const int idx = __builtin_amdgcn_readfirstlane((int)slot[k & 1]) + i_lo;
    if (threadIdx.x == 0) slot[(k + 1) & 1] = atomicAdd(head, 1u);
    if (idx >= i_hi) break;
    Item it = decode(p, layer, idx); it.pflags = qidx >= 2 ? PROBE_ATT_FLAGS : 0;
    if (it.mode == 3) { if (qidx < 2) copy_item(p, layer, it.h); continue; }
    if (it.past == 0) { if (it.mode == 0) run_item<0, false>(p, layer, it, lds); else if (it.mode == 1) run_item<1, false>(p, layer, it, lds); else run_item<2, false>(p, layer, it, lds); }
    else { if (it.mode == 0) run_item<0, true>(p, layer, it, lds); else if (it.mode == 1) run_item<1, true>(p, layer, it, lds); else run_item<2, true>(p, layer, it, lds); }
  }
}
}
#define XB_TMO      128
#define XB_XCNT(j)  (256  + 64 * (j))
#define XB_XSUB(j)  (1280 + 64 * (j))
#define XB_XGEN(j)  (2304 + 64 * (j))
#define XB_TOP      3328
#define XB_TOPGEN   3392
#define XCD_BAR_WORDS 3456
#define XB_SPIN_CAP (1u << 18)
DI unsigned xb_ld(unsigned* p)              { return __hip_atomic_load(p, __ATOMIC_RELAXED, __HIP_MEMORY_SCOPE_AGENT); }
DI unsigned xb_add(unsigned* p, unsigned v) { return __hip_atomic_fetch_add(p, v, __ATOMIC_RELAXED, __HIP_MEMORY_SCOPE_AGENT); }
DI unsigned xb_xcc_id() { return (unsigned)__builtin_amdgcn_s_getreg((3 << 11) | 20) & 0xFu; }
#define XB_SPIN(cond, bar) do { unsigned _sp = 0; while (cond) { __builtin_amdgcn_s_sleep(1); \
    if ((++_sp & 255u) == 0u) { if (xb_ld(&(bar)[XB_TMO])) break; if (_sp > XB_SPIN_CAP) { atomicAdd(&(bar)[XB_TMO], 1u); break; } } } } while (0)
struct XcdBarrier { unsigned* bar; unsigned x; volatile LAS unsigned* st; };
DI XcdBarrier xcd_barrier_post(unsigned* bar, volatile LAS unsigned* st) {
  XcdBarrier b; b.bar = bar; b.x = xb_xcc_id(); b.st = st;
  if (threadIdx.x == 0) (void)xb_add(&bar[XB_XCNT(b.x)], 1u);
  return b;
}
DI void xcd_barrier_complete(unsigned* bar, unsigned x, unsigned& nloc, unsigned& nx) {
  const unsigned G = gridDim.x * gridDim.y * gridDim.z;
  unsigned sum, cnt, mine, sp = 0u;
  for (;;) {
    sum = 0u; cnt = 0u; mine = 0u;
#pragma unroll
    for (unsigned j = 0; j < 16; ++j) { const unsigned c = xb_ld(&bar[XB_XCNT(j)]); sum += c; cnt += (c > 0u) ? 1u : 0u; mine = (j == x) ? c : mine; }
    if (sum == G) break;
    __builtin_amdgcn_s_sleep(1);
    if ((++sp & 255u) == 0u) { if (xb_ld(&bar[XB_TMO])) break; if (sp > XB_SPIN_CAP) { atomicAdd(&bar[XB_TMO], 1u); break; } }
  }
  nloc = mine > 0u ? mine : 1u; nx = cnt > 0u ? cnt : 1u;
}
DI void xcd_barrier(const XcdBarrier& b) {
  asm volatile("s_waitcnt vmcnt(0)" ::: "memory");
  __syncthreads();
  if (threadIdx.x == 0) {
    unsigned* bar = b.bar;
    __builtin_amdgcn_s_waitcnt(0);
    unsigned nloc = b.st[0], nx = b.st[1];
    if (nloc == 0u) { xcd_barrier_complete(bar, b.x, nloc, nx); b.st[0] = nloc; b.st[1] = nx; }
    const unsigned old = xb_add(&bar[XB_XSUB(b.x)], 1u);
    const unsigned gen = old / nloc;
    if (old + 1u == (gen + 1u) * nloc) {
      __builtin_amdgcn_fence(__ATOMIC_RELEASE, "agent");
      asm volatile("s_waitcnt vmcnt(0)" ::: "memory");
      const unsigned og = xb_add(&bar[XB_TOP], 1u);
      const unsigned tg = og / nx;
      if (og + 1u == (tg + 1u) * nx) xb_add(&bar[XB_TOPGEN], 1u);
      else XB_SPIN(xb_ld(&bar[XB_TOPGEN]) == tg, bar);
      __builtin_amdgcn_fence(__ATOMIC_ACQUIRE, "agent");
      xb_add(&bar[XB_XGEN(b.x)], 1u);
      asm volatile("s_waitcnt vmcnt(0)" ::: "memory");
    } else {
      XB_SPIN(xb_ld(&bar[XB_XGEN(b.x)]) == gen, bar);
      __builtin_amdgcn_fence(__ATOMIC_ACQUIRE, "agent");
      asm volatile("s_waitcnt vmcnt(0)" ::: "memory");
    }
  }
  __syncthreads();
}
constexpr int L_BARST = LDS_BYTES - 64;

#ifndef PROBE_P1_FLAGS
#define PROBE_P1_FLAGS 0
#endif
#ifndef PROBE_NULL_EPI
#define PROBE_NULL_EPI 0
#endif
#ifndef PROBE_MASK
#define PROBE_MASK 0
#endif
#define REPEAT(k) for (int rep_ = 0; rep_ < (((PROBE_MASK >> (k)) & 1) ? 2 : 1); ++rep_)
constexpr int NPHASE = 2 + 6 * NLAYER;
__global__ void __launch_bounds__(NTHREADS, 2) fwd_megakernel(Params p_k) {
  extern __shared__ __attribute__((aligned(16))) unsigned char lds_raw[];
  LAS unsigned char* lds = (LAS unsigned char*)lds_raw;
  cg::grid_group grid = cg::this_grid();
  const int lo = p_k.ph_lo, hi = p_k.ph_hi;
#define IN(k) (lo <= (k) && (k) < hi)
#define SEAM(k) do { if (IN(k) && IN((k) + 1)) xcd_barrier(bar); } while (0)
  const int G = gridDim.x, c = blockIdx.x;
  if (threadIdx.x < 2) ((LAS unsigned*)(lds + L_BARST))[threadIdx.x] = 0u;
  XcdBarrier bar; bar.bar = (unsigned*)(p_k.ws + WS_CTL) + CW_BAR; bar.x = 0; bar.st = (volatile LAS unsigned*)(lds + L_BARST);
  if (p_k.ph_lo < 0) grid.sync();
  bar = xcd_barrier_post((unsigned*)(p_k.ws + WS_CTL) + CW_BAR, (volatile LAS unsigned*)(lds + L_BARST));
  if (IN(0)) { p0_prologue(p_k, lds); if ((PROBE_MASK >> 6) & 1) { __syncthreads(); p0_prologue(p_k, lds); } }
  SEAM(0);
  for (int l = 0; l < NLAYER; ++l) {
    const int pb = 1 + 6 * l;
    const Params& p = p_k; unsigned char* ws = p.ws;
    if (IN(pb + 0)) REPEAT(0) {
      pg8::GemmDesc g{(const char*)(ws + WS_XB), (const char*)(ws + WS_WIN) + (size_t)l * INC * D * 2, D, D, D / 64, (size_t)256 * D * 2, (size_t)128 * D * 2};
      pg8::P1Order S; S.R1.init(TOK / 256, pg8::P1_NN, G, c);
      EpiP1 E{(const float*)(ws + WS_SS), (bf16_t*)(ws + WS_QKV), (bf16_t*)(ws + WS_GATE), p.b_gate + (size_t)l * 3 * D, p.out, l, rep_ == 1 ? PROBE_P1_FLAGS : 0, lds};
#if PROBE_NULL_EPI
      if (rep_ == 1) { EpiNull EN; pg8::gemm_phase<EpiNull, false, false, pg8::P1Order>(lds, g, S, EN); } else
#endif
      pg8::gemm_phase<EpiP1, false, false, pg8::P1Order>(lds, g, S, E);
    }
    SEAM(pb + 0);
    if (IN(pb + 1)) REPEAT(1) {
      for (int j = G - 1 - c; j < pg8::P1_DEFER; j += G) { pg8::OneUnit S1; S1.u = pg8::p1_deferred_unit(j);
        pg8::gemm_phase<EpiP1, false, false, pg8::OneUnit>(lds, p1_desc(ws, l), S1, p1_epi(p, l, lds)); }
      attn::attn_phase(p, l + 2 * rep_, lds); }
    SEAM(pb + 1);
    if (IN(pb + 2)) REPEAT(2) {
      pg8::GemmDesc g{(const char*)(ws + WS_O), (const char*)(ws + WS_WBR) + (size_t)l * D * OW * 2, OW, OW, OW / 64, (size_t)256 * OW * 2, (size_t)128 * OW * 2};
      pg8::StaticOrder S; S.init(TOKP / 256, D / 256, G, c);
      EpiP3 E{(const bf16_t*)(ws + WS_GATE), (bf16_t*)(ws + WS_H)};
      pg8::gemm_phase<EpiP3>(lds, g, S, E);
      pg8::GemmDesc gh = g; gh.b_tile = (size_t)128 * OW * 2;
      pg8::StaticOrder S2; S2.init(TOKS / 128, D / 128, G, c, TOKP / 128);
      EpiP3T<true, true> E2{(const bf16_t*)(ws + WS_GATE), (bf16_t*)(ws + WS_H)};
      pg8::gemm_phase<EpiP3T<true, true>, true, true>(lds, gh, S2, E2);
      if (rep_ == 0) { const int nidle = G - S2.nwg, f0 = l == 0 ? SL_03 : SL_13, n0 = l == 0 ? SN_03 : SN_13; if (nidle <= 0) late_transposes(p, lds, f0, n0, c, G); else if (c >= S2.nwg) late_transposes(p, lds, f0, n0, c - S2.nwg, nidle); }
    }
    SEAM(pb + 2);
    if (IN(pb + 3)) {
      pg8::GemmDesc g{(const char*)(ws + WS_H), (const char*)(ws + WS_WOUT) + (size_t)l * D * D * 2, D, D, D / 64, (size_t)256 * D * 2, (size_t)128 * D * 2};
      pg8::StaticOrder S; S.init(TOKP / 256, D / 256, G, c);
      EpiRes E{(float*)(ws + WS_X32), (bf16_t*)(ws + WS_XB), (float*)(ws + WS_SS), lds, l == 0 ? p.x_prompt : nullptr, l == 0 ? p.x_sample : nullptr};
      pg8::gemm_phase<EpiRes>(lds, g, S, E);
      pg8::GemmDesc gh = g; gh.b_tile = (size_t)128 * D * 2;
      pg8::StaticOrder S2; S2.init(TOKS / 128, D / 128, G, c, TOKP / 128);
      EpiResT<true, true> E2{(float*)(ws + WS_X32), (bf16_t*)(ws + WS_XB), (float*)(ws + WS_SS), lds, l == 0 ? p.x_prompt : nullptr, l == 0 ? p.x_sample : nullptr};
      pg8::gemm_phase<EpiResT<true, true>, true, true>(lds, gh, S2, E2);
      { const int nidle = G - S2.nwg, f0 = SL_04, n0 = l == 0 ? SN_04 : 0; if (nidle <= 0) late_transposes(p, lds, f0, n0, c, G); else if (c >= S2.nwg) late_transposes(p, lds, f0, n0, c - S2.nwg, nidle); }
    }
    SEAM(pb + 3);
    if (IN(pb + 4)) REPEAT(4) {
      pg8::GemmDesc g{(const char*)(ws + WS_XB), (const char*)(ws + WS_WUP) + (size_t)l * 2 * DFF * D * 2, D, D, D / 64, (size_t)128 * D * 2, (size_t)DFF * D * 2};
      pg8::StaticOrder S; S.init(TOKP / 256, DFF / 128, G, c);
      EpiP5F E{(const float*)(ws + WS_SS), (bf16_t*)(ws + WS_HF), p.out, p.conv_w + (size_t)l * 3 * DFF, p.conv_b + (size_t)l * DFF, p.state_conv + (size_t)l * DB * 2 * DFF, (float*)(ws + WS_SIDE), lds, l};
      pg8::gemm_phase<EpiP5F>(lds, g, S, E);
      pg8::StaticOrder S2; S2.init(TOKS / 128, DFF / 128, G, (c + G / 2) % G, TOKP / 128);
      EpiP5FT<true> E2{(const float*)(ws + WS_SS), (bf16_t*)(ws + WS_HF), p.out, p.conv_w + (size_t)l * 3 * DFF, p.conv_b + (size_t)l * DFF, p.state_conv + (size_t)l * DB * 2 * DFF, (float*)(ws + WS_SIDE), lds, l};
      pg8::gemm_phase<EpiP5FT<true>, false, true>(lds, g, S2, E2);
      if (rep_ == 0) {
        const int nfull = S.nwg % G, f0 = l == 0 ? SL_05 : SL_15, n0 = l == 0 ? SN_05 : SN_15;
        if (nfull <= 0 || nfull >= G) late_transposes(p, lds, f0, n0, c, G); else if (c >= nfull) late_transposes(p, lds, f0, n0, c - nfull, G - nfull); }
    }
    SEAM(pb + 4);
    if (IN(pb + 5)) {
      pg8::GemmDesc g{(const char*)(ws + WS_HF), (const char*)(ws + WS_WDN) + (size_t)l * D * DFF * 2, DFF, DFF, DFF / 64, (size_t)256 * DFF * 2, (size_t)128 * DFF * 2};
      pg8::StaticOrder S; S.init(TOKP / 256, D / 256, G, c);
      { pg8::Unit uu; for (int i = 0; S.next(i, uu); ++i) if (uu.pm < 64 && (uu.pm & 15) != 0) p6_fixup_panel(uu.pm, (const float*)(ws + WS_SIDE), p.conv_w + (size_t)l * 3 * DFF, (bf16_t*)(ws + WS_HF));
        asm volatile("s_waitcnt vmcnt(0)" ::: "memory"); __syncthreads(); }
      EpiRes E{(float*)(ws + WS_X32), (bf16_t*)(ws + WS_XB), (float*)(ws + WS_SS), lds, nullptr, nullptr};
      pg8::gemm_phase<EpiRes>(lds, g, S, E);
      pg8::GemmDesc gh = g; gh.b_tile = (size_t)128 * DFF * 2;
      pg8::StaticOrder S2; S2.init(TOKS / 128, D / 128, G, c, TOKP / 128);
      EpiResT<true, true> E2{(float*)(ws + WS_X32), (bf16_t*)(ws + WS_XB), (float*)(ws + WS_SS), lds, nullptr, nullptr};
      pg8::gemm_phase<EpiResT<true, true>, true, true>(lds, gh, S2, E2);
      if (l == 0) { const int nidle = G - S2.nwg; if (nidle <= 0) late_transposes(p, lds, SL_06, SN_06, c, G); else if (c >= S2.nwg) late_transposes(p, lds, SL_06, SN_06, c - S2.nwg, nidle); }
    }
    SEAM(pb + 5);
  }
  if (IN(NPHASE - 1)) { pfinal_norm(p_k); }
#undef IN
#undef SEAM
}

#ifndef MK_ONE_LAUNCH
#define MK_ONE_LAUNCH 1
#endif
extern "C" void kernel_launch(void* const* d_in, const int* in_sizes, int n_in, void* d_out, int out_size, void* d_ws, size_t ws_size, hipStream_t stream) {
  static int grid_blocks = 0;
  if (grid_blocks == 0) {
    int dev = 0, cus = 0, per_cu = 0;
    (void)hipGetDevice(&dev);
    (void)hipDeviceGetAttribute(&cus, hipDeviceAttributeMultiprocessorCount, dev);
    (void)hipFuncSetAttribute((const void*)fwd_megakernel, hipFuncAttributeMaxDynamicSharedMemorySize, LDS_BYTES);
    (void)hipOccupancyMaxActiveBlocksPerMultiprocessor(&per_cu, (const void*)fwd_megakernel, NTHREADS, LDS_BYTES);
    if (per_cu < 1) { fprintf(stderr, "kernel_launch: occupancy query says %d blocks/CU\n", per_cu); per_cu = 1; }
    grid_blocks = cus * per_cu;
    if (n_in != 24 || (size_t)out_size != O_END || ws_size < WS_END) { fprintf(stderr, "kernel_launch: unexpected problem (n_in %d out %d ws %zu, need %zu)\n", n_in, out_size, ws_size, (size_t)WS_END); grid_blocks = -1; }
  }
  if (grid_blocks < 0) return;
  Params p{};
  const float** f = (const float**)&p;
  for (int i = 0; i < 24; ++i) f[i] = (const float*)d_in[i];
  p.out = (float*)d_out; p.ws = (unsigned char*)d_ws;
#if MK_ONE_LAUNCH
  p.ph_lo = 0; p.ph_hi = NPHASE;
  (void)hipMemsetAsync((unsigned char*)d_ws + WS_CTL + (size_t)CW_BAR * 4, 0, (size_t)XCD_BAR_WORDS * 4, stream);
  { void* args[] = {&p};
    hipError_t e = hipLaunchCooperativeKernel((void*)fwd_megakernel, dim3(grid_blocks), dim3(NTHREADS), args, LDS_BYTES, stream);
    if (e != hipSuccess) fprintf(stderr, "cooperative launch failed: %s (grid %d)\n", hipGetErrorString(e), grid_blocks); }
#else
  for (int k = 0; k < NPHASE; ++k) { p.ph_lo = k; p.ph_hi = k + 1; void* args[] = {&p};
    hipError_t e = hipLaunchCooperativeKernel((void*)fwd_megakernel, dim3(grid_blocks), dim3(NTHREADS), args, LDS_BYTES, stream);
    if (e != hipSuccess) { fprintf(stderr, "launch %d failed: %s (grid %d)\n", k, hipGetErrorString(e), grid_blocks); break; } }
#endif
}
```

```cpp
#include <hip/hip_runtime.h>
#include <hip/hip_cooperative_groups.h>
#include <cstdio>
#include <cstdint>
namespace cg = cooperative_groups;

#define DI __device__ __forceinline__
#define LAS __attribute__((address_space(3)))
typedef unsigned short bf16_t;
typedef short bf16x8 __attribute__((ext_vector_type(8)));
typedef short s16x4 __attribute__((ext_vector_type(4)));
typedef float f32x2 __attribute__((ext_vector_type(2)));
typedef float f32x4 __attribute__((ext_vector_type(4)));
typedef float f32x8 __attribute__((ext_vector_type(8)));
typedef float f32x16 __attribute__((ext_vector_type(16)));
typedef unsigned u32x2 __attribute__((ext_vector_type(2)));
typedef unsigned u32x4 __attribute__((ext_vector_type(4)));
typedef __bf16 bfv4 __attribute__((ext_vector_type(4)));
typedef __bf16 bfv8 __attribute__((ext_vector_type(8)));

constexpr int D = 1024, SEQ = 4096, NB = 4, TOKP = NB * SEQ, DB = 32, DSEQ = 64, TOKS = DB * DSEQ, TOK = TOKP + TOKS;
constexpr int PAST = 1024, ALEN = 512, INC = 7680, DFF = 2816, NLAYER = 2;
constexpr int QKVW = 4608, GATEW = 3072, OW = 1536;
constexpr float EPS = 1e-6f, LOG2E = 1.4426950408889634f;

constexpr size_t O_YP = 0, O_YS = O_YP + (size_t)TOKP * D, O_PAK = O_YS + (size_t)TOKS * D, O_PAV = O_PAK + (size_t)2 * 4 * 512 * 512,
                 O_PBK = O_PAV + (size_t)2 * 4 * 512 * 512, O_PBV = O_PBK + (size_t)2 * TOKP * 512, O_PCK = O_PBV + (size_t)2 * TOKP * 512,
                 O_PCV = O_PCK + (size_t)2 * TOKP * 512, O_PCONV = O_PCV + (size_t)2 * TOKP * 512, O_SAK = O_PCONV + (size_t)2 * 4 * 2 * DFF,
                 O_SAV = O_SAK + (size_t)2 * DB * 512 * 512, O_SBK = O_SAV + (size_t)2 * DB * 512 * 512, O_SBV = O_SBK + (size_t)2 * TOKS * 512,
                 O_SCK = O_SBV + (size_t)2 * TOKS * 512, O_SCV = O_SCK + (size_t)2 * TOKS * 512, O_SCONV = O_SCV + (size_t)2 * TOKS * 512,
                 O_END = O_SCONV + (size_t)2 * DB * 2 * DFF;

constexpr size_t MiB = 1u << 20;
constexpr size_t WS_CTL = 0;
constexpr size_t WS_WIN = 1 * MiB;
constexpr size_t WS_WBR = WS_WIN + (size_t)2 * INC * D * 2;
constexpr size_t WS_WOUT = WS_WBR + (size_t)2 * D * OW * 2;
constexpr size_t WS_WUP = WS_WOUT + (size_t)2 * D * D * 2;
constexpr size_t WS_WDN = WS_WUP + (size_t)2 * 2 * DFF * D * 2;
constexpr size_t WS_XB = WS_WDN + (size_t)2 * D * DFF * 2;
constexpr size_t WS_X32 = WS_XB + (size_t)TOK * D * 2;
constexpr size_t WS_SS = WS_X32 + (size_t)TOK * D * 4;
constexpr size_t WS_SIDE = WS_SS + (size_t)TOK * 8 * 4;
constexpr size_t WS_O = WS_SIDE + (size_t)3 * 72 * 2 * DFF * 4;
constexpr size_t WS_H = WS_O + (size_t)TOK * OW * 2;
constexpr size_t WS_HF = WS_H + (size_t)TOK * D * 2;
constexpr size_t WS_QKV = WS_HF + (size_t)TOK * DFF * 2;
constexpr size_t WS_GATE = WS_QKV + (size_t)TOK * QKVW * 2;
constexpr size_t WS_END = WS_GATE + (size_t)TOK * GATEW * 2;
constexpr int CW_QUEUE = 64;
constexpr int CW_LAM = 1024;
constexpr int CW_T5 = 2048;
constexpr int CW_BAR = 8192;

constexpr int LDS_BYTES = 160 * 1024;
constexpr int NTHREADS = 512;

DI u32x4 pack8(f32x4 a, f32x4 b) { f32x8 v = {a[0], a[1], a[2], a[3], b[0], b[1], b[2], b[3]}; return __builtin_bit_cast(u32x4, __builtin_convertvector(v, bfv8)); }
DI u32x2 pack4(f32x4 a) { return __builtin_bit_cast(u32x2, __builtin_convertvector(a, bfv4)); }
DI float bflo(unsigned w) { return __uint_as_float(w << 16); }
DI float bfhi(unsigned w) { return __uint_as_float(w & 0xffff0000u); }
DI float wave_sum(float v) {
#pragma unroll
  for (int o = 1; o < 64; o <<= 1) v += __shfl_xor(v, o);
  return v;
}
DI float fast_rcp(float x) { return __builtin_amdgcn_rcpf(x); }
DI float fast_exp2(float x) { return __builtin_amdgcn_exp2f(x); }
DI float fast_log2(float x) { return __builtin_amdgcn_logf(x); }

DI LAS unsigned char* opaque_lds(LAS unsigned char* p) { unsigned v = (unsigned)(__UINTPTR_TYPE__)p; asm volatile("" : "+s"(v)); return (LAS unsigned char*)(__UINTPTR_TYPE__)v; }

struct Params {
  const float* x_prompt; const float* x_sample;
  const float* cache_a_k; const float* cache_a_v; const float* cache_b_k; const float* cache_b_v; const float* cache_c_k; const float* cache_c_v;
  const float* state_conv; const float* norm_mix; const float* w_in; const float* b_gate; const float* a_rel_bias; const float* t5_bias;
  const float* c_lambda; const float* c_subln; const float* w_branch; const float* w_out; const float* norm_ffn; const float* w_up;
  const float* conv_w; const float* conv_b; const float* w_down; const float* norm_final;
  float* out; unsigned char* ws;
  int ph_lo, ph_hi;
};

struct TItem { const float* W; const float* ks; bf16_t* WT; int N, dst_ld, dst_col, item; };
DI void p0_tload(const TItem& d, float (&wv)[32], int lane) {
  const int nblk = d.N / 32, kb = d.item / nblk, nb = d.item % nblk, k0 = 64 * kb, n0 = 32 * nb;
#pragma unroll
  for (int i = 0; i < 32; ++i) wv[i] = __builtin_nontemporal_load(&d.W[(size_t)(k0 + 2 * i + (lane >> 5)) * d.N + n0 + (lane & 31)]);
}
DI void p0_tfinish(const TItem& d, const float (&wv)[32], LAS float* scr, int lane) {
  const int nblk = d.N / 32, kb = d.item / nblk, nb = d.item % nblk, k0 = 64 * kb, n0 = 32 * nb;
#pragma unroll
  for (int i = 0; i < 32; ++i) { const int kk = 2 * i + (lane >> 5); float v = wv[i]; if (d.ks) v *= d.ks[k0 + kk]; scr[kk * 33 + (lane & 31)] = v; }
  asm volatile("s_waitcnt lgkmcnt(0)" ::: "memory");
  const int c = lane & 7;
#pragma unroll
  for (int j = 0; j < 4; ++j) { const int n = (lane >> 3) + 8 * j; const LAS float* s = scr + (8 * c) * 33 + n;
    f32x4 a = {s[0 * 33], s[1 * 33], s[2 * 33], s[3 * 33]}, b = {s[4 * 33], s[5 * 33], s[6 * 33], s[7 * 33]};
    *(u32x4*)(d.WT + (size_t)(n0 + n) * d.dst_ld + d.dst_col + k0 + 8 * c) = pack8(a, b); }
  asm volatile("s_waitcnt lgkmcnt(0)" ::: "memory");
}

DI int t5_bucket_of(int rel) {
  const int n = rel < 0 ? -rel : rel; int f;
  if (n < 8) f = n; else if (n < 12) f = 8; else if (n < 16) f = 9; else if (n < 23) f = 10; else if (n < 32) f = 11; else if (n < 46) f = 12; else if (n < 64) f = 13; else if (n < 91) f = 14; else f = 15;
  return (rel > 0 ? 16 : 0) + f;
}

constexpr int I_IN = (D / 64) * (INC / 32), I_BR = (512 / 64) * (D / 32), I_OUT = (D / 64) * (D / 32), I_UP = (D / 64) * (2 * DFF / 32), I_DN = (DFF / 64) * (D / 32);
constexpr int PER_LAYER = I_IN + 3 * I_BR + I_OUT + I_UP + I_DN;
constexpr int P0_ITEMS = I_IN + 3 * I_BR;
constexpr int SL_03 = P0_ITEMS, SN_03 = I_OUT + I_UP;
constexpr int SL_05 = PER_LAYER - I_DN, SN_05 = I_DN;
constexpr int SL_04 = PER_LAYER, SN_04 = 2048;
constexpr int SL_06 = SL_04 + SN_04, SN_06 = 4096;
constexpr int SL_13 = SL_06 + SN_06, SN_13 = 2 * PER_LAYER - I_DN - SL_13;
constexpr int SL_15 = 2 * PER_LAYER - I_DN, SN_15 = I_DN;
static_assert(NLAYER == 2 && SL_06 + SN_06 >= PER_LAYER + I_IN + 3 * I_BR + I_OUT && SN_13 >= 0 && SN_13 <= 4096, "late transpose slots");
DI TItem p0_titem(const Params& p, int it) {
  const int l = it / PER_LAYER; int r = it % PER_LAYER;
  if (r < I_IN) return TItem{p.w_in + (size_t)l * D * INC, p.norm_mix + l * D, (bf16_t*)(p.ws + WS_WIN) + (size_t)l * INC * D, INC, D, 0, r};
  r -= I_IN;
  if (r < 3 * I_BR) { const int n = r / I_BR; return TItem{p.w_branch + ((size_t)l * 3 + n) * 512 * D, nullptr, (bf16_t*)(p.ws + WS_WBR) + (size_t)l * D * OW, D, OW, 512 * n, r % I_BR}; }
  r -= 3 * I_BR;
  if (r < I_OUT) return TItem{p.w_out + (size_t)l * D * D, nullptr, (bf16_t*)(p.ws + WS_WOUT) + (size_t)l * D * D, D, D, 0, r};
  r -= I_OUT;
  if (r < I_UP) return TItem{p.w_up + (size_t)l * D * 2 * DFF, p.norm_ffn + l * D, (bf16_t*)(p.ws + WS_WUP) + (size_t)l * 2 * DFF * D, 2 * DFF, D, 0, r};
  r -= I_UP;
  return TItem{p.w_down + (size_t)l * DFF * D, nullptr, (bf16_t*)(p.ws + WS_WDN) + (size_t)l * D * DFF, D, DFF, 0, r};
}
DI void p0_weight_item(const Params& p, int it, LAS float* scr, int lane) { const TItem d = p0_titem(p, it); float wv[32]; p0_tload(d, wv, lane); p0_tfinish(d, wv, scr, lane); }
DI void late_transposes(const Params& p, LAS unsigned char* lds_in, int first, int count, int w_block, int n_blocks) {
  LAS unsigned char* lds = opaque_lds(lds_in);
  int tid_ = threadIdx.x; asm volatile("" : "+v"(tid_));
  const int lane = tid_ & 63, wave = tid_ >> 6;
  LAS float* scr = (LAS float*)(lds + wave * 8448);
  const int nw = n_blocks * 8;
  for (int j = w_block * 8 + wave; j < count; j += 2 * nw) {
    const bool two = j + nw < count;
    const TItem a = p0_titem(p, first + j), b = p0_titem(p, first + (two ? j + nw : j));
    float wa[32], wb[32];
    p0_tload(a, wa, lane); p0_tload(b, wb, lane);
    p0_tfinish(a, wa, scr, lane);
    if (two) p0_tfinish(b, wb, scr, lane);
  }
}
DI void p0_prologue(const Params& p, LAS unsigned char* lds_in) {
  LAS unsigned char* lds = opaque_lds(lds_in);
  int tid_ = threadIdx.x; asm volatile("" : "+v"(tid_));
  const int tid = tid_, lane = tid & 63, wave = tid >> 6;
  const int gw = blockIdx.x * 8 + wave, NGW = gridDim.x * 8;
  unsigned* ctl = (unsigned*)(p.ws + WS_CTL);
  if (blockIdx.x == 0) {
    if (tid < 4) ctl[CW_QUEUE + 64 * tid] = 0u;
    if (wave == 1) {
      for (int l = 0; l < NLAYER; ++l) { const float* lp = p.c_lambda + l * 256; const float a = wave_sum(lp[lane] * lp[64 + lane]), b = wave_sum(lp[128 + lane] * lp[192 + lane]);
        const float lam_init = 0.8f - 0.6f * expf(-0.3f * (float)l);
        if (lane == 0) ((float*)ctl)[CW_LAM + l] = expf(a) - expf(b) + lam_init; }
    }
    for (int i = tid; i < 4 * 192; i += NTHREADS) { const int h = i / 192, idx = i % 192; int rel = idx - 127; if (rel > 63) rel = 63;
      ((float*)ctl)[CW_T5 + i] = p.t5_bias[t5_bucket_of(rel) * 4 + h] - p.t5_bias[15 * 4 + h]; }
  }
  LAS float* scr = (LAS float*)(lds + wave * 8448);
  for (int j = gw; j < P0_ITEMS; j += 2 * NGW) {
    const bool two = j + NGW < P0_ITEMS;
    const TItem a = p0_titem(p, j), b = p0_titem(p, two ? j + NGW : j);
    float wa[32], wb[32];
    p0_tload(a, wa, lane); p0_tload(b, wb, lane);
    p0_tfinish(a, wa, scr, lane);
    if (two) p0_tfinish(b, wb, scr, lane);
  }
  bf16_t* XB = (bf16_t*)(p.ws + WS_XB); float* SS = (float*)(p.ws + WS_SS);
#pragma unroll 3
  for (int m = gw; m < TOK; m += NGW) {
    const float* src = m < TOKP ? p.x_prompt + (size_t)m * D : p.x_sample + (size_t)(m - TOKP) * D;
    float s = 0.f;
#pragma unroll
    for (int j = 0; j < 4; ++j) { const f32x4 v = __builtin_nontemporal_load(&((const f32x4*)src)[lane + 64 * j]); ((u32x2*)(XB + (size_t)m * D))[lane + 64 * j] = pack4(v);
      s += (v[0] * v[0] + v[1] * v[1]) + (v[2] * v[2] + v[3] * v[3]); }
    s = wave_sum(s);
    if (lane < 8) SS[(size_t)m * 8 + lane] = lane == 0 ? s : 0.f;
  }
}

namespace pg8 {
constexpr int BM = 256, BK = 64, HALF = 128, HTB = HALF * BK * 2, STAGE_BYTES = 8 * HTB, NXCD = 8, WGM = 8;
DI int lds_byte(int r, int c) { const int st = (r >> 4) * 2 + (c >> 5), rr = r & 15, cc = c & 31, ob = rr * 64 + cc * 2; return st * 1024 + (ob ^ (((ob >> 9) & 1) << 5)); }
DI void stage_rc(int b, int& R, int& C) { const int st = b / 1024, sb = b % 1024, swz = sb ^ (((sb >> 9) & 1) << 5); R = (st >> 1) * 16 + swz / 64; C = (st & 1) * 32 + (swz % 64) / 2; }
DI int perm32(int rho) { const int n = rho >> 4, i = rho & 15; return 8 * (i >> 2) + 4 * n + (i & 3); }
struct Unit { int pm, pn; };
struct GemmDesc { const char* A; const char* B; int lda, ldb, nt; size_t b_tile, b_half; };
struct StaticOrder {
  int nM, nN, nwg, G, c, pm0;
  DI void init(int nM_, int nN_, int G_, int c_, int pm0_ = 0) { nM = nM_; nN = nN_; nwg = nM * nN; G = G_; c = c_; pm0 = pm0_; }
  DI bool next(int i, Unit& u) const {
    const long L = (long)i * G + c; if (L >= nwg) return false;
    int wgid = (int)L; { const int q = nwg / NXCD, r = nwg % NXCD, xcd = wgid % NXCD, off = wgid / NXCD; wgid = (xcd < r ? xcd * (q + 1) : r * (q + 1) + (xcd - r) * q) + off; }
    const int nig = WGM * nN, gid = wgid / nig, fm = gid * WGM, gsz = (nM - fm) < WGM ? (nM - fm) : WGM;
    u.pm = pm0 + fm + ((wgid % nig) % gsz); u.pn = (wgid % nig) / gsz; return true;
  }
};
constexpr int P1_NN = 28, P1_EXTRA = 32, P1_DEFER = 72 + (72 - P1_EXTRA);
struct P1Order {
  StaticOrder R1;
  DI bool next(int i, Unit& u) const {
    if (R1.next(i, u)) return true;
    const long L = (long)i * R1.G + R1.c - R1.nwg; if (L >= P1_EXTRA) return false;
    u.pm = (int)L; u.pn = P1_NN; return true;
  }
};
DI Unit p1_deferred_unit(int j) { Unit u; if (j < 72) { u.pm = j; u.pn = P1_NN + 1; } else { u.pm = P1_EXTRA + (j - 72); u.pn = P1_NN; } return u; }
struct OneUnit { Unit u; DI bool next(int i, Unit& o) const { if (i != 0) return false; o = u; return true; } };
template <class Epi, bool HALFN = false, bool HALFM = false, class Sched = StaticOrder>
DI void gemm_phase(LAS unsigned char* lds_in, const GemmDesc g, const Sched& S, const Epi& E) {
  LAS unsigned char* lds = opaque_lds(lds_in);
  int tid_ = threadIdx.x; asm volatile("" : "+v"(tid_));
  const int tid = tid_, wid = __builtin_amdgcn_readfirstlane(tid >> 6), lane = tid & 63, wr = wid >> 2, wc = wid & 3, fr = lane & 15, fq = lane >> 4;
  const int nt = g.nt;
  unsigned voffA[2], voffB[2];
#pragma unroll
  for (int i = 0; i < 2; ++i) { int R, C; stage_rc(tid * 16 + i * 8192, R, C); const int Rb = Epi::PERM ? ((R & ~31) + perm32(R & 31)) : R;
    voffA[i] = (unsigned)(R * g.lda + C) * 2u; voffB[i] = (unsigned)(Rb * g.ldb + C) * 2u; }
  const size_t kstep = (size_t)(BK * 2);
  const size_t hsA = (size_t)HALF * g.lda * 2, tsA = HALFM ? hsA : 2 * hsA, hsB = g.b_half, tsB = g.b_tile;
  const unsigned ldsw = (unsigned)wid * 1024u;
  const int aoff = lds_byte(wr * 64 + fr, fq * 8), boff = lds_byte(wc * 32 + fr, fq * 8);
#define PG8_SA(b, h) (((b) * 2 + (h)) * HTB)
#define PG8_SB(b, h) ((4 + (b) * 2 + (h)) * HTB)
#define PG8_STAGE(bufoff, gbase, voff) do { _Pragma("unroll") for (int _i = 0; _i < 2; ++_i) \
    __builtin_amdgcn_global_load_lds((const unsigned*)((const char*)(gbase) + (voff)[_i]), (LAS unsigned*)(lds + (bufoff) + ldsw + _i * 8192), 16, 0, 0); } while (0)
#define PG8_LDA(dst, b, h) do { _Pragma("unroll") for (int m = 0; m < 4; ++m) _Pragma("unroll") for (int k = 0; k < 2; ++k) dst[m][k] = *(const LAS bf16x8*)(lds + PG8_SA(b, h) + aoff + m * 2048 + k * 1024); } while (0)
#define PG8_LDB(dst, b, h) do { _Pragma("unroll") for (int n = 0; n < 2; ++n) _Pragma("unroll") for (int k = 0; k < 2; ++k) dst[n][k] = *(const LAS bf16x8*)(lds + PG8_SB(b, h) + boff + n * 2048 + k * 1024); } while (0)
#define PG8_MMA(ai, bj, At, Bt) do { __builtin_amdgcn_s_setprio(1); _Pragma("unroll") for (int m = 0; m < 4; ++m) _Pragma("unroll") for (int n = 0; n < 2; ++n) _Pragma("unroll") for (int k = 0; k < 2; ++k) \
    acc[ai][bj][m][n] = __builtin_amdgcn_mfma_f32_16x16x32_bf16(Bt[n][k], At[m][k], acc[ai][bj][m][n], 0, 0, 0); __builtin_amdgcn_s_setprio(0); } while (0)
#define PG8_WAIT_V(n) asm volatile("s_waitcnt vmcnt(" #n ")" ::: "memory")
#define PG8_WAIT_LOOP do { if constexpr (HALFM && HALFN) PG8_WAIT_V(4); else if constexpr (HALFM || HALFN) PG8_WAIT_V(6); else PG8_WAIT_V(8); } while (0)
#define PG8_WAIT_L(n) asm volatile("s_waitcnt lgkmcnt(" #n ")" ::: "memory")
#define PG8_BAR __builtin_amdgcn_s_barrier()
#define PG8_SCHED __builtin_amdgcn_sched_barrier(0)
  Unit cur, nxt; int ui = 0;
  if (!S.next(0, cur)) return;
  f32x4 acc[2][2][4][2];
#pragma unroll
  for (int a = 0; a < 2; ++a)
#pragma unroll
    for (int b = 0; b < 2; ++b)
#pragma unroll
      for (int m = 0; m < 4; ++m)
#pragma unroll
        for (int n = 0; n < 2; ++n) acc[a][b][m][n] = (f32x4){0.f, 0.f, 0.f, 0.f};
  bf16x8 At[4][2], B0[2][2], B1[2][2];
  const char* cA = g.A + (size_t)cur.pm * tsA; const char* cB = g.B + (size_t)cur.pn * tsB;
  f32x4 ssv = {0.f, 0.f, 0.f, 0.f};
  if constexpr (Epi::HAS_RS) ssv = E.prefetch(cur, tid);
  PG8_STAGE(PG8_SB(0, 0), cB, voffB); if constexpr (!HALFN) PG8_STAGE(PG8_SB(0, 1), cB + hsB, voffB); PG8_STAGE(PG8_SA(0, 0), cA, voffA); if constexpr (!HALFM) PG8_STAGE(PG8_SA(0, 1), cA + hsA, voffA);
  if (wr == 1) PG8_BAR;
  if constexpr (HALFM) PG8_WAIT_V(0); else PG8_WAIT_V(2);
  PG8_BAR;
  PG8_STAGE(PG8_SB(1, 0), cB + kstep, voffB); PG8_STAGE(PG8_SA(1, 0), cA + kstep, voffA); if constexpr (!HALFN) PG8_STAGE(PG8_SB(1, 1), cB + hsB + kstep, voffB);
  if constexpr (HALFN) PG8_WAIT_V(4); else PG8_WAIT_V(6);
  PG8_BAR;
  for (;;) {
    const bool has_next = S.next(ui + 1, nxt);
    const char* nA = has_next ? g.A + (size_t)nxt.pm * tsA : cA; const char* nB = has_next ? g.B + (size_t)nxt.pn * tsB : cB;
    for (int t = 0; t < nt; t += 2) {
      const bool last = (t == nt - 2);
      const char* a1 = cA + (size_t)(t + 1) * kstep;
      const char* a2 = last ? nA : cA + (size_t)(t + 2) * kstep; const char* b2 = last ? nB : cB + (size_t)(t + 2) * kstep;
      const char* a3 = a2 + kstep; const char* b3 = b2 + kstep;
      if constexpr (Epi::HAS_MID) { if (t == 8 || t == 16) E.mid(acc, cur, t, wr, wc, fr, fq); }
      PG8_LDB(B0, 0, 0); if constexpr (!HALFN) PG8_LDB(B1, 0, 1); PG8_SCHED; PG8_LDA(At, 0, 0); if constexpr (!HALFM) PG8_STAGE(PG8_SA(1, 1), a1 + hsA, voffA);
      PG8_WAIT_LOOP; PG8_WAIT_L(0); PG8_BAR; PG8_MMA(0, 0, At, B0); if constexpr (!HALFN) PG8_MMA(0, 1, At, B1); PG8_BAR; PG8_SCHED;
      if constexpr (!HALFM) PG8_LDA(At, 0, 1); PG8_STAGE(PG8_SB(0, 0), b2, voffB); if constexpr (!HALFN) PG8_STAGE(PG8_SB(0, 1), b2 + hsB, voffB); PG8_STAGE(PG8_SA(0, 0), a2, voffA);
      PG8_WAIT_LOOP; PG8_WAIT_L(0); PG8_BAR; if constexpr (!HALFM) { PG8_MMA(1, 0, At, B0); if constexpr (!HALFN) PG8_MMA(1, 1, At, B1); } PG8_BAR; PG8_SCHED;
      PG8_LDB(B0, 1, 0); if constexpr (!HALFN) PG8_LDB(B1, 1, 1); PG8_SCHED; PG8_LDA(At, 1, 0); if constexpr (!HALFM) PG8_STAGE(PG8_SA(0, 1), a2 + hsA, voffA);
      PG8_WAIT_LOOP; PG8_WAIT_L(0); PG8_BAR; PG8_MMA(0, 0, At, B0); if constexpr (!HALFN) PG8_MMA(0, 1, At, B1); PG8_BAR; PG8_SCHED;
      if constexpr (!HALFM) PG8_LDA(At, 1, 1); PG8_STAGE(PG8_SB(1, 0), b3, voffB); if constexpr (!HALFN) PG8_STAGE(PG8_SB(1, 1), b3 + hsB, voffB); PG8_STAGE(PG8_SA(1, 0), a3, voffA);
      PG8_WAIT_LOOP; PG8_WAIT_L(0); PG8_BAR; if constexpr (!HALFM) { PG8_MMA(1, 0, At, B0); if constexpr (!HALFN) PG8_MMA(1, 1, At, B1); } PG8_BAR; PG8_SCHED;
    }
    if (wr == 0) PG8_BAR;
    if constexpr (Epi::HAS_RS) { E.stash(ssv, cur, tid, lds); PG8_WAIT_L(0); PG8_BAR; asm volatile("" ::: "memory"); }
    E(acc, cur, wr, wc, fr, fq);
    if (!has_next) break;
#pragma unroll
    for (int a = 0; a < 2; ++a)
#pragma unroll
      for (int b = 0; b < 2; ++b)
#pragma unroll
        for (int m = 0; m < 4; ++m)
#pragma unroll
          for (int n = 0; n < 2; ++n) acc[a][b][m][n] = (f32x4){0.f, 0.f, 0.f, 0.f};
    cur = nxt; cA = nA; cB = nB; ++ui;
    if constexpr (Epi::HAS_RS) ssv = E.prefetch(cur, tid);
    if (wr == 1) PG8_BAR;
  }
  PG8_WAIT_V(0);
  PG8_BAR;
#undef PG8_SA
#undef PG8_SB
#undef PG8_STAGE
#undef PG8_LDA
#undef PG8_LDB
#undef PG8_MMA
#undef PG8_WAIT_V
#undef PG8_WAIT_LOOP
#undef PG8_WAIT_L
#undef PG8_BAR
#undef PG8_SCHED
}
}
using pg8::Unit;
DI f32x4 ss_load(const float* SS, int r) { const f32x4* q = (const f32x4*)(SS + (size_t)r * 8); return q[0] + q[1]; }
DI float ss_to_rs(const f32x4& a) { return __builtin_amdgcn_rsqf(((a[0] + a[1]) + (a[2] + a[3])) * (1.0f / D) + EPS); }
DI float row_rs(const float* SS, int r) { return ss_to_rs(ss_load(SS, r)); }
DI float sigmoidf_(float x) { return fast_rcp(1.0f + fast_exp2(-x * LOG2E)); }

struct EpiP1 {
  static constexpr bool PERM = true, HAS_MID = false, HAS_RS = true;
  const float* SS; bf16_t* QKV; bf16_t* GATE; const float* bgate; float* out; int layer; int probe_flags; LAS unsigned char* lds;
  DI void mid(f32x4 (&)[2][2][4][2], const Unit&, int, int, int, int, int) const {}
  DI f32x4 prefetch(const Unit& u, int tid) const {
    f32x4 v = {0.f, 0.f, 0.f, 0.f};
    if (tid < 256) v = ss_load(SS, u.pm * 256 + tid);
    return v;
  }
  DI void stash(const f32x4& v, const Unit& u, int tid, LAS unsigned char* l) const {
    if (tid < 256) *(LAS float*)(l + 131072 + 12288 + tid * 4) = ss_to_rs(v);
  }
  DI void operator()(f32x4 (&acc)[2][2][4][2], const Unit& u, int wr, int wc, int fr, int fq) const {
    const int pn = u.pn, rin0 = wr * 64 + fr, row0 = u.pm * 256 + rin0;
    float rs[2][4];
#pragma unroll
    for (int ai = 0; ai < 2; ++ai)
#pragma unroll
      for (int m = 0; m < 4; ++m) rs[ai][m] = *(const LAS float*)(lds + 131072 + 12288 + (rin0 + ai * 128 + m * 16) * 4);
    if (pn < 18) {
      const int colq = pn * 256 + wc * 32 + 8 * fq;
#pragma unroll
      for (int ai = 0; ai < 2; ++ai)
#pragma unroll
        for (int m = 0; m < 4; ++m) {
          const int rin = rin0 + ai * 128 + m * 16, r = u.pm * 256 + rin; const float s = rs[ai][m];
          bf16_t* rowp = QKV + (size_t)r * QKVW + colq;
#pragma unroll
          for (int bj = 0; bj < 2; ++bj) { const f32x4 v0 = acc[ai][bj][m][0] * s, v1 = acc[ai][bj][m][1] * s;
            { const u32x4 pk = pack8(v0, v1); if (!(probe_flags & 2)) *(u32x4*)(rowp + bj * 128) = pk; else asm volatile("" :: "v"(pk)); }
            }
        }
    } else {
      const int gi = pn - 18, nb = gi >> 2, colg = (gi & 3) * 256 + wc * 32 + 8 * fq;
      f32x4 bv[2][2];
#pragma unroll
      for (int bj = 0; bj < 2; ++bj) { bv[bj][0] = *(const f32x4*)(bgate + nb * D + colg + bj * 128); bv[bj][1] = *(const f32x4*)(bgate + nb * D + colg + bj * 128 + 4); }
#pragma unroll
      for (int ai = 0; ai < 2; ++ai)
#pragma unroll
        for (int m = 0; m < 4; ++m) { const int r = row0 + ai * 128 + m * 16; const float s = rs[ai][m];
          bf16_t* rowp = GATE + (size_t)r * GATEW + gi * 256 + wc * 32 + 8 * fq;
#pragma unroll
          for (int bj = 0; bj < 2; ++bj) { f32x4 v0 = acc[ai][bj][m][0] * s + bv[bj][0], v1 = acc[ai][bj][m][1] * s + bv[bj][1];
#pragma unroll
            for (int j = 0; j < 4; ++j) { v0[j] = 1.0f + fast_exp2(fminf(-v0[j] * LOG2E, 100.0f)); v1[j] = 1.0f + fast_exp2(fminf(-v1[j] * LOG2E, 100.0f)); }
            { const u32x4 pk = pack8(v0, v1); if (!(probe_flags & 2)) __builtin_nontemporal_store(pk, (u32x4*)(rowp + bj * 128)); else asm volatile("" :: "v"(pk)); } } }
    }
  }
};

template <bool HALFN, bool HALFM = false> struct EpiP3T {
  static constexpr bool PERM = true, HAS_MID = true, HAS_RS = false;
  const bf16_t* GATE; bf16_t* H;
  DI void mid(f32x4 (&acc)[2][2][4][2], const Unit& u, int t, int wr, int wc, int fr, int fq) const {
    const int nb = (t >> 3) - 1;
    const bf16_t* gp = GATE + (size_t)(u.pm * (HALFM ? 128 : 256) + wr * 64 + fr) * GATEW + nb * D + u.pn * (HALFN ? 128 : 256) + wc * 32 + 8 * fq;
    constexpr int NSB = (HALFM ? 1 : 2) * 2, NBJ = HALFN ? 1 : 2;
    u32x4 gA[2][2][2] = {}, gB[2][2][2] = {};
#define P3_LOAD(G_, k_) do { _Pragma("unroll") for (int mm = 0; mm < 2; ++mm) _Pragma("unroll") for (int bj = 0; bj < NBJ; ++bj) { \
      const bf16_t* q = gp + (size_t)(((k_) >> 1) * 128 + (2 * ((k_) & 1) + mm) * 16) * GATEW + bj * 128; G_[0][mm][bj] = *(const u32x4*)q; G_[1][mm][bj] = *(const u32x4*)(q + D); } asm volatile("" ::: "memory"); } while (0)
#define P3_APPLY(G_, k_) do { _Pragma("unroll") for (int mm = 0; mm < 2; ++mm) _Pragma("unroll") for (int bj = 0; bj < NBJ; ++bj) _Pragma("unroll") for (int n = 0; n < 2; ++n) { \
      const unsigned a0 = G_[0][mm][bj][2 * n], a1 = G_[0][mm][bj][2 * n + 1], b0 = G_[1][mm][bj][2 * n], b1 = G_[1][mm][bj][2 * n + 1]; f32x4& c = acc[(k_) >> 1][bj][2 * ((k_) & 1) + mm][n]; \
      c[0] *= bflo(b0) * fast_rcp(bflo(a0)); c[1] *= bfhi(b0) * fast_rcp(bfhi(a0)); c[2] *= bflo(b1) * fast_rcp(bflo(a1)); c[3] *= bfhi(b1) * fast_rcp(bfhi(a1)); } asm volatile("" ::: "memory"); } while (0)
    P3_LOAD(gA, 0); P3_LOAD(gB, 1); P3_APPLY(gA, 0);
    if (NSB == 4) { P3_LOAD(gA, 2); P3_APPLY(gB, 1); P3_LOAD(gB, 3); P3_APPLY(gA, 2); P3_APPLY(gB, 3); }
    else P3_APPLY(gB, 1);
#undef P3_LOAD
#undef P3_APPLY
  }
  DI void operator()(f32x4 (&acc)[2][2][4][2], const Unit& u, int wr, int wc, int fr, int fq) const {
    const int row0 = u.pm * (HALFM ? 128 : 256) + wr * 64 + fr, col0 = u.pn * (HALFN ? 128 : 256) + wc * 32 + 8 * fq;
    const bf16_t* gp = GATE + (size_t)row0 * GATEW + 2 * D + col0; bf16_t* hp = H + (size_t)row0 * D + col0;
    constexpr int NSB = (HALFM ? 1 : 2) * 2, NBJ = HALFN ? 1 : 2;
    u32x4 gA[2][2] = {}, gB[2][2] = {};
#define P3F_LOAD(G_, k_) do { _Pragma("unroll") for (int mm = 0; mm < 2; ++mm) _Pragma("unroll") for (int bj = 0; bj < NBJ; ++bj) \
      G_[mm][bj] = *(const u32x4*)(gp + (size_t)(((k_) >> 1) * 128 + (2 * ((k_) & 1) + mm) * 16) * GATEW + bj * 128); asm volatile("" ::: "memory"); } while (0)
#define P3F_APPLY(G_, k_) do { _Pragma("unroll") for (int mm = 0; mm < 2; ++mm) _Pragma("unroll") for (int bj = 0; bj < NBJ; ++bj) { const u32x4 g = G_[mm][bj]; \
      f32x4 v0 = acc[(k_) >> 1][bj][2 * ((k_) & 1) + mm][0], v1 = acc[(k_) >> 1][bj][2 * ((k_) & 1) + mm][1]; \
      v0[0] *= fast_rcp(bflo(g[0])); v0[1] *= fast_rcp(bfhi(g[0])); v0[2] *= fast_rcp(bflo(g[1])); v0[3] *= fast_rcp(bfhi(g[1])); v1[0] *= fast_rcp(bflo(g[2])); v1[1] *= fast_rcp(bfhi(g[2])); v1[2] *= fast_rcp(bflo(g[3])); v1[3] *= fast_rcp(bfhi(g[3])); \
      *(u32x4*)(hp + (size_t)(((k_) >> 1) * 128 + (2 * ((k_) & 1) + mm) * 16) * D + bj * 128) = pack8(v0, v1); } asm volatile("" ::: "memory"); } while (0)
    P3F_LOAD(gA, 0); P3F_LOAD(gB, 1); P3F_APPLY(gA, 0);
    if (NSB == 4) { P3F_LOAD(gA, 2); P3F_APPLY(gB, 1); P3F_LOAD(gB, 3); P3F_APPLY(gA, 2); P3F_APPLY(gB, 3); }
    else P3F_APPLY(gB, 1);
#undef P3F_LOAD
#undef P3F_APPLY
  }
};

typedef EpiP3T<false> EpiP3;

template <bool HALFN, bool HALFM = false> struct EpiResT {
  static constexpr bool PERM = true, HAS_MID = false, HAS_RS = false;
  float* X32; bf16_t* XB; float* SS; LAS unsigned char* lds; const float* xin_p; const float* xin_s;
  DI void mid(f32x4 (&)[2][2][4][2], const Unit&, int, int, int, int, int) const {}
  DI void operator()(f32x4 (&acc)[2][2][4][2], const Unit& u, int wr, int wc, int fr, int fq) const {
    const int rin0 = wr * 64 + fr, row0 = u.pm * (HALFM ? 128 : 256) + rin0, col0 = u.pn * (HALFN ? 128 : 256) + wc * 32 + 8 * fq;
    LAS float* red = (LAS float*)(lds + 131072 + 8192);
#pragma unroll
    for (int ai = 0; ai < (HALFM ? 1 : 2); ++ai) {
      f32x4 xo[4][2][2] = {};
#pragma unroll
      for (int m = 0; m < 4; ++m) { const int r = row0 + ai * 128 + m * 16;
        if (xin_p) { const float* xr = (r < TOKP ? xin_p + (size_t)r * D : xin_s + (size_t)(r - TOKP) * D) + col0;
#pragma unroll
          for (int bj = 0; bj < (HALFN ? 1 : 2); ++bj)
#pragma unroll
            for (int n = 0; n < 2; ++n) xo[m][bj][n] = *(const f32x4*)(xr + bj * 128 + n * 4);
        } else {
#pragma unroll
          for (int bj = 0; bj < (HALFN ? 1 : 2); ++bj) { const u32x4 w = *(const u32x4*)(XB + (size_t)r * D + col0 + bj * 128);
            xo[m][bj][0] = (f32x4){bflo(w[0]), bfhi(w[0]), bflo(w[1]), bfhi(w[1])}; xo[m][bj][1] = (f32x4){bflo(w[2]), bfhi(w[2]), bflo(w[3]), bfhi(w[3])}; } } }
#pragma unroll
      for (int m = 0; m < 4; ++m) { const int r = row0 + ai * 128 + m * 16; bf16_t* bp = XB + (size_t)r * D + col0; float q = 0.f;
#pragma unroll
        for (int bj = 0; bj < (HALFN ? 1 : 2); ++bj)
          { const f32x4 x0 = xo[m][bj][0] + acc[ai][bj][m][0], x1 = xo[m][bj][1] + acc[ai][bj][m][1];
            *(u32x4*)(bp + bj * 128) = pack8(x0, x1);
            q += ((x0[0] * x0[0] + x0[1] * x0[1]) + (x0[2] * x0[2] + x0[3] * x0[3])) + ((x1[0] * x1[0] + x1[1] * x1[1]) + (x1[2] * x1[2] + x1[3] * x1[3])); }
        q += __shfl_xor(q, 16); q += __shfl_xor(q, 32);
        if (fq == 0) red[(rin0 + ai * 128 + m * 16) * 4 + wc] = q; }
      asm volatile("" ::: "memory"); }
    asm volatile("s_waitcnt lgkmcnt(0)" ::: "memory"); __builtin_amdgcn_s_barrier(); asm volatile("" ::: "memory");
    int t = threadIdx.x; asm volatile("" : "+v"(t));
    if (t < (HALFM ? 128 : 256)) { const f32x4 v = *(const LAS f32x4*)(red + t * 4); const float q = (v[0] + v[1]) + (v[2] + v[3]); float* sp = SS + (size_t)(u.pm * (HALFM ? 128 : 256) + t) * 8;
      if (HALFN) sp[u.pn] = q; else *(f32x2*)(sp + 2 * u.pn) = (f32x2){q, 0.f}; }
  }
};

typedef EpiResT<false> EpiRes;

DI float dpp_ror1(float v) { return __builtin_bit_cast(float, __builtin_amdgcn_update_dpp(0, __builtin_bit_cast(int, v), 0x121, 0xf, 0xf, false)); }
DI float dpp_ror2(float v) { return __builtin_bit_cast(float, __builtin_amdgcn_update_dpp(0, __builtin_bit_cast(int, v), 0x122, 0xf, 0xf, false)); }
DI float gelu_mul(float x, float uv) {
  const float t = __builtin_fmaf(x * x, 2.0f * LOG2E * 0.7978845608028654f * 0.044715f, 2.0f * LOG2E * 0.7978845608028654f);
  const float r = fast_rcp(fast_exp2(x * t) + 1.0f);
  return __builtin_fmaf(-x, r, x) * uv;
}
constexpr size_t SIDE_ROWS = (size_t)72 * 2 * DFF;
template <bool HALFM> struct EpiP5FT {
  static constexpr bool PERM = true, HAS_MID = false, HAS_RS = true;
  const float* SS; bf16_t* HF; float* out; const float* cw; const float* cb; const float* st; float* side; LAS unsigned char* lds; int layer;
  DI void mid(f32x4 (&)[2][2][4][2], const Unit&, int, int, int, int, int) const {}
  DI f32x4 prefetch(const Unit& u, int tid) const {
    f32x4 v = {0.f, 0.f, 0.f, 0.f};
    if (tid < (HALFM ? 128 : 256)) v = ss_load(SS, u.pm * (HALFM ? 128 : 256) + tid);
    else if (tid >= 256 && tid < 384) { int j = tid - 256; asm volatile("" : "+v"(j));
      const int arr = j >> 5, c4 = (j & 31) * 4; v = *(const f32x4*)((arr < 3 ? cw + arr * DFF : cb) + u.pn * 128 + c4); }
    return v;
  }
  DI void stash(const f32x4& v, const Unit& u, int tid, LAS unsigned char* l) const {
    if (tid < (HALFM ? 128 : 256)) *(LAS float*)(l + 131072 + 12288 + tid * 4) = ss_to_rs(v);
    else if (tid >= 256 && tid < 384) *(LAS f32x4*)(l + 131072 + 13312 + (tid - 256) * 16) = v;
  }
  DI void operator()(f32x4 (&acc)[2][2][4][2], const Unit& u, int wr, int wc, int fr_in, int fq_in) const {
    int fr = fr_in, fq = fq_in; asm volatile("" : "+v"(fr), "+v"(fq));
    const int rin0 = wr * 64 + fr, col0 = u.pn * 128 + wc * 32 + 8 * fq;
    const bool sample = HALFM ? true : u.pm >= 64, cont = !sample && (u.pm & 15) != 0;
    const int bd0 = HALFM ? (u.pm - TOKP / 128) * 2 : (u.pm - 64) * 4;
    LAS float* xh = (LAS float*)(lds + 131072);
    float* TAILG = side; float* HEADC = side + SIDE_ROWS; float* HEADU = side + 2 * SIDE_ROWS;
#pragma unroll
    for (int ai = 0; ai < (HALFM ? 1 : 2); ++ai)
#pragma unroll
      for (int m = 0; m < 4; ++m) { const float s = *(const LAS float*)(lds + 131072 + 12288 + (rin0 + ai * 128 + m * 16) * 4);
#pragma unroll
        for (int n = 0; n < 2; ++n) { acc[ai][0][m][n] *= s; acc[ai][1][m][n] *= s; } }
    if (fr >= 14) {
#pragma unroll
      for (int ai = 0; ai < (HALFM ? 1 : 2); ++ai) { const int gidx = 2 * ai + wr; LAS float* xp = xh + ((gidx * 4 + wc) * 2 + (fr - 14)) * 32 + fq * 8;
        *(LAS f32x4*)xp = acc[ai][0][3][0]; *(LAS f32x4*)(xp + 4) = acc[ai][0][3][1];
        float* cp = nullptr;
        if (sample) cp = out + O_SCONV + ((size_t)(layer * DB + bd0 + gidx) * 2 + (fr - 14)) * DFF + col0;
        else if (gidx == 3) { float* tp = TAILG + ((size_t)u.pm * 2 + (fr - 14)) * DFF + col0; *(f32x4*)tp = acc[ai][0][3][0]; *(f32x4*)(tp + 4) = acc[ai][0][3][1];
          if ((u.pm & 15) == 15) cp = out + O_PCONV + ((size_t)(layer * 4 + (u.pm >> 4)) * 2 + (fr - 14)) * DFF + col0; }
        if (cp) { *(f32x4*)cp = acc[ai][0][3][0]; *(f32x4*)(cp + 4) = acc[ai][0][3][1]; } }
    }
    asm volatile("s_waitcnt lgkmcnt(0)" ::: "memory"); __builtin_amdgcn_s_barrier(); asm volatile("" ::: "memory");
#pragma unroll
    for (int n = 0; n < 2; ++n) {
      const LAS float* cl = (const LAS float*)(lds + 131072 + 13312) + wc * 32 + 8 * fq + 4 * n;
      const f32x4 w0 = *(const LAS f32x4*)cl, w1 = *(const LAS f32x4*)(cl + 128), w2 = *(const LAS f32x4*)(cl + 256), bb = *(const LAS f32x4*)(cl + 384);
#pragma unroll
      for (int ai = 0; ai < (HALFM ? 1 : 2); ++ai) { const int gidx = 2 * ai + wr;
        f32x4 gp = {0.f, 0.f, 0.f, 0.f};
        if (fr >= 14) {
          if (sample) gp = *(const f32x4*)(st + ((size_t)(bd0 + gidx) * 2 + (fr - 14)) * DFF + col0 + 4 * n);
          else if (gidx > 0) gp = *(const LAS f32x4*)(xh + (((gidx - 1) * 4 + wc) * 2 + (fr - 14)) * 32 + fq * 8 + 4 * n);
        }
#pragma unroll
        for (int m = 0; m < 4; ++m) { const int rin = rin0 + ai * 128 + m * 16; f32x4 o, cc;
#pragma unroll
          for (int j = 0; j < 4; ++j) { const float g = acc[ai][0][m][n][j], gq = gp[j];
            const float r1g = dpp_ror1(g), r1q = dpp_ror1(gq), r2g = dpp_ror2(g), r2q = dpp_ror2(gq);
            const float p1 = fr >= 1 ? r1g : r1q, p2 = fr >= 2 ? r2g : r2q;
            const float c = __builtin_fmaf(w2[j], g, __builtin_fmaf(w1[j], p1, __builtin_fmaf(w0[j], p2, bb[j])));
            cc[j] = c; o[j] = gelu_mul(c, acc[ai][1][m][n][j]); }
          *(u32x2*)(HF + (size_t)(u.pm * (HALFM ? 128 : 256) + rin) * DFF + col0 + 4 * n) = pack4(o);
          if (cont && gidx == 0 && m == 0 && fr < 2) { *(f32x4*)(HEADC + ((size_t)u.pm * 2 + fr) * DFF + col0 + 4 * n) = cc; *(f32x4*)(HEADU + ((size_t)u.pm * 2 + fr) * DFF + col0 + 4 * n) = acc[ai][1][m][n]; }
          gp = acc[ai][0][m][n]; }
      }
    }
  }
};
typedef EpiP5FT<false> EpiP5F;
DI void p6_fixup_panel(int pm, const float* side, const float* cw, bf16_t* HF) {
  const float* TAILG = side + (size_t)(pm - 1) * 2 * DFF; const float* HEADC = side + SIDE_ROWS + (size_t)pm * 2 * DFF; const float* HEADU = side + 2 * SIDE_ROWS + (size_t)pm * 2 * DFF;
  int tid_ = threadIdx.x; asm volatile("" : "+v"(tid_));
  constexpr int NIT = (DFF + NTHREADS - 1) / NTHREADS;
  float t0[NIT], t1[NIT], a0[NIT], a1[NIT], hc0[NIT], hc1[NIT], hu0[NIT], hu1[NIT];
#pragma unroll
  for (int i = 0; i < NIT; ++i) { const int k = tid_ + i * NTHREADS; const int kk = k < DFF ? k : 0;
    t0[i] = TAILG[kk]; t1[i] = TAILG[DFF + kk]; a0[i] = cw[kk]; a1[i] = cw[DFF + kk]; hc0[i] = HEADC[kk]; hc1[i] = HEADC[DFF + kk]; hu0[i] = HEADU[kk]; hu1[i] = HEADU[DFF + kk]; }
#pragma unroll
  for (int i = 0; i < NIT; ++i) { const int k = tid_ + i * NTHREADS;
    const float c0 = hc0[i] + a0[i] * t0[i] + a1[i] * t1[i], c1 = hc1[i] + a0[i] * t1[i];
    const float h0 = gelu_mul(c0, hu0[i]), h1 = gelu_mul(c1, hu1[i]);
    f32x4 v = {h0, h1, 0.f, 0.f}; const u32x2 pk = pack4(v);
    if (k < DFF) { HF[(size_t)(pm * 256) * DFF + k] = (bf16_t)(pk[0] & 0xffffu); HF[(size_t)(pm * 256 + 1) * DFF + k] = (bf16_t)(pk[0] >> 16); } }
}

struct EpiNull {
  static constexpr bool PERM = true, HAS_MID = false, HAS_RS = false;
  DI void mid(f32x4 (&)[2][2][4][2], const Unit&, int, int, int, int, int) const {}
  DI void operator()(f32x4 (&acc)[2][2][4][2], const Unit& u, int wr, int wc, int fr, int fq) const {
#pragma unroll
    for (int ai = 0; ai < 2; ++ai)
#pragma unroll
      for (int bj = 0; bj < 2; ++bj)
#pragma unroll
        for (int m = 0; m < 4; ++m)
#pragma unroll
          for (int n = 0; n < 2; ++n) asm volatile("" :: "v"(acc[ai][bj][m][n]));
  }
};

DI float gelu_tanh(float x) {
  const float y = 0.7978845608028654f * (x + 0.044715f * x * x * x);
  const float e = fast_exp2(2.0f * LOG2E * y);
  const float th = 1.0f - 2.0f * fast_rcp(e + 1.0f);
  return 0.5f * x * (1.0f + th);
}
DI void pfinal_norm(const Params& p) {
  const bf16_t* XB = (const bf16_t*)(p.ws + WS_XB); const float* SS = (const float*)(p.ws + WS_SS);
  int tid_ = threadIdx.x; asm volatile("" : "+v"(tid_));
  const int lane = tid_ & 63, gw = blockIdx.x * 8 + (tid_ >> 6), NGW = gridDim.x * 8;
#pragma unroll 3
  for (int m = gw; m < TOK; m += NGW) { const float s = row_rs(SS, m);
#pragma unroll
    for (int j = 0; j < 2; ++j) { const u32x4 w = ((const u32x4*)(XB + (size_t)m * D))[lane + 64 * j];
      const f32x4 g0 = ((const f32x4*)p.norm_final)[2 * (lane + 64 * j)], g1 = ((const f32x4*)p.norm_final)[2 * (lane + 64 * j) + 1];
      const f32x4 a = {bflo(w[0]), bfhi(w[0]), bflo(w[1]), bfhi(w[1])}, b = {bflo(w[2]), bfhi(w[2]), bflo(w[3]), bfhi(w[3])};
      f32x4* o = (f32x4*)(p.out + (size_t)m * D) + 2 * (lane + 64 * j);
      __builtin_nontemporal_store(a * s * g0, o); __builtin_nontemporal_store(b * s * g1, o + 1); } }
}

DI pg8::GemmDesc p1_desc(unsigned char* ws, int l) {
  return pg8::GemmDesc{(const char*)(ws + WS_XB), (const char*)(ws + WS_WIN) + (size_t)l * INC * D * 2, D, D, D / 64, (size_t)256 * D * 2, (size_t)128 * D * 2};
}
DI EpiP1 p1_epi(const Params& p, int l, LAS unsigned char* lds) {
  return EpiP1{(const float*)(p.ws + WS_SS), (bf16_t*)(p.ws + WS_QKV), (bf16_t*)(p.ws + WS_GATE), p.b_gate + (size_t)l * 3 * D, p.out, l, 0, lds};
}
namespace attn {
constexpr int N_CPY = 0, N_CS = 128, N_CP = 512, N_AP = 512, N_BP = 512, N_AS = 256, N_BS = 256, NITEMS = N_CPY + N_CS + N_CP + N_AP + N_BP + N_AS + N_BS;
constexpr float STICK_DONE = 9.35762e-14f;

struct Item { int mode, h, tok0, past, q0, nqv, pflags; const float* cK; const float* cV; };

DI Item decode(const Params& p, int layer, int idx) {
  Item it; it.cK = nullptr; it.cV = nullptr; it.past = 0; it.pflags = 0;
  if (idx < N_CPY) { it.mode = 3; it.h = idx; return it; }
  idx -= N_CPY;
  if (idx < N_CS) { const int bd = idx >> 2, h = idx & 3; it.mode = 2; it.h = h; it.tok0 = TOKP + bd * 64; it.past = PAST; it.q0 = PAST; it.nqv = 64;
    it.cK = p.cache_c_k + (size_t)(layer * DB + bd) * PAST * 512 + h * 128; it.cV = p.cache_c_v + (size_t)(layer * DB + bd) * PAST * 512 + h * 128; return it; }
  idx -= N_CS;
  if (idx < N_CP) { const int jj = 31 - (idx >> 4), rem = idx & 15; it.mode = 2; it.h = rem & 3; it.tok0 = (rem >> 2) * SEQ; it.q0 = jj * 128; it.nqv = 128; return it; }
  idx -= N_CP;
  if (idx < N_AP + N_BP) { const int isb = idx >= N_AP; if (isb) idx -= N_AP; const int qt = 15 - (idx >> 5), rem = idx & 31; it.mode = isb; it.h = rem & 7; it.tok0 = (rem >> 3) * SEQ; it.q0 = qt * 256; it.nqv = 256; return it; }
  idx -= N_AP + N_BP;
  if (idx < N_AS) { const int bd = idx >> 3, h = idx & 7; it.mode = 0; it.h = h; it.tok0 = TOKP + bd * 64; it.past = ALEN; it.q0 = ALEN; it.nqv = 64;
    it.cK = p.cache_a_k + (size_t)(layer * DB + bd) * ALEN * 512 + h * 64; it.cV = p.cache_a_v + (size_t)(layer * DB + bd) * ALEN * 512 + h * 64; return it; }
  idx -= N_AS;
  { const int bd = idx >> 3, h = idx & 7; it.mode = 1; it.h = h; it.tok0 = TOKP + bd * 64; it.past = PAST; it.q0 = PAST; it.nqv = 64;
    it.cK = p.cache_b_k + (size_t)(layer * DB + bd) * PAST * 512 + h * 64; it.cV = p.cache_b_v + (size_t)(layer * DB + bd) * PAST * 512 + h * 64; return it; }
}


template <int MODE, bool SAMPLE>
DI void load_piece(u32x4& r0, u32x4& r1, u32x4& r2, u32x4& r3, const Item& it, const float* cache, const bf16_t* QKV, int col, int kt, int tid) {
  constexpr int CPR = MODE == 2 ? 16 : 8;
  const int j0 = kt * 64;
  const int ra = tid / CPR, ca = tid % CPR;
  if (SAMPLE && j0 < it.past) {
    const unsigned lo = (unsigned)(ra * 512 + ca * 8) * 4u; const char* b = (const char*)(cache + (size_t)j0 * 512);
    { const u32x4* q = (const u32x4*)(b + lo); r0 = __builtin_nontemporal_load(q); r1 = __builtin_nontemporal_load(q + 1); }
    if constexpr (MODE == 2) { const u32x4* q = (const u32x4*)(b + (size_t)32 * 512 * 4 + lo); r2 = __builtin_nontemporal_load(q); r3 = __builtin_nontemporal_load(q + 1); }
  } else {
    const unsigned lo = (unsigned)(ra * QKVW + ca * 8) * 2u; const char* b = (const char*)(QKV + (size_t)(it.tok0 + j0 - it.past) * QKVW + col);
    r0 = *(const u32x4*)(b + lo);
    if constexpr (MODE == 2) r2 = *(const u32x4*)(b + (size_t)32 * QKVW * 2 + lo);
  }
}
DI u32x4 pair_swap(u32x2 a, u32x2 b) {
  unsigned a0 = a[0], a1 = a[1], b0 = b[0], b1 = b[1];
  asm("s_nop 1\n\tv_permlane32_swap_b32 %0, %1" : "+v"(a0), "+v"(b0));
  asm("s_nop 1\n\tv_permlane32_swap_b32 %0, %1" : "+v"(a1), "+v"(b1));
  return (u32x4){a0, a1, b0, b1};
}
DI u32x4 cvt8(u32x4 a, u32x4 b) { return pack8(__builtin_bit_cast(f32x4, a), __builtin_bit_cast(f32x4, b)); }
template <int MODE, bool ISK, bool SAMPLE>
DI void write_piece(const u32x4& r0, const u32x4& r1, const u32x4& r2, const u32x4& r3, const Item& it, LAS unsigned char* buf, int kt, int tid) {
  constexpr int CPR = MODE == 2 ? 16 : 8, VS = MODE == 2 ? 320 : 192;
  const bool f32src = SAMPLE && kt * 64 < it.past;
  const int ra = tid / CPR, ca = tid % CPR, rb = (tid + NTHREADS) / CPR, cb = (tid + NTHREADS) % CPR;
  { const u32x4 x = f32src ? cvt8(r0, r1) : r0;
    if (ISK) *(LAS u32x4*)(buf + ((MODE == 2 && ca >= 8) ? 8192 : 0) + ra * 128 + (((ca & 7) ^ ((ra >> 1) & 7)) << 4)) = x;
    else *(LAS u32x4*)(buf + ra * VS + ca * 16) = x; }
  if constexpr (MODE == 2) { const u32x4 x = f32src ? cvt8(r2, r3) : r2;
    if (ISK) *(LAS u32x4*)(buf + (cb >= 8 ? 8192 : 0) + rb * 128 + (((cb & 7) ^ ((rb >> 1) & 7)) << 4)) = x;
    else *(LAS u32x4*)(buf + rb * VS + cb * 16) = x; }
}

template <int MODE>
DI void state_store(const u32x4& r0, const u32x4& r2, float* dst, int tid) {
  constexpr int CPR = MODE == 2 ? 16 : 8;
  const int ra = tid / CPR, ca = tid % CPR, rb = (tid + NTHREADS) / CPR, cb = (tid + NTHREADS) % CPR;
  { float* q = dst + (size_t)ra * 512 + ca * 8;
    __builtin_nontemporal_store((f32x4){bflo(r0[0]), bfhi(r0[0]), bflo(r0[1]), bfhi(r0[1])}, (f32x4*)q); __builtin_nontemporal_store((f32x4){bflo(r0[2]), bfhi(r0[2]), bflo(r0[3]), bfhi(r0[3])}, (f32x4*)(q + 4)); }
  if constexpr (MODE == 2) { float* q = dst + (size_t)rb * 512 + cb * 8;
    __builtin_nontemporal_store((f32x4){bflo(r2[0]), bfhi(r2[0]), bflo(r2[1]), bfhi(r2[1])}, (f32x4*)q); __builtin_nontemporal_store((f32x4){bflo(r2[2]), bfhi(r2[2]), bflo(r2[3]), bfhi(r2[3])}, (f32x4*)(q + 4)); }
}
template <int MODE>
DI float* state_dst(const Params& p, int layer, const Item& it, int kt, int isv) {
  const int hoff = MODE == 2 ? it.h * 128 : it.h * 64;
  if (it.past == 0) {
    const int t0 = kt * 64; if (t0 < it.q0 || t0 >= it.q0 + it.nqv) return nullptr;
    const int b = it.tok0 / SEQ;
    if (MODE == 0) { if (t0 < SEQ - 512) return nullptr; return p.out + (isv ? O_PAV : O_PAK) + ((size_t)(layer * 4 + b) * 512 + (t0 - (SEQ - 512))) * 512 + hoff; }
    return p.out + (MODE == 1 ? (isv ? O_PBV : O_PBK) : (isv ? O_PCV : O_PCK)) + ((size_t)(layer * 4 + b) * SEQ + t0) * 512 + hoff;
  } else {
    if (kt * 64 != it.past) return nullptr;
    const int bd = (it.tok0 - TOKP) / 64;
    if (MODE == 0) return p.out + (isv ? O_SAV : O_SAK) + ((size_t)(layer * DB + bd) * 512 + 448) * 512 + hoff;
    return p.out + (MODE == 1 ? (isv ? O_SBV : O_SBK) : (isv ? O_SCV : O_SCK)) + ((size_t)(layer * DB + bd) * 64) * 512 + hoff;
  }
}

DI void roll_store(const u32x4& r0, const u32x4& r1, const Params& p, int layer, const Item& it, int kt, int isv, int tid) {
  if (kt < 1 || kt * 64 >= it.past) return;
  const int bd = (it.tok0 - TOKP) / 64, ra = tid >> 3, ca = tid & 7;
  float* q = p.out + (isv ? O_SAV : O_SAK) + ((size_t)(layer * DB + bd) * 512 + (kt - 1) * 64 + ra) * 512 + it.h * 64 + ca * 8;
  __builtin_nontemporal_store(__builtin_bit_cast(f32x4, r0), (f32x4*)q); __builtin_nontemporal_store(__builtin_bit_cast(f32x4, r1), (f32x4*)(q + 4));
}
DI bf16x8 pack_p(const f32x16& x, int s) {
  const f32x4 a = {x[8 * s], x[8 * s + 1], x[8 * s + 2], x[8 * s + 3]}, b = {x[8 * s + 4], x[8 * s + 5], x[8 * s + 6], x[8 * s + 7]};
  return __builtin_bit_cast(bf16x8, pack8(a, b));
}
#define MFMA32(a, b, c) __builtin_amdgcn_mfma_f32_32x32x16_bf16((a), (b), (c), 0, 0, 0)

constexpr int L_KB = 0, KB_BYTES = 16384, L_VB = 32768, VB_BYTES = 20480, L_LUT = 73728, L_FLAGS = 75776, L_XCH = 81920;

template <int MODE, bool SAMPLE>
DI void run_item(const Params& p, int layer, const Item& it, LAS unsigned char* lds_in) {
  LAS unsigned char* lds = opaque_lds(lds_in);
  constexpr int NDV = MODE == 2 ? 4 : 2, VS = MODE == 2 ? 320 : 192;
  int tid_ = threadIdx.x; asm volatile("" : "+v"(tid_));
  const int tid = tid_, lane = tid & 63, wave = __builtin_amdgcn_readfirstlane(tid >> 6);
  const int qi = lane & 31, h2 = lane >> 5;
  const int mp = MODE == 2 ? (wave >> 2) : 0, wrow = MODE == 2 ? (wave & 3) : wave;
  const int q0w = it.q0 + 32 * wrow;
  const bool active = 32 * wrow < it.nqv;
  const bf16_t* QKV = (const bf16_t*)(p.ws + WS_QKV);
  const int hb = MODE == 2 ? it.h * 128 : it.h * 64;
  const int qcol = (MODE == 0 ? 0 : MODE == 1 ? 1536 : 3072) + hb + 64 * mp, kcol = (MODE == 0 ? 512 : MODE == 1 ? 2048 : 3584) + hb, vcol = (MODE == 0 ? 1024 : MODE == 1 ? 2560 : 4096) + hb;
  const int cw = q0w >> 6;
  int kt_first, step, NT;
  if (MODE == 0) { kt_first = (it.q0 >> 6) - 8; if (kt_first < 0) kt_first = 0; step = 1; NT = ((it.q0 + it.nqv - 1) >> 6) - kt_first + 1; }
  else if (MODE == 2) { kt_first = 0; step = 1; NT = ((it.q0 + it.nqv - 1) >> 6) + 1; }
  else { kt_first = (it.q0 + it.nqv - 2) >> 6; step = -1; NT = kt_first + 1; }
  const bool wr_state = it.pflags == 0;
  u32x4 k0 = {}, k1 = {}, k2 = {}, k3 = {}, v0 = {}, v1 = {}, v2 = {}, v3 = {};
  load_piece<MODE, SAMPLE>(k0, k1, k2, k3, it, it.cK, QKV, kcol, kt_first, tid);
  load_piece<MODE, SAMPLE>(v0, v1, v2, v3, it, it.cV, QKV, vcol, kt_first, tid);
  LAS float* lut = (LAS float*)(lds + L_LUT);
  LAS unsigned* flags = (LAS unsigned*)(lds + L_FLAGS);
  if (MODE == 0) { const float bfar = p.a_rel_bias[((size_t)layer * 257 + 256) * 8 + it.h]; for (int i = tid; i < 257; i += NTHREADS) lut[i] = p.a_rel_bias[((size_t)layer * 257 + i) * 8 + it.h] - bfar; }
  if (MODE == 2) { if (tid < 192) lut[tid] = ((const float*)(p.ws + WS_CTL))[CW_T5 + it.h * 192 + tid]; }
  bf16x8 qf[4];
  if (active) { const bf16_t* qp = QKV + (size_t)(it.tok0 + q0w + qi - it.past) * QKVW + qcol + 8 * h2;
#pragma unroll
    for (int s = 0; s < 4; ++s) { const u32x4 w = *(const u32x4*)(qp + 16 * s);
      const f32x4 a = {bflo(w[0]) * 0.125f, bfhi(w[0]) * 0.125f, bflo(w[1]) * 0.125f, bfhi(w[1]) * 0.125f}, b = {bflo(w[2]) * 0.125f, bfhi(w[2]) * 0.125f, bflo(w[3]) * 0.125f, bfhi(w[3]) * 0.125f};
      qf[s] = __builtin_bit_cast(bf16x8, pack8(a, b)); } }
  f32x16 O[NDV];
#pragma unroll
  for (int b = 0; b < NDV; ++b)
#pragma unroll
    for (int i = 0; i < 16; ++i) O[b][i] = 0.f;
  float m_run = -1e30f, l_run = 0.f, R2 = 1.0f; bool done = false, have_p = false;
  bf16x8 pf[4];
#pragma unroll
  for (int s = 0; s < 4; ++s) pf[s] = (bf16x8){0, 0, 0, 0, 0, 0, 0, 0};
  const int krow_off = qi * 128, kswz = (qi >> 1) & 7;
  const int g16 = lane >> 4, trq = (lane & 15) >> 2, trp = lane & 3;
  const int vtr_off = (4 * (g16 >> 1) + trq) * VS + (16 * (g16 & 1) + 4 * trp) * 2;

  write_piece<MODE, true, SAMPLE>(k0, k1, k2, k3, it, lds + L_KB, kt_first, tid);
  if (wr_state) { float* d = state_dst<MODE>(p, layer, it, kt_first, 0); if (d) state_store<MODE>(k0, k2, d, tid); }
  if (MODE == 0 && SAMPLE && wr_state) roll_store(k0, k1, p, layer, it, kt_first, 0, tid);
  if (NT > 1) load_piece<MODE, SAMPLE>(k0, k1, k2, k3, it, it.cK, QKV, kcol, kt_first + step, tid);
  for (int t = 0;; ++t) {
    __syncthreads();
    if (MODE == 1 && t > 0 && t < NT) { const unsigned any = flags[0] | flags[1] | flags[2] | flags[3] | flags[4] | flags[5] | flags[6] | flags[7]; if (!any) NT = t; }
    const int kt = kt_first + step * t;
    bool mine = false;
    if (t < NT && !(it.pflags & 2)) {
      if (MODE == 0) mine = active && kt >= cw - 8 && kt <= cw;
      else if (MODE == 2) mine = active && kt <= cw;
      else mine = active && !done && kt * 64 <= q0w + 30;
    }
    LAS unsigned char* vb = lds + L_VB + ((t - 1) & 1) * VB_BYTES + vtr_off;
    LAS unsigned char* kb = lds + L_KB + (t & 1) * KB_BYTES + ((MODE == 2 && mp) ? 8192 : 0);
    constexpr int HB = NDV / 2, NST = 4 * HB;
    bf16x8 kfa[4], vfa[2], vfb[2];
    const bool do_pv = have_p && !(it.pflags & 8);
#define V_LOAD(dst, j_) do { if (do_pv) { _Pragma("unroll") for (int bb = 0; bb < 2; ++bb) { const int a0 = 16 * ((j_) / HB) * VS + 64 * (2 * ((j_) % HB) + bb); \
      const s16x4 lo = __builtin_amdgcn_ds_read_tr16_b64_v4i16((LAS s16x4*)(vb + a0)), hi = __builtin_amdgcn_ds_read_tr16_b64_v4i16((LAS s16x4*)(vb + a0 + 8 * VS)); \
      dst[bb] = __builtin_shufflevector(lo, hi, 0, 1, 2, 3, 4, 5, 6, 7); } } } while (0)
#define V_MMA(src, j_) do { if (do_pv) { _Pragma("unroll") for (int bb = 0; bb < 2; ++bb) O[2 * ((j_) % HB) + bb] = MFMA32(src[bb], pf[(j_) / HB], O[2 * ((j_) % HB) + bb]); } } while (0)
#define STG(j_, cur, nxt) do { if (SAMPLE) { V_LOAD(cur, j_); V_MMA(cur, j_); } else { if ((j_) + 1 < NST) V_LOAD(nxt, (j_) + 1); V_MMA(cur, j_); } } while (0)
    if (!SAMPLE) {
      if (mine) {
#pragma unroll
        for (int s = 0; s < 4; ++s) kfa[s] = *(const LAS bf16x8*)(kb + krow_off + (((2 * s + h2) ^ kswz) << 4)); }
      V_LOAD(vfa, 0);
      __builtin_amdgcn_sched_barrier(0);
    }
    if (t < NT && !(it.pflags & 1)) { write_piece<MODE, false, SAMPLE>(v0, v1, v2, v3, it, lds + L_VB + (t & 1) * VB_BYTES, kt_first + step * t, tid);
      if (wr_state) { float* d = state_dst<MODE>(p, layer, it, kt_first + step * t, 1); if (d) state_store<MODE>(v0, v2, d, tid); }
      if (MODE == 0 && SAMPLE && wr_state) roll_store(v0, v1, p, layer, it, kt_first + step * t, 1, tid);
      if (t + 1 < NT) { write_piece<MODE, true, SAMPLE>(k0, k1, k2, k3, it, lds + L_KB + ((t + 1) & 1) * KB_BYTES, kt_first + step * (t + 1), tid);
        if (wr_state) { float* d = state_dst<MODE>(p, layer, it, kt_first + step * (t + 1), 0); if (d) state_store<MODE>(k0, k2, d, tid); }
        if (MODE == 0 && SAMPLE && wr_state) roll_store(k0, k1, p, layer, it, kt_first + step * (t + 1), 0, tid);
        load_piece<MODE, SAMPLE>(v0, v1, v2, v3, it, it.cV, QKV, vcol, kt_first + step * (t + 1), tid);
        if (t + 2 < NT) load_piece<MODE, SAMPLE>(k0, k1, k2, k3, it, it.cK, QKV, kcol, kt_first + step * (t + 2), tid); } }
    __builtin_amdgcn_sched_barrier(0);
    f32x16 sA, sB;
#pragma unroll
    for (int i = 0; i < 16; ++i) { sA[i] = 0.f; sB[i] = 0.f; }
    if (mine) {
      bf16x8 kfc[4];
      if (SAMPLE) {
#pragma unroll
        for (int s = 0; s < 4; ++s) kfa[s] = *(const LAS bf16x8*)(kb + krow_off + (((2 * s + h2) ^ kswz) << 4)); }
#pragma unroll
      for (int s = 0; s < 4; ++s) kfc[s] = *(const LAS bf16x8*)(kb + 4096 + krow_off + (((2 * s + h2) ^ kswz) << 4));
#pragma unroll
      for (int s = 0; s < 4; ++s) sA = MFMA32(kfa[s], qf[s], sA);
#pragma unroll
      for (int s = 0; s < 4; ++s) sB = MFMA32(kfc[s], qf[s], sB);
    }
    const int kbase = kt * 64 + 4 * h2;
    if (MODE != 1) {
      float mx = -1e30f, alpha = 1.0f, lsa = 0.f, lsb = 0.f; bool resc = false;
      const bool smx = mine && !(it.pflags & 4);
      STG(0, vfa, vfb);
      if (NST == 8) STG(1, vfb, vfa);
      if (smx) {
        bool cst;
        if (MODE == 0) cst = q0w - (kt * 64 + 63) >= 128; else cst = kt * 64 + 63 - q0w <= -127;
        if (!cst) {
#pragma unroll
          for (int i = 0; i < 16; ++i) { const int ko = (i & 3) + 8 * (i >> 2);
            int ia, ib;
            if (MODE == 0) { const int d = (q0w + qi) - (kbase + ko); ia = d; ib = d - 32; ia = (ia < -128 ? -128 : ia > 128 ? 128 : ia) + 128; ib = (ib < -128 ? -128 : ib > 128 ? 128 : ib) + 128; }
            else { const int d = (kbase + ko) - (q0w + qi); ia = d; ib = d + 32; ia = (ia < -127 ? -127 : ia > 63 ? 63 : ia) + 127; ib = (ib < -127 ? -127 : ib > 63 ? 63 : ib) + 127; }
            sA[i] += lut[ia]; sB[i] += lut[ib]; }
        }
        float m0 = fmaxf(fmaxf(sA[0], sA[1]), sA[2]), m1 = fmaxf(fmaxf(sB[0], sB[1]), sB[2]);
#pragma unroll
        for (int i = 3; i < 15; i += 2) { m0 = fmaxf(fmaxf(m0, sA[i]), sA[i + 1]); m1 = fmaxf(fmaxf(m1, sB[i]), sB[i + 1]); }
        mx = fmaxf(fmaxf(m0, m1), fmaxf(sA[15], sB[15]));
      }
      __builtin_amdgcn_sched_barrier(0);
      if (NST == 8) { STG(2, vfa, vfb); STG(3, vfb, vfa); } else STG(1, vfb, vfa);
      if (smx) {
        mx = fmaxf(mx, __shfl_xor(mx, 32)) * LOG2E;
        resc = !__all(mx <= m_run + 8.0f);
        if (resc) { const float mnew = fmaxf(m_run, mx); alpha = fast_exp2(m_run - mnew); m_run = mnew; l_run *= alpha; }
#pragma unroll
        for (int i = 0; i < 16; ++i) { sA[i] = fast_exp2(__builtin_fmaf(sA[i], LOG2E, -m_run)); lsa += sA[i]; }
      }
      __builtin_amdgcn_sched_barrier(0);
      if (NST == 8) { STG(4, vfa, vfb); STG(5, vfb, vfa); } else STG(2, vfa, vfb);
      if (smx) {
#pragma unroll
        for (int i = 0; i < 16; ++i) { sB[i] = fast_exp2(__builtin_fmaf(sB[i], LOG2E, -m_run)); lsb += sB[i]; }
        l_run += lsa + lsb;
      }
      __builtin_amdgcn_sched_barrier(0);
      if (NST == 8) { STG(6, vfa, vfb); STG(7, vfb, vfa); } else STG(3, vfb, vfa);
      __builtin_amdgcn_sched_barrier(0);
      if (mine) {
        if (resc) {
#pragma unroll
        for (int b = 0; b < NDV; ++b)
#pragma unroll
          for (int i = 0; i < 16; ++i) O[b][i] *= alpha;
        }
        pf[0] = pack_p(sA, 0); pf[1] = pack_p(sA, 1); pf[2] = pack_p(sB, 0); pf[3] = pack_p(sB, 1);
      }
    } else {
      STG(0, vfa, vfb); STG(1, vfb, vfa); STG(2, vfa, vfb); STG(3, vfb, vfa);
      if (mine) {
        const bool diag = kt * 64 + 63 >= q0w;
        float kpA[16], kpB[16];
#pragma unroll
        for (int i = 0; i < 16; ++i) { const int ko = (i & 3) + 8 * (i >> 2);
          { const float r = fast_rcp(1.0f + fast_exp2(sA[i] * LOG2E)); const bool ok = !diag || (kbase + ko) < (q0w + qi); kpA[i] = ok ? r : 1.0f; sA[i] = ok ? 1.0f - r : 0.0f; }
          { const float r = fast_rcp(1.0f + fast_exp2(sB[i] * LOG2E)); const bool ok = !diag || (kbase + 32 + ko) < (q0w + qi); kpB[i] = ok ? r : 1.0f; sB[i] = ok ? 1.0f - r : 0.0f; } }
        float gs[8], pg[8];
#pragma unroll
        for (int g = 0; g < 4; ++g) { gs[g] = (kpA[4 * g] * kpA[4 * g + 1]) * (kpA[4 * g + 2] * kpA[4 * g + 3]); gs[4 + g] = (kpB[4 * g] * kpB[4 * g + 1]) * (kpB[4 * g + 2] * kpB[4 * g + 3]); }
#pragma unroll
        for (int g = 0; g < 8; ++g) pg[g] = __shfl_xor(gs[g], 32);
        float suf = R2;
#pragma unroll
        for (int g = 7; g >= 0; --g) { const float off = suf * (h2 == 0 ? pg[g] : 1.0f);
          if (g >= 4) { const int b = 4 * (g - 4); const float a3 = off, a2 = a3 * kpB[b + 3], a1 = a2 * kpB[b + 2], a0 = a1 * kpB[b + 1];
            sB[b + 3] *= a3; sB[b + 2] *= a2; sB[b + 1] *= a1; sB[b] *= a0; }
          else { const int b = 4 * g; const float a3 = off, a2 = a3 * kpA[b + 3], a1 = a2 * kpA[b + 2], a0 = a1 * kpA[b + 1];
            sA[b + 3] *= a3; sA[b + 2] *= a2; sA[b + 1] *= a1; sA[b] *= a0; }
          suf *= gs[g] * pg[g]; }
        R2 = suf;
        done = __all(R2 < STICK_DONE) != 0;
        pf[0] = pack_p(sA, 0); pf[1] = pack_p(sA, 1); pf[2] = pack_p(sB, 0); pf[3] = pack_p(sB, 1);
      }
    }
#undef V_LOAD
#undef V_MMA
#undef STG
    have_p = mine;
    if (MODE == 1 && t < NT) { if (lane == 0) flags[wave] = (active && !done && kt > 0 && (kt - 1) * 64 <= q0w + 30) ? 1u : 0u; }
    if (t >= NT) break;
  }
  int lane_e = lane; asm volatile("" : "+v"(lane_e));
  const int qi_e = lane_e & 31, h2_e = lane_e >> 5;
  bf16_t* Ob = (bf16_t*)(p.ws + WS_O);
  const int ocol = MODE == 0 ? hb : MODE == 1 ? 512 + hb : 1024 + hb;
  const bool wr_out = it.pflags == 0;
  if (MODE != 2) {
    if (active && wr_out) { float sc = 1.f; if (MODE == 0) { const float lt = l_run + __shfl_xor(l_run, 32); sc = fast_rcp(lt); }
      bf16_t* op = Ob + (size_t)(it.tok0 + q0w + qi_e - it.past) * OW + ocol + 8 * h2_e;
#pragma unroll
      for (int b = 0; b < NDV; ++b)
#pragma unroll
        for (int j = 0; j < 2; ++j) { const f32x4 va = {O[b][8 * j] * sc, O[b][8 * j + 1] * sc, O[b][8 * j + 2] * sc, O[b][8 * j + 3] * sc}, vb = {O[b][8 * j + 4] * sc, O[b][8 * j + 5] * sc, O[b][8 * j + 6] * sc, O[b][8 * j + 7] * sc};
          *(u32x4*)(op + 32 * b + 16 * j) = pair_swap(pack4(va), pack4(vb)); } }
    __syncthreads();
  } else {
    const float lam = ((const float*)(p.ws + WS_CTL))[CW_LAM + layer];
    const float sub_scale = 1.0f - (0.8f - 0.6f * expf(-0.3f * (float)layer));
    LAS float* xch = (LAS float*)(lds + L_XCH);
    if (active && mp == 1) { const float lt = l_run + __shfl_xor(l_run, 32), sc = lam * fast_rcp(lt);
#pragma unroll
      for (int b = 0; b < NDV; ++b)
#pragma unroll
        for (int i = 0; i < 16; ++i) xch[((wave & 3) * 64 + b * 16 + i) * 64 + lane_e] = O[b][i] * sc; }
    __syncthreads();
    if (active && mp == 0 && wr_out) { const float lt = l_run + __shfl_xor(l_run, 32), sc = fast_rcp(lt); float q = 0.f;
#pragma unroll
      for (int b = 0; b < NDV; ++b)
#pragma unroll
        for (int i = 0; i < 16; ++i) { const float o = O[b][i] * sc - xch[((wave & 3) * 64 + b * 16 + i) * 64 + lane_e]; O[b][i] = o; q += o * o; if ((i & 7) == 7) __builtin_amdgcn_sched_barrier(0); }
      q += __shfl_xor(q, 32);
      const float rstd = __builtin_amdgcn_rsqf(q * (1.0f / 128.0f) + EPS) * sub_scale;
      const float* gain = p.c_subln + layer * 128 + 4 * h2_e;
      bf16_t* op = Ob + (size_t)(it.tok0 + q0w + qi_e - it.past) * OW + ocol + 8 * h2_e;
#pragma unroll
      for (int b = 0; b < NDV; ++b)
#pragma unroll
        for (int j = 0; j < 2; ++j) { const f32x4 ga = *(const f32x4*)(gain + 32 * b + 16 * j), gb = *(const f32x4*)(gain + 32 * b + 16 * j + 8);
          const f32x4 va = {O[b][8 * j] * rstd * ga[0], O[b][8 * j + 1] * rstd * ga[1], O[b][8 * j + 2] * rstd * ga[2], O[b][8 * j + 3] * rstd * ga[3]};
          const f32x4 vb = {O[b][8 * j + 4] * rstd * gb[0], O[b][8 * j + 5] * rstd * gb[1], O[b][8 * j + 6] * rstd * gb[2], O[b][8 * j + 7] * rstd * gb[3]};
          *(u32x4*)(op + 32 * b + 16 * j) = pair_swap(pack4(va), pack4(vb)); } }
    __syncthreads();
  }
}

DI void copy_item(const Params& p, int layer, int idx) {
  const int which = idx >> 5, bd = idx & 31;
  const size_t lb = (size_t)layer * DB + bd;
  const f32x4* src = (const f32x4*)((which ? p.cache_a_v : p.cache_a_k) + lb * 512 * 512 + 64 * 512);
  f32x4* dst = (f32x4*)(p.out + (which ? O_SAV : O_SAK) + lb * 512 * 512);
  int tid_ = threadIdx.x; asm volatile("" : "+v"(tid_));
#pragma unroll 4
  for (int i = tid_; i < 448 * 128; i += NTHREADS) __builtin_nontemporal_store(__builtin_nontemporal_load(src + i), dst + i);
}
#ifndef PROBE_ATT_FLAGS
#define PROBE_ATT_FLAGS 0
#endif
#ifndef PROBE_ATT_LO
#define PROBE_ATT_LO 0
#define PROBE_ATT_HI NITEMS
#endif
DI void attn_phase(const Params& p, int qidx, LAS unsigned char* lds) {
  const int layer = qidx & 1; const int i_lo = qidx >= 2 ? PROBE_ATT_LO : 0, i_hi = qidx >= 2 ? PROBE_ATT_HI : NITEMS;
  unsigned* head = (unsigned*)(p.ws + WS_CTL) + CW_QUEUE + 64 * qidx;
  LAS unsigned* slot = (LAS unsigned*)(lds + LDS_BYTES - 48);
  if (threadIdx.x == 0) slot[0] = atomicAdd(head, 1u);
  for (int k = 0;; ++k) {
    __syncthreads();
    const int idx = __builtin_amdgcn_readfirstlane((int)slot[k & 1]) + i_lo;
    if (threadIdx.x == 0) slot[(k + 1) & 1] = atomicAdd(head, 1u);
    if (idx >= i_hi) break;
    Item it = decode(p, layer, idx); it.pflags = qidx >= 2 ? PROBE_ATT_FLAGS : 0;
    if (it.mode == 3) { if (qidx < 2) copy_item(p, layer, it.h); continue; }
    if (it.past == 0) { if (it.mode == 0) run_item<0, false>(p, layer, it, lds); else if (it.mode == 1) run_item<1, false>(p, layer, it, lds); else run_item<2, false>(p, layer, it, lds); }
    else { if (it.mode == 0) run_item<0, true>(p, layer, it, lds); else if (it.mode == 1) run_item<1, true>(p, layer, it, lds); else run_item<2, true>(p, layer, it, lds); }
  }
}
}
#define XB_TMO      128
#define XB_XCNT(j)  (256  + 64 * (j))
#define XB_XSUB(j)  (1280 + 64 * (j))
#define XB_XGEN(j)  (2304 + 64 * (j))
#define XB_TOP      3328
#define XB_TOPGEN   3392
#define XCD_BAR_WORDS 3456
#define XB_SPIN_CAP (1u << 18)
DI unsigned xb_ld(unsigned* p)              { return __hip_atomic_load(p, __ATOMIC_RELAXED, __HIP_MEMORY_SCOPE_AGENT); }
DI unsigned xb_add(unsigned* p, unsigned v) { return __hip_atomic_fetch_add(p, v, __ATOMIC_RELAXED, __HIP_MEMORY_SCOPE_AGENT); }
DI unsigned xb_xcc_id() { return (unsigned)__builtin_amdgcn_s_getreg((3 << 11) | 20) & 0xFu; }
#define XB_SPIN(cond, bar) do { unsigned _sp = 0; while (cond) { __builtin_amdgcn_s_sleep(1); \
    if ((++_sp & 255u) == 0u) { if (xb_ld(&(bar)[XB_TMO])) break; if (_sp > XB_SPIN_CAP) { atomicAdd(&(bar)[XB_TMO], 1u); break; } } } } while (0)
struct XcdBarrier { unsigned* bar; unsigned x; volatile LAS unsigned* st; };
DI XcdBarrier xcd_barrier_post(unsigned* bar, volatile LAS unsigned* st) {
  XcdBarrier b; b.bar = bar; b.x = xb_xcc_id(); b.st = st;
  if (threadIdx.x == 0) (void)xb_add(&bar[XB_XCNT(b.x)], 1u);
  return b;
}
DI void xcd_barrier_complete(unsigned* bar, unsigned x, unsigned& nloc, unsigned& nx) {
  const unsigned G = gridDim.x * gridDim.y * gridDim.z;
  unsigned sum, cnt, mine, sp = 0u;
  for (;;) {
    sum = 0u; cnt = 0u; mine = 0u;
#pragma unroll
    for (unsigned j = 0; j < 16; ++j) { const unsigned c = xb_ld(&bar[XB_XCNT(j)]); sum += c; cnt += (c > 0u) ? 1u : 0u; mine = (j == x) ? c : mine; }
    if (sum == G) break;
    __builtin_amdgcn_s_sleep(1);
    if ((++sp & 255u) == 0u) { if (xb_ld(&bar[XB_TMO])) break; if (sp > XB_SPIN_CAP) { atomicAdd(&bar[XB_TMO], 1u); break; } }
  }
  nloc = mine > 0u ? mine : 1u; nx = cnt > 0u ? cnt : 1u;
}
DI void xcd_barrier(const XcdBarrier& b) {
  asm volatile("s_waitcnt vmcnt(0)" ::: "memory");
  __syncthreads();
  if (threadIdx.x == 0) {
    unsigned* bar = b.bar;
    __builtin_amdgcn_s_waitcnt(0);
    unsigned nloc = b.st[0], nx = b.st[1];
    if (nloc == 0u) { xcd_barrier_complete(bar, b.x, nloc, nx); b.st[0] = nloc; b.st[1] = nx; }
    const unsigned old = xb_add(&bar[XB_XSUB(b.x)], 1u);
    const unsigned gen = old / nloc;
    if (old + 1u == (gen + 1u) * nloc) {
      __builtin_amdgcn_fence(__ATOMIC_RELEASE, "agent");
      asm volatile("s_waitcnt vmcnt(0)" ::: "memory");
      const unsigned og = xb_add(&bar[XB_TOP], 1u);
      const unsigned tg = og / nx;
      if (og + 1u == (tg + 1u) * nx) xb_add(&bar[XB_TOPGEN], 1u);
      else XB_SPIN(xb_ld(&bar[XB_TOPGEN]) == tg, bar);
      __builtin_amdgcn_fence(__ATOMIC_ACQUIRE, "agent");
      xb_add(&bar[XB_XGEN(b.x)], 1u);
      asm volatile("s_waitcnt vmcnt(0)" ::: "memory");
    } else {
      XB_SPIN(xb_ld(&bar[XB_XGEN(b.x)]) == gen, bar);
      __builtin_amdgcn_fence(__ATOMIC_ACQUIRE, "agent");
      asm volatile("s_waitcnt vmcnt(0)" ::: "memory");
    }
  }
  __syncthreads();
}
constexpr int L_BARST = LDS_BYTES - 64;

#ifndef PROBE_P1_FLAGS
#define PROBE_P1_FLAGS 0
#endif
#ifndef PROBE_NULL_EPI
#define PROBE_NULL_EPI 0
#endif
#ifndef PROBE_MASK
#define PROBE_MASK 0
#endif
#define REPEAT(k) for (int rep_ = 0; rep_ < (((PROBE_MASK >> (k)) & 1) ? 2 : 1); ++rep_)
constexpr int NPHASE = 2 + 6 * NLAYER;
__global__ void __launch_bounds__(NTHREADS, 2) fwd_megakernel(Params p_k) {
  extern __shared__ __attribute__((aligned(16))) unsigned char lds_raw[];
  LAS unsigned char* lds = (LAS unsigned char*)lds_raw;
  cg::grid_group grid = cg::this_grid();
  const int lo = p_k.ph_lo, hi = p_k.ph_hi;
#define IN(k) (lo <= (k) && (k) < hi)
#define SEAM(k) do { if (IN(k) && IN((k) + 1)) xcd_barrier(bar); } while (0)
  const int G = gridDim.x, c = blockIdx.x;
  if (threadIdx.x < 2) ((LAS unsigned*)(lds + L_BARST))[threadIdx.x] = 0u;
  XcdBarrier bar; bar.bar = (unsigned*)(p_k.ws + WS_CTL) + CW_BAR; bar.x = 0; bar.st = (volatile LAS unsigned*)(lds + L_BARST);
  if (p_k.ph_lo < 0) grid.sync();
  bar = xcd_barrier_post((unsigned*)(p_k.ws + WS_CTL) + CW_BAR, (volatile LAS unsigned*)(lds + L_BARST));
  if (IN(0)) { p0_prologue(p_k, lds); if ((PROBE_MASK >> 6) & 1) { __syncthreads(); p0_prologue(p_k, lds); } }
  SEAM(0);
  for (int l = 0; l < NLAYER; ++l) {
    const int pb = 1 + 6 * l;
    const Params& p = p_k; unsigned char* ws = p.ws;
    if (IN(pb + 0)) REPEAT(0) {
      pg8::GemmDesc g{(const char*)(ws + WS_XB), (const char*)(ws + WS_WIN) + (size_t)l * INC * D * 2, D, D, D / 64, (size_t)256 * D * 2, (size_t)128 * D * 2};
      pg8::P1Order S; S.R1.init(TOK / 256, pg8::P1_NN, G, c);
      EpiP1 E{(const float*)(ws + WS_SS), (bf16_t*)(ws + WS_QKV), (bf16_t*)(ws + WS_GATE), p.b_gate + (size_t)l * 3 * D, p.out, l, rep_ == 1 ? PROBE_P1_FLAGS : 0, lds};
#if PROBE_NULL_EPI
      if (rep_ == 1) { EpiNull EN; pg8::gemm_phase<EpiNull, false, false, pg8::P1Order>(lds, g, S, EN); } else
#endif
      pg8::gemm_phase<EpiP1, false, false, pg8::P1Order>(lds, g, S, E);
    }
    SEAM(pb + 0);
    if (IN(pb + 1)) REPEAT(1) {
      for (int j = G - 1 - c; j < pg8::P1_DEFER; j += G) { pg8::OneUnit S1; S1.u = pg8::p1_deferred_unit(j);
        pg8::gemm_phase<EpiP1, false, false, pg8::OneUnit>(lds, p1_desc(ws, l), S1, p1_epi(p, l, lds)); }
      attn::attn_phase(p, l + 2 * rep_, lds); }
    SEAM(pb + 1);
    if (IN(pb + 2)) REPEAT(2) {
      pg8::GemmDesc g{(const char*)(ws + WS_O), (const char*)(ws + WS_WBR) + (size_t)l * D * OW * 2, OW, OW, OW / 64, (size_t)256 * OW * 2, (size_t)128 * OW * 2};
      pg8::StaticOrder S; S.init(TOKP / 256, D / 256, G, c);
      EpiP3 E{(const bf16_t*)(ws + WS_GATE), (bf16_t*)(ws + WS_H)};
      pg8::gemm_phase<EpiP3>(lds, g, S, E);
      pg8::GemmDesc gh = g; gh.b_tile = (size_t)128 * OW * 2;
      pg8::StaticOrder S2; S2.init(TOKS / 128, D / 128, G, c, TOKP / 128);
      EpiP3T<true, true> E2{(const bf16_t*)(ws + WS_GATE), (bf16_t*)(ws + WS_H)};
      pg8::gemm_phase<EpiP3T<true, true>, true, true>(lds, gh, S2, E2);
      if (rep_ == 0) { const int nidle = G - S2.nwg, f0 = l == 0 ? SL_03 : SL_13, n0 = l == 0 ? SN_03 : SN_13; if (nidle <= 0) late_transposes(p, lds, f0, n0, c, G); else if (c >= S2.nwg) late_transposes(p, lds, f0, n0, c - S2.nwg, nidle); }
    }
    SEAM(pb + 2);
    if (IN(pb + 3)) {
      pg8::GemmDesc g{(const char*)(ws + WS_H), (const char*)(ws + WS_WOUT) + (size_t)l * D * D * 2, D, D, D / 64, (size_t)256 * D * 2, (size_t)128 * D * 2};
      pg8::StaticOrder S; S.init(TOKP / 256, D / 256, G, c);
      EpiRes E{(float*)(ws + WS_X32), (bf16_t*)(ws + WS_XB), (float*)(ws + WS_SS), lds, l == 0 ? p.x_prompt : nullptr, l == 0 ? p.x_sample : nullptr};
      pg8::gemm_phase<EpiRes>(lds, g, S, E);
      pg8::GemmDesc gh = g; gh.b_tile = (size_t)128 * D * 2;
      pg8::StaticOrder S2; S2.init(TOKS / 128, D / 128, G, c, TOKP / 128);
      EpiResT<true, true> E2{(float*)(ws + WS_X32), (bf16_t*)(ws + WS_XB), (float*)(ws + WS_SS), lds, l == 0 ? p.x_prompt : nullptr, l == 0 ? p.x_sample : nullptr};
      pg8::gemm_phase<EpiResT<true, true>, true, true>(lds, gh, S2, E2);
      { const int nidle = G - S2.nwg, f0 = SL_04, n0 = l == 0 ? SN_04 : 0; if (nidle <= 0) late_transposes(p, lds, f0, n0, c, G); else if (c >= S2.nwg) late_transposes(p, lds, f0, n0, c - S2.nwg, nidle); }
    }
    SEAM(pb + 3);
    if (IN(pb + 4)) REPEAT(4) {
      pg8::GemmDesc g{(const char*)(ws + WS_XB), (const char*)(ws + WS_WUP) + (size_t)l * 2 * DFF * D * 2, D, D, D / 64, (size_t)128 * D * 2, (size_t)DFF * D * 2};
      pg8::StaticOrder S; S.init(TOKP / 256, DFF / 128, G, c);
      EpiP5F E{(const float*)(ws + WS_SS), (bf16_t*)(ws + WS_HF), p.out, p.conv_w + (size_t)l * 3 * DFF, p.conv_b + (size_t)l * DFF, p.state_conv + (size_t)l * DB * 2 * DFF, (float*)(ws + WS_SIDE), lds, l};
      pg8::gemm_phase<EpiP5F>(lds, g, S, E);
      pg8::StaticOrder S2; S2.init(TOKS / 128, DFF / 128, G, (c + G / 2) % G, TOKP / 128);
      EpiP5FT<true> E2{(const float*)(ws + WS_SS), (bf16_t*)(ws + WS_HF), p.out, p.conv_w + (size_t)l * 3 * DFF, p.conv_b + (size_t)l * DFF, p.state_conv + (size_t)l * DB * 2 * DFF, (float*)(ws + WS_SIDE), lds, l};
      pg8::gemm_phase<EpiP5FT<true>, false, true>(lds, g, S2, E2);
      if (rep_ == 0) {
        const int nfull = S.nwg % G, f0 = l == 0 ? SL_05 : SL_15, n0 = l == 0 ? SN_05 : SN_15;
        if (nfull <= 0 || nfull >= G) late_transposes(p, lds, f0, n0, c, G); else if (c >= nfull) late_transposes(p, lds, f0, n0, c - nfull, G - nfull); }
    }
    SEAM(pb + 4);
    if (IN(pb + 5)) {
      pg8::GemmDesc g{(const char*)(ws + WS_HF), (const char*)(ws + WS_WDN) + (size_t)l * D * DFF * 2, DFF, DFF, DFF / 64, (size_t)256 * DFF * 2, (size_t)128 * DFF * 2};
      pg8::StaticOrder S; S.init(TOKP / 256, D / 256, G, c);
      { pg8::Unit uu; for (int i = 0; S.next(i, uu); ++i) if (uu.pm < 64 && (uu.pm & 15) != 0) p6_fixup_panel(uu.pm, (const float*)(ws + WS_SIDE), p.conv_w + (size_t)l * 3 * DFF, (bf16_t*)(ws + WS_HF));
        asm volatile("s_waitcnt vmcnt(0)" ::: "memory"); __syncthreads(); }
      EpiRes E{(float*)(ws + WS_X32), (bf16_t*)(ws + WS_XB), (float*)(ws + WS_SS), lds, nullptr, nullptr};
      pg8::gemm_phase<EpiRes>(lds, g, S, E);
      pg8::GemmDesc gh = g; gh.b_tile = (size_t)128 * DFF * 2;
      pg8::StaticOrder S2; S2.init(TOKS / 128, D / 128, G, c, TOKP / 128);
      EpiResT<true, true> E2{(float*)(ws + WS_X32), (bf16_t*)(ws + WS_XB), (float*)(ws + WS_SS), lds, nullptr, nullptr};
      pg8::gemm_phase<EpiResT<true, true>, true, true>(lds, gh, S2, E2);
      if (l == 0) { const int nidle = G - S2.nwg; if (nidle <= 0) late_transposes(p, lds, SL_06, SN_06, c, G); else if (c >= S2.nwg) late_transposes(p, lds, SL_06, SN_06, c - S2.nwg, nidle); }
    }
    SEAM(pb + 5);
  }
  if (IN(NPHASE - 1)) { pfinal_norm(p_k); }
#undef IN
#undef SEAM
}

#ifndef MK_ONE_LAUNCH
#define MK_ONE_LAUNCH 1
#endif
extern "C" void kernel_launch(void* const* d_in, const int* in_sizes, int n_in, void* d_out, int out_size, void* d_ws, size_t ws_size, hipStream_t stream) {
  static int grid_blocks = 0;
  if (grid_blocks == 0) {
    int dev = 0, cus = 0, per_cu = 0;
    (void)hipGetDevice(&dev);
    (void)hipDeviceGetAttribute(&cus, hipDeviceAttributeMultiprocessorCount, dev);
    (void)hipFuncSetAttribute((const void*)fwd_megakernel, hipFuncAttributeMaxDynamicSharedMemorySize, LDS_BYTES);
    (void)hipOccupancyMaxActiveBlocksPerMultiprocessor(&per_cu, (const void*)fwd_megakernel, NTHREADS, LDS_BYTES);
    if (per_cu < 1) { fprintf(stderr, "kernel_launch: occupancy query says %d blocks/CU\n", per_cu); per_cu = 1; }
    grid_blocks = cus * per_cu;
    if (n_in != 24 || (size_t)out_size != O_END || ws_size < WS_END) { fprintf(stderr, "kernel_launch: unexpected problem (n_in %d out %d ws %zu, need %zu)\n", n_in, out_size, ws_size, (size_t)WS_END); grid_blocks = -1; }
  }
  if (grid_blocks < 0) return;
  Params p{};
  const float** f = (const float**)&p;
  for (int i = 0; i < 24; ++i) f[i] = (const float*)d_in[i];
  p.out = (float*)d_out; p.ws = (unsigned char*)d_ws;
#if MK_ONE_LAUNCH
  p.ph_lo = 0; p.ph_hi = NPHASE;
  (void)hipMemsetAsync((unsigned char*)d_ws + WS_CTL + (size_t)CW_BAR * 4, 0, (size_t)XCD_BAR_WORDS * 4, stream);
  { void* args[] = {&p};
    hipError_t e = hipLaunchCooperativeKernel((void*)fwd_megakernel, dim3(grid_blocks), dim3(NTHREADS), args, LDS_BYTES, stream);
    if (e != hipSuccess) fprintf(stderr, "cooperative launch failed: %s (grid %d)\n", hipGetErrorString(e), grid_blocks); }
#else
  for (int k = 0; k < NPHASE; ++k) { p.ph_lo = k; p.ph_hi = k + 1; void* args[] = {&p};
    hipError_t e = hipLaunchCooperativeKernel((void*)fwd_megakernel, dim3(grid_blocks), dim3(NTHREADS), args, LDS_BYTES, stream);
    if (e != hipSuccess) { fprintf(stderr, "launch %d failed: %s (grid %d)\n", k, hipGetErrorString(e), grid_blocks); break; } }
#endif
}
```

```cpp
#include <hip/hip_runtime.h>
#include <hip/hip_cooperative_groups.h>
#include <cstdio>
#include <cstdint>
namespace cg = cooperative_groups;

#define DI __device__ __forceinline__
#define LAS __attribute__((address_space(3)))
typedef unsigned short bf16_t;
typedef short bf16x8 __attribute__((ext_vector_type(8)));
typedef short s16x4 __attribute__((ext_vector_type(4)));
typedef float f32x2 __attribute__((ext_vector_type(2)));
typedef float f32x4 __attribute__((ext_vector_type(4)));
typedef float f32x8 __attribute__((ext_vector_type(8)));
typedef float f32x16 __attribute__((ext_vector_type(16)));
typedef unsigned u32x2 __attribute__((ext_vector_type(2)));
typedef unsigned u32x4 __attribute__((ext_vector_type(4)));
typedef __bf16 bfv4 __attribute__((ext_vector_type(4)));
typedef __bf16 bfv8 __attribute__((ext_vector_type(8)));

constexpr int D = 1024, SEQ = 4096, NB = 4, TOKP = NB * SEQ, DB = 32, DSEQ = 64, TOKS = DB * DSEQ, TOK = TOKP + TOKS;
constexpr int PAST = 1024, ALEN = 512, INC = 7680, DFF = 2816, NLAYER = 2;
constexpr int QKVW = 4608, GATEW = 3072, OW = 1536;
constexpr float EPS = 1e-6f, LOG2E = 1.4426950408889634f;

constexpr size_t O_YP = 0, O_YS = O_YP + (size_t)TOKP * D, O_PAK = O_YS + (size_t)TOKS * D, O_PAV = O_PAK + (size_t)2 * 4 * 512 * 512,
                 O_PBK = O_PAV + (size_t)2 * 4 * 512 * 512, O_PBV = O_PBK + (size_t)2 * TOKP * 512, O_PCK = O_PBV + (size_t)2 * TOKP * 512,
                 O_PCV = O_PCK + (size_t)2 * TOKP * 512, O_PCONV = O_PCV + (size_t)2 * TOKP * 512, O_SAK = O_PCONV + (size_t)2 * 4 * 2 * DFF,
                 O_SAV = O_SAK + (size_t)2 * DB * 512 * 512, O_SBK = O_SAV + (size_t)2 * DB * 512 * 512, O_SBV = O_SBK + (size_t)2 * TOKS * 512,
                 O_SCK = O_SBV + (size_t)2 * TOKS * 512, O_SCV = O_SCK + (size_t)2 * TOKS * 512, O_SCONV = O_SCV + (size_t)2 * TOKS * 512,
                 O_END = O_SCONV + (size_t)2 * DB * 2 * DFF;

constexpr size_t MiB = 1u << 20;
constexpr size_t WS_CTL = 0;
constexpr size_t WS_WIN = 1 * MiB;
constexpr size_t WS_WBR = WS_WIN + (size_t)2 * INC * D * 2;
constexpr size_t WS_WOUT = WS_WBR + (size_t)2 * D * OW * 2;
constexpr size_t WS_WUP = WS_WOUT + (size_t)2 * D * D * 2;
constexpr size_t WS_WDN = WS_WUP + (size_t)2 * 2 * DFF * D * 2;
constexpr size_t WS_XB = WS_WDN + (size_t)2 * D * DFF * 2;
constexpr size_t WS_X32 = WS_XB + (size_t)TOK * D * 2;
constexpr size_t WS_SS = WS_X32 + (size_t)TOK * D * 4;
constexpr size_t WS_SIDE = WS_SS + (size_t)TOK * 8 * 4;
constexpr size_t WS_O = WS_SIDE + (size_t)3 * 72 * 2 * DFF * 4;
constexpr size_t WS_H = WS_O + (size_t)TOK * OW * 2;
constexpr size_t WS_HF = WS_H + (size_t)TOK * D * 2;
constexpr size_t WS_QKV = WS_HF + (size_t)TOK * DFF * 2;
constexpr size_t WS_GATE = WS_QKV + (size_t)TOK * QKVW * 2;
constexpr size_t WS_END = WS_GATE + (size_t)TOK * GATEW * 2;
constexpr int CW_QUEUE = 64;
constexpr int CW_FIN = 512;
constexpr int CW_LAM = 1024;
constexpr int CW_T5 = 2048;
constexpr int CW_BAR = 8192;

constexpr int LDS_BYTES = 160 * 1024;
constexpr int NTHREADS = 512;

DI u32x4 pack8(f32x4 a, f32x4 b) { f32x8 v = {a[0], a[1], a[2], a[3], b[0], b[1], b[2], b[3]}; return __builtin_bit_cast(u32x4, __builtin_convertvector(v, bfv8)); }
DI u32x2 pack4(f32x4 a) { return __builtin_bit_cast(u32x2, __builtin_convertvector(a, bfv4)); }
DI float bflo(unsigned w) { return __uint_as_float(w << 16); }
DI float bfhi(unsigned w) { return __uint_as_float(w & 0xffff0000u); }
DI float wave_sum(float v) {
#pragma unroll
  for (int o = 1; o < 64; o <<= 1) v += __shfl_xor(v, o);
  return v;
}
DI float fast_rcp(float x) { return __builtin_amdgcn_rcpf(x); }
DI float fast_exp2(float x) { return __builtin_amdgcn_exp2f(x); }
DI float fast_log2(float x) { return __builtin_amdgcn_logf(x); }

DI LAS unsigned char* opaque_lds(LAS unsigned char* p) { unsigned v = (unsigned)(__UINTPTR_TYPE__)p; asm volatile("" : "+s"(v)); return (LAS unsigned char*)(__UINTPTR_TYPE__)v; }

struct Params {
  const float* x_prompt; const float* x_sample;
  const float* cache_a_k; const float* cache_a_v; const float* cache_b_k; const float* cache_b_v; const float* cache_c_k; const float* cache_c_v;
  const float* state_conv; const float* norm_mix; const float* w_in; const float* b_gate; const float* a_rel_bias; const float* t5_bias;
  const float* c_lambda; const float* c_subln; const float* w_branch; const float* w_out; const float* norm_ffn; const float* w_up;
  const float* conv_w; const float* conv_b; const float* w_down; const float* norm_final;
  float* out; unsigned char* ws;
  int ph_lo, ph_hi;
};

struct TItem { const float* W; const float* ks; bf16_t* WT; int N, dst_ld, dst_col, item; };
DI void p0_tload(const TItem& d, float (&wv)[32], int lane) {
  const int nblk = d.N / 32, kb = d.item / nblk, nb = d.item % nblk, k0 = 64 * kb, n0 = 32 * nb;
#pragma unroll
  for (int i = 0; i < 32; ++i) wv[i] = __builtin_nontemporal_load(&d.W[(size_t)(k0 + 2 * i + (lane >> 5)) * d.N + n0 + (lane & 31)]);
}
DI void p0_tfinish(const TItem& d, const float (&wv)[32], LAS float* scr, int lane) {
  const int nblk = d.N / 32, kb = d.item / nblk, nb = d.item % nblk, k0 = 64 * kb, n0 = 32 * nb;
#pragma unroll
  for (int i = 0; i < 32; ++i) { const int kk = 2 * i + (lane >> 5); float v = wv[i]; if (d.ks) v *= d.ks[k0 + kk]; scr[kk * 33 + (lane & 31)] = v; }
  asm volatile("s_waitcnt lgkmcnt(0)" ::: "memory");
  const int c = lane & 7;
#pragma unroll
  for (int j = 0; j < 4; ++j) { const int n = (lane >> 3) + 8 * j; const LAS float* s = scr + (8 * c) * 33 + n;
    f32x4 a = {s[0 * 33], s[1 * 33], s[2 * 33], s[3 * 33]}, b = {s[4 * 33], s[5 * 33], s[6 * 33], s[7 * 33]};
    *(u32x4*)(d.WT + (size_t)(n0 + n) * d.dst_ld + d.dst_col + k0 + 8 * c) = pack8(a, b); }
  asm volatile("s_waitcnt lgkmcnt(0)" ::: "memory");
}

DI int t5_bucket_of(int rel) {
  const int n = rel < 0 ? -rel : rel; int f;
  if (n < 8) f = n; else if (n < 12) f = 8; else if (n < 16) f = 9; else if (n < 23) f = 10; else if (n < 32) f = 11; else if (n < 46) f = 12; else if (n < 64) f = 13; else if (n < 91) f = 14; else f = 15;
  return (rel > 0 ? 16 : 0) + f;
}

constexpr int I_IN = (D / 64) * (INC / 32), I_BR = (512 / 64) * (D / 32), I_OUT = (D / 64) * (D / 32), I_UP = (D / 64) * (2 * DFF / 32), I_DN = (DFF / 64) * (D / 32);
constexpr int PER_LAYER = I_IN + 3 * I_BR + I_OUT + I_UP + I_DN;
constexpr int P0_ITEMS = I_IN + 3 * I_BR;
constexpr int SL_03 = P0_ITEMS, SN_03 = I_OUT + I_UP;
constexpr int SL_05 = PER_LAYER - I_DN, SN_05 = I_DN;
constexpr int SL_04 = PER_LAYER, SN_04 = 2048;
constexpr int SL_06 = SL_04 + SN_04, SN_06 = 4096;
constexpr int SL_13 = SL_06 + SN_06, SN_13 = 2 * PER_LAYER - I_DN - SL_13;
constexpr int SL_15 = 2 * PER_LAYER - I_DN, SN_15 = I_DN;
static_assert(NLAYER == 2 && SL_06 + SN_06 >= PER_LAYER + I_IN + 3 * I_BR + I_OUT && SN_13 >= 0 && SN_13 <= 4096, "late transpose slots");
DI TItem p0_titem(const Params& p, int it) {
  const int l = it / PER_LAYER; int r = it % PER_LAYER;
  if (r < I_IN) return TItem{p.w_in + (size_t)l * D * INC, p.norm_mix + l * D, (bf16_t*)(p.ws + WS_WIN) + (size_t)l * INC * D, INC, D, 0, r};
  r -= I_IN;
  if (r < 3 * I_BR) { const int n = r / I_BR; return TItem{p.w_branch + ((size_t)l * 3 + n) * 512 * D, nullptr, (bf16_t*)(p.ws + WS_WBR) + (size_t)l * D * OW, D, OW, 512 * n, r % I_BR}; }
  r -= 3 * I_BR;
  if (r < I_OUT) return TItem{p.w_out + (size_t)l * D * D, nullptr, (bf16_t*)(p.ws + WS_WOUT) + (size_t)l * D * D, D, D, 0, r};
  r -= I_OUT;
  if (r < I_UP) return TItem{p.w_up + (size_t)l * D * 2 * DFF, p.norm_ffn + l * D, (bf16_t*)(p.ws + WS_WUP) + (size_t)l * 2 * DFF * D, 2 * DFF, D, 0, r};
  r -= I_UP;
  return TItem{p.w_down + (size_t)l * DFF * D, nullptr, (bf16_t*)(p.ws + WS_WDN) + (size_t)l * D * DFF, D, DFF, 0, r};
}
DI void p0_weight_item(const Params& p, int it, LAS float* scr, int lane) { const TItem d = p0_titem(p, it); float wv[32]; p0_tload(d, wv, lane); p0_tfinish(d, wv, scr, lane); }
DI void late_transposes(const Params& p, LAS unsigned char* lds_in, int first, int count, int w_block, int n_blocks) {
  LAS unsigned char* lds = opaque_lds(lds_in);
  int tid_ = threadIdx.x; asm volatile("" : "+v"(tid_));
  const int lane = tid_ & 63, wave = tid_ >> 6;
  LAS float* scr = (LAS float*)(lds + wave * 8448);
  const int nw = n_blocks * 8;
  for (int j = w_block * 8 + wave; j < count; j += 2 * nw) {
    const bool two = j + nw < count;
    const TItem a = p0_titem(p, first + j), b = p0_titem(p, first + (two ? j + nw : j));
    float wa[32], wb[32];
    p0_tload(a, wa, lane); p0_tload(b, wb, lane);
    p0_tfinish(a, wa, scr, lane);
    if (two) p0_tfinish(b, wb, scr, lane);
  }
}
DI void p0_prologue(const Params& p, LAS unsigned char* lds_in) {
  LAS unsigned char* lds = opaque_lds(lds_in);
  int tid_ = threadIdx.x; asm volatile("" : "+v"(tid_));
  const int tid = tid_, lane = tid & 63, wave = tid >> 6;
  const int gw = blockIdx.x * 8 + wave, NGW = gridDim.x * 8;
  unsigned* ctl = (unsigned*)(p.ws + WS_CTL);
  if (blockIdx.x == 0) {
    if (tid < 4) ctl[CW_QUEUE + 64 * tid] = 0u;
    if (tid == 4) ctl[CW_FIN] = 0u;
    if (wave == 1) {
      for (int l = 0; l < NLAYER; ++l) { const float* lp = p.c_lambda + l * 256; const float a = wave_sum(lp[lane] * lp[64 + lane]), b = wave_sum(lp[128 + lane] * lp[192 + lane]);
        const float lam_init = 0.8f - 0.6f * expf(-0.3f * (float)l);
        if (lane == 0) ((float*)ctl)[CW_LAM + l] = expf(a) - expf(b) + lam_init; }
    }
    for (int i = tid; i < 4 * 192; i += NTHREADS) { const int h = i / 192, idx = i % 192; int rel = idx - 127; if (rel > 63) rel = 63;
      ((float*)ctl)[CW_T5 + i] = p.t5_bias[t5_bucket_of(rel) * 4 + h] - p.t5_bias[15 * 4 + h]; }
  }
  LAS float* scr = (LAS float*)(lds + wave * 8448);
  for (int j = gw; j < P0_ITEMS; j += 2 * NGW) {
    const bool two = j + NGW < P0_ITEMS;
    const TItem a = p0_titem(p, j), b = p0_titem(p, two ? j + NGW : j);
    float wa[32], wb[32];
    p0_tload(a, wa, lane); p0_tload(b, wb, lane);
    p0_tfinish(a, wa, scr, lane);
    if (two) p0_tfinish(b, wb, scr, lane);
  }
  bf16_t* XB = (bf16_t*)(p.ws + WS_XB); float* SS = (float*)(p.ws + WS_SS);
#pragma unroll 3
  for (int m = gw; m < TOK; m += NGW) {
    const float* src = m < TOKP ? p.x_prompt + (size_t)m * D : p.x_sample + (size_t)(m - TOKP) * D;
    float s = 0.f;
#pragma unroll
    for (int j = 0; j < 4; ++j) { const f32x4 v = __builtin_nontemporal_load(&((const f32x4*)src)[lane + 64 * j]); ((u32x2*)(XB + (size_t)m * D))[lane + 64 * j] = pack4(v);
      s += (v[0] * v[0] + v[1] * v[1]) + (v[2] * v[2] + v[3] * v[3]); }
    s = wave_sum(s);
    if (lane < 8) SS[(size_t)m * 8 + lane] = lane == 0 ? s : 0.f;
  }
}

namespace pg8 {
constexpr int BM = 256, BK = 64, HALF = 128, HTB = HALF * BK * 2, STAGE_BYTES = 8 * HTB, NXCD = 8, WGM = 8;
DI int lds_byte(int r, int c) { const int st = (r >> 4) * 2 + (c >> 5), rr = r & 15, cc = c & 31, ob = rr * 64 + cc * 2; return st * 1024 + (ob ^ (((ob >> 9) & 1) << 5)); }
DI void stage_rc(int b, int& R, int& C) { const int st = b / 1024, sb = b % 1024, swz = sb ^ (((sb >> 9) & 1) << 5); R = (st >> 1) * 16 + swz / 64; C = (st & 1) * 32 + (swz % 64) / 2; }
DI int perm32(int rho) { const int n = rho >> 4, i = rho & 15; return 8 * (i >> 2) + 4 * n + (i & 3); }
struct Unit { int pm, pn; };
struct GemmDesc { const char* A; const char* B; int lda, ldb, nt; size_t b_tile, b_half; };
struct StaticOrder {
  int nM, nN, nwg, G, c, pm0;
  DI void init(int nM_, int nN_, int G_, int c_, int pm0_ = 0) { nM = nM_; nN = nN_; nwg = nM * nN; G = G_; c = c_; pm0 = pm0_; }
  DI bool next(int i, Unit& u) const {
    const long L = (long)i * G + c; if (L >= nwg) return false;
    int wgid = (int)L; { const int q = nwg / NXCD, r = nwg % NXCD, xcd = wgid % NXCD, off = wgid / NXCD; wgid = (xcd < r ? xcd * (q + 1) : r * (q + 1) + (xcd - r) * q) + off; }
    const int nig = WGM * nN, gid = wgid / nig, fm = gid * WGM, gsz = (nM - fm) < WGM ? (nM - fm) : WGM;
    u.pm = pm0 + fm + ((wgid % nig) % gsz); u.pn = (wgid % nig) / gsz; return true;
  }
};
constexpr int P1_NN = 28, P1_EXTRA = 32, P1_DEFER = 72 + (72 - P1_EXTRA);
struct P1Order {
  StaticOrder R1;
  DI bool next(int i, Unit& u) const {
    if (R1.next(i, u)) return true;
    const long L = (long)i * R1.G + R1.c - R1.nwg; if (L >= P1_EXTRA) return false;
    u.pm = (int)L; u.pn = P1_NN; return true;
  }
};
DI Unit p1_deferred_unit(int j) { Unit u; if (j < 72) { u.pm = j; u.pn = P1_NN + 1; } else { u.pm = P1_EXTRA + (j - 72); u.pn = P1_NN; } return u; }
struct OneUnit { Unit u; DI bool next(int i, Unit& o) const { if (i != 0) return false; o = u; return true; } };
template <class Epi, bool HALFN = false, bool HALFM = false, class Sched = StaticOrder>
DI void gemm_phase(LAS unsigned char* lds_in, const GemmDesc g, const Sched& S, const Epi& E) {
  LAS unsigned char* lds = opaque_lds(lds_in);
  int tid_ = threadIdx.x; asm volatile("" : "+v"(tid_));
  const int tid = tid_, wid = __builtin_amdgcn_readfirstlane(tid >> 6), lane = tid & 63, wr = wid >> 2, wc = wid & 3, fr = lane & 15, fq = lane >> 4;
  const int nt = g.nt;
  unsigned voffA[2], voffB[2];
#pragma unroll
  for (int i = 0; i < 2; ++i) { int R, C; stage_rc(tid * 16 + i * 8192, R, C); const int Rb = Epi::PERM ? ((R & ~31) + perm32(R & 31)) : R;
    voffA[i] = (unsigned)(R * g.lda + C) * 2u; voffB[i] = (unsigned)(Rb * g.ldb + C) * 2u; }
  const size_t kstep = (size_t)(BK * 2);
  const size_t hsA = (size_t)HALF * g.lda * 2, tsA = HALFM ? hsA : 2 * hsA, hsB = g.b_half, tsB = g.b_tile;
  const unsigned ldsw = (unsigned)wid * 1024u;
  const int aoff = lds_byte(wr * 64 + fr, fq * 8), boff = lds_byte(wc * 32 + fr, fq * 8);
#define PG8_SA(b, h) (((b) * 2 + (h)) * HTB)
#define PG8_SB(b, h) ((4 + (b) * 2 + (h)) * HTB)
#define PG8_STAGE(bufoff, gbase, voff) do { _Pragma("unroll") for (int _i = 0; _i < 2; ++_i) \
    __builtin_amdgcn_global_load_lds((const unsigned*)((const char*)(gbase) + (voff)[_i]), (LAS unsigned*)(lds + (bufoff) + ldsw + _i * 8192), 16, 0, 0); } while (0)
#define PG8_LDA(dst, b, h) do { _Pragma("unroll") for (int m = 0; m < 4; ++m) _Pragma("unroll") for (int k = 0; k < 2; ++k) dst[m][k] = *(const LAS bf16x8*)(lds + PG8_SA(b, h) + aoff + m * 2048 + k * 1024); } while (0)
#define PG8_LDB(dst, b, h) do { _Pragma("unroll") for (int n = 0; n < 2; ++n) _Pragma("unroll") for (int k = 0; k < 2; ++k) dst[n][k] = *(const LAS bf16x8*)(lds + PG8_SB(b, h) + boff + n * 2048 + k * 1024); } while (0)
#define PG8_MMA(ai, bj, At, Bt) do { __builtin_amdgcn_s_setprio(1); _Pragma("unroll") for (int m = 0; m < 4; ++m) _Pragma("unroll") for (int n = 0; n < 2; ++n) _Pragma("unroll") for (int k = 0; k < 2; ++k) \
    acc[ai][bj][m][n] = __builtin_amdgcn_mfma_f32_16x16x32_bf16(Bt[n][k], At[m][k], acc[ai][bj][m][n], 0, 0, 0); __builtin_amdgcn_s_setprio(0); } while (0)
#define PG8_WAIT_V(n) asm volatile("s_waitcnt vmcnt(" #n ")" ::: "memory")
#define PG8_WAIT_LOOP do { if constexpr (HALFM && HALFN) PG8_WAIT_V(4); else if constexpr (HALFM || HALFN) PG8_WAIT_V(6); else PG8_WAIT_V(8); } while (0)
#define PG8_WAIT_L(n) asm volatile("s_waitcnt lgkmcnt(" #n ")" ::: "memory")
#define PG8_BAR __builtin_amdgcn_s_barrier()
#define PG8_SCHED __builtin_amdgcn_sched_barrier(0)
  Unit cur, nxt; int ui = 0;
  if (!S.next(0, cur)) return;
  f32x4 acc[2][2][4][2];
#pragma unroll
  for (int a = 0; a < 2; ++a)
#pragma unroll
    for (int b = 0; b < 2; ++b)
#pragma unroll
      for (int m = 0; m < 4; ++m)
#pragma unroll
        for (int n = 0; n < 2; ++n) acc[a][b][m][n] = (f32x4){0.f, 0.f, 0.f, 0.f};
  bf16x8 At[4][2], B0[2][2], B1[2][2];
  const char* cA = g.A + (size_t)cur.pm * tsA; const char* cB = g.B + (size_t)cur.pn * tsB;
  f32x4 ssv = {0.f, 0.f, 0.f, 0.f};
  if constexpr (Epi::HAS_RS) ssv = E.prefetch(cur, tid);
  PG8_STAGE(PG8_SB(0, 0), cB, voffB); if constexpr (!HALFN) PG8_STAGE(PG8_SB(0, 1), cB + hsB, voffB); PG8_STAGE(PG8_SA(0, 0), cA, voffA); if constexpr (!HALFM) PG8_STAGE(PG8_SA(0, 1), cA + hsA, voffA);
  if (wr == 1) PG8_BAR;
  if constexpr (HALFM) PG8_WAIT_V(0); else PG8_WAIT_V(2);
  PG8_BAR;
  PG8_STAGE(PG8_SB(1, 0), cB + kstep, voffB); PG8_STAGE(PG8_SA(1, 0), cA + kstep, voffA); if constexpr (!HALFN) PG8_STAGE(PG8_SB(1, 1), cB + hsB + kstep, voffB);
  if constexpr (HALFN) PG8_WAIT_V(4); else PG8_WAIT_V(6);
  PG8_BAR;
  for (;;) {
    const bool has_next = S.next(ui + 1, nxt);
    const char* nA = has_next ? g.A + (size_t)nxt.pm * tsA : cA; const char* nB = has_next ? g.B + (size_t)nxt.pn * tsB : cB;
    for (int t = 0; t < nt; t += 2) {
      const bool last = (t == nt - 2);
      const char* a1 = cA + (size_t)(t + 1) * kstep;
      const char* a2 = last ? nA : cA + (size_t)(t + 2) * kstep; const char* b2 = last ? nB : cB + (size_t)(t + 2) * kstep;
      const char* a3 = a2 + kstep; const char* b3 = b2 + kstep;
      if constexpr (Epi::HAS_MID) { if (t == 8 || t == 16) E.mid(acc, cur, t, wr, wc, fr, fq); }
      PG8_LDB(B0, 0, 0); if constexpr (!HALFN) PG8_LDB(B1, 0, 1); PG8_SCHED; PG8_LDA(At, 0, 0); if constexpr (!HALFM) PG8_STAGE(PG8_SA(1, 1), a1 + hsA, voffA);
      PG8_WAIT_LOOP; PG8_WAIT_L(0); PG8_BAR; PG8_MMA(0, 0, At, B0); if constexpr (!HALFN) PG8_MMA(0, 1, At, B1); PG8_BAR; PG8_SCHED;
      if constexpr (!HALFM) PG8_LDA(At, 0, 1); PG8_STAGE(PG8_SB(0, 0), b2, voffB); if constexpr (!HALFN) PG8_STAGE(PG8_SB(0, 1), b2 + hsB, voffB); PG8_STAGE(PG8_SA(0, 0), a2, voffA);
      PG8_WAIT_LOOP; PG8_WAIT_L(0); PG8_BAR; if constexpr (!HALFM) { PG8_MMA(1, 0, At, B0); if constexpr (!HALFN) PG8_MMA(1, 1, At, B1); } PG8_BAR; PG8_SCHED;
      PG8_LDB(B0, 1, 0); if constexpr (!HALFN) PG8_LDB(B1, 1, 1); PG8_SCHED; PG8_LDA(At, 1, 0); if constexpr (!HALFM) PG8_STAGE(PG8_SA(0, 1), a2 + hsA, voffA);
      PG8_WAIT_LOOP; PG8_WAIT_L(0); PG8_BAR; PG8_MMA(0, 0, At, B0); if constexpr (!HALFN) PG8_MMA(0, 1, At, B1); PG8_BAR; PG8_SCHED;
      if constexpr (!HALFM) PG8_LDA(At, 1, 1); PG8_STAGE(PG8_SB(1, 0), b3, voffB); if constexpr (!HALFN) PG8_STAGE(PG8_SB(1, 1), b3 + hsB, voffB); PG8_STAGE(PG8_SA(1, 0), a3, voffA);
      PG8_WAIT_LOOP; PG8_WAIT_L(0); PG8_BAR; if constexpr (!HALFM) { PG8_MMA(1, 0, At, B0); if constexpr (!HALFN) PG8_MMA(1, 1, At, B1); } PG8_BAR; PG8_SCHED;
    }
    if (wr == 0) PG8_BAR;
    if constexpr (Epi::HAS_RS) { E.stash(ssv, cur, tid, lds); PG8_WAIT_L(0); PG8_BAR; asm volatile("" ::: "memory"); }
    E(acc, cur, wr, wc, fr, fq);
    if (!has_next) break;
#pragma unroll
    for (int a = 0; a < 2; ++a)
#pragma unroll
      for (int b = 0; b < 2; ++b)
#pragma unroll
        for (int m = 0; m < 4; ++m)
#pragma unroll
          for (int n = 0; n < 2; ++n) acc[a][b][m][n] = (f32x4){0.f, 0.f, 0.f, 0.f};
    cur = nxt; cA = nA; cB = nB; ++ui;
    if constexpr (Epi::HAS_RS) ssv = E.prefetch(cur, tid);
    if (wr == 1) PG8_BAR;
  }
  PG8_WAIT_V(0);
  PG8_BAR;
#undef PG8_SA
#undef PG8_SB
#undef PG8_STAGE
#undef PG8_LDA
#undef PG8_LDB
#undef PG8_MMA
#undef PG8_WAIT_V
#undef PG8_WAIT_LOOP
#undef PG8_WAIT_L
#undef PG8_BAR
#undef PG8_SCHED
}
}
using pg8::Unit;
DI f32x4 ss_load(const float* SS, int r) { const f32x4* q = (const f32x4*)(SS + (size_t)r * 8); return q[0] + q[1]; }
DI float ss_to_rs(const f32x4& a) { return __builtin_amdgcn_rsqf(((a[0] + a[1]) + (a[2] + a[3])) * (1.0f / D) + EPS); }
DI float row_rs(const float* SS, int r) { return ss_to_rs(ss_load(SS, r)); }
DI float sigmoidf_(float x) { return fast_rcp(1.0f + fast_exp2(-x * LOG2E)); }

struct EpiP1 {
  static constexpr bool PERM = true, HAS_MID = false, HAS_RS = true;
  const float* SS; bf16_t* QKV; bf16_t* GATE; const float* bgate; float* out; int layer; int probe_flags; LAS unsigned char* lds;
  DI void mid(f32x4 (&)[2][2][4][2], const Unit&, int, int, int, int, int) const {}
  DI f32x4 prefetch(const Unit& u, int tid) const {
    f32x4 v = {0.f, 0.f, 0.f, 0.f};
    if (tid < 256) v = ss_load(SS, u.pm * 256 + tid);
    return v;
  }
  DI void stash(const f32x4& v, const Unit& u, int tid, LAS unsigned char* l) const {
    if (tid < 256) *(LAS float*)(l + 131072 + 12288 + tid * 4) = ss_to_rs(v);
  }
  DI void operator()(f32x4 (&acc)[2][2][4][2], const Unit& u, int wr, int wc, int fr, int fq) const {
    const int pn = u.pn, rin0 = wr * 64 + fr, row0 = u.pm * 256 + rin0;
    float rs[2][4];
#pragma unroll
    for (int ai = 0; ai < 2; ++ai)
#pragma unroll
      for (int m = 0; m < 4; ++m) rs[ai][m] = *(const LAS float*)(lds + 131072 + 12288 + (rin0 + ai * 128 + m * 16) * 4);
    if (pn < 18) {
      const int colq = pn * 256 + wc * 32 + 8 * fq;
#pragma unroll
      for (int ai = 0; ai < 2; ++ai)
#pragma unroll
        for (int m = 0; m < 4; ++m) {
          const int rin = rin0 + ai * 128 + m * 16, r = u.pm * 256 + rin; const float s = rs[ai][m];
          bf16_t* rowp = QKV + (size_t)r * QKVW + colq;
#pragma unroll
          for (int bj = 0; bj < 2; ++bj) { const f32x4 v0 = acc[ai][bj][m][0] * s, v1 = acc[ai][bj][m][1] * s;
            { const u32x4 pk = pack8(v0, v1); if (!(probe_flags & 2)) *(u32x4*)(rowp + bj * 128) = pk; else asm volatile("" :: "v"(pk)); }
            }
        }
    } else {
      const int gi = pn - 18, nb = gi >> 2, colg = (gi & 3) * 256 + wc * 32 + 8 * fq;
      f32x4 bv[2][2];
#pragma unroll
      for (int bj = 0; bj < 2; ++bj) { bv[bj][0] = *(const f32x4*)(bgate + nb * D + colg + bj * 128); bv[bj][1] = *(const f32x4*)(bgate + nb * D + colg + bj * 128 + 4); }
#pragma unroll
      for (int ai = 0; ai < 2; ++ai)
#pragma unroll
        for (int m = 0; m < 4; ++m) { const int r = row0 + ai * 128 + m * 16; const float s = rs[ai][m];
          bf16_t* rowp = GATE + (size_t)r * GATEW + gi * 256 + wc * 32 + 8 * fq;
#pragma unroll
          for (int bj = 0; bj < 2; ++bj) { f32x4 v0 = acc[ai][bj][m][0] * s + bv[bj][0], v1 = acc[ai][bj][m][1] * s + bv[bj][1];
#pragma unroll
            for (int j = 0; j < 4; ++j) { v0[j] = 1.0f + fast_exp2(fminf(-v0[j] * LOG2E, 100.0f)); v1[j] = 1.0f + fast_exp2(fminf(-v1[j] * LOG2E, 100.0f)); }
            { const u32x4 pk = pack8(v0, v1); if (!(probe_flags & 2)) __builtin_nontemporal_store(pk, (u32x4*)(rowp + bj * 128)); else asm volatile("" :: "v"(pk)); } } }
    }
  }
};

template <bool HALFN, bool HALFM = false> struct EpiP3T {
  static constexpr bool PERM = true, HAS_MID = true, HAS_RS = false;
  const bf16_t* GATE; bf16_t* H;
  DI void mid(f32x4 (&acc)[2][2][4][2], const Unit& u, int t, int wr, int wc, int fr, int fq) const {
    const int nb = (t >> 3) - 1;
    const bf16_t* gp = GATE + (size_t)(u.pm * (HALFM ? 128 : 256) + wr * 64 + fr) * GATEW + nb * D + u.pn * (HALFN ? 128 : 256) + wc * 32 + 8 * fq;
    constexpr int NSB = (HALFM ? 1 : 2) * 2, NBJ = HALFN ? 1 : 2;
    u32x4 gA[2][2][2] = {}, gB[2][2][2] = {};
#define P3_LOAD(G_, k_) do { _Pragma("unroll") for (int mm = 0; mm < 2; ++mm) _Pragma("unroll") for (int bj = 0; bj < NBJ; ++bj) { \
      const bf16_t* q = gp + (size_t)(((k_) >> 1) * 128 + (2 * ((k_) & 1) + mm) * 16) * GATEW + bj * 128; G_[0][mm][bj] = *(const u32x4*)q; G_[1][mm][bj] = *(const u32x4*)(q + D); } asm volatile("" ::: "memory"); } while (0)
#define P3_APPLY(G_, k_) do { _Pragma("unroll") for (int mm = 0; mm < 2; ++mm) _Pragma("unroll") for (int bj = 0; bj < NBJ; ++bj) _Pragma("unroll") for (int n = 0; n < 2; ++n) { \
      const unsigned a0 = G_[0][mm][bj][2 * n], a1 = G_[0][mm][bj][2 * n + 1], b0 = G_[1][mm][bj][2 * n], b1 = G_[1][mm][bj][2 * n + 1]; f32x4& c = acc[(k_) >> 1][bj][2 * ((k_) & 1) + mm][n]; \
      c[0] *= bflo(b0) * fast_rcp(bflo(a0)); c[1] *= bfhi(b0) * fast_rcp(bfhi(a0)); c[2] *= bflo(b1) * fast_rcp(bflo(a1)); c[3] *= bfhi(b1) * fast_rcp(bfhi(a1)); } asm volatile("" ::: "memory"); } while (0)
    P3_LOAD(gA, 0); P3_LOAD(gB, 1); P3_APPLY(gA, 0);
    if (NSB == 4) { P3_LOAD(gA, 2); P3_APPLY(gB, 1); P3_LOAD(gB, 3); P3_APPLY(gA, 2); P3_APPLY(gB, 3); }
    else P3_APPLY(gB, 1);
#undef P3_LOAD
#undef P3_APPLY
  }
  DI void operator()(f32x4 (&acc)[2][2][4][2], const Unit& u, int wr, int wc, int fr, int fq) const {
    const int row0 = u.pm * (HALFM ? 128 : 256) + wr * 64 + fr, col0 = u.pn * (HALFN ? 128 : 256) + wc * 32 + 8 * fq;
    const bf16_t* gp = GATE + (size_t)row0 * GATEW + 2 * D + col0; bf16_t* hp = H + (size_t)row0 * D + col0;
    constexpr int NSB = (HALFM ? 1 : 2) * 2, NBJ = HALFN ? 1 : 2;
    u32x4 gA[2][2] = {}, gB[2][2] = {};
#define P3F_LOAD(G_, k_) do { _Pragma("unroll") for (int mm = 0; mm < 2; ++mm) _Pragma("unroll") for (int bj = 0; bj < NBJ; ++bj) \
      G_[mm][bj] = *(const u32x4*)(gp + (size_t)(((k_) >> 1) * 128 + (2 * ((k_) & 1) + mm) * 16) * GATEW + bj * 128); asm volatile("" ::: "memory"); } while (0)
#define P3F_APPLY(G_, k_) do { _Pragma("unroll") for (int mm = 0; mm < 2; ++mm) _Pragma("unroll") for (int bj = 0; bj < NBJ; ++bj) { const u32x4 g = G_[mm][bj]; \
      f32x4 v0 = acc[(k_) >> 1][bj][2 * ((k_) & 1) + mm][0], v1 = acc[(k_) >> 1][bj][2 * ((k_) & 1) + mm][1]; \
      v0[0] *= fast_rcp(bflo(g[0])); v0[1] *= fast_rcp(bfhi(g[0])); v0[2] *= fast_rcp(bflo(g[1])); v0[3] *= fast_rcp(bfhi(g[1])); v1[0] *= fast_rcp(bflo(g[2])); v1[1] *= fast_rcp(bfhi(g[2])); v1[2] *= fast_rcp(bflo(g[3])); v1[3] *= fast_rcp(bfhi(g[3])); \
      *(u32x4*)(hp + (size_t)(((k_) >> 1) * 128 + (2 * ((k_) & 1) + mm) * 16) * D + bj * 128) = pack8(v0, v1); } asm volatile("" ::: "memory"); } while (0)
    P3F_LOAD(gA, 0); P3F_LOAD(gB, 1); P3F_APPLY(gA, 0);
    if (NSB == 4) { P3F_LOAD(gA, 2); P3F_APPLY(gB, 1); P3F_LOAD(gB, 3); P3F_APPLY(gA, 2); P3F_APPLY(gB, 3); }
    else P3F_APPLY(gB, 1);
#undef P3F_LOAD
#undef P3F_APPLY
  }
};

typedef EpiP3T<false> EpiP3;

template <bool HALFN, bool HALFM = false> struct EpiResT {
  static constexpr bool PERM = true, HAS_MID = false, HAS_RS = false;
  float* X32; bf16_t* XB; float* SS; LAS unsigned char* lds; const float* xin_p; const float* xin_s;
  DI void mid(f32x4 (&)[2][2][4][2], const Unit&, int, int, int, int, int) const {}
  DI void operator()(f32x4 (&acc)[2][2][4][2], const Unit& u, int wr, int wc, int fr, int fq) const {
    const int rin0 = wr * 64 + fr, row0 = u.pm * (HALFM ? 128 : 256) + rin0, col0 = u.pn * (HALFN ? 128 : 256) + wc * 32 + 8 * fq;
    LAS float* red = (LAS float*)(lds + 131072 + 8192);
#pragma unroll
    for (int ai = 0; ai < (HALFM ? 1 : 2); ++ai) {
      f32x4 xo[4][2][2] = {};
#pragma unroll
      for (int m = 0; m < 4; ++m) { const int r = row0 + ai * 128 + m * 16;
        if (xin_p) { const float* xr = (r < TOKP ? xin_p + (size_t)r * D : xin_s + (size_t)(r - TOKP) * D) + col0;
#pragma unroll
          for (int bj = 0; bj < (HALFN ? 1 : 2); ++bj)
#pragma unroll
            for (int n = 0; n < 2; ++n) xo[m][bj][n] = *(const f32x4*)(xr + bj * 128 + n * 4);
        } else {
#pragma unroll
          for (int bj = 0; bj < (HALFN ? 1 : 2); ++bj) { const u32x4 w = *(const u32x4*)(XB + (size_t)r * D + col0 + bj * 128);
            xo[m][bj][0] = (f32x4){bflo(w[0]), bfhi(w[0]), bflo(w[1]), bfhi(w[1])}; xo[m][bj][1] = (f32x4){bflo(w[2]), bfhi(w[2]), bflo(w[3]), bfhi(w[3])}; } } }
#pragma unroll
      for (int m = 0; m < 4; ++m) { const int r = row0 + ai * 128 + m * 16; bf16_t* bp = XB + (size_t)r * D + col0; float q = 0.f;
#pragma unroll
        for (int bj = 0; bj < (HALFN ? 1 : 2); ++bj)
          { const f32x4 x0 = xo[m][bj][0] + acc[ai][bj][m][0], x1 = xo[m][bj][1] + acc[ai][bj][m][1];
            *(u32x4*)(bp + bj * 128) = pack8(x0, x1);
            q += ((x0[0] * x0[0] + x0[1] * x0[1]) + (x0[2] * x0[2] + x0[3] * x0[3])) + ((x1[0] * x1[0] + x1[1] * x1[1]) + (x1[2] * x1[2] + x1[3] * x1[3])); }
        q += __shfl_xor(q, 16); q += __shfl_xor(q, 32);
        if (fq == 0) red[(rin0 + ai * 128 + m * 16) * 4 + wc] = q; }
      asm volatile("" ::: "memory"); }
    asm volatile("s_waitcnt lgkmcnt(0)" ::: "memory"); __builtin_amdgcn_s_barrier(); asm volatile("" ::: "memory");
    int t = threadIdx.x; asm volatile("" : "+v"(t));
    if (t < (HALFM ? 128 : 256)) { const f32x4 v = *(const LAS f32x4*)(red + t * 4); const float q = (v[0] + v[1]) + (v[2] + v[3]); float* sp = SS + (size_t)(u.pm * (HALFM ? 128 : 256) + t) * 8;
      if (HALFN) sp[u.pn] = q; else *(f32x2*)(sp + 2 * u.pn) = (f32x2){q, 0.f}; }
  }
};

typedef EpiResT<false> EpiRes;

DI float dpp_ror1(float v) { return __builtin_bit_cast(float, __builtin_amdgcn_update_dpp(0, __builtin_bit_cast(int, v), 0x121, 0xf, 0xf, false)); }
DI float dpp_ror2(float v) { return __builtin_bit_cast(float, __builtin_amdgcn_update_dpp(0, __builtin_bit_cast(int, v), 0x122, 0xf, 0xf, false)); }
DI float gelu_mul(float x, float uv) {
  const float t = __builtin_fmaf(x * x, 2.0f * LOG2E * 0.7978845608028654f * 0.044715f, 2.0f * LOG2E * 0.7978845608028654f);
  const float r = fast_rcp(fast_exp2(x * t) + 1.0f);
  return __builtin_fmaf(-x, r, x) * uv;
}
constexpr size_t SIDE_ROWS = (size_t)72 * 2 * DFF;
template <bool HALFM> struct EpiP5FT {
  static constexpr bool PERM = true, HAS_MID = false, HAS_RS = true;
  const float* SS; bf16_t* HF; float* out; const float* cw; const float* cb; const float* st; float* side; LAS unsigned char* lds; int layer;
  DI void mid(f32x4 (&)[2][2][4][2], const Unit&, int, int, int, int, int) const {}
  DI f32x4 prefetch(const Unit& u, int tid) const {
    f32x4 v = {0.f, 0.f, 0.f, 0.f};
    if (tid < (HALFM ? 128 : 256)) v = ss_load(SS, u.pm * (HALFM ? 128 : 256) + tid);
    else if (tid >= 256 && tid < 384) { int j = tid - 256; asm volatile("" : "+v"(j));
      const int arr = j >> 5, c4 = (j & 31) * 4; v = *(const f32x4*)((arr < 3 ? cw + arr * DFF : cb) + u.pn * 128 + c4); }
    return v;
  }
  DI void stash(const f32x4& v, const Unit& u, int tid, LAS unsigned char* l) const {
    if (tid < (HALFM ? 128 : 256)) *(LAS float*)(l + 131072 + 12288 + tid * 4) = ss_to_rs(v);
    else if (tid >= 256 && tid < 384) *(LAS f32x4*)(l + 131072 + 13312 + (tid - 256) * 16) = v;
  }
  DI void operator()(f32x4 (&acc)[2][2][4][2], const Unit& u, int wr, int wc, int fr_in, int fq_in) const {
    int fr = fr_in, fq = fq_in; asm volatile("" : "+v"(fr), "+v"(fq));
    const int rin0 = wr * 64 + fr, col0 = u.pn * 128 + wc * 32 + 8 * fq;
    const bool sample = HALFM ? true : u.pm >= 64, cont = !sample && (u.pm & 15) != 0;
    const int bd0 = HALFM ? (u.pm - TOKP / 128) * 2 : (u.pm - 64) * 4;
    LAS float* xh = (LAS float*)(lds + 131072);
    float* TAILG = side; float* HEADC = side + SIDE_ROWS; float* HEADU = side + 2 * SIDE_ROWS;
#pragma unroll
    for (int ai = 0; ai < (HALFM ? 1 : 2); ++ai)
#pragma unroll
      for (int m = 0; m < 4; ++m) { const float s = *(const LAS float*)(lds + 131072 + 12288 + (rin0 + ai * 128 + m * 16) * 4);
#pragma unroll
        for (int n = 0; n < 2; ++n) { acc[ai][0][m][n] *= s; acc[ai][1][m][n] *= s; } }
    if (fr >= 14) {
#pragma unroll
      for (int ai = 0; ai < (HALFM ? 1 : 2); ++ai) { const int gidx = 2 * ai + wr; LAS float* xp = xh + ((gidx * 4 + wc) * 2 + (fr - 14)) * 32 + fq * 8;
        *(LAS f32x4*)xp = acc[ai][0][3][0]; *(LAS f32x4*)(xp + 4) = acc[ai][0][3][1];
        float* cp = nullptr;
        if (sample) cp = out + O_SCONV + ((size_t)(layer * DB + bd0 + gidx) * 2 + (fr - 14)) * DFF + col0;
        else if (gidx == 3) { float* tp = TAILG + ((size_t)u.pm * 2 + (fr - 14)) * DFF + col0; *(f32x4*)tp = acc[ai][0][3][0]; *(f32x4*)(tp + 4) = acc[ai][0][3][1];
          if ((u.pm & 15) == 15) cp = out + O_PCONV + ((size_t)(layer * 4 + (u.pm >> 4)) * 2 + (fr - 14)) * DFF + col0; }
        if (cp) { *(f32x4*)cp = acc[ai][0][3][0]; *(f32x4*)(cp + 4) = acc[ai][0][3][1]; } }
    }
    asm volatile("s_waitcnt lgkmcnt(0)" ::: "memory"); __builtin_amdgcn_s_barrier(); asm volatile("" ::: "memory");
#pragma unroll
    for (int n = 0; n < 2; ++n) {
      const LAS float* cl = (const LAS float*)(lds + 131072 + 13312) + wc * 32 + 8 * fq + 4 * n;
      const f32x4 w0 = *(const LAS f32x4*)cl, w1 = *(const LAS f32x4*)(cl + 128), w2 = *(const LAS f32x4*)(cl + 256), bb = *(const LAS f32x4*)(cl + 384);
#pragma unroll
      for (int ai = 0; ai < (HALFM ? 1 : 2); ++ai) { const int gidx = 2 * ai + wr;
        f32x4 gp = {0.f, 0.f, 0.f, 0.f};
        if (fr >= 14) {
          if (sample) gp = *(const f32x4*)(st + ((size_t)(bd0 + gidx) * 2 + (fr - 14)) * DFF + col0 + 4 * n);
          else if (gidx > 0) gp = *(const LAS f32x4*)(xh + (((gidx - 1) * 4 + wc) * 2 + (fr - 14)) * 32 + fq * 8 + 4 * n);
        }
#pragma unroll
        for (int m = 0; m < 4; ++m) { const int rin = rin0 + ai * 128 + m * 16; f32x4 o, cc;
#pragma unroll
          for (int j = 0; j < 4; ++j) { const float g = acc[ai][0][m][n][j], gq = gp[j];
            const float r1g = dpp_ror1(g), r1q = dpp_ror1(gq), r2g = dpp_ror2(g), r2q = dpp_ror2(gq);
            const float p1 = fr >= 1 ? r1g : r1q, p2 = fr >= 2 ? r2g : r2q;
            const float c = __builtin_fmaf(w2[j], g, __builtin_fmaf(w1[j], p1, __builtin_fmaf(w0[j], p2, bb[j])));
            cc[j] = c; o[j] = gelu_mul(c, acc[ai][1][m][n][j]); }
          *(u32x2*)(HF + (size_t)(u.pm * (HALFM ? 128 : 256) + rin) * DFF + col0 + 4 * n) = pack4(o);
          if (cont && gidx == 0 && m == 0 && fr < 2) { *(f32x4*)(HEADC + ((size_t)u.pm * 2 + fr) * DFF + col0 + 4 * n) = cc; *(f32x4*)(HEADU + ((size_t)u.pm * 2 + fr) * DFF + col0 + 4 * n) = acc[ai][1][m][n]; }
          gp = acc[ai][0][m][n]; }
      }
    }
  }
};
typedef EpiP5FT<false> EpiP5F;
DI void p6_fixup_panel(int pm, const float* side, const float* cw, bf16_t* HF) {
  const float* TAILG = side + (size_t)(pm - 1) * 2 * DFF; const float* HEADC = side + SIDE_ROWS + (size_t)pm * 2 * DFF; const float* HEADU = side + 2 * SIDE_ROWS + (size_t)pm * 2 * DFF;
  int tid_ = threadIdx.x; asm volatile("" : "+v"(tid_));
  constexpr int NIT = (DFF + NTHREADS - 1) / NTHREADS;
  float t0[NIT], t1[NIT], a0[NIT], a1[NIT], hc0[NIT], hc1[NIT], hu0[NIT], hu1[NIT];
#pragma unroll
  for (int i = 0; i < NIT; ++i) { const int k = tid_ + i * NTHREADS; const int kk = k < DFF ? k : 0;
    t0[i] = TAILG[kk]; t1[i] = TAILG[DFF + kk]; a0[i] = cw[kk]; a1[i] = cw[DFF + kk]; hc0[i] = HEADC[kk]; hc1[i] = HEADC[DFF + kk]; hu0[i] = HEADU[kk]; hu1[i] = HEADU[DFF + kk]; }
#pragma unroll
  for (int i = 0; i < NIT; ++i) { const int k = tid_ + i * NTHREADS;
    const float c0 = hc0[i] + a0[i] * t0[i] + a1[i] * t1[i], c1 = hc1[i] + a0[i] * t1[i];
    const float h0 = gelu_mul(c0, hu0[i]), h1 = gelu_mul(c1, hu1[i]);
    f32x4 v = {h0, h1, 0.f, 0.f}; const u32x2 pk = pack4(v);
    if (k < DFF) { HF[(size_t)(pm * 256) * DFF + k] = (bf16_t)(pk[0] & 0xffffu); HF[(size_t)(pm * 256 + 1) * DFF + k] = (bf16_t)(pk[0] >> 16); } }
}

struct EpiNull {
  static constexpr bool PERM = true, HAS_MID = false, HAS_RS = false;
  DI void mid(f32x4 (&)[2][2][4][2], const Unit&, int, int, int, int, int) const {}
  DI void operator()(f32x4 (&acc)[2][2][4][2], const Unit& u, int wr, int wc, int fr, int fq) const {
#pragma unroll
    for (int ai = 0; ai < 2; ++ai)
#pragma unroll
      for (int bj = 0; bj < 2; ++bj)
#pragma unroll
        for (int m = 0; m < 4; ++m)
#pragma unroll
          for (int n = 0; n < 2; ++n) asm volatile("" :: "v"(acc[ai][bj][m][n]));
  }
};

DI float gelu_tanh(float x) {
  const float y = 0.7978845608028654f * (x + 0.044715f * x * x * x);
  const float e = fast_exp2(2.0f * LOG2E * y);
  const float th = 1.0f - 2.0f * fast_rcp(e + 1.0f);
  return 0.5f * x * (1.0f + th);
}
DI void pfinal_norm(const Params& p, int row0, int row1, int wblock, int nblocks) {
  const bf16_t* XB = (const bf16_t*)(p.ws + WS_XB); const float* SS = (const float*)(p.ws + WS_SS);
  int tid_ = threadIdx.x; asm volatile("" : "+v"(tid_));
  int ngw_ = nblocks * 8; asm volatile("" : "+s"(ngw_));
  const int lane = tid_ & 63, gw = wblock * 8 + (tid_ >> 6), NGW = ngw_;
#pragma unroll 3
  for (int m = row0 + gw; m < row1; m += NGW) { const float s = row_rs(SS, m);
#pragma unroll
    for (int j = 0; j < 2; ++j) { const u32x4 w = ((const u32x4*)(XB + (size_t)m * D))[lane + 64 * j];
      const f32x4 g0 = ((const f32x4*)p.norm_final)[2 * (lane + 64 * j)], g1 = ((const f32x4*)p.norm_final)[2 * (lane + 64 * j) + 1];
      const f32x4 a = {bflo(w[0]), bfhi(w[0]), bflo(w[1]), bfhi(w[1])}, b = {bflo(w[2]), bfhi(w[2]), bflo(w[3]), bfhi(w[3])};
      f32x4* o = (f32x4*)(p.out + (size_t)m * D) + 2 * (lane + 64 * j);
      __builtin_nontemporal_store(a * s * g0, o); __builtin_nontemporal_store(b * s * g1, o + 1); } }
}

DI pg8::GemmDesc p1_desc(unsigned char* ws, int l) {
  return pg8::GemmDesc{(const char*)(ws + WS_XB), (const char*)(ws + WS_WIN) + (size_t)l * INC * D * 2, D, D, D / 64, (size_t)256 * D * 2, (size_t)128 * D * 2};
}
DI EpiP1 p1_epi(const Params& p, int l, LAS unsigned char* lds) {
  return EpiP1{(const float*)(p.ws + WS_SS), (bf16_t*)(p.ws + WS_QKV), (bf16_t*)(p.ws + WS_GATE), p.b_gate + (size_t)l * 3 * D, p.out, l, 0, lds};
}
namespace attn {
constexpr int N_CPY = 0, N_CS = 128, N_CP = 512, N_AP = 512, N_BP = 512, N_AS = 256, N_BS = 256, NITEMS = N_CPY + N_CS + N_CP + N_AP + N_BP + N_AS + N_BS;
constexpr float STICK_DONE = 9.35762e-14f;

struct Item { int mode, h, tok0, past, q0, nqv, pflags; const float* cK; const float* cV; };

DI Item decode(const Params& p, int layer, int idx) {
  Item it; it.cK = nullptr; it.cV = nullptr; it.past = 0; it.pflags = 0;
  if (idx < N_CPY) { it.mode = 3; it.h = idx; return it; }
  idx -= N_CPY;
  if (idx < N_CS) { const int bd = idx >> 2, h = idx & 3; it.mode = 2; it.h = h; it.tok0 = TOKP + bd * 64; it.past = PAST; it.q0 = PAST; it.nqv = 64;
    it.cK = p.cache_c_k + (size_t)(layer * DB + bd) * PAST * 512 + h * 128; it.cV = p.cache_c_v + (size_t)(layer * DB + bd) * PAST * 512 + h * 128; return it; }
  idx -= N_CS;
  if (idx < N_CP) { const int jj = 31 - (idx >> 4), rem = idx & 15; it.mode = 2; it.h = rem & 3; it.tok0 = (rem >> 2) * SEQ; it.q0 = jj * 128; it.nqv = 128; return it; }
  idx -= N_CP;
  if (idx < N_AP + N_BP) { const int isb = idx >= N_AP; if (isb) idx -= N_AP; const int qt = 15 - (idx >> 5), rem = idx & 31; it.mode = isb; it.h = rem & 7; it.tok0 = (rem >> 3) * SEQ; it.q0 = qt * 256; it.nqv = 256; return it; }
  idx -= N_AP + N_BP;
  if (idx < N_AS) { const int bd = idx >> 3, h = idx & 7; it.mode = 0; it.h = h; it.tok0 = TOKP + bd * 64; it.past = ALEN; it.q0 = ALEN; it.nqv = 64;
    it.cK = p.cache_a_k + (size_t)(layer * DB + bd) * ALEN * 512 + h * 64; it.cV = p.cache_a_v + (size_t)(layer * DB + bd) * ALEN * 512 + h * 64; return it; }
  idx -= N_AS;
  { const int bd = idx >> 3, h = idx & 7; it.mode = 1; it.h = h; it.tok0 = TOKP + bd * 64; it.past = PAST; it.q0 = PAST; it.nqv = 64;
    it.cK = p.cache_b_k + (size_t)(layer * DB + bd) * PAST * 512 + h * 64; it.cV = p.cache_b_v + (size_t)(layer * DB + bd) * PAST * 512 + h * 64; return it; }
}


template <int MODE, bool SAMPLE>
DI void load_piece(u32x4& r0, u32x4& r1, u32x4& r2, u32x4& r3, const Item& it, const float* cache, const bf16_t* QKV, int col, int kt, int tid) {
  constexpr int CPR = MODE == 2 ? 16 : 8;
  const int j0 = kt * 64;
  const int ra = tid / CPR, ca = tid % CPR;
  if (SAMPLE && j0 < it.past) {
    const unsigned lo = (unsigned)(ra * 512 + ca * 8) * 4u; const char* b = (const char*)(cache + (size_t)j0 * 512);
    { const u32x4* q = (const u32x4*)(b + lo); r0 = __builtin_nontemporal_load(q); r1 = __builtin_nontemporal_load(q + 1); }
    if constexpr (MODE == 2) { const u32x4* q = (const u32x4*)(b + (size_t)32 * 512 * 4 + lo); r2 = __builtin_nontemporal_load(q); r3 = __builtin_nontemporal_load(q + 1); }
  } else {
    const unsigned lo = (unsigned)(ra * QKVW + ca * 8) * 2u; const char* b = (const char*)(QKV + (size_t)(it.tok0 + j0 - it.past) * QKVW + col);
    r0 = *(const u32x4*)(b + lo);
    if constexpr (MODE == 2) r2 = *(const u32x4*)(b + (size_t)32 * QKVW * 2 + lo);
  }
}
DI u32x4 pair_swap(u32x2 a, u32x2 b) {
  unsigned a0 = a[0], a1 = a[1], b0 = b[0], b1 = b[1];
  asm("s_nop 1\n\tv_permlane32_swap_b32 %0, %1" : "+v"(a0), "+v"(b0));
  asm("s_nop 1\n\tv_permlane32_swap_b32 %0, %1" : "+v"(a1), "+v"(b1));
  return (u32x4){a0, a1, b0, b1};
}
DI u32x4 cvt8(u32x4 a, u32x4 b) { return pack8(__builtin_bit_cast(f32x4, a), __builtin_bit_cast(f32x4, b)); }
template <int MODE, bool ISK, bool SAMPLE>
DI void write_piece(const u32x4& r0, const u32x4& r1, const u32x4& r2, const u32x4& r3, const Item& it, LAS unsigned char* buf, int kt, int tid) {
  constexpr int CPR = MODE == 2 ? 16 : 8, VS = MODE == 2 ? 320 : 192;
  const bool f32src = SAMPLE && kt * 64 < it.past;
  const int ra = tid / CPR, ca = tid % CPR, rb = (tid + NTHREADS) / CPR, cb = (tid + NTHREADS) % CPR;
  { const u32x4 x = f32src ? cvt8(r0, r1) : r0;
    if (ISK) *(LAS u32x4*)(buf + ((MODE == 2 && ca >= 8) ? 8192 : 0) + ra * 128 + (((ca & 7) ^ ((ra >> 1) & 7)) << 4)) = x;
    else *(LAS u32x4*)(buf + ra * VS + ca * 16) = x; }
  if constexpr (MODE == 2) { const u32x4 x = f32src ? cvt8(r2, r3) : r2;
    if (ISK) *(LAS u32x4*)(buf + (cb >= 8 ? 8192 : 0) + rb * 128 + (((cb & 7) ^ ((rb >> 1) & 7)) << 4)) = x;
    else *(LAS u32x4*)(buf + rb * VS + cb * 16) = x; }
}

template <int MODE>
DI void state_store(const u32x4& r0, const u32x4& r2, float* dst, int tid) {
  constexpr int CPR = MODE == 2 ? 16 : 8;
  const int ra = tid / CPR, ca = tid % CPR, rb = (tid + NTHREADS) / CPR, cb = (tid + NTHREADS) % CPR;
  { float* q = dst + (size_t)ra * 512 + ca * 8;
    __builtin_nontemporal_store((f32x4){bflo(r0[0]), bfhi(r0[0]), bflo(r0[1]), bfhi(r0[1])}, (f32x4*)q); __builtin_nontemporal_store((f32x4){bflo(r0[2]), bfhi(r0[2]), bflo(r0[3]), bfhi(r0[3])}, (f32x4*)(q + 4)); }
  if constexpr (MODE == 2) { float* q = dst + (size_t)rb * 512 + cb * 8;
    __builtin_nontemporal_store((f32x4){bflo(r2[0]), bfhi(r2[0]), bflo(r2[1]), bfhi(r2[1])}, (f32x4*)q); __builtin_nontemporal_store((f32x4){bflo(r2[2]), bfhi(r2[2]), bflo(r2[3]), bfhi(r2[3])}, (f32x4*)(q + 4)); }
}
template <int MODE>
DI float* state_dst(const Params& p, int layer, const Item& it, int kt, int isv) {
  const int hoff = MODE == 2 ? it.h * 128 : it.h * 64;
  if (it.past == 0) {
    const int t0 = kt * 64; if (t0 < it.q0 || t0 >= it.q0 + it.nqv) return nullptr;
    const int b = it.tok0 / SEQ;
    if (MODE == 0) { if (t0 < SEQ - 512) return nullptr; return p.out + (isv ? O_PAV : O_PAK) + ((size_t)(layer * 4 + b) * 512 + (t0 - (SEQ - 512))) * 512 + hoff; }
    return p.out + (MODE == 1 ? (isv ? O_PBV : O_PBK) : (isv ? O_PCV : O_PCK)) + ((size_t)(layer * 4 + b) * SEQ + t0) * 512 + hoff;
  } else {
    if (kt * 64 != it.past) return nullptr;
    const int bd = (it.tok0 - TOKP) / 64;
    if (MODE == 0) return p.out + (isv ? O_SAV : O_SAK) + ((size_t)(layer * DB + bd) * 512 + 448) * 512 + hoff;
    return p.out + (MODE == 1 ? (isv ? O_SBV : O_SBK) : (isv ? O_SCV : O_SCK)) + ((size_t)(layer * DB + bd) * 64) * 512 + hoff;
  }
}

DI void roll_store(const u32x4& r0, const u32x4& r1, const Params& p, int layer, const Item& it, int kt, int isv, int tid) {
  if (kt < 1 || kt * 64 >= it.past) return;
  const int bd = (it.tok0 - TOKP) / 64, ra = tid >> 3, ca = tid & 7;
  float* q = p.out + (isv ? O_SAV : O_SAK) + ((size_t)(layer * DB + bd) * 512 + (kt - 1) * 64 + ra) * 512 + it.h * 64 + ca * 8;
  __builtin_nontemporal_store(__builtin_bit_cast(f32x4, r0), (f32x4*)q); __builtin_nontemporal_store(__builtin_bit_cast(f32x4, r1), (f32x4*)(q + 4));
}
DI bf16x8 pack_p(const f32x16& x, int s) {
  const f32x4 a = {x[8 * s], x[8 * s + 1], x[8 * s + 2], x[8 * s + 3]}, b = {x[8 * s + 4], x[8 * s + 5], x[8 * s + 6], x[8 * s + 7]};
  return __builtin_bit_cast(bf16x8, pack8(a, b));
}
#define MFMA32(a, b, c) __builtin_amdgcn_mfma_f32_32x32x16_bf16((a), (b), (c), 0, 0, 0)

constexpr int L_KB = 0, KB_BYTES = 16384, L_VB = 32768, VB_BYTES = 20480, L_LUT = 73728, L_FLAGS = 75776, L_XCH = 81920;

template <int MODE, bool SAMPLE>
DI void run_item(const Params& p, int layer, const Item& it, LAS unsigned char* lds_in) {
  LAS unsigned char* lds = opaque_lds(lds_in);
  constexpr int NDV = MODE == 2 ? 4 : 2, VS = MODE == 2 ? 320 : 192;
  int tid_ = threadIdx.x; asm volatile("" : "+v"(tid_));
  const int tid = tid_, lane = tid & 63, wave = __builtin_amdgcn_readfirstlane(tid >> 6);
  const int qi = lane & 31, h2 = lane >> 5;
  const int mp = MODE == 2 ? (wave >> 2) : 0, wrow = MODE == 2 ? (wave & 3) : wave;
  const int q0w = it.q0 + 32 * wrow;
  const bool active = 32 * wrow < it.nqv;
  const bf16_t* QKV = (const bf16_t*)(p.ws + WS_QKV);
  const int hb = MODE == 2 ? it.h * 128 : it.h * 64;
  const int qcol = (MODE == 0 ? 0 : MODE == 1 ? 1536 : 3072) + hb + 64 * mp, kcol = (MODE == 0 ? 512 : MODE == 1 ? 2048 : 3584) + hb, vcol = (MODE == 0 ? 1024 : MODE == 1 ? 2560 : 4096) + hb;
  const int cw = q0w >> 6;
  int kt_first, step, NT;
  if (MODE == 0) { kt_first = (it.q0 >> 6) - 8; if (kt_first < 0) kt_first = 0; step = 1; NT = ((it.q0 + it.nqv - 1) >> 6) - kt_first + 1; }
  else if (MODE == 2) { kt_first = 0; step = 1; NT = ((it.q0 + it.nqv - 1) >> 6) + 1; }
  else { kt_first = (it.q0 + it.nqv - 2) >> 6; step = -1; NT = kt_first + 1; }
  const bool wr_state = it.pflags == 0;
  u32x4 k0 = {}, k1 = {}, k2 = {}, k3 = {}, v0 = {}, v1 = {}, v2 = {}, v3 = {};
  load_piece<MODE, SAMPLE>(k0, k1, k2, k3, it, it.cK, QKV, kcol, kt_first, tid);
  load_piece<MODE, SAMPLE>(v0, v1, v2, v3, it, it.cV, QKV, vcol, kt_first, tid);
  LAS float* lut = (LAS float*)(lds + L_LUT);
  LAS unsigned* flags = (LAS unsigned*)(lds + L_FLAGS);
  if (MODE == 0) { const float bfar = p.a_rel_bias[((size_t)layer * 257 + 256) * 8 + it.h]; for (int i = tid; i < 257; i += NTHREADS) lut[i] = p.a_rel_bias[((size_t)layer * 257 + i) * 8 + it.h] - bfar; }
  if (MODE == 2) { if (tid < 192) lut[tid] = ((const float*)(p.ws + WS_CTL))[CW_T5 + it.h * 192 + tid]; }
  bf16x8 qf[4];
  if (active) { const bf16_t* qp = QKV + (size_t)(it.tok0 + q0w + qi - it.past) * QKVW + qcol + 8 * h2;
#pragma unroll
    for (int s = 0; s < 4; ++s) { const u32x4 w = *(const u32x4*)(qp + 16 * s);
      const f32x4 a = {bflo(w[0]) * 0.125f, bfhi(w[0]) * 0.125f, bflo(w[1]) * 0.125f, bfhi(w[1]) * 0.125f}, b = {bflo(w[2]) * 0.125f, bfhi(w[2]) * 0.125f, bflo(w[3]) * 0.125f, bfhi(w[3]) * 0.125f};
      qf[s] = __builtin_bit_cast(bf16x8, pack8(a, b)); } }
  f32x16 O[NDV];
#pragma unroll
  for (int b = 0; b < NDV; ++b)
#pragma unroll
    for (int i = 0; i < 16; ++i) O[b][i] = 0.f;
  float m_run = -1e30f, l_run = 0.f, R2 = 1.0f; bool done = false, have_p = false;
  bf16x8 pf[4];
#pragma unroll
  for (int s = 0; s < 4; ++s) pf[s] = (bf16x8){0, 0, 0, 0, 0, 0, 0, 0};
  const int krow_off = qi * 128, kswz = (qi >> 1) & 7;
  const int g16 = lane >> 4, trq = (lane & 15) >> 2, trp = lane & 3;
  const int vtr_off = (4 * (g16 >> 1) + trq) * VS + (16 * (g16 & 1) + 4 * trp) * 2;

  write_piece<MODE, true, SAMPLE>(k0, k1, k2, k3, it, lds + L_KB, kt_first, tid);
  if (wr_state) { float* d = state_dst<MODE>(p, layer, it, kt_first, 0); if (d) state_store<MODE>(k0, k2, d, tid); }
  if (MODE == 0 && SAMPLE && wr_state) roll_store(k0, k1, p, layer, it, kt_first, 0, tid);
  if (NT > 1) load_piece<MODE, SAMPLE>(k0, k1, k2, k3, it, it.cK, QKV, kcol, kt_first + step, tid);
  for (int t = 0;; ++t) {
    __syncthreads();
    if (MODE == 1 && t > 0 && t < NT) { const unsigned any = flags[0] | flags[1] | flags[2] | flags[3] | flags[4] | flags[5] | flags[6] | flags[7]; if (!any) NT = t; }
    const int kt = kt_first + step * t;
    bool mine = false;
    if (t < NT && !(it.pflags & 2)) {
      if (MODE == 0) mine = active && kt >= cw - 8 && kt <= cw;
      else if (MODE == 2) mine = active && kt <= cw;
      else mine = active && !done && kt * 64 <= q0w + 30;
    }
    LAS unsigned char* vb = lds + L_VB + ((t - 1) & 1) * VB_BYTES + vtr_off;
    LAS unsigned char* kb = lds + L_KB + (t & 1) * KB_BYTES + ((MODE == 2 && mp) ? 8192 : 0);
    constexpr int HB = NDV / 2, NST = 4 * HB;
    bf16x8 kfa[4], vfa[2], vfb[2];
    const bool do_pv = have_p && !(it.pflags & 8);
#define V_LOAD(dst, j_) do { if (do_pv) { _Pragma("unroll") for (int bb = 0; bb < 2; ++bb) { const int a0 = 16 * ((j_) / HB) * VS + 64 * (2 * ((j_) % HB) + bb); \
      const s16x4 lo = __builtin_amdgcn_ds_read_tr16_b64_v4i16((LAS s16x4*)(vb + a0)), hi = __builtin_amdgcn_ds_read_tr16_b64_v4i16((LAS s16x4*)(vb + a0 + 8 * VS)); \
      dst[bb] = __builtin_shufflevector(lo, hi, 0, 1, 2, 3, 4, 5, 6, 7); } } } while (0)
#define V_MMA(src, j_) do { if (do_pv) { _Pragma("unroll") for (int bb = 0; bb < 2; ++bb) O[2 * ((j_) % HB) + bb] = MFMA32(src[bb], pf[(j_) / HB], O[2 * ((j_) % HB) + bb]); } } while (0)
#define STG(j_, cur, nxt) do { if (SAMPLE) { V_LOAD(cur, j_); V_MMA(cur, j_); } else { if ((j_) + 1 < NST) V_LOAD(nxt, (j_) + 1); V_MMA(cur, j_); } } while (0)
    if (!SAMPLE) {
      if (mine) {
#pragma unroll
        for (int s = 0; s < 4; ++s) kfa[s] = *(const LAS bf16x8*)(kb + krow_off + (((2 * s + h2) ^ kswz) << 4)); }
      V_LOAD(vfa, 0);
      __builtin_amdgcn_sched_barrier(0);
    }
    if (t < NT && !(it.pflags & 1)) { write_piece<MODE, false, SAMPLE>(v0, v1, v2, v3, it, lds + L_VB + (t & 1) * VB_BYTES, kt_first + step * t, tid);
      if (wr_state) { float* d = state_dst<MODE>(p, layer, it, kt_first + step * t, 1); if (d) state_store<MODE>(v0, v2, d, tid); }
      if (MODE == 0 && SAMPLE && wr_state) roll_store(v0, v1, p, layer, it, kt_first + step * t, 1, tid);
      if (t + 1 < NT) { write_piece<MODE, true, SAMPLE>(k0, k1, k2, k3, it, lds + L_KB + ((t + 1) & 1) * KB_BYTES, kt_first + step * (t + 1), tid);
        if (wr_state) { float* d = state_dst<MODE>(p, layer, it, kt_first + step * (t + 1), 0); if (d) state_store<MODE>(k0, k2, d, tid); }
        if (MODE == 0 && SAMPLE && wr_state) roll_store(k0, k1, p, layer, it, kt_first + step * (t + 1), 0, tid);
        load_piece<MODE, SAMPLE>(v0, v1, v2, v3, it, it.cV, QKV, vcol, kt_first + step * (t + 1), tid);
        if (t + 2 < NT) load_piece<MODE, SAMPLE>(k0, k1, k2, k3, it, it.cK, QKV, kcol, kt_first + step * (t + 2), tid); } }
    __builtin_amdgcn_sched_barrier(0);
    f32x16 sA, sB;
#pragma unroll
    for (int i = 0; i < 16; ++i) { sA[i] = 0.f; sB[i] = 0.f; }
    if (mine) {
      bf16x8 kfc[4];
      if (SAMPLE) {
#pragma unroll
        for (int s = 0; s < 4; ++s) kfa[s] = *(const LAS bf16x8*)(kb + krow_off + (((2 * s + h2) ^ kswz) << 4)); }
#pragma unroll
      for (int s = 0; s < 4; ++s) kfc[s] = *(const LAS bf16x8*)(kb + 4096 + krow_off + (((2 * s + h2) ^ kswz) << 4));
#pragma unroll
      for (int s = 0; s < 4; ++s) sA = MFMA32(kfa[s], qf[s], sA);
#pragma unroll
      for (int s = 0; s < 4; ++s) sB = MFMA32(kfc[s], qf[s], sB);
    }
    const int kbase = kt * 64 + 4 * h2;
    if (MODE != 1) {
      float mx = -1e30f, alpha = 1.0f, lsa = 0.f, lsb = 0.f; bool resc = false;
      const bool smx = mine && !(it.pflags & 4);
      STG(0, vfa, vfb);
      if (NST == 8) STG(1, vfb, vfa);
      if (smx) {
        bool cst;
        if (MODE == 0) cst = q0w - (kt * 64 + 63) >= 128; else cst = kt * 64 + 63 - q0w <= -127;
        if (!cst) {
#pragma unroll
          for (int i = 0; i < 16; ++i) { const int ko = (i & 3) + 8 * (i >> 2);
            int ia, ib;
            if (MODE == 0) { const int d = (q0w + qi) - (kbase + ko); ia = d; ib = d - 32; ia = (ia < -128 ? -128 : ia > 128 ? 128 : ia) + 128; ib = (ib < -128 ? -128 : ib > 128 ? 128 : ib) + 128; }
            else { const int d = (kbase + ko) - (q0w + qi); ia = d; ib = d + 32; ia = (ia < -127 ? -127 : ia > 63 ? 63 : ia) + 127; ib = (ib < -127 ? -127 : ib > 63 ? 63 : ib) + 127; }
            sA[i] += lut[ia]; sB[i] += lut[ib]; }
        }
        float m0 = fmaxf(fmaxf(sA[0], sA[1]), sA[2]), m1 = fmaxf(fmaxf(sB[0], sB[1]), sB[2]);
#pragma unroll
        for (int i = 3; i < 15; i += 2) { m0 = fmaxf(fmaxf(m0, sA[i]), sA[i + 1]); m1 = fmaxf(fmaxf(m1, sB[i]), sB[i + 1]); }
        mx = fmaxf(fmaxf(m0, m1), fmaxf(sA[15], sB[15]));
      }
      __builtin_amdgcn_sched_barrier(0);
      if (NST == 8) { STG(2, vfa, vfb); STG(3, vfb, vfa); } else STG(1, vfb, vfa);
      if (smx) {
        mx = fmaxf(mx, __shfl_xor(mx, 32)) * LOG2E;
        resc = !__all(mx <= m_run + 8.0f);
        if (resc) { const float mnew = fmaxf(m_run, mx); alpha = fast_exp2(m_run - mnew); m_run = mnew; l_run *= alpha; }
#pragma unroll
        for (int i = 0; i < 16; ++i) { sA[i] = fast_exp2(__builtin_fmaf(sA[i], LOG2E, -m_run)); lsa += sA[i]; }
      }
      __builtin_amdgcn_sched_barrier(0);
      if (NST == 8) { STG(4, vfa, vfb); STG(5, vfb, vfa); } else STG(2, vfa, vfb);
      if (smx) {
#pragma unroll
        for (int i = 0; i < 16; ++i) { sB[i] = fast_exp2(__builtin_fmaf(sB[i], LOG2E, -m_run)); lsb += sB[i]; }
        l_run += lsa + lsb;
      }
      __builtin_amdgcn_sched_barrier(0);
      if (NST == 8) { STG(6, vfa, vfb); STG(7, vfb, vfa); } else STG(3, vfb, vfa);
      __builtin_amdgcn_sched_barrier(0);
      if (mine) {
        if (resc) {
#pragma unroll
        for (int b = 0; b < NDV; ++b)
#pragma unroll
          for (int i = 0; i < 16; ++i) O[b][i] *= alpha;
        }
        pf[0] = pack_p(sA, 0); pf[1] = pack_p(sA, 1); pf[2] = pack_p(sB, 0); pf[3] = pack_p(sB, 1);
      }
    } else {
      STG(0, vfa, vfb); STG(1, vfb, vfa); STG(2, vfa, vfb); STG(3, vfb, vfa);
      if (mine) {
        const bool diag = kt * 64 + 63 >= q0w;
        float kpA[16], kpB[16];
#pragma unroll
        for (int i = 0; i < 16; ++i) { const int ko = (i & 3) + 8 * (i >> 2);
          { const float r = fast_rcp(1.0f + fast_exp2(sA[i] * LOG2E)); const bool ok = !diag || (kbase + ko) < (q0w + qi); kpA[i] = ok ? r : 1.0f; sA[i] = ok ? 1.0f - r : 0.0f; }
          { const float r = fast_rcp(1.0f + fast_exp2(sB[i] * LOG2E)); const bool ok = !diag || (kbase + 32 + ko) < (q0w + qi); kpB[i] = ok ? r : 1.0f; sB[i] = ok ? 1.0f - r : 0.0f; } }
        float gs[8], pg[8];
#pragma unroll
        for (int g = 0; g < 4; ++g) { gs[g] = (kpA[4 * g] * kpA[4 * g + 1]) * (kpA[4 * g + 2] * kpA[4 * g + 3]); gs[4 + g] = (kpB[4 * g] * kpB[4 * g + 1]) * (kpB[4 * g + 2] * kpB[4 * g + 3]); }
#pragma unroll
        for (int g = 0; g < 8; ++g) pg[g] = __shfl_xor(gs[g], 32);
        float suf = R2;
#pragma unroll
        for (int g = 7; g >= 0; --g) { const float off = suf * (h2 == 0 ? pg[g] : 1.0f);
          if (g >= 4) { const int b = 4 * (g - 4); const float a3 = off, a2 = a3 * kpB[b + 3], a1 = a2 * kpB[b + 2], a0 = a1 * kpB[b + 1];
            sB[b + 3] *= a3; sB[b + 2] *= a2; sB[b + 1] *= a1; sB[b] *= a0; }
          else { const int b = 4 * g; const float a3 = off, a2 = a3 * kpA[b + 3], a1 = a2 * kpA[b + 2], a0 = a1 * kpA[b + 1];
            sA[b + 3] *= a3; sA[b + 2] *= a2; sA[b + 1] *= a1; sA[b] *= a0; }
          suf *= gs[g] * pg[g]; }
        R2 = suf;
        done = __all(R2 < STICK_DONE) != 0;
        pf[0] = pack_p(sA, 0); pf[1] = pack_p(sA, 1); pf[2] = pack_p(sB, 0); pf[3] = pack_p(sB, 1);
      }
    }
#undef V_LOAD
#undef V_MMA
#undef STG
    have_p = mine;
    if (MODE == 1 && t < NT) { if (lane == 0) flags[wave] = (active && !done && kt > 0 && (kt - 1) * 64 <= q0w + 30) ? 1u : 0u; }
    if (t >= NT) break;
  }
  int lane_e = lane; asm volatile("" : "+v"(lane_e));
  const int qi_e = lane_e & 31, h2_e = lane_e >> 5;
  bf16_t* Ob = (bf16_t*)(p.ws + WS_O);
  const int ocol = MODE == 0 ? hb : MODE == 1 ? 512 + hb : 1024 + hb;
  const bool wr_out = it.pflags == 0;
  if (MODE != 2) {
    if (active && wr_out) { float sc = 1.f; if (MODE == 0) { const float lt = l_run + __shfl_xor(l_run, 32); sc = fast_rcp(lt); }
      bf16_t* op = Ob + (size_t)(it.tok0 + q0w + qi_e - it.past) * OW + ocol + 8 * h2_e;
#pragma unroll
      for (int b = 0; b < NDV; ++b)
#pragma unroll
        for (int j = 0; j < 2; ++j) { const f32x4 va = {O[b][8 * j] * sc, O[b][8 * j + 1] * sc, O[b][8 * j + 2] * sc, O[b][8 * j + 3] * sc}, vb = {O[b][8 * j + 4] * sc, O[b][8 * j + 5] * sc, O[b][8 * j + 6] * sc, O[b][8 * j + 7] * sc};
          *(u32x4*)(op + 32 * b + 16 * j) = pair_swap(pack4(va), pack4(vb)); } }
    __syncthreads();
  } else {
    const float lam = ((const float*)(p.ws + WS_CTL))[CW_LAM + layer];
    const float sub_scale = 1.0f - (0.8f - 0.6f * expf(-0.3f * (float)layer));
    LAS float* xch = (LAS float*)(lds + L_XCH);
    if (active && mp == 1) { const float lt = l_run + __shfl_xor(l_run, 32), sc = lam * fast_rcp(lt);
#pragma unroll
      for (int b = 0; b < NDV; ++b)
#pragma unroll
        for (int i = 0; i < 16; ++i) xch[((wave & 3) * 64 + b * 16 + i) * 64 + lane_e] = O[b][i] * sc; }
    __syncthreads();
    if (active && mp == 0 && wr_out) { const float lt = l_run + __shfl_xor(l_run, 32), sc = fast_rcp(lt); float q = 0.f;
#pragma unroll
      for (int b = 0; b < NDV; ++b)
#pragma unroll
        for (int i = 0; i < 16; ++i) { const float o = O[b][i] * sc - xch[((wave & 3) * 64 + b * 16 + i) * 64 + lane_e]; O[b][i] = o; q += o * o; if ((i & 7) == 7) __builtin_amdgcn_sched_barrier(0); }
      q += __shfl_xor(q, 32);
      const float rstd = __builtin_amdgcn_rsqf(q * (1.0f / 128.0f) + EPS) * sub_scale;
      const float* gain = p.c_subln + layer * 128 + 4 * h2_e;
      bf16_t* op = Ob + (size_t)(it.tok0 + q0w + qi_e - it.past) * OW + ocol + 8 * h2_e;
#pragma unroll
      for (int b = 0; b < NDV; ++b)
#pragma unroll
        for (int j = 0; j < 2; ++j) { const f32x4 ga = *(const f32x4*)(gain + 32 * b + 16 * j), gb = *(const f32x4*)(gain + 32 * b + 16 * j + 8);
          const f32x4 va = {O[b][8 * j] * rstd * ga[0], O[b][8 * j + 1] * rstd * ga[1], O[b][8 * j + 2] * rstd * ga[2], O[b][8 * j + 3] * rstd * ga[3]};
          const f32x4 vb = {O[b][8 * j + 4] * rstd * gb[0], O[b][8 * j + 5] * rstd * gb[1], O[b][8 * j + 6] * rstd * gb[2], O[b][8 * j + 7] * rstd * gb[3]};
          *(u32x4*)(op + 32 * b + 16 * j) = pair_swap(pack4(va), pack4(vb)); } }
    __syncthreads();
  }
}

DI void copy_item(const Params& p, int layer, int idx) {
  const int which = idx >> 5, bd = idx & 31;
  const size_t lb = (size_t)layer * DB + bd;
  const f32x4* src = (const f32x4*)((which ? p.cache_a_v : p.cache_a_k) + lb * 512 * 512 + 64 * 512);
  f32x4* dst = (f32x4*)(p.out + (which ? O_SAV : O_SAK) + lb * 512 * 512);
  int tid_ = threadIdx.x; asm volatile("" : "+v"(tid_));
#pragma unroll 4
  for (int i = tid_; i < 448 * 128; i += NTHREADS) __builtin_nontemporal_store(__builtin_nontemporal_load(src + i), dst + i);
}
#ifndef PROBE_ATT_FLAGS
#define PROBE_ATT_FLAGS 0
#endif
#ifndef PROBE_ATT_LO
#define PROBE_ATT_LO 0
#define PROBE_ATT_HI NITEMS
#endif
DI void attn_phase(const Params& p, int qidx, LAS unsigned char* lds) {
  const int layer = qidx & 1; const int i_lo = qidx >= 2 ? PROBE_ATT_LO : 0, i_hi = qidx >= 2 ? PROBE_ATT_HI : NITEMS;
  unsigned* head = (unsigned*)(p.ws + WS_CTL) + CW_QUEUE + 64 * qidx;
  LAS unsigned* slot = (LAS unsigned*)(lds + LDS_BYTES - 48);
  if (threadIdx.x == 0) slot[0] = atomicAdd(head, 1u);
  for (int k = 0;; ++k) {
    __syncthreads();
    const int idx = __builtin_amdgcn_readfirstlane((int)slot[k & 1]) + i_lo;
    if (threadIdx.x == 0) slot[(k + 1) & 1] = atomicAdd(head, 1u);
    if (idx >= i_hi) break;
    Item it = decode(p, layer, idx); it.pflags = qidx >= 2 ? PROBE_ATT_FLAGS : 0;
    if (it.mode == 3) { if (qidx < 2) copy_item(p, layer, it.h); continue; }
    if (it.past == 0) { if (it.mode == 0) run_item<0, false>(p, layer, it, lds); else if (it.mode == 1) run_item<1, false>(p, layer, it, lds); else run_item<2, false>(p, layer, it, lds); }
    else { if (it.mode == 0) run_item<0, true>(p, layer, it, lds); else if (it.mode == 1) run_item<1, true>(p, layer, it, lds); else run_item<2, true>(p, layer, it, lds); }
  }
}
}
#define XB_TMO      128
#define XB_XCNT(j)  (256  + 64 * (j))
#define XB_XSUB(j)  (1280 + 64 * (j))
#define XB_XGEN(j)  (2304 + 64 * (j))
#define XB_TOP      3328
#define XB_TOPGEN   3392
#define XCD_BAR_WORDS 3456
#define XB_SPIN_CAP (1u << 18)
DI unsigned xb_ld(unsigned* p)              { return __hip_atomic_load(p, __ATOMIC_RELAXED, __HIP_MEMORY_SCOPE_AGENT); }
DI unsigned xb_add(unsigned* p, unsigned v) { return __hip_atomic_fetch_add(p, v, __ATOMIC_RELAXED, __HIP_MEMORY_SCOPE_AGENT); }
DI unsigned xb_xcc_id() { return (unsigned)__builtin_amdgcn_s_getreg((3 << 11) | 20) & 0xFu; }
#define XB_SPIN(cond, bar) do { unsigned _sp = 0; while (cond) { __builtin_amdgcn_s_sleep(1); \
    if ((++_sp & 255u) == 0u) { if (xb_ld(&(bar)[XB_TMO])) break; if (_sp > XB_SPIN_CAP) { atomicAdd(&(bar)[XB_TMO], 1u); break; } } } } while (0)
struct XcdBarrier { unsigned* bar; unsigned x; volatile LAS unsigned* st; };
DI XcdBarrier xcd_barrier_post(unsigned* bar, volatile LAS unsigned* st) {
  XcdBarrier b; b.bar = bar; b.x = xb_xcc_id(); b.st = st;
  if (threadIdx.x == 0) (void)xb_add(&bar[XB_XCNT(b.x)], 1u);
  return b;
}
DI void xcd_barrier_complete(unsigned* bar, unsigned x, unsigned& nloc, unsigned& nx) {
  const unsigned G = gridDim.x * gridDim.y * gridDim.z;
  unsigned sum, cnt, mine, sp = 0u;
  for (;;) {
    sum = 0u; cnt = 0u; mine = 0u;
#pragma unroll
    for (unsigned j = 0; j < 16; ++j) { const unsigned c = xb_ld(&bar[XB_XCNT(j)]); sum += c; cnt += (c > 0u) ? 1u : 0u; mine = (j == x) ? c : mine; }
    if (sum == G) break;
    __builtin_amdgcn_s_sleep(1);
    if ((++sp & 255u) == 0u) { if (xb_ld(&bar[XB_TMO])) break; if (sp > XB_SPIN_CAP) { atomicAdd(&bar[XB_TMO], 1u); break; } }
  }
  nloc = mine > 0u ? mine : 1u; nx = cnt > 0u ? cnt : 1u;
}
DI void xcd_barrier(const XcdBarrier& b) {
  asm volatile("s_waitcnt vmcnt(0)" ::: "memory");
  __syncthreads();
  if (threadIdx.x == 0) {
    unsigned* bar = b.bar;
    __builtin_amdgcn_s_waitcnt(0);
    unsigned nloc = b.st[0], nx = b.st[1];
    if (nloc == 0u) { xcd_barrier_complete(bar, b.x, nloc, nx); b.st[0] = nloc; b.st[1] = nx; }
    const unsigned old = xb_add(&bar[XB_XSUB(b.x)], 1u);
    const unsigned gen = old / nloc;
    if (old + 1u == (gen + 1u) * nloc) {
      __builtin_amdgcn_fence(__ATOMIC_RELEASE, "agent");
      asm volatile("s_waitcnt vmcnt(0)" ::: "memory");
      const unsigned og = xb_add(&bar[XB_TOP], 1u);
      const unsigned tg = og / nx;
      if (og + 1u == (tg + 1u) * nx) xb_add(&bar[XB_TOPGEN], 1u);
      else XB_SPIN(xb_ld(&bar[XB_TOPGEN]) == tg, bar);
      __builtin_amdgcn_fence(__ATOMIC_ACQUIRE, "agent");
      xb_add(&bar[XB_XGEN(b.x)], 1u);
      asm volatile("s_waitcnt vmcnt(0)" ::: "memory");
    } else {
      XB_SPIN(xb_ld(&bar[XB_XGEN(b.x)]) == gen, bar);
      __builtin_amdgcn_fence(__ATOMIC_ACQUIRE, "agent");
      asm volatile("s_waitcnt vmcnt(0)" ::: "memory");
    }
  }
  __syncthreads();
}
constexpr int L_BARST = LDS_BYTES - 64;

#ifndef PROBE_P1_FLAGS
#define PROBE_P1_FLAGS 0
#endif
#ifndef PROBE_NULL_EPI
#define PROBE_NULL_EPI 0
#endif
#ifndef PROBE_MASK
#define PROBE_MASK 0
#endif
#define REPEAT(k) for (int rep_ = 0; rep_ < (((PROBE_MASK >> (k)) & 1) ? 2 : 1); ++rep_)
constexpr int NPHASE = 2 + 6 * NLAYER;
__global__ void __launch_bounds__(NTHREADS, 2) fwd_megakernel(Params p_k) {
  extern __shared__ __attribute__((aligned(16))) unsigned char lds_raw[];
  LAS unsigned char* lds = (LAS unsigned char*)lds_raw;
  cg::grid_group grid = cg::this_grid();
  const int lo = p_k.ph_lo, hi = p_k.ph_hi;
#define IN(k) (lo <= (k) && (k) < hi)
#define SEAM(k) do { if (IN(k) && IN((k) + 1)) xcd_barrier(bar); } while (0)
  const int G = gridDim.x, c = blockIdx.x;
  if (threadIdx.x < 2) ((LAS unsigned*)(lds + L_BARST))[threadIdx.x] = 0u;
  XcdBarrier bar; bar.bar = (unsigned*)(p_k.ws + WS_CTL) + CW_BAR; bar.x = 0; bar.st = (volatile LAS unsigned*)(lds + L_BARST);
  if (p_k.ph_lo < 0) grid.sync();
  bar = xcd_barrier_post((unsigned*)(p_k.ws + WS_CTL) + CW_BAR, (volatile LAS unsigned*)(lds + L_BARST));
  if (IN(0)) { p0_prologue(p_k, lds); if ((PROBE_MASK >> 6) & 1) { __syncthreads(); p0_prologue(p_k, lds); } }
  SEAM(0);
  for (int l = 0; l < NLAYER; ++l) {
    const int pb = 1 + 6 * l;
    const Params& p = p_k; unsigned char* ws = p.ws;
    if (IN(pb + 0)) REPEAT(0) {
      pg8::GemmDesc g{(const char*)(ws + WS_XB), (const char*)(ws + WS_WIN) + (size_t)l * INC * D * 2, D, D, D / 64, (size_t)256 * D * 2, (size_t)128 * D * 2};
      pg8::P1Order S; S.R1.init(TOK / 256, pg8::P1_NN, G, c);
      EpiP1 E{(const float*)(ws + WS_SS), (bf16_t*)(ws + WS_QKV), (bf16_t*)(ws + WS_GATE), p.b_gate + (size_t)l * 3 * D, p.out, l, rep_ == 1 ? PROBE_P1_FLAGS : 0, lds};
#if PROBE_NULL_EPI
      if (rep_ == 1) { EpiNull EN; pg8::gemm_phase<EpiNull, false, false, pg8::P1Order>(lds, g, S, EN); } else
#endif
      pg8::gemm_phase<EpiP1, false, false, pg8::P1Order>(lds, g, S, E);
    }
    SEAM(pb + 0);
    if (IN(pb + 1)) REPEAT(1) {
      for (int j = G - 1 - c; j < pg8::P1_DEFER; j += G) { pg8::OneUnit S1; S1.u = pg8::p1_deferred_unit(j);
        pg8::gemm_phase<EpiP1, false, false, pg8::OneUnit>(lds, p1_desc(ws, l), S1, p1_epi(p, l, lds)); }
      attn::attn_phase(p, l + 2 * rep_, lds); }
    SEAM(pb + 1);
    if (IN(pb + 2)) REPEAT(2) {
      pg8::GemmDesc g{(const char*)(ws + WS_O), (const char*)(ws + WS_WBR) + (size_t)l * D * OW * 2, OW, OW, OW / 64, (size_t)256 * OW * 2, (size_t)128 * OW * 2};
      pg8::StaticOrder S; S.init(TOKP / 256, D / 256, G, c);
      EpiP3 E{(const bf16_t*)(ws + WS_GATE), (bf16_t*)(ws + WS_H)};
      pg8::gemm_phase<EpiP3>(lds, g, S, E);
      pg8::GemmDesc gh = g; gh.b_tile = (size_t)128 * OW * 2;
      pg8::StaticOrder S2; S2.init(TOKS / 128, D / 128, G, c, TOKP / 128);
      EpiP3T<true, true> E2{(const bf16_t*)(ws + WS_GATE), (bf16_t*)(ws + WS_H)};
      pg8::gemm_phase<EpiP3T<true, true>, true, true>(lds, gh, S2, E2);
      if (rep_ == 0) { const int nidle = G - S2.nwg, f0 = l == 0 ? SL_03 : SL_13, n0 = l == 0 ? SN_03 : SN_13; if (nidle <= 0) late_transposes(p, lds, f0, n0, c, G); else if (c >= S2.nwg) late_transposes(p, lds, f0, n0, c - S2.nwg, nidle); }
    }
    SEAM(pb + 2);
    if (IN(pb + 3)) {
      pg8::GemmDesc g{(const char*)(ws + WS_H), (const char*)(ws + WS_WOUT) + (size_t)l * D * D * 2, D, D, D / 64, (size_t)256 * D * 2, (size_t)128 * D * 2};
      pg8::StaticOrder S; S.init(TOKP / 256, D / 256, G, c);
      EpiRes E{(float*)(ws + WS_X32), (bf16_t*)(ws + WS_XB), (float*)(ws + WS_SS), lds, l == 0 ? p.x_prompt : nullptr, l == 0 ? p.x_sample : nullptr};
      pg8::gemm_phase<EpiRes>(lds, g, S, E);
      pg8::GemmDesc gh = g; gh.b_tile = (size_t)128 * D * 2;
      pg8::StaticOrder S2; S2.init(TOKS / 128, D / 128, G, c, TOKP / 128);
      EpiResT<true, true> E2{(float*)(ws + WS_X32), (bf16_t*)(ws + WS_XB), (float*)(ws + WS_SS), lds, l == 0 ? p.x_prompt : nullptr, l == 0 ? p.x_sample : nullptr};
      pg8::gemm_phase<EpiResT<true, true>, true, true>(lds, gh, S2, E2);
      { const int nidle = G - S2.nwg, f0 = SL_04, n0 = l == 0 ? SN_04 : 0; if (nidle <= 0) late_transposes(p, lds, f0, n0, c, G); else if (c >= S2.nwg) late_transposes(p, lds, f0, n0, c - S2.nwg, nidle); }
    }
    SEAM(pb + 3);
    if (IN(pb + 4)) REPEAT(4) {
      pg8::GemmDesc g{(const char*)(ws + WS_XB), (const char*)(ws + WS_WUP) + (size_t)l * 2 * DFF * D * 2, D, D, D / 64, (size_t)128 * D * 2, (size_t)DFF * D * 2};
      pg8::StaticOrder S; S.init(TOKP / 256, DFF / 128, G, c);
      EpiP5F E{(const float*)(ws + WS_SS), (bf16_t*)(ws + WS_HF), p.out, p.conv_w + (size_t)l * 3 * DFF, p.conv_b + (size_t)l * DFF, p.state_conv + (size_t)l * DB * 2 * DFF, (float*)(ws + WS_SIDE), lds, l};
      pg8::gemm_phase<EpiP5F>(lds, g, S, E);
      pg8::StaticOrder S2; S2.init(TOKS / 128, DFF / 128, G, (c + G / 2) % G, TOKP / 128);
      EpiP5FT<true> E2{(const float*)(ws + WS_SS), (bf16_t*)(ws + WS_HF), p.out, p.conv_w + (size_t)l * 3 * DFF, p.conv_b + (size_t)l * DFF, p.state_conv + (size_t)l * DB * 2 * DFF, (float*)(ws + WS_SIDE), lds, l};
      pg8::gemm_phase<EpiP5FT<true>, false, true>(lds, g, S2, E2);
      if (rep_ == 0) {
        const int nfull = S.nwg % G, f0 = l == 0 ? SL_05 : SL_15, n0 = l == 0 ? SN_05 : SN_15;
        if (nfull <= 0 || nfull >= G) late_transposes(p, lds, f0, n0, c, G); else if (c >= nfull) late_transposes(p, lds, f0, n0, c - nfull, G - nfull); }
    }
    SEAM(pb + 4);
    if (IN(pb + 5)) {
      pg8::GemmDesc g{(const char*)(ws + WS_HF), (const char*)(ws + WS_WDN) + (size_t)l * D * DFF * 2, DFF, DFF, DFF / 64, (size_t)256 * DFF * 2, (size_t)128 * DFF * 2};
      pg8::StaticOrder S; S.init(TOKP / 256, D / 256, G, c);
      { pg8::Unit uu; for (int i = 0; S.next(i, uu); ++i) if (uu.pm < 64 && (uu.pm & 15) != 0) p6_fixup_panel(uu.pm, (const float*)(ws + WS_SIDE), p.conv_w + (size_t)l * 3 * DFF, (bf16_t*)(ws + WS_HF));
        asm volatile("s_waitcnt vmcnt(0)" ::: "memory"); __syncthreads(); }
      EpiRes E{(float*)(ws + WS_X32), (bf16_t*)(ws + WS_XB), (float*)(ws + WS_SS), lds, nullptr, nullptr};
      pg8::gemm_phase<EpiRes>(lds, g, S, E);
      const bool early_fin = l == NLAYER - 1 && G > (TOKS / 128) * (D / 128);
      if (early_fin) { asm volatile("s_waitcnt vmcnt(0)" ::: "memory"); __syncthreads();
        if (threadIdx.x == 0) { __builtin_amdgcn_fence(__ATOMIC_RELEASE, "agent"); asm volatile("s_waitcnt vmcnt(0)" ::: "memory"); (void)xb_add((unsigned*)(ws + WS_CTL) + CW_FIN, 1u); } }
      pg8::GemmDesc gh = g; gh.b_tile = (size_t)128 * DFF * 2;
      pg8::StaticOrder S2; S2.init(TOKS / 128, D / 128, G, c, TOKP / 128);
      EpiResT<true, true> E2{(float*)(ws + WS_X32), (bf16_t*)(ws + WS_XB), (float*)(ws + WS_SS), lds, nullptr, nullptr};
      pg8::gemm_phase<EpiResT<true, true>, true, true>(lds, gh, S2, E2);
      if (l == 0) { const int nidle = G - S2.nwg; if (nidle <= 0) late_transposes(p, lds, SL_06, SN_06, c, G); else if (c >= S2.nwg) late_transposes(p, lds, SL_06, SN_06, c - S2.nwg, nidle); }
      if (early_fin && c >= S2.nwg) {
        if (threadIdx.x == 0) { unsigned* fin = (unsigned*)(ws + WS_CTL) + CW_FIN; XB_SPIN(xb_ld(fin) < (unsigned)G, bar.bar); __builtin_amdgcn_fence(__ATOMIC_ACQUIRE, "agent"); asm volatile("s_waitcnt vmcnt(0)" ::: "memory"); }
        __syncthreads();
        pfinal_norm(p, 0, TOKP, c - S2.nwg, G - S2.nwg);
      }
    }
    SEAM(pb + 5);
  }
  if (IN(NPHASE - 1)) { if (G > (TOKS / 128) * (D / 128)) pfinal_norm(p_k, TOKP, TOK, c, G); else pfinal_norm(p_k, 0, TOK, c, G); }
#undef IN
#undef SEAM
}

#ifndef MK_ONE_LAUNCH
#define MK_ONE_LAUNCH 1
#endif
extern "C" void kernel_launch(void* const* d_in, const int* in_sizes, int n_in, void* d_out, int out_size, void* d_ws, size_t ws_size, hipStream_t stream) {
  static int grid_blocks = 0;
  if (grid_blocks == 0) {
    int dev = 0, cus = 0, per_cu = 0;
    (void)hipGetDevice(&dev);
    (void)hipDeviceGetAttribute(&cus, hipDeviceAttributeMultiprocessorCount, dev);
    (void)hipFuncSetAttribute((const void*)fwd_megakernel, hipFuncAttributeMaxDynamicSharedMemorySize, LDS_BYTES);
    (void)hipOccupancyMaxActiveBlocksPerMultiprocessor(&per_cu, (const void*)fwd_megakernel, NTHREADS, LDS_BYTES);
    if (per_cu < 1) { fprintf(stderr, "kernel_launch: occupancy query says %d blocks/CU\n", per_cu); per_cu = 1; }
    grid_blocks = cus * per_cu;
    if (n_in != 24 || (size_t)out_size != O_END || ws_size < WS_END) { fprintf(stderr, "kernel_launch: unexpected problem (n_in %d out %d ws %zu, need %zu)\n", n_in, out_size, ws_size, (size_t)WS_END); grid_blocks = -1; }
  }
  if (grid_blocks < 0) return;
  Params p{};
  const float** f = (const float**)&p;
  for (int i = 0; i < 24; ++i) f[i] = (const float*)d_in[i];
  p.out = (float*)d_out; p.ws = (unsigned char*)d_ws;
#if MK_ONE_LAUNCH
  p.ph_lo = 0; p.ph_hi = NPHASE;
  (void)hipMemsetAsync((unsigned char*)d_ws + WS_CTL + (size_t)CW_BAR * 4, 0, (size_t)XCD_BAR_WORDS * 4, stream);
  { void* args[] = {&p};
    hipError_t e = hipLaunchCooperativeKernel((void*)fwd_megakernel, dim3(grid_blocks), dim3(NTHREADS), args, LDS_BYTES, stream);
    if (e != hipSuccess) fprintf(stderr, "cooperative launch failed: %s (grid %d)\n", hipGetErrorString(e), grid_blocks); }
#else
  for (int k = 0; k < NPHASE; ++k) { p.ph_lo = k; p.ph_hi = k + 1; void* args[] = {&p};
    hipError_t e = hipLaunchCooperativeKernel((void*)fwd_megakernel, dim3(grid_blocks), dim3(NTHREADS), args, LDS_BYTES, stream);
    if (e != hipSuccess) { fprintf(stderr, "launch %d failed: %s (grid %d)\n", k, hipGetErrorString(e), grid_blocks); break; } }
#endif
}
```
